# Optimizing an MI355X kernel written in HIP

```python
import math
import jax, jax.numpy as jnp
from jax import lax
import numpy as np

D_MODEL = 2048
BATCH = 8
SEQ = 2048
DEPTH = 1

SSM_WIDTH = D_MODEL // 2
SSM_GROUP = 16
SSM_GROUPS = SSM_WIDTH // SSM_GROUP
SSM_STATE = 64
RET_WIDTH = D_MODEL - SSM_WIDTH
RET_HEADS = 8
RET_HEAD_DIM = RET_WIDTH // RET_HEADS
RET_CHUNK = 128
ROPE_BASE = 10000.0
N_GROUPS = 4
EXPERTS_PER_GROUP = 8
N_EXPERTS = N_GROUPS * EXPERTS_PER_GROUP
TOP_K = 2
D_EXPERT = D_MODEL // 2
MOE_BLOCK = 256
N_MOD = 6
NORM_EPS = 1e-6
GN_EPS = 1e-5
DT_MIN = 1e-3
DT_MAX = 1e-1

kernel_name = "hymba_s5_retnet_hiermoe_adaln"


def rms_norm(x, gain):
    xf = x.astype(jnp.float32)
    y = xf * lax.rsqrt(jnp.mean(xf * xf, axis=-1, keepdims=True) + NORM_EPS)
    return (y * gain.astype(jnp.float32)).astype(x.dtype)


def cmul(ar, ai, br, bi):
    return ar * br - ai * bi, ar * bi + ai * br


def s5_mixer(u, a_re, a_im, b_re, b_im, c_re, c_im, d_skip, log_dt, w_glu, beta):
    bn, L, _ = u.shape
    f32 = jnp.float32
    uf = u.astype(f32).reshape(bn, L, SSM_GROUPS, SSM_GROUP)
    a_re = a_re.astype(f32)
    a_im = a_im.astype(f32)
    dt = jnp.exp(log_dt.astype(f32))[:, None]
    mag = jnp.exp(dt * a_re)
    ab_re = mag * jnp.cos(dt * a_im)
    ab_im = mag * jnp.sin(dt * a_im)
    inv_abs2 = 1.0 / (a_re * a_re + a_im * a_im)
    n_re = ab_re - 1.0
    f_re = (n_re * a_re + ab_im * a_im) * inv_abs2
    f_im = (ab_im * a_re - n_re * a_im) * inv_abs2
    bb_re, bb_im = cmul(f_re[..., None], f_im[..., None],
                        b_re.astype(f32), b_im.astype(f32))
    bu_re = jnp.einsum('blgh,gph->blgp', uf, bb_re)
    bu_im = jnp.einsum('blgh,gph->blgp', uf, bb_im)
    a_seq_re = jnp.broadcast_to(ab_re, (1, L, SSM_GROUPS, SSM_STATE))
    a_seq_im = jnp.broadcast_to(ab_im, (1, L, SSM_GROUPS, SSM_STATE))

    def combine(e1, e2):
        ar1, ai1, br1, bi1 = e1
        ar2, ai2, br2, bi2 = e2
        ar, ai = cmul(ar2, ai2, ar1, ai1)
        xr, xi = cmul(ar2, ai2, br1, bi1)
        return ar, ai, xr + br2, xi + bi2

    _, _, s_re, s_im = lax.associative_scan(
        combine, (a_seq_re, a_seq_im, bu_re, bu_im), axis=1)
    y = (jnp.einsum('blgp,ghp->blgh', s_re, c_re.astype(f32))
         - jnp.einsum('blgp,ghp->blgh', s_im, c_im.astype(f32))
         + d_skip.astype(f32) * uf)
    y = y.reshape(bn, L, SSM_WIDTH)
    z = jax.nn.gelu(y)
    out = z * jax.nn.sigmoid(z @ w_glu.astype(f32))
    return rms_norm(out, beta)


def rope(x, L):
    half = RET_HEAD_DIM // 2
    inv_freq = 1.0 / (ROPE_BASE ** (jnp.arange(half, dtype=jnp.float32) * 2.0 / RET_HEAD_DIM))
    ang = jnp.arange(L, dtype=jnp.float32)[:, None] * inv_freq[None, :]
    cos = jnp.cos(ang)[None, :, None, :]
    sin = jnp.sin(ang)[None, :, None, :]
    x1, x2 = x[..., :half], x[..., half:]
    return jnp.concatenate([x1 * cos - x2 * sin, x2 * cos + x1 * sin], axis=-1)


def retention(q, k, v, g, beta):
    bn, L, _ = q.shape
    f32 = jnp.float32
    H, Dh, C = RET_HEADS, RET_HEAD_DIM, RET_CHUNK
    nc = L // C
    q = rope(q.astype(f32).reshape(bn, L, H, Dh), L)
    k = rope(k.astype(f32).reshape(bn, L, H, Dh), L) * (Dh ** -0.5)
    v = v.astype(f32).reshape(bn, L, H, Dh)
    gamma = 1.0 - jnp.exp2(-5.0 - jnp.arange(H, dtype=f32))
    log_g = jnp.log(gamma)
    idx = jnp.arange(C, dtype=f32)
    rel = idx[:, None] - idx[None, :]
    decay = jnp.where(rel >= 0, jnp.exp(log_g[:, None, None] * jnp.maximum(rel, 0.0)), 0.0)
    qc = q.reshape(bn, nc, C, H, Dh)
    kc = k.reshape(bn, nc, C, H, Dh)
    vc = v.reshape(bn, nc, C, H, Dh)
    s = jnp.einsum('bnchd,bnmhd->bnhcm', qc, kc) * decay[None, None]
    inner = jnp.einsum('bnhcm,bnmhe->bnche', s, vc)
    zeta = jnp.exp(log_g[:, None] * (C - 1.0 - idx)[None, :])
    kv = jnp.einsum('bnmhd,hm,bnmhe->bnhde', kc, zeta, vc)
    g_chunk = jnp.exp(log_g * C)[None, :, None, None]

    def step(r, kv_n):
        return r * g_chunk + kv_n, r

    _, r_prev = lax.scan(step, jnp.zeros((bn, H, Dh, Dh), f32), jnp.moveaxis(kv, 1, 0))
    r_prev = jnp.moveaxis(r_prev, 0, 1)
    xi = jnp.exp(log_g[None, :] * (idx + 1.0)[:, None])
    cross = jnp.einsum('bnchd,bnhde->bnche', qc, r_prev) * xi[None, None, :, :, None]
    y = (inner + cross).reshape(bn, L, H, Dh)
    mu = jnp.mean(y, axis=-1, keepdims=True)
    var = jnp.mean(jnp.square(y - mu), axis=-1, keepdims=True)
    y = ((y - mu) * lax.rsqrt(var + GN_EPS)).reshape(bn, L, RET_WIDTH) * beta.astype(f32)
    return jax.nn.silu(g.astype(f32)) * y


def hier_moe(h, w_rg, b_rg, w_re, b_re, w_gate, w_up, w_down):
    bn, L, D = h.shape
    T = bn * L
    f32 = jnp.float32
    hf = h.reshape(T, D)
    gl = (hf @ w_rg + b_rg).astype(f32)
    gp = jax.nn.softmax(gl, axis=-1)
    g_sel = jnp.argmax(gl, axis=-1)
    g_w = jnp.take_along_axis(gp, g_sel[:, None], axis=1)[:, 0]
    el = (hf @ w_re + b_re).astype(f32).reshape(T, N_GROUPS, EXPERTS_PER_GROUP)
    el_sel = jnp.take_along_axis(el, g_sel[:, None, None], axis=1)[:, 0]
    top_l, top_j = lax.top_k(el_sel, TOP_K)
    top_w = jax.nn.softmax(top_l, axis=-1) * g_w[:, None]
    eid = g_sel[:, None] * EXPERTS_PER_GROUP + top_j
    A = T * TOP_K
    e_flat = eid.reshape(A).astype(jnp.int32)
    w_flat = top_w.reshape(A)
    tok = jnp.arange(A, dtype=jnp.int32) // TOP_K
    order = jnp.argsort(e_flat)
    s_e = e_flat[order]
    s_tok = tok[order]
    s_w = w_flat[order]
    counts = jnp.bincount(e_flat, length=N_EXPERTS)
    padded = ((counts + MOE_BLOCK - 1) // MOE_BLOCK) * MOE_BLOCK
    off = jnp.cumsum(counts) - counts
    pend = jnp.cumsum(padded)
    poff = pend - padded
    dest = poff[s_e] + jnp.arange(A, dtype=jnp.int32) - off[s_e]
    nb = -(-A // MOE_BLOCK) + N_EXPERTS
    P = nb * MOE_BLOCK
    slot_tok = jnp.full((P,), T, jnp.int32).at[dest].set(s_tok)
    slot_w = jnp.zeros((P,), f32).at[dest].set(s_w)
    block_e = jnp.minimum(
        jnp.searchsorted(pend, jnp.arange(nb, dtype=jnp.int32) * MOE_BLOCK, side='right'),
        N_EXPERTS - 1)
    x_pad = jnp.concatenate([hf, jnp.zeros((1, D), hf.dtype)], axis=0)
    xs = x_pad[slot_tok].reshape(nb, MOE_BLOCK, D)

    def expert_block(args):
        xb, e = args
        return (jax.nn.silu(xb @ w_gate[e]) * (xb @ w_up[e])) @ w_down[e]

    ys = lax.map(expert_block, (xs, block_e)).reshape(P, D)
    ys = ys * slot_w[:, None].astype(ys.dtype)
    out = jax.ops.segment_sum(ys, slot_tok, num_segments=T + 1)[:T]
    return out.reshape(bn, L, D)


def setup_inputs(seed: int = 0) -> dict:
    key = jax.random.key(seed)
    ks = jax.random.split(key, 32)
    f32 = jnp.float32
    D, G, P, Hc = D_MODEL, SSM_GROUPS, SSM_STATE, SSM_GROUP
    nrm = lambda k, shape, s: jax.random.normal(k, shape, f32) * s
    gain = lambda k, shape: 1.0 + 0.02 * jax.random.normal(k, shape, f32)
    return {
        "x": jax.random.normal(ks[0], (BATCH, SEQ, D), f32),
        "c": jax.random.normal(ks[1], (BATCH, D), f32),
        "w_ada": nrm(ks[2], (DEPTH, D, N_MOD * D), D ** -0.5),
        "b_ada": nrm(ks[3], (DEPTH, N_MOD * D), 0.02),
        "g_norm1": gain(ks[4], (DEPTH, D)),
        "w_in": nrm(ks[5], (DEPTH, D, SSM_WIDTH + 4 * RET_WIDTH), D ** -0.5),
        "ssm_a_re": -0.5 + 0.01 * jax.random.normal(ks[6], (DEPTH, G, P), f32),
        "ssm_a_im": math.pi * jnp.arange(P, dtype=f32)[None, None, :]
                    + 0.01 * jax.random.normal(ks[7], (DEPTH, G, P), f32),
        "ssm_b_re": nrm(ks[8], (DEPTH, G, P, Hc), (2 * Hc) ** -0.5),
        "ssm_b_im": nrm(ks[9], (DEPTH, G, P, Hc), (2 * Hc) ** -0.5),
        "ssm_c_re": nrm(ks[10], (DEPTH, G, Hc, P), (2 * P) ** -0.5),
        "ssm_c_im": nrm(ks[11], (DEPTH, G, Hc, P), (2 * P) ** -0.5),
        "ssm_d": nrm(ks[12], (DEPTH, G, Hc), 1.0),
        "ssm_log_dt": jax.random.uniform(ks[13], (DEPTH, G), f32,
                                         math.log(DT_MIN), math.log(DT_MAX)),
        "w_glu": nrm(ks[14], (DEPTH, SSM_WIDTH, SSM_WIDTH), SSM_WIDTH ** -0.5),
        "beta_ssm": gain(ks[15], (DEPTH, SSM_WIDTH)),
        "beta_ret": gain(ks[16], (DEPTH, RET_WIDTH)),
        "w_out": nrm(ks[17], (DEPTH, D, D), D ** -0.5),
        "g_norm2": gain(ks[18], (DEPTH, D)),
        "w_router_group": nrm(ks[19], (DEPTH, D, N_GROUPS), D ** -0.5),
        "b_router_group": nrm(ks[20], (DEPTH, N_GROUPS), 0.01),
        "w_router_expert": nrm(ks[21], (DEPTH, D, N_EXPERTS), D ** -0.5),
        "b_router_expert": nrm(ks[22], (DEPTH, N_EXPERTS), 0.01),
        "w_gate": nrm(ks[23], (DEPTH, N_EXPERTS, D, D_EXPERT), D ** -0.5),
        "w_up": nrm(ks[24], (DEPTH, N_EXPERTS, D, D_EXPERT), D ** -0.5),
        "w_down": nrm(ks[25], (DEPTH, N_EXPERTS, D_EXPERT, D), D_EXPERT ** -0.5),
        "g_final": gain(ks[26], (D,)),
    }


def reference(x, c, w_ada, b_ada, g_norm1, w_in, ssm_a_re, ssm_a_im, ssm_b_re, ssm_b_im,
              ssm_c_re, ssm_c_im, ssm_d, ssm_log_dt, w_glu, beta_ssm, beta_ret, w_out,
              g_norm2, w_router_group, b_router_group, w_router_expert, b_router_expert,
              w_gate, w_up, w_down, g_final):
    splits = [SSM_WIDTH, SSM_WIDTH + RET_WIDTH, SSM_WIDTH + 2 * RET_WIDTH,
              SSM_WIDTH + 3 * RET_WIDTH]
    for l in range(DEPTH):
        mod = jax.nn.silu(c) @ w_ada[l] + b_ada[l]
        sh1, sc1, gt1, sh2, sc2, gt2 = jnp.split(mod, N_MOD, axis=-1)
        h = rms_norm(x, g_norm1[l]) * (1.0 + sc1[:, None, :]) + sh1[:, None, :]
        proj = h @ w_in[l]
        u, q, k, v, g = jnp.split(proj, splits, axis=-1)
        y_ssm = s5_mixer(u, ssm_a_re[l], ssm_a_im[l], ssm_b_re[l], ssm_b_im[l],
                         ssm_c_re[l], ssm_c_im[l], ssm_d[l], ssm_log_dt[l],
                         w_glu[l], beta_ssm[l])
        y_ret = retention(q, k, v, g, beta_ret[l])
        mixed = jnp.concatenate([y_ssm, y_ret], axis=-1).astype(x.dtype) @ w_out[l]
        x = x + gt1[:, None, :] * mixed
        h2 = rms_norm(x, g_norm2[l]) * (1.0 + sc2[:, None, :]) + sh2[:, None, :]
        y_moe = hier_moe(h2, w_router_group[l], b_router_group[l], w_router_expert[l],
                         b_router_expert[l], w_gate[l], w_up[l], w_down[l])
        x = x + gt2[:, None, :] * y_moe.astype(x.dtype)
    return rms_norm(x, g_final)
```

```cpp
#include <hip/hip_runtime.h>
#include <cstdio>
#include <cstdint>

#define LAS __attribute__((address_space(3)))
typedef unsigned short bf16_t;
typedef short bf16x8 __attribute__((ext_vector_type(8)));
typedef short bf16x4 __attribute__((ext_vector_type(4)));
typedef float f32x4 __attribute__((ext_vector_type(4)));
typedef float f32x2 __attribute__((ext_vector_type(2)));
typedef unsigned u32x4 __attribute__((ext_vector_type(4)));
typedef unsigned u32x2 __attribute__((ext_vector_type(2)));

constexpr int DM = 2048, NB = 8, SEQ = 2048, NTOK = NB * SEQ;
constexpr int NPROJ = 5120;
constexpr int NMOD = 6 * DM;
constexpr int NEXP = 32, DEXP = 1024;
constexpr int NTHREADS = 512;

constexpr size_t WS_BAR   = 0;
constexpr size_t WS_CNT   = 16384;
constexpr size_t WS_ROWSS1= WS_CNT + 4096;
constexpr size_t WS_ROWSS2= WS_ROWSS1 + 65536;
constexpr size_t WS_MODP  = WS_ROWSS2 + 65536;
constexpr size_t WS_MOD   = WS_MODP + (size_t)4 * 8 * NMOD * 4;
constexpr size_t WS_ROPE  = WS_MOD + (size_t)8 * NMOD * 4;
constexpr size_t WS_SSMA  = WS_ROPE + (size_t)2048 * 64 * 8;
constexpr size_t WS_WR    = WS_SSMA + (size_t)64 * 64 * 8;
constexpr size_t WS_SSMM  = WS_WR + (size_t)48 * 2048 * 2;
constexpr size_t WS_WIN   = WS_SSMM + (size_t)64 * 131072 * 2;
constexpr size_t WS_WOUT  = WS_WIN + (size_t)NPROJ * DM * 2;
constexpr size_t WS_WGLU  = WS_WOUT + (size_t)DM * DM * 2;
constexpr size_t WS_WGU   = WS_WGLU + (size_t)1024 * 1024 * 2;
constexpr size_t WS_WD    = WS_WGU + (size_t)NEXP * 2048 * 2048 * 2;
constexpr size_t WS_H     = WS_WD + (size_t)NEXP * 2048 * 1024 * 2;
constexpr size_t WS_PROJ  = WS_H + (size_t)NTOK * DM * 2;
constexpr size_t WS_Z     = WS_PROJ + (size_t)NTOK * NPROJ * 2;
constexpr size_t WS_CAT   = WS_Z + (size_t)NTOK * 1024 * 2;
constexpr size_t WS_WGT   = WS_CAT + (size_t)NTOK * DM * 2;
constexpr size_t WS_LIST  = WS_WGT + (size_t)32768 * 4;
constexpr size_t WS_END   = WS_LIST + (size_t)32 * 16384 * 4;
constexpr size_t WS_Y2    = WS_PROJ;
constexpr size_t WS_HM    = WS_Z;

constexpr int LDS_STAGE = 131072;
constexpr int LDS_BYTES = 147456;
constexpr int LDS_MISC  = LDS_BYTES - 2048;

struct Params { const float* in[27]; float* out; unsigned char* ws; int ph_lo, ph_hi; };

#define XB_TMO      128
#define XB_XCNT(j)  (256  + 64 * (j))
#define XB_XSUB(j)  (1280 + 64 * (j))
#define XB_XGEN(j)  (2304 + 64 * (j))
#define XB_TOP      3328
#define XB_TOPGEN   3392
#define XCD_BAR_WORDS 3456
#define XB_SPIN_CAP (1u << 22)

__device__ __forceinline__ unsigned xb_ld(unsigned* p)              { return __hip_atomic_load(p, __ATOMIC_RELAXED, __HIP_MEMORY_SCOPE_AGENT); }
__device__ __forceinline__ unsigned xb_add(unsigned* p, unsigned v) { return __hip_atomic_fetch_add(p, v, __ATOMIC_RELAXED, __HIP_MEMORY_SCOPE_AGENT); }
__device__ __forceinline__ unsigned xb_xcc_id() { return (unsigned)__builtin_amdgcn_s_getreg((3 << 11) | 20) & 0xFu; }
#define XB_SPIN(cond, bar) do { unsigned _sp = 0; while (cond) { __builtin_amdgcn_s_sleep(1); \
    if ((++_sp & 255u) == 0u) { if (xb_ld(&(bar)[XB_TMO])) break; if (_sp > XB_SPIN_CAP) { atomicAdd(&(bar)[XB_TMO], 1u); break; } } } } while (0)

struct XcdBarrier { unsigned* bar; unsigned x; volatile LAS unsigned* st; };

__device__ __forceinline__ XcdBarrier xcd_barrier_post(unsigned* bar, volatile LAS unsigned* st) {
    XcdBarrier b; b.bar = bar; b.x = xb_xcc_id(); b.st = st;
    if (threadIdx.x == 0) (void)xb_add(&bar[XB_XCNT(b.x)], 1u);
    return b;
}
__device__ __forceinline__ void xcd_barrier_complete(unsigned* bar, unsigned x, unsigned& nloc, unsigned& nx) {
    const unsigned G = gridDim.x * gridDim.y * gridDim.z;
    unsigned sum, cnt, mine, sp = 0u;
    for (;;) {
        sum = 0u; cnt = 0u; mine = 0u;
#pragma unroll
        for (unsigned j = 0; j < 16; ++j) { const unsigned c = xb_ld(&bar[XB_XCNT(j)]); sum += c; cnt += (c > 0u) ? 1u : 0u; mine = (j == x) ? c : mine; }
        if (sum == G) break;
        __builtin_amdgcn_s_sleep(1);
        if ((++sp & 255u) == 0u) { if (xb_ld(&bar[XB_TMO])) break; if (sp > XB_SPIN_CAP) { atomicAdd(&bar[XB_TMO], 1u); break; } }
    }
    nloc = mine > 0u ? mine : 1u; nx = cnt > 0u ? cnt : 1u;
}
__device__ __forceinline__ void xcd_barrier(const XcdBarrier& b) {
    asm volatile("s_waitcnt vmcnt(0)" ::: "memory");
    __syncthreads();
    if (threadIdx.x == 0) {
        unsigned* bar = b.bar;
        __builtin_amdgcn_s_waitcnt(0);
        unsigned nloc = b.st[0], nx = b.st[1];
        if (nloc == 0u) { xcd_barrier_complete(bar, b.x, nloc, nx); b.st[0] = nloc; b.st[1] = nx; }
        const unsigned old = xb_add(&bar[XB_XSUB(b.x)], 1u);
        const unsigned gen = old / nloc;
        if (old + 1u == (gen + 1u) * nloc) {
            __builtin_amdgcn_fence(__ATOMIC_RELEASE, "agent");
            asm volatile("s_waitcnt vmcnt(0)" ::: "memory");
            const unsigned og = xb_add(&bar[XB_TOP], 1u);
            const unsigned tg = og / nx;
            if (og + 1u == (tg + 1u) * nx) xb_add(&bar[XB_TOPGEN], 1u);
            else XB_SPIN(xb_ld(&bar[XB_TOPGEN]) == tg, bar);
            __builtin_amdgcn_fence(__ATOMIC_ACQUIRE, "agent");
            xb_add(&bar[XB_XGEN(b.x)], 1u);
            asm volatile("s_waitcnt vmcnt(0)" ::: "memory");
        } else {
            XB_SPIN(xb_ld(&bar[XB_XGEN(b.x)]) == gen, bar);
            __builtin_amdgcn_fence(__ATOMIC_ACQUIRE, "agent");
            asm volatile("s_waitcnt vmcnt(0)" ::: "memory");
        }
    }
    __syncthreads();
}

__device__ __forceinline__ unsigned cvt_pk_bf16(float lo, float hi) { unsigned r; asm("v_cvt_pk_bf16_f32 %0, %1, %2" : "=v"(r) : "v"(lo), "v"(hi)); return r; }
__device__ __forceinline__ float bf_lo(unsigned w) { return __uint_as_float(w << 16); }
__device__ __forceinline__ float bf_hi(unsigned w) { return __uint_as_float(w & 0xffff0000u); }
__device__ __forceinline__ float sigmoidf_(float x) { return 1.0f / (1.0f + __expf(-x)); }
__device__ __forceinline__ float gelu_tanh(float x) {
    const float u = 0.7978845608028654f * (x + 0.044715f * x * x * x);
    const float t = 1.0f - 2.0f / (1.0f + __expf(2.0f * u));
    return 0.5f * x * (1.0f + t);
}
__device__ __forceinline__ float wave_sum(float v) {
    v += __shfl_xor(v, 1); v += __shfl_xor(v, 2); v += __shfl_xor(v, 4); v += __shfl_xor(v, 8); v += __shfl_xor(v, 16); v += __shfl_xor(v, 32); return v;
}
__device__ __forceinline__ void sincos_d(double x, double& s, double& c) {
    const double TWO_PI = 6.283185307179586476925286766559;
    double r = x - TWO_PI * rint(x / TWO_PI);
    const double r2 = r * r;
    double ts = r, tc = 1.0; s = r; c = 1.0;
#pragma unroll 1
    for (int k = 1; k <= 14; ++k) { tc *= -r2 / (double)((2 * k - 1) * (2 * k)); ts *= -r2 / (double)((2 * k) * (2 * k + 1)); c += tc; s += ts; }
}

namespace g8 {
constexpr int BM = 256, BK = 64, HALF = 128, HTB = HALF * BK * 2, NXCD = 8, WGM = 8;
__device__ __forceinline__ int lds_byte(int r, int c) { const int st = (r >> 4) * 2 + (c >> 5), rr = r & 15, cc = c & 31, ob = rr * 64 + cc * 2; return st * 1024 + (ob ^ (((ob >> 9) & 1) << 5)); }
__device__ __forceinline__ void stage_rc(int b, int& R, int& C) { const int st = b / 1024, sb = b % 1024, swz = sb ^ (((sb >> 9) & 1) << 5); R = (st >> 1) * 16 + swz / 64; C = (st & 1) * 32 + (swz % 64) / 2; }
__device__ __forceinline__ int perm32(int rho) { const int n = rho >> 4, i = rho & 15; return 8 * (i >> 2) + 4 * n + (i & 3); }

struct Unit { unsigned aoff, boff; int pm, pn, flags, aux; };
typedef f32x4 Acc[2][2][4][2];

struct StaticOrder {
    int nM, nN, nwg, G, c;
    __device__ void init(int M, int N, int G_, int c_) { nM = M / BM; nN = N / BM; nwg = nM * nN; G = G_; c = c_; }
    __device__ __forceinline__ bool tile(int i, int& pm, int& pn) const {
        const long L = (long)i * G + c; if (L >= nwg) return false;
        int wgid = (int)L; { const int q = nwg / NXCD, r = nwg % NXCD, xcd = wgid % NXCD, off = wgid / NXCD; wgid = (xcd < r ? xcd * (q + 1) : r * (q + 1) + (xcd - r) * q) + off; }
        const int nig = WGM * nN, gid = wgid / nig, fm = gid * WGM, gsz = (nM - fm) < WGM ? (nM - fm) : WGM;
        pm = fm + ((wgid % nig) % gsz); pn = (wgid % nig) / gsz; return true;
    }
};

template <class Epi, class Sched>
__device__ __forceinline__ void gemm_phase(LAS unsigned char* lds, const unsigned char* ws, const int nt, const int ldb  , const Sched& S, const Epi& E) {
    const int tid = threadIdx.x, wid = __builtin_amdgcn_readfirstlane(tid >> 6), lane = tid & 63, wr = wid >> 2, wc = wid & 3, fr = lane & 15, fq = lane >> 4;
    int R0, C0, R1, C1; stage_rc(tid * 16, R0, C0); stage_rc(tid * 16 + 8192, R1, C1);
    unsigned voffB[2];
    { const int Rb0 = Epi::PERM ? ((R0 & ~31) + perm32(R0 & 31)) : R0, Rb1 = Epi::PERM ? ((R1 & ~31) + perm32(R1 & 31)) : R1;
      voffB[0] = (unsigned)(Rb0 * ldb + C0) * 2u; voffB[1] = (unsigned)(Rb1 * ldb + C1) * 2u; }
    const unsigned kstep = (unsigned)(BK * 2);
    const unsigned hstepB = (unsigned)HALF * (unsigned)ldb * 2u;
    const unsigned ldsw = (unsigned)wid * 1024u;
    const int aoff = lds_byte(wr * 64 + fr, fq * 8), boff = lds_byte(wc * 32 + fr, fq * 8);
#define G8_SA(b, h) (((b) * 2 + (h)) * HTB)
#define G8_SB(b, h) ((4 + (b) * 2 + (h)) * HTB)
#define G8_STAGE(bufoff, gbase, v0, v1) do { \
        __builtin_amdgcn_global_load_lds((const unsigned*)((gbase) + (v0)), (LAS unsigned*)(lds + (bufoff) + ldsw), 16, 0, 0); \
        __builtin_amdgcn_global_load_lds((const unsigned*)((gbase) + (v1)), (LAS unsigned*)(lds + (bufoff) + ldsw + 8192), 16, 0, 0); } while (0)
#define G8_LDA(dst, b, h) do { _Pragma("unroll") for (int m = 0; m < 4; ++m) _Pragma("unroll") for (int k = 0; k < 2; ++k) dst[m][k] = *(const LAS bf16x8*)(lds + G8_SA(b, h) + aoff + m * 2048 + k * 1024); } while (0)
#define G8_LDB(dst, b, h) do { _Pragma("unroll") for (int n = 0; n < 2; ++n) _Pragma("unroll") for (int k = 0; k < 2; ++k) dst[n][k] = *(const LAS bf16x8*)(lds + G8_SB(b, h) + boff + n * 2048 + k * 1024); } while (0)
#define G8_MMA(ai, bj, At, Bt) do { __builtin_amdgcn_s_setprio(1); _Pragma("unroll") for (int m = 0; m < 4; ++m) _Pragma("unroll") for (int n = 0; n < 2; ++n) _Pragma("unroll") for (int k = 0; k < 2; ++k) \
        acc[ai][bj][m][n] = __builtin_amdgcn_mfma_f32_16x16x32_bf16(Bt[n][k], At[m][k], acc[ai][bj][m][n], 0, 0, 0); __builtin_amdgcn_s_setprio(0); } while (0)
#define G8_WAIT_V(n) asm volatile("s_waitcnt vmcnt(" #n ")" ::: "memory")
#define G8_WAIT_L(n) asm volatile("s_waitcnt lgkmcnt(" #n ")" ::: "memory")
#define G8_BAR __builtin_amdgcn_s_barrier()
#define G8_SCHED __builtin_amdgcn_sched_barrier(0)
    Unit cur, nxt; int ui = 0;
    if (!S.next(0, cur)) return;
    Acc acc;
#pragma unroll
    for (int a = 0; a < 2; ++a)
#pragma unroll
        for (int b = 0; b < 2; ++b)
#pragma unroll
            for (int m = 0; m < 4; ++m)
#pragma unroll
                for (int n = 0; n < 2; ++n) acc[a][b][m][n] = (f32x4){0.f, 0.f, 0.f, 0.f};
    bf16x8 At[4][2], B0[2][2], B1[2][2];
    unsigned cv[2][2], nv[2][2];
    S.aoffs(cur, R0, C0, R1, C1, cv);
    const unsigned char* cA = ws + cur.aoff; const unsigned char* cB = ws + cur.boff;
    G8_STAGE(G8_SB(0, 0), cB, voffB[0], voffB[1]); G8_STAGE(G8_SA(0, 0), cA, cv[0][0], cv[0][1]);
    G8_STAGE(G8_SB(0, 1), cB + hstepB, voffB[0], voffB[1]); G8_STAGE(G8_SA(0, 1), cA, cv[1][0], cv[1][1]);
    if (wr == 1) G8_BAR;
    G8_WAIT_V(4); G8_BAR;
    G8_STAGE(G8_SB(1, 0), cB + kstep, voffB[0], voffB[1]); G8_STAGE(G8_SA(1, 0), cA + kstep, cv[0][0], cv[0][1]);
    G8_STAGE(G8_SB(1, 1), cB + hstepB + kstep, voffB[0], voffB[1]);
    G8_WAIT_V(6); G8_BAR;
    for (;;) {
        const bool has_next = S.next(ui + 1, nxt);
        if (has_next) S.aoffs(nxt, R0, C0, R1, C1, nv);
        else { nv[0][0] = cv[0][0]; nv[0][1] = cv[0][1]; nv[1][0] = cv[1][0]; nv[1][1] = cv[1][1]; }
        const unsigned char* nA = has_next ? ws + nxt.aoff : cA; const unsigned char* nB = has_next ? ws + nxt.boff : cB;
        for (int t = 0; t < nt; t += 2) {
            const bool last = (t == nt - 2);
            const unsigned char* a1 = cA + (size_t)(t + 1) * kstep;
            const unsigned char* a2 = last ? nA : cA + (size_t)(t + 2) * kstep; const unsigned char* b2 = last ? nB : cB + (size_t)(t + 2) * kstep;
            const unsigned char* a3 = a2 + kstep; const unsigned char* b3 = b2 + kstep;
            const unsigned o00 = last ? nv[0][0] : cv[0][0], o01 = last ? nv[0][1] : cv[0][1], o10 = last ? nv[1][0] : cv[1][0], o11 = last ? nv[1][1] : cv[1][1];
            G8_LDB(B0, 0, 0); G8_SCHED; G8_LDA(At, 0, 0); G8_STAGE(G8_SA(1, 1), a1, cv[1][0], cv[1][1]);
            G8_WAIT_L(8); G8_BAR; G8_WAIT_L(0); G8_MMA(0, 0, At, B0); G8_BAR; G8_SCHED;
            G8_LDB(B1, 0, 1); G8_STAGE(G8_SB(0, 0), b2, voffB[0], voffB[1]);
            G8_BAR; G8_WAIT_L(0); G8_MMA(0, 1, At, B1); G8_BAR;
            G8_LDA(At, 0, 1); G8_STAGE(G8_SA(0, 0), a2, o00, o01);
            G8_BAR; G8_WAIT_L(0); G8_MMA(1, 0, At, B0); G8_BAR; G8_SCHED;
            G8_STAGE(G8_SB(0, 1), b2 + hstepB, voffB[0], voffB[1]);
            G8_WAIT_V(6); G8_BAR; G8_MMA(1, 1, At, B1); G8_BAR;
            G8_LDB(B0, 1, 0); G8_SCHED; G8_LDA(At, 1, 0); G8_STAGE(G8_SA(0, 1), a2, o10, o11);
            G8_WAIT_L(8); G8_BAR; G8_WAIT_L(0); G8_MMA(0, 0, At, B0); G8_BAR; G8_SCHED;
            G8_LDB(B1, 1, 1); G8_STAGE(G8_SB(1, 0), b3, voffB[0], voffB[1]);
            G8_BAR; G8_WAIT_L(0); G8_MMA(0, 1, At, B1); G8_BAR;
            G8_LDA(At, 1, 1); G8_STAGE(G8_SA(1, 0), a3, o00, o01);
            G8_BAR; G8_WAIT_L(0); G8_MMA(1, 0, At, B0); G8_BAR; G8_SCHED;
            G8_STAGE(G8_SB(1, 1), b3 + hstepB, voffB[0], voffB[1]);
            G8_WAIT_V(6); G8_BAR; G8_MMA(1, 1, At, B1); G8_BAR;
        }
        E(acc, cur, wr, wc, fr, fq);
        if (!has_next) break;
        if (!(cur.flags & 1)) {
#pragma unroll
            for (int a = 0; a < 2; ++a)
#pragma unroll
                for (int b = 0; b < 2; ++b)
#pragma unroll
                    for (int m = 0; m < 4; ++m)
#pragma unroll
                        for (int n = 0; n < 2; ++n) acc[a][b][m][n] = (f32x4){0.f, 0.f, 0.f, 0.f};
        }
        cur = nxt; cA = nA; cB = nB; ++ui;
        cv[0][0] = nv[0][0]; cv[0][1] = nv[0][1]; cv[1][0] = nv[1][0]; cv[1][1] = nv[1][1];
    }
    G8_WAIT_V(0);
    if (wr == 0) G8_BAR;
    G8_BAR;
#undef G8_SA
#undef G8_SB
#undef G8_STAGE
#undef G8_LDA
#undef G8_LDB
#undef G8_MMA
#undef G8_WAIT_V
#undef G8_WAIT_L
#undef G8_BAR
#undef G8_SCHED
}
}

__device__ __forceinline__ void p0_adaln(const Params& P, LAS unsigned char* lds, int tid, int item) {
    const int ks = item & 3, nc = item >> 2;
    LAS float* sc = (LAS float*)lds;
    LAS float* red = (LAS float*)(lds + 16384);
    const float* c = P.in[1];
    for (int i = tid; i < 4096; i += NTHREADS) { const int kl = i >> 3, b = i & 7; const float v = c[b * 2048 + ks * 512 + kl]; sc[i] = v / (1.0f + expf(-v)); }
    __syncthreads();
    if (tid < 384) {
        const int nq = tid % 48, kg = tid / 48;
        const float* W = P.in[2] + (size_t)(ks * 512 + kg * 64) * NMOD + nc * 192 + nq * 4;
        f32x4 acc[8];
#pragma unroll
        for (int b = 0; b < 8; ++b) acc[b] = (f32x4){0.f, 0.f, 0.f, 0.f};
#pragma unroll 8
        for (int kk = 0; kk < 64; ++kk) {
            const f32x4 w = *(const f32x4*)(W + (size_t)kk * NMOD);
            const f32x4 s0 = *(const LAS f32x4*)(sc + (kg * 64 + kk) * 8), s1 = *(const LAS f32x4*)(sc + (kg * 64 + kk) * 8 + 4);
            acc[0] += w * s0[0]; acc[1] += w * s0[1]; acc[2] += w * s0[2]; acc[3] += w * s0[3];
            acc[4] += w * s1[0]; acc[5] += w * s1[1]; acc[6] += w * s1[2]; acc[7] += w * s1[3];
        }
#pragma unroll
        for (int b = 0; b < 8; ++b) *(LAS f32x4*)(red + (kg * 8 + b) * 192 + nq * 4) = acc[b];
    }
    __syncthreads();
    float* modp = (float*)(P.ws + WS_MODP);
    for (int i = tid; i < 8 * 192; i += NTHREADS) {
        const int b = i / 192, n = i % 192; float s = 0.f;
#pragma unroll
        for (int kg = 0; kg < 8; ++kg) s += red[(kg * 8 + b) * 192 + n];
        modp[(size_t)(ks * 8 + b) * NMOD + nc * 192 + n] = s;
    }
    __syncthreads();
}

struct CvtUnit { const float* src; bf16_t* dst; int Nd, Kd, k0, n0, nmode; const float* s0; const float* s1; };
constexpr int CVT_UNITS = 640 + 256 + 64 + 3 * 4096;
__device__ __forceinline__ void cvt_unit_decode(const Params& P, int L, CvtUnit& u) {
    u.s0 = nullptr; u.s1 = nullptr; u.nmode = 0;
    if (L < 640) { u.src = P.in[5]; u.dst = (bf16_t*)(P.ws + WS_WIN); u.Kd = 2048; u.Nd = 5120; u.k0 = (L / 20) * 64; u.n0 = (L % 20) * 256; return; }
    L -= 640;
    if (L < 256) { u.src = P.in[17]; u.dst = (bf16_t*)(P.ws + WS_WOUT); u.Kd = 2048; u.Nd = 2048; u.k0 = (L / 8) * 64; u.n0 = (L % 8) * 256; u.s0 = P.in[15]; u.s1 = P.in[16]; return; }
    L -= 256;
    if (L < 64) { u.src = P.in[14]; u.dst = (bf16_t*)(P.ws + WS_WGLU); u.Kd = 1024; u.Nd = 1024; u.k0 = (L / 4) * 64; u.n0 = (L % 4) * 256; return; }
    L -= 64;
    if (L < 4096) { const int e = L >> 7, r = L & 127; u.src = P.in[23] + (size_t)e * 2048 * 1024; u.dst = (bf16_t*)(P.ws + WS_WGU) + (size_t)e * 2048 * 2048; u.Kd = 2048; u.Nd = 1024; u.k0 = (r >> 2) * 64; u.n0 = (r & 3) * 256; u.nmode = 1; return; }
    L -= 4096;
    if (L < 4096) { const int e = L >> 7, r = L & 127; u.src = P.in[24] + (size_t)e * 2048 * 1024; u.dst = (bf16_t*)(P.ws + WS_WGU) + (size_t)e * 2048 * 2048; u.Kd = 2048; u.Nd = 1024; u.k0 = (r >> 2) * 64; u.n0 = (r & 3) * 256; u.nmode = 2; return; }
    L -= 4096;
    { const int e = L >> 7, r = L & 127; u.src = P.in[25] + (size_t)e * 1024 * 2048; u.dst = (bf16_t*)(P.ws + WS_WD) + (size_t)e * 2048 * 1024; u.Kd = 1024; u.Nd = 2048; u.k0 = (r >> 3) * 64; u.n0 = (r & 7) * 256; }
}
__device__ __forceinline__ void cvt_load(const CvtUnit& u, int tid, f32x4 (&r)[8]) {
    const int kp = tid >> 4, nq = tid & 15;
    const float* p = u.src + (size_t)(u.k0 + 2 * kp) * u.Nd + u.n0 + nq * 4;
#pragma unroll
    for (int s = 0; s < 4; ++s) { r[2 * s] = *(const f32x4*)(p + s * 64); r[2 * s + 1] = *(const f32x4*)(p + u.Nd + s * 64); }
    if (u.s0) {
        const int k = u.k0 + 2 * kp;
        const float a = (k < 1024) ? u.s0[k] : u.s1[k - 1024], b = (k + 1 < 1024) ? u.s0[k + 1] : u.s1[k + 1 - 1024];
#pragma unroll
        for (int s = 0; s < 4; ++s) { r[2 * s] *= a; r[2 * s + 1] *= b; }
    }
}
__device__ __forceinline__ void p0_convert(const Params& P, LAS unsigned char* lds, int tid, int blk, int G) {
    LAS unsigned* tile = (LAS unsigned*)lds;
    const int kp = tid >> 4, nq = tid & 15, nl = tid >> 3, kq = tid & 7;
    CvtUnit u, un; f32x4 r[8];
    int L = blk;
    if (L >= CVT_UNITS) return;
    cvt_unit_decode(P, L, u); cvt_load(u, tid, r);
    for (;;) {
#pragma unroll
        for (int s = 0; s < 4; ++s)
#pragma unroll
            for (int j = 0; j < 4; ++j) tile[s * 2112 + (nq * 4 + j) * 33 + kp] = cvt_pk_bf16(r[2 * s][j], r[2 * s + 1][j]);
        __syncthreads();
        const int Ln = L + G; const bool more = Ln < CVT_UNITS;
        if (more) { cvt_unit_decode(P, Ln, un); cvt_load(un, tid, r); }
#pragma unroll
        for (int s = 0; s < 4; ++s) {
            u32x4 w; w.x = tile[s * 2112 + nl * 33 + kq * 4]; w.y = tile[s * 2112 + nl * 33 + kq * 4 + 1]; w.z = tile[s * 2112 + nl * 33 + kq * 4 + 2]; w.w = tile[s * 2112 + nl * 33 + kq * 4 + 3];
            const int n = u.n0 + s * 64 + nl;
            const int np = (u.nmode == 0) ? n : ((n >> 7) * 256 + (n & 127) + (u.nmode == 2 ? 128 : 0));
            *(u32x4*)(u.dst + (size_t)np * u.Kd + u.k0 + kq * 8) = w;
        }
        __syncthreads();
        if (!more) break;
        u = un; L = Ln;
    }
}

__device__ __forceinline__ void p0_ssm_mats(const Params& P, LAS unsigned char* lds, int tid, int item) {
    const int g = item & 63, q = item >> 6;
    LAS f32x2* pw = (LAS f32x2*)lds;
    LAS f32x2* Bb = pw + 17 * 64;
    LAS f32x2* Cc = Bb + 64 * 16;
    LAS float* Kt = (LAS float*)(Cc + 16 * 64);
    if (tid < 64) {
        const int p = tid;
        const float dt = expf(P.in[13][g]);
        const float are = P.in[6][g * 64 + p], aim = P.in[7][g * 64 + p];
        const float mag = expf(dt * are);
        double sd, cd; sincos_d((double)(dt * aim), sd, cd);
        const float abr = mag * (float)cd, abi = mag * (float)sd;
        const float inv = 1.0f / (are * are + aim * aim);
        const float nre = abr - 1.0f;
        const float fre = (nre * are + abi * aim) * inv, fim = (abi * are - nre * aim) * inv;
        float pr = 1.0f, pi = 0.0f;
        for (int n = 0; n <= 16; ++n) { pw[n * 64 + p] = (f32x2){pr, pi}; const float t = pr * abr - pi * abi; pi = pr * abi + pi * abr; pr = t; }
        for (int h = 0; h < 16; ++h) {
            const float br = P.in[8][(g * 64 + p) * 16 + h], bi = P.in[9][(g * 64 + p) * 16 + h];
            Bb[p * 16 + h] = (f32x2){fre * br - fim * bi, fre * bi + fim * br};
            Cc[h * 64 + p] = (f32x2){P.in[10][(g * 16 + h) * 64 + p], P.in[11][(g * 16 + h) * 64 + p]};
        }
        if (q == 0) { f32x2* AL = (f32x2*)(P.ws + WS_SSMA); const f32x2 v = pw[16 * 64 + p]; AL[g * 64 + p] = v; }
    }
    __syncthreads();
    for (int o = tid; o < 4096; o += NTHREADS) {
        const int tau = o >> 8, ho = (o >> 4) & 15, hi = o & 15; float s = 0.f;
        for (int p = 0; p < 64; ++p) {
            const f32x2 c = Cc[ho * 64 + p], a = pw[tau * 64 + p], b = Bb[p * 16 + hi];
            const float cr = c.x * a.x - c.y * a.y, ci = c.x * a.y + c.y * a.x;
            s += cr * b.x - ci * b.y;
        }
        Kt[o] = s;
    }
    __syncthreads();
    bf16_t* Ms = (bf16_t*)(P.ws + WS_SSMM) + (size_t)g * 131072;
    bf16_t* TM = Ms + 32768;
    for (int o = tid; o < 32 * 128; o += NTHREADS) {
        const int row = 32 * q + (o >> 7), col = (o & 127) * 2;
        const int p = row & 63, j = col >> 4, hi = col & 15;
        const f32x2 a = pw[(15 - j) * 64 + p], b0 = Bb[p * 16 + hi], b1 = Bb[p * 16 + hi + 1];
        float v0, v1;
        if (row < 64) { v0 = a.x * b0.x - a.y * b0.y; v1 = a.x * b1.x - a.y * b1.y; } else { v0 = a.x * b0.y + a.y * b0.x; v1 = a.x * b1.y + a.y * b1.x; }
        *(unsigned*)(Ms + (size_t)row * 256 + col) = cvt_pk_bf16(v0, v1);
    }
    for (int o = tid; o < 64 * 192; o += NTHREADS) {
        const int row = 64 * q + o / 192, col = (o % 192) * 2;
        const int i = row >> 4, ho = row & 15; float v0, v1;
        if (col < 256) { const int j = col >> 4, hi = col & 15; if (j <= i) { v0 = Kt[((i - j) * 16 + ho) * 16 + hi]; v1 = Kt[((i - j) * 16 + ho) * 16 + hi + 1]; } else { v0 = 0.f; v1 = 0.f; } }
        else { const int cc = col - 256; const int p0 = cc & 63;
            const f32x2 c0 = Cc[ho * 64 + p0], a0 = pw[(i + 1) * 64 + p0], c1 = Cc[ho * 64 + p0 + 1], a1 = pw[(i + 1) * 64 + p0 + 1];
            if (cc < 64) { v0 = c0.x * a0.x - c0.y * a0.y; v1 = c1.x * a1.x - c1.y * a1.y; } else { v0 = -(c0.x * a0.y + c0.y * a0.x); v1 = -(c1.x * a1.y + c1.y * a1.x); } }
        *(unsigned*)(TM + (size_t)row * 384 + col) = cvt_pk_bf16(v0, v1);
    }
    __syncthreads();
}

__device__ __forceinline__ void p0_misc(const Params& P, int tid, int blk, int G) {
    f32x2* rope = (f32x2*)(P.ws + WS_ROPE);
    for (int i = blk * NTHREADS + tid; i < 2048 * 64; i += G * NTHREADS) {
        const int pos = i >> 6, d = i & 63;
        double th = 1.0; { const double r = 0.86596432336006535; double b = r; int e = d; while (e) { if (e & 1) th *= b; b *= b; e >>= 1; } }
        double s1, c1; sincos_d(th, s1, c1);
        double cr = 1.0, ci = 0.0, br = c1, bi = s1; int e = pos;
        while (e) { if (e & 1) { const double t = cr * br - ci * bi; ci = cr * bi + ci * br; cr = t; } const double t2 = br * br - bi * bi; bi = 2.0 * br * bi; br = t2; e >>= 1; }
        rope[i] = (f32x2){(float)cr, (float)ci};
    }
    bf16_t* wr = (bf16_t*)(P.ws + WS_WR);
    for (int i = blk * NTHREADS + tid; i < 48 * 2048; i += G * NTHREADS) {
        const int n = i >> 11, k = i & 2047; float v = 0.f;
        if (n < 4) v = P.in[19][k * 4 + n]; else if (n < 36) v = P.in[21][k * 32 + (n - 4)];
        wr[i] = (bf16_t)(cvt_pk_bf16(v, 0.f) & 0xffffu);
    }
    float* z1 = (float*)(P.ws + WS_ROWSS1);
    for (int i = blk * NTHREADS + tid; i < 2 * 16384; i += G * NTHREADS) z1[i] = 0.f;
    if (blk == 0 && tid < 64) ((int*)(P.ws + WS_CNT))[tid] = 0;
}

__device__ __forceinline__ void p1_norm1(const Params& P, LAS unsigned char* lds, int tid, int blk, int G) {
    const float* modp = (const float*)(P.ws + WS_MODP); const float* bada = P.in[3];
    float* mod = (float*)(P.ws + WS_MOD);
    for (int i = blk * NTHREADS + tid; i < 8 * NMOD; i += G * NTHREADS) {
        const int b = i / NMOD, j = i % NMOD;
        mod[i] = bada[j] + ((modp[(size_t)(0 * 8 + b) * NMOD + j] + modp[(size_t)(1 * 8 + b) * NMOD + j]) + (modp[(size_t)(2 * 8 + b) * NMOD + j] + modp[(size_t)(3 * 8 + b) * NMOD + j]));
    }
    LAS float* gm = (LAS float*)lds; LAS float* sh = gm + 2048;
    const int wave = tid >> 6, lane = tid & 63;
    bf16_t* H = (bf16_t*)(P.ws + WS_H);
    for (int rb = blk; rb < 256; rb += G) {
        const int b = rb >> 5;
        for (int k = tid; k < 2048; k += NTHREADS) {
            const int js = 2048 + k, jh = k;
            const float sc = bada[js] + ((modp[(size_t)(0 * 8 + b) * NMOD + js] + modp[(size_t)(1 * 8 + b) * NMOD + js]) + (modp[(size_t)(2 * 8 + b) * NMOD + js] + modp[(size_t)(3 * 8 + b) * NMOD + js]));
            const float sv = bada[jh] + ((modp[(size_t)(0 * 8 + b) * NMOD + jh] + modp[(size_t)(1 * 8 + b) * NMOD + jh]) + (modp[(size_t)(2 * 8 + b) * NMOD + jh] + modp[(size_t)(3 * 8 + b) * NMOD + jh]));
            gm[k] = P.in[4][k] * (1.0f + sc); sh[k] = sv;
        }
        __syncthreads();
        for (int rr = 0; rr < 8; ++rr) {
            const int row = rb * 64 + wave * 8 + rr;
            const float* xr = P.in[0] + (size_t)row * DM;
            f32x4 v[8]; float ss = 0.f;
#pragma unroll
            for (int i = 0; i < 8; ++i) { v[i] = *(const f32x4*)(xr + (i * 64 + lane) * 4); ss += v[i][0] * v[i][0] + v[i][1] * v[i][1] + v[i][2] * v[i][2] + v[i][3] * v[i][3]; }
            ss = wave_sum(ss);
            const float r = rsqrtf(ss * (1.0f / 2048.0f) + 1e-6f);
#pragma unroll
            for (int i = 0; i < 8; ++i) {
                const int k = (i * 64 + lane) * 4;
                const f32x4 g4 = *(const LAS f32x4*)(gm + k), s4 = *(const LAS f32x4*)(sh + k);
                const f32x4 o = v[i] * r * g4 + s4;
                u32x2 w; w.x = cvt_pk_bf16(o[0], o[1]); w.y = cvt_pk_bf16(o[2], o[3]);
                *(u32x2*)(H + (size_t)row * DM + k) = w;
            }
        }
        __syncthreads();
    }
}

struct DenseSched : g8::StaticOrder {
    unsigned abase, bbase; int lda, ldb;
    __device__ __forceinline__ bool next(int i, g8::Unit& u) const {
        int pm, pn; if (!tile(i, pm, pn)) return false;
        u.pm = __builtin_amdgcn_readfirstlane(pm); u.pn = __builtin_amdgcn_readfirstlane(pn); u.flags = 0; u.aux = 0;
        u.aoff = abase + (unsigned)u.pm * 256u * (unsigned)lda * 2u; u.boff = bbase + (unsigned)u.pn * 256u * (unsigned)ldb * 2u; return true;
    }
    __device__ __forceinline__ void aoffs(const g8::Unit&, int R0, int C0, int R1, int C1, unsigned (&v)[2][2]) const {
        v[0][0] = (unsigned)(R0 * lda + C0) * 2u; v[0][1] = (unsigned)(R1 * lda + C1) * 2u;
        v[1][0] = (unsigned)((128 + R0) * lda + C0) * 2u; v[1][1] = (unsigned)((128 + R1) * lda + C1) * 2u;
    }
};
struct EpiStoreBf16 {
    static constexpr bool PERM = true;
    bf16_t* O; int ldc;
    __device__ __forceinline__ void operator()(g8::Acc& acc, const g8::Unit& u, int wr, int wc, int fr, int fq) const {
        const int row0 = u.pm * 256 + wr * 64 + fr, col0 = u.pn * 256 + wc * 32 + 8 * fq;
#pragma unroll
        for (int ai = 0; ai < 2; ++ai)
#pragma unroll
            for (int m = 0; m < 4; ++m) { bf16_t* rowp = O + (size_t)(row0 + ai * 128 + m * 16) * ldc + col0;
#pragma unroll
                for (int bj = 0; bj < 2; ++bj) { const f32x4 v0 = acc[ai][bj][m][0], v1 = acc[ai][bj][m][1];
                    u32x4 w; w.x = cvt_pk_bf16(v0[0], v0[1]); w.y = cvt_pk_bf16(v0[2], v0[3]); w.z = cvt_pk_bf16(v1[0], v1[1]); w.w = cvt_pk_bf16(v1[2], v1[3]);
                    *(u32x4*)(rowp + bj * 128) = w; } }
    }
};
struct EpiGlu {
    static constexpr bool PERM = true;
    const bf16_t* Z; bf16_t* CAT; float* rowss;
    __device__ __forceinline__ void operator()(g8::Acc& acc, const g8::Unit& u, int wr, int wc, int fr, int fq) const {
        const int row0 = u.pm * 256 + wr * 64 + fr, col0 = u.pn * 256 + wc * 32 + 8 * fq;
#pragma unroll
        for (int ai = 0; ai < 2; ++ai)
#pragma unroll
            for (int m = 0; m < 4; ++m) { const int row = row0 + ai * 128 + m * 16; float ss = 0.f;
#pragma unroll
                for (int bj = 0; bj < 2; ++bj) { const f32x4 v0 = acc[ai][bj][m][0], v1 = acc[ai][bj][m][1];
                    const u32x4 zz = *(const u32x4*)(Z + (size_t)row * 1024 + col0 + bj * 128);
                    float o[8];
                    o[0] = bf_lo(zz.x) * sigmoidf_(v0[0]); o[1] = bf_hi(zz.x) * sigmoidf_(v0[1]); o[2] = bf_lo(zz.y) * sigmoidf_(v0[2]); o[3] = bf_hi(zz.y) * sigmoidf_(v0[3]);
                    o[4] = bf_lo(zz.z) * sigmoidf_(v1[0]); o[5] = bf_hi(zz.z) * sigmoidf_(v1[1]); o[6] = bf_lo(zz.w) * sigmoidf_(v1[2]); o[7] = bf_hi(zz.w) * sigmoidf_(v1[3]);
#pragma unroll
                    for (int j = 0; j < 8; ++j) ss += o[j] * o[j];
                    u32x4 w; w.x = cvt_pk_bf16(o[0], o[1]); w.y = cvt_pk_bf16(o[2], o[3]); w.z = cvt_pk_bf16(o[4], o[5]); w.w = cvt_pk_bf16(o[6], o[7]);
                    *(u32x4*)(CAT + (size_t)row * DM + col0 + bj * 128) = w; }
                ss += __shfl_xor(ss, 16); ss += __shfl_xor(ss, 32);
                if (fq == 0) atomicAdd(rowss + row, ss); }
    }
};
struct OutSched : g8::StaticOrder {
    unsigned abase, bbase;
    __device__ __forceinline__ bool next(int i, g8::Unit& u) const {
        int pm, pn; if (!tile(i >> 1, pm, pn)) return false;
        const int half = i & 1;
        u.pm = __builtin_amdgcn_readfirstlane(pm); u.pn = __builtin_amdgcn_readfirstlane(pn); u.flags = half ? 0 : 1; u.aux = half;
        u.aoff = abase + (unsigned)u.pm * 256u * 4096u + (unsigned)half * 2048u; u.boff = bbase + (unsigned)u.pn * 256u * 4096u + (unsigned)half * 2048u; return true;
    }
    __device__ __forceinline__ void aoffs(const g8::Unit&, int R0, int C0, int R1, int C1, unsigned (&v)[2][2]) const {
        v[0][0] = (unsigned)(R0 * 2048 + C0) * 2u; v[0][1] = (unsigned)(R1 * 2048 + C1) * 2u;
        v[1][0] = (unsigned)((128 + R0) * 2048 + C0) * 2u; v[1][1] = (unsigned)((128 + R1) * 2048 + C1) * 2u;
    }
};
struct EpiOut {
    static constexpr bool PERM = false;
    const float* x; const float* mod; const float* rowss1; float* rowss2; float* out;
    __device__ __forceinline__ void operator()(g8::Acc& acc, const g8::Unit& u, int wr, int wc, int fr, int fq) const {
        const int row0 = u.pm * 256 + wr * 64 + fr;
        if (u.aux == 0) {
#pragma unroll
            for (int ai = 0; ai < 2; ++ai)
#pragma unroll
                for (int m = 0; m < 4; ++m) { const float r = rsqrtf(rowss1[row0 + ai * 128 + m * 16] * (1.0f / 1024.0f) + 1e-6f);
#pragma unroll
                    for (int bj = 0; bj < 2; ++bj)
#pragma unroll
                        for (int n = 0; n < 2; ++n) acc[ai][bj][m][n] *= r; }
            return;
        }
        const int col0 = u.pn * 256 + wc * 32 + 4 * fq;
        const int b = (u.pm * 256) >> 11;
        f32x4 gt[2][2];
#pragma unroll
        for (int bj = 0; bj < 2; ++bj)
#pragma unroll
            for (int n = 0; n < 2; ++n) gt[bj][n] = *(const f32x4*)(mod + (size_t)b * NMOD + 2 * DM + col0 + bj * 128 + n * 16);
#pragma unroll
        for (int ai = 0; ai < 2; ++ai)
#pragma unroll
            for (int m = 0; m < 4; ++m) { const int row = row0 + ai * 128 + m * 16; float ss = 0.f;
#pragma unroll
                for (int bj = 0; bj < 2; ++bj)
#pragma unroll
                    for (int n = 0; n < 2; ++n) { const size_t off = (size_t)row * DM + col0 + bj * 128 + n * 16;
                        const f32x4 xv = *(const f32x4*)(x + off); const f32x4 o = xv + gt[bj][n] * acc[ai][bj][m][n];
                        ss += o[0] * o[0] + o[1] * o[1] + o[2] * o[2] + o[3] * o[3];
                        *(f32x4*)(out + off) = o; }
                ss += __shfl_xor(ss, 16); ss += __shfl_xor(ss, 32);
                if (fq == 0) atomicAdd(rowss2 + row, ss); }
    }
};
struct MoeSched {
    const LAS int* tpre; const LAS int* cnt; int G, c; const int* list; unsigned abase, bbase; int mode;
    __device__ __forceinline__ bool next(int i, g8::Unit& u) const {
        const int L = i * G + c; const int total = tpre[32] * 8; if (L >= total) return false;
        const int pn = L & 7, ti = L >> 3; int e = 0;
#pragma unroll 1
        for (int s = 16; s > 0; s >>= 1) if (tpre[e + s] <= ti) e += s;
        e = __builtin_amdgcn_readfirstlane(e);
        u.pm = __builtin_amdgcn_readfirstlane(ti); u.pn = pn; u.flags = 0; u.aux = e;
        if (mode == 0) { u.aoff = abase; u.boff = bbase + (unsigned)e * (2048u * 2048u * 2u) + (unsigned)pn * (256u * 2048u * 2u); }
        else { u.aoff = abase + (unsigned)ti * (256u * 1024u * 2u); u.boff = bbase + (unsigned)e * (2048u * 1024u * 2u) + (unsigned)pn * (256u * 1024u * 2u); }
        return true;
    }
    __device__ __forceinline__ void aoffs(const g8::Unit& u, int R0, int C0, int R1, int C1, unsigned (&v)[2][2]) const {
        if (mode == 0) {
            const int e = u.aux, r0 = (u.pm - tpre[e]) * 256, n = cnt[e]; const int* le = list + e * 16384;
            const int i00 = r0 + R0, i01 = r0 + R1, i10 = r0 + 128 + R0, i11 = r0 + 128 + R1;
            const int t00 = (i00 < n) ? (le[i00] >> 1) : 0, t01 = (i01 < n) ? (le[i01] >> 1) : 0, t10 = (i10 < n) ? (le[i10] >> 1) : 0, t11 = (i11 < n) ? (le[i11] >> 1) : 0;
            v[0][0] = (unsigned)(t00 * 2048 + C0) * 2u; v[0][1] = (unsigned)(t01 * 2048 + C1) * 2u; v[1][0] = (unsigned)(t10 * 2048 + C0) * 2u; v[1][1] = (unsigned)(t11 * 2048 + C1) * 2u;
        } else {
            v[0][0] = (unsigned)(R0 * 1024 + C0) * 2u; v[0][1] = (unsigned)(R1 * 1024 + C1) * 2u;
            v[1][0] = (unsigned)((128 + R0) * 1024 + C0) * 2u; v[1][1] = (unsigned)((128 + R1) * 1024 + C1) * 2u;
        }
    }
};
struct EpiMoe1 {
    static constexpr bool PERM = true;
    bf16_t* HM;
    __device__ __forceinline__ void operator()(g8::Acc& acc, const g8::Unit& u, int wr, int wc, int fr, int fq) const {
        const int row0 = u.pm * 256 + wr * 64 + fr, col0 = u.pn * 128 + wc * 32 + 8 * fq;
#pragma unroll
        for (int ai = 0; ai < 2; ++ai)
#pragma unroll
            for (int m = 0; m < 4; ++m) { float o[8];
#pragma unroll
                for (int n = 0; n < 2; ++n)
#pragma unroll
                    for (int j = 0; j < 4; ++j) { const float gv = acc[ai][0][m][n][j], uv = acc[ai][1][m][n][j]; o[n * 4 + j] = gv * sigmoidf_(gv) * uv; }
                u32x4 w; w.x = cvt_pk_bf16(o[0], o[1]); w.y = cvt_pk_bf16(o[2], o[3]); w.z = cvt_pk_bf16(o[4], o[5]); w.w = cvt_pk_bf16(o[6], o[7]);
                *(u32x4*)(HM + (size_t)(row0 + ai * 128 + m * 16) * 1024 + col0) = w; }
    }
};
struct EpiMoe2 {
    static constexpr bool PERM = true;
    const LAS int* tpre; const LAS int* cnt; const int* list; const float* wgt; bf16_t* Y2;
    __device__ __forceinline__ void operator()(g8::Acc& acc, const g8::Unit& u, int wr, int wc, int fr, int fq) const {
        const int e = u.aux, r0 = (u.pm - tpre[e]) * 256, n = cnt[e]; const int* le = list + e * 16384;
        const int col0 = u.pn * 256 + wc * 32 + 8 * fq;
#pragma unroll
        for (int ai = 0; ai < 2; ++ai)
#pragma unroll
            for (int m = 0; m < 4; ++m) { const int r = r0 + ai * 128 + wr * 64 + m * 16 + fr;
                if (r < n) { const int asg = le[r]; const float w8 = wgt[asg]; bf16_t* rowp = Y2 + (size_t)asg * DM + col0;
#pragma unroll
                    for (int bj = 0; bj < 2; ++bj) { const f32x4 v0 = acc[ai][bj][m][0] * w8, v1 = acc[ai][bj][m][1] * w8;
                        u32x4 w; w.x = cvt_pk_bf16(v0[0], v0[1]); w.y = cvt_pk_bf16(v0[2], v0[3]); w.z = cvt_pk_bf16(v1[0], v1[1]); w.w = cvt_pk_bf16(v1[2], v1[3]);
                        *(u32x4*)(rowp + bj * 128) = w; } } }
    }
};

__device__ __forceinline__ void ssm_item(const Params& P, LAS unsigned char* lds, int tid, int item) {
    const int g = item >> 2, bp = item & 3;
    const int wave = __builtin_amdgcn_readfirstlane(tid >> 6), lane = tid & 63, fr = lane & 15, fq = lane >> 4;
    const bf16_t* proj = (const bf16_t*)(P.ws + WS_PROJ);
    const bf16_t* Ms = (const bf16_t*)(P.ws + WS_SSMM) + (size_t)g * 131072;
    const bf16_t* TM = Ms + 32768;
    bf16_t* Zo = (bf16_t*)(P.ws + WS_Z);
    LAS float* zs = (LAS float*)lds;
    constexpr int ZS = 132;
    const int b = 2 * bp + (wave >> 2);
    int tok0[2];
    bf16x8 Uf[2][8];
#pragma unroll
    for (int mt = 0; mt < 2; ++mt) {
        const int c = 32 * (wave & 3) + 16 * mt + fr; tok0[mt] = b * 2048 + c * 16;
#pragma unroll
        for (int ks = 0; ks < 8; ++ks) Uf[mt][ks] = *(const bf16x8*)(proj + (size_t)(tok0[mt] + 2 * ks + (fq >> 1)) * NPROJ + g * 16 + 8 * (fq & 1));
    }
#pragma unroll
    for (int nt = 0; nt < 8; ++nt) {
        f32x4 a0 = {0.f, 0.f, 0.f, 0.f}, a1 = {0.f, 0.f, 0.f, 0.f};
#pragma unroll
        for (int ks = 0; ks < 8; ++ks) {
            const bf16x8 bf = *(const bf16x8*)(Ms + (size_t)(16 * nt + fr) * 256 + 32 * ks + 8 * fq);
            a0 = __builtin_amdgcn_mfma_f32_16x16x32_bf16(bf, Uf[0][ks], a0, 0, 0, 0);
            a1 = __builtin_amdgcn_mfma_f32_16x16x32_bf16(bf, Uf[1][ks], a1, 0, 0, 0);
        }
        *(LAS f32x4*)(zs + (32 * wave + fr) * ZS + 16 * nt + 4 * fq) = a0;
        *(LAS f32x4*)(zs + (32 * wave + 16 + fr) * ZS + 16 * nt + 4 * fq) = a1;
    }
    __syncthreads();
    if (tid < 128) {
        const int bl = tid >> 6, p = tid & 63;
        const f32x2 al = ((const f32x2*)(P.ws + WS_SSMA))[g * 64 + p];
        float xr = 0.f, xi = 0.f;
        LAS float* zp = zs + (bl * 128) * ZS + p;
#pragma unroll 4
        for (int c = 0; c < 128; ++c) {
            const float zr = zp[c * ZS], zi = zp[c * ZS + 64];
            zp[c * ZS] = xr; zp[c * ZS + 64] = xi;
            const float t = al.x * xr - al.y * xi + zr; xi = al.x * xi + al.y * xr + zi; xr = t;
        }
    }
    __syncthreads();
    bf16x8 Xf[2][4];
#pragma unroll
    for (int mt = 0; mt < 2; ++mt)
#pragma unroll
        for (int k2 = 0; k2 < 4; ++k2) {
            const LAS float* s = zs + (32 * wave + 16 * mt + fr) * ZS + 32 * k2 + 8 * fq;
            const f32x4 v0 = *(const LAS f32x4*)s, v1 = *(const LAS f32x4*)(s + 4);
            u32x4 w; w.x = cvt_pk_bf16(v0[0], v0[1]); w.y = cvt_pk_bf16(v0[2], v0[3]); w.z = cvt_pk_bf16(v1[0], v1[1]); w.w = cvt_pk_bf16(v1[2], v1[3]);
            Xf[mt][k2] = __builtin_bit_cast(bf16x8, w);
        }
    const f32x4 dv = *(const f32x4*)(P.in[12] + g * 16 + 4 * fq);
#pragma unroll
    for (int nt = 0; nt < 16; ++nt) {
        f32x4 a0 = {0.f, 0.f, 0.f, 0.f}, a1 = {0.f, 0.f, 0.f, 0.f};
        const bf16_t* brow = TM + (size_t)(16 * nt + fr) * 384 + 8 * fq;
#pragma unroll
        for (int ks = 0; ks < 8; ++ks) {
            if (2 * ks <= nt) {
                const bf16x8 bf = *(const bf16x8*)(brow + 32 * ks);
                a0 = __builtin_amdgcn_mfma_f32_16x16x32_bf16(bf, Uf[0][ks], a0, 0, 0, 0);
                a1 = __builtin_amdgcn_mfma_f32_16x16x32_bf16(bf, Uf[1][ks], a1, 0, 0, 0);
            }
        }
#pragma unroll
        for (int k2 = 0; k2 < 4; ++k2) {
            const bf16x8 bf = *(const bf16x8*)(brow + 256 + 32 * k2);
            a0 = __builtin_amdgcn_mfma_f32_16x16x32_bf16(bf, Xf[0][k2], a0, 0, 0, 0);
            a1 = __builtin_amdgcn_mfma_f32_16x16x32_bf16(bf, Xf[1][k2], a1, 0, 0, 0);
        }
#pragma unroll
        for (int mt = 0; mt < 2; ++mt) {
            const f32x4 a = mt ? a1 : a0;
            const size_t tok = (size_t)(tok0[mt] + nt);
            const u32x2 uu = *(const u32x2*)(proj + tok * NPROJ + g * 16 + 4 * fq);
            const float y0 = a[0] + dv[0] * bf_lo(uu.x), y1 = a[1] + dv[1] * bf_hi(uu.x), y2 = a[2] + dv[2] * bf_lo(uu.y), y3 = a[3] + dv[3] * bf_hi(uu.y);
            u32x2 w; w.x = cvt_pk_bf16(gelu_tanh(y0), gelu_tanh(y1)); w.y = cvt_pk_bf16(gelu_tanh(y2), gelu_tanh(y3));
            *(u32x2*)(Zo + tok * 1024 + g * 16 + 4 * fq) = w;
        }
    }
    __syncthreads();
}

__device__ __forceinline__ bf16x8 tr_frag(const LAS bf16_t* tile, int row0, int col0, int fr, int fq) {
    const LAS bf16_t* p = tile + (row0 + 8 * fq + (fr >> 2)) * 136 + col0 + 4 * (fr & 3);
    const bf16x4 a = __builtin_amdgcn_ds_read_tr16_b64_v4i16((LAS bf16x4*)p);
    const bf16x4 b = __builtin_amdgcn_ds_read_tr16_b64_v4i16((LAS bf16x4*)(p + 4 * 136));
    bf16x8 r; r[0] = a[0]; r[1] = a[1]; r[2] = a[2]; r[3] = a[3]; r[4] = b[0]; r[5] = b[1]; r[6] = b[2]; r[7] = b[3]; return r;
}
__device__ __forceinline__ void ret_item(const Params& P, LAS unsigned char* lds, int tid, int item) {
    const int b = item >> 3, h = item & 7;
    const int wave = __builtin_amdgcn_readfirstlane(tid >> 6), lane = tid & 63, fr = lane & 15, fq = lane >> 4;
    constexpr int RS = 136;
    LAS bf16_t* Qs = (LAS bf16_t*)lds;
    LAS bf16_t* Ks = Qs + 128 * RS;
    LAS bf16_t* Vs = Ks + 128 * RS;
    LAS bf16_t* Rs = Vs + 128 * RS;
    const bf16_t* proj = (const bf16_t*)(P.ws + WS_PROJ);
    const f32x2* rope = (const f32x2*)(P.ws + WS_ROPE);
    bf16_t* CAT = (bf16_t*)(P.ws + WS_CAT);
    const float gam = 1.0f - exp2f(-5.0f - (float)h);
    const float lg2 = log2f(gam);
    const float gC1 = exp2f(lg2 * 127.0f);
    f32x4 accR[8];
#pragma unroll
    for (int nt = 0; nt < 8; ++nt) accR[nt] = (f32x4){0.f, 0.f, 0.f, 0.f};
    const int si = tid >> 2, part = tid & 3;
    for (int n = 0; n < 16; ++n) {
        {
            const int pos = n * 128 + si; const size_t tok = (size_t)b * 2048 + pos;
            const bf16_t* pr = proj + tok * NPROJ + h * 128 + 16 * part;
            const float qsc = exp2f(lg2 * (float)si), ksc = exp2f(-lg2 * (float)si) * 0.08838834764831845f;
            u32x4 q1[2], q2[2], k1[2], k2[2];
#pragma unroll
            for (int j = 0; j < 2; ++j) { q1[j] = *(const u32x4*)(pr + 1024 + 8 * j); q2[j] = *(const u32x4*)(pr + 1024 + 64 + 8 * j); k1[j] = *(const u32x4*)(pr + 2048 + 8 * j); k2[j] = *(const u32x4*)(pr + 2048 + 64 + 8 * j); }
            const f32x2* rp = rope + (size_t)pos * 64 + 16 * part;
#pragma unroll
            for (int j = 0; j < 2; ++j) {
                unsigned oq1[4], oq2[4], ok1[4], ok2[4];
#pragma unroll
                for (int w = 0; w < 4; ++w) {
                    const f32x4 cs = *(const f32x4*)(rp + 8 * j + 2 * w);
                    const unsigned a1 = q1[j][w], a2 = q2[j][w], c1 = k1[j][w], c2 = k2[j][w];
                    const float x1l = bf_lo(a1), x1h = bf_hi(a1), x2l = bf_lo(a2), x2h = bf_hi(a2);
                    oq1[w] = cvt_pk_bf16((x1l * cs[0] - x2l * cs[1]) * qsc, (x1h * cs[2] - x2h * cs[3]) * qsc);
                    oq2[w] = cvt_pk_bf16((x2l * cs[0] + x1l * cs[1]) * qsc, (x2h * cs[2] + x1h * cs[3]) * qsc);
                    const float y1l = bf_lo(c1), y1h = bf_hi(c1), y2l = bf_lo(c2), y2h = bf_hi(c2);
                    ok1[w] = cvt_pk_bf16((y1l * cs[0] - y2l * cs[1]) * ksc, (y1h * cs[2] - y2h * cs[3]) * ksc);
                    ok2[w] = cvt_pk_bf16((y2l * cs[0] + y1l * cs[1]) * ksc, (y2h * cs[2] + y1h * cs[3]) * ksc);
                }
                *(LAS u32x4*)(Qs + si * RS + 16 * part + 8 * j) = (u32x4){oq1[0], oq1[1], oq1[2], oq1[3]};
                *(LAS u32x4*)(Qs + si * RS + 64 + 16 * part + 8 * j) = (u32x4){oq2[0], oq2[1], oq2[2], oq2[3]};
                *(LAS u32x4*)(Ks + si * RS + 16 * part + 8 * j) = (u32x4){ok1[0], ok1[1], ok1[2], ok1[3]};
                *(LAS u32x4*)(Ks + si * RS + 64 + 16 * part + 8 * j) = (u32x4){ok2[0], ok2[1], ok2[2], ok2[3]};
            }
            const bf16_t* pv = proj + tok * NPROJ + 3072 + h * 128 + 32 * part;
#pragma unroll
            for (int j = 0; j < 4; ++j) *(LAS u32x4*)(Vs + si * RS + 32 * part + 8 * j) = *(const u32x4*)(pv + 8 * j);
        }
        __syncthreads();
        const int i0 = 16 * wave;
        bf16x8 Qf[4];
#pragma unroll
        for (int ks = 0; ks < 4; ++ks) Qf[ks] = *(const LAS bf16x8*)(Qs + (i0 + fr) * RS + 32 * ks + 8 * fq);
        f32x4 accS[8], accO[8];
#pragma unroll
        for (int nt = 0; nt < 8; ++nt) { accS[nt] = (f32x4){0.f, 0.f, 0.f, 0.f}; accO[nt] = (f32x4){0.f, 0.f, 0.f, 0.f}; }
#pragma unroll
        for (int nt = 0; nt < 8; ++nt) {
            if (nt <= wave) {
#pragma unroll
                for (int ks = 0; ks < 4; ++ks) { const bf16x8 kf = *(const LAS bf16x8*)(Ks + (16 * nt + fr) * RS + 32 * ks + 8 * fq); accS[nt] = __builtin_amdgcn_mfma_f32_16x16x32_bf16(kf, Qf[ks], accS[nt], 0, 0, 0); }
            }
        }
        if (n > 0) {
#pragma unroll
            for (int nt = 0; nt < 8; ++nt) {
#pragma unroll
                for (int ks = 0; ks < 4; ++ks) { const bf16x8 rf = *(const LAS bf16x8*)(Rs + (16 * nt + fr) * RS + 32 * ks + 8 * fq); accO[nt] = __builtin_amdgcn_mfma_f32_16x16x32_bf16(rf, Qf[ks], accO[nt], 0, 0, 0); }
                accO[nt] *= gam;
            }
        }
#pragma unroll
        for (int nt = 0; nt < 8; ++nt) {
            const int i = i0 + fr, j0 = 16 * nt + 4 * fq;
            const float p0 = (j0 <= i) ? accS[nt][0] : 0.f, p1 = (j0 + 1 <= i) ? accS[nt][1] : 0.f, p2 = (j0 + 2 <= i) ? accS[nt][2] : 0.f, p3 = (j0 + 3 <= i) ? accS[nt][3] : 0.f;
            *(LAS u32x2*)(Qs + i * RS + j0) = (u32x2){cvt_pk_bf16(p0, p1), cvt_pk_bf16(p2, p3)};
        }
        bf16x8 Pf[4];
#pragma unroll
        for (int ks = 0; ks < 4; ++ks) Pf[ks] = *(const LAS bf16x8*)(Qs + (i0 + fr) * RS + 32 * ks + 8 * fq);
#pragma unroll
        for (int ks = 0; ks < 4; ++ks) {
            if (2 * ks <= wave) {
#pragma unroll
                for (int nt = 0; nt < 8; ++nt) { const bf16x8 vf = tr_frag(Vs, 32 * ks, 16 * nt, fr, fq); accO[nt] = __builtin_amdgcn_mfma_f32_16x16x32_bf16(vf, Pf[ks], accO[nt], 0, 0, 0); }
            }
        }
        {
            bf16x8 Vt[4];
#pragma unroll
            for (int ks = 0; ks < 4; ++ks) Vt[ks] = tr_frag(Vs, 32 * ks, i0, fr, fq);
#pragma unroll
            for (int nt = 0; nt < 8; ++nt) {
                accR[nt] *= gam;
#pragma unroll
                for (int ks = 0; ks < 4; ++ks) { const bf16x8 kf = tr_frag(Ks, 32 * ks, 16 * nt, fr, fq); accR[nt] = __builtin_amdgcn_mfma_f32_16x16x32_bf16(kf, Vt[ks], accR[nt], 0, 0, 0); }
                accR[nt] *= gC1;
            }
        }
        {
            float s = 0.f;
#pragma unroll
            for (int nt = 0; nt < 8; ++nt) s += (accO[nt][0] + accO[nt][1]) + (accO[nt][2] + accO[nt][3]);
            s += __shfl_xor(s, 16); s += __shfl_xor(s, 32);
            const float mu = s * (1.0f / 128.0f); float qv = 0.f;
#pragma unroll
            for (int nt = 0; nt < 8; ++nt) { const f32x4 d = accO[nt] - mu; qv += (d[0] * d[0] + d[1] * d[1]) + (d[2] * d[2] + d[3] * d[3]); }
            qv += __shfl_xor(qv, 16); qv += __shfl_xor(qv, 32);
            const float rstd = rsqrtf(qv * (1.0f / 128.0f) + 1e-5f);
            const size_t tok = (size_t)b * 2048 + n * 128 + i0 + fr;
            const bf16_t* gp = proj + tok * NPROJ + 4096 + h * 128 + 4 * fq;
            bf16_t* op = CAT + tok * DM + 1024 + h * 128 + 4 * fq;
#pragma unroll
            for (int nt = 0; nt < 8; ++nt) {
                const u32x2 gg = *(const u32x2*)(gp + 16 * nt);
                const float g0 = bf_lo(gg.x), g1 = bf_hi(gg.x), g2 = bf_lo(gg.y), g3 = bf_hi(gg.y);
                const f32x4 y = (accO[nt] - mu) * rstd;
                u32x2 w; w.x = cvt_pk_bf16(y[0] * g0 * sigmoidf_(g0), y[1] * g1 * sigmoidf_(g1)); w.y = cvt_pk_bf16(y[2] * g2 * sigmoidf_(g2), y[3] * g3 * sigmoidf_(g3));
                *(u32x2*)(op + 16 * nt) = w;
            }
        }
        __syncthreads();
#pragma unroll
        for (int nt = 0; nt < 8; ++nt)
            *(LAS u32x2*)(Rs + (i0 + fr) * RS + 16 * nt + 4 * fq) = (u32x2){cvt_pk_bf16(accR[nt][0], accR[nt][1]), cvt_pk_bf16(accR[nt][2], accR[nt][3])};
    }
    __syncthreads();
}

__device__ __forceinline__ void p6_route(const Params& P, LAS unsigned char* lds, int tid, int blk, int G) {
    const int wave = __builtin_amdgcn_readfirstlane(tid >> 6), lane = tid & 63, fr = lane & 15, fq = lane >> 4;
    LAS float* gm = (LAS float*)lds; LAS float* sh = gm + 2048; LAS float* lg = sh + 2048;
    const float* mod = (const float*)(P.ws + WS_MOD);
    const float* x1 = P.out; const float* rowss2 = (const float*)(P.ws + WS_ROWSS2);
    bf16_t* H2 = (bf16_t*)(P.ws + WS_H);
    const bf16_t* WR = (const bf16_t*)(P.ws + WS_WR);
    int* cnt = (int*)(P.ws + WS_CNT); int* list = (int*)(P.ws + WS_LIST); float* wgt = (float*)(P.ws + WS_WGT);
    for (int rb = blk; rb < 256; rb += G) {
        const int b = rb >> 5;
        for (int k = tid; k < 2048; k += NTHREADS) { gm[k] = P.in[18][k] * (1.0f + mod[(size_t)b * NMOD + 4 * DM + k]); sh[k] = mod[(size_t)b * NMOD + 3 * DM + k]; }
        __syncthreads();
        const int mt = wave & 3, kh = wave >> 2;
        const int row = rb * 64 + 16 * mt + fr;
        const float r2 = rsqrtf(rowss2[row] * (1.0f / 2048.0f) + 1e-6f);
        f32x4 acc[3];
#pragma unroll
        for (int nt = 0; nt < 3; ++nt) acc[nt] = (f32x4){0.f, 0.f, 0.f, 0.f};
#pragma unroll 4
        for (int ks = 0; ks < 32; ++ks) {
            const int k0 = 1024 * kh + 32 * ks + 8 * fq;
            const f32x4 a = *(const f32x4*)(x1 + (size_t)row * DM + k0), c = *(const f32x4*)(x1 + (size_t)row * DM + k0 + 4);
            const f32x4 g0 = *(const LAS f32x4*)(gm + k0), g1 = *(const LAS f32x4*)(gm + k0 + 4), s0 = *(const LAS f32x4*)(sh + k0), s1 = *(const LAS f32x4*)(sh + k0 + 4);
            const f32x4 h0 = a * r2 * g0 + s0, h1 = c * r2 * g1 + s1;
            u32x4 w; w.x = cvt_pk_bf16(h0[0], h0[1]); w.y = cvt_pk_bf16(h0[2], h0[3]); w.z = cvt_pk_bf16(h1[0], h1[1]); w.w = cvt_pk_bf16(h1[2], h1[3]);
            *(u32x4*)(H2 + (size_t)row * DM + k0) = w;
            const bf16x8 af = __builtin_bit_cast(bf16x8, w);
#pragma unroll
            for (int nt = 0; nt < 3; ++nt) { const bf16x8 bf = *(const bf16x8*)(WR + (size_t)(16 * nt + fr) * 2048 + k0); acc[nt] = __builtin_amdgcn_mfma_f32_16x16x32_bf16(bf, af, acc[nt], 0, 0, 0); }
        }
#pragma unroll
        for (int nt = 0; nt < 3; ++nt) *(LAS f32x4*)(lg + (kh * 64 + 16 * mt + fr) * 48 + 16 * nt + 4 * fq) = acc[nt];
        __syncthreads();
        if (tid < 64) {
            const int tok = rb * 64 + tid;
            float l[36];
#pragma unroll
            for (int nn = 0; nn < 36; ++nn) l[nn] = lg[tid * 48 + nn] + lg[(64 + tid) * 48 + nn];
            float gl[4]; int gs = 0;
#pragma unroll
            for (int j = 0; j < 4; ++j) gl[j] = l[j] + P.in[20][j];
#pragma unroll
            for (int j = 1; j < 4; ++j) if (gl[j] > gl[gs]) gs = j;
            float gmax = gl[0];
#pragma unroll
            for (int j = 1; j < 4; ++j) gmax = fmaxf(gmax, gl[j]);
            float den = 0.f;
#pragma unroll
            for (int j = 0; j < 4; ++j) den += expf(gl[j] - gmax);
            const float gw = 1.0f / den;
            float el[8];
#pragma unroll
            for (int j = 0; j < 8; ++j) { float v = 0.f;
#pragma unroll
                for (int q = 0; q < 4; ++q) v = (gs == q) ? (l[4 + q * 8 + j] + P.in[22][q * 8 + j]) : v;
                el[j] = v; }
            int j1 = 0;
#pragma unroll
            for (int j = 1; j < 8; ++j) if (el[j] > el[j1]) j1 = j;
            int j2 = (j1 == 0) ? 1 : 0;
#pragma unroll
            for (int j = 0; j < 8; ++j) if (j != j1 && j != j2 && el[j] > el[j2]) j2 = j;
            float e1 = el[0], e2 = el[0];
#pragma unroll
            for (int j = 0; j < 8; ++j) { e1 = (j == j1) ? el[j] : e1; e2 = (j == j2) ? el[j] : e2; }
            const float t2 = expf(e2 - e1), w1 = gw / (1.0f + t2), w2 = gw * t2 / (1.0f + t2);
            const int ea = gs * 8 + j1, eb = gs * 8 + j2;
            const int pa = atomicAdd(cnt + ea, 1); list[ea * 16384 + pa] = tok * 2; wgt[tok * 2] = w1;
            const int pb = atomicAdd(cnt + eb, 1); list[eb * 16384 + pb] = tok * 2 + 1; wgt[tok * 2 + 1] = w2;
        }
        __syncthreads();
    }
}

__device__ __forceinline__ void p9_final(const Params& P, int tid, int blk, int G) {
    const int wave = tid >> 6, lane = tid & 63;
    const float* mod = (const float*)(P.ws + WS_MOD); const bf16_t* Y2 = (const bf16_t*)(P.ws + WS_Y2);
    for (int row = blk * 8 + wave; row < NTOK; row += G * 8) {
        const int b = row >> 11;
        float* xr = P.out + (size_t)row * DM;
        f32x4 v[8]; float ss = 0.f;
#pragma unroll
        for (int i = 0; i < 8; ++i) {
            const int k = (i * 64 + lane) * 4;
            const f32x4 xv = *(const f32x4*)(xr + k);
            const u32x2 ya = *(const u32x2*)(Y2 + (size_t)(2 * row) * DM + k), yb = *(const u32x2*)(Y2 + (size_t)(2 * row + 1) * DM + k);
            const f32x4 gt = *(const f32x4*)(mod + (size_t)b * NMOD + 5 * DM + k);
            f32x4 y; y[0] = bf_lo(ya.x) + bf_lo(yb.x); y[1] = bf_hi(ya.x) + bf_hi(yb.x); y[2] = bf_lo(ya.y) + bf_lo(yb.y); y[3] = bf_hi(ya.y) + bf_hi(yb.y);
            v[i] = xv + gt * y;
            ss += v[i][0] * v[i][0] + v[i][1] * v[i][1] + v[i][2] * v[i][2] + v[i][3] * v[i][3];
        }
        ss = wave_sum(ss);
        const float r = rsqrtf(ss * (1.0f / 2048.0f) + 1e-6f);
#pragma unroll
        for (int i = 0; i < 8; ++i) { const int k = (i * 64 + lane) * 4; const f32x4 gf = *(const f32x4*)(P.in[26] + k); *(f32x4*)(xr + k) = v[i] * r * gf; }
    }
}

__global__ void __launch_bounds__(NTHREADS, 2) hymba_fwd(Params P) {
    extern __shared__ __attribute__((aligned(16))) unsigned char lds_raw[];
    LAS unsigned char* lds = (LAS unsigned char*)lds_raw;
    const int tid = threadIdx.x, blk = blockIdx.x, G = gridDim.x;
    volatile LAS unsigned* misc = (volatile LAS unsigned*)(lds + LDS_MISC);
    if (tid < 64) misc[tid] = 0u;
    __syncthreads();
    XcdBarrier bar = xcd_barrier_post((unsigned*)(P.ws + WS_BAR), misc);
    const int lo = P.ph_lo, hi = P.ph_hi;
#define IN(k) (lo <= (k) && (k) < hi)
#define SEAM(k) do { if (IN(k) && IN((k) + 1)) xcd_barrier(bar); } while (0)
    unsigned char* ws = P.ws;

    if (IN(0)) {
        for (int it = blk; it < 256; it += G) p0_adaln(P, lds, tid, it);
        for (int it = blk; it < 256; it += G) p0_ssm_mats(P, lds, tid, it);
        p0_misc(P, tid, blk, G);
        p0_convert(P, lds, tid, blk, G);
    }
    SEAM(0);
    if (IN(1)) p1_norm1(P, lds, tid, blk, G);
    SEAM(1);
    if (IN(2)) {
        DenseSched S; S.init(NTOK, NPROJ, G, blk); S.abase = (unsigned)WS_H; S.bbase = (unsigned)WS_WIN; S.lda = DM; S.ldb = DM;
        EpiStoreBf16 E{(bf16_t*)(ws + WS_PROJ), NPROJ};
        g8::gemm_phase(lds, ws, DM / 64, DM, S, E);
    }
    SEAM(2);
    if (IN(3)) {
        const int nret = (G >= 128) ? 64 : (G / 2 > 0 ? G / 2 : 1);
        if (blk < nret) { for (int it = blk; it < 64; it += nret) ret_item(P, lds, tid, it); }
        if (G == 1 || blk >= nret) { const int c = (G == 1) ? 0 : blk - nret, st = (G == 1) ? 1 : G - nret; for (int it = c; it < 256; it += st) ssm_item(P, lds, tid, it); }
    }
    SEAM(3);
    if (IN(4)) {
        DenseSched S; S.init(NTOK, 1024, G, blk); S.abase = (unsigned)WS_Z; S.bbase = (unsigned)WS_WGLU; S.lda = 1024; S.ldb = 1024;
        EpiGlu E{(const bf16_t*)(ws + WS_Z), (bf16_t*)(ws + WS_CAT), (float*)(ws + WS_ROWSS1)};
        g8::gemm_phase(lds, ws, 1024 / 64, 1024, S, E);
    }
    SEAM(4);
    if (IN(5)) {
        OutSched S; S.init(NTOK, DM, G, blk); S.abase = (unsigned)WS_CAT; S.bbase = (unsigned)WS_WOUT;
        EpiOut E{P.in[0], (const float*)(ws + WS_MOD), (const float*)(ws + WS_ROWSS1), (float*)(ws + WS_ROWSS2), P.out};
        g8::gemm_phase(lds, ws, 1024 / 64, DM, S, E);
    }
    SEAM(5);
    if (IN(6)) p6_route(P, lds, tid, blk, G);
    SEAM(6);
    if (IN(7) || IN(8)) {
        LAS int* tpre = (LAS int*)(lds + LDS_MISC + 256); LAS int* cn = tpre + 64;
        if (tid == 0) { const int* cg = (const int*)(ws + WS_CNT); int s = 0; for (int e = 0; e < 32; ++e) { const int c = cg[e]; cn[e] = c; tpre[e] = s; s += (c + 255) >> 8; } tpre[32] = s; }
        __syncthreads();
        const int vc = (G % 8 == 0) ? blk : blk;
        if (IN(7)) {
            MoeSched S{tpre, cn, G, vc, (const int*)(ws + WS_LIST), (unsigned)WS_H, (unsigned)WS_WGU, 0};
            EpiMoe1 E{(bf16_t*)(ws + WS_HM)};
            g8::gemm_phase(lds, ws, DM / 64, DM, S, E);
        }
        SEAM(7);
        if (IN(8)) {
            MoeSched S{tpre, cn, G, vc, (const int*)(ws + WS_LIST), (unsigned)WS_HM, (unsigned)WS_WD, 1};
            EpiMoe2 E{tpre, cn, (const int*)(ws + WS_LIST), (const float*)(ws + WS_WGT), (bf16_t*)(ws + WS_Y2)};
            g8::gemm_phase(lds, ws, DEXP / 64, DEXP, S, E);
        }
    }
    SEAM(8);
    if (IN(9)) p9_final(P, tid, blk, G);
#undef IN
#undef SEAM
}

#ifndef N_LAUNCH_SPLIT
#define N_LAUNCH_SPLIT 0
#endif
extern "C" void kernel_launch(void* const* d_in, const int* in_sizes, int n_in, void* d_out, int out_size, void* d_ws, size_t ws_size, hipStream_t stream) {
    static int grid = 0;
    if (grid == 0) {
        if (n_in != 27 || out_size != NTOK * DM || ws_size < WS_END) { fprintf(stderr, "kernel_launch: unexpected shapes (n_in %d out %d ws %zu need %zu)\n", n_in, out_size, ws_size, (size_t)WS_END); grid = -1; return; }
        int dev = 0, cus = 0, per_cu = 0;
        if (hipGetDevice(&dev) != hipSuccess || hipDeviceGetAttribute(&cus, hipDeviceAttributeMultiprocessorCount, dev) != hipSuccess) { grid = -1; return; }
        if (hipFuncSetAttribute((const void*)hymba_fwd, hipFuncAttributeMaxDynamicSharedMemorySize, LDS_BYTES) != hipSuccess) { fprintf(stderr, "kernel_launch: hipFuncSetAttribute failed\n"); grid = -1; return; }
        if (hipOccupancyMaxActiveBlocksPerMultiprocessor(&per_cu, (const void*)hymba_fwd, NTHREADS, LDS_BYTES) != hipSuccess || per_cu < 1) { fprintf(stderr, "kernel_launch: occupancy query says %d\n", per_cu); }
        (void)hipGetLastError();
        grid = cus;
    }
    if (grid < 0) return;
    (void)hipMemsetAsync((char*)d_ws + WS_BAR, 0, 16384, stream);
    Params p{};
    for (int i = 0; i < 27; ++i) p.in[i] = (const float*)d_in[i];
    p.out = (float*)d_out; p.ws = (unsigned char*)d_ws;
#if N_LAUNCH_SPLIT
    for (int ph = 0; ph < 10; ++ph) { p.ph_lo = ph; p.ph_hi = ph + 1; hipLaunchKernelGGL(hymba_fwd, dim3(grid), dim3(NTHREADS), LDS_BYTES, stream, p); }
#else
    p.ph_lo = 0; p.ph_hi = 10;
    hipLaunchKernelGGL(hymba_fwd, dim3(grid), dim3(NTHREADS), LDS_BYTES, stream, p);
#endif
    const hipError_t le = hipPeekAtLastError();
    if (le != hipSuccess) fprintf(stderr, "kernel_launch: launch failed: %s\n", hipGetErrorName(le));
}
```

```cpp
#include <hip/hip_runtime.h>
#include <cstdio>
#include <cstdint>

#define LAS __attribute__((address_space(3)))
typedef unsigned short bf16_t;
typedef short bf16x8 __attribute__((ext_vector_type(8)));
typedef short bf16x4 __attribute__((ext_vector_type(4)));
typedef float f32x4 __attribute__((ext_vector_type(4)));
typedef float f32x2 __attribute__((ext_vector_type(2)));
typedef unsigned u32x4 __attribute__((ext_vector_type(4)));
typedef unsigned u32x2 __attribute__((ext_vector_type(2)));

constexpr int DM = 2048, NB = 8, SEQ = 2048, NTOK = NB * SEQ;
constexpr int NPROJ = 5120;
constexpr int NMOD = 6 * DM;
constexpr int NEXP = 32, DEXP = 1024;
constexpr int NTHREADS = 512;

constexpr size_t WS_BAR   = 0;
constexpr size_t WS_CNT   = 16384;
constexpr size_t WS_ROWSS1= WS_CNT + 4096;
constexpr size_t WS_ROWSS2= WS_ROWSS1 + (size_t)16384 * 16 * 4;
constexpr size_t WS_MODP  = WS_ROWSS2 + (size_t)16384 * 32 * 4;
constexpr size_t WS_MOD   = WS_MODP + (size_t)4 * 8 * NMOD * 4;
constexpr size_t WS_ROPE  = WS_MOD + (size_t)8 * NMOD * 4;
constexpr size_t WS_SSMA  = WS_ROPE + (size_t)2048 * 64 * 8;
constexpr size_t WS_WR    = WS_SSMA + (size_t)64 * 64 * 8;
constexpr size_t WS_SSMM  = WS_WR + (size_t)48 * 2048 * 2;
constexpr size_t WS_WIN   = WS_SSMM + (size_t)64 * 131072 * 2;
constexpr size_t WS_WOUT  = WS_WIN + (size_t)NPROJ * DM * 2;
constexpr size_t WS_WGLU  = WS_WOUT + (size_t)DM * DM * 2;
constexpr size_t WS_WGU   = WS_WGLU + (size_t)1024 * 1024 * 2;
constexpr size_t WS_WD    = WS_WGU + (size_t)NEXP * 2048 * 2048 * 2;
constexpr size_t WS_H     = WS_WD + (size_t)NEXP * 2048 * 1024 * 2;
constexpr size_t WS_PROJ  = WS_H + (size_t)NTOK * DM * 2;
constexpr size_t WS_Z     = WS_PROJ + (size_t)NTOK * NPROJ * 2;
constexpr size_t WS_CAT   = WS_Z + (size_t)NTOK * 1024 * 2;
constexpr size_t WS_WGT   = WS_CAT + (size_t)NTOK * DM * 2;
constexpr size_t WS_LIST  = WS_WGT + (size_t)32768 * 4;
constexpr size_t WS_X1    = WS_LIST + (size_t)32 * 16384 * 4;
constexpr size_t WS_END   = WS_X1 + (size_t)NTOK * DM * 2;
constexpr size_t WS_Y2    = WS_PROJ;
constexpr size_t WS_HM    = WS_Z;

constexpr int LDS_STAGE = 131072;
constexpr int LDS_BYTES = 147456;
constexpr int LDS_MISC  = LDS_BYTES - 2048;

struct Params { const float* in[27]; float* out; unsigned char* ws; int ph_lo, ph_hi; };

#define XB_TMO      128
#define XB_XCNT(j)  (256  + 64 * (j))
#define XB_XSUB(j)  (1280 + 64 * (j))
#define XB_XGEN(j)  (2304 + 64 * (j))
#define XB_TOP      3328
#define XB_TOPGEN   3392
#define XCD_BAR_WORDS 3456
#define XB_SPIN_CAP (1u << 22)

__device__ __forceinline__ unsigned xb_ld(unsigned* p)              { return __hip_atomic_load(p, __ATOMIC_RELAXED, __HIP_MEMORY_SCOPE_AGENT); }
__device__ __forceinline__ unsigned xb_add(unsigned* p, unsigned v) { return __hip_atomic_fetch_add(p, v, __ATOMIC_RELAXED, __HIP_MEMORY_SCOPE_AGENT); }
__device__ __forceinline__ unsigned xb_xcc_id() { return (unsigned)__builtin_amdgcn_s_getreg((3 << 11) | 20) & 0xFu; }
#define XB_SPIN(cond, bar) do { unsigned _sp = 0; while (cond) { __builtin_amdgcn_s_sleep(1); \
    if ((++_sp & 255u) == 0u) { if (xb_ld(&(bar)[XB_TMO])) break; if (_sp > XB_SPIN_CAP) { atomicAdd(&(bar)[XB_TMO], 1u); break; } } } } while (0)

struct XcdBarrier { unsigned* bar; unsigned x; volatile LAS unsigned* st; };

__device__ __forceinline__ XcdBarrier xcd_barrier_post(unsigned* bar, volatile LAS unsigned* st) {
    XcdBarrier b; b.bar = bar; b.x = xb_xcc_id(); b.st = st;
    if (threadIdx.x == 0) (void)xb_add(&bar[XB_XCNT(b.x)], 1u);
    return b;
}
__device__ __forceinline__ void xcd_barrier_complete(unsigned* bar, unsigned x, unsigned& nloc, unsigned& nx) {
    const unsigned G = gridDim.x * gridDim.y * gridDim.z;
    unsigned sum, cnt, mine, sp = 0u;
    for (;;) {
        sum = 0u; cnt = 0u; mine = 0u;
#pragma unroll
        for (unsigned j = 0; j < 16; ++j) { const unsigned c = xb_ld(&bar[XB_XCNT(j)]); sum += c; cnt += (c > 0u) ? 1u : 0u; mine = (j == x) ? c : mine; }
        if (sum == G) break;
        __builtin_amdgcn_s_sleep(1);
        if ((++sp & 255u) == 0u) { if (xb_ld(&bar[XB_TMO])) break; if (sp > XB_SPIN_CAP) { atomicAdd(&bar[XB_TMO], 1u); break; } }
    }
    nloc = mine > 0u ? mine : 1u; nx = cnt > 0u ? cnt : 1u;
}
__device__ __forceinline__ void xcd_barrier(const XcdBarrier& b) {
    asm volatile("s_waitcnt vmcnt(0)" ::: "memory");
    __syncthreads();
    if (threadIdx.x == 0) {
        unsigned* bar = b.bar;
        __builtin_amdgcn_s_waitcnt(0);
        unsigned nloc = b.st[0], nx = b.st[1];
        if (nloc == 0u) { xcd_barrier_complete(bar, b.x, nloc, nx); b.st[0] = nloc; b.st[1] = nx; }
        const unsigned old = xb_add(&bar[XB_XSUB(b.x)], 1u);
        const unsigned gen = old / nloc;
        if (old + 1u == (gen + 1u) * nloc) {
            __builtin_amdgcn_fence(__ATOMIC_RELEASE, "agent");
            asm volatile("s_waitcnt vmcnt(0)" ::: "memory");
            const unsigned og = xb_add(&bar[XB_TOP], 1u);
            const unsigned tg = og / nx;
            if (og + 1u == (tg + 1u) * nx) xb_add(&bar[XB_TOPGEN], 1u);
            else XB_SPIN(xb_ld(&bar[XB_TOPGEN]) == tg, bar);
            __builtin_amdgcn_fence(__ATOMIC_ACQUIRE, "agent");
            xb_add(&bar[XB_XGEN(b.x)], 1u);
            asm volatile("s_waitcnt vmcnt(0)" ::: "memory");
        } else {
            XB_SPIN(xb_ld(&bar[XB_XGEN(b.x)]) == gen, bar);
            __builtin_amdgcn_fence(__ATOMIC_ACQUIRE, "agent");
            asm volatile("s_waitcnt vmcnt(0)" ::: "memory");
        }
    }
    __syncthreads();
}

typedef __bf16 bf16x2_t __attribute__((ext_vector_type(2)));
__device__ __forceinline__ unsigned cvt_pk_bf16(float lo, float hi) { const f32x2 v = {lo, hi}; return __builtin_bit_cast(unsigned, __builtin_convertvector(v, bf16x2_t)); }
__device__ __forceinline__ float bf_lo(unsigned w) { return __uint_as_float(w << 16); }
__device__ __forceinline__ float bf_hi(unsigned w) { return __uint_as_float(w & 0xffff0000u); }
__device__ __forceinline__ float sigmoidf_(float x) { return 1.0f / (1.0f + __expf(-x)); }
__device__ __forceinline__ float gelu_tanh(float x) {
    const float u = 0.7978845608028654f * (x + 0.044715f * x * x * x);
    const float t = 1.0f - 2.0f / (1.0f + __expf(2.0f * u));
    return 0.5f * x * (1.0f + t);
}
__device__ __forceinline__ float wave_sum(float v) {
    v += __shfl_xor(v, 1); v += __shfl_xor(v, 2); v += __shfl_xor(v, 4); v += __shfl_xor(v, 8); v += __shfl_xor(v, 16); v += __shfl_xor(v, 32); return v;
}
__device__ __forceinline__ void sincos_d(double x, double& s, double& c) {
    const double TWO_PI = 6.283185307179586476925286766559;
    double r = x - TWO_PI * rint(x / TWO_PI);
    const double r2 = r * r;
    double ts = r, tc = 1.0; s = r; c = 1.0;
#pragma unroll 1
    for (int k = 1; k <= 14; ++k) { tc *= -r2 / (double)((2 * k - 1) * (2 * k)); ts *= -r2 / (double)((2 * k) * (2 * k + 1)); c += tc; s += ts; }
}

namespace g8 {
constexpr int BM = 256, BK = 64, HALF = 128, HTB = HALF * BK * 2, NXCD = 8, WGM = 8;
__device__ __forceinline__ int lds_byte(int r, int c) { const int st = (r >> 4) * 2 + (c >> 5), rr = r & 15, cc = c & 31, ob = rr * 64 + cc * 2; return st * 1024 + (ob ^ (((ob >> 9) & 1) << 5)); }
__device__ __forceinline__ void stage_rc(int b, int& R, int& C) { const int st = b / 1024, sb = b % 1024, swz = sb ^ (((sb >> 9) & 1) << 5); R = (st >> 1) * 16 + swz / 64; C = (st & 1) * 32 + (swz % 64) / 2; }
__device__ __forceinline__ int perm32(int rho) { const int n = rho >> 4, i = rho & 15; return 8 * (i >> 2) + 4 * n + (i & 3); }

struct Unit { unsigned aoff, boff; int pm, pn, flags, aux; };
typedef f32x4 Acc[2][2][4][2];

struct StaticOrder {
    int nM, nN, nwg, G, c;
    __device__ void init(int M, int N, int G_, int c_) { nM = M / BM; nN = N / BM; nwg = nM * nN; G = G_; c = c_; }
    __device__ __forceinline__ bool tile(int i, int& pm, int& pn) const {
        const long L = (long)i * G + c; if (L >= nwg) return false;
        int wgid = (int)L; { const int q = nwg / NXCD, r = nwg % NXCD, xcd = wgid % NXCD, off = wgid / NXCD; wgid = (xcd < r ? xcd * (q + 1) : r * (q + 1) + (xcd - r) * q) + off; }
        const int nig = WGM * nN, gid = wgid / nig, fm = gid * WGM, gsz = (nM - fm) < WGM ? (nM - fm) : WGM;
        pm = fm + ((wgid % nig) % gsz); pn = (wgid % nig) / gsz; return true;
    }
};

template <class Epi, class Sched>
__device__ __forceinline__ void gemm_phase(LAS unsigned char* lds, const unsigned char* ws, const int nt, const int ldb  , const Sched& S, const Epi& E) {
    const int tid = threadIdx.x, wid = __builtin_amdgcn_readfirstlane(tid >> 6), lane = tid & 63, wr = wid >> 2, wc = wid & 3, fr = lane & 15, fq = lane >> 4;
    int R0, C0, R1, C1; stage_rc(tid * 16, R0, C0); stage_rc(tid * 16 + 8192, R1, C1);
    unsigned voffB[2];
    { const int Rb0 = Epi::PERM ? ((R0 & ~31) + perm32(R0 & 31)) : R0, Rb1 = Epi::PERM ? ((R1 & ~31) + perm32(R1 & 31)) : R1;
      voffB[0] = (unsigned)(Rb0 * ldb + C0) * 2u; voffB[1] = (unsigned)(Rb1 * ldb + C1) * 2u; }
    const unsigned kstep = (unsigned)(BK * 2);
    const unsigned hstepB = (unsigned)HALF * (unsigned)ldb * 2u;
    const unsigned ldsw = (unsigned)wid * 1024u;
    const int aoff = lds_byte(wr * 64 + fr, fq * 8), boff = lds_byte(wc * 32 + fr, fq * 8);
#define G8_SA(b, h) (((b) * 2 + (h)) * HTB)
#define G8_SB(b, h) ((4 + (b) * 2 + (h)) * HTB)
#define G8_STAGE(bufoff, gbase, v0, v1) do { \
        __builtin_amdgcn_global_load_lds((const unsigned*)((gbase) + (v0)), (LAS unsigned*)(lds + (bufoff) + ldsw), 16, 0, 0); \
        __builtin_amdgcn_global_load_lds((const unsigned*)((gbase) + (v1)), (LAS unsigned*)(lds + (bufoff) + ldsw + 8192), 16, 0, 0); } while (0)
#define G8_LDA(dst, b, h) do { _Pragma("unroll") for (int m = 0; m < 4; ++m) _Pragma("unroll") for (int k = 0; k < 2; ++k) dst[m][k] = *(const LAS bf16x8*)(lds + G8_SA(b, h) + aoff + m * 2048 + k * 1024); } while (0)
#define G8_LDB(dst, b, h) do { _Pragma("unroll") for (int n = 0; n < 2; ++n) _Pragma("unroll") for (int k = 0; k < 2; ++k) dst[n][k] = *(const LAS bf16x8*)(lds + G8_SB(b, h) + boff + n * 2048 + k * 1024); } while (0)
#define G8_MMA(ai, bj, At, Bt) do { __builtin_amdgcn_s_setprio(1); _Pragma("unroll") for (int m = 0; m < 4; ++m) _Pragma("unroll") for (int n = 0; n < 2; ++n) _Pragma("unroll") for (int k = 0; k < 2; ++k) \
        acc[ai][bj][m][n] = __builtin_amdgcn_mfma_f32_16x16x32_bf16(Bt[n][k], At[m][k], acc[ai][bj][m][n], 0, 0, 0); __builtin_amdgcn_s_setprio(0); } while (0)
#define G8_WAIT_V(n) asm volatile("s_waitcnt vmcnt(" #n ")" ::: "memory")
#define G8_WAIT_L(n) asm volatile("s_waitcnt lgkmcnt(" #n ")" ::: "memory")
#define G8_BAR __builtin_amdgcn_s_barrier()
#define G8_SCHED __builtin_amdgcn_sched_barrier(0)
    Unit cur, nxt; int ui = 0;
    if (!S.next(0, cur)) return;
    Acc acc;
#pragma unroll
    for (int a = 0; a < 2; ++a)
#pragma unroll
        for (int b = 0; b < 2; ++b)
#pragma unroll
            for (int m = 0; m < 4; ++m)
#pragma unroll
                for (int n = 0; n < 2; ++n) acc[a][b][m][n] = (f32x4){0.f, 0.f, 0.f, 0.f};
    bf16x8 At[4][2], B0[2][2], B1[2][2];
    unsigned cv[2][2], nv[2][2];
    S.aoffs(cur, R0, C0, R1, C1, cv);
    const unsigned char* cA = ws + cur.aoff; const unsigned char* cB = ws + cur.boff;
    G8_STAGE(G8_SB(0, 0), cB, voffB[0], voffB[1]); G8_STAGE(G8_SA(0, 0), cA, cv[0][0], cv[0][1]);
    G8_STAGE(G8_SB(0, 1), cB + hstepB, voffB[0], voffB[1]); G8_STAGE(G8_SA(0, 1), cA, cv[1][0], cv[1][1]);
    if (wr == 1) G8_BAR;
    G8_WAIT_V(4); G8_BAR;
    G8_STAGE(G8_SB(1, 0), cB + kstep, voffB[0], voffB[1]); G8_STAGE(G8_SA(1, 0), cA + kstep, cv[0][0], cv[0][1]);
    G8_STAGE(G8_SB(1, 1), cB + hstepB + kstep, voffB[0], voffB[1]);
    G8_WAIT_V(6); G8_BAR;
    for (;;) {
        const bool has_next = S.next(ui + 1, nxt);
        if (has_next) S.aoffs(nxt, R0, C0, R1, C1, nv);
        else { nv[0][0] = cv[0][0]; nv[0][1] = cv[0][1]; nv[1][0] = cv[1][0]; nv[1][1] = cv[1][1]; }
        const unsigned char* nA = has_next ? ws + nxt.aoff : cA; const unsigned char* nB = has_next ? ws + nxt.boff : cB;
        for (int t = 0; t < nt; t += 2) {
            const bool last = (t == nt - 2);
            const unsigned char* a1 = cA + (size_t)(t + 1) * kstep;
            const unsigned char* a2 = last ? nA : cA + (size_t)(t + 2) * kstep; const unsigned char* b2 = last ? nB : cB + (size_t)(t + 2) * kstep;
            const unsigned char* a3 = a2 + kstep; const unsigned char* b3 = b2 + kstep;
            const unsigned o00 = last ? nv[0][0] : cv[0][0], o01 = last ? nv[0][1] : cv[0][1], o10 = last ? nv[1][0] : cv[1][0], o11 = last ? nv[1][1] : cv[1][1];
            G8_LDB(B0, 0, 0); G8_SCHED; G8_LDA(At, 0, 0); G8_STAGE(G8_SA(1, 1), a1, cv[1][0], cv[1][1]);
            G8_WAIT_L(8); G8_BAR; G8_WAIT_L(0); G8_MMA(0, 0, At, B0); G8_BAR; G8_SCHED;
            G8_LDB(B1, 0, 1); G8_STAGE(G8_SB(0, 0), b2, voffB[0], voffB[1]);
            G8_BAR; G8_WAIT_L(0); G8_MMA(0, 1, At, B1); G8_BAR;
            G8_LDA(At, 0, 1); G8_STAGE(G8_SA(0, 0), a2, o00, o01);
            G8_BAR; G8_WAIT_L(0); G8_MMA(1, 0, At, B0); G8_BAR; G8_SCHED;
            G8_STAGE(G8_SB(0, 1), b2 + hstepB, voffB[0], voffB[1]);
            G8_WAIT_V(6); G8_BAR; G8_MMA(1, 1, At, B1); G8_BAR;
            G8_LDB(B0, 1, 0); G8_SCHED; G8_LDA(At, 1, 0); G8_STAGE(G8_SA(0, 1), a2, o10, o11);
            G8_WAIT_L(8); G8_BAR; G8_WAIT_L(0); G8_MMA(0, 0, At, B0); G8_BAR; G8_SCHED;
            G8_LDB(B1, 1, 1); G8_STAGE(G8_SB(1, 0), b3, voffB[0], voffB[1]);
            G8_BAR; G8_WAIT_L(0); G8_MMA(0, 1, At, B1); G8_BAR;
            G8_LDA(At, 1, 1); G8_STAGE(G8_SA(1, 0), a3, o00, o01);
            G8_BAR; G8_WAIT_L(0); G8_MMA(1, 0, At, B0); G8_BAR; G8_SCHED;
            G8_STAGE(G8_SB(1, 1), b3 + hstepB, voffB[0], voffB[1]);
            G8_WAIT_V(6); G8_BAR; G8_MMA(1, 1, At, B1); G8_BAR;
        }
        E(acc, cur, wr, wc, fr, fq);
        if (!has_next) break;
        if (!(cur.flags & 1)) {
#pragma unroll
            for (int a = 0; a < 2; ++a)
#pragma unroll
                for (int b = 0; b < 2; ++b)
#pragma unroll
                    for (int m = 0; m < 4; ++m)
#pragma unroll
                        for (int n = 0; n < 2; ++n) acc[a][b][m][n] = (f32x4){0.f, 0.f, 0.f, 0.f};
        }
        cur = nxt; cA = nA; cB = nB; ++ui;
        cv[0][0] = nv[0][0]; cv[0][1] = nv[0][1]; cv[1][0] = nv[1][0]; cv[1][1] = nv[1][1];
    }
    G8_WAIT_V(0);
    if (wr == 0) G8_BAR;
    G8_BAR;
#undef G8_SA
#undef G8_SB
#undef G8_STAGE
#undef G8_LDA
#undef G8_LDB
#undef G8_MMA
#undef G8_WAIT_V
#undef G8_WAIT_L
#undef G8_BAR
#undef G8_SCHED
}
}

__device__ __forceinline__ void p0_adaln(const Params& P, LAS unsigned char* lds, int tid, int item) {
    const int ks = item & 3, nc = item >> 2;
    LAS float* sc = (LAS float*)lds;
    LAS float* red = (LAS float*)(lds + 16384);
    const float* c = P.in[1];
    for (int i = tid; i < 4096; i += NTHREADS) { const int kl = i >> 3, b = i & 7; const float v = c[b * 2048 + ks * 512 + kl]; sc[i] = v / (1.0f + expf(-v)); }
    __syncthreads();
    if (tid < 384) {
        const int nq = tid % 48, kg = tid / 48;
        const float* W = P.in[2] + (size_t)(ks * 512 + kg * 64) * NMOD + nc * 192 + nq * 4;
        f32x4 acc[8];
#pragma unroll
        for (int b = 0; b < 8; ++b) acc[b] = (f32x4){0.f, 0.f, 0.f, 0.f};
#pragma unroll 8
        for (int kk = 0; kk < 64; ++kk) {
            const f32x4 w = *(const f32x4*)(W + (size_t)kk * NMOD);
            const f32x4 s0 = *(const LAS f32x4*)(sc + (kg * 64 + kk) * 8), s1 = *(const LAS f32x4*)(sc + (kg * 64 + kk) * 8 + 4);
            acc[0] += w * s0[0]; acc[1] += w * s0[1]; acc[2] += w * s0[2]; acc[3] += w * s0[3];
            acc[4] += w * s1[0]; acc[5] += w * s1[1]; acc[6] += w * s1[2]; acc[7] += w * s1[3];
        }
#pragma unroll
        for (int b = 0; b < 8; ++b) *(LAS f32x4*)(red + (kg * 8 + b) * 192 + nq * 4) = acc[b];
    }
    __syncthreads();
    float* modp = (float*)(P.ws + WS_MODP);
    for (int i = tid; i < 8 * 192; i += NTHREADS) {
        const int b = i / 192, n = i % 192; float s = 0.f;
#pragma unroll
        for (int kg = 0; kg < 8; ++kg) s += red[(kg * 8 + b) * 192 + n];
        modp[(size_t)(ks * 8 + b) * NMOD + nc * 192 + n] = s;
    }
    __syncthreads();
}

struct CvtUnit { const float* src; bf16_t* dst; int Nd, Kd, k0, n0, nmode; const float* s0; const float* s1; };
constexpr int CVT_UNITS = 640 + 256 + 64 + 3 * 4096;
__device__ __forceinline__ void cvt_unit_decode(const Params& P, int L, CvtUnit& u) {
    u.s0 = nullptr; u.s1 = nullptr; u.nmode = 0;
    if (L < 640) { u.src = P.in[5]; u.dst = (bf16_t*)(P.ws + WS_WIN); u.Kd = 2048; u.Nd = 5120; u.k0 = (L / 20) * 64; u.n0 = (L % 20) * 256; u.nmode = 3; return; }
    L -= 640;
    if (L < 256) { u.src = P.in[17]; u.dst = (bf16_t*)(P.ws + WS_WOUT); u.Kd = 2048; u.Nd = 2048; u.k0 = (L / 8) * 64; u.n0 = (L % 8) * 256; u.s0 = P.in[15]; u.s1 = P.in[16]; return; }
    L -= 256;
    if (L < 64) { u.src = P.in[14]; u.dst = (bf16_t*)(P.ws + WS_WGLU); u.Kd = 1024; u.Nd = 1024; u.k0 = (L / 4) * 64; u.n0 = (L % 4) * 256; return; }
    L -= 64;
    if (L < 4096) { const int e = L >> 7, r = L & 127; u.src = P.in[23] + (size_t)e * 2048 * 1024; u.dst = (bf16_t*)(P.ws + WS_WGU) + (size_t)e * 2048 * 2048; u.Kd = 2048; u.Nd = 1024; u.k0 = (r >> 2) * 64; u.n0 = (r & 3) * 256; u.nmode = 1; return; }
    L -= 4096;
    if (L < 4096) { const int e = L >> 7, r = L & 127; u.src = P.in[24] + (size_t)e * 2048 * 1024; u.dst = (bf16_t*)(P.ws + WS_WGU) + (size_t)e * 2048 * 2048; u.Kd = 2048; u.Nd = 1024; u.k0 = (r >> 2) * 64; u.n0 = (r & 3) * 256; u.nmode = 2; return; }
    L -= 4096;
    { const int e = L >> 7, r = L & 127; u.src = P.in[25] + (size_t)e * 1024 * 2048; u.dst = (bf16_t*)(P.ws + WS_WD) + (size_t)e * 2048 * 1024; u.Kd = 1024; u.Nd = 2048; u.k0 = (r >> 3) * 64; u.n0 = (r & 7) * 256; }
}
__device__ __forceinline__ void cvt_load(const CvtUnit& u, int tid, f32x4 (&r)[8]) {
    const int kp = tid >> 4, nq = tid & 15;
    const float* p = u.src + (size_t)(u.k0 + 2 * kp) * u.Nd + u.n0 + nq * 4;
#pragma unroll
    for (int s = 0; s < 4; ++s) { r[2 * s] = *(const f32x4*)(p + s * 64); r[2 * s + 1] = *(const f32x4*)(p + u.Nd + s * 64); }
    if (u.s0) {
        const int k = u.k0 + 2 * kp;
        const float a = (k < 1024) ? u.s0[k] : u.s1[k - 1024], b = (k + 1 < 1024) ? u.s0[k + 1] : u.s1[k + 1 - 1024];
#pragma unroll
        for (int s = 0; s < 4; ++s) { r[2 * s] *= a; r[2 * s + 1] *= b; }
    }
}
__device__ __forceinline__ void cvt_to_lds(LAS unsigned* tile, const f32x4 (&r)[8], int kp, int nq) {
#pragma unroll
    for (int s = 0; s < 4; ++s)
#pragma unroll
        for (int j = 0; j < 4; ++j) tile[s * 2112 + (nq * 4 + j) * 33 + kp] = cvt_pk_bf16(r[2 * s][j], r[2 * s + 1][j]);
}
__device__ __forceinline__ void cvt_store(const LAS unsigned* tile, const CvtUnit& u, int nl, int kq) {
#pragma unroll
    for (int s = 0; s < 4; ++s) {
        u32x4 w; w.x = tile[s * 2112 + nl * 33 + kq * 4]; w.y = tile[s * 2112 + nl * 33 + kq * 4 + 1]; w.z = tile[s * 2112 + nl * 33 + kq * 4 + 2]; w.w = tile[s * 2112 + nl * 33 + kq * 4 + 3];
        const int n = u.n0 + s * 64 + nl;
        int np = n;
        if (u.nmode == 1 || u.nmode == 2) np = (n >> 7) * 256 + (n & 127) + (u.nmode == 2 ? 128 : 0);
        else if (u.nmode == 3 && n >= 1024 && n < 3072) { const int reg = (n >= 2048) ? 2048 : 1024, nr = n - reg;
            np = reg + ((nr >> 8) << 8) + (((nr >> 6) & 1) << 7) + (((nr >> 7) & 1) << 6) + (nr & 63); }
        *(u32x4*)(u.dst + (size_t)np * u.Kd + u.k0 + kq * 8) = w;
    }
}
__device__ __forceinline__ void p0_convert(const Params& P, LAS unsigned char* lds, int tid, int blk, int G) {
    LAS unsigned* tileA = (LAS unsigned*)lds;
    LAS unsigned* tileB = tileA + 4 * 2112;
    const int kp = tid >> 4, nq = tid & 15, nl = tid >> 3, kq = tid & 7;
    CvtUnit uA, uB, nA, nB; f32x4 rA[8], rB[8];
    int L = blk;
    if (L >= CVT_UNITS) return;
    bool hasB = (L + G) < CVT_UNITS;
    cvt_unit_decode(P, L, uA); cvt_load(uA, tid, rA);
    if (hasB) { cvt_unit_decode(P, L + G, uB); cvt_load(uB, tid, rB); }
    for (;;) {
        cvt_to_lds(tileA, rA, kp, nq);
        if (hasB) cvt_to_lds(tileB, rB, kp, nq);
        __syncthreads();
        const int Ln = L + 2 * G; const bool moreA = Ln < CVT_UNITS, moreB = (Ln + G) < CVT_UNITS;
        if (moreA) { cvt_unit_decode(P, Ln, nA); cvt_load(nA, tid, rA); }
        if (moreB) { cvt_unit_decode(P, Ln + G, nB); cvt_load(nB, tid, rB); }
        cvt_store(tileA, uA, nl, kq);
        if (hasB) cvt_store(tileB, uB, nl, kq);
        __syncthreads();
        if (!moreA) break;
        uA = nA; uB = nB; hasB = moreB; L = Ln;
    }
}

__device__ __forceinline__ void p0_ssm_mats(const Params& P, LAS unsigned char* lds, int tid, int item) {
    const int g = item & 63, q = item >> 6;
    LAS f32x2* pw = (LAS f32x2*)lds;
    LAS f32x2* Bb = pw + 17 * 64;
    LAS f32x2* Cc = Bb + 64 * 16;
    LAS float* Kt = (LAS float*)(Cc + 16 * 64);
    if (tid < 64) {
        const int p = tid;
        const float dt = expf(P.in[13][g]);
        const float are = P.in[6][g * 64 + p], aim = P.in[7][g * 64 + p];
        const float mag = expf(dt * are);
        double sd, cd; sincos_d((double)(dt * aim), sd, cd);
        const float abr = mag * (float)cd, abi = mag * (float)sd;
        const float inv = 1.0f / (are * are + aim * aim);
        const float nre = abr - 1.0f;
        const float fre = (nre * are + abi * aim) * inv, fim = (abi * are - nre * aim) * inv;
        float pr = 1.0f, pi = 0.0f;
        for (int n = 0; n <= 16; ++n) { pw[n * 64 + p] = (f32x2){pr, pi}; const float t = pr * abr - pi * abi; pi = pr * abi + pi * abr; pr = t; }
        for (int h = 0; h < 16; ++h) {
            const float br = P.in[8][(g * 64 + p) * 16 + h], bi = P.in[9][(g * 64 + p) * 16 + h];
            Bb[p * 16 + h] = (f32x2){fre * br - fim * bi, fre * bi + fim * br};
            Cc[h * 64 + p] = (f32x2){P.in[10][(g * 16 + h) * 64 + p], P.in[11][(g * 16 + h) * 64 + p]};
        }
        if (q == 0) { f32x2* AL = (f32x2*)(P.ws + WS_SSMA); const f32x2 v = pw[16 * 64 + p]; AL[g * 64 + p] = v; }
    }
    __syncthreads();
    for (int o = tid; o < 4096; o += NTHREADS) {
        const int tau = o >> 8, ho = (o >> 4) & 15, hi = o & 15; float s = 0.f;
        for (int p = 0; p < 64; ++p) {
            const f32x2 c = Cc[ho * 64 + p], a = pw[tau * 64 + p], b = Bb[p * 16 + hi];
            const float cr = c.x * a.x - c.y * a.y, ci = c.x * a.y + c.y * a.x;
            s += cr * b.x - ci * b.y;
        }
        Kt[o] = s;
    }
    __syncthreads();
    bf16_t* Ms = (bf16_t*)(P.ws + WS_SSMM) + (size_t)g * 131072;
    bf16_t* TM = Ms + 32768;
    for (int o = tid; o < 32 * 128; o += NTHREADS) {
        const int row = 32 * q + (o >> 7), col = (o & 127) * 2;
        const int p = row >> 1, j = col >> 4, hi = col & 15;
        const f32x2 a = pw[(15 - j) * 64 + p], b0 = Bb[p * 16 + hi], b1 = Bb[p * 16 + hi + 1];
        float v0, v1;
        if ((row & 1) == 0) { v0 = a.x * b0.x - a.y * b0.y; v1 = a.x * b1.x - a.y * b1.y; } else { v0 = a.x * b0.y + a.y * b0.x; v1 = a.x * b1.y + a.y * b1.x; }
        *(unsigned*)(Ms + (size_t)row * 256 + col) = cvt_pk_bf16(v0, v1);
    }
    for (int o = tid; o < 64 * 192; o += NTHREADS) {
        const int row = 64 * q + o / 192, col = (o % 192) * 2;
        const int i = row >> 4, ho = row & 15; float v0, v1;
        if (col < 256) { const int j = col >> 4, hi = col & 15; if (j <= i) { v0 = Kt[((i - j) * 16 + ho) * 16 + hi]; v1 = Kt[((i - j) * 16 + ho) * 16 + hi + 1]; } else { v0 = 0.f; v1 = 0.f; } }
        else { const int p0 = (col - 256) >> 1;
            const f32x2 c0 = Cc[ho * 64 + p0], a0 = pw[(i + 1) * 64 + p0];
            v0 = c0.x * a0.x - c0.y * a0.y; v1 = -(c0.x * a0.y + c0.y * a0.x); }
        *(unsigned*)(TM + (size_t)row * 384 + col) = cvt_pk_bf16(v0, v1);
    }
    __syncthreads();
}

__device__ __forceinline__ void p0_misc(const Params& P, int tid, int blk, int G) {
    f32x2* rope = (f32x2*)(P.ws + WS_ROPE);
    for (int i = blk * NTHREADS + tid; i < 2048 * 64; i += G * NTHREADS) {
        const int pos = i >> 6, d = i & 63;
        double th = 1.0; { const double r = 0.86596432336006535; double b = r; int e = d; while (e) { if (e & 1) th *= b; b *= b; e >>= 1; } }
        double s1, c1; sincos_d(th, s1, c1);
        double cr = 1.0, ci = 0.0, br = c1, bi = s1; int e = pos;
        while (e) { if (e & 1) { const double t = cr * br - ci * bi; ci = cr * bi + ci * br; cr = t; } const double t2 = br * br - bi * bi; bi = 2.0 * br * bi; br = t2; e >>= 1; }
        rope[i] = (f32x2){(float)cr, (float)ci};
    }
    bf16_t* wr = (bf16_t*)(P.ws + WS_WR);
    for (int i = blk * NTHREADS + tid; i < 48 * 2048; i += G * NTHREADS) {
        const int n = i >> 11, k = i & 2047; float v = 0.f;
        if (n < 4) v = P.in[19][k * 4 + n]; else if (n < 36) v = P.in[21][k * 32 + (n - 4)];
        wr[i] = (bf16_t)(cvt_pk_bf16(v, 0.f) & 0xffffu);
    }
    if (blk == 0 && tid < 64) ((int*)(P.ws + WS_CNT))[tid] = 0;
}

__device__ __forceinline__ void p1_norm1(const Params& P, LAS unsigned char* lds, int tid, int blk, int G) {
    const float* modp = (const float*)(P.ws + WS_MODP); const float* bada = P.in[3];
    float* mod = (float*)(P.ws + WS_MOD);
    for (int i = blk * NTHREADS + tid; i < 8 * NMOD; i += G * NTHREADS) {
        const int b = i / NMOD, j = i % NMOD;
        mod[i] = bada[j] + ((modp[(size_t)(0 * 8 + b) * NMOD + j] + modp[(size_t)(1 * 8 + b) * NMOD + j]) + (modp[(size_t)(2 * 8 + b) * NMOD + j] + modp[(size_t)(3 * 8 + b) * NMOD + j]));
    }
    LAS float* gm = (LAS float*)lds; LAS float* sh = gm + 2048;
    const int wave = tid >> 6, lane = tid & 63;
    bf16_t* H = (bf16_t*)(P.ws + WS_H);
    for (int rb = blk; rb < 256; rb += G) {
        const int b = rb >> 5;
        for (int k = tid; k < 2048; k += NTHREADS) {
            const int js = 2048 + k, jh = k;
            const float sc = bada[js] + ((modp[(size_t)(0 * 8 + b) * NMOD + js] + modp[(size_t)(1 * 8 + b) * NMOD + js]) + (modp[(size_t)(2 * 8 + b) * NMOD + js] + modp[(size_t)(3 * 8 + b) * NMOD + js]));
            const float sv = bada[jh] + ((modp[(size_t)(0 * 8 + b) * NMOD + jh] + modp[(size_t)(1 * 8 + b) * NMOD + jh]) + (modp[(size_t)(2 * 8 + b) * NMOD + jh] + modp[(size_t)(3 * 8 + b) * NMOD + jh]));
            gm[k] = P.in[4][k] * (1.0f + sc); sh[k] = sv;
        }
        __syncthreads();
        for (int rr = 0; rr < 8; ++rr) {
            const int row = rb * 64 + wave * 8 + rr;
            const float* xr = P.in[0] + (size_t)row * DM;
            f32x4 v[8]; float ss = 0.f;
#pragma unroll
            for (int i = 0; i < 8; ++i) { v[i] = *(const f32x4*)(xr + (i * 64 + lane) * 4); ss += v[i][0] * v[i][0] + v[i][1] * v[i][1] + v[i][2] * v[i][2] + v[i][3] * v[i][3]; }
            ss = wave_sum(ss);
            const float r = rsqrtf(ss * (1.0f / 2048.0f) + 1e-6f);
#pragma unroll
            for (int i = 0; i < 8; ++i) {
                const int k = (i * 64 + lane) * 4;
                const f32x4 g4 = *(const LAS f32x4*)(gm + k), s4 = *(const LAS f32x4*)(sh + k);
                const f32x4 o = v[i] * r * g4 + s4;
                u32x2 w; w.x = cvt_pk_bf16(o[0], o[1]); w.y = cvt_pk_bf16(o[2], o[3]);
                *(u32x2*)(H + (size_t)row * DM + k) = w;
            }
        }
        __syncthreads();
    }
}

struct DenseSched : g8::StaticOrder {
    unsigned abase, bbase; int lda, ldb;
    __device__ __forceinline__ bool next(int i, g8::Unit& u) const {
        int pm, pn; if (!tile(i, pm, pn)) return false;
        u.pm = __builtin_amdgcn_readfirstlane(pm); u.pn = __builtin_amdgcn_readfirstlane(pn); u.flags = 0; u.aux = 0;
        u.aoff = abase + (unsigned)u.pm * 256u * (unsigned)lda * 2u; u.boff = bbase + (unsigned)u.pn * 256u * (unsigned)ldb * 2u; return true;
    }
    __device__ __forceinline__ void aoffs(const g8::Unit&, int R0, int C0, int R1, int C1, unsigned (&v)[2][2]) const {
        v[0][0] = (unsigned)(R0 * lda + C0) * 2u; v[0][1] = (unsigned)(R1 * lda + C1) * 2u;
        v[1][0] = (unsigned)((128 + R0) * lda + C0) * 2u; v[1][1] = (unsigned)((128 + R1) * lda + C1) * 2u;
    }
};
struct EpiStoreBf16 {
    static constexpr bool PERM = true;
    bf16_t* O; int ldc;
    __device__ __forceinline__ void operator()(g8::Acc& acc, const g8::Unit& u, int wr, int wc, int fr, int fq) const {
        const int row0 = u.pm * 256 + wr * 64 + fr, col0 = u.pn * 256 + wc * 32 + 8 * fq;
#pragma unroll
        for (int ai = 0; ai < 2; ++ai)
#pragma unroll
            for (int m = 0; m < 4; ++m) { bf16_t* rowp = O + (size_t)(row0 + ai * 128 + m * 16) * ldc + col0;
#pragma unroll
                for (int bj = 0; bj < 2; ++bj) { const f32x4 v0 = acc[ai][bj][m][0], v1 = acc[ai][bj][m][1];
                    u32x4 w; w.x = cvt_pk_bf16(v0[0], v0[1]); w.y = cvt_pk_bf16(v0[2], v0[3]); w.z = cvt_pk_bf16(v1[0], v1[1]); w.w = cvt_pk_bf16(v1[2], v1[3]);
                    *(u32x4*)(rowp + bj * 128) = w; } }
    }
};
struct EpiInProj {
    static constexpr bool PERM = true;
    bf16_t* O; const f32x2* rope;
    __device__ __forceinline__ void operator()(g8::Acc& acc, const g8::Unit& u, int wr, int wc, int fr, int fq) const {
        const int pn = u.pn;
        const int row0 = u.pm * 256 + wr * 64 + fr;
        if (pn < 4 || pn >= 12) {
            const int col0 = pn * 256 + wc * 32 + 8 * fq;
#pragma unroll
            for (int ai = 0; ai < 2; ++ai)
#pragma unroll
                for (int m = 0; m < 4; ++m) { bf16_t* rowp = O + (size_t)(row0 + ai * 128 + m * 16) * NPROJ + col0;
#pragma unroll
                    for (int bj = 0; bj < 2; ++bj) { const f32x4 v0 = acc[ai][bj][m][0], v1 = acc[ai][bj][m][1];
                        u32x4 w; w.x = cvt_pk_bf16(v0[0], v0[1]); w.y = cvt_pk_bf16(v0[2], v0[3]); w.z = cvt_pk_bf16(v1[0], v1[1]); w.w = cvt_pk_bf16(v1[2], v1[3]);
                        *(u32x4*)(rowp + bj * 128) = w; } }
            return;
        }
        const bool isq = pn < 8;
        const int head = 2 * ((pn - 4) & 3) + (wc >> 1);
        const int dd0 = 32 * (wc & 1) + 8 * fq;
        const int colbase = (isq ? 1024 : 2048) + head * 128 + dd0;
        const float lg2 = log2f(1.0f - exp2f(-5.0f - (float)head));
#pragma unroll
        for (int ai = 0; ai < 2; ++ai)
#pragma unroll
            for (int m = 0; m < 4; ++m) {
                const int row = row0 + ai * 128 + m * 16, pos = row & 2047, i = wr * 64 + m * 16 + fr;
                const float sc = isq ? exp2f(lg2 * (float)i) : exp2f(-lg2 * (float)i) * 0.08838834764831845f;
                const f32x4* rp = (const f32x4*)(rope + (size_t)pos * 64 + dd0);
                float o1[8], o2[8];
#pragma unroll
                for (int w = 0; w < 4; ++w) { const f32x4 cs = rp[w];
                    const int n = w >> 1, j = (w & 1) * 2;
                    const float a0 = acc[ai][0][m][n][j], a1 = acc[ai][0][m][n][j + 1], b0 = acc[ai][1][m][n][j], b1 = acc[ai][1][m][n][j + 1];
                    o1[2 * w] = (a0 * cs[0] - b0 * cs[1]) * sc; o1[2 * w + 1] = (a1 * cs[2] - b1 * cs[3]) * sc;
                    o2[2 * w] = (b0 * cs[0] + a0 * cs[1]) * sc; o2[2 * w + 1] = (b1 * cs[2] + a1 * cs[3]) * sc; }
                bf16_t* rowp = O + (size_t)row * NPROJ + colbase;
                u32x4 w1, w2; w1.x = cvt_pk_bf16(o1[0], o1[1]); w1.y = cvt_pk_bf16(o1[2], o1[3]); w1.z = cvt_pk_bf16(o1[4], o1[5]); w1.w = cvt_pk_bf16(o1[6], o1[7]);
                w2.x = cvt_pk_bf16(o2[0], o2[1]); w2.y = cvt_pk_bf16(o2[2], o2[3]); w2.z = cvt_pk_bf16(o2[4], o2[5]); w2.w = cvt_pk_bf16(o2[6], o2[7]);
                *(u32x4*)rowp = w1; *(u32x4*)(rowp + 64) = w2;
            }
    }
};
struct EpiGlu {
    static constexpr bool PERM = true;
    const bf16_t* Z; bf16_t* CAT; float* rowss;
    __device__ __forceinline__ void operator()(g8::Acc& acc, const g8::Unit& u, int wr, int wc, int fr, int fq) const {
        const int row0 = u.pm * 256 + wr * 64 + fr, col0 = u.pn * 256 + wc * 32 + 8 * fq;
#pragma unroll
        for (int ai = 0; ai < 2; ++ai)
#pragma unroll
            for (int m = 0; m < 4; ++m) { const int row = row0 + ai * 128 + m * 16; float ss = 0.f;
#pragma unroll
                for (int bj = 0; bj < 2; ++bj) { const f32x4 v0 = acc[ai][bj][m][0], v1 = acc[ai][bj][m][1];
                    const u32x4 zz = *(const u32x4*)(Z + (size_t)row * 1024 + col0 + bj * 128);
                    float o[8];
                    o[0] = bf_lo(zz.x) * sigmoidf_(v0[0]); o[1] = bf_hi(zz.x) * sigmoidf_(v0[1]); o[2] = bf_lo(zz.y) * sigmoidf_(v0[2]); o[3] = bf_hi(zz.y) * sigmoidf_(v0[3]);
                    o[4] = bf_lo(zz.z) * sigmoidf_(v1[0]); o[5] = bf_hi(zz.z) * sigmoidf_(v1[1]); o[6] = bf_lo(zz.w) * sigmoidf_(v1[2]); o[7] = bf_hi(zz.w) * sigmoidf_(v1[3]);
#pragma unroll
                    for (int j = 0; j < 8; ++j) ss += o[j] * o[j];
                    u32x4 w; w.x = cvt_pk_bf16(o[0], o[1]); w.y = cvt_pk_bf16(o[2], o[3]); w.z = cvt_pk_bf16(o[4], o[5]); w.w = cvt_pk_bf16(o[6], o[7]);
                    *(u32x4*)(CAT + (size_t)row * DM + col0 + bj * 128) = w; }
                ss += __shfl_xor(ss, 16); ss += __shfl_xor(ss, 32);
                if (fq == 0) rowss[(size_t)row * 16 + u.pn * 4 + wc] = ss; }
    }
};
struct OutSched : g8::StaticOrder {
    unsigned abase, bbase;
    __device__ __forceinline__ bool next(int i, g8::Unit& u) const {
        int pm, pn; if (!tile(i >> 1, pm, pn)) return false;
        const int half = i & 1;
        u.pm = __builtin_amdgcn_readfirstlane(pm); u.pn = __builtin_amdgcn_readfirstlane(pn); u.flags = half ? 0 : 1; u.aux = half;
        u.aoff = abase + (unsigned)u.pm * 256u * 4096u + (unsigned)half * 2048u; u.boff = bbase + (unsigned)u.pn * 256u * 4096u + (unsigned)half * 2048u; return true;
    }
    __device__ __forceinline__ void aoffs(const g8::Unit&, int R0, int C0, int R1, int C1, unsigned (&v)[2][2]) const {
        v[0][0] = (unsigned)(R0 * 2048 + C0) * 2u; v[0][1] = (unsigned)(R1 * 2048 + C1) * 2u;
        v[1][0] = (unsigned)((128 + R0) * 2048 + C0) * 2u; v[1][1] = (unsigned)((128 + R1) * 2048 + C1) * 2u;
    }
};
struct EpiOut {
    static constexpr bool PERM = true;
    const float* x; const float* mod; const float* rowss1; float* rowss2; bf16_t* X1;
    __device__ __forceinline__ void operator()(g8::Acc& acc, const g8::Unit& u, int wr, int wc, int fr, int fq) const {
        const int row0 = u.pm * 256 + wr * 64 + fr;
        if (u.aux == 0) {
#pragma unroll
            for (int ai = 0; ai < 2; ++ai)
#pragma unroll
                for (int m = 0; m < 4; ++m) { const f32x4* pp = (const f32x4*)(rowss1 + (size_t)(row0 + ai * 128 + m * 16) * 16);
                    const f32x4 p0 = pp[0], p1 = pp[1], p2 = pp[2], p3 = pp[3];
                    const float tot = (((p0[0] + p0[1]) + (p0[2] + p0[3])) + ((p1[0] + p1[1]) + (p1[2] + p1[3]))) + (((p2[0] + p2[1]) + (p2[2] + p2[3])) + ((p3[0] + p3[1]) + (p3[2] + p3[3])));
                    const float r = rsqrtf(tot * (1.0f / 1024.0f) + 1e-6f);
#pragma unroll
                    for (int bj = 0; bj < 2; ++bj)
#pragma unroll
                        for (int n = 0; n < 2; ++n) acc[ai][bj][m][n] *= r; }
            return;
        }
        const int col0 = u.pn * 256 + wc * 32 + 8 * fq;
        const int b = (u.pm * 256) >> 11;
        f32x4 gt[2][2];
#pragma unroll
        for (int bj = 0; bj < 2; ++bj)
#pragma unroll
            for (int n = 0; n < 2; ++n) gt[bj][n] = *(const f32x4*)(mod + (size_t)b * NMOD + 2 * DM + col0 + bj * 128 + n * 4);
#pragma unroll
        for (int ai = 0; ai < 2; ++ai)
#pragma unroll
            for (int m = 0; m < 4; ++m) { const int row = row0 + ai * 128 + m * 16; float ss = 0.f;
#pragma unroll
                for (int bj = 0; bj < 2; ++bj) { const size_t off = (size_t)row * DM + col0 + bj * 128;
                    const f32x4 xa = *(const f32x4*)(x + off), xb = *(const f32x4*)(x + off + 4);
                    const f32x4 o0 = xa + gt[bj][0] * acc[ai][bj][m][0], o1 = xb + gt[bj][1] * acc[ai][bj][m][1];
                    ss += (o0[0] * o0[0] + o0[1] * o0[1]) + (o0[2] * o0[2] + o0[3] * o0[3]) + (o1[0] * o1[0] + o1[1] * o1[1]) + (o1[2] * o1[2] + o1[3] * o1[3]);
                    u32x4 w; w.x = cvt_pk_bf16(o0[0], o0[1]); w.y = cvt_pk_bf16(o0[2], o0[3]); w.z = cvt_pk_bf16(o1[0], o1[1]); w.w = cvt_pk_bf16(o1[2], o1[3]);
                    *(u32x4*)(X1 + off) = w; }
                ss += __shfl_xor(ss, 16); ss += __shfl_xor(ss, 32);
                if (fq == 0) rowss2[(size_t)row * 32 + u.pn * 4 + wc] = ss; }
    }
};
struct MoeSched {
    const LAS int* tpre; const LAS int* cnt; int G, c; const int* list; unsigned abase, bbase; int mode;
    __device__ __forceinline__ bool next(int i, g8::Unit& u) const {
        const int L = i * G + c; const int total = tpre[32] * 8; if (L >= total) return false;
        const int pn = L & 7, ti = L >> 3; int e = 0;
#pragma unroll 1
        for (int s = 16; s > 0; s >>= 1) if (tpre[e + s] <= ti) e += s;
        e = __builtin_amdgcn_readfirstlane(e);
        u.pm = __builtin_amdgcn_readfirstlane(ti); u.pn = pn; u.flags = 0; u.aux = e;
        if (mode == 0) { u.aoff = abase; u.boff = bbase + (unsigned)e * (2048u * 2048u * 2u) + (unsigned)pn * (256u * 2048u * 2u); }
        else { u.aoff = abase + (unsigned)ti * (256u * 1024u * 2u); u.boff = bbase + (unsigned)e * (2048u * 1024u * 2u) + (unsigned)pn * (256u * 1024u * 2u); }
        return true;
    }
    __device__ __forceinline__ void aoffs(const g8::Unit& u, int R0, int C0, int R1, int C1, unsigned (&v)[2][2]) const {
        if (mode == 0) {
            const int e = u.aux, r0 = (u.pm - tpre[e]) * 256, n = cnt[e]; const int* le = list + e * 16384;
            const int i00 = r0 + R0, i01 = r0 + R1, i10 = r0 + 128 + R0, i11 = r0 + 128 + R1;
            const int t00 = (i00 < n) ? (le[i00] >> 1) : 0, t01 = (i01 < n) ? (le[i01] >> 1) : 0, t10 = (i10 < n) ? (le[i10] >> 1) : 0, t11 = (i11 < n) ? (le[i11] >> 1) : 0;
            v[0][0] = (unsigned)(t00 * 2048 + C0) * 2u; v[0][1] = (unsigned)(t01 * 2048 + C1) * 2u; v[1][0] = (unsigned)(t10 * 2048 + C0) * 2u; v[1][1] = (unsigned)(t11 * 2048 + C1) * 2u;
        } else {
            v[0][0] = (unsigned)(R0 * 1024 + C0) * 2u; v[0][1] = (unsigned)(R1 * 1024 + C1) * 2u;
            v[1][0] = (unsigned)((128 + R0) * 1024 + C0) * 2u; v[1][1] = (unsigned)((128 + R1) * 1024 + C1) * 2u;
        }
    }
};
struct EpiMoe1 {
    static constexpr bool PERM = true;
    bf16_t* HM;
    __device__ __forceinline__ void operator()(g8::Acc& acc, const g8::Unit& u, int wr, int wc, int fr, int fq) const {
        const int row0 = u.pm * 256 + wr * 64 + fr, col0 = u.pn * 128 + wc * 32 + 8 * fq;
#pragma unroll
        for (int ai = 0; ai < 2; ++ai)
#pragma unroll
            for (int m = 0; m < 4; ++m) { float o[8];
#pragma unroll
                for (int n = 0; n < 2; ++n)
#pragma unroll
                    for (int j = 0; j < 4; ++j) { const float gv = acc[ai][0][m][n][j], uv = acc[ai][1][m][n][j]; o[n * 4 + j] = gv * sigmoidf_(gv) * uv; }
                u32x4 w; w.x = cvt_pk_bf16(o[0], o[1]); w.y = cvt_pk_bf16(o[2], o[3]); w.z = cvt_pk_bf16(o[4], o[5]); w.w = cvt_pk_bf16(o[6], o[7]);
                *(u32x4*)(HM + (size_t)(row0 + ai * 128 + m * 16) * 1024 + col0) = w; }
    }
};
struct EpiMoe2 {
    static constexpr bool PERM = true;
    const LAS int* tpre; const LAS int* cnt; const int* list; const float* wgt; bf16_t* Y2;
    __device__ __forceinline__ void operator()(g8::Acc& acc, const g8::Unit& u, int wr, int wc, int fr, int fq) const {
        const int e = u.aux, r0 = (u.pm - tpre[e]) * 256, n = cnt[e]; const int* le = list + e * 16384;
        const int col0 = u.pn * 256 + wc * 32 + 8 * fq;
#pragma unroll
        for (int ai = 0; ai < 2; ++ai)
#pragma unroll
            for (int m = 0; m < 4; ++m) { const int r = r0 + ai * 128 + wr * 64 + m * 16 + fr;
                if (r < n) { const int asg = le[r]; const float w8 = wgt[asg]; bf16_t* rowp = Y2 + (size_t)asg * DM + col0;
#pragma unroll
                    for (int bj = 0; bj < 2; ++bj) { const f32x4 v0 = acc[ai][bj][m][0] * w8, v1 = acc[ai][bj][m][1] * w8;
                        u32x4 w; w.x = cvt_pk_bf16(v0[0], v0[1]); w.y = cvt_pk_bf16(v0[2], v0[3]); w.z = cvt_pk_bf16(v1[0], v1[1]); w.w = cvt_pk_bf16(v1[2], v1[3]);
                        *(u32x4*)(rowp + bj * 128) = w; } } }
    }
};

constexpr size_t WS_KV = WS_H;
__device__ __forceinline__ void ssm_item(const Params& P, LAS unsigned char* lds, int tid, int item) {
    const int g = item >> 2, bp = item & 3;
    const int wave = __builtin_amdgcn_readfirstlane(tid >> 6), lane = tid & 63, fr = lane & 15, fq = lane >> 4;
    const bf16_t* proj = (const bf16_t*)(P.ws + WS_PROJ);
    const bf16_t* Ms = (const bf16_t*)(P.ws + WS_SSMM) + (size_t)g * 131072;
    const bf16_t* TM = Ms + 32768;
    bf16_t* Zo = (bf16_t*)(P.ws + WS_Z);
    constexpr int ZS = 136, MS = 264, TS = 392;
    LAS bf16_t* ZB = (LAS bf16_t*)lds;
    LAS bf16_t* WB = (LAS bf16_t*)(lds + 256 * ZS * 2);
    const int b = 2 * bp + (wave >> 2);
    int tok0[2];
    bf16x8 Uf[2][8];
#pragma unroll
    for (int mt = 0; mt < 2; ++mt) {
        const int c = 32 * (wave & 3) + 16 * mt + fr; tok0[mt] = b * 2048 + c * 16;
#pragma unroll
        for (int ks = 0; ks < 8; ++ks) Uf[mt][ks] = *(const bf16x8*)(proj + (size_t)(tok0[mt] + 2 * ks + (fq >> 1)) * NPROJ + g * 16 + 8 * (fq & 1));
    }
#pragma unroll
    for (int i = 0; i < 8; ++i) { const int c = tid + 512 * i, row = c >> 5, kc = c & 31; *(LAS u32x4*)(WB + row * MS + kc * 8) = *(const u32x4*)(Ms + row * 256 + kc * 8); }
    __syncthreads();
#pragma unroll
    for (int nt = 0; nt < 8; ++nt) {
        f32x4 a0 = {0.f, 0.f, 0.f, 0.f}, a1 = {0.f, 0.f, 0.f, 0.f};
#pragma unroll
        for (int ks = 0; ks < 8; ++ks) {
            const bf16x8 bf = *(const LAS bf16x8*)(WB + (16 * nt + fr) * MS + 32 * ks + 8 * fq);
            a0 = __builtin_amdgcn_mfma_f32_16x16x32_bf16(bf, Uf[0][ks], a0, 0, 0, 0);
            a1 = __builtin_amdgcn_mfma_f32_16x16x32_bf16(bf, Uf[1][ks], a1, 0, 0, 0);
        }
        *(LAS u32x2*)(ZB + (32 * wave + fr) * ZS + 16 * nt + 4 * fq) = (u32x2){cvt_pk_bf16(a0[0], a0[1]), cvt_pk_bf16(a0[2], a0[3])};
        *(LAS u32x2*)(ZB + (32 * wave + 16 + fr) * ZS + 16 * nt + 4 * fq) = (u32x2){cvt_pk_bf16(a1[0], a1[1]), cvt_pk_bf16(a1[2], a1[3])};
    }
    u32x4 tmr[6];
#pragma unroll
    for (int i = 0; i < 6; ++i) { const int c = tid + 512 * i, row = c / 48, kc = c % 48; tmr[i] = *(const u32x4*)(TM + (size_t)row * 384 + kc * 8); }
    __syncthreads();
    if (tid < 128) {
        const int bl = tid >> 6, p = tid & 63;
        const f32x2 al = ((const f32x2*)(P.ws + WS_SSMA))[g * 64 + p];
        float xr = 0.f, xi = 0.f;
        LAS unsigned* zw = (LAS unsigned*)ZB + (bl * 128) * (ZS / 2) + p;
        for (int c0 = 0; c0 < 128; c0 += 8) {
            unsigned zv[8];
#pragma unroll
            for (int k = 0; k < 8; ++k) zv[k] = zw[(c0 + k) * (ZS / 2)];
#pragma unroll
            for (int k = 0; k < 8; ++k) {
                zw[(c0 + k) * (ZS / 2)] = cvt_pk_bf16(xr, xi);
                const float t = al.x * xr - al.y * xi + bf_lo(zv[k]); xi = al.x * xi + al.y * xr + bf_hi(zv[k]); xr = t;
            }
        }
    }
#pragma unroll
    for (int i = 0; i < 6; ++i) { const int c = tid + 512 * i, row = c / 48, kc = c % 48; *(LAS u32x4*)(WB + row * TS + kc * 8) = tmr[i]; }
    __syncthreads();
    bf16x8 Xf[2][4];
#pragma unroll
    for (int mt = 0; mt < 2; ++mt)
#pragma unroll
        for (int k2 = 0; k2 < 4; ++k2) Xf[mt][k2] = *(const LAS bf16x8*)(ZB + (32 * wave + 16 * mt + fr) * ZS + 32 * k2 + 8 * fq);
    const f32x4 dv = *(const f32x4*)(P.in[12] + g * 16 + 4 * fq);
#pragma unroll
    for (int cq = 0; cq < 4; ++cq) {
        if (cq < 3) {
#pragma unroll
            for (int i = 0; i < 6; ++i) { const int c = tid + 512 * i, row = c / 48, kc = c % 48; tmr[i] = *(const u32x4*)(TM + (size_t)(64 * (cq + 1) + row) * 384 + kc * 8); }
        }
#pragma unroll
        for (int ntl = 0; ntl < 4; ++ntl) {
            const int nt = 4 * cq + ntl;
            f32x4 a0 = {0.f, 0.f, 0.f, 0.f}, a1 = {0.f, 0.f, 0.f, 0.f};
            const LAS bf16_t* brow = WB + (16 * ntl + fr) * TS + 8 * fq;
#pragma unroll
            for (int ks = 0; ks < 8; ++ks) {
                if (2 * ks <= nt) {
                    const bf16x8 bf = *(const LAS bf16x8*)(brow + 32 * ks);
                    a0 = __builtin_amdgcn_mfma_f32_16x16x32_bf16(bf, Uf[0][ks], a0, 0, 0, 0);
                    a1 = __builtin_amdgcn_mfma_f32_16x16x32_bf16(bf, Uf[1][ks], a1, 0, 0, 0);
                }
            }
#pragma unroll
            for (int k2 = 0; k2 < 4; ++k2) {
                const bf16x8 bf = *(const LAS bf16x8*)(brow + 256 + 32 * k2);
                a0 = __builtin_amdgcn_mfma_f32_16x16x32_bf16(bf, Xf[0][k2], a0, 0, 0, 0);
                a1 = __builtin_amdgcn_mfma_f32_16x16x32_bf16(bf, Xf[1][k2], a1, 0, 0, 0);
            }
#pragma unroll
            for (int mt = 0; mt < 2; ++mt) {
                const f32x4 a = mt ? a1 : a0;
                const size_t tok = (size_t)(tok0[mt] + nt);
                const u32x2 uu = *(const u32x2*)(proj + tok * NPROJ + g * 16 + 4 * fq);
                const float y0 = a[0] + dv[0] * bf_lo(uu.x), y1 = a[1] + dv[1] * bf_hi(uu.x), y2 = a[2] + dv[2] * bf_lo(uu.y), y3 = a[3] + dv[3] * bf_hi(uu.y);
                u32x2 w; w.x = cvt_pk_bf16(gelu_tanh(y0), gelu_tanh(y1)); w.y = cvt_pk_bf16(gelu_tanh(y2), gelu_tanh(y3));
                *(u32x2*)(Zo + tok * 1024 + g * 16 + 4 * fq) = w;
            }
        }
        __syncthreads();
        if (cq < 3) {
#pragma unroll
            for (int i = 0; i < 6; ++i) { const int c = tid + 512 * i, row = c / 48, kc = c % 48; *(LAS u32x4*)(WB + row * TS + kc * 8) = tmr[i]; }
            __syncthreads();
        }
    }
}

__device__ __forceinline__ bf16x8 tr_frag(const LAS bf16_t* tile, int row0, int col0, int fr, int fq) {
    const LAS bf16_t* p = tile + (row0 + 8 * fq + (fr >> 2)) * 136 + col0 + 4 * (fr & 3);
    const bf16x4 a = __builtin_amdgcn_ds_read_tr16_b64_v4i16((LAS bf16x4*)p);
    const bf16x4 b = __builtin_amdgcn_ds_read_tr16_b64_v4i16((LAS bf16x4*)(p + 4 * 136));
    bf16x8 r; r[0] = a[0]; r[1] = a[1]; r[2] = a[2]; r[3] = a[3]; r[4] = b[0]; r[5] = b[1]; r[6] = b[2]; r[7] = b[3]; return r;
}
__device__ __forceinline__ void ret_kv_items(const Params& P, LAS unsigned char* lds, int tid, int first, int stride) {
    const int wave = __builtin_amdgcn_readfirstlane(tid >> 6), lane = tid & 63, fr = lane & 15, fq = lane >> 4;
    constexpr int RS = 136;
    LAS bf16_t* Ks = (LAS bf16_t*)lds; LAS bf16_t* Vs = Ks + 128 * RS;
    const bf16_t* proj = (const bf16_t*)(P.ws + WS_PROJ);
    bf16_t* KV = (bf16_t*)(P.ws + WS_KV);
    const int si = tid >> 2, part = tid & 3, i0 = 16 * wave;
    u32x4 kr[4], vr[4];
    int item = first;
    if (item >= 768) return;
    { const int bh = item / 12, n = item % 12; const bf16_t* pr = proj + ((size_t)(bh >> 3) * 2048 + n * 128 + si) * NPROJ + (bh & 7) * 128 + 32 * part;
#pragma unroll
      for (int j = 0; j < 4; ++j) { kr[j] = *(const u32x4*)(pr + 2048 + 8 * j); vr[j] = *(const u32x4*)(pr + 3072 + 8 * j); } }
    for (;;) {
#pragma unroll
        for (int j = 0; j < 4; ++j) { *(LAS u32x4*)(Ks + si * RS + 32 * part + 8 * j) = kr[j]; *(LAS u32x4*)(Vs + si * RS + 32 * part + 8 * j) = vr[j]; }
        __syncthreads();
        const int nxt = item + stride; const bool more = nxt < 768;
        if (more) { const int bh = nxt / 12, n = nxt % 12; const bf16_t* pr = proj + ((size_t)(bh >> 3) * 2048 + n * 128 + si) * NPROJ + (bh & 7) * 128 + 32 * part;
#pragma unroll
            for (int j = 0; j < 4; ++j) { kr[j] = *(const u32x4*)(pr + 2048 + 8 * j); vr[j] = *(const u32x4*)(pr + 3072 + 8 * j); } }
        bf16x8 Vt[4];
#pragma unroll
        for (int ks = 0; ks < 4; ++ks) Vt[ks] = tr_frag(Vs, 32 * ks, i0, fr, fq);
        const int bh = item / 12, n = item % 12;
        bf16_t* op = KV + ((size_t)(bh * 16 + n) * 128 + i0 + fr) * 128 + 4 * fq;
#pragma unroll
        for (int nt = 0; nt < 8; ++nt) {
            f32x4 a = {0.f, 0.f, 0.f, 0.f};
#pragma unroll
            for (int ks = 0; ks < 4; ++ks) { const bf16x8 kf = tr_frag(Ks, 32 * ks, 16 * nt, fr, fq); a = __builtin_amdgcn_mfma_f32_16x16x32_bf16(kf, Vt[ks], a, 0, 0, 0); }
            *(u32x2*)(op + 16 * nt) = (u32x2){cvt_pk_bf16(a[0], a[1]), cvt_pk_bf16(a[2], a[3])};
        }
        __syncthreads();
        if (!more) break;
        item = nxt;
    }
}
__device__ __forceinline__ void ret_out_item(const Params& P, LAS unsigned char* lds, int tid, int item) {
    const int bh = item >> 2, q = item & 3, b = bh >> 3, h = bh & 7;
    const int wave = __builtin_amdgcn_readfirstlane(tid >> 6), lane = tid & 63, fr = lane & 15, fq = lane >> 4;
    constexpr int RS = 136;
    LAS bf16_t* Qs = (LAS bf16_t*)lds;
    LAS bf16_t* Ks = Qs + 128 * RS;
    LAS bf16_t* Vs = Ks + 128 * RS;
    LAS bf16_t* Rs = Vs + 128 * RS;
    const bf16_t* proj = (const bf16_t*)(P.ws + WS_PROJ);
    const bf16_t* KV = (const bf16_t*)(P.ws + WS_KV);
    bf16_t* CAT = (bf16_t*)(P.ws + WS_CAT);
    const float gam = 1.0f - exp2f(-5.0f - (float)h);
    const float lg2 = log2f(gam);
    const float gC1 = exp2f(lg2 * 127.0f), gC = exp2f(lg2 * 128.0f);
    const int si = tid >> 2, part = tid & 3, i0 = 16 * wave;
    u32x4 st[12];
    { const bf16_t* pr = proj + ((size_t)b * 2048 + (4 * q) * 128 + si) * NPROJ + h * 128 + 32 * part;
#pragma unroll
      for (int j = 0; j < 4; ++j) { st[j] = *(const u32x4*)(pr + 1024 + 8 * j); st[4 + j] = *(const u32x4*)(pr + 2048 + 8 * j); st[8 + j] = *(const u32x4*)(pr + 3072 + 8 * j); } }
    f32x4 accR[8];
#pragma unroll
    for (int nt = 0; nt < 8; ++nt) accR[nt] = (f32x4){0.f, 0.f, 0.f, 0.f};
    for (int m = 0; m < 4 * q; ++m) {
        const bf16_t* tp = KV + ((size_t)(bh * 16 + m) * 128 + i0 + fr) * 128 + 4 * fq;
        u32x2 t[8];
#pragma unroll
        for (int nt = 0; nt < 8; ++nt) t[nt] = *(const u32x2*)(tp + 16 * nt);
#pragma unroll
        for (int nt = 0; nt < 8; ++nt) { const f32x4 kv = {bf_lo(t[nt].x), bf_hi(t[nt].x), bf_lo(t[nt].y), bf_hi(t[nt].y)}; accR[nt] = accR[nt] * gC + kv * gC1; }
    }
#pragma unroll
    for (int nt = 0; nt < 8; ++nt)
        *(LAS u32x2*)(Rs + (i0 + fr) * RS + 16 * nt + 4 * fq) = (u32x2){cvt_pk_bf16(accR[nt][0], accR[nt][1]), cvt_pk_bf16(accR[nt][2], accR[nt][3])};
    for (int nn = 0; nn < 4; ++nn) {
        const int n = 4 * q + nn;
#pragma unroll
        for (int j = 0; j < 4; ++j) { *(LAS u32x4*)(Qs + si * RS + 32 * part + 8 * j) = st[j]; *(LAS u32x4*)(Ks + si * RS + 32 * part + 8 * j) = st[4 + j]; *(LAS u32x4*)(Vs + si * RS + 32 * part + 8 * j) = st[8 + j]; }
        __syncthreads();
        if (nn < 3) { const bf16_t* pr = proj + ((size_t)b * 2048 + (n + 1) * 128 + si) * NPROJ + h * 128 + 32 * part;
#pragma unroll
            for (int j = 0; j < 4; ++j) { st[j] = *(const u32x4*)(pr + 1024 + 8 * j); st[4 + j] = *(const u32x4*)(pr + 2048 + 8 * j); st[8 + j] = *(const u32x4*)(pr + 3072 + 8 * j); } }
        const size_t tok = (size_t)b * 2048 + n * 128 + i0 + fr;
        u32x2 gg[8];
        { const bf16_t* gp = proj + tok * NPROJ + 4096 + h * 128 + 4 * fq;
#pragma unroll
          for (int nt = 0; nt < 8; ++nt) gg[nt] = *(const u32x2*)(gp + 16 * nt); }
        bf16x8 Qf[4];
#pragma unroll
        for (int ks = 0; ks < 4; ++ks) Qf[ks] = *(const LAS bf16x8*)(Qs + (i0 + fr) * RS + 32 * ks + 8 * fq);
        f32x4 accS[8], accO[8];
#pragma unroll
        for (int nt = 0; nt < 8; ++nt) { accS[nt] = (f32x4){0.f, 0.f, 0.f, 0.f}; accO[nt] = (f32x4){0.f, 0.f, 0.f, 0.f}; }
#pragma unroll
        for (int nt = 0; nt < 8; ++nt) {
            if (nt <= wave) {
#pragma unroll
                for (int ks = 0; ks < 4; ++ks) { const bf16x8 kf = *(const LAS bf16x8*)(Ks + (16 * nt + fr) * RS + 32 * ks + 8 * fq); accS[nt] = __builtin_amdgcn_mfma_f32_16x16x32_bf16(kf, Qf[ks], accS[nt], 0, 0, 0); }
            }
        }
        if (n > 0) {
#pragma unroll
            for (int nt = 0; nt < 8; ++nt) {
#pragma unroll
                for (int ks = 0; ks < 4; ++ks) { const bf16x8 rf = *(const LAS bf16x8*)(Rs + (16 * nt + fr) * RS + 32 * ks + 8 * fq); accO[nt] = __builtin_amdgcn_mfma_f32_16x16x32_bf16(rf, Qf[ks], accO[nt], 0, 0, 0); }
                accO[nt] *= gam;
            }
        }
#pragma unroll
        for (int nt = 0; nt < 8; ++nt) {
            const int i = i0 + fr, j0 = 16 * nt + 4 * fq;
            const float p0 = (j0 <= i) ? accS[nt][0] : 0.f, p1 = (j0 + 1 <= i) ? accS[nt][1] : 0.f, p2 = (j0 + 2 <= i) ? accS[nt][2] : 0.f, p3 = (j0 + 3 <= i) ? accS[nt][3] : 0.f;
            *(LAS u32x2*)(Qs + i * RS + j0) = (u32x2){cvt_pk_bf16(p0, p1), cvt_pk_bf16(p2, p3)};
        }
        asm volatile("" ::: "memory");
        bf16x8 Pf[4];
#pragma unroll
        for (int ks = 0; ks < 4; ++ks) Pf[ks] = *(const LAS bf16x8*)(Qs + (i0 + fr) * RS + 32 * ks + 8 * fq);
#pragma unroll
        for (int ks = 0; ks < 4; ++ks) {
            if (2 * ks <= wave) {
#pragma unroll
                for (int nt = 0; nt < 8; ++nt) { const bf16x8 vf = tr_frag(Vs, 32 * ks, 16 * nt, fr, fq); accO[nt] = __builtin_amdgcn_mfma_f32_16x16x32_bf16(vf, Pf[ks], accO[nt], 0, 0, 0); }
            }
        }
        if (nn < 3) {
            bf16x8 Vt[4];
#pragma unroll
            for (int ks = 0; ks < 4; ++ks) Vt[ks] = tr_frag(Vs, 32 * ks, i0, fr, fq);
#pragma unroll
            for (int nt = 0; nt < 8; ++nt) {
                accR[nt] *= gam;
#pragma unroll
                for (int ks = 0; ks < 4; ++ks) { const bf16x8 kf = tr_frag(Ks, 32 * ks, 16 * nt, fr, fq); accR[nt] = __builtin_amdgcn_mfma_f32_16x16x32_bf16(kf, Vt[ks], accR[nt], 0, 0, 0); }
                accR[nt] *= gC1;
            }
        }
        {
            float s = 0.f;
#pragma unroll
            for (int nt = 0; nt < 8; ++nt) s += (accO[nt][0] + accO[nt][1]) + (accO[nt][2] + accO[nt][3]);
            s += __shfl_xor(s, 16); s += __shfl_xor(s, 32);
            const float mu = s * (1.0f / 128.0f); float qv = 0.f;
#pragma unroll
            for (int nt = 0; nt < 8; ++nt) { const f32x4 d = accO[nt] - mu; qv += (d[0] * d[0] + d[1] * d[1]) + (d[2] * d[2] + d[3] * d[3]); }
            qv += __shfl_xor(qv, 16); qv += __shfl_xor(qv, 32);
            const float rstd = rsqrtf(qv * (1.0f / 128.0f) + 1e-5f);
            bf16_t* op = CAT + tok * DM + 1024 + h * 128 + 4 * fq;
#pragma unroll
            for (int nt = 0; nt < 8; ++nt) {
                const float g0 = bf_lo(gg[nt].x), g1 = bf_hi(gg[nt].x), g2 = bf_lo(gg[nt].y), g3 = bf_hi(gg[nt].y);
                const f32x4 y = (accO[nt] - mu) * rstd;
                u32x2 w; w.x = cvt_pk_bf16(y[0] * g0 * sigmoidf_(g0), y[1] * g1 * sigmoidf_(g1)); w.y = cvt_pk_bf16(y[2] * g2 * sigmoidf_(g2), y[3] * g3 * sigmoidf_(g3));
                *(u32x2*)(op + 16 * nt) = w;
            }
        }
        __syncthreads();
        if (nn < 3) {
#pragma unroll
            for (int nt = 0; nt < 8; ++nt)
                *(LAS u32x2*)(Rs + (i0 + fr) * RS + 16 * nt + 4 * fq) = (u32x2){cvt_pk_bf16(accR[nt][0], accR[nt][1]), cvt_pk_bf16(accR[nt][2], accR[nt][3])};
        }
    }
}

__device__ __forceinline__ void p6_route(const Params& P, LAS unsigned char* lds, int tid, int blk, int G) {
    const int wave = __builtin_amdgcn_readfirstlane(tid >> 6), lane = tid & 63, fr = lane & 15, fq = lane >> 4;
    LAS float* gm = (LAS float*)lds; LAS float* sh = gm + 2048; LAS float* lg = sh + 2048;
    const float* mod = (const float*)(P.ws + WS_MOD);
    const bf16_t* x1 = (const bf16_t*)(P.ws + WS_X1); const float* rowss2 = (const float*)(P.ws + WS_ROWSS2);
    bf16_t* H2 = (bf16_t*)(P.ws + WS_H);
    const bf16_t* WR = (const bf16_t*)(P.ws + WS_WR);
    int* cnt = (int*)(P.ws + WS_CNT); int* list = (int*)(P.ws + WS_LIST); float* wgt = (float*)(P.ws + WS_WGT);
    for (int rb = blk; rb < 256; rb += G) {
        const int b = rb >> 5;
        for (int k = tid; k < 2048; k += NTHREADS) { gm[k] = P.in[18][k] * (1.0f + mod[(size_t)b * NMOD + 4 * DM + k]); sh[k] = mod[(size_t)b * NMOD + 3 * DM + k]; }
        __syncthreads();
        const int mt = wave & 3, kh = wave >> 2;
        const int row = rb * 64 + 16 * mt + fr;
        float tot2 = 0.f;
        { const f32x4* pp = (const f32x4*)(rowss2 + (size_t)row * 32);
#pragma unroll
          for (int i = 0; i < 8; ++i) { const f32x4 v = pp[i]; tot2 += (v[0] + v[1]) + (v[2] + v[3]); } }
        const float r2 = rsqrtf(tot2 * (1.0f / 2048.0f) + 1e-6f);
        f32x4 acc[3];
#pragma unroll
        for (int nt = 0; nt < 3; ++nt) acc[nt] = (f32x4){0.f, 0.f, 0.f, 0.f};
#pragma unroll 4
        for (int ks = 0; ks < 32; ++ks) {
            const int k0 = 1024 * kh + 32 * ks + 8 * fq;
            const u32x4 xw = *(const u32x4*)(x1 + (size_t)row * DM + k0);
            const f32x4 a = {bf_lo(xw.x), bf_hi(xw.x), bf_lo(xw.y), bf_hi(xw.y)}, c = {bf_lo(xw.z), bf_hi(xw.z), bf_lo(xw.w), bf_hi(xw.w)};
            const f32x4 g0 = *(const LAS f32x4*)(gm + k0), g1 = *(const LAS f32x4*)(gm + k0 + 4), s0 = *(const LAS f32x4*)(sh + k0), s1 = *(const LAS f32x4*)(sh + k0 + 4);
            const f32x4 h0 = a * r2 * g0 + s0, h1 = c * r2 * g1 + s1;
            u32x4 w; w.x = cvt_pk_bf16(h0[0], h0[1]); w.y = cvt_pk_bf16(h0[2], h0[3]); w.z = cvt_pk_bf16(h1[0], h1[1]); w.w = cvt_pk_bf16(h1[2], h1[3]);
            *(u32x4*)(H2 + (size_t)row * DM + k0) = w;
            const bf16x8 af = __builtin_bit_cast(bf16x8, w);
#pragma unroll
            for (int nt = 0; nt < 3; ++nt) { const bf16x8 bf = *(const bf16x8*)(WR + (size_t)(16 * nt + fr) * 2048 + k0); acc[nt] = __builtin_amdgcn_mfma_f32_16x16x32_bf16(bf, af, acc[nt], 0, 0, 0); }
        }
#pragma unroll
        for (int nt = 0; nt < 3; ++nt) *(LAS f32x4*)(lg + (kh * 64 + 16 * mt + fr) * 48 + 16 * nt + 4 * fq) = acc[nt];
        __syncthreads();
        if (tid < 64) {
            const int tok = rb * 64 + tid;
            float l[36];
#pragma unroll
            for (int nn = 0; nn < 36; ++nn) l[nn] = lg[tid * 48 + nn] + lg[(64 + tid) * 48 + nn];
            float gl[4]; int gs = 0;
#pragma unroll
            for (int j = 0; j < 4; ++j) gl[j] = l[j] + P.in[20][j];
#pragma unroll
            for (int j = 1; j < 4; ++j) if (gl[j] > gl[gs]) gs = j;
            float gmax = gl[0];
#pragma unroll
            for (int j = 1; j < 4; ++j) gmax = fmaxf(gmax, gl[j]);
            float den = 0.f;
#pragma unroll
            for (int j = 0; j < 4; ++j) den += expf(gl[j] - gmax);
            const float gw = 1.0f / den;
            float el[8];
#pragma unroll
            for (int j = 0; j < 8; ++j) { float v = 0.f;
#pragma unroll
                for (int q = 0; q < 4; ++q) v = (gs == q) ? (l[4 + q * 8 + j] + P.in[22][q * 8 + j]) : v;
                el[j] = v; }
            int j1 = 0;
#pragma unroll
            for (int j = 1; j < 8; ++j) if (el[j] > el[j1]) j1 = j;
            int j2 = (j1 == 0) ? 1 : 0;
#pragma unroll
            for (int j = 0; j < 8; ++j) if (j != j1 && j != j2 && el[j] > el[j2]) j2 = j;
            float e1 = el[0], e2 = el[0];
#pragma unroll
            for (int j = 0; j < 8; ++j) { e1 = (j == j1) ? el[j] : e1; e2 = (j == j2) ? el[j] : e2; }
            const float t2 = expf(e2 - e1), w1 = gw / (1.0f + t2), w2 = gw * t2 / (1.0f + t2);
            const int ea = gs * 8 + j1, eb = gs * 8 + j2;
            const int pa = atomicAdd(cnt + ea, 1); list[ea * 16384 + pa] = tok * 2; wgt[tok * 2] = w1;
            const int pb = atomicAdd(cnt + eb, 1); list[eb * 16384 + pb] = tok * 2 + 1; wgt[tok * 2 + 1] = w2;
        }
        __syncthreads();
    }
}

__device__ __forceinline__ void p9_final(const Params& P, int tid, int blk, int G) {
    const int wave = tid >> 6, lane = tid & 63;
    const float* mod = (const float*)(P.ws + WS_MOD); const bf16_t* Y2 = (const bf16_t*)(P.ws + WS_Y2);
    for (int row = blk * 8 + wave; row < NTOK; row += G * 8) {
        const int b = row >> 11;
        float* xr = P.out + (size_t)row * DM;
        const bf16_t* x1r = (const bf16_t*)(P.ws + WS_X1) + (size_t)row * DM;
        f32x4 v[8]; float ss = 0.f;
#pragma unroll
        for (int i = 0; i < 8; ++i) {
            const int k = (i * 64 + lane) * 4;
            const u32x2 xw = *(const u32x2*)(x1r + k);
            const f32x4 xv = {bf_lo(xw.x), bf_hi(xw.x), bf_lo(xw.y), bf_hi(xw.y)};
            const u32x2 ya = *(const u32x2*)(Y2 + (size_t)(2 * row) * DM + k), yb = *(const u32x2*)(Y2 + (size_t)(2 * row + 1) * DM + k);
            const f32x4 gt = *(const f32x4*)(mod + (size_t)b * NMOD + 5 * DM + k);
            f32x4 y; y[0] = bf_lo(ya.x) + bf_lo(yb.x); y[1] = bf_hi(ya.x) + bf_hi(yb.x); y[2] = bf_lo(ya.y) + bf_lo(yb.y); y[3] = bf_hi(ya.y) + bf_hi(yb.y);
            v[i] = xv + gt * y;
            ss += v[i][0] * v[i][0] + v[i][1] * v[i][1] + v[i][2] * v[i][2] + v[i][3] * v[i][3];
        }
        ss = wave_sum(ss);
        const float r = rsqrtf(ss * (1.0f / 2048.0f) + 1e-6f);
#pragma unroll
        for (int i = 0; i < 8; ++i) { const int k = (i * 64 + lane) * 4; const f32x4 gf = *(const f32x4*)(P.in[26] + k); *(f32x4*)(xr + k) = v[i] * r * gf; }
    }
}

__global__ void __launch_bounds__(NTHREADS, 2) hymba_fwd(Params P) {
    extern __shared__ __attribute__((aligned(16))) unsigned char lds_raw[];
    LAS unsigned char* lds = (LAS unsigned char*)lds_raw;
    const int tid = threadIdx.x, blk = blockIdx.x, G = gridDim.x;
    volatile LAS unsigned* misc = (volatile LAS unsigned*)(lds + LDS_MISC);
    if (tid < 64) misc[tid] = 0u;
    __syncthreads();
    XcdBarrier bar = xcd_barrier_post((unsigned*)(P.ws + WS_BAR), misc);
    const int lo = P.ph_lo, hi = P.ph_hi;
#define IN(k) (lo <= (k) && (k) < hi)
#define SEAM(k) do { if (IN(k) && IN((k) + 1)) xcd_barrier(bar); } while (0)
    unsigned char* ws = P.ws;

#ifndef REPR
#define REPR 1
#endif
#ifndef REPS
#define REPS 1
#endif
#ifndef REP0
#define REP0 1
#endif
#ifndef REP2
#define REP2 1
#endif
#ifndef REP7
#define REP7 1
#endif
#ifndef REP8
#define REP8 1
#endif
    if (IN(0)) for (int rep0 = 0; rep0 < REP0; ++rep0) {
        for (int it = blk; it < 256; it += G) p0_adaln(P, lds, tid, it);
        for (int it = blk; it < 256; it += G) p0_ssm_mats(P, lds, tid, it);
        p0_misc(P, tid, blk, G);
        p0_convert(P, lds, tid, blk, G);
    }
    SEAM(0);
    if (IN(1)) p1_norm1(P, lds, tid, blk, G);
    SEAM(1);
    if (IN(2)) for (int rep2 = 0; rep2 < REP2; ++rep2) {
        DenseSched S; S.init(NTOK, NPROJ, G, blk); S.abase = (unsigned)WS_H; S.bbase = (unsigned)WS_WIN; S.lda = DM; S.ldb = DM;
        EpiInProj E{(bf16_t*)(ws + WS_PROJ), (const f32x2*)(ws + WS_ROPE)};
        g8::gemm_phase(lds, ws, DM / 64, DM, S, E);
    }
    SEAM(2);
    if (IN(3)) {
        for (int it = blk; it < 256; it += G) ssm_item(P, lds, tid, it);
        ret_kv_items(P, lds, tid, blk, G);
    }
    SEAM(3);
    if (IN(4)) {
        for (int it = blk; it < 256; it += G) ret_out_item(P, lds, tid, it);
        __syncthreads();
        DenseSched S; S.init(NTOK, 1024, G, blk); S.abase = (unsigned)WS_Z; S.bbase = (unsigned)WS_WGLU; S.lda = 1024; S.ldb = 1024;
        EpiGlu E{(const bf16_t*)(ws + WS_Z), (bf16_t*)(ws + WS_CAT), (float*)(ws + WS_ROWSS1)};
        g8::gemm_phase(lds, ws, 1024 / 64, 1024, S, E);
    }
    SEAM(4);
    if (IN(5)) {
        OutSched S; S.init(NTOK, DM, G, blk); S.abase = (unsigned)WS_CAT; S.bbase = (unsigned)WS_WOUT;
        EpiOut E{P.in[0], (const float*)(ws + WS_MOD), (const float*)(ws + WS_ROWSS1), (float*)(ws + WS_ROWSS2), (bf16_t*)(ws + WS_X1)};
        g8::gemm_phase(lds, ws, 1024 / 64, DM, S, E);
    }
    SEAM(5);
    if (IN(6)) p6_route(P, lds, tid, blk, G);
    SEAM(6);
    if (IN(7) || IN(8)) {
        LAS int* tpre = (LAS int*)(lds + LDS_MISC + 256); LAS int* cn = tpre + 64;
        if (tid == 0) { const int* cg = (const int*)(ws + WS_CNT); int s = 0; for (int e = 0; e < 32; ++e) { const int c = cg[e]; cn[e] = c; tpre[e] = s; s += (c + 255) >> 8; } tpre[32] = s; }
        __syncthreads();
        const int vc = (G % 8 == 0) ? blk : blk;
        if (IN(7)) for (int rep7 = 0; rep7 < REP7; ++rep7) {
            MoeSched S{tpre, cn, G, vc, (const int*)(ws + WS_LIST), (unsigned)WS_H, (unsigned)WS_WGU, 0};
            EpiMoe1 E{(bf16_t*)(ws + WS_HM)};
            g8::gemm_phase(lds, ws, DM / 64, DM, S, E);
        }
        SEAM(7);
        if (IN(8)) for (int rep8 = 0; rep8 < REP8; ++rep8) {
            MoeSched S{tpre, cn, G, vc, (const int*)(ws + WS_LIST), (unsigned)WS_HM, (unsigned)WS_WD, 1};
            EpiMoe2 E{tpre, cn, (const int*)(ws + WS_LIST), (const float*)(ws + WS_WGT), (bf16_t*)(ws + WS_Y2)};
            g8::gemm_phase(lds, ws, DEXP / 64, DEXP, S, E);
        }
    }
    SEAM(8);
    if (IN(9)) p9_final(P, tid, blk, G);
#undef IN
#undef SEAM
}

#ifndef N_LAUNCH_SPLIT
#define N_LAUNCH_SPLIT 0
#endif
extern "C" void kernel_launch(void* const* d_in, const int* in_sizes, int n_in, void* d_out, int out_size, void* d_ws, size_t ws_size, hipStream_t stream) {
    static int grid = 0;
    if (grid == 0) {
        if (n_in != 27 || out_size != NTOK * DM || ws_size < WS_END) { fprintf(stderr, "kernel_launch: unexpected shapes (n_in %d out %d ws %zu need %zu)\n", n_in, out_size, ws_size, (size_t)WS_END); grid = -1; return; }
        int dev = 0, cus = 0, per_cu = 0;
        if (hipGetDevice(&dev) != hipSuccess || hipDeviceGetAttribute(&cus, hipDeviceAttributeMultiprocessorCount, dev) != hipSuccess) { grid = -1; return; }
        if (hipFuncSetAttribute((const void*)hymba_fwd, hipFuncAttributeMaxDynamicSharedMemorySize, LDS_BYTES) != hipSuccess) { fprintf(stderr, "kernel_launch: hipFuncSetAttribute failed\n"); grid = -1; return; }
        if (hipOccupancyMaxActiveBlocksPerMultiprocessor(&per_cu, (const void*)hymba_fwd, NTHREADS, LDS_BYTES) != hipSuccess || per_cu < 1) { fprintf(stderr, "kernel_launch: occupancy query says %d\n", per_cu); }
        (void)hipGetLastError();
        grid = cus;
    }
    if (grid < 0) return;
    (void)hipMemsetAsync((char*)d_ws + WS_BAR, 0, 16384, stream);
    Params p{};
    for (int i = 0; i < 27; ++i) p.in[i] = (const float*)d_in[i];
    p.out = (float*)d_out; p.ws = (unsigned char*)d_ws;
#if N_LAUNCH_SPLIT
    for (int ph = 0; ph < 10; ++ph) { p.ph_lo = ph; p.ph_hi = ph + 1; hipLaunchKernelGGL(hymba_fwd, dim3(grid), dim3(NTHREADS), LDS_BYTES, stream, p); }
#else
    p.ph_lo = 0; p.ph_hi = 10;
    hipLaunchKernelGGL(hymba_fwd, dim3(grid), dim3(NTHREADS), LDS_BYTES, stream, p);
#endif
    const hipError_t le = hipPeekAtLastError();
    if (le != hipSuccess) fprintf(stderr, "kernel_launch: launch failed: %s\n", hipGetErrorName(le));
}
```

```cpp
#include <hip/hip_runtime.h>
#include <cstdio>
#include <cstdint>

#define LAS __attribute__((address_space(3)))
typedef unsigned short bf16_t;
typedef short bf16x8 __attribute__((ext_vector_type(8)));
typedef short bf16x4 __attribute__((ext_vector_type(4)));
typedef float f32x4 __attribute__((ext_vector_type(4)));
typedef float f32x2 __attribute__((ext_vector_type(2)));
typedef unsigned u32x4 __attribute__((ext_vector_type(4)));
typedef unsigned u32x2 __attribute__((ext_vector_type(2)));

constexpr int DM = 2048, NB = 8, SEQ = 2048, NTOK = NB * SEQ;
constexpr int NPROJ = 5120;
constexpr int NMOD = 6 * DM;
constexpr int NEXP = 32, DEXP = 1024;
constexpr int NTHREADS = 512;

constexpr size_t WS_BAR   = 0;
constexpr size_t WS_CNT   = 16384;
constexpr size_t WS_ROWSS1= WS_CNT + 8192;
constexpr size_t WS_ROWSS2= WS_ROWSS1 + (size_t)16384 * 16 * 4;
constexpr size_t WS_MODP  = WS_ROWSS2 + (size_t)16384 * 32 * 4;
constexpr size_t WS_MOD   = WS_MODP + (size_t)4 * 8 * NMOD * 4;
constexpr size_t WS_ROPE  = WS_MOD + (size_t)8 * NMOD * 4;
constexpr size_t WS_SSMA  = WS_ROPE + (size_t)2048 * 64 * 8;
constexpr size_t WS_WR    = WS_SSMA + (size_t)64 * 64 * 8;
constexpr size_t WS_SSMM  = WS_WR + (size_t)48 * 2048 * 2;
constexpr size_t WS_WIN   = WS_SSMM + (size_t)64 * 131072 * 2;
constexpr size_t WS_WOUT  = WS_WIN + (size_t)NPROJ * DM * 2;
constexpr size_t WS_WGLU  = WS_WOUT + (size_t)DM * DM * 2;
constexpr size_t WS_WGU   = WS_WGLU + (size_t)1024 * 1024 * 2;
constexpr size_t WS_WD    = WS_WGU + (size_t)NEXP * 2048 * 2048 * 2;
constexpr size_t WS_H     = WS_WD + (size_t)NEXP * 2048 * 1024 * 2;
constexpr size_t WS_PROJ  = WS_H + (size_t)NTOK * DM * 2;
constexpr size_t WS_Z     = WS_PROJ + (size_t)NTOK * NPROJ * 2;
constexpr size_t WS_CAT   = WS_Z + (size_t)NTOK * 1024 * 2;
constexpr size_t WS_WGT   = WS_CAT + (size_t)NTOK * DM * 2;
constexpr size_t WS_LIST  = WS_WGT + (size_t)32768 * 4;
constexpr size_t WS_X1    = WS_LIST + (size_t)32 * 16384 * 4;
constexpr size_t WS_END   = WS_X1 + (size_t)NTOK * DM * 2;
constexpr size_t WS_Y2    = WS_PROJ;
constexpr size_t WS_HM    = WS_Z;

constexpr int LDS_STAGE = 131072;
constexpr int LDS_BYTES = 147456;
constexpr int LDS_MISC  = LDS_BYTES - 2048;

struct Params { const float* in[27]; float* out; unsigned char* ws; int ph_lo, ph_hi; };

#define XB_TMO      128
#define XB_XCNT(j)  (256  + 64 * (j))
#define XB_XSUB(j)  (1280 + 64 * (j))
#define XB_XGEN(j)  (2304 + 64 * (j))
#define XB_TOP      3328
#define XB_TOPGEN   3392
#define XCD_BAR_WORDS 3456
#define XB_SPIN_CAP (1u << 22)

__device__ __forceinline__ unsigned xb_ld(unsigned* p)              { return __hip_atomic_load(p, __ATOMIC_RELAXED, __HIP_MEMORY_SCOPE_AGENT); }
__device__ __forceinline__ unsigned xb_add(unsigned* p, unsigned v) { return __hip_atomic_fetch_add(p, v, __ATOMIC_RELAXED, __HIP_MEMORY_SCOPE_AGENT); }
__device__ __forceinline__ unsigned xb_xcc_id() { return (unsigned)__builtin_amdgcn_s_getreg((3 << 11) | 20) & 0xFu; }
#define XB_SPIN(cond, bar) do { unsigned _sp = 0; while (cond) { __builtin_amdgcn_s_sleep(1); \
    if ((++_sp & 255u) == 0u) { if (xb_ld(&(bar)[XB_TMO])) break; if (_sp > XB_SPIN_CAP) { atomicAdd(&(bar)[XB_TMO], 1u); break; } } } } while (0)

struct XcdBarrier { unsigned* bar; unsigned x; volatile LAS unsigned* st; };

__device__ __forceinline__ XcdBarrier xcd_barrier_post(unsigned* bar, volatile LAS unsigned* st) {
    XcdBarrier b; b.bar = bar; b.x = xb_xcc_id(); b.st = st;
    if (threadIdx.x == 0) (void)xb_add(&bar[XB_XCNT(b.x)], 1u);
    return b;
}
__device__ __forceinline__ void xcd_barrier_complete(unsigned* bar, unsigned x, unsigned& nloc, unsigned& nx) {
    const unsigned G = gridDim.x * gridDim.y * gridDim.z;
    unsigned sum, cnt, mine, sp = 0u;
    for (;;) {
        sum = 0u; cnt = 0u; mine = 0u;
#pragma unroll
        for (unsigned j = 0; j < 16; ++j) { const unsigned c = xb_ld(&bar[XB_XCNT(j)]); sum += c; cnt += (c > 0u) ? 1u : 0u; mine = (j == x) ? c : mine; }
        if (sum == G) break;
        __builtin_amdgcn_s_sleep(1);
        if ((++sp & 255u) == 0u) { if (xb_ld(&bar[XB_TMO])) break; if (sp > XB_SPIN_CAP) { atomicAdd(&bar[XB_TMO], 1u); break; } }
    }
    nloc = mine > 0u ? mine : 1u; nx = cnt > 0u ? cnt : 1u;
}
__device__ __forceinline__ void xcd_barrier(const XcdBarrier& b) {
    asm volatile("s_waitcnt vmcnt(0)" ::: "memory");
    __syncthreads();
    if (threadIdx.x == 0) {
        unsigned* bar = b.bar;
        __builtin_amdgcn_s_waitcnt(0);
        unsigned nloc = b.st[0], nx = b.st[1];
        if (nloc == 0u) { xcd_barrier_complete(bar, b.x, nloc, nx); b.st[0] = nloc; b.st[1] = nx; }
        const unsigned old = xb_add(&bar[XB_XSUB(b.x)], 1u);
        const unsigned gen = old / nloc;
        if (old + 1u == (gen + 1u) * nloc) {
            __builtin_amdgcn_fence(__ATOMIC_RELEASE, "agent");
            asm volatile("s_waitcnt vmcnt(0)" ::: "memory");
            const unsigned og = xb_add(&bar[XB_TOP], 1u);
            const unsigned tg = og / nx;
            if (og + 1u == (tg + 1u) * nx) xb_add(&bar[XB_TOPGEN], 1u);
            else XB_SPIN(xb_ld(&bar[XB_TOPGEN]) == tg, bar);
            __builtin_amdgcn_fence(__ATOMIC_ACQUIRE, "agent");
            xb_add(&bar[XB_XGEN(b.x)], 1u);
            asm volatile("s_waitcnt vmcnt(0)" ::: "memory");
        } else {
            XB_SPIN(xb_ld(&bar[XB_XGEN(b.x)]) == gen, bar);
            __builtin_amdgcn_fence(__ATOMIC_ACQUIRE, "agent");
            asm volatile("s_waitcnt vmcnt(0)" ::: "memory");
        }
    }
    __syncthreads();
}

typedef __bf16 bf16x2_t __attribute__((ext_vector_type(2)));
__device__ __forceinline__ unsigned cvt_pk_bf16(float lo, float hi) { const f32x2 v = {lo, hi}; return __builtin_bit_cast(unsigned, __builtin_convertvector(v, bf16x2_t)); }
__device__ __forceinline__ float bf_lo(unsigned w) { return __uint_as_float(w << 16); }
__device__ __forceinline__ float bf_hi(unsigned w) { return __uint_as_float(w & 0xffff0000u); }
__device__ __forceinline__ float sigmoidf_(float x) { return 1.0f / (1.0f + __expf(-x)); }
__device__ __forceinline__ float gelu_tanh(float x) {
    const float u = 0.7978845608028654f * (x + 0.044715f * x * x * x);
    const float t = 1.0f - 2.0f / (1.0f + __expf(2.0f * u));
    return 0.5f * x * (1.0f + t);
}
__device__ __forceinline__ float wave_sum(float v) {
    v += __shfl_xor(v, 1); v += __shfl_xor(v, 2); v += __shfl_xor(v, 4); v += __shfl_xor(v, 8); v += __shfl_xor(v, 16); v += __shfl_xor(v, 32); return v;
}
__device__ __forceinline__ void sincos_d(double x, double& s, double& c) {
    const double TWO_PI = 6.283185307179586476925286766559;
    double r = x - TWO_PI * rint(x / TWO_PI);
    const double r2 = r * r;
    double ts = r, tc = 1.0; s = r; c = 1.0;
#pragma unroll 1
    for (int k = 1; k <= 14; ++k) { tc *= -r2 / (double)((2 * k - 1) * (2 * k)); ts *= -r2 / (double)((2 * k) * (2 * k + 1)); c += tc; s += ts; }
}

namespace g8 {
constexpr int BM = 256, BK = 64, HALF = 128, HTB = HALF * BK * 2, NXCD = 8, WGM = 8;
__device__ __forceinline__ int lds_byte(int r, int c) { const int st = (r >> 4) * 2 + (c >> 5), rr = r & 15, cc = c & 31, ob = rr * 64 + cc * 2; return st * 1024 + (ob ^ (((ob >> 9) & 1) << 5)); }
__device__ __forceinline__ void stage_rc(int b, int& R, int& C) { const int st = b / 1024, sb = b % 1024, swz = sb ^ (((sb >> 9) & 1) << 5); R = (st >> 1) * 16 + swz / 64; C = (st & 1) * 32 + (swz % 64) / 2; }
__device__ __forceinline__ int perm32(int rho) { const int n = rho >> 4, i = rho & 15; return 8 * (i >> 2) + 4 * n + (i & 3); }

struct Unit { unsigned aoff, boff; int pm, pn, flags, aux, aux2; };
typedef f32x4 Acc[2][2][4][2];

struct StaticOrder {
    int nM, nN, nwg, G, c;
    __device__ void init(int M, int N, int G_, int c_) { nM = M / BM; nN = N / BM; nwg = nM * nN; G = G_; c = c_; }
    __device__ __forceinline__ bool tile(int i, int& pm, int& pn) const {
        const long L = (long)i * G + c; if (L >= nwg) return false;
        int wgid = (int)L; { const int q = nwg / NXCD, r = nwg % NXCD, xcd = wgid % NXCD, off = wgid / NXCD; wgid = (xcd < r ? xcd * (q + 1) : r * (q + 1) + (xcd - r) * q) + off; }
        const int nig = WGM * nN, gid = wgid / nig, fm = gid * WGM, gsz = (nM - fm) < WGM ? (nM - fm) : WGM;
        pm = fm + ((wgid % nig) % gsz); pn = (wgid % nig) / gsz; return true;
    }
};

template <class Epi, class Sched, bool SKIP = false>
__device__ __forceinline__ void gemm_phase(LAS unsigned char* lds, const unsigned char* ws, const int nt, const int ldb  , const Sched& S, const Epi& E) {
    const int tid = threadIdx.x, wid = __builtin_amdgcn_readfirstlane(tid >> 6), lane = tid & 63, wr = wid >> 2, wc = wid & 3, fr = lane & 15, fq = lane >> 4;
    int R0, C0, R1, C1; stage_rc(tid * 16, R0, C0); stage_rc(tid * 16 + 8192, R1, C1);
    unsigned voffB[2];
    { const int Rb0 = Epi::PERM ? ((R0 & ~31) + perm32(R0 & 31)) : R0, Rb1 = Epi::PERM ? ((R1 & ~31) + perm32(R1 & 31)) : R1;
      voffB[0] = (unsigned)(Rb0 * ldb + C0) * 2u; voffB[1] = (unsigned)(Rb1 * ldb + C1) * 2u; }
    const unsigned kstep = (unsigned)(BK * 2);
    const unsigned hstepB = (unsigned)HALF * (unsigned)ldb * 2u;
    const unsigned ldsw = (unsigned)wid * 1024u;
    const int aoff = lds_byte(wr * 64 + fr, fq * 8), boff = lds_byte(wc * 32 + fr, fq * 8);
#define G8_SA(b, h) (((b) * 2 + (h)) * HTB)
#define G8_SB(b, h) ((4 + (b) * 2 + (h)) * HTB)
#define G8_STAGE(bufoff, gbase, v0, v1) do { \
        __builtin_amdgcn_global_load_lds((const unsigned*)((gbase) + (v0)), (LAS unsigned*)(lds + (bufoff) + ldsw), 16, 0, 0); \
        __builtin_amdgcn_global_load_lds((const unsigned*)((gbase) + (v1)), (LAS unsigned*)(lds + (bufoff) + ldsw + 8192), 16, 0, 0); } while (0)
#define G8_LDA(dst, b, h) do { _Pragma("unroll") for (int m = 0; m < 4; ++m) _Pragma("unroll") for (int k = 0; k < 2; ++k) dst[m][k] = *(const LAS bf16x8*)(lds + G8_SA(b, h) + aoff + m * 2048 + k * 1024); } while (0)
#define G8_LDB(dst, b, h) do { _Pragma("unroll") for (int n = 0; n < 2; ++n) _Pragma("unroll") for (int k = 0; k < 2; ++k) dst[n][k] = *(const LAS bf16x8*)(lds + G8_SB(b, h) + boff + n * 2048 + k * 1024); } while (0)
#define G8_MMA(ai, bj, At, Bt) do { __builtin_amdgcn_s_setprio(1); _Pragma("unroll") for (int m = 0; m < 4; ++m) _Pragma("unroll") for (int n = 0; n < 2; ++n) _Pragma("unroll") for (int k = 0; k < 2; ++k) \
        acc[ai][bj][m][n] = __builtin_amdgcn_mfma_f32_16x16x32_bf16(Bt[n][k], At[m][k], acc[ai][bj][m][n], 0, 0, 0); __builtin_amdgcn_s_setprio(0); } while (0)
#define G8_WAIT_V(n) asm volatile("s_waitcnt vmcnt(" #n ")" ::: "memory")
#define G8_WAIT_L(n) asm volatile("s_waitcnt lgkmcnt(" #n ")" ::: "memory")
#define G8_BAR __builtin_amdgcn_s_barrier()
#define G8_SCHED __builtin_amdgcn_sched_barrier(0)
    Unit cur, nxt; int ui = 0;
    if (!S.next(0, cur)) return;
    Acc acc;
#pragma unroll
    for (int a = 0; a < 2; ++a)
#pragma unroll
        for (int b = 0; b < 2; ++b)
#pragma unroll
            for (int m = 0; m < 4; ++m)
#pragma unroll
                for (int n = 0; n < 2; ++n) acc[a][b][m][n] = (f32x4){0.f, 0.f, 0.f, 0.f};
    bf16x8 At[4][2], B0[2][2], B1[2][2];
    unsigned cv[2][2], nv[2][2];
    S.aoffs(cur, R0, C0, R1, C1, cv);
    const unsigned char* cA = ws + cur.aoff; const unsigned char* cB = ws + cur.boff;
    G8_STAGE(G8_SB(0, 0), cB, voffB[0], voffB[1]); G8_STAGE(G8_SA(0, 0), cA, cv[0][0], cv[0][1]);
    G8_STAGE(G8_SB(0, 1), cB + hstepB, voffB[0], voffB[1]); G8_STAGE(G8_SA(0, 1), cA, cv[1][0], cv[1][1]);
    if (wr == 1) G8_BAR;
    G8_WAIT_V(4); G8_BAR;
    G8_STAGE(G8_SB(1, 0), cB + kstep, voffB[0], voffB[1]); G8_STAGE(G8_SA(1, 0), cA + kstep, cv[0][0], cv[0][1]);
    G8_STAGE(G8_SB(1, 1), cB + hstepB + kstep, voffB[0], voffB[1]);
    G8_WAIT_V(6); G8_BAR;
    for (;;) {
        const bool has_next = S.next(ui + 1, nxt);
        if (has_next) S.aoffs(nxt, R0, C0, R1, C1, nv);
        else { nv[0][0] = cv[0][0]; nv[0][1] = cv[0][1]; nv[1][0] = cv[1][0]; nv[1][1] = cv[1][1]; }
        const unsigned char* nA = has_next ? ws + nxt.aoff : cA; const unsigned char* nB = has_next ? ws + nxt.boff : cB;
        const int vrows = SKIP ? cur.aux2 : 256;
        const bool do0 = !SKIP || vrows > 64 || wr == 0, do1 = !SKIP || vrows > 128;
        for (int t = 0; t < nt; t += 2) {
            const bool last = (t == nt - 2);
            const unsigned char* a1 = cA + (size_t)(t + 1) * kstep;
            const unsigned char* a2 = last ? nA : cA + (size_t)(t + 2) * kstep; const unsigned char* b2 = last ? nB : cB + (size_t)(t + 2) * kstep;
            const unsigned char* a3 = a2 + kstep; const unsigned char* b3 = b2 + kstep;
            const unsigned o00 = last ? nv[0][0] : cv[0][0], o01 = last ? nv[0][1] : cv[0][1], o10 = last ? nv[1][0] : cv[1][0], o11 = last ? nv[1][1] : cv[1][1];
            G8_LDB(B0, 0, 0); G8_SCHED; G8_LDA(At, 0, 0); G8_STAGE(G8_SA(1, 1), a1, cv[1][0], cv[1][1]);
            G8_WAIT_L(8); G8_BAR; G8_WAIT_L(0); if (do0) G8_MMA(0, 0, At, B0); G8_BAR; G8_SCHED;
            G8_LDB(B1, 0, 1); G8_STAGE(G8_SB(0, 0), b2, voffB[0], voffB[1]);
            G8_BAR; G8_WAIT_L(0); if (do0) G8_MMA(0, 1, At, B1); G8_BAR;
            G8_LDA(At, 0, 1); G8_STAGE(G8_SA(0, 0), a2, o00, o01);
            G8_BAR; G8_WAIT_L(0); if (do1) G8_MMA(1, 0, At, B0); G8_BAR; G8_SCHED;
            G8_STAGE(G8_SB(0, 1), b2 + hstepB, voffB[0], voffB[1]);
            G8_WAIT_V(6); G8_BAR; if (do1) G8_MMA(1, 1, At, B1); G8_BAR;
            G8_LDB(B0, 1, 0); G8_SCHED; G8_LDA(At, 1, 0); G8_STAGE(G8_SA(0, 1), a2, o10, o11);
            G8_WAIT_L(8); G8_BAR; G8_WAIT_L(0); if (do0) G8_MMA(0, 0, At, B0); G8_BAR; G8_SCHED;
            G8_LDB(B1, 1, 1); G8_STAGE(G8_SB(1, 0), b3, voffB[0], voffB[1]);
            G8_BAR; G8_WAIT_L(0); if (do0) G8_MMA(0, 1, At, B1); G8_BAR;
            G8_LDA(At, 1, 1); G8_STAGE(G8_SA(1, 0), a3, o00, o01);
            G8_BAR; G8_WAIT_L(0); if (do1) G8_MMA(1, 0, At, B0); G8_BAR; G8_SCHED;
            G8_STAGE(G8_SB(1, 1), b3 + hstepB, voffB[0], voffB[1]);
            G8_WAIT_V(6); G8_BAR; if (do1) G8_MMA(1, 1, At, B1); G8_BAR;
        }
        E(acc, cur, wr, wc, fr, fq);
        if (!has_next) break;
        if (!(cur.flags & 1)) {
#pragma unroll
            for (int a = 0; a < 2; ++a)
#pragma unroll
                for (int b = 0; b < 2; ++b)
#pragma unroll
                    for (int m = 0; m < 4; ++m)
#pragma unroll
                        for (int n = 0; n < 2; ++n) acc[a][b][m][n] = (f32x4){0.f, 0.f, 0.f, 0.f};
        }
        cur = nxt; cA = nA; cB = nB; ++ui;
        cv[0][0] = nv[0][0]; cv[0][1] = nv[0][1]; cv[1][0] = nv[1][0]; cv[1][1] = nv[1][1];
    }
    G8_WAIT_V(0);
    if (wr == 0) G8_BAR;
    G8_BAR;
#undef G8_SA
#undef G8_SB
#undef G8_STAGE
#undef G8_LDA
#undef G8_LDB
#undef G8_MMA
#undef G8_WAIT_V
#undef G8_WAIT_L
#undef G8_BAR
#undef G8_SCHED
}
}

__device__ __forceinline__ void p0_adaln(const Params& P, LAS unsigned char* lds, int tid, int item) {
    const int ks = item & 3, nc = item >> 2;
    LAS float* sc = (LAS float*)lds;
    LAS float* red = (LAS float*)(lds + 16384);
    const float* c = P.in[1];
    for (int i = tid; i < 4096; i += NTHREADS) { const int kl = i >> 3, b = i & 7; const float v = c[b * 2048 + ks * 512 + kl]; sc[i] = v / (1.0f + expf(-v)); }
    __syncthreads();
    if (tid < 384) {
        const int nq = tid % 48, kg = tid / 48;
        const float* W = P.in[2] + (size_t)(ks * 512 + kg * 64) * NMOD + nc * 192 + nq * 4;
        f32x4 acc[8];
#pragma unroll
        for (int b = 0; b < 8; ++b) acc[b] = (f32x4){0.f, 0.f, 0.f, 0.f};
#pragma unroll 8
        for (int kk = 0; kk < 64; ++kk) {
            const f32x4 w = *(const f32x4*)(W + (size_t)kk * NMOD);
            const f32x4 s0 = *(const LAS f32x4*)(sc + (kg * 64 + kk) * 8), s1 = *(const LAS f32x4*)(sc + (kg * 64 + kk) * 8 + 4);
            acc[0] += w * s0[0]; acc[1] += w * s0[1]; acc[2] += w * s0[2]; acc[3] += w * s0[3];
            acc[4] += w * s1[0]; acc[5] += w * s1[1]; acc[6] += w * s1[2]; acc[7] += w * s1[3];
        }
#pragma unroll
        for (int b = 0; b < 8; ++b) *(LAS f32x4*)(red + (kg * 8 + b) * 192 + nq * 4) = acc[b];
    }
    __syncthreads();
    float* modp = (float*)(P.ws + WS_MODP);
    for (int i = tid; i < 8 * 192; i += NTHREADS) {
        const int b = i / 192, n = i % 192; float s = 0.f;
#pragma unroll
        for (int kg = 0; kg < 8; ++kg) s += red[(kg * 8 + b) * 192 + n];
        modp[(size_t)(ks * 8 + b) * NMOD + nc * 192 + n] = s;
    }
    __syncthreads();
}

struct CvtUnit { const float* src; bf16_t* dst; int Nd, Kd, k0, n0, nmode; const float* s0; const float* s1; };
constexpr int CVT_UNITS = 640 + 256 + 64 + 3 * 4096;
__device__ __forceinline__ void cvt_unit_decode(const Params& P, int L, CvtUnit& u) {
    u.s0 = nullptr; u.s1 = nullptr; u.nmode = 0;
    if (L < 640) { u.src = P.in[5]; u.dst = (bf16_t*)(P.ws + WS_WIN); u.Kd = 2048; u.Nd = 5120; u.k0 = (L / 20) * 64; u.n0 = (L % 20) * 256; u.nmode = 3; return; }
    L -= 640;
    if (L < 256) { u.src = P.in[17]; u.dst = (bf16_t*)(P.ws + WS_WOUT); u.Kd = 2048; u.Nd = 2048; u.k0 = (L / 8) * 64; u.n0 = (L % 8) * 256; u.s0 = P.in[15]; u.s1 = P.in[16]; return; }
    L -= 256;
    if (L < 64) { u.src = P.in[14]; u.dst = (bf16_t*)(P.ws + WS_WGLU); u.Kd = 1024; u.Nd = 1024; u.k0 = (L / 4) * 64; u.n0 = (L % 4) * 256; return; }
    L -= 64;
    if (L < 4096) { const int e = L >> 7, r = L & 127; u.src = P.in[23] + (size_t)e * 2048 * 1024; u.dst = (bf16_t*)(P.ws + WS_WGU) + (size_t)e * 2048 * 2048; u.Kd = 2048; u.Nd = 1024; u.k0 = (r >> 2) * 64; u.n0 = (r & 3) * 256; u.nmode = 1; return; }
    L -= 4096;
    if (L < 4096) { const int e = L >> 7, r = L & 127; u.src = P.in[24] + (size_t)e * 2048 * 1024; u.dst = (bf16_t*)(P.ws + WS_WGU) + (size_t)e * 2048 * 2048; u.Kd = 2048; u.Nd = 1024; u.k0 = (r >> 2) * 64; u.n0 = (r & 3) * 256; u.nmode = 2; return; }
    L -= 4096;
    { const int e = L >> 7, r = L & 127; u.src = P.in[25] + (size_t)e * 1024 * 2048; u.dst = (bf16_t*)(P.ws + WS_WD) + (size_t)e * 2048 * 1024; u.Kd = 1024; u.Nd = 2048; u.k0 = (r >> 3) * 64; u.n0 = (r & 7) * 256; }
}
__device__ __forceinline__ void cvt_load(const CvtUnit& u, int tid, f32x4 (&r)[8]) {
    const int kp = tid >> 4, nq = tid & 15;
    const float* p = u.src + (size_t)(u.k0 + 2 * kp) * u.Nd + u.n0 + nq * 4;
#pragma unroll
    for (int s = 0; s < 4; ++s) { r[2 * s] = *(const f32x4*)(p + s * 64); r[2 * s + 1] = *(const f32x4*)(p + u.Nd + s * 64); }
    if (u.s0) {
        const int k = u.k0 + 2 * kp;
        const float a = (k < 1024) ? u.s0[k] : u.s1[k - 1024], b = (k + 1 < 1024) ? u.s0[k + 1] : u.s1[k + 1 - 1024];
#pragma unroll
        for (int s = 0; s < 4; ++s) { r[2 * s] *= a; r[2 * s + 1] *= b; }
    }
}
__device__ __forceinline__ void cvt_to_lds(LAS unsigned* tile, const f32x4 (&r)[8], int kp, int nq) {
#pragma unroll
    for (int s = 0; s < 4; ++s)
#pragma unroll
        for (int j = 0; j < 4; ++j) tile[s * 2112 + (nq * 4 + j) * 33 + kp] = cvt_pk_bf16(r[2 * s][j], r[2 * s + 1][j]);
}
__device__ __forceinline__ void cvt_store(const LAS unsigned* tile, const CvtUnit& u, int nl, int kq) {
#pragma unroll
    for (int s = 0; s < 4; ++s) {
        u32x4 w; w.x = tile[s * 2112 + nl * 33 + kq * 4]; w.y = tile[s * 2112 + nl * 33 + kq * 4 + 1]; w.z = tile[s * 2112 + nl * 33 + kq * 4 + 2]; w.w = tile[s * 2112 + nl * 33 + kq * 4 + 3];
        const int n = u.n0 + s * 64 + nl;
        int np = n;
        if (u.nmode == 1 || u.nmode == 2) np = (n >> 7) * 256 + (n & 127) + (u.nmode == 2 ? 128 : 0);
        else if (u.nmode == 3 && n >= 1024 && n < 3072) { const int reg = (n >= 2048) ? 2048 : 1024, nr = n - reg;
            np = reg + ((nr >> 8) << 8) + (((nr >> 6) & 1) << 7) + (((nr >> 7) & 1) << 6) + (nr & 63); }
        *(u32x4*)(u.dst + (size_t)np * u.Kd + u.k0 + kq * 8) = w;
    }
}
__device__ __forceinline__ void p0_convert(const Params& P, LAS unsigned char* lds, int tid, int blk, int G) {
    LAS unsigned* tileA = (LAS unsigned*)lds;
    LAS unsigned* tileB = tileA + 4 * 2112;
    const int kp = tid >> 4, nq = tid & 15, nl = tid >> 3, kq = tid & 7;
    CvtUnit uA, uB, nA, nB; f32x4 rA[8], rB[8];
    int L = blk;
    if (L >= CVT_UNITS) return;
    bool hasB = (L + G) < CVT_UNITS;
    cvt_unit_decode(P, L, uA); cvt_load(uA, tid, rA);
    if (hasB) { cvt_unit_decode(P, L + G, uB); cvt_load(uB, tid, rB); }
    for (;;) {
        cvt_to_lds(tileA, rA, kp, nq);
        if (hasB) cvt_to_lds(tileB, rB, kp, nq);
        __syncthreads();
        const int Ln = L + 2 * G; const bool moreA = Ln < CVT_UNITS, moreB = (Ln + G) < CVT_UNITS;
        if (moreA) { cvt_unit_decode(P, Ln, nA); cvt_load(nA, tid, rA); }
        if (moreB) { cvt_unit_decode(P, Ln + G, nB); cvt_load(nB, tid, rB); }
        cvt_store(tileA, uA, nl, kq);
        if (hasB) cvt_store(tileB, uB, nl, kq);
        __syncthreads();
        if (!moreA) break;
        uA = nA; uB = nB; hasB = moreB; L = Ln;
    }
}

__device__ __forceinline__ void p0_ssm_mats(const Params& P, LAS unsigned char* lds, int tid, int item) {
    const int g = item & 63, q = item >> 6;
    LAS f32x2* pw = (LAS f32x2*)lds;
    LAS f32x2* Bb = pw + 17 * 64;
    LAS f32x2* Cc = Bb + 64 * 16;
    LAS float* Kt = (LAS float*)(Cc + 16 * 64);
    if (tid < 64) {
        const int p = tid;
        const float dt = expf(P.in[13][g]);
        const float are = P.in[6][g * 64 + p], aim = P.in[7][g * 64 + p];
        const float mag = expf(dt * are);
        double sd, cd; sincos_d((double)(dt * aim), sd, cd);
        const float abr = mag * (float)cd, abi = mag * (float)sd;
        const float inv = 1.0f / (are * are + aim * aim);
        const float nre = abr - 1.0f;
        const float fre = (nre * are + abi * aim) * inv, fim = (abi * are - nre * aim) * inv;
        float pr = 1.0f, pi = 0.0f;
        for (int n = 0; n <= 16; ++n) { pw[n * 64 + p] = (f32x2){pr, pi}; const float t = pr * abr - pi * abi; pi = pr * abi + pi * abr; pr = t; }
        for (int h = 0; h < 16; ++h) {
            const float br = P.in[8][(g * 64 + p) * 16 + h], bi = P.in[9][(g * 64 + p) * 16 + h];
            Bb[p * 16 + h] = (f32x2){fre * br - fim * bi, fre * bi + fim * br};
            Cc[h * 64 + p] = (f32x2){P.in[10][(g * 16 + h) * 64 + p], P.in[11][(g * 16 + h) * 64 + p]};
        }
        if (q == 0) { f32x2* AL = (f32x2*)(P.ws + WS_SSMA); const f32x2 v = pw[16 * 64 + p]; AL[g * 64 + p] = v; }
    }
    __syncthreads();
    for (int o = tid; o < 4096; o += NTHREADS) {
        const int tau = o >> 8, ho = (o >> 4) & 15, hi = o & 15; float s = 0.f;
        for (int p = 0; p < 64; ++p) {
            const f32x2 c = Cc[ho * 64 + p], a = pw[tau * 64 + p], b = Bb[p * 16 + hi];
            const float cr = c.x * a.x - c.y * a.y, ci = c.x * a.y + c.y * a.x;
            s += cr * b.x - ci * b.y;
        }
        Kt[o] = s;
    }
    __syncthreads();
    bf16_t* Ms = (bf16_t*)(P.ws + WS_SSMM) + (size_t)g * 131072;
    bf16_t* TM = Ms + 32768;
    for (int o = tid; o < 32 * 128; o += NTHREADS) {
        const int row = 32 * q + (o >> 7), col = (o & 127) * 2;
        const int p = row >> 1, j = col >> 4, hi = col & 15;
        const f32x2 a = pw[(15 - j) * 64 + p], b0 = Bb[p * 16 + hi], b1 = Bb[p * 16 + hi + 1];
        float v0, v1;
        if ((row & 1) == 0) { v0 = a.x * b0.x - a.y * b0.y; v1 = a.x * b1.x - a.y * b1.y; } else { v0 = a.x * b0.y + a.y * b0.x; v1 = a.x * b1.y + a.y * b1.x; }
        *(unsigned*)(Ms + (size_t)row * 256 + col) = cvt_pk_bf16(v0, v1);
    }
    for (int o = tid; o < 64 * 192; o += NTHREADS) {
        const int row = 64 * q + o / 192, col = (o % 192) * 2;
        const int i = row >> 4, ho = row & 15; float v0, v1;
        if (col < 256) { const int j = col >> 4, hi = col & 15; if (j <= i) { v0 = Kt[((i - j) * 16 + ho) * 16 + hi]; v1 = Kt[((i - j) * 16 + ho) * 16 + hi + 1]; } else { v0 = 0.f; v1 = 0.f; } }
        else { const int p0 = (col - 256) >> 1;
            const f32x2 c0 = Cc[ho * 64 + p0], a0 = pw[(i + 1) * 64 + p0];
            v0 = c0.x * a0.x - c0.y * a0.y; v1 = -(c0.x * a0.y + c0.y * a0.x); }
        *(unsigned*)(TM + (size_t)row * 384 + col) = cvt_pk_bf16(v0, v1);
    }
    __syncthreads();
}

__device__ __forceinline__ void p0_misc(const Params& P, int tid, int blk, int G) {
    f32x2* rope = (f32x2*)(P.ws + WS_ROPE);
    for (int i = blk * NTHREADS + tid; i < 2048 * 64; i += G * NTHREADS) {
        const int pos = i >> 6, d = i & 63;
        double th = 1.0; { const double r = 0.86596432336006535; double b = r; int e = d; while (e) { if (e & 1) th *= b; b *= b; e >>= 1; } }
        double s1, c1; sincos_d(th, s1, c1);
        double cr = 1.0, ci = 0.0, br = c1, bi = s1; int e = pos;
        while (e) { if (e & 1) { const double t = cr * br - ci * bi; ci = cr * bi + ci * br; cr = t; } const double t2 = br * br - bi * bi; bi = 2.0 * br * bi; br = t2; e >>= 1; }
        rope[i] = (f32x2){(float)cr, (float)ci};
    }
    bf16_t* wr = (bf16_t*)(P.ws + WS_WR);
    for (int i = blk * NTHREADS + tid; i < 48 * 2048; i += G * NTHREADS) {
        const int n = i >> 11, k = i & 2047; float v = 0.f;
        if (n < 4) v = P.in[19][k * 4 + n]; else if (n < 36) v = P.in[21][k * 32 + (n - 4)];
        wr[i] = (bf16_t)(cvt_pk_bf16(v, 0.f) & 0xffffu);
    }
    if (blk == 0) for (int i = tid; i < 2048; i += NTHREADS) ((int*)(P.ws + WS_CNT))[i] = 0;
}

__device__ __forceinline__ void p1_norm1(const Params& P, LAS unsigned char* lds, int tid, int blk, int G) {
    const float* modp = (const float*)(P.ws + WS_MODP); const float* bada = P.in[3];
    float* mod = (float*)(P.ws + WS_MOD);
    for (int i = blk * NTHREADS + tid; i < 8 * NMOD; i += G * NTHREADS) {
        const int b = i / NMOD, j = i % NMOD;
        mod[i] = bada[j] + ((modp[(size_t)(0 * 8 + b) * NMOD + j] + modp[(size_t)(1 * 8 + b) * NMOD + j]) + (modp[(size_t)(2 * 8 + b) * NMOD + j] + modp[(size_t)(3 * 8 + b) * NMOD + j]));
    }
    LAS float* gm = (LAS float*)lds; LAS float* sh = gm + 2048;
    const int wave = tid >> 6, lane = tid & 63;
    bf16_t* H = (bf16_t*)(P.ws + WS_H);
    for (int rb = blk; rb < 256; rb += G) {
        const int b = rb >> 5;
        for (int k = tid; k < 2048; k += NTHREADS) {
            const int js = 2048 + k, jh = k;
            const float sc = bada[js] + ((modp[(size_t)(0 * 8 + b) * NMOD + js] + modp[(size_t)(1 * 8 + b) * NMOD + js]) + (modp[(size_t)(2 * 8 + b) * NMOD + js] + modp[(size_t)(3 * 8 + b) * NMOD + js]));
            const float sv = bada[jh] + ((modp[(size_t)(0 * 8 + b) * NMOD + jh] + modp[(size_t)(1 * 8 + b) * NMOD + jh]) + (modp[(size_t)(2 * 8 + b) * NMOD + jh] + modp[(size_t)(3 * 8 + b) * NMOD + jh]));
            gm[k] = P.in[4][k] * (1.0f + sc); sh[k] = sv;
        }
        __syncthreads();
        for (int rr = 0; rr < 8; ++rr) {
            const int row = rb * 64 + wave * 8 + rr;
            const float* xr = P.in[0] + (size_t)row * DM;
            f32x4 v[8]; float ss = 0.f;
#pragma unroll
            for (int i = 0; i < 8; ++i) { v[i] = *(const f32x4*)(xr + (i * 64 + lane) * 4); ss += v[i][0] * v[i][0] + v[i][1] * v[i][1] + v[i][2] * v[i][2] + v[i][3] * v[i][3]; }
            ss = wave_sum(ss);
            const float r = rsqrtf(ss * (1.0f / 2048.0f) + 1e-6f);
#pragma unroll
            for (int i = 0; i < 8; ++i) {
                const int k = (i * 64 + lane) * 4;
                const f32x4 g4 = *(const LAS f32x4*)(gm + k), s4 = *(const LAS f32x4*)(sh + k);
                const f32x4 o = v[i] * r * g4 + s4;
                u32x2 w; w.x = cvt_pk_bf16(o[0], o[1]); w.y = cvt_pk_bf16(o[2], o[3]);
                *(u32x2*)(H + (size_t)row * DM + k) = w;
            }
        }
        __syncthreads();
    }
}

struct DenseSched : g8::StaticOrder {
    unsigned abase, bbase; int lda, ldb;
    __device__ __forceinline__ bool next(int i, g8::Unit& u) const {
        int pm, pn; if (!tile(i, pm, pn)) return false;
        u.pm = __builtin_amdgcn_readfirstlane(pm); u.pn = __builtin_amdgcn_readfirstlane(pn); u.flags = 0; u.aux = 0;
        u.aoff = abase + (unsigned)u.pm * 256u * (unsigned)lda * 2u; u.boff = bbase + (unsigned)u.pn * 256u * (unsigned)ldb * 2u; return true;
    }
    __device__ __forceinline__ void aoffs(const g8::Unit&, int R0, int C0, int R1, int C1, unsigned (&v)[2][2]) const {
        v[0][0] = (unsigned)(R0 * lda + C0) * 2u; v[0][1] = (unsigned)(R1 * lda + C1) * 2u;
        v[1][0] = (unsigned)((128 + R0) * lda + C0) * 2u; v[1][1] = (unsigned)((128 + R1) * lda + C1) * 2u;
    }
};
struct EpiStoreBf16 {
    static constexpr bool PERM = true;
    bf16_t* O; int ldc;
    __device__ __forceinline__ void operator()(g8::Acc& acc, const g8::Unit& u, int wr, int wc, int fr, int fq) const {
        const int row0 = u.pm * 256 + wr * 64 + fr, col0 = u.pn * 256 + wc * 32 + 8 * fq;
#pragma unroll
        for (int ai = 0; ai < 2; ++ai)
#pragma unroll
            for (int m = 0; m < 4; ++m) { bf16_t* rowp = O + (size_t)(row0 + ai * 128 + m * 16) * ldc + col0;
#pragma unroll
                for (int bj = 0; bj < 2; ++bj) { const f32x4 v0 = acc[ai][bj][m][0], v1 = acc[ai][bj][m][1];
                    u32x4 w; w.x = cvt_pk_bf16(v0[0], v0[1]); w.y = cvt_pk_bf16(v0[2], v0[3]); w.z = cvt_pk_bf16(v1[0], v1[1]); w.w = cvt_pk_bf16(v1[2], v1[3]);
                    *(u32x4*)(rowp + bj * 128) = w; } }
    }
};
struct EpiInProj {
    static constexpr bool PERM = true;
    bf16_t* O; const f32x2* rope;
    __device__ __forceinline__ void operator()(g8::Acc& acc, const g8::Unit& u, int wr, int wc, int fr, int fq) const {
        const int pn = u.pn;
        const int row0 = u.pm * 256 + wr * 64 + fr;
        if (pn < 4 || pn >= 12) {
            const int col0 = pn * 256 + wc * 32 + 8 * fq;
#pragma unroll
            for (int ai = 0; ai < 2; ++ai)
#pragma unroll
                for (int m = 0; m < 4; ++m) { bf16_t* rowp = O + (size_t)(row0 + ai * 128 + m * 16) * NPROJ + col0;
#pragma unroll
                    for (int bj = 0; bj < 2; ++bj) { const f32x4 v0 = acc[ai][bj][m][0], v1 = acc[ai][bj][m][1];
                        u32x4 w; w.x = cvt_pk_bf16(v0[0], v0[1]); w.y = cvt_pk_bf16(v0[2], v0[3]); w.z = cvt_pk_bf16(v1[0], v1[1]); w.w = cvt_pk_bf16(v1[2], v1[3]);
                        *(u32x4*)(rowp + bj * 128) = w; } }
            return;
        }
        const bool isq = pn < 8;
        const int head = 2 * ((pn - 4) & 3) + (wc >> 1);
        const int dd0 = 32 * (wc & 1) + 8 * fq;
        const int colbase = (isq ? 1024 : 2048) + head * 128 + dd0;
        const float lg2 = log2f(1.0f - exp2f(-5.0f - (float)head));
#pragma unroll
        for (int ai = 0; ai < 2; ++ai)
#pragma unroll
            for (int m = 0; m < 4; ++m) {
                const int row = row0 + ai * 128 + m * 16, pos = row & 2047, i = wr * 64 + m * 16 + fr;
                const float sc = isq ? exp2f(lg2 * (float)i) : exp2f(-lg2 * (float)i) * 0.08838834764831845f;
                const f32x4* rp = (const f32x4*)(rope + (size_t)pos * 64 + dd0);
                float o1[8], o2[8];
#pragma unroll
                for (int w = 0; w < 4; ++w) { const f32x4 cs = rp[w];
                    const int n = w >> 1, j = (w & 1) * 2;
                    const float a0 = acc[ai][0][m][n][j], a1 = acc[ai][0][m][n][j + 1], b0 = acc[ai][1][m][n][j], b1 = acc[ai][1][m][n][j + 1];
                    o1[2 * w] = (a0 * cs[0] - b0 * cs[1]) * sc; o1[2 * w + 1] = (a1 * cs[2] - b1 * cs[3]) * sc;
                    o2[2 * w] = (b0 * cs[0] + a0 * cs[1]) * sc; o2[2 * w + 1] = (b1 * cs[2] + a1 * cs[3]) * sc; }
                bf16_t* rowp = O + (size_t)row * NPROJ + colbase;
                u32x4 w1, w2; w1.x = cvt_pk_bf16(o1[0], o1[1]); w1.y = cvt_pk_bf16(o1[2], o1[3]); w1.z = cvt_pk_bf16(o1[4], o1[5]); w1.w = cvt_pk_bf16(o1[6], o1[7]);
                w2.x = cvt_pk_bf16(o2[0], o2[1]); w2.y = cvt_pk_bf16(o2[2], o2[3]); w2.z = cvt_pk_bf16(o2[4], o2[5]); w2.w = cvt_pk_bf16(o2[6], o2[7]);
                *(u32x4*)rowp = w1; *(u32x4*)(rowp + 64) = w2;
            }
    }
};
struct EpiGlu {
    static constexpr bool PERM = true;
    const bf16_t* Z; bf16_t* CAT; float* rowss;
    __device__ __forceinline__ void operator()(g8::Acc& acc, const g8::Unit& u, int wr, int wc, int fr, int fq) const {
        const int row0 = u.pm * 256 + wr * 64 + fr, col0 = u.pn * 256 + wc * 32 + 8 * fq;
#pragma unroll
        for (int ai = 0; ai < 2; ++ai)
#pragma unroll
            for (int m = 0; m < 4; ++m) { const int row = row0 + ai * 128 + m * 16; float ss = 0.f;
#pragma unroll
                for (int bj = 0; bj < 2; ++bj) { const f32x4 v0 = acc[ai][bj][m][0], v1 = acc[ai][bj][m][1];
                    const u32x4 zz = *(const u32x4*)(Z + (size_t)row * 1024 + col0 + bj * 128);
                    float o[8];
                    o[0] = bf_lo(zz.x) * sigmoidf_(v0[0]); o[1] = bf_hi(zz.x) * sigmoidf_(v0[1]); o[2] = bf_lo(zz.y) * sigmoidf_(v0[2]); o[3] = bf_hi(zz.y) * sigmoidf_(v0[3]);
                    o[4] = bf_lo(zz.z) * sigmoidf_(v1[0]); o[5] = bf_hi(zz.z) * sigmoidf_(v1[1]); o[6] = bf_lo(zz.w) * sigmoidf_(v1[2]); o[7] = bf_hi(zz.w) * sigmoidf_(v1[3]);
#pragma unroll
                    for (int j = 0; j < 8; ++j) ss += o[j] * o[j];
                    u32x4 w; w.x = cvt_pk_bf16(o[0], o[1]); w.y = cvt_pk_bf16(o[2], o[3]); w.z = cvt_pk_bf16(o[4], o[5]); w.w = cvt_pk_bf16(o[6], o[7]);
                    *(u32x4*)(CAT + (size_t)row * DM + col0 + bj * 128) = w; }
                ss += __shfl_xor(ss, 16); ss += __shfl_xor(ss, 32);
                if (fq == 0) rowss[(size_t)row * 16 + u.pn * 4 + wc] = ss; }
    }
};
struct OutSched : g8::StaticOrder {
    unsigned abase, bbase;
    __device__ __forceinline__ bool next(int i, g8::Unit& u) const {
        int pm, pn; if (!tile(i >> 1, pm, pn)) return false;
        const int half = i & 1;
        u.pm = __builtin_amdgcn_readfirstlane(pm); u.pn = __builtin_amdgcn_readfirstlane(pn); u.flags = half ? 0 : 1; u.aux = half;
        u.aoff = abase + (unsigned)u.pm * 256u * 4096u + (unsigned)half * 2048u; u.boff = bbase + (unsigned)u.pn * 256u * 4096u + (unsigned)half * 2048u; return true;
    }
    __device__ __forceinline__ void aoffs(const g8::Unit&, int R0, int C0, int R1, int C1, unsigned (&v)[2][2]) const {
        v[0][0] = (unsigned)(R0 * 2048 + C0) * 2u; v[0][1] = (unsigned)(R1 * 2048 + C1) * 2u;
        v[1][0] = (unsigned)((128 + R0) * 2048 + C0) * 2u; v[1][1] = (unsigned)((128 + R1) * 2048 + C1) * 2u;
    }
};
struct EpiOut {
    static constexpr bool PERM = true;
    const float* x; const float* mod; const float* rowss1; float* rowss2; bf16_t* X1;
    __device__ __forceinline__ void operator()(g8::Acc& acc, const g8::Unit& u, int wr, int wc, int fr, int fq) const {
        const int row0 = u.pm * 256 + wr * 64 + fr;
        if (u.aux == 0) {
#pragma unroll
            for (int ai = 0; ai < 2; ++ai)
#pragma unroll
                for (int m = 0; m < 4; ++m) { const f32x4* pp = (const f32x4*)(rowss1 + (size_t)(row0 + ai * 128 + m * 16) * 16);
                    const f32x4 p0 = pp[0], p1 = pp[1], p2 = pp[2], p3 = pp[3];
                    const float tot = (((p0[0] + p0[1]) + (p0[2] + p0[3])) + ((p1[0] + p1[1]) + (p1[2] + p1[3]))) + (((p2[0] + p2[1]) + (p2[2] + p2[3])) + ((p3[0] + p3[1]) + (p3[2] + p3[3])));
                    const float r = rsqrtf(tot * (1.0f / 1024.0f) + 1e-6f);
#pragma unroll
                    for (int bj = 0; bj < 2; ++bj)
#pragma unroll
                        for (int n = 0; n < 2; ++n) acc[ai][bj][m][n] *= r; }
            return;
        }
        const int col0 = u.pn * 256 + wc * 32 + 8 * fq;
        const int b = (u.pm * 256) >> 11;
        f32x4 gt[2][2];
#pragma unroll
        for (int bj = 0; bj < 2; ++bj)
#pragma unroll
            for (int n = 0; n < 2; ++n) gt[bj][n] = *(const f32x4*)(mod + (size_t)b * NMOD + 2 * DM + col0 + bj * 128 + n * 4);
#pragma unroll
        for (int ai = 0; ai < 2; ++ai)
#pragma unroll
            for (int m = 0; m < 4; ++m) { const int row = row0 + ai * 128 + m * 16; float ss = 0.f;
#pragma unroll
                for (int bj = 0; bj < 2; ++bj) { const size_t off = (size_t)row * DM + col0 + bj * 128;
                    const f32x4 xa = *(const f32x4*)(x + off), xb = *(const f32x4*)(x + off + 4);
                    const f32x4 o0 = xa + gt[bj][0] * acc[ai][bj][m][0], o1 = xb + gt[bj][1] * acc[ai][bj][m][1];
                    ss += (o0[0] * o0[0] + o0[1] * o0[1]) + (o0[2] * o0[2] + o0[3] * o0[3]) + (o1[0] * o1[0] + o1[1] * o1[1]) + (o1[2] * o1[2] + o1[3] * o1[3]);
                    u32x4 w; w.x = cvt_pk_bf16(o0[0], o0[1]); w.y = cvt_pk_bf16(o0[2], o0[3]); w.z = cvt_pk_bf16(o1[0], o1[1]); w.w = cvt_pk_bf16(o1[2], o1[3]);
                    *(u32x4*)(X1 + off) = w; }
                ss += __shfl_xor(ss, 16); ss += __shfl_xor(ss, 32);
                if (fq == 0) rowss2[(size_t)row * 32 + u.pn * 4 + wc] = ss; }
    }
};
struct MoeSched {
    const LAS int* tinfo; const LAS int* trows; int ntiles; int G, c; const int* list; unsigned abase, bbase; int mode;
    __device__ __forceinline__ bool next(int i, g8::Unit& u) const {
        int pn, ti;
        if ((G & 63) == 0) { const int x = c & 7, r = c >> 3, per = G >> 6;
            ti = (i * 8 + x) * per + (r >> 3); pn = r & 7; }
        else { const int L = i * G + c; pn = L & 7; ti = L >> 3; }
        if (ti >= ntiles) return false;
        const int inf = __builtin_amdgcn_readfirstlane(tinfo[ti]);
        const int e = inf & 255;
        u.pm = __builtin_amdgcn_readfirstlane(ti); u.pn = pn; u.flags = 0; u.aux = inf; u.aux2 = __builtin_amdgcn_readfirstlane(trows[ti]);
        if (mode == 0) { u.aoff = abase; u.boff = bbase + (unsigned)e * (2048u * 2048u * 2u) + (unsigned)pn * (256u * 2048u * 2u); }
        else { u.aoff = abase + (unsigned)ti * (256u * 1024u * 2u); u.boff = bbase + (unsigned)e * (2048u * 1024u * 2u) + (unsigned)pn * (256u * 1024u * 2u); }
        return true;
    }
    __device__ __forceinline__ void aoffs(const g8::Unit& u, int R0, int C0, int R1, int C1, unsigned (&v)[2][2]) const {
        if (mode == 0) {
            const int e = u.aux & 255, r0 = u.aux >> 8, n = u.aux2; const int* le = list + e * 16384 + r0;
            const int i00 = R0, i01 = R1, i10 = 128 + R0, i11 = 128 + R1;
            const int t00 = (i00 < n) ? (le[i00] >> 1) : 0, t01 = (i01 < n) ? (le[i01] >> 1) : 0, t10 = (i10 < n) ? (le[i10] >> 1) : 0, t11 = (i11 < n) ? (le[i11] >> 1) : 0;
            v[0][0] = (unsigned)(t00 * 2048 + C0) * 2u; v[0][1] = (unsigned)(t01 * 2048 + C1) * 2u; v[1][0] = (unsigned)(t10 * 2048 + C0) * 2u; v[1][1] = (unsigned)(t11 * 2048 + C1) * 2u;
        } else {
            v[0][0] = (unsigned)(R0 * 1024 + C0) * 2u; v[0][1] = (unsigned)(R1 * 1024 + C1) * 2u;
            v[1][0] = (unsigned)((128 + R0) * 1024 + C0) * 2u; v[1][1] = (unsigned)((128 + R1) * 1024 + C1) * 2u;
        }
    }
};
struct EpiMoe1 {
    static constexpr bool PERM = true;
    bf16_t* HM;
    __device__ __forceinline__ void operator()(g8::Acc& acc, const g8::Unit& u, int wr, int wc, int fr, int fq) const {
        const int row0 = u.pm * 256 + wr * 64 + fr, col0 = u.pn * 128 + wc * 32 + 8 * fq;
#pragma unroll
        for (int ai = 0; ai < 2; ++ai)
#pragma unroll
            for (int m = 0; m < 4; ++m) { float o[8];
#pragma unroll
                for (int n = 0; n < 2; ++n)
#pragma unroll
                    for (int j = 0; j < 4; ++j) { const float gv = acc[ai][0][m][n][j], uv = acc[ai][1][m][n][j]; o[n * 4 + j] = gv * sigmoidf_(gv) * uv; }
                u32x4 w; w.x = cvt_pk_bf16(o[0], o[1]); w.y = cvt_pk_bf16(o[2], o[3]); w.z = cvt_pk_bf16(o[4], o[5]); w.w = cvt_pk_bf16(o[6], o[7]);
                *(u32x4*)(HM + (size_t)(row0 + ai * 128 + m * 16) * 1024 + col0) = w; }
    }
};
struct EpiMoe2 {
    static constexpr bool PERM = true;
    const int* list; const float* wgt; bf16_t* Y2;
    __device__ __forceinline__ void operator()(g8::Acc& acc, const g8::Unit& u, int wr, int wc, int fr, int fq) const {
        const int e = u.aux & 255, r0 = u.aux >> 8, n = u.aux2; const int* le = list + e * 16384 + r0;
        const int col0 = u.pn * 256 + wc * 32 + 8 * fq;
#pragma unroll
        for (int ai = 0; ai < 2; ++ai)
#pragma unroll
            for (int m = 0; m < 4; ++m) { const int r = ai * 128 + wr * 64 + m * 16 + fr;
                if (r < n) { const int asg = le[r]; const float w8 = wgt[asg]; bf16_t* rowp = Y2 + (size_t)asg * DM + col0;
#pragma unroll
                    for (int bj = 0; bj < 2; ++bj) { const f32x4 v0 = acc[ai][bj][m][0] * w8, v1 = acc[ai][bj][m][1] * w8;
                        u32x4 w; w.x = cvt_pk_bf16(v0[0], v0[1]); w.y = cvt_pk_bf16(v0[2], v0[3]); w.z = cvt_pk_bf16(v1[0], v1[1]); w.w = cvt_pk_bf16(v1[2], v1[3]);
                        *(u32x4*)(rowp + bj * 128) = w; } } }
    }
};

constexpr size_t WS_KV = WS_H;
__device__ __forceinline__ void ssm_item(const Params& P, LAS unsigned char* lds, int tid, int item) {
    const int g = item >> 2, bp = item & 3;
    const int wave = __builtin_amdgcn_readfirstlane(tid >> 6), lane = tid & 63, fr = lane & 15, fq = lane >> 4;
    const bf16_t* proj = (const bf16_t*)(P.ws + WS_PROJ);
    const bf16_t* Ms = (const bf16_t*)(P.ws + WS_SSMM) + (size_t)g * 131072;
    const bf16_t* TM = Ms + 32768;
    bf16_t* Zo = (bf16_t*)(P.ws + WS_Z);
    constexpr int ZS = 136, MS = 264, TS = 392;
    LAS bf16_t* ZB = (LAS bf16_t*)lds;
    LAS bf16_t* WB = (LAS bf16_t*)(lds + 256 * ZS * 2);
    const int b = 2 * bp + (wave >> 2);
    int tok0[2];
    bf16x8 Uf[2][8];
#pragma unroll
    for (int mt = 0; mt < 2; ++mt) {
        const int c = 32 * (wave & 3) + 16 * mt + fr; tok0[mt] = b * 2048 + c * 16;
#pragma unroll
        for (int ks = 0; ks < 8; ++ks) Uf[mt][ks] = *(const bf16x8*)(proj + (size_t)(tok0[mt] + 2 * ks + (fq >> 1)) * NPROJ + g * 16 + 8 * (fq & 1));
    }
#pragma unroll
    for (int i = 0; i < 8; ++i) { const int c = tid + 512 * i, row = c >> 5, kc = c & 31; *(LAS u32x4*)(WB + row * MS + kc * 8) = *(const u32x4*)(Ms + row * 256 + kc * 8); }
    __syncthreads();
#pragma unroll
    for (int nt = 0; nt < 8; ++nt) {
        f32x4 a0 = {0.f, 0.f, 0.f, 0.f}, a1 = {0.f, 0.f, 0.f, 0.f};
#pragma unroll
        for (int ks = 0; ks < 8; ++ks) {
            const bf16x8 bf = *(const LAS bf16x8*)(WB + (16 * nt + fr) * MS + 32 * ks + 8 * fq);
            a0 = __builtin_amdgcn_mfma_f32_16x16x32_bf16(bf, Uf[0][ks], a0, 0, 0, 0);
            a1 = __builtin_amdgcn_mfma_f32_16x16x32_bf16(bf, Uf[1][ks], a1, 0, 0, 0);
        }
        *(LAS u32x2*)(ZB + (32 * wave + fr) * ZS + 16 * nt + 4 * fq) = (u32x2){cvt_pk_bf16(a0[0], a0[1]), cvt_pk_bf16(a0[2], a0[3])};
        *(LAS u32x2*)(ZB + (32 * wave + 16 + fr) * ZS + 16 * nt + 4 * fq) = (u32x2){cvt_pk_bf16(a1[0], a1[1]), cvt_pk_bf16(a1[2], a1[3])};
    }
    u32x4 tmr[6];
#pragma unroll
    for (int i = 0; i < 6; ++i) { const int c = tid + 512 * i, row = c / 48, kc = c % 48; tmr[i] = *(const u32x4*)(TM + (size_t)row * 384 + kc * 8); }
    __syncthreads();
    if (tid < 128) {
        const int bl = tid >> 6, p = tid & 63;
        const f32x2 al = ((const f32x2*)(P.ws + WS_SSMA))[g * 64 + p];
        float xr = 0.f, xi = 0.f;
        LAS unsigned* zw = (LAS unsigned*)ZB + (bl * 128) * (ZS / 2) + p;
        for (int c0 = 0; c0 < 128; c0 += 8) {
            unsigned zv[8];
#pragma unroll
            for (int k = 0; k < 8; ++k) zv[k] = zw[(c0 + k) * (ZS / 2)];
#pragma unroll
            for (int k = 0; k < 8; ++k) {
                zw[(c0 + k) * (ZS / 2)] = cvt_pk_bf16(xr, xi);
                const float t = al.x * xr - al.y * xi + bf_lo(zv[k]); xi = al.x * xi + al.y * xr + bf_hi(zv[k]); xr = t;
            }
        }
    }
#pragma unroll
    for (int i = 0; i < 6; ++i) { const int c = tid + 512 * i, row = c / 48, kc = c % 48; *(LAS u32x4*)(WB + row * TS + kc * 8) = tmr[i]; }
    __syncthreads();
    bf16x8 Xf[2][4];
#pragma unroll
    for (int mt = 0; mt < 2; ++mt)
#pragma unroll
        for (int k2 = 0; k2 < 4; ++k2) Xf[mt][k2] = *(const LAS bf16x8*)(ZB + (32 * wave + 16 * mt + fr) * ZS + 32 * k2 + 8 * fq);
    const f32x4 dv = *(const f32x4*)(P.in[12] + g * 16 + 4 * fq);
#pragma unroll
    for (int cq = 0; cq < 4; ++cq) {
        if (cq < 3) {
#pragma unroll
            for (int i = 0; i < 6; ++i) { const int c = tid + 512 * i, row = c / 48, kc = c % 48; tmr[i] = *(const u32x4*)(TM + (size_t)(64 * (cq + 1) + row) * 384 + kc * 8); }
        }
#pragma unroll
        for (int ntl = 0; ntl < 4; ++ntl) {
            const int nt = 4 * cq + ntl;
            f32x4 a0 = {0.f, 0.f, 0.f, 0.f}, a1 = {0.f, 0.f, 0.f, 0.f};
            const LAS bf16_t* brow = WB + (16 * ntl + fr) * TS + 8 * fq;
#pragma unroll
            for (int ks = 0; ks < 8; ++ks) {
                if (2 * ks <= nt) {
                    const bf16x8 bf = *(const LAS bf16x8*)(brow + 32 * ks);
                    a0 = __builtin_amdgcn_mfma_f32_16x16x32_bf16(bf, Uf[0][ks], a0, 0, 0, 0);
                    a1 = __builtin_amdgcn_mfma_f32_16x16x32_bf16(bf, Uf[1][ks], a1, 0, 0, 0);
                }
            }
#pragma unroll
            for (int k2 = 0; k2 < 4; ++k2) {
                const bf16x8 bf = *(const LAS bf16x8*)(brow + 256 + 32 * k2);
                a0 = __builtin_amdgcn_mfma_f32_16x16x32_bf16(bf, Xf[0][k2], a0, 0, 0, 0);
                a1 = __builtin_amdgcn_mfma_f32_16x16x32_bf16(bf, Xf[1][k2], a1, 0, 0, 0);
            }
#pragma unroll
            for (int mt = 0; mt < 2; ++mt) {
                const f32x4 a = mt ? a1 : a0;
                const size_t tok = (size_t)(tok0[mt] + nt);
                const u32x2 uu = *(const u32x2*)(proj + tok * NPROJ + g * 16 + 4 * fq);
                const float y0 = a[0] + dv[0] * bf_lo(uu.x), y1 = a[1] + dv[1] * bf_hi(uu.x), y2 = a[2] + dv[2] * bf_lo(uu.y), y3 = a[3] + dv[3] * bf_hi(uu.y);
                u32x2 w; w.x = cvt_pk_bf16(gelu_tanh(y0), gelu_tanh(y1)); w.y = cvt_pk_bf16(gelu_tanh(y2), gelu_tanh(y3));
                *(u32x2*)(Zo + tok * 1024 + g * 16 + 4 * fq) = w;
            }
        }
        __syncthreads();
        if (cq < 3) {
#pragma unroll
            for (int i = 0; i < 6; ++i) { const int c = tid + 512 * i, row = c / 48, kc = c % 48; *(LAS u32x4*)(WB + row * TS + kc * 8) = tmr[i]; }
            __syncthreads();
        }
    }
}

__device__ __forceinline__ bf16x8 tr_frag(const LAS bf16_t* tile, int row0, int col0, int fr, int fq) {
    const LAS bf16_t* p = tile + (row0 + 8 * fq + (fr >> 2)) * 136 + col0 + 4 * (fr & 3);
    const bf16x4 a = __builtin_amdgcn_ds_read_tr16_b64_v4i16((LAS bf16x4*)p);
    const bf16x4 b = __builtin_amdgcn_ds_read_tr16_b64_v4i16((LAS bf16x4*)(p + 4 * 136));
    bf16x8 r; r[0] = a[0]; r[1] = a[1]; r[2] = a[2]; r[3] = a[3]; r[4] = b[0]; r[5] = b[1]; r[6] = b[2]; r[7] = b[3]; return r;
}
__device__ __forceinline__ void ret_kv_items(const Params& P, LAS unsigned char* lds, int tid, int first, int stride) {
    const int wave = __builtin_amdgcn_readfirstlane(tid >> 6), lane = tid & 63, fr = lane & 15, fq = lane >> 4;
    constexpr int RS = 136;
    LAS bf16_t* Ks = (LAS bf16_t*)lds; LAS bf16_t* Vs = Ks + 128 * RS;
    const bf16_t* proj = (const bf16_t*)(P.ws + WS_PROJ);
    bf16_t* KV = (bf16_t*)(P.ws + WS_KV);
    const int si = tid >> 2, part = tid & 3, i0 = 16 * wave;
    u32x4 kr[4], vr[4];
    int item = first;
    if (item >= 768) return;
    { const int bh = item / 12, n = item % 12; const bf16_t* pr = proj + ((size_t)(bh >> 3) * 2048 + n * 128 + si) * NPROJ + (bh & 7) * 128 + 32 * part;
#pragma unroll
      for (int j = 0; j < 4; ++j) { kr[j] = *(const u32x4*)(pr + 2048 + 8 * j); vr[j] = *(const u32x4*)(pr + 3072 + 8 * j); } }
    for (;;) {
#pragma unroll
        for (int j = 0; j < 4; ++j) { *(LAS u32x4*)(Ks + si * RS + 32 * part + 8 * j) = kr[j]; *(LAS u32x4*)(Vs + si * RS + 32 * part + 8 * j) = vr[j]; }
        __syncthreads();
        const int nxt = item + stride; const bool more = nxt < 768;
        if (more) { const int bh = nxt / 12, n = nxt % 12; const bf16_t* pr = proj + ((size_t)(bh >> 3) * 2048 + n * 128 + si) * NPROJ + (bh & 7) * 128 + 32 * part;
#pragma unroll
            for (int j = 0; j < 4; ++j) { kr[j] = *(const u32x4*)(pr + 2048 + 8 * j); vr[j] = *(const u32x4*)(pr + 3072 + 8 * j); } }
        bf16x8 Vt[4];
#pragma unroll
        for (int ks = 0; ks < 4; ++ks) Vt[ks] = tr_frag(Vs, 32 * ks, i0, fr, fq);
        const int bh = item / 12, n = item % 12;
        bf16_t* op = KV + ((size_t)(bh * 16 + n) * 128 + i0 + fr) * 128 + 4 * fq;
#pragma unroll
        for (int nt = 0; nt < 8; ++nt) {
            f32x4 a = {0.f, 0.f, 0.f, 0.f};
#pragma unroll
            for (int ks = 0; ks < 4; ++ks) { const bf16x8 kf = tr_frag(Ks, 32 * ks, 16 * nt, fr, fq); a = __builtin_amdgcn_mfma_f32_16x16x32_bf16(kf, Vt[ks], a, 0, 0, 0); }
            *(u32x2*)(op + 16 * nt) = (u32x2){cvt_pk_bf16(a[0], a[1]), cvt_pk_bf16(a[2], a[3])};
        }
        __syncthreads();
        if (!more) break;
        item = nxt;
    }
}
__device__ __forceinline__ void ret_out_item(const Params& P, LAS unsigned char* lds, int tid, int item) {
    const int bh = item >> 2, q = item & 3, b = bh >> 3, h = bh & 7;
    const int wave = __builtin_amdgcn_readfirstlane(tid >> 6), lane = tid & 63, fr = lane & 15, fq = lane >> 4;
    constexpr int RS = 136;
    LAS bf16_t* Qs = (LAS bf16_t*)lds;
    LAS bf16_t* Ks = Qs + 128 * RS;
    LAS bf16_t* Vs = Ks + 128 * RS;
    LAS bf16_t* Rs = Vs + 128 * RS;
    const bf16_t* proj = (const bf16_t*)(P.ws + WS_PROJ);
    const bf16_t* KV = (const bf16_t*)(P.ws + WS_KV);
    bf16_t* CAT = (bf16_t*)(P.ws + WS_CAT);
    const float gam = 1.0f - exp2f(-5.0f - (float)h);
    const float lg2 = log2f(gam);
    const float gC1 = exp2f(lg2 * 127.0f), gC = exp2f(lg2 * 128.0f);
    const int si = tid >> 2, part = tid & 3, i0 = 16 * wave;
    u32x4 st[12];
    { const bf16_t* pr = proj + ((size_t)b * 2048 + (4 * q) * 128 + si) * NPROJ + h * 128 + 32 * part;
#pragma unroll
      for (int j = 0; j < 4; ++j) { st[j] = *(const u32x4*)(pr + 1024 + 8 * j); st[4 + j] = *(const u32x4*)(pr + 2048 + 8 * j); st[8 + j] = *(const u32x4*)(pr + 3072 + 8 * j); } }
    f32x4 accR[8];
#pragma unroll
    for (int nt = 0; nt < 8; ++nt) accR[nt] = (f32x4){0.f, 0.f, 0.f, 0.f};
    for (int m = 0; m < 4 * q; ++m) {
        const bf16_t* tp = KV + ((size_t)(bh * 16 + m) * 128 + i0 + fr) * 128 + 4 * fq;
        u32x2 t[8];
#pragma unroll
        for (int nt = 0; nt < 8; ++nt) t[nt] = *(const u32x2*)(tp + 16 * nt);
#pragma unroll
        for (int nt = 0; nt < 8; ++nt) { const f32x4 kv = {bf_lo(t[nt].x), bf_hi(t[nt].x), bf_lo(t[nt].y), bf_hi(t[nt].y)}; accR[nt] = accR[nt] * gC + kv * gC1; }
    }
#pragma unroll
    for (int nt = 0; nt < 8; ++nt)
        *(LAS u32x2*)(Rs + (i0 + fr) * RS + 16 * nt + 4 * fq) = (u32x2){cvt_pk_bf16(accR[nt][0], accR[nt][1]), cvt_pk_bf16(accR[nt][2], accR[nt][3])};
    for (int nn = 0; nn < 4; ++nn) {
        const int n = 4 * q + nn;
#pragma unroll
        for (int j = 0; j < 4; ++j) { *(LAS u32x4*)(Qs + si * RS + 32 * part + 8 * j) = st[j]; *(LAS u32x4*)(Ks + si * RS + 32 * part + 8 * j) = st[4 + j]; *(LAS u32x4*)(Vs + si * RS + 32 * part + 8 * j) = st[8 + j]; }
        __syncthreads();
        if (nn < 3) { const bf16_t* pr = proj + ((size_t)b * 2048 + (n + 1) * 128 + si) * NPROJ + h * 128 + 32 * part;
#pragma unroll
            for (int j = 0; j < 4; ++j) { st[j] = *(const u32x4*)(pr + 1024 + 8 * j); st[4 + j] = *(const u32x4*)(pr + 2048 + 8 * j); st[8 + j] = *(const u32x4*)(pr + 3072 + 8 * j); } }
        const size_t tok = (size_t)b * 2048 + n * 128 + i0 + fr;
        u32x2 gg[8];
        { const bf16_t* gp = proj + tok * NPROJ + 4096 + h * 128 + 4 * fq;
#pragma unroll
          for (int nt = 0; nt < 8; ++nt) gg[nt] = *(const u32x2*)(gp + 16 * nt); }
        bf16x8 Qf[4];
#pragma unroll
        for (int ks = 0; ks < 4; ++ks) Qf[ks] = *(const LAS bf16x8*)(Qs + (i0 + fr) * RS + 32 * ks + 8 * fq);
        f32x4 accS[8], accO[8];
#pragma unroll
        for (int nt = 0; nt < 8; ++nt) { accS[nt] = (f32x4){0.f, 0.f, 0.f, 0.f}; accO[nt] = (f32x4){0.f, 0.f, 0.f, 0.f}; }
#pragma unroll
        for (int nt = 0; nt < 8; ++nt) {
            if (nt <= wave) {
#pragma unroll
                for (int ks = 0; ks < 4; ++ks) { const bf16x8 kf = *(const LAS bf16x8*)(Ks + (16 * nt + fr) * RS + 32 * ks + 8 * fq); accS[nt] = __builtin_amdgcn_mfma_f32_16x16x32_bf16(kf, Qf[ks], accS[nt], 0, 0, 0); }
            }
        }
        if (n > 0) {
#pragma unroll
            for (int nt = 0; nt < 8; ++nt) {
#pragma unroll
                for (int ks = 0; ks < 4; ++ks) { const bf16x8 rf = *(const LAS bf16x8*)(Rs + (16 * nt + fr) * RS + 32 * ks + 8 * fq); accO[nt] = __builtin_amdgcn_mfma_f32_16x16x32_bf16(rf, Qf[ks], accO[nt], 0, 0, 0); }
                accO[nt] *= gam;
            }
        }
#pragma unroll
        for (int nt = 0; nt < 8; ++nt) {
            const int i = i0 + fr, j0 = 16 * nt + 4 * fq;
            const float p0 = (j0 <= i) ? accS[nt][0] : 0.f, p1 = (j0 + 1 <= i) ? accS[nt][1] : 0.f, p2 = (j0 + 2 <= i) ? accS[nt][2] : 0.f, p3 = (j0 + 3 <= i) ? accS[nt][3] : 0.f;
            *(LAS u32x2*)(Qs + i * RS + j0) = (u32x2){cvt_pk_bf16(p0, p1), cvt_pk_bf16(p2, p3)};
        }
        asm volatile("" ::: "memory");
        bf16x8 Pf[4];
#pragma unroll
        for (int ks = 0; ks < 4; ++ks) Pf[ks] = *(const LAS bf16x8*)(Qs + (i0 + fr) * RS + 32 * ks + 8 * fq);
#pragma unroll
        for (int ks = 0; ks < 4; ++ks) {
            if (2 * ks <= wave) {
#pragma unroll
                for (int nt = 0; nt < 8; ++nt) { const bf16x8 vf = tr_frag(Vs, 32 * ks, 16 * nt, fr, fq); accO[nt] = __builtin_amdgcn_mfma_f32_16x16x32_bf16(vf, Pf[ks], accO[nt], 0, 0, 0); }
            }
        }
        if (nn < 3) {
            bf16x8 Vt[4];
#pragma unroll
            for (int ks = 0; ks < 4; ++ks) Vt[ks] = tr_frag(Vs, 32 * ks, i0, fr, fq);
#pragma unroll
            for (int nt = 0; nt < 8; ++nt) {
                accR[nt] *= gam;
#pragma unroll
                for (int ks = 0; ks < 4; ++ks) { const bf16x8 kf = tr_frag(Ks, 32 * ks, 16 * nt, fr, fq); accR[nt] = __builtin_amdgcn_mfma_f32_16x16x32_bf16(kf, Vt[ks], accR[nt], 0, 0, 0); }
                accR[nt] *= gC1;
            }
        }
        {
            float s = 0.f;
#pragma unroll
            for (int nt = 0; nt < 8; ++nt) s += (accO[nt][0] + accO[nt][1]) + (accO[nt][2] + accO[nt][3]);
            s += __shfl_xor(s, 16); s += __shfl_xor(s, 32);
            const float mu = s * (1.0f / 128.0f); float qv = 0.f;
#pragma unroll
            for (int nt = 0; nt < 8; ++nt) { const f32x4 d = accO[nt] - mu; qv += (d[0] * d[0] + d[1] * d[1]) + (d[2] * d[2] + d[3] * d[3]); }
            qv += __shfl_xor(qv, 16); qv += __shfl_xor(qv, 32);
            const float rstd = rsqrtf(qv * (1.0f / 128.0f) + 1e-5f);
            bf16_t* op = CAT + tok * DM + 1024 + h * 128 + 4 * fq;
#pragma unroll
            for (int nt = 0; nt < 8; ++nt) {
                const float g0 = bf_lo(gg[nt].x), g1 = bf_hi(gg[nt].x), g2 = bf_lo(gg[nt].y), g3 = bf_hi(gg[nt].y);
                const f32x4 y = (accO[nt] - mu) * rstd;
                u32x2 w; w.x = cvt_pk_bf16(y[0] * g0 * sigmoidf_(g0), y[1] * g1 * sigmoidf_(g1)); w.y = cvt_pk_bf16(y[2] * g2 * sigmoidf_(g2), y[3] * g3 * sigmoidf_(g3));
                *(u32x2*)(op + 16 * nt) = w;
            }
        }
        __syncthreads();
        if (nn < 3) {
#pragma unroll
            for (int nt = 0; nt < 8; ++nt)
                *(LAS u32x2*)(Rs + (i0 + fr) * RS + 16 * nt + 4 * fq) = (u32x2){cvt_pk_bf16(accR[nt][0], accR[nt][1]), cvt_pk_bf16(accR[nt][2], accR[nt][3])};
        }
    }
}

__device__ __forceinline__ void p6_route(const Params& P, LAS unsigned char* lds, int tid, int blk, int G) {
    const int wave = __builtin_amdgcn_readfirstlane(tid >> 6), lane = tid & 63, fr = lane & 15, fq = lane >> 4;
    LAS float* gm = (LAS float*)lds; LAS float* sh = gm + 2048; LAS float* lg = sh + 2048;
    LAS int* lcnt = (LAS int*)(lg + 2 * 64 * 48); LAS int* lbase = lcnt + 32;
    int ra_ = 0, rb_ = 0, ea_ = 0, eb_ = 0; float w1_ = 0.f, w2_ = 0.f;
    const float* mod = (const float*)(P.ws + WS_MOD);
    const bf16_t* x1 = (const bf16_t*)(P.ws + WS_X1); const float* rowss2 = (const float*)(P.ws + WS_ROWSS2);
    bf16_t* H2 = (bf16_t*)(P.ws + WS_H);
    const bf16_t* WR = (const bf16_t*)(P.ws + WS_WR);
    int* cnt = (int*)(P.ws + WS_CNT); int* list = (int*)(P.ws + WS_LIST); float* wgt = (float*)(P.ws + WS_WGT);
    for (int rb = blk; rb < 256; rb += G) {
        const int b = rb >> 5;
        for (int k = tid; k < 2048; k += NTHREADS) { gm[k] = P.in[18][k] * (1.0f + mod[(size_t)b * NMOD + 4 * DM + k]); sh[k] = mod[(size_t)b * NMOD + 3 * DM + k]; }
        if (tid < 32) lcnt[tid] = 0;
        __syncthreads();
        const int mt = wave & 3, kh = wave >> 2;
        const int row = rb * 64 + 16 * mt + fr;
        float tot2 = 0.f;
        { const f32x4* pp = (const f32x4*)(rowss2 + (size_t)row * 32);
#pragma unroll
          for (int i = 0; i < 8; ++i) { const f32x4 v = pp[i]; tot2 += (v[0] + v[1]) + (v[2] + v[3]); } }
        const float r2 = rsqrtf(tot2 * (1.0f / 2048.0f) + 1e-6f);
        f32x4 acc[3];
#pragma unroll
        for (int nt = 0; nt < 3; ++nt) acc[nt] = (f32x4){0.f, 0.f, 0.f, 0.f};
#pragma unroll 4
        for (int ks = 0; ks < 32; ++ks) {
            const int k0 = 1024 * kh + 32 * ks + 8 * fq;
            const u32x4 xw = *(const u32x4*)(x1 + (size_t)row * DM + k0);
            const f32x4 a = {bf_lo(xw.x), bf_hi(xw.x), bf_lo(xw.y), bf_hi(xw.y)}, c = {bf_lo(xw.z), bf_hi(xw.z), bf_lo(xw.w), bf_hi(xw.w)};
            const f32x4 g0 = *(const LAS f32x4*)(gm + k0), g1 = *(const LAS f32x4*)(gm + k0 + 4), s0 = *(const LAS f32x4*)(sh + k0), s1 = *(const LAS f32x4*)(sh + k0 + 4);
            const f32x4 h0 = a * r2 * g0 + s0, h1 = c * r2 * g1 + s1;
            u32x4 w; w.x = cvt_pk_bf16(h0[0], h0[1]); w.y = cvt_pk_bf16(h0[2], h0[3]); w.z = cvt_pk_bf16(h1[0], h1[1]); w.w = cvt_pk_bf16(h1[2], h1[3]);
            *(u32x4*)(H2 + (size_t)row * DM + k0) = w;
            const bf16x8 af = __builtin_bit_cast(bf16x8, w);
#pragma unroll
            for (int nt = 0; nt < 3; ++nt) { const bf16x8 bf = *(const bf16x8*)(WR + (size_t)(16 * nt + fr) * 2048 + k0); acc[nt] = __builtin_amdgcn_mfma_f32_16x16x32_bf16(bf, af, acc[nt], 0, 0, 0); }
        }
#pragma unroll
        for (int nt = 0; nt < 3; ++nt) *(LAS f32x4*)(lg + (kh * 64 + 16 * mt + fr) * 48 + 16 * nt + 4 * fq) = acc[nt];
        __syncthreads();
        if (tid < 64) {
            const int tok = rb * 64 + tid;
            float l[36];
#pragma unroll
            for (int nn = 0; nn < 36; ++nn) l[nn] = lg[tid * 48 + nn] + lg[(64 + tid) * 48 + nn];
            float gl[4]; int gs = 0;
#pragma unroll
            for (int j = 0; j < 4; ++j) gl[j] = l[j] + P.in[20][j];
#pragma unroll
            for (int j = 1; j < 4; ++j) if (gl[j] > gl[gs]) gs = j;
            float gmax = gl[0];
#pragma unroll
            for (int j = 1; j < 4; ++j) gmax = fmaxf(gmax, gl[j]);
            float den = 0.f;
#pragma unroll
            for (int j = 0; j < 4; ++j) den += expf(gl[j] - gmax);
            const float gw = 1.0f / den;
            float el[8];
#pragma unroll
            for (int j = 0; j < 8; ++j) { float v = 0.f;
#pragma unroll
                for (int q = 0; q < 4; ++q) v = (gs == q) ? (l[4 + q * 8 + j] + P.in[22][q * 8 + j]) : v;
                el[j] = v; }
            int j1 = 0;
#pragma unroll
            for (int j = 1; j < 8; ++j) if (el[j] > el[j1]) j1 = j;
            int j2 = (j1 == 0) ? 1 : 0;
#pragma unroll
            for (int j = 0; j < 8; ++j) if (j != j1 && j != j2 && el[j] > el[j2]) j2 = j;
            float e1 = el[0], e2 = el[0];
#pragma unroll
            for (int j = 0; j < 8; ++j) { e1 = (j == j1) ? el[j] : e1; e2 = (j == j2) ? el[j] : e2; }
            const float t2 = expf(e2 - e1), w1 = gw / (1.0f + t2), w2 = gw * t2 / (1.0f + t2);
            const int ea = gs * 8 + j1, eb = gs * 8 + j2;
            ra_ = atomicAdd((int*)&lcnt[ea], 1); rb_ = atomicAdd((int*)&lcnt[eb], 1); ea_ = ea; eb_ = eb; w1_ = w1; w2_ = w2;
        }
        __syncthreads();
        if (tid < 32) { const int c = lcnt[tid]; lbase[tid] = c > 0 ? atomicAdd(cnt + tid * 64, c) : 0; }
        __syncthreads();
        if (tid < 64) {
            const int tok = rb * 64 + tid;
            list[ea_ * 16384 + lbase[ea_] + ra_] = tok * 2; wgt[tok * 2] = w1_;
            list[eb_ * 16384 + lbase[eb_] + rb_] = tok * 2 + 1; wgt[tok * 2 + 1] = w2_;
        }
        __syncthreads();
    }
}

__device__ __forceinline__ void p9_final(const Params& P, int tid, int blk, int G) {
    const int wave = tid >> 6, lane = tid & 63;
    const float* mod = (const float*)(P.ws + WS_MOD); const bf16_t* Y2 = (const bf16_t*)(P.ws + WS_Y2);
    for (int row = blk * 8 + wave; row < NTOK; row += G * 8) {
        const int b = row >> 11;
        float* xr = P.out + (size_t)row * DM;
        const bf16_t* x1r = (const bf16_t*)(P.ws + WS_X1) + (size_t)row * DM;
        f32x4 v[8]; float ss = 0.f;
#pragma unroll
        for (int i = 0; i < 8; ++i) {
            const int k = (i * 64 + lane) * 4;
            const u32x2 xw = *(const u32x2*)(x1r + k);
            const f32x4 xv = {bf_lo(xw.x), bf_hi(xw.x), bf_lo(xw.y), bf_hi(xw.y)};
            const u32x2 ya = *(const u32x2*)(Y2 + (size_t)(2 * row) * DM + k), yb = *(const u32x2*)(Y2 + (size_t)(2 * row + 1) * DM + k);
            const f32x4 gt = *(const f32x4*)(mod + (size_t)b * NMOD + 5 * DM + k);
            f32x4 y; y[0] = bf_lo(ya.x) + bf_lo(yb.x); y[1] = bf_hi(ya.x) + bf_hi(yb.x); y[2] = bf_lo(ya.y) + bf_lo(yb.y); y[3] = bf_hi(ya.y) + bf_hi(yb.y);
            v[i] = xv + gt * y;
            ss += v[i][0] * v[i][0] + v[i][1] * v[i][1] + v[i][2] * v[i][2] + v[i][3] * v[i][3];
        }
        ss = wave_sum(ss);
        const float r = rsqrtf(ss * (1.0f / 2048.0f) + 1e-6f);
#pragma unroll
        for (int i = 0; i < 8; ++i) { const int k = (i * 64 + lane) * 4; const f32x4 gf = *(const f32x4*)(P.in[26] + k); *(f32x4*)(xr + k) = v[i] * r * gf; }
    }
}

__global__ void __launch_bounds__(NTHREADS, 2) hymba_fwd(Params P) {
    extern __shared__ __attribute__((aligned(16))) unsigned char lds_raw[];
    LAS unsigned char* lds = (LAS unsigned char*)lds_raw;
    const int tid = threadIdx.x, blk = blockIdx.x, G = gridDim.x;
    volatile LAS unsigned* misc = (volatile LAS unsigned*)(lds + LDS_MISC);
    if (tid < 64) misc[tid] = 0u;
    __syncthreads();
    XcdBarrier bar = xcd_barrier_post((unsigned*)(P.ws + WS_BAR), misc);
    const int lo = P.ph_lo, hi = P.ph_hi;
#define IN(k) (lo <= (k) && (k) < hi)
#define SEAM(k) do { if (IN(k) && IN((k) + 1)) xcd_barrier(bar); } while (0)
    unsigned char* ws = P.ws;

#ifndef REPR
#define REPR 1
#endif
#ifndef REPS
#define REPS 1
#endif
#ifndef REP0
#define REP0 1
#endif
#ifndef REP2
#define REP2 1
#endif
#ifndef REP7
#define REP7 1
#endif
#ifndef REP8
#define REP8 1
#endif
    if (IN(0)) for (int rep0 = 0; rep0 < REP0; ++rep0) {
        for (int it = blk; it < 256; it += G) p0_adaln(P, lds, tid, it);
        for (int it = blk; it < 256; it += G) p0_ssm_mats(P, lds, tid, it);
        p0_misc(P, tid, blk, G);
        p0_convert(P, lds, tid, blk, G);
    }
    SEAM(0);
    if (IN(1)) p1_norm1(P, lds, tid, blk, G);
    SEAM(1);
    if (IN(2)) for (int rep2 = 0; rep2 < REP2; ++rep2) {
        DenseSched S; S.init(NTOK, NPROJ, G, blk); S.abase = (unsigned)WS_H; S.bbase = (unsigned)WS_WIN; S.lda = DM; S.ldb = DM;
        EpiInProj E{(bf16_t*)(ws + WS_PROJ), (const f32x2*)(ws + WS_ROPE)};
        g8::gemm_phase(lds, ws, DM / 64, DM, S, E);
    }
    SEAM(2);
    if (IN(3)) {
        for (int it = blk; it < 256; it += G) ssm_item(P, lds, tid, it);
        ret_kv_items(P, lds, tid, blk, G);
    }
    SEAM(3);
    if (IN(4)) {
        for (int it = blk; it < 256; it += G) ret_out_item(P, lds, tid, it);
        __syncthreads();
        DenseSched S; S.init(NTOK, 1024, G, blk); S.abase = (unsigned)WS_Z; S.bbase = (unsigned)WS_WGLU; S.lda = 1024; S.ldb = 1024;
        EpiGlu E{(const bf16_t*)(ws + WS_Z), (bf16_t*)(ws + WS_CAT), (float*)(ws + WS_ROWSS1)};
        g8::gemm_phase(lds, ws, 1024 / 64, 1024, S, E);
    }
    SEAM(4);
    if (IN(5)) {
        OutSched S; S.init(NTOK, DM, G, blk); S.abase = (unsigned)WS_CAT; S.bbase = (unsigned)WS_WOUT;
        EpiOut E{P.in[0], (const float*)(ws + WS_MOD), (const float*)(ws + WS_ROWSS1), (float*)(ws + WS_ROWSS2), (bf16_t*)(ws + WS_X1)};
        g8::gemm_phase(lds, ws, 1024 / 64, DM, S, E);
    }
    SEAM(5);
    if (IN(6)) p6_route(P, lds, tid, blk, G);
    SEAM(6);
    if (IN(7) || IN(8)) {
        LAS int* tinfo = (LAS int*)(lds + LDS_MISC + 256); LAS int* trows = tinfo + 192; LAS int* ntl = trows + 192;
        if (tid == 0) {
            const int* cg = (const int*)(ws + WS_CNT); int nt_ = 0;
            for (int e = 0; e < 32; ++e) { const int c = cg[e * 64], full = c >> 8, rem = c & 255;
                for (int t = 0; t < full; ++t) { tinfo[nt_] = e | ((t * 256) << 8); trows[nt_] = 256; ++nt_; }
                if (rem > 128) { tinfo[nt_] = e | ((full * 256) << 8); trows[nt_] = rem; ++nt_; } }
            for (int e = 0; e < 32; ++e) { const int c = cg[e * 64], full = c >> 8, rem = c & 255; if (rem > 64 && rem <= 128) { tinfo[nt_] = e | ((full * 256) << 8); trows[nt_] = rem; ++nt_; } }
            for (int e = 0; e < 32; ++e) { const int c = cg[e * 64], full = c >> 8, rem = c & 255; if (rem > 0 && rem <= 64) { tinfo[nt_] = e | ((full * 256) << 8); trows[nt_] = rem; ++nt_; } }
            ntl[0] = nt_;
        }
        __syncthreads();
        const int ntiles = __builtin_amdgcn_readfirstlane(ntl[0]);
        if (IN(7)) {
            MoeSched S{tinfo, trows, ntiles, G, blk, (const int*)(ws + WS_LIST), (unsigned)WS_H, (unsigned)WS_WGU, 0};
            EpiMoe1 E{(bf16_t*)(ws + WS_HM)};
            for (int r_ = 0; r_ < REP7; ++r_) g8::gemm_phase<EpiMoe1, MoeSched, true>(lds, ws, DM / 64, DM, S, E);
        }
        SEAM(7);
        if (IN(8)) {
            MoeSched S{tinfo, trows, ntiles, G, blk, (const int*)(ws + WS_LIST), (unsigned)WS_HM, (unsigned)WS_WD, 1};
            EpiMoe2 E{(const int*)(ws + WS_LIST), (const float*)(ws + WS_WGT), (bf16_t*)(ws + WS_Y2)};
            for (int r_ = 0; r_ < REP8; ++r_) g8::gemm_phase<EpiMoe2, MoeSched, true>(lds, ws, DEXP / 64, DEXP, S, E);
        }
    }
    SEAM(8);
    if (IN(9)) p9_final(P, tid, blk, G);
#undef IN
#undef SEAM
}

#ifndef N_LAUNCH_SPLIT
#define N_LAUNCH_SPLIT 0
#endif
extern "C" void kernel_launch(void* const* d_in, const int* in_sizes, int n_in, void* d_out, int out_size, void* d_ws, size_t ws_size, hipStream_t stream) {
    static int grid = 0;
    if (grid == 0) {
        if (n_in != 27 || out_size != NTOK * DM || ws_size < WS_END) { fprintf(stderr, "kernel_launch: unexpected shapes (n_in %d out %d ws %zu need %zu)\n", n_in, out_size, ws_size, (size_t)WS_END); grid = -1; return; }
        int dev = 0, cus = 0, per_cu = 0;
        if (hipGetDevice(&dev) != hipSuccess || hipDeviceGetAttribute(&cus, hipDeviceAttributeMultiprocessorCount, dev) != hipSuccess) { grid = -1; return; }
        if (hipFuncSetAttribute((const void*)hymba_fwd, hipFuncAttributeMaxDynamicSharedMemorySize, LDS_BYTES) != hipSuccess) { fprintf(stderr, "kernel_launch: hipFuncSetAttribute failed\n"); grid = -1; return; }
        if (hipOccupancyMaxActiveBlocksPerMultiprocessor(&per_cu, (const void*)hymba_fwd, NTHREADS, LDS_BYTES) != hipSuccess || per_cu < 1) { fprintf(stderr, "kernel_launch: occupancy query says %d\n", per_cu); }
        (void)hipGetLastError();
        grid = cus;
    }
    if (grid < 0) return;
    (void)hipMemsetAsync((char*)d_ws + WS_BAR, 0, 16384, stream);
    Params p{};
    for (int i = 0; i < 27; ++i) p.in[i] = (const float*)d_in[i];
    p.out = (float*)d_out; p.ws = (unsigned char*)d_ws;
#if N_LAUNCH_SPLIT
    for (int ph = 0; ph < 10; ++ph) { p.ph_lo = ph; p.ph_hi = ph + 1; hipLaunchKernelGGL(hymba_fwd, dim3(grid), dim3(NTHREADS), LDS_BYTES, stream, p); }
#else
    p.ph_lo = 0; p.ph_hi = 10;
    hipLaunchKernelGGL(hymba_fwd, dim3(grid), dim3(NTHREADS), LDS_BYTES, stream, p);
#endif
    const hipError_t le = hipPeekAtLastError();
    if (le != hipSuccess) fprintf(stderr, "kernel_launch: launch failed: %s\n", hipGetErrorName(le));
}
```

```cpp
#include <hip/hip_runtime.h>
#include <cstdio>
#include <cstdint>

#define LAS __attribute__((address_space(3)))
typedef unsigned short bf16_t;
typedef short bf16x8 __attribute__((ext_vector_type(8)));
typedef short bf16x4 __attribute__((ext_vector_type(4)));
typedef float f32x4 __attribute__((ext_vector_type(4)));
typedef float f32x2 __attribute__((ext_vector_type(2)));
typedef unsigned u32x4 __attribute__((ext_vector_type(4)));
typedef unsigned u32x2 __attribute__((ext_vector_type(2)));

constexpr int DM = 2048, NB = 8, SEQ = 2048, NTOK = NB * SEQ;
constexpr int NPROJ = 5120;
constexpr int NMOD = 6 * DM;
constexpr int NEXP = 32, DEXP = 1024;
constexpr int NTHREADS = 512;

constexpr size_t WS_BAR   = 0;
constexpr size_t WS_CNT   = 16384;
constexpr size_t WS_ROWSS1= WS_CNT + 8192;
constexpr size_t WS_ROWSS2= WS_ROWSS1 + (size_t)16384 * 16 * 4;
constexpr size_t WS_MODP  = WS_ROWSS2 + (size_t)16384 * 32 * 4;
constexpr size_t WS_MOD   = WS_MODP + (size_t)4 * 8 * NMOD * 4;
constexpr size_t WS_ROPE  = WS_MOD + (size_t)8 * NMOD * 4;
constexpr size_t WS_SSMA  = WS_ROPE + (size_t)2048 * 64 * 8;
constexpr size_t WS_WR    = WS_SSMA + (size_t)64 * 64 * 8;
constexpr size_t WS_SSMM  = WS_WR + (size_t)48 * 2048 * 2;
constexpr size_t WS_WIN   = WS_SSMM + (size_t)64 * 131072 * 2;
constexpr size_t WS_WOUT  = WS_WIN + (size_t)NPROJ * DM * 2;
constexpr size_t WS_WGLU  = WS_WOUT + (size_t)DM * DM * 2;
constexpr size_t WS_WGU   = WS_WGLU + (size_t)1024 * 1024 * 2;
constexpr size_t WS_WD    = WS_WGU + (size_t)NEXP * 2048 * 2048 * 2;
constexpr size_t WS_H     = WS_WD + (size_t)NEXP * 2048 * 1024 * 2;
constexpr size_t WS_PROJ  = WS_H + (size_t)NTOK * DM * 2;
constexpr size_t WS_Z     = WS_PROJ + (size_t)NTOK * NPROJ * 2;
constexpr size_t WS_CAT   = WS_Z + (size_t)NTOK * 1024 * 2;
constexpr size_t WS_WGT   = WS_CAT + (size_t)NTOK * DM * 2;
constexpr size_t WS_LIST  = WS_WGT + (size_t)32768 * 4;
constexpr size_t WS_X1    = WS_LIST + (size_t)32 * 16384 * 4;
constexpr size_t WS_END   = WS_X1 + (size_t)NTOK * DM * 2;
constexpr size_t WS_Y2    = WS_PROJ;
constexpr size_t WS_HM    = WS_Z;

constexpr int LDS_STAGE = 131072;
constexpr int LDS_BYTES = 147456;
constexpr int LDS_MISC  = LDS_BYTES - 2048;

struct Params { const float* in[27]; float* out; unsigned char* ws; int ph_lo, ph_hi; };

#define XB_TMO      128
#define XB_XCNT(j)  (256  + 64 * (j))
#define XB_XSUB(j)  (1280 + 64 * (j))
#define XB_XGEN(j)  (2304 + 64 * (j))
#define XB_TOP      3328
#define XB_TOPGEN   3392
#define XCD_BAR_WORDS 3456
#define XB_SPIN_CAP (1u << 22)

__device__ __forceinline__ unsigned xb_ld(unsigned* p)              { return __hip_atomic_load(p, __ATOMIC_RELAXED, __HIP_MEMORY_SCOPE_AGENT); }
__device__ __forceinline__ unsigned xb_add(unsigned* p, unsigned v) { return __hip_atomic_fetch_add(p, v, __ATOMIC_RELAXED, __HIP_MEMORY_SCOPE_AGENT); }
__device__ __forceinline__ unsigned xb_xcc_id() { return (unsigned)__builtin_amdgcn_s_getreg((3 << 11) | 20) & 0xFu; }
#define XB_SPIN(cond, bar) do { unsigned _sp = 0; while (cond) { __builtin_amdgcn_s_sleep(1); \
    if ((++_sp & 255u) == 0u) { if (xb_ld(&(bar)[XB_TMO])) break; if (_sp > XB_SPIN_CAP) { atomicAdd(&(bar)[XB_TMO], 1u); break; } } } } while (0)

struct XcdBarrier { unsigned* bar; unsigned x; volatile LAS unsigned* st; };

__device__ __forceinline__ XcdBarrier xcd_barrier_post(unsigned* bar, volatile LAS unsigned* st) {
    XcdBarrier b; b.bar = bar; b.x = xb_xcc_id(); b.st = st;
    if (threadIdx.x == 0) (void)xb_add(&bar[XB_XCNT(b.x)], 1u);
    return b;
}
__device__ __forceinline__ void xcd_barrier_complete(unsigned* bar, unsigned x, unsigned& nloc, unsigned& nx) {
    const unsigned G = gridDim.x * gridDim.y * gridDim.z;
    unsigned sum, cnt, mine, sp = 0u;
    for (;;) {
        sum = 0u; cnt = 0u; mine = 0u;
#pragma unroll
        for (unsigned j = 0; j < 16; ++j) { const unsigned c = xb_ld(&bar[XB_XCNT(j)]); sum += c; cnt += (c > 0u) ? 1u : 0u; mine = (j == x) ? c : mine; }
        if (sum == G) break;
        __builtin_amdgcn_s_sleep(1);
        if ((++sp & 255u) == 0u) { if (xb_ld(&bar[XB_TMO])) break; if (sp > XB_SPIN_CAP) { atomicAdd(&bar[XB_TMO], 1u); break; } }
    }
    nloc = mine > 0u ? mine : 1u; nx = cnt > 0u ? cnt : 1u;
}
__device__ __forceinline__ void xcd_barrier(const XcdBarrier& b) {
    asm volatile("s_waitcnt vmcnt(0)" ::: "memory");
    __syncthreads();
    if (threadIdx.x == 0) {
        unsigned* bar = b.bar;
        __builtin_amdgcn_s_waitcnt(0);
        unsigned nloc = b.st[0], nx = b.st[1];
        if (nloc == 0u) { xcd_barrier_complete(bar, b.x, nloc, nx); b.st[0] = nloc; b.st[1] = nx; }
        const unsigned old = xb_add(&bar[XB_XSUB(b.x)], 1u);
        const unsigned gen = old / nloc;
        if (old + 1u == (gen + 1u) * nloc) {
            __builtin_amdgcn_fence(__ATOMIC_RELEASE, "agent");
            asm volatile("s_waitcnt vmcnt(0)" ::: "memory");
            const unsigned og = xb_add(&bar[XB_TOP], 1u);
            const unsigned tg = og / nx;
            if (og + 1u == (tg + 1u) * nx) xb_add(&bar[XB_TOPGEN], 1u);
            else XB_SPIN(xb_ld(&bar[XB_TOPGEN]) == tg, bar);
            __builtin_amdgcn_fence(__ATOMIC_ACQUIRE, "agent");
            xb_add(&bar[XB_XGEN(b.x)], 1u);
            asm volatile("s_waitcnt vmcnt(0)" ::: "memory");
        } else {
            XB_SPIN(xb_ld(&bar[XB_XGEN(b.x)]) == gen, bar);
            __builtin_amdgcn_fence(__ATOMIC_ACQUIRE, "agent");
            asm volatile("s_waitcnt vmcnt(0)" ::: "memory");
        }
    }
    __syncthreads();
}

typedef __bf16 bf16x2_t __attribute__((ext_vector_type(2)));
__device__ __forceinline__ unsigned cvt_pk_bf16(float lo, float hi) { const f32x2 v = {lo, hi}; return __builtin_bit_cast(unsigned, __builtin_convertvector(v, bf16x2_t)); }
__device__ __forceinline__ float bf_lo(unsigned w) { return __uint_as_float(w << 16); }
__device__ __forceinline__ float bf_hi(unsigned w) { return __uint_as_float(w & 0xffff0000u); }
__device__ __forceinline__ float sigmoidf_(float x) { return 1.0f / (1.0f + __expf(-x)); }
__device__ __forceinline__ float gelu_tanh(float x) {
    const float u = 0.7978845608028654f * (x + 0.044715f * x * x * x);
    const float t = 1.0f - 2.0f / (1.0f + __expf(2.0f * u));
    return 0.5f * x * (1.0f + t);
}
__device__ __forceinline__ float wave_sum(float v) {
    v += __shfl_xor(v, 1); v += __shfl_xor(v, 2); v += __shfl_xor(v, 4); v += __shfl_xor(v, 8); v += __shfl_xor(v, 16); v += __shfl_xor(v, 32); return v;
}
__device__ __forceinline__ void sincos_d(double x, double& s, double& c) {
    const double TWO_PI = 6.283185307179586476925286766559;
    double r = x - TWO_PI * rint(x / TWO_PI);
    const double r2 = r * r;
    double ts = r, tc = 1.0; s = r; c = 1.0;
#pragma unroll 1
    for (int k = 1; k <= 14; ++k) { tc *= -r2 / (double)((2 * k - 1) * (2 * k)); ts *= -r2 / (double)((2 * k) * (2 * k + 1)); c += tc; s += ts; }
}

namespace g8 {
constexpr int BM = 256, BK = 64, HALF = 128, HTB = HALF * BK * 2, NXCD = 8, WGM = 8;
__device__ __forceinline__ int lds_byte(int r, int c) { const int st = (r >> 4) * 2 + (c >> 5), rr = r & 15, cc = c & 31, ob = rr * 64 + cc * 2; return st * 1024 + (ob ^ (((ob >> 9) & 1) << 5)); }
__device__ __forceinline__ void stage_rc(int b, int& R, int& C) { const int st = b / 1024, sb = b % 1024, swz = sb ^ (((sb >> 9) & 1) << 5); R = (st >> 1) * 16 + swz / 64; C = (st & 1) * 32 + (swz % 64) / 2; }
__device__ __forceinline__ int perm32(int rho) { const int n = rho >> 4, i = rho & 15; return 8 * (i >> 2) + 4 * n + (i & 3); }

struct Unit { unsigned aoff, boff; int pm, pn, flags, aux, aux2; };
typedef f32x4 Acc[2][2][4][2];

struct StaticOrder {
    int nM, nN, nwg, G, c;
    __device__ void init(int M, int N, int G_, int c_) { nM = M / BM; nN = N / BM; nwg = nM * nN; G = G_; c = c_; }
    __device__ __forceinline__ bool tile(int i, int& pm, int& pn) const {
        const long L = (long)i * G + c; if (L >= nwg) return false;
        int wgid = (int)L; { const int q = nwg / NXCD, r = nwg % NXCD, xcd = wgid % NXCD, off = wgid / NXCD; wgid = (xcd < r ? xcd * (q + 1) : r * (q + 1) + (xcd - r) * q) + off; }
        const int nig = WGM * nN, gid = wgid / nig, fm = gid * WGM, gsz = (nM - fm) < WGM ? (nM - fm) : WGM;
        pm = fm + ((wgid % nig) % gsz); pn = (wgid % nig) / gsz; return true;
    }
};

template <class Epi, class Sched, bool SKIP = false>
__device__ __forceinline__ void gemm_phase(LAS unsigned char* lds, const unsigned char* ws, const int nt, const int ldb  , const Sched& S, const Epi& E) {
    const int tid = threadIdx.x, wid = __builtin_amdgcn_readfirstlane(tid >> 6), lane = tid & 63, wr = wid >> 2, wc = wid & 3, fr = lane & 15, fq = lane >> 4;
    int R0, C0, R1, C1; stage_rc(tid * 16, R0, C0); stage_rc(tid * 16 + 8192, R1, C1);
    unsigned voffB[2];
    { const int Rb0 = Epi::PERM ? ((R0 & ~31) + perm32(R0 & 31)) : R0, Rb1 = Epi::PERM ? ((R1 & ~31) + perm32(R1 & 31)) : R1;
      voffB[0] = (unsigned)(Rb0 * ldb + C0) * 2u; voffB[1] = (unsigned)(Rb1 * ldb + C1) * 2u; }
    const unsigned kstep = (unsigned)(BK * 2);
    const unsigned hstepB = (unsigned)HALF * (unsigned)ldb * 2u;
    const unsigned ldsw = (unsigned)wid * 1024u;
    const int aoff = lds_byte(wr * 64 + fr, fq * 8), boff = lds_byte(wc * 32 + fr, fq * 8);
#define G8_SA(b, h) (((b) * 2 + (h)) * HTB)
#define G8_SB(b, h) ((4 + (b) * 2 + (h)) * HTB)
#define G8_STAGE(bufoff, gbase, v0, v1) do { \
        __builtin_amdgcn_global_load_lds((const unsigned*)((gbase) + (v0)), (LAS unsigned*)(lds + (bufoff) + ldsw), 16, 0, 0); \
        __builtin_amdgcn_global_load_lds((const unsigned*)((gbase) + (v1)), (LAS unsigned*)(lds + (bufoff) + ldsw + 8192), 16, 0, 0); } while (0)
#define G8_LDA(dst, b, h) do { _Pragma("unroll") for (int m = 0; m < 4; ++m) _Pragma("unroll") for (int k = 0; k < 2; ++k) dst[m][k] = *(const LAS bf16x8*)(lds + G8_SA(b, h) + aoff + m * 2048 + k * 1024); } while (0)
#define G8_LDB(dst, b, h) do { _Pragma("unroll") for (int n = 0; n < 2; ++n) _Pragma("unroll") for (int k = 0; k < 2; ++k) dst[n][k] = *(const LAS bf16x8*)(lds + G8_SB(b, h) + boff + n * 2048 + k * 1024); } while (0)
#define G8_MMA(ai, bj, At, Bt) do { __builtin_amdgcn_s_setprio(1); _Pragma("unroll") for (int m = 0; m < 4; ++m) _Pragma("unroll") for (int n = 0; n < 2; ++n) _Pragma("unroll") for (int k = 0; k < 2; ++k) \
        acc[ai][bj][m][n] = __builtin_amdgcn_mfma_f32_16x16x32_bf16(Bt[n][k], At[m][k], acc[ai][bj][m][n], 0, 0, 0); __builtin_amdgcn_s_setprio(0); } while (0)
#define G8_WAIT_V(n) asm volatile("s_waitcnt vmcnt(" #n ")" ::: "memory")
#define G8_WAIT_L(n) asm volatile("s_waitcnt lgkmcnt(" #n ")" ::: "memory")
#define G8_BAR __builtin_amdgcn_s_barrier()
#define G8_SCHED __builtin_amdgcn_sched_barrier(0)
    Unit cur, nxt; int ui = 0;
    if (!S.next(0, cur)) return;
    Acc acc;
#pragma unroll
    for (int a = 0; a < 2; ++a)
#pragma unroll
        for (int b = 0; b < 2; ++b)
#pragma unroll
            for (int m = 0; m < 4; ++m)
#pragma unroll
                for (int n = 0; n < 2; ++n) acc[a][b][m][n] = (f32x4){0.f, 0.f, 0.f, 0.f};
    bf16x8 At[4][2], B0[2][2], B1[2][2];
    unsigned cv[2][2], nv[2][2];
    S.aoffs(cur, R0, C0, R1, C1, cv);
    const unsigned char* cA = ws + cur.aoff; const unsigned char* cB = ws + cur.boff;
    G8_STAGE(G8_SB(0, 0), cB, voffB[0], voffB[1]); G8_STAGE(G8_SA(0, 0), cA, cv[0][0], cv[0][1]);
    G8_STAGE(G8_SB(0, 1), cB + hstepB, voffB[0], voffB[1]); G8_STAGE(G8_SA(0, 1), cA, cv[1][0], cv[1][1]);
    if (wr == 1) G8_BAR;
    G8_WAIT_V(4); G8_BAR;
    G8_STAGE(G8_SB(1, 0), cB + kstep, voffB[0], voffB[1]); G8_STAGE(G8_SA(1, 0), cA + kstep, cv[0][0], cv[0][1]);
    G8_STAGE(G8_SB(1, 1), cB + hstepB + kstep, voffB[0], voffB[1]);
    G8_WAIT_V(6); G8_BAR;
    for (;;) {
        const bool has_next = S.next(ui + 1, nxt);
        if (has_next) S.aoffs(nxt, R0, C0, R1, C1, nv);
        else { nv[0][0] = cv[0][0]; nv[0][1] = cv[0][1]; nv[1][0] = cv[1][0]; nv[1][1] = cv[1][1]; }
        const unsigned char* nA = has_next ? ws + nxt.aoff : cA; const unsigned char* nB = has_next ? ws + nxt.boff : cB;
        const int vrows = SKIP ? cur.aux2 : 256;
        const bool do0 = !SKIP || vrows > 64 || wr == 0, do1 = !SKIP || vrows > 128;
        for (int t = 0; t < nt; t += 2) {
            const bool last = (t == nt - 2);
            const unsigned char* a1 = cA + (size_t)(t + 1) * kstep;
            const unsigned char* a2 = last ? nA : cA + (size_t)(t + 2) * kstep; const unsigned char* b2 = last ? nB : cB + (size_t)(t + 2) * kstep;
            const unsigned char* a3 = a2 + kstep; const unsigned char* b3 = b2 + kstep;
            const unsigned o00 = last ? nv[0][0] : cv[0][0], o01 = last ? nv[0][1] : cv[0][1], o10 = last ? nv[1][0] : cv[1][0], o11 = last ? nv[1][1] : cv[1][1];
            G8_LDB(B0, 0, 0); G8_SCHED; G8_LDA(At, 0, 0); G8_STAGE(G8_SA(1, 1), a1, cv[1][0], cv[1][1]);
            G8_WAIT_L(8); G8_BAR; G8_WAIT_L(0); if (do0) G8_MMA(0, 0, At, B0); G8_BAR; G8_SCHED;
            G8_LDB(B1, 0, 1); G8_STAGE(G8_SB(0, 0), b2, voffB[0], voffB[1]);
            G8_BAR; G8_WAIT_L(0); if (do0) G8_MMA(0, 1, At, B1); G8_BAR;
            G8_LDA(At, 0, 1); G8_STAGE(G8_SA(0, 0), a2, o00, o01);
            G8_BAR; G8_WAIT_L(0); if (do1) G8_MMA(1, 0, At, B0); G8_BAR; G8_SCHED;
            G8_STAGE(G8_SB(0, 1), b2 + hstepB, voffB[0], voffB[1]);
            G8_WAIT_V(6); G8_BAR; if (do1) G8_MMA(1, 1, At, B1); G8_BAR;
            G8_LDB(B0, 1, 0); G8_SCHED; G8_LDA(At, 1, 0); G8_STAGE(G8_SA(0, 1), a2, o10, o11);
            G8_WAIT_L(8); G8_BAR; G8_WAIT_L(0); if (do0) G8_MMA(0, 0, At, B0); G8_BAR; G8_SCHED;
            G8_LDB(B1, 1, 1); G8_STAGE(G8_SB(1, 0), b3, voffB[0], voffB[1]);
            G8_BAR; G8_WAIT_L(0); if (do0) G8_MMA(0, 1, At, B1); G8_BAR;
            G8_LDA(At, 1, 1); G8_STAGE(G8_SA(1, 0), a3, o00, o01);
            G8_BAR; G8_WAIT_L(0); if (do1) G8_MMA(1, 0, At, B0); G8_BAR; G8_SCHED;
            G8_STAGE(G8_SB(1, 1), b3 + hstepB, voffB[0], voffB[1]);
            G8_WAIT_V(6); G8_BAR; if (do1) G8_MMA(1, 1, At, B1); G8_BAR;
        }
        E(acc, cur, wr, wc, fr, fq);
        if (!has_next) break;
        if (!(cur.flags & 1)) {
#pragma unroll
            for (int a = 0; a < 2; ++a)
#pragma unroll
                for (int b = 0; b < 2; ++b)
#pragma unroll
                    for (int m = 0; m < 4; ++m)
#pragma unroll
                        for (int n = 0; n < 2; ++n) acc[a][b][m][n] = (f32x4){0.f, 0.f, 0.f, 0.f};
        }
        cur = nxt; cA = nA; cB = nB; ++ui;
        cv[0][0] = nv[0][0]; cv[0][1] = nv[0][1]; cv[1][0] = nv[1][0]; cv[1][1] = nv[1][1];
    }
    G8_WAIT_V(0);
    if (wr == 0) G8_BAR;
    G8_BAR;
#undef G8_SA
#undef G8_SB
#undef G8_STAGE
#undef G8_LDA
#undef G8_LDB
#undef G8_MMA
#undef G8_WAIT_V
#undef G8_WAIT_L
#undef G8_BAR
#undef G8_SCHED
}
}

__device__ __forceinline__ void p0_adaln(const Params& P, LAS unsigned char* lds, int tid, int item) {
    const int ks = item & 3, nc = item >> 2;
    LAS float* sc = (LAS float*)lds;
    LAS float* red = (LAS float*)(lds + 16384);
    const float* c = P.in[1];
    for (int i = tid; i < 4096; i += NTHREADS) { const int kl = i >> 3, b = i & 7; const float v = c[b * 2048 + ks * 512 + kl]; sc[i] = v / (1.0f + expf(-v)); }
    __syncthreads();
    if (tid < 384) {
        const int nq = tid % 48, kg = tid / 48;
        const float* W = P.in[2] + (size_t)(ks * 512 + kg * 64) * NMOD + nc * 192 + nq * 4;
        f32x4 acc[8];
#pragma unroll
        for (int b = 0; b < 8; ++b) acc[b] = (f32x4){0.f, 0.f, 0.f, 0.f};
#pragma unroll 8
        for (int kk = 0; kk < 64; ++kk) {
            const f32x4 w = *(const f32x4*)(W + (size_t)kk * NMOD);
            const f32x4 s0 = *(const LAS f32x4*)(sc + (kg * 64 + kk) * 8), s1 = *(const LAS f32x4*)(sc + (kg * 64 + kk) * 8 + 4);
            acc[0] += w * s0[0]; acc[1] += w * s0[1]; acc[2] += w * s0[2]; acc[3] += w * s0[3];
            acc[4] += w * s1[0]; acc[5] += w * s1[1]; acc[6] += w * s1[2]; acc[7] += w * s1[3];
        }
#pragma unroll
        for (int b = 0; b < 8; ++b) *(LAS f32x4*)(red + (kg * 8 + b) * 192 + nq * 4) = acc[b];
    }
    __syncthreads();
    float* modp = (float*)(P.ws + WS_MODP);
    for (int i = tid; i < 8 * 192; i += NTHREADS) {
        const int b = i / 192, n = i % 192; float s = 0.f;
#pragma unroll
        for (int kg = 0; kg < 8; ++kg) s += red[(kg * 8 + b) * 192 + n];
        modp[(size_t)(ks * 8 + b) * NMOD + nc * 192 + n] = s;
    }
    __syncthreads();
}

struct CvtUnit { const float* src; bf16_t* dst; int Nd, Kd, k0, n0, nmode; const float* s0; const float* s1; };
constexpr int CVT_UNITS = 640 + 256 + 64 + 3 * 4096;
__device__ __forceinline__ void cvt_unit_decode(const Params& P, int L, CvtUnit& u) {
    u.s0 = nullptr; u.s1 = nullptr; u.nmode = 0;
    if (L < 640) { u.src = P.in[5]; u.dst = (bf16_t*)(P.ws + WS_WIN); u.Kd = 2048; u.Nd = 5120; u.k0 = (L / 20) * 64; u.n0 = (L % 20) * 256; u.nmode = 3; return; }
    L -= 640;
    if (L < 256) { u.src = P.in[17]; u.dst = (bf16_t*)(P.ws + WS_WOUT); u.Kd = 2048; u.Nd = 2048; u.k0 = (L / 8) * 64; u.n0 = (L % 8) * 256; u.s0 = P.in[15]; u.s1 = P.in[16]; return; }
    L -= 256;
    if (L < 64) { u.src = P.in[14]; u.dst = (bf16_t*)(P.ws + WS_WGLU); u.Kd = 1024; u.Nd = 1024; u.k0 = (L / 4) * 64; u.n0 = (L % 4) * 256; return; }
    L -= 64;
    if (L < 4096) { const int e = L >> 7, r = L & 127; u.src = P.in[23] + (size_t)e * 2048 * 1024; u.dst = (bf16_t*)(P.ws + WS_WGU) + (size_t)e * 2048 * 2048; u.Kd = 2048; u.Nd = 1024; u.k0 = (r >> 2) * 64; u.n0 = (r & 3) * 256; u.nmode = 1; return; }
    L -= 4096;
    if (L < 4096) { const int e = L >> 7, r = L & 127; u.src = P.in[24] + (size_t)e * 2048 * 1024; u.dst = (bf16_t*)(P.ws + WS_WGU) + (size_t)e * 2048 * 2048; u.Kd = 2048; u.Nd = 1024; u.k0 = (r >> 2) * 64; u.n0 = (r & 3) * 256; u.nmode = 2; return; }
    L -= 4096;
    { const int e = L >> 7, r = L & 127; u.src = P.in[25] + (size_t)e * 1024 * 2048; u.dst = (bf16_t*)(P.ws + WS_WD) + (size_t)e * 2048 * 1024; u.Kd = 1024; u.Nd = 2048; u.k0 = (r >> 3) * 64; u.n0 = (r & 7) * 256; }
}
__device__ __forceinline__ void cvt_load(const CvtUnit& u, int tid, f32x4 (&r)[8]) {
    const int kp = tid >> 4, nq = tid & 15;
    const float* p = u.src + (size_t)(u.k0 + 2 * kp) * u.Nd + u.n0 + nq * 4;
#pragma unroll
    for (int s = 0; s < 4; ++s) { r[2 * s] = *(const f32x4*)(p + s * 64); r[2 * s + 1] = *(const f32x4*)(p + u.Nd + s * 64); }
    if (u.s0) {
        const int k = u.k0 + 2 * kp;
        const float a = (k < 1024) ? u.s0[k] : u.s1[k - 1024], b = (k + 1 < 1024) ? u.s0[k + 1] : u.s1[k + 1 - 1024];
#pragma unroll
        for (int s = 0; s < 4; ++s) { r[2 * s] *= a; r[2 * s + 1] *= b; }
    }
}
__device__ __forceinline__ void cvt_to_lds(LAS unsigned* tile, const f32x4 (&r)[8], int kp, int nq) {
#pragma unroll
    for (int s = 0; s < 4; ++s)
#pragma unroll
        for (int j = 0; j < 4; ++j) tile[s * 2112 + (nq * 4 + j) * 33 + kp] = cvt_pk_bf16(r[2 * s][j], r[2 * s + 1][j]);
}
__device__ __forceinline__ void cvt_store(const LAS unsigned* tile, const CvtUnit& u, int nl, int kq) {
#pragma unroll
    for (int s = 0; s < 4; ++s) {
        u32x4 w; w.x = tile[s * 2112 + nl * 33 + kq * 4]; w.y = tile[s * 2112 + nl * 33 + kq * 4 + 1]; w.z = tile[s * 2112 + nl * 33 + kq * 4 + 2]; w.w = tile[s * 2112 + nl * 33 + kq * 4 + 3];
        const int n = u.n0 + s * 64 + nl;
        int np = n;
        if (u.nmode == 1 || u.nmode == 2) np = (n >> 7) * 256 + (n & 127) + (u.nmode == 2 ? 128 : 0);
        else if (u.nmode == 3 && n >= 1024 && n < 3072) { const int reg = (n >= 2048) ? 2048 : 1024, nr = n - reg;
            np = reg + ((nr >> 8) << 8) + (((nr >> 6) & 1) << 7) + (((nr >> 7) & 1) << 6) + (nr & 63); }
        *(u32x4*)(u.dst + (size_t)np * u.Kd + u.k0 + kq * 8) = w;
    }
}
__device__ __forceinline__ void p0_convert(const Params& P, LAS unsigned char* lds, int tid, int blk, int G) {
    LAS unsigned* tileA = (LAS unsigned*)lds;
    LAS unsigned* tileB = tileA + 4 * 2112;
    const int kp = tid >> 4, nq = tid & 15, nl = tid >> 3, kq = tid & 7;
    CvtUnit uA, uB, nA, nB; f32x4 rA[8], rB[8];
    int L = blk;
    if (L >= CVT_UNITS) return;
    bool hasB = (L + G) < CVT_UNITS;
    cvt_unit_decode(P, L, uA); cvt_load(uA, tid, rA);
    if (hasB) { cvt_unit_decode(P, L + G, uB); cvt_load(uB, tid, rB); }
    for (;;) {
        cvt_to_lds(tileA, rA, kp, nq);
        if (hasB) cvt_to_lds(tileB, rB, kp, nq);
        __syncthreads();
        const int Ln = L + 2 * G; const bool moreA = Ln < CVT_UNITS, moreB = (Ln + G) < CVT_UNITS;
        if (moreA) { cvt_unit_decode(P, Ln, nA); cvt_load(nA, tid, rA); }
        if (moreB) { cvt_unit_decode(P, Ln + G, nB); cvt_load(nB, tid, rB); }
        cvt_store(tileA, uA, nl, kq);
        if (hasB) cvt_store(tileB, uB, nl, kq);
        __syncthreads();
        if (!moreA) break;
        uA = nA; uB = nB; hasB = moreB; L = Ln;
    }
}

__device__ __forceinline__ void p0_ssm_mats(const Params& P, LAS unsigned char* lds, int tid, int item) {
    const int g = item & 63, q = item >> 6;
    LAS f32x2* pw = (LAS f32x2*)lds;
    LAS f32x2* Bb = pw + 17 * 64;
    LAS f32x2* Cc = Bb + 64 * 16;
    LAS float* Kt = (LAS float*)(Cc + 16 * 64);
    if (tid < 64) {
        const int p = tid;
        const float dt = expf(P.in[13][g]);
        const float are = P.in[6][g * 64 + p], aim = P.in[7][g * 64 + p];
        const float mag = expf(dt * are);
        double sd, cd; sincos_d((double)(dt * aim), sd, cd);
        const float abr = mag * (float)cd, abi = mag * (float)sd;
        const float inv = 1.0f / (are * are + aim * aim);
        const float nre = abr - 1.0f;
        const float fre = (nre * are + abi * aim) * inv, fim = (abi * are - nre * aim) * inv;
        float pr = 1.0f, pi = 0.0f;
        for (int n = 0; n <= 16; ++n) { pw[n * 64 + p] = (f32x2){pr, pi}; const float t = pr * abr - pi * abi; pi = pr * abi + pi * abr; pr = t; }
        for (int h = 0; h < 16; ++h) {
            const float br = P.in[8][(g * 64 + p) * 16 + h], bi = P.in[9][(g * 64 + p) * 16 + h];
            Bb[p * 16 + h] = (f32x2){fre * br - fim * bi, fre * bi + fim * br};
            Cc[h * 64 + p] = (f32x2){P.in[10][(g * 16 + h) * 64 + p], P.in[11][(g * 16 + h) * 64 + p]};
        }
        if (q == 0) { f32x2* AL = (f32x2*)(P.ws + WS_SSMA); const f32x2 v = pw[16 * 64 + p]; AL[g * 64 + p] = v; }
    }
    __syncthreads();
    for (int o = tid; o < 4096; o += NTHREADS) {
        const int tau = o >> 8, ho = (o >> 4) & 15, hi = o & 15; float s = 0.f;
        for (int p = 0; p < 64; ++p) {
            const f32x2 c = Cc[ho * 64 + p], a = pw[tau * 64 + p], b = Bb[p * 16 + hi];
            const float cr = c.x * a.x - c.y * a.y, ci = c.x * a.y + c.y * a.x;
            s += cr * b.x - ci * b.y;
        }
        Kt[o] = s;
    }
    __syncthreads();
    bf16_t* Ms = (bf16_t*)(P.ws + WS_SSMM) + (size_t)g * 131072;
    bf16_t* TM = Ms + 32768;
    for (int o = tid; o < 32 * 128; o += NTHREADS) {
        const int row = 32 * q + (o >> 7), col = (o & 127) * 2;
        const int p = row >> 1, j = col >> 4, hi = col & 15;
        const f32x2 a = pw[(15 - j) * 64 + p], b0 = Bb[p * 16 + hi], b1 = Bb[p * 16 + hi + 1];
        float v0, v1;
        if ((row & 1) == 0) { v0 = a.x * b0.x - a.y * b0.y; v1 = a.x * b1.x - a.y * b1.y; } else { v0 = a.x * b0.y + a.y * b0.x; v1 = a.x * b1.y + a.y * b1.x; }
        *(unsigned*)(Ms + (size_t)row * 256 + col) = cvt_pk_bf16(v0, v1);
    }
    for (int o = tid; o < 64 * 192; o += NTHREADS) {
        const int row = 64 * q + o / 192, col = (o % 192) * 2;
        const int i = row >> 4, ho = row & 15; float v0, v1;
        if (col < 256) { const int j = col >> 4, hi = col & 15; if (j <= i) { v0 = Kt[((i - j) * 16 + ho) * 16 + hi]; v1 = Kt[((i - j) * 16 + ho) * 16 + hi + 1]; } else { v0 = 0.f; v1 = 0.f; } }
        else { const int p0 = (col - 256) >> 1;
            const f32x2 c0 = Cc[ho * 64 + p0], a0 = pw[(i + 1) * 64 + p0];
            v0 = c0.x * a0.x - c0.y * a0.y; v1 = -(c0.x * a0.y + c0.y * a0.x); }
        *(unsigned*)(TM + (size_t)row * 384 + col) = cvt_pk_bf16(v0, v1);
    }
    __syncthreads();
}

__device__ __forceinline__ void p0_misc(const Params& P, int tid, int blk, int G) {
    f32x2* rope = (f32x2*)(P.ws + WS_ROPE);
    for (int i = blk * NTHREADS + tid; i < 2048 * 64; i += G * NTHREADS) {
        const int pos = i >> 6, d = i & 63;
        double th = 1.0; { const double r = 0.86596432336006535; double b = r; int e = d; while (e) { if (e & 1) th *= b; b *= b; e >>= 1; } }
        double s1, c1; sincos_d(th, s1, c1);
        double cr = 1.0, ci = 0.0, br = c1, bi = s1; int e = pos;
        while (e) { if (e & 1) { const double t = cr * br - ci * bi; ci = cr * bi + ci * br; cr = t; } const double t2 = br * br - bi * bi; bi = 2.0 * br * bi; br = t2; e >>= 1; }
        rope[i] = (f32x2){(float)cr, (float)ci};
    }
    bf16_t* wr = (bf16_t*)(P.ws + WS_WR);
    for (int i = blk * NTHREADS + tid; i < 48 * 2048; i += G * NTHREADS) {
        const int n = i >> 11, k = i & 2047; float v = 0.f;
        if (n < 4) v = P.in[19][k * 4 + n]; else if (n < 36) v = P.in[21][k * 32 + (n - 4)];
        wr[i] = (bf16_t)(cvt_pk_bf16(v, 0.f) & 0xffffu);
    }
    if (blk == 0) for (int i = tid; i < 2048; i += NTHREADS) ((int*)(P.ws + WS_CNT))[i] = 0;
}

__device__ __forceinline__ void p1_norm1(const Params& P, LAS unsigned char* lds, int tid, int blk, int G) {
    const float* modp = (const float*)(P.ws + WS_MODP); const float* bada = P.in[3];
    float* mod = (float*)(P.ws + WS_MOD);
    for (int i = blk * NTHREADS + tid; i < 8 * NMOD; i += G * NTHREADS) {
        const int b = i / NMOD, j = i % NMOD;
        mod[i] = bada[j] + ((modp[(size_t)(0 * 8 + b) * NMOD + j] + modp[(size_t)(1 * 8 + b) * NMOD + j]) + (modp[(size_t)(2 * 8 + b) * NMOD + j] + modp[(size_t)(3 * 8 + b) * NMOD + j]));
    }
    LAS float* gm = (LAS float*)lds; LAS float* sh = gm + 2048;
    const int wave = tid >> 6, lane = tid & 63;
    bf16_t* H = (bf16_t*)(P.ws + WS_H);
    for (int rb = blk; rb < 256; rb += G) {
        const int b = rb >> 5;
        for (int k = tid; k < 2048; k += NTHREADS) {
            const int js = 2048 + k, jh = k;
            const float sc = bada[js] + ((modp[(size_t)(0 * 8 + b) * NMOD + js] + modp[(size_t)(1 * 8 + b) * NMOD + js]) + (modp[(size_t)(2 * 8 + b) * NMOD + js] + modp[(size_t)(3 * 8 + b) * NMOD + js]));
            const float sv = bada[jh] + ((modp[(size_t)(0 * 8 + b) * NMOD + jh] + modp[(size_t)(1 * 8 + b) * NMOD + jh]) + (modp[(size_t)(2 * 8 + b) * NMOD + jh] + modp[(size_t)(3 * 8 + b) * NMOD + jh]));
            gm[k] = P.in[4][k] * (1.0f + sc); sh[k] = sv;
        }
        __syncthreads();
        f32x4 v[8], vn[8];
        { const float* xr = P.in[0] + (size_t)(rb * 64 + wave * 8) * DM;
#pragma unroll
          for (int i = 0; i < 8; ++i) v[i] = *(const f32x4*)(xr + (i * 64 + lane) * 4); }
        for (int rr = 0; rr < 8; ++rr) {
            const int row = rb * 64 + wave * 8 + rr;
            if (rr < 7) { const float* xn = P.in[0] + (size_t)(row + 1) * DM;
#pragma unroll
                for (int i = 0; i < 8; ++i) vn[i] = *(const f32x4*)(xn + (i * 64 + lane) * 4); }
            float ss = 0.f;
#pragma unroll
            for (int i = 0; i < 8; ++i) ss += v[i][0] * v[i][0] + v[i][1] * v[i][1] + v[i][2] * v[i][2] + v[i][3] * v[i][3];
            ss = wave_sum(ss);
            const float r = rsqrtf(ss * (1.0f / 2048.0f) + 1e-6f);
#pragma unroll
            for (int i = 0; i < 8; ++i) {
                const int k = (i * 64 + lane) * 4;
                const f32x4 g4 = *(const LAS f32x4*)(gm + k), s4 = *(const LAS f32x4*)(sh + k);
                const f32x4 o = v[i] * r * g4 + s4;
                u32x2 w; w.x = cvt_pk_bf16(o[0], o[1]); w.y = cvt_pk_bf16(o[2], o[3]);
                *(u32x2*)(H + (size_t)row * DM + k) = w;
            }
#pragma unroll
            for (int i = 0; i < 8; ++i) v[i] = vn[i];
        }
        __syncthreads();
    }
}

struct DenseSched : g8::StaticOrder {
    unsigned abase, bbase; int lda, ldb;
    __device__ __forceinline__ bool next(int i, g8::Unit& u) const {
        int pm, pn; if (!tile(i, pm, pn)) return false;
        u.pm = __builtin_amdgcn_readfirstlane(pm); u.pn = __builtin_amdgcn_readfirstlane(pn); u.flags = 0; u.aux = 0;
        u.aoff = abase + (unsigned)u.pm * 256u * (unsigned)lda * 2u; u.boff = bbase + (unsigned)u.pn * 256u * (unsigned)ldb * 2u; return true;
    }
    __device__ __forceinline__ void aoffs(const g8::Unit&, int R0, int C0, int R1, int C1, unsigned (&v)[2][2]) const {
        v[0][0] = (unsigned)(R0 * lda + C0) * 2u; v[0][1] = (unsigned)(R1 * lda + C1) * 2u;
        v[1][0] = (unsigned)((128 + R0) * lda + C0) * 2u; v[1][1] = (unsigned)((128 + R1) * lda + C1) * 2u;
    }
};
struct EpiStoreBf16 {
    static constexpr bool PERM = true;
    bf16_t* O; int ldc;
    __device__ __forceinline__ void operator()(g8::Acc& acc, const g8::Unit& u, int wr, int wc, int fr, int fq) const {
        const int row0 = u.pm * 256 + wr * 64 + fr, col0 = u.pn * 256 + wc * 32 + 8 * fq;
#pragma unroll
        for (int ai = 0; ai < 2; ++ai)
#pragma unroll
            for (int m = 0; m < 4; ++m) { bf16_t* rowp = O + (size_t)(row0 + ai * 128 + m * 16) * ldc + col0;
#pragma unroll
                for (int bj = 0; bj < 2; ++bj) { const f32x4 v0 = acc[ai][bj][m][0], v1 = acc[ai][bj][m][1];
                    u32x4 w; w.x = cvt_pk_bf16(v0[0], v0[1]); w.y = cvt_pk_bf16(v0[2], v0[3]); w.z = cvt_pk_bf16(v1[0], v1[1]); w.w = cvt_pk_bf16(v1[2], v1[3]);
                    *(u32x4*)(rowp + bj * 128) = w; } }
    }
};
struct EpiInProj {
    static constexpr bool PERM = true;
    bf16_t* O;
    __device__ __forceinline__ void operator()(g8::Acc& acc, const g8::Unit& u, int wr, int wc, int fr, int fq) const {
        const int pn = u.pn;
        const int row0 = u.pm * 256 + wr * 64 + fr;
        if (pn < 4 || pn >= 12) {
            const int col0 = pn * 256 + wc * 32 + 8 * fq;
#pragma unroll
            for (int ai = 0; ai < 2; ++ai)
#pragma unroll
                for (int m = 0; m < 4; ++m) { bf16_t* rowp = O + (size_t)(row0 + ai * 128 + m * 16) * NPROJ + col0;
#pragma unroll
                    for (int bj = 0; bj < 2; ++bj) { const f32x4 v0 = acc[ai][bj][m][0], v1 = acc[ai][bj][m][1];
                        u32x4 w; w.x = cvt_pk_bf16(v0[0], v0[1]); w.y = cvt_pk_bf16(v0[2], v0[3]); w.z = cvt_pk_bf16(v1[0], v1[1]); w.w = cvt_pk_bf16(v1[2], v1[3]);
                        *(u32x4*)(rowp + bj * 128) = w; } }
            return;
        }
        const bool isq = pn < 8;
        const int head = 2 * ((pn - 4) & 3) + (wc >> 1);
        const int dd0 = 32 * (wc & 1) + 8 * fq;
        const int colbase = (isq ? 1024 : 2048) + head * 128 + dd0;
        const float lg2 = log2f(1.0f - exp2f(-5.0f - (float)head));
        float fr_[8];
#pragma unroll
        for (int t = 0; t < 8; ++t) fr_[t] = exp2f(-(float)(dd0 + t) * 0.20762050593046014f) * 0.15915494309189535f;
#pragma unroll
        for (int ai = 0; ai < 2; ++ai)
#pragma unroll
            for (int m = 0; m < 4; ++m) {
                const int row = row0 + ai * 128 + m * 16, pos = row & 2047, i = wr * 64 + m * 16 + fr;
                const float sc = isq ? exp2f(lg2 * (float)i) : exp2f(-lg2 * (float)i) * 0.08838834764831845f;
                const float fp = (float)pos;
                float o1[8], o2[8];
#pragma unroll
                for (int t = 0; t < 8; ++t) {
                    const float rev = __builtin_amdgcn_fractf(fp * fr_[t]);
                    const float cs = __builtin_amdgcn_cosf(rev) * sc, sn = __builtin_amdgcn_sinf(rev) * sc;
                    const float a = acc[ai][0][m][t >> 2][t & 3], b = acc[ai][1][m][t >> 2][t & 3];
                    o1[t] = a * cs - b * sn; o2[t] = b * cs + a * sn;
                }
                bf16_t* rowp = O + (size_t)row * NPROJ + colbase;
                u32x4 w1, w2; w1.x = cvt_pk_bf16(o1[0], o1[1]); w1.y = cvt_pk_bf16(o1[2], o1[3]); w1.z = cvt_pk_bf16(o1[4], o1[5]); w1.w = cvt_pk_bf16(o1[6], o1[7]);
                w2.x = cvt_pk_bf16(o2[0], o2[1]); w2.y = cvt_pk_bf16(o2[2], o2[3]); w2.z = cvt_pk_bf16(o2[4], o2[5]); w2.w = cvt_pk_bf16(o2[6], o2[7]);
                *(u32x4*)rowp = w1; *(u32x4*)(rowp + 64) = w2;
            }
    }
};
struct EpiGlu {
    static constexpr bool PERM = true;
    const bf16_t* Z; bf16_t* CAT; float* rowss;
    __device__ __forceinline__ void operator()(g8::Acc& acc, const g8::Unit& u, int wr, int wc, int fr, int fq) const {
        const int row0 = u.pm * 256 + wr * 64 + fr, col0 = u.pn * 256 + wc * 32 + 8 * fq;
#pragma unroll
        for (int ai = 0; ai < 2; ++ai) {
            u32x4 zz[4][2];
#pragma unroll
            for (int m = 0; m < 4; ++m)
#pragma unroll
                for (int bj = 0; bj < 2; ++bj) zz[m][bj] = *(const u32x4*)(Z + (size_t)(row0 + ai * 128 + m * 16) * 1024 + col0 + bj * 128);
#pragma unroll
            for (int m = 0; m < 4; ++m) { const int row = row0 + ai * 128 + m * 16; float ss = 0.f;
#pragma unroll
                for (int bj = 0; bj < 2; ++bj) { const f32x4 v0 = acc[ai][bj][m][0], v1 = acc[ai][bj][m][1];
                    const u32x4 z4 = zz[m][bj];
                    float o[8];
                    o[0] = bf_lo(z4.x) * sigmoidf_(v0[0]); o[1] = bf_hi(z4.x) * sigmoidf_(v0[1]); o[2] = bf_lo(z4.y) * sigmoidf_(v0[2]); o[3] = bf_hi(z4.y) * sigmoidf_(v0[3]);
                    o[4] = bf_lo(z4.z) * sigmoidf_(v1[0]); o[5] = bf_hi(z4.z) * sigmoidf_(v1[1]); o[6] = bf_lo(z4.w) * sigmoidf_(v1[2]); o[7] = bf_hi(z4.w) * sigmoidf_(v1[3]);
#pragma unroll
                    for (int j = 0; j < 8; ++j) ss += o[j] * o[j];
                    u32x4 w; w.x = cvt_pk_bf16(o[0], o[1]); w.y = cvt_pk_bf16(o[2], o[3]); w.z = cvt_pk_bf16(o[4], o[5]); w.w = cvt_pk_bf16(o[6], o[7]);
                    *(u32x4*)(CAT + (size_t)row * DM + col0 + bj * 128) = w; }
                ss += __shfl_xor(ss, 16); ss += __shfl_xor(ss, 32);
                if (fq == 0) rowss[(size_t)row * 16 + u.pn * 4 + wc] = ss; }
        }
    }
};
struct OutSched : g8::StaticOrder {
    unsigned abase, bbase;
    __device__ __forceinline__ bool next(int i, g8::Unit& u) const {
        int pm, pn; if (!tile(i >> 1, pm, pn)) return false;
        const int half = i & 1;
        u.pm = __builtin_amdgcn_readfirstlane(pm); u.pn = __builtin_amdgcn_readfirstlane(pn); u.flags = half ? 0 : 1; u.aux = half;
        u.aoff = abase + (unsigned)u.pm * 256u * 4096u + (unsigned)half * 2048u; u.boff = bbase + (unsigned)u.pn * 256u * 4096u + (unsigned)half * 2048u; return true;
    }
    __device__ __forceinline__ void aoffs(const g8::Unit&, int R0, int C0, int R1, int C1, unsigned (&v)[2][2]) const {
        v[0][0] = (unsigned)(R0 * 2048 + C0) * 2u; v[0][1] = (unsigned)(R1 * 2048 + C1) * 2u;
        v[1][0] = (unsigned)((128 + R0) * 2048 + C0) * 2u; v[1][1] = (unsigned)((128 + R1) * 2048 + C1) * 2u;
    }
};
struct EpiOut {
    static constexpr bool PERM = true;
    const float* x; const float* mod; const float* rowss1; float* rowss2; bf16_t* X1;
    __device__ __forceinline__ void operator()(g8::Acc& acc, const g8::Unit& u, int wr, int wc, int fr, int fq) const {
        const int row0 = u.pm * 256 + wr * 64 + fr;
        if (u.aux == 0) {
#pragma unroll
            for (int ai = 0; ai < 2; ++ai)
#pragma unroll
                for (int m = 0; m < 4; ++m) { const f32x4* pp = (const f32x4*)(rowss1 + (size_t)(row0 + ai * 128 + m * 16) * 16);
                    const f32x4 p0 = pp[0], p1 = pp[1], p2 = pp[2], p3 = pp[3];
                    const float tot = (((p0[0] + p0[1]) + (p0[2] + p0[3])) + ((p1[0] + p1[1]) + (p1[2] + p1[3]))) + (((p2[0] + p2[1]) + (p2[2] + p2[3])) + ((p3[0] + p3[1]) + (p3[2] + p3[3])));
                    const float r = rsqrtf(tot * (1.0f / 1024.0f) + 1e-6f);
#pragma unroll
                    for (int bj = 0; bj < 2; ++bj)
#pragma unroll
                        for (int n = 0; n < 2; ++n) acc[ai][bj][m][n] *= r; }
            return;
        }
        const int col0 = u.pn * 256 + wc * 32 + 8 * fq;
        const int b = (u.pm * 256) >> 11;
        f32x4 gt[2][2];
#pragma unroll
        for (int bj = 0; bj < 2; ++bj)
#pragma unroll
            for (int n = 0; n < 2; ++n) gt[bj][n] = *(const f32x4*)(mod + (size_t)b * NMOD + 2 * DM + col0 + bj * 128 + n * 4);
#pragma unroll
        for (int am = 0; am < 4; ++am) {
            const int ai = am >> 1, m0 = (am & 1) * 2;
            f32x4 xv[2][2][2];
#pragma unroll
            for (int mm = 0; mm < 2; ++mm)
#pragma unroll
                for (int bj = 0; bj < 2; ++bj) { const size_t off = (size_t)(row0 + ai * 128 + (m0 + mm) * 16) * DM + col0 + bj * 128; xv[mm][bj][0] = *(const f32x4*)(x + off); xv[mm][bj][1] = *(const f32x4*)(x + off + 4); }
#pragma unroll
            for (int mm = 0; mm < 2; ++mm) { const int m = m0 + mm; const int row = row0 + ai * 128 + m * 16; float ss = 0.f;
#pragma unroll
                for (int bj = 0; bj < 2; ++bj) { const size_t off = (size_t)row * DM + col0 + bj * 128;
                    const f32x4 o0 = xv[mm][bj][0] + gt[bj][0] * acc[ai][bj][m][0], o1 = xv[mm][bj][1] + gt[bj][1] * acc[ai][bj][m][1];
                    ss += (o0[0] * o0[0] + o0[1] * o0[1]) + (o0[2] * o0[2] + o0[3] * o0[3]) + (o1[0] * o1[0] + o1[1] * o1[1]) + (o1[2] * o1[2] + o1[3] * o1[3]);
                    u32x4 w; w.x = cvt_pk_bf16(o0[0], o0[1]); w.y = cvt_pk_bf16(o0[2], o0[3]); w.z = cvt_pk_bf16(o1[0], o1[1]); w.w = cvt_pk_bf16(o1[2], o1[3]);
                    *(u32x4*)(X1 + off) = w; }
                ss += __shfl_xor(ss, 16); ss += __shfl_xor(ss, 32);
                if (fq == 0) rowss2[(size_t)row * 32 + u.pn * 4 + wc] = ss; }
        }
    }
};
struct MoeSched {
    const LAS int* tinfo; const LAS int* trows; int ntiles; int G, c; const int* list; unsigned abase, bbase; int mode;
    __device__ __forceinline__ bool next(int i, g8::Unit& u) const {
        int pn, ti;
        if ((G & 63) == 0) { const int x = c & 7, r = c >> 3, per = G >> 6;
            ti = (i * 8 + x) * per + (r >> 3); pn = r & 7; }
        else { const int L = i * G + c; pn = L & 7; ti = L >> 3; }
        if (ti >= ntiles) return false;
        const int inf = __builtin_amdgcn_readfirstlane(tinfo[ti]);
        const int e = inf & 255;
        u.pm = __builtin_amdgcn_readfirstlane(ti); u.pn = pn; u.flags = 0; u.aux = inf; u.aux2 = __builtin_amdgcn_readfirstlane(trows[ti]);
        if (mode == 0) { u.aoff = abase; u.boff = bbase + (unsigned)e * (2048u * 2048u * 2u) + (unsigned)pn * (256u * 2048u * 2u); }
        else { u.aoff = abase + (unsigned)ti * (256u * 1024u * 2u); u.boff = bbase + (unsigned)e * (2048u * 1024u * 2u) + (unsigned)pn * (256u * 1024u * 2u); }
        return true;
    }
    __device__ __forceinline__ void aoffs(const g8::Unit& u, int R0, int C0, int R1, int C1, unsigned (&v)[2][2]) const {
        if (mode == 0) {
            const int e = u.aux & 255, r0 = u.aux >> 8, n = u.aux2; const int* le = list + e * 16384 + r0;
            const int i00 = R0, i01 = R1, i10 = 128 + R0, i11 = 128 + R1;
            const int t00 = (i00 < n) ? (le[i00] >> 1) : 0, t01 = (i01 < n) ? (le[i01] >> 1) : 0, t10 = (i10 < n) ? (le[i10] >> 1) : 0, t11 = (i11 < n) ? (le[i11] >> 1) : 0;
            v[0][0] = (unsigned)(t00 * 2048 + C0) * 2u; v[0][1] = (unsigned)(t01 * 2048 + C1) * 2u; v[1][0] = (unsigned)(t10 * 2048 + C0) * 2u; v[1][1] = (unsigned)(t11 * 2048 + C1) * 2u;
        } else {
            v[0][0] = (unsigned)(R0 * 1024 + C0) * 2u; v[0][1] = (unsigned)(R1 * 1024 + C1) * 2u;
            v[1][0] = (unsigned)((128 + R0) * 1024 + C0) * 2u; v[1][1] = (unsigned)((128 + R1) * 1024 + C1) * 2u;
        }
    }
};
struct EpiMoe1 {
    static constexpr bool PERM = true;
    bf16_t* HM;
    __device__ __forceinline__ void operator()(g8::Acc& acc, const g8::Unit& u, int wr, int wc, int fr, int fq) const {
        const int row0 = u.pm * 256 + wr * 64 + fr, col0 = u.pn * 128 + wc * 32 + 8 * fq;
#pragma unroll
        for (int ai = 0; ai < 2; ++ai)
#pragma unroll
            for (int m = 0; m < 4; ++m) { float o[8];
#pragma unroll
                for (int n = 0; n < 2; ++n)
#pragma unroll
                    for (int j = 0; j < 4; ++j) { const float gv = acc[ai][0][m][n][j], uv = acc[ai][1][m][n][j]; o[n * 4 + j] = gv * sigmoidf_(gv) * uv; }
                u32x4 w; w.x = cvt_pk_bf16(o[0], o[1]); w.y = cvt_pk_bf16(o[2], o[3]); w.z = cvt_pk_bf16(o[4], o[5]); w.w = cvt_pk_bf16(o[6], o[7]);
                *(u32x4*)(HM + (size_t)(row0 + ai * 128 + m * 16) * 1024 + col0) = w; }
    }
};
struct EpiMoe2 {
    static constexpr bool PERM = true;
    const int* list; const float* wgt; bf16_t* Y2;
    __device__ __forceinline__ void operator()(g8::Acc& acc, const g8::Unit& u, int wr, int wc, int fr, int fq) const {
        const int e = u.aux & 255, r0 = u.aux >> 8, n = u.aux2; const int* le = list + e * 16384 + r0;
        const int col0 = u.pn * 256 + wc * 32 + 8 * fq;
        int asg[2][4]; float w8[2][4];
#pragma unroll
        for (int ai = 0; ai < 2; ++ai)
#pragma unroll
            for (int m = 0; m < 4; ++m) { const int r = ai * 128 + wr * 64 + m * 16 + fr; asg[ai][m] = (r < n) ? le[r] : -1; }
#pragma unroll
        for (int ai = 0; ai < 2; ++ai)
#pragma unroll
            for (int m = 0; m < 4; ++m) w8[ai][m] = (asg[ai][m] >= 0) ? wgt[asg[ai][m]] : 0.f;
#pragma unroll
        for (int ai = 0; ai < 2; ++ai)
#pragma unroll
            for (int m = 0; m < 4; ++m) {
                if (asg[ai][m] >= 0) { bf16_t* rowp = Y2 + (size_t)asg[ai][m] * DM + col0; const float ww = w8[ai][m];
#pragma unroll
                    for (int bj = 0; bj < 2; ++bj) { const f32x4 v0 = acc[ai][bj][m][0] * ww, v1 = acc[ai][bj][m][1] * ww;
                        u32x4 w; w.x = cvt_pk_bf16(v0[0], v0[1]); w.y = cvt_pk_bf16(v0[2], v0[3]); w.z = cvt_pk_bf16(v1[0], v1[1]); w.w = cvt_pk_bf16(v1[2], v1[3]);
                        *(u32x4*)(rowp + bj * 128) = w; } } }
    }
};

constexpr size_t WS_KV = WS_H;
__device__ __forceinline__ void ssm_item(const Params& P, LAS unsigned char* lds, int tid, int item) {
    const int g = item >> 2, bp = item & 3;
    const int wave = __builtin_amdgcn_readfirstlane(tid >> 6), lane = tid & 63, fr = lane & 15, fq = lane >> 4;
    const bf16_t* proj = (const bf16_t*)(P.ws + WS_PROJ);
    const bf16_t* Ms = (const bf16_t*)(P.ws + WS_SSMM) + (size_t)g * 131072;
    const bf16_t* TM = Ms + 32768;
    bf16_t* Zo = (bf16_t*)(P.ws + WS_Z);
    constexpr int ZS = 136, MS = 264, TS = 392;
    LAS bf16_t* ZB = (LAS bf16_t*)lds;
    LAS bf16_t* WB = (LAS bf16_t*)(lds + 256 * ZS * 2);
    const int b = 2 * bp + (wave >> 2);
    int tok0[2];
    bf16x8 Uf[2][8];
#pragma unroll
    for (int mt = 0; mt < 2; ++mt) {
        const int c = 32 * (wave & 3) + 16 * mt + fr; tok0[mt] = b * 2048 + c * 16;
#pragma unroll
        for (int ks = 0; ks < 8; ++ks) Uf[mt][ks] = *(const bf16x8*)(proj + (size_t)(tok0[mt] + 2 * ks + (fq >> 1)) * NPROJ + g * 16 + 8 * (fq & 1));
    }
#pragma unroll
    for (int i = 0; i < 8; ++i) { const int row = tid >> 2, kc = (tid & 3) + 4 * i; *(LAS u32x4*)(WB + row * MS + kc * 8) = *(const u32x4*)(Ms + row * 256 + kc * 8); }
    __syncthreads();
#pragma unroll
    for (int nt = 0; nt < 8; ++nt) {
        f32x4 a0 = {0.f, 0.f, 0.f, 0.f}, a1 = {0.f, 0.f, 0.f, 0.f};
#pragma unroll
        for (int ks = 0; ks < 8; ++ks) {
            const bf16x8 bf = *(const LAS bf16x8*)(WB + (16 * nt + fr) * MS + 32 * ks + 8 * fq);
            a0 = __builtin_amdgcn_mfma_f32_16x16x32_bf16(bf, Uf[0][ks], a0, 0, 0, 0);
            a1 = __builtin_amdgcn_mfma_f32_16x16x32_bf16(bf, Uf[1][ks], a1, 0, 0, 0);
        }
        *(LAS u32x2*)(ZB + (32 * wave + fr) * ZS + 16 * nt + 4 * fq) = (u32x2){cvt_pk_bf16(a0[0], a0[1]), cvt_pk_bf16(a0[2], a0[3])};
        *(LAS u32x2*)(ZB + (32 * wave + 16 + fr) * ZS + 16 * nt + 4 * fq) = (u32x2){cvt_pk_bf16(a1[0], a1[1]), cvt_pk_bf16(a1[2], a1[3])};
    }
    u32x4 tmr[6];
#pragma unroll
    for (int i = 0; i < 6; ++i) { const int row = tid >> 3, kc = (tid & 7) + 8 * i; tmr[i] = *(const u32x4*)(TM + (size_t)row * 384 + kc * 8); }
    __syncthreads();
    if (tid < 128) {
        const int bl = tid >> 6, p = tid & 63;
        const f32x2 al = ((const f32x2*)(P.ws + WS_SSMA))[g * 64 + p];
        float xr = 0.f, xi = 0.f;
        LAS unsigned* zw = (LAS unsigned*)ZB + (bl * 128) * (ZS / 2) + p;
        for (int c0 = 0; c0 < 128; c0 += 8) {
            unsigned zv[8];
#pragma unroll
            for (int k = 0; k < 8; ++k) zv[k] = zw[(c0 + k) * (ZS / 2)];
#pragma unroll
            for (int k = 0; k < 8; ++k) {
                zw[(c0 + k) * (ZS / 2)] = cvt_pk_bf16(xr, xi);
                const float t = al.x * xr - al.y * xi + bf_lo(zv[k]); xi = al.x * xi + al.y * xr + bf_hi(zv[k]); xr = t;
            }
        }
    }
#pragma unroll
    for (int i = 0; i < 6; ++i) { const int row = tid >> 3, kc = (tid & 7) + 8 * i; *(LAS u32x4*)(WB + row * TS + kc * 8) = tmr[i]; }
    __syncthreads();
    const LAS bf16_t* xrow = ZB + (32 * wave + fr) * ZS + 8 * fq;
    const f32x4 dv = *(const f32x4*)(P.in[12] + g * 16 + 4 * fq);
#pragma unroll
    for (int cq = 0; cq < 4; ++cq) {
        u32x2 uu[4][2];
#pragma unroll
        for (int ntl = 0; ntl < 4; ++ntl)
#pragma unroll
            for (int mt = 0; mt < 2; ++mt) uu[ntl][mt] = *(const u32x2*)(proj + (size_t)(tok0[mt] + 4 * cq + ntl) * NPROJ + g * 16 + 4 * fq);
        if (cq < 3) {
#pragma unroll
            for (int i = 0; i < 6; ++i) { const int row = tid >> 3, kc = (tid & 7) + 8 * i; tmr[i] = *(const u32x4*)(TM + (size_t)(64 * (cq + 1) + row) * 384 + kc * 8); }
        }
#pragma unroll
        for (int ntl = 0; ntl < 4; ++ntl) {
            const int nt = 4 * cq + ntl;
            f32x4 a0 = {0.f, 0.f, 0.f, 0.f}, a1 = {0.f, 0.f, 0.f, 0.f};
            const LAS bf16_t* brow = WB + (16 * ntl + fr) * TS + 8 * fq;
#pragma unroll
            for (int ks = 0; ks < 8; ++ks) {
                if (2 * ks <= nt) {
                    const bf16x8 bf = *(const LAS bf16x8*)(brow + 32 * ks);
                    a0 = __builtin_amdgcn_mfma_f32_16x16x32_bf16(bf, Uf[0][ks], a0, 0, 0, 0);
                    a1 = __builtin_amdgcn_mfma_f32_16x16x32_bf16(bf, Uf[1][ks], a1, 0, 0, 0);
                }
            }
#pragma unroll
            for (int k2 = 0; k2 < 4; ++k2) {
                const bf16x8 bf = *(const LAS bf16x8*)(brow + 256 + 32 * k2);
                const bf16x8 x0 = *(const LAS bf16x8*)(xrow + 32 * k2), x1 = *(const LAS bf16x8*)(xrow + 16 * ZS + 32 * k2);
                a0 = __builtin_amdgcn_mfma_f32_16x16x32_bf16(bf, x0, a0, 0, 0, 0);
                a1 = __builtin_amdgcn_mfma_f32_16x16x32_bf16(bf, x1, a1, 0, 0, 0);
            }
#pragma unroll
            for (int mt = 0; mt < 2; ++mt) {
                const f32x4 a = mt ? a1 : a0;
                const size_t tok = (size_t)(tok0[mt] + nt);
                const u32x2 u2 = uu[ntl][mt];
                const float y0 = a[0] + dv[0] * bf_lo(u2.x), y1 = a[1] + dv[1] * bf_hi(u2.x), y2 = a[2] + dv[2] * bf_lo(u2.y), y3 = a[3] + dv[3] * bf_hi(u2.y);
                u32x2 w; w.x = cvt_pk_bf16(gelu_tanh(y0), gelu_tanh(y1)); w.y = cvt_pk_bf16(gelu_tanh(y2), gelu_tanh(y3));
                *(u32x2*)(Zo + tok * 1024 + g * 16 + 4 * fq) = w;
            }
        }
        __syncthreads();
        if (cq < 3) {
#pragma unroll
            for (int i = 0; i < 6; ++i) { const int row = tid >> 3, kc = (tid & 7) + 8 * i; *(LAS u32x4*)(WB + row * TS + kc * 8) = tmr[i]; }
            __syncthreads();
        }
    }
}

__device__ __forceinline__ bf16x8 tr_frag(const LAS bf16_t* tile, int row0, int col0, int fr, int fq) {
    const LAS bf16_t* p = tile + (row0 + 8 * fq + (fr >> 2)) * 136 + col0 + 4 * (fr & 3);
    const bf16x4 a = __builtin_amdgcn_ds_read_tr16_b64_v4i16((LAS bf16x4*)p);
    const bf16x4 b = __builtin_amdgcn_ds_read_tr16_b64_v4i16((LAS bf16x4*)(p + 4 * 136));
    bf16x8 r; r[0] = a[0]; r[1] = a[1]; r[2] = a[2]; r[3] = a[3]; r[4] = b[0]; r[5] = b[1]; r[6] = b[2]; r[7] = b[3]; return r;
}
__device__ __forceinline__ void ret_kv_items(const Params& P, LAS unsigned char* lds, int tid, int first, int stride) {
    const int wave = __builtin_amdgcn_readfirstlane(tid >> 6), lane = tid & 63, fr = lane & 15, fq = lane >> 4;
    constexpr int RS = 136;
    LAS bf16_t* Ks = (LAS bf16_t*)lds; LAS bf16_t* Vs = Ks + 128 * RS;
    const bf16_t* proj = (const bf16_t*)(P.ws + WS_PROJ);
    bf16_t* KV = (bf16_t*)(P.ws + WS_KV);
    const int si = tid >> 2, part = tid & 3, i0 = 16 * wave;
    u32x4 kr[4], vr[4];
    int item = first;
    if (item >= 768) return;
    { const int bh = item / 12, n = item % 12; const bf16_t* pr = proj + ((size_t)(bh >> 3) * 2048 + n * 128 + si) * NPROJ + (bh & 7) * 128 + 32 * part;
#pragma unroll
      for (int j = 0; j < 4; ++j) { kr[j] = *(const u32x4*)(pr + 2048 + 8 * j); vr[j] = *(const u32x4*)(pr + 3072 + 8 * j); } }
    for (;;) {
#pragma unroll
        for (int j = 0; j < 4; ++j) { *(LAS u32x4*)(Ks + si * RS + 32 * part + 8 * j) = kr[j]; *(LAS u32x4*)(Vs + si * RS + 32 * part + 8 * j) = vr[j]; }
        __syncthreads();
        const int nxt = item + stride; const bool more = nxt < 768;
        if (more) { const int bh = nxt / 12, n = nxt % 12; const bf16_t* pr = proj + ((size_t)(bh >> 3) * 2048 + n * 128 + si) * NPROJ + (bh & 7) * 128 + 32 * part;
#pragma unroll
            for (int j = 0; j < 4; ++j) { kr[j] = *(const u32x4*)(pr + 2048 + 8 * j); vr[j] = *(const u32x4*)(pr + 3072 + 8 * j); } }
        bf16x8 Vt[4];
#pragma unroll
        for (int ks = 0; ks < 4; ++ks) Vt[ks] = tr_frag(Vs, 32 * ks, i0, fr, fq);
        const int bh = item / 12, n = item % 12;
        bf16_t* op = KV + ((size_t)(bh * 16 + n) * 128 + i0 + fr) * 128 + 4 * fq;
#pragma unroll
        for (int nt = 0; nt < 8; ++nt) {
            f32x4 a = {0.f, 0.f, 0.f, 0.f};
#pragma unroll
            for (int ks = 0; ks < 4; ++ks) { const bf16x8 kf = tr_frag(Ks, 32 * ks, 16 * nt, fr, fq); a = __builtin_amdgcn_mfma_f32_16x16x32_bf16(kf, Vt[ks], a, 0, 0, 0); }
            *(u32x2*)(op + 16 * nt) = (u32x2){cvt_pk_bf16(a[0], a[1]), cvt_pk_bf16(a[2], a[3])};
        }
        __syncthreads();
        if (!more) break;
        item = nxt;
    }
}
__device__ __forceinline__ void ret_out_item(const Params& P, LAS unsigned char* lds, int tid, int item) {
    const int bh = item >> 2, q = item & 3, b = bh >> 3, h = bh & 7;
    const int wave = __builtin_amdgcn_readfirstlane(tid >> 6), lane = tid & 63, fr = lane & 15, fq = lane >> 4;
    constexpr int RS = 136;
    LAS bf16_t* Qs = (LAS bf16_t*)lds;
    LAS bf16_t* Ks = Qs + 128 * RS;
    LAS bf16_t* Vs = Ks + 128 * RS;
    LAS bf16_t* Rs = Vs + 128 * RS;
    const bf16_t* proj = (const bf16_t*)(P.ws + WS_PROJ);
    const bf16_t* KV = (const bf16_t*)(P.ws + WS_KV);
    bf16_t* CAT = (bf16_t*)(P.ws + WS_CAT);
    const float gam = 1.0f - exp2f(-5.0f - (float)h);
    const float lg2 = log2f(gam);
    const float gC1 = exp2f(lg2 * 127.0f), gC = exp2f(lg2 * 128.0f);
    const int si = tid >> 2, part = tid & 3, i0 = 16 * wave;
    u32x4 st[12];
    { const bf16_t* pr = proj + ((size_t)b * 2048 + (4 * q) * 128 + si) * NPROJ + h * 128 + 32 * part;
#pragma unroll
      for (int j = 0; j < 4; ++j) { st[j] = *(const u32x4*)(pr + 1024 + 8 * j); st[4 + j] = *(const u32x4*)(pr + 2048 + 8 * j); st[8 + j] = *(const u32x4*)(pr + 3072 + 8 * j); } }
    f32x4 accR[8];
#pragma unroll
    for (int nt = 0; nt < 8; ++nt) accR[nt] = (f32x4){0.f, 0.f, 0.f, 0.f};
    for (int m = 0; m < 4 * q; ++m) {
        const bf16_t* tp = KV + ((size_t)(bh * 16 + m) * 128 + i0 + fr) * 128 + 4 * fq;
        u32x2 t[8];
#pragma unroll
        for (int nt = 0; nt < 8; ++nt) t[nt] = *(const u32x2*)(tp + 16 * nt);
#pragma unroll
        for (int nt = 0; nt < 8; ++nt) { const f32x4 kv = {bf_lo(t[nt].x), bf_hi(t[nt].x), bf_lo(t[nt].y), bf_hi(t[nt].y)}; accR[nt] = accR[nt] * gC + kv * gC1; }
    }
#pragma unroll
    for (int nt = 0; nt < 8; ++nt)
        *(LAS u32x2*)(Rs + (i0 + fr) * RS + 16 * nt + 4 * fq) = (u32x2){cvt_pk_bf16(accR[nt][0], accR[nt][1]), cvt_pk_bf16(accR[nt][2], accR[nt][3])};
    for (int nn = 0; nn < 4; ++nn) {
        const int n = 4 * q + nn;
#pragma unroll
        for (int j = 0; j < 4; ++j) { *(LAS u32x4*)(Qs + si * RS + 32 * part + 8 * j) = st[j]; *(LAS u32x4*)(Ks + si * RS + 32 * part + 8 * j) = st[4 + j]; *(LAS u32x4*)(Vs + si * RS + 32 * part + 8 * j) = st[8 + j]; }
        __syncthreads();
        if (nn < 3) { const bf16_t* pr = proj + ((size_t)b * 2048 + (n + 1) * 128 + si) * NPROJ + h * 128 + 32 * part;
#pragma unroll
            for (int j = 0; j < 4; ++j) { st[j] = *(const u32x4*)(pr + 1024 + 8 * j); st[4 + j] = *(const u32x4*)(pr + 2048 + 8 * j); st[8 + j] = *(const u32x4*)(pr + 3072 + 8 * j); } }
        const size_t tok = (size_t)b * 2048 + n * 128 + i0 + fr;
        u32x2 gg[8];
        { const bf16_t* gp = proj + tok * NPROJ + 4096 + h * 128 + 4 * fq;
#pragma unroll
          for (int nt = 0; nt < 8; ++nt) gg[nt] = *(const u32x2*)(gp + 16 * nt); }
        bf16x8 Qf[4];
#pragma unroll
        for (int ks = 0; ks < 4; ++ks) Qf[ks] = *(const LAS bf16x8*)(Qs + (i0 + fr) * RS + 32 * ks + 8 * fq);
        f32x4 accS[8], accO[8];
#pragma unroll
        for (int nt = 0; nt < 8; ++nt) { accS[nt] = (f32x4){0.f, 0.f, 0.f, 0.f}; accO[nt] = (f32x4){0.f, 0.f, 0.f, 0.f}; }
#pragma unroll
        for (int nt = 0; nt < 8; ++nt) {
            if (nt <= wave) {
#pragma unroll
                for (int ks = 0; ks < 4; ++ks) { const bf16x8 kf = *(const LAS bf16x8*)(Ks + (16 * nt + fr) * RS + 32 * ks + 8 * fq); accS[nt] = __builtin_amdgcn_mfma_f32_16x16x32_bf16(kf, Qf[ks], accS[nt], 0, 0, 0); }
            }
        }
        if (n > 0) {
#pragma unroll
            for (int nt = 0; nt < 8; ++nt) {
#pragma unroll
                for (int ks = 0; ks < 4; ++ks) { const bf16x8 rf = *(const LAS bf16x8*)(Rs + (16 * nt + fr) * RS + 32 * ks + 8 * fq); accO[nt] = __builtin_amdgcn_mfma_f32_16x16x32_bf16(rf, Qf[ks], accO[nt], 0, 0, 0); }
                accO[nt] *= gam;
            }
        }
#pragma unroll
        for (int nt = 0; nt < 8; ++nt) {
            const int i = i0 + fr, j0 = 16 * nt + 4 * fq;
            const float p0 = (j0 <= i) ? accS[nt][0] : 0.f, p1 = (j0 + 1 <= i) ? accS[nt][1] : 0.f, p2 = (j0 + 2 <= i) ? accS[nt][2] : 0.f, p3 = (j0 + 3 <= i) ? accS[nt][3] : 0.f;
            *(LAS u32x2*)(Qs + i * RS + j0) = (u32x2){cvt_pk_bf16(p0, p1), cvt_pk_bf16(p2, p3)};
        }
        asm volatile("" ::: "memory");
        bf16x8 Pf[4];
#pragma unroll
        for (int ks = 0; ks < 4; ++ks) Pf[ks] = *(const LAS bf16x8*)(Qs + (i0 + fr) * RS + 32 * ks + 8 * fq);
#pragma unroll
        for (int ks = 0; ks < 4; ++ks) {
            if (2 * ks <= wave) {
#pragma unroll
                for (int nt = 0; nt < 8; ++nt) { const bf16x8 vf = tr_frag(Vs, 32 * ks, 16 * nt, fr, fq); accO[nt] = __builtin_amdgcn_mfma_f32_16x16x32_bf16(vf, Pf[ks], accO[nt], 0, 0, 0); }
            }
        }
        if (nn < 3) {
            bf16x8 Vt[4];
#pragma unroll
            for (int ks = 0; ks < 4; ++ks) Vt[ks] = tr_frag(Vs, 32 * ks, i0, fr, fq);
#pragma unroll
            for (int nt = 0; nt < 8; ++nt) {
                accR[nt] *= gam;
#pragma unroll
                for (int ks = 0; ks < 4; ++ks) { const bf16x8 kf = tr_frag(Ks, 32 * ks, 16 * nt, fr, fq); accR[nt] = __builtin_amdgcn_mfma_f32_16x16x32_bf16(kf, Vt[ks], accR[nt], 0, 0, 0); }
                accR[nt] *= gC1;
            }
        }
        {
            float s = 0.f;
#pragma unroll
            for (int nt = 0; nt < 8; ++nt) s += (accO[nt][0] + accO[nt][1]) + (accO[nt][2] + accO[nt][3]);
            s += __shfl_xor(s, 16); s += __shfl_xor(s, 32);
            const float mu = s * (1.0f / 128.0f); float qv = 0.f;
#pragma unroll
            for (int nt = 0; nt < 8; ++nt) { const f32x4 d = accO[nt] - mu; qv += (d[0] * d[0] + d[1] * d[1]) + (d[2] * d[2] + d[3] * d[3]); }
            qv += __shfl_xor(qv, 16); qv += __shfl_xor(qv, 32);
            const float rstd = rsqrtf(qv * (1.0f / 128.0f) + 1e-5f);
            bf16_t* op = CAT + tok * DM + 1024 + h * 128 + 4 * fq;
#pragma unroll
            for (int nt = 0; nt < 8; ++nt) {
                const float g0 = bf_lo(gg[nt].x), g1 = bf_hi(gg[nt].x), g2 = bf_lo(gg[nt].y), g3 = bf_hi(gg[nt].y);
                const f32x4 y = (accO[nt] - mu) * rstd;
                u32x2 w; w.x = cvt_pk_bf16(y[0] * g0 * sigmoidf_(g0), y[1] * g1 * sigmoidf_(g1)); w.y = cvt_pk_bf16(y[2] * g2 * sigmoidf_(g2), y[3] * g3 * sigmoidf_(g3));
                *(u32x2*)(op + 16 * nt) = w;
            }
        }
        __syncthreads();
        if (nn < 3) {
#pragma unroll
            for (int nt = 0; nt < 8; ++nt)
                *(LAS u32x2*)(Rs + (i0 + fr) * RS + 16 * nt + 4 * fq) = (u32x2){cvt_pk_bf16(accR[nt][0], accR[nt][1]), cvt_pk_bf16(accR[nt][2], accR[nt][3])};
        }
    }
}

__device__ __forceinline__ void p6_route(const Params& P, LAS unsigned char* lds, int tid, int blk, int G) {
    const int wave = __builtin_amdgcn_readfirstlane(tid >> 6), lane = tid & 63, fr = lane & 15, fq = lane >> 4;
    LAS float* gm = (LAS float*)lds; LAS float* sh = gm + 2048; LAS float* lg = sh + 2048;
    LAS int* lcnt = (LAS int*)(lg + 2 * 64 * 48); LAS int* lbase = lcnt + 32;
    int ra_ = 0, rb_ = 0, ea_ = 0, eb_ = 0; float w1_ = 0.f, w2_ = 0.f;
    const float* mod = (const float*)(P.ws + WS_MOD);
    const bf16_t* x1 = (const bf16_t*)(P.ws + WS_X1); const float* rowss2 = (const float*)(P.ws + WS_ROWSS2);
    bf16_t* H2 = (bf16_t*)(P.ws + WS_H);
    const bf16_t* WR = (const bf16_t*)(P.ws + WS_WR);
    int* cnt = (int*)(P.ws + WS_CNT); int* list = (int*)(P.ws + WS_LIST); float* wgt = (float*)(P.ws + WS_WGT);
    for (int rb = blk; rb < 256; rb += G) {
        const int b = rb >> 5;
        for (int k = tid; k < 2048; k += NTHREADS) { gm[k] = P.in[18][k] * (1.0f + mod[(size_t)b * NMOD + 4 * DM + k]); sh[k] = mod[(size_t)b * NMOD + 3 * DM + k]; }
        if (tid < 32) lcnt[tid] = 0;
        __syncthreads();
        const int mt = wave & 3, kh = wave >> 2;
        const int row = rb * 64 + 16 * mt + fr;
        float tot2 = 0.f;
        { const f32x4* pp = (const f32x4*)(rowss2 + (size_t)row * 32);
#pragma unroll
          for (int i = 0; i < 8; ++i) { const f32x4 v = pp[i]; tot2 += (v[0] + v[1]) + (v[2] + v[3]); } }
        const float r2 = rsqrtf(tot2 * (1.0f / 2048.0f) + 1e-6f);
        f32x4 acc[3];
#pragma unroll
        for (int nt = 0; nt < 3; ++nt) acc[nt] = (f32x4){0.f, 0.f, 0.f, 0.f};
#pragma unroll 4
        for (int ks = 0; ks < 32; ++ks) {
            const int k0 = 1024 * kh + 32 * ks + 8 * fq;
            const u32x4 xw = *(const u32x4*)(x1 + (size_t)row * DM + k0);
            const f32x4 a = {bf_lo(xw.x), bf_hi(xw.x), bf_lo(xw.y), bf_hi(xw.y)}, c = {bf_lo(xw.z), bf_hi(xw.z), bf_lo(xw.w), bf_hi(xw.w)};
            const f32x4 g0 = *(const LAS f32x4*)(gm + k0), g1 = *(const LAS f32x4*)(gm + k0 + 4), s0 = *(const LAS f32x4*)(sh + k0), s1 = *(const LAS f32x4*)(sh + k0 + 4);
            const f32x4 h0 = a * r2 * g0 + s0, h1 = c * r2 * g1 + s1;
            u32x4 w; w.x = cvt_pk_bf16(h0[0], h0[1]); w.y = cvt_pk_bf16(h0[2], h0[3]); w.z = cvt_pk_bf16(h1[0], h1[1]); w.w = cvt_pk_bf16(h1[2], h1[3]);
            *(u32x4*)(H2 + (size_t)row * DM + k0) = w;
            const bf16x8 af = __builtin_bit_cast(bf16x8, w);
#pragma unroll
            for (int nt = 0; nt < 3; ++nt) { const bf16x8 bf = *(const bf16x8*)(WR + (size_t)(16 * nt + fr) * 2048 + k0); acc[nt] = __builtin_amdgcn_mfma_f32_16x16x32_bf16(bf, af, acc[nt], 0, 0, 0); }
        }
#pragma unroll
        for (int nt = 0; nt < 3; ++nt) *(LAS f32x4*)(lg + (kh * 64 + 16 * mt + fr) * 48 + 16 * nt + 4 * fq) = acc[nt];
        __syncthreads();
        if (tid < 64) {
            const int tok = rb * 64 + tid;
            float l[36];
#pragma unroll
            for (int nn = 0; nn < 36; ++nn) l[nn] = lg[tid * 48 + nn] + lg[(64 + tid) * 48 + nn];
            float gl[4]; int gs = 0;
#pragma unroll
            for (int j = 0; j < 4; ++j) gl[j] = l[j] + P.in[20][j];
#pragma unroll
            for (int j = 1; j < 4; ++j) if (gl[j] > gl[gs]) gs = j;
            float gmax = gl[0];
#pragma unroll
            for (int j = 1; j < 4; ++j) gmax = fmaxf(gmax, gl[j]);
            float den = 0.f;
#pragma unroll
            for (int j = 0; j < 4; ++j) den += expf(gl[j] - gmax);
            const float gw = 1.0f / den;
            float el[8];
#pragma unroll
            for (int j = 0; j < 8; ++j) { float v = 0.f;
#pragma unroll
                for (int q = 0; q < 4; ++q) v = (gs == q) ? (l[4 + q * 8 + j] + P.in[22][q * 8 + j]) : v;
                el[j] = v; }
            int j1 = 0;
#pragma unroll
            for (int j = 1; j < 8; ++j) if (el[j] > el[j1]) j1 = j;
            int j2 = (j1 == 0) ? 1 : 0;
#pragma unroll
            for (int j = 0; j < 8; ++j) if (j != j1 && j != j2 && el[j] > el[j2]) j2 = j;
            float e1 = el[0], e2 = el[0];
#pragma unroll
            for (int j = 0; j < 8; ++j) { e1 = (j == j1) ? el[j] : e1; e2 = (j == j2) ? el[j] : e2; }
            const float t2 = expf(e2 - e1), w1 = gw / (1.0f + t2), w2 = gw * t2 / (1.0f + t2);
            const int ea = gs * 8 + j1, eb = gs * 8 + j2;
            ra_ = atomicAdd((int*)&lcnt[ea], 1); rb_ = atomicAdd((int*)&lcnt[eb], 1); ea_ = ea; eb_ = eb; w1_ = w1; w2_ = w2;
        }
        __syncthreads();
        if (tid < 32) { const int c = lcnt[tid]; lbase[tid] = c > 0 ? atomicAdd(cnt + tid * 64, c) : 0; }
        __syncthreads();
        if (tid < 64) {
            const int tok = rb * 64 + tid;
            list[ea_ * 16384 + lbase[ea_] + ra_] = tok * 2; wgt[tok * 2] = w1_;
            list[eb_ * 16384 + lbase[eb_] + rb_] = tok * 2 + 1; wgt[tok * 2 + 1] = w2_;
        }
        __syncthreads();
    }
}

__device__ __forceinline__ void p9_final(const Params& P, int tid, int blk, int G) {
    const int wave = tid >> 6, lane = tid & 63;
    const float* mod = (const float*)(P.ws + WS_MOD); const bf16_t* Y2 = (const bf16_t*)(P.ws + WS_Y2); const bf16_t* X1 = (const bf16_t*)(P.ws + WS_X1);
    f32x4 gf[8];
#pragma unroll
    for (int i = 0; i < 8; ++i) gf[i] = *(const f32x4*)(P.in[26] + (i * 64 + lane) * 4);
    int row = blk * 8 + wave;
    u32x2 xw[8], ya[8], yb[8], xwn[8], yan[8], ybn[8];
    if (row < NTOK) {
#pragma unroll
        for (int i = 0; i < 8; ++i) { const int k = (i * 64 + lane) * 4; xw[i] = *(const u32x2*)(X1 + (size_t)row * DM + k); ya[i] = *(const u32x2*)(Y2 + (size_t)(2 * row) * DM + k); yb[i] = *(const u32x2*)(Y2 + (size_t)(2 * row + 1) * DM + k); }
    }
    for (; row < NTOK; row += G * 8) {
        const int b = row >> 11, rown = row + G * 8;
        if (rown < NTOK) {
#pragma unroll
            for (int i = 0; i < 8; ++i) { const int k = (i * 64 + lane) * 4; xwn[i] = *(const u32x2*)(X1 + (size_t)rown * DM + k); yan[i] = *(const u32x2*)(Y2 + (size_t)(2 * rown) * DM + k); ybn[i] = *(const u32x2*)(Y2 + (size_t)(2 * rown + 1) * DM + k); }
        }
        f32x4 v[8]; float ss = 0.f;
#pragma unroll
        for (int i = 0; i < 8; ++i) {
            const int k = (i * 64 + lane) * 4;
            const f32x4 xv = {bf_lo(xw[i].x), bf_hi(xw[i].x), bf_lo(xw[i].y), bf_hi(xw[i].y)};
            const f32x4 gt = *(const f32x4*)(mod + (size_t)b * NMOD + 5 * DM + k);
            f32x4 y; y[0] = bf_lo(ya[i].x) + bf_lo(yb[i].x); y[1] = bf_hi(ya[i].x) + bf_hi(yb[i].x); y[2] = bf_lo(ya[i].y) + bf_lo(yb[i].y); y[3] = bf_hi(ya[i].y) + bf_hi(yb[i].y);
            v[i] = xv + gt * y;
            ss += v[i][0] * v[i][0] + v[i][1] * v[i][1] + v[i][2] * v[i][2] + v[i][3] * v[i][3];
        }
        ss = wave_sum(ss);
        const float r = rsqrtf(ss * (1.0f / 2048.0f) + 1e-6f);
        float* xr = P.out + (size_t)row * DM;
#pragma unroll
        for (int i = 0; i < 8; ++i) { const int k = (i * 64 + lane) * 4; *(f32x4*)(xr + k) = v[i] * r * gf[i]; }
#pragma unroll
        for (int i = 0; i < 8; ++i) { xw[i] = xwn[i]; ya[i] = yan[i]; yb[i] = ybn[i]; }
    }
}

__global__ void __launch_bounds__(NTHREADS, 2) hymba_fwd(Params P) {
    extern __shared__ __attribute__((aligned(16))) unsigned char lds_raw[];
    LAS unsigned char* lds = (LAS unsigned char*)lds_raw;
    const int tid = threadIdx.x, blk = blockIdx.x, G = gridDim.x;
    volatile LAS unsigned* misc = (volatile LAS unsigned*)(lds + LDS_MISC);
    if (tid < 64) misc[tid] = 0u;
    __syncthreads();
    XcdBarrier bar = xcd_barrier_post((unsigned*)(P.ws + WS_BAR), misc);
    const int lo = P.ph_lo, hi = P.ph_hi;
#define IN(k) (lo <= (k) && (k) < hi)
#define SEAM(k) do { if (IN(k) && IN((k) + 1)) xcd_barrier(bar); } while (0)
    unsigned char* ws = P.ws;

#ifndef REPR
#define REPR 1
#endif
#ifndef REPS
#define REPS 1
#endif
#ifndef REP0
#define REP0 1
#endif
#ifndef REP2
#define REP2 1
#endif
#ifndef REP7
#define REP7 1
#endif
#ifndef REP8
#define REP8 1
#endif
    if (IN(0)) for (int rep0 = 0; rep0 < REP0; ++rep0) {
        for (int it = blk; it < 256; it += G) p0_adaln(P, lds, tid, it);
        for (int it = blk; it < 256; it += G) p0_ssm_mats(P, lds, tid, it);
        p0_misc(P, tid, blk, G);
        p0_convert(P, lds, tid, blk, G);
    }
    SEAM(0);
    if (IN(1)) p1_norm1(P, lds, tid, blk, G);
    SEAM(1);
    if (IN(2)) for (int rep2 = 0; rep2 < REP2; ++rep2) {
        DenseSched S; S.init(NTOK, NPROJ, G, blk); S.abase = (unsigned)WS_H; S.bbase = (unsigned)WS_WIN; S.lda = DM; S.ldb = DM;
        EpiInProj E{(bf16_t*)(ws + WS_PROJ)};
        g8::gemm_phase(lds, ws, DM / 64, DM, S, E);
    }
    SEAM(2);
    if (IN(3)) {
        for (int it = blk; it < 256; it += G) ssm_item(P, lds, tid, it);
        ret_kv_items(P, lds, tid, blk, G);
    }
    SEAM(3);
    if (IN(4)) {
        for (int it = blk; it < 256; it += G) ret_out_item(P, lds, tid, it);
        __syncthreads();
        DenseSched S; S.init(NTOK, 1024, G, blk); S.abase = (unsigned)WS_Z; S.bbase = (unsigned)WS_WGLU; S.lda = 1024; S.ldb = 1024;
        EpiGlu E{(const bf16_t*)(ws + WS_Z), (bf16_t*)(ws + WS_CAT), (float*)(ws + WS_ROWSS1)};
        g8::gemm_phase(lds, ws, 1024 / 64, 1024, S, E);
    }
    SEAM(4);
    if (IN(5)) {
        OutSched S; S.init(NTOK, DM, G, blk); S.abase = (unsigned)WS_CAT; S.bbase = (unsigned)WS_WOUT;
        EpiOut E{P.in[0], (const float*)(ws + WS_MOD), (const float*)(ws + WS_ROWSS1), (float*)(ws + WS_ROWSS2), (bf16_t*)(ws + WS_X1)};
        g8::gemm_phase(lds, ws, 1024 / 64, DM, S, E);
    }
    SEAM(5);
    if (IN(6)) p6_route(P, lds, tid, blk, G);
    SEAM(6);
    if (IN(7) || IN(8)) {
        LAS int* tinfo = (LAS int*)(lds + LDS_MISC + 256); LAS int* trows = tinfo + 192; LAS int* ntl = trows + 192;
        if (tid == 0) {
            const int* cg = (const int*)(ws + WS_CNT); int nt_ = 0;
            for (int e = 0; e < 32; ++e) { const int c = cg[e * 64], full = c >> 8, rem = c & 255;
                for (int t = 0; t < full; ++t) { tinfo[nt_] = e | ((t * 256) << 8); trows[nt_] = 256; ++nt_; }
                if (rem > 128) { tinfo[nt_] = e | ((full * 256) << 8); trows[nt_] = rem; ++nt_; } }
            for (int e = 0; e < 32; ++e) { const int c = cg[e * 64], full = c >> 8, rem = c & 255; if (rem > 64 && rem <= 128) { tinfo[nt_] = e | ((full * 256) << 8); trows[nt_] = rem; ++nt_; } }
            for (int e = 0; e < 32; ++e) { const int c = cg[e * 64], full = c >> 8, rem = c & 255; if (rem > 0 && rem <= 64) { tinfo[nt_] = e | ((full * 256) << 8); trows[nt_] = rem; ++nt_; } }
            ntl[0] = nt_;
        }
        __syncthreads();
        const int ntiles = __builtin_amdgcn_readfirstlane(ntl[0]);
        if (IN(7)) {
            MoeSched S{tinfo, trows, ntiles, G, blk, (const int*)(ws + WS_LIST), (unsigned)WS_H, (unsigned)WS_WGU, 0};
            EpiMoe1 E{(bf16_t*)(ws + WS_HM)};
            for (int r_ = 0; r_ < REP7; ++r_) g8::gemm_phase<EpiMoe1, MoeSched, true>(lds, ws, DM / 64, DM, S, E);
        }
        SEAM(7);
        if (IN(8)) {
            MoeSched S{tinfo, trows, ntiles, G, blk, (const int*)(ws + WS_LIST), (unsigned)WS_HM, (unsigned)WS_WD, 1};
            EpiMoe2 E{(const int*)(ws + WS_LIST), (const float*)(ws + WS_WGT), (bf16_t*)(ws + WS_Y2)};
            for (int r_ = 0; r_ < REP8; ++r_) g8::gemm_phase<EpiMoe2, MoeSched, true>(lds, ws, DEXP / 64, DEXP, S, E);
        }
    }
    SEAM(8);
    if (IN(9)) p9_final(P, tid, blk, G);
#undef IN
#undef SEAM
}

#ifndef N_LAUNCH_SPLIT
#define N_LAUNCH_SPLIT 0
#endif
extern "C" void kernel_launch(void* const* d_in, const int* in_sizes, int n_in, void* d_out, int out_size, void* d_ws, size_t ws_size, hipStream_t stream) {
    static int grid = 0;
    if (grid == 0) {
        if (n_in != 27 || out_size != NTOK * DM || ws_size < WS_END) { fprintf(stderr, "kernel_launch: unexpected shapes (n_in %d out %d ws %zu need %zu)\n", n_in, out_size, ws_size, (size_t)WS_END); grid = -1; return; }
        int dev = 0, cus = 0, per_cu = 0;
        if (hipGetDevice(&dev) != hipSuccess || hipDeviceGetAttribute(&cus, hipDeviceAttributeMultiprocessorCount, dev) != hipSuccess) { grid = -1; return; }
        if (hipFuncSetAttribute((const void*)hymba_fwd, hipFuncAttributeMaxDynamicSharedMemorySize, LDS_BYTES) != hipSuccess) { fprintf(stderr, "kernel_launch: hipFuncSetAttribute failed\n"); grid = -1; return; }
        if (hipOccupancyMaxActiveBlocksPerMultiprocessor(&per_cu, (const void*)hymba_fwd, NTHREADS, LDS_BYTES) != hipSuccess || per_cu < 1) { fprintf(stderr, "kernel_launch: occupancy query says %d\n", per_cu); }
        (void)hipGetLastError();
        grid = cus;
    }
    if (grid < 0) return;
    (void)hipMemsetAsync((char*)d_ws + WS_BAR, 0, 16384, stream);
    Params p{};
    for (int i = 0; i < 27; ++i) p.in[i] = (const float*)d_in[i];
    p.out = (float*)d_out; p.ws = (unsigned char*)d_ws;
#if N_LAUNCH_SPLIT
    for (int ph = 0; ph < 10; ++ph) { p.ph_lo = ph; p.ph_hi = ph + 1; hipLaunchKernelGGL(hymba_fwd, dim3(grid), dim3(NTHREADS), LDS_BYTES, stream, p); }
#else
    p.ph_lo = 0; p.ph_hi = 10;
    hipLaunchKernelGGL(hymba_fwd, dim3(grid), dim3(NTHREADS), LDS_BYTES, stream, p);
#endif
    const hipError_t le = hipPeekAtLastError();
    if (le != hipSuccess) fprintf(stderr, "kernel_launch: launch failed: %s\n", hipGetErrorName(le));
}
```

```cpp
#include <hip/hip_runtime.h>
#include <cstdio>
#include <cstdint>

#define LAS __attribute__((address_space(3)))
typedef unsigned short bf16_t;
typedef short bf16x8 __attribute__((ext_vector_type(8)));
typedef short bf16x4 __attribute__((ext_vector_type(4)));
typedef float f32x4 __attribute__((ext_vector_type(4)));
typedef float f32x2 __attribute__((ext_vector_type(2)));
typedef unsigned u32x4 __attribute__((ext_vector_type(4)));
typedef unsigned u32x2 __attribute__((ext_vector_type(2)));

constexpr int DM = 2048, NB = 8, SEQ = 2048, NTOK = NB * SEQ;
constexpr int NPROJ = 5120;
constexpr int NMOD = 6 * DM;
constexpr int NEXP = 32, DEXP = 1024;
constexpr int NTHREADS = 512;

constexpr size_t WS_BAR   = 0;
constexpr size_t WS_CNT   = 16384;
constexpr size_t WS_ROWSS1= WS_CNT + 8192;
constexpr size_t WS_ROWSS2= WS_ROWSS1 + (size_t)16384 * 16 * 4;
constexpr size_t WS_MODP  = WS_ROWSS2 + (size_t)16384 * 32 * 4;
constexpr size_t WS_MOD   = WS_MODP + (size_t)4 * 8 * NMOD * 4;
constexpr size_t WS_ROPE  = WS_MOD + (size_t)8 * NMOD * 4;
constexpr size_t WS_SSMA  = WS_ROPE + (size_t)2048 * 64 * 8;
constexpr size_t WS_WR    = WS_SSMA + (size_t)64 * 64 * 8;
constexpr size_t WS_SSMM  = WS_WR + (size_t)48 * 2048 * 2;
constexpr size_t WS_WIN   = WS_SSMM + (size_t)64 * 131072 * 2;
constexpr size_t WS_WOUT  = WS_WIN + (size_t)NPROJ * DM * 2;
constexpr size_t WS_WGLU  = WS_WOUT + (size_t)DM * DM * 2;
constexpr size_t WS_WGU   = WS_WGLU + (size_t)1024 * 1024 * 2;
constexpr size_t WS_WD    = WS_WGU + (size_t)NEXP * 2048 * 2048 * 2;
constexpr size_t WS_H     = WS_WD + (size_t)NEXP * 2048 * 1024 * 2;
constexpr size_t WS_PROJ  = WS_H + (size_t)NTOK * DM * 2;
constexpr size_t WS_Z     = WS_PROJ + (size_t)NTOK * NPROJ * 2;
constexpr size_t WS_CAT   = WS_Z + (size_t)NTOK * 1024 * 2;
constexpr size_t WS_WGT   = WS_CAT + (size_t)NTOK * DM * 2;
constexpr size_t WS_LIST  = WS_WGT + (size_t)32768 * 4;
constexpr size_t WS_X1    = WS_LIST + (size_t)32 * 16384 * 4;
constexpr size_t WS_END   = WS_X1 + (size_t)NTOK * DM * 2;
constexpr size_t WS_Y2    = WS_PROJ;
constexpr size_t WS_HM    = WS_Z;

constexpr int LDS_STAGE = 131072;
constexpr int LDS_BYTES = 147456;
constexpr int LDS_MISC  = LDS_BYTES - 2048;

struct Params { const float* in[27]; float* out; unsigned char* ws; int ph_lo, ph_hi; };

#define XB_TMO      128
#define XB_XCNT(j)  (256  + 64 * (j))
#define XB_XSUB(j)  (1280 + 64 * (j))
#define XB_XGEN(j)  (2304 + 64 * (j))
#define XB_TOP      3328
#define XB_TOPGEN   3392
#define XCD_BAR_WORDS 3456
#define XB_SPIN_CAP (1u << 22)

__device__ __forceinline__ unsigned xb_ld(unsigned* p)              { return __hip_atomic_load(p, __ATOMIC_RELAXED, __HIP_MEMORY_SCOPE_AGENT); }
__device__ __forceinline__ unsigned xb_add(unsigned* p, unsigned v) { return __hip_atomic_fetch_add(p, v, __ATOMIC_RELAXED, __HIP_MEMORY_SCOPE_AGENT); }
__device__ __forceinline__ unsigned xb_xcc_id() { return (unsigned)__builtin_amdgcn_s_getreg((3 << 11) | 20) & 0xFu; }
#define XB_SPIN(cond, bar) do { unsigned _sp = 0; while (cond) { __builtin_amdgcn_s_sleep(1); \
    if ((++_sp & 255u) == 0u) { if (xb_ld(&(bar)[XB_TMO])) break; if (_sp > XB_SPIN_CAP) { atomicAdd(&(bar)[XB_TMO], 1u); break; } } } } while (0)

struct XcdBarrier { unsigned* bar; unsigned x; volatile LAS unsigned* st; };

__device__ __forceinline__ XcdBarrier xcd_barrier_post(unsigned* bar, volatile LAS unsigned* st) {
    XcdBarrier b; b.bar = bar; b.x = xb_xcc_id(); b.st = st;
    if (threadIdx.x == 0) (void)xb_add(&bar[XB_XCNT(b.x)], 1u);
    return b;
}
__device__ __forceinline__ void xcd_barrier_complete(unsigned* bar, unsigned x, unsigned& nloc, unsigned& nx) {
    const unsigned G = gridDim.x * gridDim.y * gridDim.z;
    unsigned sum, cnt, mine, sp = 0u;
    for (;;) {
        sum = 0u; cnt = 0u; mine = 0u;
#pragma unroll
        for (unsigned j = 0; j < 16; ++j) { const unsigned c = xb_ld(&bar[XB_XCNT(j)]); sum += c; cnt += (c > 0u) ? 1u : 0u; mine = (j == x) ? c : mine; }
        if (sum == G) break;
        __builtin_amdgcn_s_sleep(1);
        if ((++sp & 255u) == 0u) { if (xb_ld(&bar[XB_TMO])) break; if (sp > XB_SPIN_CAP) { atomicAdd(&bar[XB_TMO], 1u); break; } }
    }
    nloc = mine > 0u ? mine : 1u; nx = cnt > 0u ? cnt : 1u;
}
__device__ __forceinline__ void xcd_barrier(const XcdBarrier& b) {
    asm volatile("s_waitcnt vmcnt(0)" ::: "memory");
    __syncthreads();
    if (threadIdx.x == 0) {
        unsigned* bar = b.bar;
        __builtin_amdgcn_s_waitcnt(0);
        unsigned nloc = b.st[0], nx = b.st[1];
        if (nloc == 0u) { xcd_barrier_complete(bar, b.x, nloc, nx); b.st[0] = nloc; b.st[1] = nx; }
        const unsigned old = xb_add(&bar[XB_XSUB(b.x)], 1u);
        const unsigned gen = old / nloc;
        if (old + 1u == (gen + 1u) * nloc) {
            __builtin_amdgcn_fence(__ATOMIC_RELEASE, "agent");
            asm volatile("s_waitcnt vmcnt(0)" ::: "memory");
            const unsigned og = xb_add(&bar[XB_TOP], 1u);
            const unsigned tg = og / nx;
            if (og + 1u == (tg + 1u) * nx) xb_add(&bar[XB_TOPGEN], 1u);
            else XB_SPIN(xb_ld(&bar[XB_TOPGEN]) == tg, bar);
            __builtin_amdgcn_fence(__ATOMIC_ACQUIRE, "agent");
            xb_add(&bar[XB_XGEN(b.x)], 1u);
            asm volatile("s_waitcnt vmcnt(0)" ::: "memory");
        } else {
            XB_SPIN(xb_ld(&bar[XB_XGEN(b.x)]) == gen, bar);
            __builtin_amdgcn_fence(__ATOMIC_ACQUIRE, "agent");
            asm volatile("s_waitcnt vmcnt(0)" ::: "memory");
        }
    }
    __syncthreads();
}

typedef __bf16 bf16x2_t __attribute__((ext_vector_type(2)));
__device__ __forceinline__ unsigned cvt_pk_bf16(float lo, float hi) { const f32x2 v = {lo, hi}; return __builtin_bit_cast(unsigned, __builtin_convertvector(v, bf16x2_t)); }
__device__ __forceinline__ float bf_lo(unsigned w) { return __uint_as_float(w << 16); }
__device__ __forceinline__ float bf_hi(unsigned w) { return __uint_as_float(w & 0xffff0000u); }
__device__ __forceinline__ float sigmoidf_(float x) { return 1.0f / (1.0f + __expf(-x)); }
__device__ __forceinline__ float gelu_tanh(float x) {
    const float u = 0.7978845608028654f * (x + 0.044715f * x * x * x);
    const float t = 1.0f - 2.0f / (1.0f + __expf(2.0f * u));
    return 0.5f * x * (1.0f + t);
}
__device__ __forceinline__ float wave_sum(float v) {
    v += __shfl_xor(v, 1); v += __shfl_xor(v, 2); v += __shfl_xor(v, 4); v += __shfl_xor(v, 8); v += __shfl_xor(v, 16); v += __shfl_xor(v, 32); return v;
}
__device__ __forceinline__ void sincos_d(double x, double& s, double& c) {
    const double TWO_PI = 6.283185307179586476925286766559;
    double r = x - TWO_PI * rint(x / TWO_PI);
    const double r2 = r * r;
    double ts = r, tc = 1.0; s = r; c = 1.0;
#pragma unroll 1
    for (int k = 1; k <= 14; ++k) { tc *= -r2 / (double)((2 * k - 1) * (2 * k)); ts *= -r2 / (double)((2 * k) * (2 * k + 1)); c += tc; s += ts; }
}

namespace g8 {
constexpr int BM = 256, BK = 64, HALF = 128, HTB = HALF * BK * 2, NXCD = 8, WGM = 8;
__device__ __forceinline__ int lds_byte(int r, int c) { const int st = (r >> 4) * 2 + (c >> 5), rr = r & 15, cc = c & 31, ob = rr * 64 + cc * 2; return st * 1024 + (ob ^ (((ob >> 9) & 1) << 5)); }
__device__ __forceinline__ void stage_rc(int b, int& R, int& C) { const int st = b / 1024, sb = b % 1024, swz = sb ^ (((sb >> 9) & 1) << 5); R = (st >> 1) * 16 + swz / 64; C = (st & 1) * 32 + (swz % 64) / 2; }
__device__ __forceinline__ int perm32(int rho) { const int n = rho >> 4, i = rho & 15; return 8 * (i >> 2) + 4 * n + (i & 3); }

struct Unit { unsigned aoff, boff; int pm, pn, flags, aux, aux2; };
typedef f32x4 Acc[2][2][4][2];

struct StaticOrder {
    int nM, nN, nwg, G, c;
    __device__ void init(int M, int N, int G_, int c_) { nM = M / BM; nN = N / BM; nwg = nM * nN; G = G_; c = c_; }
    __device__ __forceinline__ bool tile(int i, int& pm, int& pn) const {
        const long L = (long)i * G + c; if (L >= nwg) return false;
        int wgid = (int)L; { const int q = nwg / NXCD, r = nwg % NXCD, xcd = wgid % NXCD, off = wgid / NXCD; wgid = (xcd < r ? xcd * (q + 1) : r * (q + 1) + (xcd - r) * q) + off; }
        const int nig = WGM * nN, gid = wgid / nig, fm = gid * WGM, gsz = (nM - fm) < WGM ? (nM - fm) : WGM;
        pm = fm + ((wgid % nig) % gsz); pn = (wgid % nig) / gsz; return true;
    }
};

template <class Epi, class Sched, bool SKIP = false>
__device__ __forceinline__ void gemm_phase(LAS unsigned char* lds, const unsigned char* ws, const int nt, const int ldb  , const Sched& S, const Epi& E) {
    const int tid = threadIdx.x, wid = __builtin_amdgcn_readfirstlane(tid >> 6), lane = tid & 63, wr = wid >> 2, wc = wid & 3, fr = lane & 15, fq = lane >> 4;
    int R0, C0, R1, C1; stage_rc(tid * 16, R0, C0); stage_rc(tid * 16 + 8192, R1, C1);
    unsigned voffB[2];
    { const int Rb0 = Epi::PERM ? ((R0 & ~31) + perm32(R0 & 31)) : R0, Rb1 = Epi::PERM ? ((R1 & ~31) + perm32(R1 & 31)) : R1;
      voffB[0] = (unsigned)(Rb0 * 64 + C0) * 2u; voffB[1] = (unsigned)(Rb1 * 64 + C1) * 2u; }
    const unsigned kstep = (unsigned)(BK * 2);
    const unsigned kstepB = 256u * 64u * 2u;
    const unsigned hstepB = (unsigned)HALF * 64u * 2u;
    const unsigned ldsw = (unsigned)wid * 1024u;
    const int aoff = lds_byte(wr * 64 + fr, fq * 8), boff = lds_byte(wc * 32 + fr, fq * 8);
#define G8_SA(b, h) (((b) * 2 + (h)) * HTB)
#define G8_SB(b, h) ((4 + (b) * 2 + (h)) * HTB)
#define G8_STAGE(bufoff, gbase, v0, v1) do { \
        __builtin_amdgcn_global_load_lds((const unsigned*)((gbase) + (v0)), (LAS unsigned*)(lds + (bufoff) + ldsw), 16, 0, 0); \
        __builtin_amdgcn_global_load_lds((const unsigned*)((gbase) + (v1)), (LAS unsigned*)(lds + (bufoff) + ldsw + 8192), 16, 0, 0); } while (0)
#define G8_LDA(dst, b, h) do { _Pragma("unroll") for (int m = 0; m < 4; ++m) _Pragma("unroll") for (int k = 0; k < 2; ++k) dst[m][k] = *(const LAS bf16x8*)(lds + G8_SA(b, h) + aoff + m * 2048 + k * 1024); } while (0)
#define G8_LDB(dst, b, h) do { _Pragma("unroll") for (int n = 0; n < 2; ++n) _Pragma("unroll") for (int k = 0; k < 2; ++k) dst[n][k] = *(const LAS bf16x8*)(lds + G8_SB(b, h) + boff + n * 2048 + k * 1024); } while (0)
#define G8_MMA(ai, bj, At, Bt) do { __builtin_amdgcn_s_setprio(1); _Pragma("unroll") for (int m = 0; m < 4; ++m) _Pragma("unroll") for (int n = 0; n < 2; ++n) _Pragma("unroll") for (int k = 0; k < 2; ++k) \
        acc[ai][bj][m][n] = __builtin_amdgcn_mfma_f32_16x16x32_bf16(Bt[n][k], At[m][k], acc[ai][bj][m][n], 0, 0, 0); __builtin_amdgcn_s_setprio(0); } while (0)
#define G8_WAIT_V(n) asm volatile("s_waitcnt vmcnt(" #n ")" ::: "memory")
#define G8_WAIT_L(n) asm volatile("s_waitcnt lgkmcnt(" #n ")" ::: "memory")
#define G8_BAR __builtin_amdgcn_s_barrier()
#define G8_SCHED __builtin_amdgcn_sched_barrier(0)
    Unit cur, nxt; int ui = 0;
    if (!S.next(0, cur)) return;
    Acc acc;
#pragma unroll
    for (int a = 0; a < 2; ++a)
#pragma unroll
        for (int b = 0; b < 2; ++b)
#pragma unroll
            for (int m = 0; m < 4; ++m)
#pragma unroll
                for (int n = 0; n < 2; ++n) acc[a][b][m][n] = (f32x4){0.f, 0.f, 0.f, 0.f};
    bf16x8 At[4][2], B0[2][2], B1[2][2];
    unsigned cv[2][2], nv[2][2];
    S.aoffs(cur, R0, C0, R1, C1, cv);
    const unsigned char* cA = ws + cur.aoff; const unsigned char* cB = ws + cur.boff;
    G8_STAGE(G8_SB(0, 0), cB, voffB[0], voffB[1]); G8_STAGE(G8_SA(0, 0), cA, cv[0][0], cv[0][1]);
    G8_STAGE(G8_SB(0, 1), cB + hstepB, voffB[0], voffB[1]); G8_STAGE(G8_SA(0, 1), cA, cv[1][0], cv[1][1]);
    if (wr == 1) G8_BAR;
    G8_WAIT_V(4); G8_BAR;
    G8_STAGE(G8_SB(1, 0), cB + kstepB, voffB[0], voffB[1]); G8_STAGE(G8_SA(1, 0), cA + kstep, cv[0][0], cv[0][1]);
    G8_STAGE(G8_SB(1, 1), cB + hstepB + kstepB, voffB[0], voffB[1]);
    G8_WAIT_V(6); G8_BAR;
    for (;;) {
        const bool has_next = S.next(ui + 1, nxt);
        if (has_next) S.aoffs(nxt, R0, C0, R1, C1, nv);
        else { nv[0][0] = cv[0][0]; nv[0][1] = cv[0][1]; nv[1][0] = cv[1][0]; nv[1][1] = cv[1][1]; }
        const unsigned char* nA = has_next ? ws + nxt.aoff : cA; const unsigned char* nB = has_next ? ws + nxt.boff : cB;
        const int vrows = SKIP ? cur.aux2 : 256;
        const bool do0 = !SKIP || vrows > 64 || wr == 0, do1 = !SKIP || vrows > 128;
        for (int t = 0; t < nt; t += 2) {
            const bool last = (t == nt - 2);
            const unsigned char* a1 = cA + (size_t)(t + 1) * kstep;
            const unsigned char* a2 = last ? nA : cA + (size_t)(t + 2) * kstep; const unsigned char* b2 = last ? nB : cB + (size_t)(t + 2) * kstepB;
            const unsigned char* a3 = a2 + kstep; const unsigned char* b3 = b2 + kstepB;
            const unsigned o00 = last ? nv[0][0] : cv[0][0], o01 = last ? nv[0][1] : cv[0][1], o10 = last ? nv[1][0] : cv[1][0], o11 = last ? nv[1][1] : cv[1][1];
            G8_LDB(B0, 0, 0); G8_SCHED; G8_LDA(At, 0, 0); G8_STAGE(G8_SA(1, 1), a1, cv[1][0], cv[1][1]);
            G8_WAIT_L(8); G8_BAR; G8_WAIT_L(0); if (do0) G8_MMA(0, 0, At, B0); G8_BAR; G8_SCHED;
            G8_LDB(B1, 0, 1); G8_STAGE(G8_SB(0, 0), b2, voffB[0], voffB[1]);
            G8_BAR; G8_WAIT_L(0); if (do0) G8_MMA(0, 1, At, B1); G8_BAR;
            G8_LDA(At, 0, 1); G8_STAGE(G8_SA(0, 0), a2, o00, o01);
            G8_BAR; G8_WAIT_L(0); if (do1) G8_MMA(1, 0, At, B0); G8_BAR; G8_SCHED;
            G8_STAGE(G8_SB(0, 1), b2 + hstepB, voffB[0], voffB[1]);
            G8_WAIT_V(6); G8_BAR; if (do1) G8_MMA(1, 1, At, B1); G8_BAR;
            G8_LDB(B0, 1, 0); G8_SCHED; G8_LDA(At, 1, 0); G8_STAGE(G8_SA(0, 1), a2, o10, o11);
            G8_WAIT_L(8); G8_BAR; G8_WAIT_L(0); if (do0) G8_MMA(0, 0, At, B0); G8_BAR; G8_SCHED;
            G8_LDB(B1, 1, 1); G8_STAGE(G8_SB(1, 0), b3, voffB[0], voffB[1]);
            G8_BAR; G8_WAIT_L(0); if (do0) G8_MMA(0, 1, At, B1); G8_BAR;
            G8_LDA(At, 1, 1); G8_STAGE(G8_SA(1, 0), a3, o00, o01);
            G8_BAR; G8_WAIT_L(0); if (do1) G8_MMA(1, 0, At, B0); G8_BAR; G8_SCHED;
            G8_STAGE(G8_SB(1, 1), b3 + hstepB, voffB[0], voffB[1]);
            G8_WAIT_V(6); G8_BAR; if (do1) G8_MMA(1, 1, At, B1); G8_BAR;
        }
        E(acc, cur, wr, wc, fr, fq);
        if (!has_next) break;
        if (!(cur.flags & 1)) {
#pragma unroll
            for (int a = 0; a < 2; ++a)
#pragma unroll
                for (int b = 0; b < 2; ++b)
#pragma unroll
                    for (int m = 0; m < 4; ++m)
#pragma unroll
                        for (int n = 0; n < 2; ++n) acc[a][b][m][n] = (f32x4){0.f, 0.f, 0.f, 0.f};
        }
        cur = nxt; cA = nA; cB = nB; ++ui;
        cv[0][0] = nv[0][0]; cv[0][1] = nv[0][1]; cv[1][0] = nv[1][0]; cv[1][1] = nv[1][1];
    }
    G8_WAIT_V(0);
    if (wr == 0) G8_BAR;
    G8_BAR;
#undef G8_SA
#undef G8_SB
#undef G8_STAGE
#undef G8_LDA
#undef G8_LDB
#undef G8_MMA
#undef G8_WAIT_V
#undef G8_WAIT_L
#undef G8_BAR
#undef G8_SCHED
}
}

__device__ __forceinline__ void p0_adaln(const Params& P, LAS unsigned char* lds, int tid, int item) {
    const int ks = item & 3, nc = item >> 2;
    LAS float* sc = (LAS float*)lds;
    LAS float* red = (LAS float*)(lds + 16384);
    const float* c = P.in[1];
    for (int i = tid; i < 4096; i += NTHREADS) { const int kl = i >> 3, b = i & 7; const float v = c[b * 2048 + ks * 512 + kl]; sc[i] = v / (1.0f + expf(-v)); }
    __syncthreads();
    if (tid < 384) {
        const int nq = tid % 48, kg = tid / 48;
        const float* W = P.in[2] + (size_t)(ks * 512 + kg * 64) * NMOD + nc * 192 + nq * 4;
        f32x4 acc[8];
#pragma unroll
        for (int b = 0; b < 8; ++b) acc[b] = (f32x4){0.f, 0.f, 0.f, 0.f};
#pragma unroll 16
        for (int kk = 0; kk < 64; ++kk) {
            const f32x4 w = *(const f32x4*)(W + (size_t)kk * NMOD);
            const f32x4 s0 = *(const LAS f32x4*)(sc + (kg * 64 + kk) * 8), s1 = *(const LAS f32x4*)(sc + (kg * 64 + kk) * 8 + 4);
            acc[0] += w * s0[0]; acc[1] += w * s0[1]; acc[2] += w * s0[2]; acc[3] += w * s0[3];
            acc[4] += w * s1[0]; acc[5] += w * s1[1]; acc[6] += w * s1[2]; acc[7] += w * s1[3];
        }
#pragma unroll
        for (int b = 0; b < 8; ++b) *(LAS f32x4*)(red + (kg * 8 + b) * 192 + nq * 4) = acc[b];
    }
    __syncthreads();
    float* modp = (float*)(P.ws + WS_MODP);
    for (int i = tid; i < 8 * 192; i += NTHREADS) {
        const int b = i / 192, n = i % 192; float s = 0.f;
#pragma unroll
        for (int kg = 0; kg < 8; ++kg) s += red[(kg * 8 + b) * 192 + n];
        modp[(size_t)(ks * 8 + b) * NMOD + nc * 192 + n] = s;
    }
    __syncthreads();
}

struct CvtUnit { const float* src; bf16_t* dst; int Nd, Kd, k0, n0, nmode; const float* s0; const float* s1; };
constexpr int CVT_UNITS = 640 + 256 + 64 + 3 * 4096;
__device__ __forceinline__ void cvt_unit_decode(const Params& P, int L, CvtUnit& u) {
    u.s0 = nullptr; u.s1 = nullptr; u.nmode = 0;
    if (L < 640) { u.src = P.in[5]; u.dst = (bf16_t*)(P.ws + WS_WIN); u.Kd = 2048; u.Nd = 5120; u.k0 = (L / 20) * 64; u.n0 = (L % 20) * 256; u.nmode = 3; return; }
    L -= 640;
    if (L < 256) { u.src = P.in[17]; u.dst = (bf16_t*)(P.ws + WS_WOUT); u.Kd = 2048; u.Nd = 2048; u.k0 = (L / 8) * 64; u.n0 = (L % 8) * 256; u.s0 = P.in[15]; u.s1 = P.in[16]; return; }
    L -= 256;
    if (L < 64) { u.src = P.in[14]; u.dst = (bf16_t*)(P.ws + WS_WGLU); u.Kd = 1024; u.Nd = 1024; u.k0 = (L / 4) * 64; u.n0 = (L % 4) * 256; return; }
    L -= 64;
    if (L < 4096) { const int e = L >> 7, r = L & 127; u.src = P.in[23] + (size_t)e * 2048 * 1024; u.dst = (bf16_t*)(P.ws + WS_WGU) + (size_t)e * 2048 * 2048; u.Kd = 2048; u.Nd = 1024; u.k0 = (r >> 2) * 64; u.n0 = (r & 3) * 256; u.nmode = 1; return; }
    L -= 4096;
    if (L < 4096) { const int e = L >> 7, r = L & 127; u.src = P.in[24] + (size_t)e * 2048 * 1024; u.dst = (bf16_t*)(P.ws + WS_WGU) + (size_t)e * 2048 * 2048; u.Kd = 2048; u.Nd = 1024; u.k0 = (r >> 2) * 64; u.n0 = (r & 3) * 256; u.nmode = 2; return; }
    L -= 4096;
    { const int e = L >> 7, r = L & 127; u.src = P.in[25] + (size_t)e * 1024 * 2048; u.dst = (bf16_t*)(P.ws + WS_WD) + (size_t)e * 2048 * 1024; u.Kd = 1024; u.Nd = 2048; u.k0 = (r >> 3) * 64; u.n0 = (r & 7) * 256; }
}
__device__ __forceinline__ void cvt_load(const CvtUnit& u, int tid, f32x4 (&r)[8]) {
    const int kp = tid >> 4, nq = tid & 15;
    const float* p = u.src + (size_t)(u.k0 + 2 * kp) * u.Nd + u.n0 + nq * 4;
#pragma unroll
    for (int s = 0; s < 4; ++s) { r[2 * s] = *(const f32x4*)(p + s * 64); r[2 * s + 1] = *(const f32x4*)(p + u.Nd + s * 64); }
    if (u.s0) {
        const int k = u.k0 + 2 * kp;
        const float a = (k < 1024) ? u.s0[k] : u.s1[k - 1024], b = (k + 1 < 1024) ? u.s0[k + 1] : u.s1[k + 1 - 1024];
#pragma unroll
        for (int s = 0; s < 4; ++s) { r[2 * s] *= a; r[2 * s + 1] *= b; }
    }
}
__device__ __forceinline__ void cvt_to_lds(LAS unsigned* tile, const f32x4 (&r)[8], int kp, int nq) {
#pragma unroll
    for (int s = 0; s < 4; ++s)
#pragma unroll
        for (int j = 0; j < 4; ++j) tile[s * 2112 + (nq * 4 + j) * 33 + kp] = cvt_pk_bf16(r[2 * s][j], r[2 * s + 1][j]);
}
__device__ __forceinline__ void cvt_store(const LAS unsigned* tile, const CvtUnit& u, int nl, int kq) {
#pragma unroll
    for (int s = 0; s < 4; ++s) {
        u32x4 w; w.x = tile[s * 2112 + nl * 33 + kq * 4]; w.y = tile[s * 2112 + nl * 33 + kq * 4 + 1]; w.z = tile[s * 2112 + nl * 33 + kq * 4 + 2]; w.w = tile[s * 2112 + nl * 33 + kq * 4 + 3];
        const int n = u.n0 + s * 64 + nl;
        int np = n;
        if (u.nmode == 1 || u.nmode == 2) np = (n >> 7) * 256 + (n & 127) + (u.nmode == 2 ? 128 : 0);
        else if (u.nmode == 3 && n >= 1024 && n < 3072) { const int reg = (n >= 2048) ? 2048 : 1024, nr = n - reg;
            np = reg + ((nr >> 8) << 8) + (((nr >> 6) & 1) << 7) + (((nr >> 7) & 1) << 6) + (nr & 63); }
        *(u32x4*)(u.dst + (size_t)(np >> 8) * ((size_t)u.Kd * 256) + (size_t)(u.k0 >> 6) * 16384 + (np & 255) * 64 + kq * 8) = w;
    }
}
__device__ __forceinline__ void p0_convert(const Params& P, LAS unsigned char* lds, int tid, int blk, int G) {
    LAS unsigned* tileA = (LAS unsigned*)lds;
    LAS unsigned* tileB = tileA + 4 * 2112;
    const int kp = tid >> 4, nq = tid & 15, nl = tid >> 3, kq = tid & 7;
    CvtUnit uA, uB, nA, nB; f32x4 rA[8], rB[8];
    int L = blk;
    if (L >= CVT_UNITS) return;
    bool hasB = (L + G) < CVT_UNITS;
    cvt_unit_decode(P, L, uA); cvt_load(uA, tid, rA);
    if (hasB) { cvt_unit_decode(P, L + G, uB); cvt_load(uB, tid, rB); }
    for (;;) {
        cvt_to_lds(tileA, rA, kp, nq);
        if (hasB) cvt_to_lds(tileB, rB, kp, nq);
        __syncthreads();
        const int Ln = L + 2 * G; const bool moreA = Ln < CVT_UNITS, moreB = (Ln + G) < CVT_UNITS;
        if (moreA) { cvt_unit_decode(P, Ln, nA); cvt_load(nA, tid, rA); }
        if (moreB) { cvt_unit_decode(P, Ln + G, nB); cvt_load(nB, tid, rB); }
        cvt_store(tileA, uA, nl, kq);
        if (hasB) cvt_store(tileB, uB, nl, kq);
        __syncthreads();
        if (!moreA) break;
        uA = nA; uB = nB; hasB = moreB; L = Ln;
    }
}

__device__ __forceinline__ void p0_ssm_mats(const Params& P, LAS unsigned char* lds, int tid, int item) {
    const int g = item & 63, q = item >> 6;
    LAS f32x2* pw = (LAS f32x2*)lds;
    LAS f32x2* Bb = pw + 17 * 64;
    LAS f32x2* Cc = Bb + 64 * 16;
    LAS float* Kt = (LAS float*)(Cc + 16 * 64);
    if (tid < 64) {
        const int p = tid;
        const float dt = expf(P.in[13][g]);
        const float are = P.in[6][g * 64 + p], aim = P.in[7][g * 64 + p];
        const float mag = expf(dt * are);
        double sd, cd; sincos_d((double)(dt * aim), sd, cd);
        const float abr = mag * (float)cd, abi = mag * (float)sd;
        const float inv = 1.0f / (are * are + aim * aim);
        const float nre = abr - 1.0f;
        const float fre = (nre * are + abi * aim) * inv, fim = (abi * are - nre * aim) * inv;
        float pr = 1.0f, pi = 0.0f;
        for (int n = 0; n <= 16; ++n) { pw[n * 64 + p] = (f32x2){pr, pi}; const float t = pr * abr - pi * abi; pi = pr * abi + pi * abr; pr = t; }
        for (int h = 0; h < 16; ++h) {
            const float br = P.in[8][(g * 64 + p) * 16 + h], bi = P.in[9][(g * 64 + p) * 16 + h];
            Bb[p * 16 + h] = (f32x2){fre * br - fim * bi, fre * bi + fim * br};
            Cc[h * 64 + p] = (f32x2){P.in[10][(g * 16 + h) * 64 + p], P.in[11][(g * 16 + h) * 64 + p]};
        }
        if (q == 0) { f32x2* AL = (f32x2*)(P.ws + WS_SSMA); const f32x2 v = pw[16 * 64 + p]; AL[g * 64 + p] = v; }
    }
    __syncthreads();
    for (int o = tid; o < 4096; o += NTHREADS) {
        const int tau = o >> 8, ho = (o >> 4) & 15, hi = o & 15; float s = 0.f;
        for (int p = 0; p < 64; ++p) {
            const f32x2 c = Cc[ho * 64 + p], a = pw[tau * 64 + p], b = Bb[p * 16 + hi];
            const float cr = c.x * a.x - c.y * a.y, ci = c.x * a.y + c.y * a.x;
            s += cr * b.x - ci * b.y;
        }
        Kt[o] = s;
    }
    __syncthreads();
    bf16_t* Ms = (bf16_t*)(P.ws + WS_SSMM) + (size_t)g * 131072;
    bf16_t* TM = Ms + 32768;
    for (int o = tid; o < 32 * 128; o += NTHREADS) {
        const int row = 32 * q + (o >> 7), col = (o & 127) * 2;
        const int p = row >> 1, j = col >> 4, hi = col & 15;
        const f32x2 a = pw[(15 - j) * 64 + p], b0 = Bb[p * 16 + hi], b1 = Bb[p * 16 + hi + 1];
        float v0, v1;
        if ((row & 1) == 0) { v0 = a.x * b0.x - a.y * b0.y; v1 = a.x * b1.x - a.y * b1.y; } else { v0 = a.x * b0.y + a.y * b0.x; v1 = a.x * b1.y + a.y * b1.x; }
        *(unsigned*)(Ms + (size_t)row * 256 + col) = cvt_pk_bf16(v0, v1);
    }
    for (int o = tid; o < 64 * 192; o += NTHREADS) {
        const int row = 64 * q + o / 192, col = (o % 192) * 2;
        const int i = row >> 4, ho = row & 15; float v0, v1;
        if (col < 256) { const int j = col >> 4, hi = col & 15; if (j <= i) { v0 = Kt[((i - j) * 16 + ho) * 16 + hi]; v1 = Kt[((i - j) * 16 + ho) * 16 + hi + 1]; } else { v0 = 0.f; v1 = 0.f; } }
        else { const int p0 = (col - 256) >> 1;
            const f32x2 c0 = Cc[ho * 64 + p0], a0 = pw[(i + 1) * 64 + p0];
            v0 = c0.x * a0.x - c0.y * a0.y; v1 = -(c0.x * a0.y + c0.y * a0.x); }
        *(unsigned*)(TM + (size_t)row * 384 + col) = cvt_pk_bf16(v0, v1);
    }
    __syncthreads();
}

__device__ __forceinline__ void p0_misc(const Params& P, int tid, int blk, int G) {
    bf16_t* wr = (bf16_t*)(P.ws + WS_WR);
    for (int i = blk * NTHREADS + tid; i < 48 * 2048; i += G * NTHREADS) {
        const int n = i >> 11, k = i & 2047; float v = 0.f;
        if (n < 4) v = P.in[19][k * 4 + n]; else if (n < 36) v = P.in[21][k * 32 + (n - 4)];
        wr[i] = (bf16_t)(cvt_pk_bf16(v, 0.f) & 0xffffu);
    }
    if (blk == 0) for (int i = tid; i < 2048; i += NTHREADS) ((int*)(P.ws + WS_CNT))[i] = 0;
}

__device__ __forceinline__ void p1_norm1(const Params& P, LAS unsigned char* lds, int tid, int blk, int G) {
    const float* modp = (const float*)(P.ws + WS_MODP); const float* bada = P.in[3];
    float* mod = (float*)(P.ws + WS_MOD);
    for (int i = blk * NTHREADS + tid; i < 8 * NMOD; i += G * NTHREADS) {
        const int b = i / NMOD, j = i % NMOD;
        mod[i] = bada[j] + ((modp[(size_t)(0 * 8 + b) * NMOD + j] + modp[(size_t)(1 * 8 + b) * NMOD + j]) + (modp[(size_t)(2 * 8 + b) * NMOD + j] + modp[(size_t)(3 * 8 + b) * NMOD + j]));
    }
    LAS float* gm = (LAS float*)lds; LAS float* sh = gm + 2048;
    const int wave = tid >> 6, lane = tid & 63;
    bf16_t* H = (bf16_t*)(P.ws + WS_H);
    for (int rb = blk; rb < 256; rb += G) {
        const int b = rb >> 5;
        for (int k = tid; k < 2048; k += NTHREADS) {
            const int js = 2048 + k, jh = k;
            const float sc = bada[js] + ((modp[(size_t)(0 * 8 + b) * NMOD + js] + modp[(size_t)(1 * 8 + b) * NMOD + js]) + (modp[(size_t)(2 * 8 + b) * NMOD + js] + modp[(size_t)(3 * 8 + b) * NMOD + js]));
            const float sv = bada[jh] + ((modp[(size_t)(0 * 8 + b) * NMOD + jh] + modp[(size_t)(1 * 8 + b) * NMOD + jh]) + (modp[(size_t)(2 * 8 + b) * NMOD + jh] + modp[(size_t)(3 * 8 + b) * NMOD + jh]));
            gm[k] = P.in[4][k] * (1.0f + sc); sh[k] = sv;
        }
        __syncthreads();
        f32x4 v[8], vn[8];
        { const float* xr = P.in[0] + (size_t)(rb * 64 + wave * 8) * DM;
#pragma unroll
          for (int i = 0; i < 8; ++i) v[i] = *(const f32x4*)(xr + (i * 64 + lane) * 4); }
        for (int rr = 0; rr < 8; ++rr) {
            const int row = rb * 64 + wave * 8 + rr;
            if (rr < 7) { const float* xn = P.in[0] + (size_t)(row + 1) * DM;
#pragma unroll
                for (int i = 0; i < 8; ++i) vn[i] = *(const f32x4*)(xn + (i * 64 + lane) * 4); }
            float ss = 0.f;
#pragma unroll
            for (int i = 0; i < 8; ++i) ss += v[i][0] * v[i][0] + v[i][1] * v[i][1] + v[i][2] * v[i][2] + v[i][3] * v[i][3];
            ss = wave_sum(ss);
            const float r = rsqrtf(ss * (1.0f / 2048.0f) + 1e-6f);
#pragma unroll
            for (int i = 0; i < 8; ++i) {
                const int k = (i * 64 + lane) * 4;
                const f32x4 g4 = *(const LAS f32x4*)(gm + k), s4 = *(const LAS f32x4*)(sh + k);
                const f32x4 o = v[i] * r * g4 + s4;
                u32x2 w; w.x = cvt_pk_bf16(o[0], o[1]); w.y = cvt_pk_bf16(o[2], o[3]);
                *(u32x2*)(H + (size_t)row * DM + k) = w;
            }
#pragma unroll
            for (int i = 0; i < 8; ++i) v[i] = vn[i];
        }
        __syncthreads();
    }
}

struct DenseSched : g8::StaticOrder {
    unsigned abase, bbase; int lda, ldb;
    __device__ __forceinline__ bool next(int i, g8::Unit& u) const {
        int pm, pn; if (!tile(i, pm, pn)) return false;
        u.pm = __builtin_amdgcn_readfirstlane(pm); u.pn = __builtin_amdgcn_readfirstlane(pn); u.flags = 0; u.aux = 0;
        u.aoff = abase + (unsigned)u.pm * 256u * (unsigned)lda * 2u; u.boff = bbase + (unsigned)u.pn * 256u * (unsigned)ldb * 2u; return true;
    }
    __device__ __forceinline__ void aoffs(const g8::Unit&, int R0, int C0, int R1, int C1, unsigned (&v)[2][2]) const {
        v[0][0] = (unsigned)(R0 * lda + C0) * 2u; v[0][1] = (unsigned)(R1 * lda + C1) * 2u;
        v[1][0] = (unsigned)((128 + R0) * lda + C0) * 2u; v[1][1] = (unsigned)((128 + R1) * lda + C1) * 2u;
    }
};
struct EpiStoreBf16 {
    static constexpr bool PERM = true;
    bf16_t* O; int ldc;
    __device__ __forceinline__ void operator()(g8::Acc& acc, const g8::Unit& u, int wr, int wc, int fr, int fq) const {
        const int row0 = u.pm * 256 + wr * 64 + fr, col0 = u.pn * 256 + wc * 32 + 8 * fq;
#pragma unroll
        for (int ai = 0; ai < 2; ++ai)
#pragma unroll
            for (int m = 0; m < 4; ++m) { bf16_t* rowp = O + (size_t)(row0 + ai * 128 + m * 16) * ldc + col0;
#pragma unroll
                for (int bj = 0; bj < 2; ++bj) { const f32x4 v0 = acc[ai][bj][m][0], v1 = acc[ai][bj][m][1];
                    u32x4 w; w.x = cvt_pk_bf16(v0[0], v0[1]); w.y = cvt_pk_bf16(v0[2], v0[3]); w.z = cvt_pk_bf16(v1[0], v1[1]); w.w = cvt_pk_bf16(v1[2], v1[3]);
                    *(u32x4*)(rowp + bj * 128) = w; } }
    }
};
struct EpiInProj {
    static constexpr bool PERM = true;
    bf16_t* O;
    __device__ __forceinline__ void operator()(g8::Acc& acc, const g8::Unit& u, int wr, int wc, int fr, int fq) const {
        const int pn = u.pn;
        const int row0 = u.pm * 256 + wr * 64 + fr;
        if (pn < 4 || pn >= 12) {
            const int col0 = pn * 256 + wc * 32 + 8 * fq;
#pragma unroll
            for (int ai = 0; ai < 2; ++ai)
#pragma unroll
                for (int m = 0; m < 4; ++m) { bf16_t* rowp = O + (size_t)(row0 + ai * 128 + m * 16) * NPROJ + col0;
#pragma unroll
                    for (int bj = 0; bj < 2; ++bj) { const f32x4 v0 = acc[ai][bj][m][0], v1 = acc[ai][bj][m][1];
                        u32x4 w; w.x = cvt_pk_bf16(v0[0], v0[1]); w.y = cvt_pk_bf16(v0[2], v0[3]); w.z = cvt_pk_bf16(v1[0], v1[1]); w.w = cvt_pk_bf16(v1[2], v1[3]);
                        *(u32x4*)(rowp + bj * 128) = w; } }
            return;
        }
        const bool isq = pn < 8;
        const int head = 2 * ((pn - 4) & 3) + (wc >> 1);
        const int dd0 = 32 * (wc & 1) + 8 * fq;
        const int colbase = (isq ? 1024 : 2048) + head * 128 + dd0;
        const float lg2 = log2f(1.0f - exp2f(-5.0f - (float)head));
        float fr_[8];
#pragma unroll
        for (int t = 0; t < 8; ++t) fr_[t] = exp2f(-(float)(dd0 + t) * 0.20762050593046014f) * 0.15915494309189535f;
#pragma unroll
        for (int ai = 0; ai < 2; ++ai)
#pragma unroll
            for (int m = 0; m < 4; ++m) {
                const int row = row0 + ai * 128 + m * 16, pos = row & 2047, i = wr * 64 + m * 16 + fr;
                const float sc = isq ? exp2f(lg2 * (float)i) : exp2f(-lg2 * (float)i) * 0.08838834764831845f;
                const float fp = (float)pos;
                float o1[8], o2[8];
#pragma unroll
                for (int t = 0; t < 8; ++t) {
                    const float rev = __builtin_amdgcn_fractf(fp * fr_[t]);
                    const float cs = __builtin_amdgcn_cosf(rev) * sc, sn = __builtin_amdgcn_sinf(rev) * sc;
                    const float a = acc[ai][0][m][t >> 2][t & 3], b = acc[ai][1][m][t >> 2][t & 3];
                    o1[t] = a * cs - b * sn; o2[t] = b * cs + a * sn;
                }
                bf16_t* rowp = O + (size_t)row * NPROJ + colbase;
                u32x4 w1, w2; w1.x = cvt_pk_bf16(o1[0], o1[1]); w1.y = cvt_pk_bf16(o1[2], o1[3]); w1.z = cvt_pk_bf16(o1[4], o1[5]); w1.w = cvt_pk_bf16(o1[6], o1[7]);
                w2.x = cvt_pk_bf16(o2[0], o2[1]); w2.y = cvt_pk_bf16(o2[2], o2[3]); w2.z = cvt_pk_bf16(o2[4], o2[5]); w2.w = cvt_pk_bf16(o2[6], o2[7]);
                *(u32x4*)rowp = w1; *(u32x4*)(rowp + 64) = w2;
            }
    }
};
struct EpiGlu {
    static constexpr bool PERM = true;
    const bf16_t* Z; bf16_t* CAT; float* rowss;
    __device__ __forceinline__ void operator()(g8::Acc& acc, const g8::Unit& u, int wr, int wc, int fr, int fq) const {
        const int row0 = u.pm * 256 + wr * 64 + fr, col0 = u.pn * 256 + wc * 32 + 8 * fq;
#pragma unroll
        for (int ai = 0; ai < 2; ++ai) {
            u32x4 zz[4][2];
#pragma unroll
            for (int m = 0; m < 4; ++m)
#pragma unroll
                for (int bj = 0; bj < 2; ++bj) zz[m][bj] = *(const u32x4*)(Z + (size_t)(row0 + ai * 128 + m * 16) * 1024 + col0 + bj * 128);
#pragma unroll
            for (int m = 0; m < 4; ++m) { const int row = row0 + ai * 128 + m * 16; float ss = 0.f;
#pragma unroll
                for (int bj = 0; bj < 2; ++bj) { const f32x4 v0 = acc[ai][bj][m][0], v1 = acc[ai][bj][m][1];
                    const u32x4 z4 = zz[m][bj];
                    float o[8];
                    o[0] = bf_lo(z4.x) * sigmoidf_(v0[0]); o[1] = bf_hi(z4.x) * sigmoidf_(v0[1]); o[2] = bf_lo(z4.y) * sigmoidf_(v0[2]); o[3] = bf_hi(z4.y) * sigmoidf_(v0[3]);
                    o[4] = bf_lo(z4.z) * sigmoidf_(v1[0]); o[5] = bf_hi(z4.z) * sigmoidf_(v1[1]); o[6] = bf_lo(z4.w) * sigmoidf_(v1[2]); o[7] = bf_hi(z4.w) * sigmoidf_(v1[3]);
#pragma unroll
                    for (int j = 0; j < 8; ++j) ss += o[j] * o[j];
                    u32x4 w; w.x = cvt_pk_bf16(o[0], o[1]); w.y = cvt_pk_bf16(o[2], o[3]); w.z = cvt_pk_bf16(o[4], o[5]); w.w = cvt_pk_bf16(o[6], o[7]);
                    *(u32x4*)(CAT + (size_t)row * DM + col0 + bj * 128) = w; }
                ss += __shfl_xor(ss, 16); ss += __shfl_xor(ss, 32);
                if (fq == 0) rowss[(size_t)row * 16 + u.pn * 4 + wc] = ss; }
        }
    }
};
struct OutSched : g8::StaticOrder {
    unsigned abase, bbase;
    __device__ __forceinline__ bool next(int i, g8::Unit& u) const {
        int pm, pn; if (!tile(i >> 1, pm, pn)) return false;
        const int half = i & 1;
        u.pm = __builtin_amdgcn_readfirstlane(pm); u.pn = __builtin_amdgcn_readfirstlane(pn); u.flags = half ? 0 : 1; u.aux = half;
        u.aoff = abase + (unsigned)u.pm * 256u * 4096u + (unsigned)half * 2048u; u.boff = bbase + (unsigned)u.pn * 256u * 4096u + (unsigned)half * (16u * 32768u); return true;
    }
    __device__ __forceinline__ void aoffs(const g8::Unit&, int R0, int C0, int R1, int C1, unsigned (&v)[2][2]) const {
        v[0][0] = (unsigned)(R0 * 2048 + C0) * 2u; v[0][1] = (unsigned)(R1 * 2048 + C1) * 2u;
        v[1][0] = (unsigned)((128 + R0) * 2048 + C0) * 2u; v[1][1] = (unsigned)((128 + R1) * 2048 + C1) * 2u;
    }
};
struct EpiOut {
    static constexpr bool PERM = true;
    const float* x; const float* mod; const float* rowss1; float* rowss2; bf16_t* X1;
    __device__ __forceinline__ void operator()(g8::Acc& acc, const g8::Unit& u, int wr, int wc, int fr, int fq) const {
        const int row0 = u.pm * 256 + wr * 64 + fr;
        if (u.aux == 0) {
#pragma unroll
            for (int ai = 0; ai < 2; ++ai)
#pragma unroll
                for (int m = 0; m < 4; ++m) { const f32x4* pp = (const f32x4*)(rowss1 + (size_t)(row0 + ai * 128 + m * 16) * 16);
                    const f32x4 p0 = pp[0], p1 = pp[1], p2 = pp[2], p3 = pp[3];
                    const float tot = (((p0[0] + p0[1]) + (p0[2] + p0[3])) + ((p1[0] + p1[1]) + (p1[2] + p1[3]))) + (((p2[0] + p2[1]) + (p2[2] + p2[3])) + ((p3[0] + p3[1]) + (p3[2] + p3[3])));
                    const float r = rsqrtf(tot * (1.0f / 1024.0f) + 1e-6f);
#pragma unroll
                    for (int bj = 0; bj < 2; ++bj)
#pragma unroll
                        for (int n = 0; n < 2; ++n) acc[ai][bj][m][n] *= r; }
            return;
        }
        const int col0 = u.pn * 256 + wc * 32 + 8 * fq;
        const int b = (u.pm * 256) >> 11;
        f32x4 gt[2][2];
#pragma unroll
        for (int bj = 0; bj < 2; ++bj)
#pragma unroll
            for (int n = 0; n < 2; ++n) gt[bj][n] = *(const f32x4*)(mod + (size_t)b * NMOD + 2 * DM + col0 + bj * 128 + n * 4);
#pragma unroll
        for (int am = 0; am < 4; ++am) {
            const int ai = am >> 1, m0 = (am & 1) * 2;
            f32x4 xv[2][2][2];
#pragma unroll
            for (int mm = 0; mm < 2; ++mm)
#pragma unroll
                for (int bj = 0; bj < 2; ++bj) { const size_t off = (size_t)(row0 + ai * 128 + (m0 + mm) * 16) * DM + col0 + bj * 128; xv[mm][bj][0] = *(const f32x4*)(x + off); xv[mm][bj][1] = *(const f32x4*)(x + off + 4); }
#pragma unroll
            for (int mm = 0; mm < 2; ++mm) { const int m = m0 + mm; const int row = row0 + ai * 128 + m * 16; float ss = 0.f;
#pragma unroll
                for (int bj = 0; bj < 2; ++bj) { const size_t off = (size_t)row * DM + col0 + bj * 128;
                    const f32x4 o0 = xv[mm][bj][0] + gt[bj][0] * acc[ai][bj][m][0], o1 = xv[mm][bj][1] + gt[bj][1] * acc[ai][bj][m][1];
                    ss += (o0[0] * o0[0] + o0[1] * o0[1]) + (o0[2] * o0[2] + o0[3] * o0[3]) + (o1[0] * o1[0] + o1[1] * o1[1]) + (o1[2] * o1[2] + o1[3] * o1[3]);
                    u32x4 w; w.x = cvt_pk_bf16(o0[0], o0[1]); w.y = cvt_pk_bf16(o0[2], o0[3]); w.z = cvt_pk_bf16(o1[0], o1[1]); w.w = cvt_pk_bf16(o1[2], o1[3]);
                    *(u32x4*)(X1 + off) = w; }
                ss += __shfl_xor(ss, 16); ss += __shfl_xor(ss, 32);
                if (fq == 0) rowss2[(size_t)row * 32 + u.pn * 4 + wc] = ss; }
        }
    }
};
struct MoeSched {
    const LAS int* tinfo; const LAS int* trows; int ntiles; int G, c; const int* list; unsigned abase, bbase; int mode;
    __device__ __forceinline__ bool next(int i, g8::Unit& u) const {
        int pn, ti;
        if ((G & 63) == 0) { const int x = c & 7, r = c >> 3, per = G >> 6;
            ti = (i * 8 + x) * per + (r >> 3); pn = r & 7; }
        else { const int L = i * G + c; pn = L & 7; ti = L >> 3; }
        if (ti >= ntiles) return false;
        const int inf = __builtin_amdgcn_readfirstlane(tinfo[ti]);
        const int e = inf & 255;
        u.pm = __builtin_amdgcn_readfirstlane(ti); u.pn = pn; u.flags = 0; u.aux = inf; u.aux2 = __builtin_amdgcn_readfirstlane(trows[ti]);
        if (mode == 0) { u.aoff = abase; u.boff = bbase + (unsigned)e * (2048u * 2048u * 2u) + (unsigned)pn * (256u * 2048u * 2u); }
        else { u.aoff = abase + (unsigned)ti * (256u * 1024u * 2u); u.boff = bbase + (unsigned)e * (2048u * 1024u * 2u) + (unsigned)pn * (256u * 1024u * 2u); }
        return true;
    }
    __device__ __forceinline__ void aoffs(const g8::Unit& u, int R0, int C0, int R1, int C1, unsigned (&v)[2][2]) const {
        if (mode == 0) {
            const int e = u.aux & 255, r0 = u.aux >> 8, n = u.aux2; const int* le = list + e * 16384 + r0;
            const int i00 = R0, i01 = R1, i10 = 128 + R0, i11 = 128 + R1;
            const int t00 = (i00 < n) ? (le[i00] >> 1) : 0, t01 = (i01 < n) ? (le[i01] >> 1) : 0, t10 = (i10 < n) ? (le[i10] >> 1) : 0, t11 = (i11 < n) ? (le[i11] >> 1) : 0;
            v[0][0] = (unsigned)(t00 * 2048 + C0) * 2u; v[0][1] = (unsigned)(t01 * 2048 + C1) * 2u; v[1][0] = (unsigned)(t10 * 2048 + C0) * 2u; v[1][1] = (unsigned)(t11 * 2048 + C1) * 2u;
        } else {
            v[0][0] = (unsigned)(R0 * 1024 + C0) * 2u; v[0][1] = (unsigned)(R1 * 1024 + C1) * 2u;
            v[1][0] = (unsigned)((128 + R0) * 1024 + C0) * 2u; v[1][1] = (unsigned)((128 + R1) * 1024 + C1) * 2u;
        }
    }
};
struct EpiMoe1 {
    static constexpr bool PERM = true;
    bf16_t* HM;
    __device__ __forceinline__ void operator()(g8::Acc& acc, const g8::Unit& u, int wr, int wc, int fr, int fq) const {
        const int row0 = u.pm * 256 + wr * 64 + fr, col0 = u.pn * 128 + wc * 32 + 8 * fq;
#pragma unroll
        for (int ai = 0; ai < 2; ++ai)
#pragma unroll
            for (int m = 0; m < 4; ++m) { float o[8];
#pragma unroll
                for (int n = 0; n < 2; ++n)
#pragma unroll
                    for (int j = 0; j < 4; ++j) { const float gv = acc[ai][0][m][n][j], uv = acc[ai][1][m][n][j]; o[n * 4 + j] = gv * sigmoidf_(gv) * uv; }
                u32x4 w; w.x = cvt_pk_bf16(o[0], o[1]); w.y = cvt_pk_bf16(o[2], o[3]); w.z = cvt_pk_bf16(o[4], o[5]); w.w = cvt_pk_bf16(o[6], o[7]);
                *(u32x4*)(HM + (size_t)(row0 + ai * 128 + m * 16) * 1024 + col0) = w; }
    }
};
struct EpiMoe2 {
    static constexpr bool PERM = true;
    const int* list; const float* wgt; bf16_t* Y2;
    __device__ __forceinline__ void operator()(g8::Acc& acc, const g8::Unit& u, int wr, int wc, int fr, int fq) const {
        const int e = u.aux & 255, r0 = u.aux >> 8, n = u.aux2; const int* le = list + e * 16384 + r0;
        const int col0 = u.pn * 256 + wc * 32 + 8 * fq;
        int asg[2][4]; float w8[2][4];
#pragma unroll
        for (int ai = 0; ai < 2; ++ai)
#pragma unroll
            for (int m = 0; m < 4; ++m) { const int r = ai * 128 + wr * 64 + m * 16 + fr; asg[ai][m] = (r < n) ? le[r] : -1; }
#pragma unroll
        for (int ai = 0; ai < 2; ++ai)
#pragma unroll
            for (int m = 0; m < 4; ++m) w8[ai][m] = (asg[ai][m] >= 0) ? wgt[asg[ai][m]] : 0.f;
#pragma unroll
        for (int ai = 0; ai < 2; ++ai)
#pragma unroll
            for (int m = 0; m < 4; ++m) {
                if (asg[ai][m] >= 0) { bf16_t* rowp = Y2 + (size_t)asg[ai][m] * DM + col0; const float ww = w8[ai][m];
#pragma unroll
                    for (int bj = 0; bj < 2; ++bj) { const f32x4 v0 = acc[ai][bj][m][0] * ww, v1 = acc[ai][bj][m][1] * ww;
                        u32x4 w; w.x = cvt_pk_bf16(v0[0], v0[1]); w.y = cvt_pk_bf16(v0[2], v0[3]); w.z = cvt_pk_bf16(v1[0], v1[1]); w.w = cvt_pk_bf16(v1[2], v1[3]);
                        *(u32x4*)(rowp + bj * 128) = w; } } }
    }
};

constexpr size_t WS_KV = WS_H;
__device__ __forceinline__ void ssm_item(const Params& P, LAS unsigned char* lds, int tid, int item) {
    const int g = item >> 2, bp = item & 3;
    const int wave = __builtin_amdgcn_readfirstlane(tid >> 6), lane = tid & 63, fr = lane & 15, fq = lane >> 4;
    const bf16_t* proj = (const bf16_t*)(P.ws + WS_PROJ);
    const bf16_t* Ms = (const bf16_t*)(P.ws + WS_SSMM) + (size_t)g * 131072;
    const bf16_t* TM = Ms + 32768;
    bf16_t* Zo = (bf16_t*)(P.ws + WS_Z);
    constexpr int ZS = 136, MS = 264, TS = 392;
    LAS bf16_t* ZB = (LAS bf16_t*)lds;
    LAS bf16_t* WB = (LAS bf16_t*)(lds + 256 * ZS * 2);
    const int b = 2 * bp + (wave >> 2);
    int tok0[2];
    bf16x8 Uf[2][8];
#pragma unroll
    for (int mt = 0; mt < 2; ++mt) {
        const int c = 32 * (wave & 3) + 16 * mt + fr; tok0[mt] = b * 2048 + c * 16;
#pragma unroll
        for (int ks = 0; ks < 8; ++ks) Uf[mt][ks] = *(const bf16x8*)(proj + (size_t)(tok0[mt] + 2 * ks + (fq >> 1)) * NPROJ + g * 16 + 8 * (fq & 1));
    }
#pragma unroll
    for (int i = 0; i < 8; ++i) { const int row = tid >> 2, kc = (tid & 3) + 4 * i; *(LAS u32x4*)(WB + row * MS + kc * 8) = *(const u32x4*)(Ms + row * 256 + kc * 8); }
    __syncthreads();
#pragma unroll
    for (int nt = 0; nt < 8; ++nt) {
        f32x4 a0 = {0.f, 0.f, 0.f, 0.f}, a1 = {0.f, 0.f, 0.f, 0.f};
#pragma unroll
        for (int ks = 0; ks < 8; ++ks) {
            const bf16x8 bf = *(const LAS bf16x8*)(WB + (16 * nt + fr) * MS + 32 * ks + 8 * fq);
            a0 = __builtin_amdgcn_mfma_f32_16x16x32_bf16(bf, Uf[0][ks], a0, 0, 0, 0);
            a1 = __builtin_amdgcn_mfma_f32_16x16x32_bf16(bf, Uf[1][ks], a1, 0, 0, 0);
        }
        *(LAS u32x2*)(ZB + (32 * wave + fr) * ZS + 16 * nt + 4 * fq) = (u32x2){cvt_pk_bf16(a0[0], a0[1]), cvt_pk_bf16(a0[2], a0[3])};
        *(LAS u32x2*)(ZB + (32 * wave + 16 + fr) * ZS + 16 * nt + 4 * fq) = (u32x2){cvt_pk_bf16(a1[0], a1[1]), cvt_pk_bf16(a1[2], a1[3])};
    }
    u32x4 tmr[6];
#pragma unroll
    for (int i = 0; i < 6; ++i) { const int row = tid >> 3, kc = (tid & 7) + 8 * i; tmr[i] = *(const u32x4*)(TM + (size_t)row * 384 + kc * 8); }
    __syncthreads();
    if (tid < 128) {
        const int bl = tid >> 6, p = tid & 63;
        const f32x2 al = ((const f32x2*)(P.ws + WS_SSMA))[g * 64 + p];
        float xr = 0.f, xi = 0.f;
        LAS unsigned* zw = (LAS unsigned*)ZB + (bl * 128) * (ZS / 2) + p;
        for (int c0 = 0; c0 < 128; c0 += 8) {
            unsigned zv[8];
#pragma unroll
            for (int k = 0; k < 8; ++k) zv[k] = zw[(c0 + k) * (ZS / 2)];
#pragma unroll
            for (int k = 0; k < 8; ++k) {
                zw[(c0 + k) * (ZS / 2)] = cvt_pk_bf16(xr, xi);
                const float t = al.x * xr - al.y * xi + bf_lo(zv[k]); xi = al.x * xi + al.y * xr + bf_hi(zv[k]); xr = t;
            }
        }
    }
#pragma unroll
    for (int i = 0; i < 6; ++i) { const int row = tid >> 3, kc = (tid & 7) + 8 * i; *(LAS u32x4*)(WB + row * TS + kc * 8) = tmr[i]; }
    __syncthreads();
    const LAS bf16_t* xrow = ZB + (32 * wave + fr) * ZS + 8 * fq;
    const f32x4 dv = *(const f32x4*)(P.in[12] + g * 16 + 4 * fq);
#pragma unroll
    for (int cq = 0; cq < 4; ++cq) {
        u32x2 uu[4][2];
#pragma unroll
        for (int ntl = 0; ntl < 4; ++ntl)
#pragma unroll
            for (int mt = 0; mt < 2; ++mt) uu[ntl][mt] = *(const u32x2*)(proj + (size_t)(tok0[mt] + 4 * cq + ntl) * NPROJ + g * 16 + 4 * fq);
        if (cq < 3) {
#pragma unroll
            for (int i = 0; i < 6; ++i) { const int row = tid >> 3, kc = (tid & 7) + 8 * i; tmr[i] = *(const u32x4*)(TM + (size_t)(64 * (cq + 1) + row) * 384 + kc * 8); }
        }
#pragma unroll
        for (int ntl = 0; ntl < 4; ++ntl) {
            const int nt = 4 * cq + ntl;
            f32x4 a0 = {0.f, 0.f, 0.f, 0.f}, a1 = {0.f, 0.f, 0.f, 0.f};
            const LAS bf16_t* brow = WB + (16 * ntl + fr) * TS + 8 * fq;
#pragma unroll
            for (int ks = 0; ks < 8; ++ks) {
                if (2 * ks <= nt) {
                    const bf16x8 bf = *(const LAS bf16x8*)(brow + 32 * ks);
                    a0 = __builtin_amdgcn_mfma_f32_16x16x32_bf16(bf, Uf[0][ks], a0, 0, 0, 0);
                    a1 = __builtin_amdgcn_mfma_f32_16x16x32_bf16(bf, Uf[1][ks], a1, 0, 0, 0);
                }
            }
#pragma unroll
            for (int k2 = 0; k2 < 4; ++k2) {
                const bf16x8 bf = *(const LAS bf16x8*)(brow + 256 + 32 * k2);
                const bf16x8 x0 = *(const LAS bf16x8*)(xrow + 32 * k2), x1 = *(const LAS bf16x8*)(xrow + 16 * ZS + 32 * k2);
                a0 = __builtin_amdgcn_mfma_f32_16x16x32_bf16(bf, x0, a0, 0, 0, 0);
                a1 = __builtin_amdgcn_mfma_f32_16x16x32_bf16(bf, x1, a1, 0, 0, 0);
            }
#pragma unroll
            for (int mt = 0; mt < 2; ++mt) {
                const f32x4 a = mt ? a1 : a0;
                const size_t tok = (size_t)(tok0[mt] + nt);
                const u32x2 u2 = uu[ntl][mt];
                const float y0 = a[0] + dv[0] * bf_lo(u2.x), y1 = a[1] + dv[1] * bf_hi(u2.x), y2 = a[2] + dv[2] * bf_lo(u2.y), y3 = a[3] + dv[3] * bf_hi(u2.y);
                u32x2 w; w.x = cvt_pk_bf16(gelu_tanh(y0), gelu_tanh(y1)); w.y = cvt_pk_bf16(gelu_tanh(y2), gelu_tanh(y3));
                *(u32x2*)(Zo + tok * 1024 + g * 16 + 4 * fq) = w;
            }
        }
        __syncthreads();
        if (cq < 3) {
#pragma unroll
            for (int i = 0; i < 6; ++i) { const int row = tid >> 3, kc = (tid & 7) + 8 * i; *(LAS u32x4*)(WB + row * TS + kc * 8) = tmr[i]; }
            __syncthreads();
        }
    }
}

__device__ __forceinline__ bf16x8 tr_frag(const LAS bf16_t* tile, int row0, int col0, int fr, int fq) {
    const LAS bf16_t* p = tile + (row0 + 8 * fq + (fr >> 2)) * 136 + col0 + 4 * (fr & 3);
    const bf16x4 a = __builtin_amdgcn_ds_read_tr16_b64_v4i16((LAS bf16x4*)p);
    const bf16x4 b = __builtin_amdgcn_ds_read_tr16_b64_v4i16((LAS bf16x4*)(p + 4 * 136));
    bf16x8 r; r[0] = a[0]; r[1] = a[1]; r[2] = a[2]; r[3] = a[3]; r[4] = b[0]; r[5] = b[1]; r[6] = b[2]; r[7] = b[3]; return r;
}
__device__ __forceinline__ void ret_kv_items(const Params& P, LAS unsigned char* lds, int tid, int first, int stride) {
    const int wave = __builtin_amdgcn_readfirstlane(tid >> 6), lane = tid & 63, fr = lane & 15, fq = lane >> 4;
    constexpr int RS = 136;
    LAS bf16_t* Ks = (LAS bf16_t*)lds; LAS bf16_t* Vs = Ks + 128 * RS;
    const bf16_t* proj = (const bf16_t*)(P.ws + WS_PROJ);
    bf16_t* KV = (bf16_t*)(P.ws + WS_KV);
    const int si = tid >> 2, part = tid & 3, i0 = 16 * wave;
    u32x4 kr[4], vr[4];
    int item = first;
    if (item >= 768) return;
    { const int bh = item / 12, n = item % 12; const bf16_t* pr = proj + ((size_t)(bh >> 3) * 2048 + n * 128 + si) * NPROJ + (bh & 7) * 128 + 32 * part;
#pragma unroll
      for (int j = 0; j < 4; ++j) { kr[j] = *(const u32x4*)(pr + 2048 + 8 * j); vr[j] = *(const u32x4*)(pr + 3072 + 8 * j); } }
    for (;;) {
#pragma unroll
        for (int j = 0; j < 4; ++j) { *(LAS u32x4*)(Ks + si * RS + 32 * part + 8 * j) = kr[j]; *(LAS u32x4*)(Vs + si * RS + 32 * part + 8 * j) = vr[j]; }
        __syncthreads();
        const int nxt = item + stride; const bool more = nxt < 768;
        if (more) { const int bh = nxt / 12, n = nxt % 12; const bf16_t* pr = proj + ((size_t)(bh >> 3) * 2048 + n * 128 + si) * NPROJ + (bh & 7) * 128 + 32 * part;
#pragma unroll
            for (int j = 0; j < 4; ++j) { kr[j] = *(const u32x4*)(pr + 2048 + 8 * j); vr[j] = *(const u32x4*)(pr + 3072 + 8 * j); } }
        bf16x8 Vt[4];
#pragma unroll
        for (int ks = 0; ks < 4; ++ks) Vt[ks] = tr_frag(Vs, 32 * ks, i0, fr, fq);
        const int bh = item / 12, n = item % 12;
        bf16_t* op = KV + ((size_t)(bh * 16 + n) * 128 + i0 + fr) * 128 + 4 * fq;
#pragma unroll
        for (int nt = 0; nt < 8; ++nt) {
            f32x4 a = {0.f, 0.f, 0.f, 0.f};
#pragma unroll
            for (int ks = 0; ks < 4; ++ks) { const bf16x8 kf = tr_frag(Ks, 32 * ks, 16 * nt, fr, fq); a = __builtin_amdgcn_mfma_f32_16x16x32_bf16(kf, Vt[ks], a, 0, 0, 0); }
            *(u32x2*)(op + 16 * nt) = (u32x2){cvt_pk_bf16(a[0], a[1]), cvt_pk_bf16(a[2], a[3])};
        }
        __syncthreads();
        if (!more) break;
        item = nxt;
    }
}
__device__ __forceinline__ void ret_out_item(const Params& P, LAS unsigned char* lds, int tid, int item) {
    const int bh = item >> 2, q = item & 3, b = bh >> 3, h = bh & 7;
    const int wave = __builtin_amdgcn_readfirstlane(tid >> 6), lane = tid & 63, fr = lane & 15, fq = lane >> 4;
    constexpr int RS = 136;
    LAS bf16_t* Qs = (LAS bf16_t*)lds;
    LAS bf16_t* Ks = Qs + 128 * RS;
    LAS bf16_t* Vs = Ks + 128 * RS;
    LAS bf16_t* Rs = Vs + 128 * RS;
    const bf16_t* proj = (const bf16_t*)(P.ws + WS_PROJ);
    const bf16_t* KV = (const bf16_t*)(P.ws + WS_KV);
    bf16_t* CAT = (bf16_t*)(P.ws + WS_CAT);
    const float gam = 1.0f - exp2f(-5.0f - (float)h);
    const float lg2 = log2f(gam);
    const float gC1 = exp2f(lg2 * 127.0f), gC = exp2f(lg2 * 128.0f);
    const int si = tid >> 2, part = tid & 3, i0 = 16 * wave;
    u32x4 st[12];
    { const bf16_t* pr = proj + ((size_t)b * 2048 + (4 * q) * 128 + si) * NPROJ + h * 128 + 32 * part;
#pragma unroll
      for (int j = 0; j < 4; ++j) { st[j] = *(const u32x4*)(pr + 1024 + 8 * j); st[4 + j] = *(const u32x4*)(pr + 2048 + 8 * j); st[8 + j] = *(const u32x4*)(pr + 3072 + 8 * j); } }
    f32x4 accR[8];
#pragma unroll
    for (int nt = 0; nt < 8; ++nt) accR[nt] = (f32x4){0.f, 0.f, 0.f, 0.f};
    for (int m = 0; m < 4 * q; ++m) {
        const bf16_t* tp = KV + ((size_t)(bh * 16 + m) * 128 + i0 + fr) * 128 + 4 * fq;
        u32x2 t[8];
#pragma unroll
        for (int nt = 0; nt < 8; ++nt) t[nt] = *(const u32x2*)(tp + 16 * nt);
#pragma unroll
        for (int nt = 0; nt < 8; ++nt) { const f32x4 kv = {bf_lo(t[nt].x), bf_hi(t[nt].x), bf_lo(t[nt].y), bf_hi(t[nt].y)}; accR[nt] = accR[nt] * gC + kv * gC1; }
    }
#pragma unroll
    for (int nt = 0; nt < 8; ++nt)
        *(LAS u32x2*)(Rs + (i0 + fr) * RS + 16 * nt + 4 * fq) = (u32x2){cvt_pk_bf16(accR[nt][0], accR[nt][1]), cvt_pk_bf16(accR[nt][2], accR[nt][3])};
    for (int nn = 0; nn < 4; ++nn) {
        const int n = 4 * q + nn;
#pragma unroll
        for (int j = 0; j < 4; ++j) { *(LAS u32x4*)(Qs + si * RS + 32 * part + 8 * j) = st[j]; *(LAS u32x4*)(Ks + si * RS + 32 * part + 8 * j) = st[4 + j]; *(LAS u32x4*)(Vs + si * RS + 32 * part + 8 * j) = st[8 + j]; }
        __syncthreads();
        if (nn < 3) { const bf16_t* pr = proj + ((size_t)b * 2048 + (n + 1) * 128 + si) * NPROJ + h * 128 + 32 * part;
#pragma unroll
            for (int j = 0; j < 4; ++j) { st[j] = *(const u32x4*)(pr + 1024 + 8 * j); st[4 + j] = *(const u32x4*)(pr + 2048 + 8 * j); st[8 + j] = *(const u32x4*)(pr + 3072 + 8 * j); } }
        const size_t tok = (size_t)b * 2048 + n * 128 + i0 + fr;
        u32x2 gg[8];
        { const bf16_t* gp = proj + tok * NPROJ + 4096 + h * 128 + 4 * fq;
#pragma unroll
          for (int nt = 0; nt < 8; ++nt) gg[nt] = *(const u32x2*)(gp + 16 * nt); }
        bf16x8 Qf[4];
#pragma unroll
        for (int ks = 0; ks < 4; ++ks) Qf[ks] = *(const LAS bf16x8*)(Qs + (i0 + fr) * RS + 32 * ks + 8 * fq);
        f32x4 accS[8], accO[8];
#pragma unroll
        for (int nt = 0; nt < 8; ++nt) { accS[nt] = (f32x4){0.f, 0.f, 0.f, 0.f}; accO[nt] = (f32x4){0.f, 0.f, 0.f, 0.f}; }
#pragma unroll
        for (int nt = 0; nt < 8; ++nt) {
            if (nt <= wave) {
#pragma unroll
                for (int ks = 0; ks < 4; ++ks) { const bf16x8 kf = *(const LAS bf16x8*)(Ks + (16 * nt + fr) * RS + 32 * ks + 8 * fq); accS[nt] = __builtin_amdgcn_mfma_f32_16x16x32_bf16(kf, Qf[ks], accS[nt], 0, 0, 0); }
            }
        }
        if (n > 0) {
#pragma unroll
            for (int nt = 0; nt < 8; ++nt) {
#pragma unroll
                for (int ks = 0; ks < 4; ++ks) { const bf16x8 rf = *(const LAS bf16x8*)(Rs + (16 * nt + fr) * RS + 32 * ks + 8 * fq); accO[nt] = __builtin_amdgcn_mfma_f32_16x16x32_bf16(rf, Qf[ks], accO[nt], 0, 0, 0); }
                accO[nt] *= gam;
            }
        }
#pragma unroll
        for (int nt = 0; nt < 8; ++nt) {
            const int i = i0 + fr, j0 = 16 * nt + 4 * fq;
            const float p0 = (j0 <= i) ? accS[nt][0] : 0.f, p1 = (j0 + 1 <= i) ? accS[nt][1] : 0.f, p2 = (j0 + 2 <= i) ? accS[nt][2] : 0.f, p3 = (j0 + 3 <= i) ? accS[nt][3] : 0.f;
            *(LAS u32x2*)(Qs + i * RS + j0) = (u32x2){cvt_pk_bf16(p0, p1), cvt_pk_bf16(p2, p3)};
        }
        asm volatile("" ::: "memory");
        bf16x8 Pf[4];
#pragma unroll
        for (int ks = 0; ks < 4; ++ks) Pf[ks] = *(const LAS bf16x8*)(Qs + (i0 + fr) * RS + 32 * ks + 8 * fq);
#pragma unroll
        for (int ks = 0; ks < 4; ++ks) {
            if (2 * ks <= wave) {
#pragma unroll
                for (int nt = 0; nt < 8; ++nt) { const bf16x8 vf = tr_frag(Vs, 32 * ks, 16 * nt, fr, fq); accO[nt] = __builtin_amdgcn_mfma_f32_16x16x32_bf16(vf, Pf[ks], accO[nt], 0, 0, 0); }
            }
        }
        if (nn < 3) {
            bf16x8 Vt[4];
#pragma unroll
            for (int ks = 0; ks < 4; ++ks) Vt[ks] = tr_frag(Vs, 32 * ks, i0, fr, fq);
#pragma unroll
            for (int nt = 0; nt < 8; ++nt) {
                accR[nt] *= gam;
#pragma unroll
                for (int ks = 0; ks < 4; ++ks) { const bf16x8 kf = tr_frag(Ks, 32 * ks, 16 * nt, fr, fq); accR[nt] = __builtin_amdgcn_mfma_f32_16x16x32_bf16(kf, Vt[ks], accR[nt], 0, 0, 0); }
                accR[nt] *= gC1;
            }
        }
        {
            float s = 0.f;
#pragma unroll
            for (int nt = 0; nt < 8; ++nt) s += (accO[nt][0] + accO[nt][1]) + (accO[nt][2] + accO[nt][3]);
            s += __shfl_xor(s, 16); s += __shfl_xor(s, 32);
            const float mu = s * (1.0f / 128.0f); float qv = 0.f;
#pragma unroll
            for (int nt = 0; nt < 8; ++nt) { const f32x4 d = accO[nt] - mu; qv += (d[0] * d[0] + d[1] * d[1]) + (d[2] * d[2] + d[3] * d[3]); }
            qv += __shfl_xor(qv, 16); qv += __shfl_xor(qv, 32);
            const float rstd = rsqrtf(qv * (1.0f / 128.0f) + 1e-5f);
            bf16_t* op = CAT + tok * DM + 1024 + h * 128 + 4 * fq;
#pragma unroll
            for (int nt = 0; nt < 8; ++nt) {
                const float g0 = bf_lo(gg[nt].x), g1 = bf_hi(gg[nt].x), g2 = bf_lo(gg[nt].y), g3 = bf_hi(gg[nt].y);
                const f32x4 y = (accO[nt] - mu) * rstd;
                u32x2 w; w.x = cvt_pk_bf16(y[0] * g0 * sigmoidf_(g0), y[1] * g1 * sigmoidf_(g1)); w.y = cvt_pk_bf16(y[2] * g2 * sigmoidf_(g2), y[3] * g3 * sigmoidf_(g3));
                *(u32x2*)(op + 16 * nt) = w;
            }
        }
        __syncthreads();
        if (nn < 3) {
#pragma unroll
            for (int nt = 0; nt < 8; ++nt)
                *(LAS u32x2*)(Rs + (i0 + fr) * RS + 16 * nt + 4 * fq) = (u32x2){cvt_pk_bf16(accR[nt][0], accR[nt][1]), cvt_pk_bf16(accR[nt][2], accR[nt][3])};
        }
    }
}

__device__ __forceinline__ void p6_route(const Params& P, LAS unsigned char* lds, int tid, int blk, int G) {
    const int wave = __builtin_amdgcn_readfirstlane(tid >> 6), lane = tid & 63, fr = lane & 15, fq = lane >> 4;
    LAS float* gm = (LAS float*)lds; LAS float* sh = gm + 2048; LAS float* lg = sh + 2048;
    LAS int* lcnt = (LAS int*)(lg + 2 * 64 * 48); LAS int* lbase = lcnt + 32;
    int ra_ = 0, rb_ = 0, ea_ = 0, eb_ = 0; float w1_ = 0.f, w2_ = 0.f;
    const float* mod = (const float*)(P.ws + WS_MOD);
    const bf16_t* x1 = (const bf16_t*)(P.ws + WS_X1); const float* rowss2 = (const float*)(P.ws + WS_ROWSS2);
    bf16_t* H2 = (bf16_t*)(P.ws + WS_H);
    const bf16_t* WR = (const bf16_t*)(P.ws + WS_WR);
    int* cnt = (int*)(P.ws + WS_CNT); int* list = (int*)(P.ws + WS_LIST); float* wgt = (float*)(P.ws + WS_WGT);
    for (int rb = blk; rb < 256; rb += G) {
        const int b = rb >> 5;
        for (int k = tid; k < 2048; k += NTHREADS) { gm[k] = P.in[18][k] * (1.0f + mod[(size_t)b * NMOD + 4 * DM + k]); sh[k] = mod[(size_t)b * NMOD + 3 * DM + k]; }
        if (tid < 32) lcnt[tid] = 0;
        __syncthreads();
        const int mt = wave & 3, kh = wave >> 2;
        const int row = rb * 64 + 16 * mt + fr;
        float tot2 = 0.f;
        { const f32x4* pp = (const f32x4*)(rowss2 + (size_t)row * 32);
#pragma unroll
          for (int i = 0; i < 8; ++i) { const f32x4 v = pp[i]; tot2 += (v[0] + v[1]) + (v[2] + v[3]); } }
        const float r2 = rsqrtf(tot2 * (1.0f / 2048.0f) + 1e-6f);
        f32x4 acc[3];
#pragma unroll
        for (int nt = 0; nt < 3; ++nt) acc[nt] = (f32x4){0.f, 0.f, 0.f, 0.f};
#pragma unroll 4
        for (int ks = 0; ks < 32; ++ks) {
            const int k0 = 1024 * kh + 32 * ks + 8 * fq;
            const u32x4 xw = *(const u32x4*)(x1 + (size_t)row * DM + k0);
            const f32x4 a = {bf_lo(xw.x), bf_hi(xw.x), bf_lo(xw.y), bf_hi(xw.y)}, c = {bf_lo(xw.z), bf_hi(xw.z), bf_lo(xw.w), bf_hi(xw.w)};
            const f32x4 g0 = *(const LAS f32x4*)(gm + k0), g1 = *(const LAS f32x4*)(gm + k0 + 4), s0 = *(const LAS f32x4*)(sh + k0), s1 = *(const LAS f32x4*)(sh + k0 + 4);
            const f32x4 h0 = a * r2 * g0 + s0, h1 = c * r2 * g1 + s1;
            u32x4 w; w.x = cvt_pk_bf16(h0[0], h0[1]); w.y = cvt_pk_bf16(h0[2], h0[3]); w.z = cvt_pk_bf16(h1[0], h1[1]); w.w = cvt_pk_bf16(h1[2], h1[3]);
            *(u32x4*)(H2 + (size_t)row * DM + k0) = w;
            const bf16x8 af = __builtin_bit_cast(bf16x8, w);
#pragma unroll
            for (int nt = 0; nt < 3; ++nt) { const bf16x8 bf = *(const bf16x8*)(WR + (size_t)(16 * nt + fr) * 2048 + k0); acc[nt] = __builtin_amdgcn_mfma_f32_16x16x32_bf16(bf, af, acc[nt], 0, 0, 0); }
        }
#pragma unroll
        for (int nt = 0; nt < 3; ++nt) *(LAS f32x4*)(lg + (kh * 64 + 16 * mt + fr) * 48 + 16 * nt + 4 * fq) = acc[nt];
        __syncthreads();
        if (tid < 64) {
            const int tok = rb * 64 + tid;
            float l[36];
#pragma unroll
            for (int nn = 0; nn < 36; ++nn) l[nn] = lg[tid * 48 + nn] + lg[(64 + tid) * 48 + nn];
            float gl[4]; int gs = 0;
#pragma unroll
            for (int j = 0; j < 4; ++j) gl[j] = l[j] + P.in[20][j];
#pragma unroll
            for (int j = 1; j < 4; ++j) if (gl[j] > gl[gs]) gs = j;
            float gmax = gl[0];
#pragma unroll
            for (int j = 1; j < 4; ++j) gmax = fmaxf(gmax, gl[j]);
            float den = 0.f;
#pragma unroll
            for (int j = 0; j < 4; ++j) den += expf(gl[j] - gmax);
            const float gw = 1.0f / den;
            float el[8];
#pragma unroll
            for (int j = 0; j < 8; ++j) { float v = 0.f;
#pragma unroll
                for (int q = 0; q < 4; ++q) v = (gs == q) ? (l[4 + q * 8 + j] + P.in[22][q * 8 + j]) : v;
                el[j] = v; }
            int j1 = 0;
#pragma unroll
            for (int j = 1; j < 8; ++j) if (el[j] > el[j1]) j1 = j;
            int j2 = (j1 == 0) ? 1 : 0;
#pragma unroll
            for (int j = 0; j < 8; ++j) if (j != j1 && j != j2 && el[j] > el[j2]) j2 = j;
            float e1 = el[0], e2 = el[0];
#pragma unroll
            for (int j = 0; j < 8; ++j) { e1 = (j == j1) ? el[j] : e1; e2 = (j == j2) ? el[j] : e2; }
            const float t2 = expf(e2 - e1), w1 = gw / (1.0f + t2), w2 = gw * t2 / (1.0f + t2);
            const int ea = gs * 8 + j1, eb = gs * 8 + j2;
            ra_ = atomicAdd((int*)&lcnt[ea], 1); rb_ = atomicAdd((int*)&lcnt[eb], 1); ea_ = ea; eb_ = eb; w1_ = w1; w2_ = w2;
        }
        __syncthreads();
        if (tid < 32) { const int c = lcnt[tid]; lbase[tid] = c > 0 ? atomicAdd(cnt + tid * 64, c) : 0; }
        __syncthreads();
        if (tid < 64) {
            const int tok = rb * 64 + tid;
            list[ea_ * 16384 + lbase[ea_] + ra_] = tok * 2; wgt[tok * 2] = w1_;
            list[eb_ * 16384 + lbase[eb_] + rb_] = tok * 2 + 1; wgt[tok * 2 + 1] = w2_;
        }
        __syncthreads();
    }
}

__device__ __forceinline__ void p9_final(const Params& P, int tid, int blk, int G) {
    const int wave = tid >> 6, lane = tid & 63;
    const float* mod = (const float*)(P.ws + WS_MOD); const bf16_t* Y2 = (const bf16_t*)(P.ws + WS_Y2); const bf16_t* X1 = (const bf16_t*)(P.ws + WS_X1);
    f32x4 gf[8];
#pragma unroll
    for (int i = 0; i < 8; ++i) gf[i] = *(const f32x4*)(P.in[26] + (i * 64 + lane) * 4);
    int row = blk * 8 + wave;
    u32x2 xw[8], ya[8], yb[8], xwn[8], yan[8], ybn[8];
    if (row < NTOK) {
#pragma unroll
        for (int i = 0; i < 8; ++i) { const int k = (i * 64 + lane) * 4; xw[i] = *(const u32x2*)(X1 + (size_t)row * DM + k); ya[i] = *(const u32x2*)(Y2 + (size_t)(2 * row) * DM + k); yb[i] = *(const u32x2*)(Y2 + (size_t)(2 * row + 1) * DM + k); }
    }
    for (; row < NTOK; row += G * 8) {
        const int b = row >> 11, rown = row + G * 8;
        if (rown < NTOK) {
#pragma unroll
            for (int i = 0; i < 8; ++i) { const int k = (i * 64 + lane) * 4; xwn[i] = *(const u32x2*)(X1 + (size_t)rown * DM + k); yan[i] = *(const u32x2*)(Y2 + (size_t)(2 * rown) * DM + k); ybn[i] = *(const u32x2*)(Y2 + (size_t)(2 * rown + 1) * DM + k); }
        }
        f32x4 v[8]; float ss = 0.f;
#pragma unroll
        for (int i = 0; i < 8; ++i) {
            const int k = (i * 64 + lane) * 4;
            const f32x4 xv = {bf_lo(xw[i].x), bf_hi(xw[i].x), bf_lo(xw[i].y), bf_hi(xw[i].y)};
            const f32x4 gt = *(const f32x4*)(mod + (size_t)b * NMOD + 5 * DM + k);
            f32x4 y; y[0] = bf_lo(ya[i].x) + bf_lo(yb[i].x); y[1] = bf_hi(ya[i].x) + bf_hi(yb[i].x); y[2] = bf_lo(ya[i].y) + bf_lo(yb[i].y); y[3] = bf_hi(ya[i].y) + bf_hi(yb[i].y);
            v[i] = xv + gt * y;
            ss += v[i][0] * v[i][0] + v[i][1] * v[i][1] + v[i][2] * v[i][2] + v[i][3] * v[i][3];
        }
        ss = wave_sum(ss);
        const float r = rsqrtf(ss * (1.0f / 2048.0f) + 1e-6f);
        float* xr = P.out + (size_t)row * DM;
#pragma unroll
        for (int i = 0; i < 8; ++i) { const int k = (i * 64 + lane) * 4; *(f32x4*)(xr + k) = v[i] * r * gf[i]; }
#pragma unroll
        for (int i = 0; i < 8; ++i) { xw[i] = xwn[i]; ya[i] = yan[i]; yb[i] = ybn[i]; }
    }
}

__global__ void __launch_bounds__(NTHREADS, 2) hymba_fwd(Params P) {
    extern __shared__ __attribute__((aligned(16))) unsigned char lds_raw[];
    LAS unsigned char* lds = (LAS unsigned char*)lds_raw;
    const int tid = threadIdx.x, blk = blockIdx.x, G = gridDim.x;
    volatile LAS unsigned* misc = (volatile LAS unsigned*)(lds + LDS_MISC);
    if (tid < 64) misc[tid] = 0u;
    __syncthreads();
    XcdBarrier bar = xcd_barrier_post((unsigned*)(P.ws + WS_BAR), misc);
    const int lo = P.ph_lo, hi = P.ph_hi;
#define IN(k) (lo <= (k) && (k) < hi)
#define SEAM(k) do { if (IN(k) && IN((k) + 1)) xcd_barrier(bar); } while (0)
    unsigned char* ws = P.ws;

#ifndef REPR
#define REPR 1
#endif
#ifndef REPS
#define REPS 1
#endif
#ifndef REP0
#define REP0 1
#endif
#ifndef REP2
#define REP2 1
#endif
#ifndef REP7
#define REP7 1
#endif
#ifndef REP8
#define REP8 1
#endif
    if (IN(0)) for (int rep0 = 0; rep0 < REP0; ++rep0) {
        for (int it = blk; it < 256; it += G) p0_adaln(P, lds, tid, it);
        for (int it = blk; it < 256; it += G) p0_ssm_mats(P, lds, tid, it);
        p0_misc(P, tid, blk, G);
        p0_convert(P, lds, tid, blk, G);
    }
    SEAM(0);
    if (IN(1)) p1_norm1(P, lds, tid, blk, G);
    SEAM(1);
    if (IN(2)) for (int rep2 = 0; rep2 < REP2; ++rep2) {
        DenseSched S; S.init(NTOK, NPROJ, G, blk); S.abase = (unsigned)WS_H; S.bbase = (unsigned)WS_WIN; S.lda = DM; S.ldb = DM;
        EpiInProj E{(bf16_t*)(ws + WS_PROJ)};
        g8::gemm_phase(lds, ws, DM / 64, DM, S, E);
    }
    SEAM(2);
    if (IN(3)) {
        for (int it = blk; it < 256; it += G) ssm_item(P, lds, tid, it);
        ret_kv_items(P, lds, tid, blk, G);
    }
    SEAM(3);
    if (IN(4)) {
        for (int it = blk; it < 256; it += G) ret_out_item(P, lds, tid, it);
        __syncthreads();
        DenseSched S; S.init(NTOK, 1024, G, blk); S.abase = (unsigned)WS_Z; S.bbase = (unsigned)WS_WGLU; S.lda = 1024; S.ldb = 1024;
        EpiGlu E{(const bf16_t*)(ws + WS_Z), (bf16_t*)(ws + WS_CAT), (float*)(ws + WS_ROWSS1)};
        g8::gemm_phase(lds, ws, 1024 / 64, 1024, S, E);
    }
    SEAM(4);
    if (IN(5)) {
        OutSched S; S.init(NTOK, DM, G, blk); S.abase = (unsigned)WS_CAT; S.bbase = (unsigned)WS_WOUT;
        EpiOut E{P.in[0], (const float*)(ws + WS_MOD), (const float*)(ws + WS_ROWSS1), (float*)(ws + WS_ROWSS2), (bf16_t*)(ws + WS_X1)};
        g8::gemm_phase(lds, ws, 1024 / 64, DM, S, E);
    }
    SEAM(5);
    if (IN(6)) p6_route(P, lds, tid, blk, G);
    SEAM(6);
    if (IN(7) || IN(8)) {
        LAS int* tinfo = (LAS int*)(lds + LDS_MISC + 256); LAS int* trows = tinfo + 192; LAS int* ntl = trows + 192;
        if (tid == 0) {
            const int* cg = (const int*)(ws + WS_CNT); int nt_ = 0;
            for (int e = 0; e < 32; ++e) { const int c = cg[e * 64], full = c >> 8, rem = c & 255;
                for (int t = 0; t < full; ++t) { tinfo[nt_] = e | ((t * 256) << 8); trows[nt_] = 256; ++nt_; }
                if (rem > 128) { tinfo[nt_] = e | ((full * 256) << 8); trows[nt_] = rem; ++nt_; } }
            for (int e = 0; e < 32; ++e) { const int c = cg[e * 64], full = c >> 8, rem = c & 255; if (rem > 64 && rem <= 128) { tinfo[nt_] = e | ((full * 256) << 8); trows[nt_] = rem; ++nt_; } }
            for (int e = 0; e < 32; ++e) { const int c = cg[e * 64], full = c >> 8, rem = c & 255; if (rem > 0 && rem <= 64) { tinfo[nt_] = e | ((full * 256) << 8); trows[nt_] = rem; ++nt_; } }
            ntl[0] = nt_;
        }
        __syncthreads();
        const int ntiles = __builtin_amdgcn_readfirstlane(ntl[0]);
        if (IN(7)) {
            MoeSched S{tinfo, trows, ntiles, G, blk, (const int*)(ws + WS_LIST), (unsigned)WS_H, (unsigned)WS_WGU, 0};
            EpiMoe1 E{(bf16_t*)(ws + WS_HM)};
            for (int r_ = 0; r_ < REP7; ++r_) g8::gemm_phase<EpiMoe1, MoeSched, true>(lds, ws, DM / 64, DM, S, E);
        }
        SEAM(7);
        if (IN(8)) {
            MoeSched S{tinfo, trows, ntiles, G, blk, (const int*)(ws + WS_LIST), (unsigned)WS_HM, (unsigned)WS_WD, 1};
            EpiMoe2 E{(const int*)(ws + WS_LIST), (const float*)(ws + WS_WGT), (bf16_t*)(ws + WS_Y2)};
            for (int r_ = 0; r_ < REP8; ++r_) g8::gemm_phase<EpiMoe2, MoeSched, true>(lds, ws, DEXP / 64, DEXP, S, E);
        }
    }
    SEAM(8);
    if (IN(9)) p9_final(P, tid, blk, G);
#undef IN
#undef SEAM
}

#ifndef N_LAUNCH_SPLIT
#define N_LAUNCH_SPLIT 0
#endif
extern "C" void kernel_launch(void* const* d_in, const int* in_sizes, int n_in, void* d_out, int out_size, void* d_ws, size_t ws_size, hipStream_t stream) {
    static int grid = 0;
    if (grid == 0) {
        if (n_in != 27 || out_size != NTOK * DM || ws_size < WS_END) { fprintf(stderr, "kernel_launch: unexpected shapes (n_in %d out %d ws %zu need %zu)\n", n_in, out_size, ws_size, (size_t)WS_END); grid = -1; return; }
        int dev = 0, cus = 0, per_cu = 0;
        if (hipGetDevice(&dev) != hipSuccess || hipDeviceGetAttribute(&cus, hipDeviceAttributeMultiprocessorCount, dev) != hipSuccess) { grid = -1; return; }
        if (hipFuncSetAttribute((const void*)hymba_fwd, hipFuncAttributeMaxDynamicSharedMemorySize, LDS_BYTES) != hipSuccess) { fprintf(stderr, "kernel_launch: hipFuncSetAttribute failed\n"); grid = -1; return; }
        if (hipOccupancyMaxActiveBlocksPerMultiprocessor(&per_cu, (const void*)hymba_fwd, NTHREADS, LDS_BYTES) != hipSuccess || per_cu < 1) { fprintf(stderr, "kernel_launch: occupancy query says %d\n", per_cu); }
        (void)hipGetLastError();
        grid = cus;
    }
    if (grid < 0) return;
    (void)hipMemsetAsync((char*)d_ws + WS_BAR, 0, 16384, stream);
    Params p{};
    for (int i = 0; i < 27; ++i) p.in[i] = (const float*)d_in[i];
    p.out = (float*)d_out; p.ws = (unsigned char*)d_ws;
#if N_LAUNCH_SPLIT
    for (int ph = 0; ph < 10; ++ph) { p.ph_lo = ph; p.ph_hi = ph + 1; hipLaunchKernelGGL(hymba_fwd, dim3(grid), dim3(NTHREADS), LDS_BYTES, stream, p); }
#else
    p.ph_lo = 0; p.ph_hi = 10;
    hipLaunchKernelGGL(hymba_fwd, dim3(grid), dim3(NTHREADS), LDS_BYTES, stream, p);
#endif
    const hipError_t le = hipPeekAtLastError();
    if (le != hipSuccess) fprintf(stderr, "kernel_launch: launch failed: %s\n", hipGetErrorName(le));
}
```

```cpp
#include <hip/hip_runtime.h>
#include <cstdio>
#include <cstdint>

#define LAS __attribute__((address_space(3)))
typedef unsigned short bf16_t;
typedef short bf16x8 __attribute__((ext_vector_type(8)));
typedef short bf16x4 __attribute__((ext_vector_type(4)));
typedef float f32x4 __attribute__((ext_vector_type(4)));
typedef float f32x2 __attribute__((ext_vector_type(2)));
typedef unsigned u32x4 __attribute__((ext_vector_type(4)));
typedef unsigned u32x2 __attribute__((ext_vector_type(2)));

constexpr int DM = 2048, NB = 8, SEQ = 2048, NTOK = NB * SEQ;
constexpr int NPROJ = 5120;
constexpr int NMOD = 6 * DM;
constexpr int NEXP = 32, DEXP = 1024;
constexpr int NTHREADS = 512;

constexpr size_t WS_BAR   = 0;
constexpr size_t WS_CNT   = 16384;
constexpr size_t WS_ROWSS1= WS_CNT + 8192;
constexpr size_t WS_ROWSS2= WS_ROWSS1 + (size_t)16384 * 16 * 4;
constexpr size_t WS_MODP  = WS_ROWSS2 + (size_t)16384 * 32 * 4;
constexpr size_t WS_MOD   = WS_MODP + (size_t)4 * 8 * NMOD * 4;
constexpr size_t WS_ROPE  = WS_MOD + (size_t)8 * NMOD * 4;
constexpr size_t WS_SSMA  = WS_ROPE + (size_t)2048 * 64 * 8;
constexpr size_t WS_WR    = WS_SSMA + (size_t)64 * 64 * 8;
constexpr size_t WS_SSMM  = WS_WR + (size_t)48 * 2048 * 2;
constexpr size_t WS_WIN   = WS_SSMM + (size_t)64 * 131072 * 2;
constexpr size_t WS_WOUT  = WS_WIN + (size_t)NPROJ * DM * 2;
constexpr size_t WS_WGLU  = WS_WOUT + (size_t)DM * DM * 2;
constexpr size_t WS_WGU   = WS_WGLU + (size_t)1024 * 1024 * 2;
constexpr size_t WS_WD    = WS_WGU + (size_t)NEXP * 2048 * 2048 * 2;
constexpr size_t WS_H     = WS_WD + (size_t)NEXP * 2048 * 1024 * 2;
constexpr size_t WS_PROJ  = WS_H + (size_t)NTOK * DM * 2;
constexpr size_t WS_Z     = WS_PROJ + (size_t)NTOK * NPROJ * 2;
constexpr size_t WS_CAT   = WS_Z + (size_t)NTOK * 1024 * 2;
constexpr size_t WS_WGT   = WS_CAT + (size_t)NTOK * DM * 2;
constexpr size_t WS_LIST  = WS_WGT + (size_t)32768 * 4;
constexpr size_t WS_X1    = WS_LIST + (size_t)32 * 16384 * 4;
constexpr size_t WS_END   = WS_X1 + (size_t)NTOK * DM * 2;
constexpr size_t WS_Y2    = WS_PROJ;
constexpr size_t WS_HM    = WS_Z;

constexpr int LDS_STAGE = 131072;
constexpr int LDS_BYTES = 147456;
constexpr int LDS_MISC  = LDS_BYTES - 2048;

struct Params { const float* in[27]; float* out; unsigned char* ws; int ph_lo, ph_hi; };

#define XB_TMO      128
#define XB_XCNT(j)  (256  + 64 * (j))
#define XB_XSUB(j)  (1280 + 64 * (j))
#define XB_XGEN(j)  (2304 + 64 * (j))
#define XB_TOP      3328
#define XB_TOPGEN   3392
#define XCD_BAR_WORDS 3456
#define XB_SPIN_CAP (1u << 22)

__device__ __forceinline__ unsigned xb_ld(unsigned* p)              { return __hip_atomic_load(p, __ATOMIC_RELAXED, __HIP_MEMORY_SCOPE_AGENT); }
__device__ __forceinline__ unsigned xb_add(unsigned* p, unsigned v) { return __hip_atomic_fetch_add(p, v, __ATOMIC_RELAXED, __HIP_MEMORY_SCOPE_AGENT); }
__device__ __forceinline__ unsigned xb_xcc_id() { return (unsigned)__builtin_amdgcn_s_getreg((3 << 11) | 20) & 0xFu; }
#define XB_SPIN(cond, bar) do { unsigned _sp = 0; while (cond) { __builtin_amdgcn_s_sleep(1); \
    if ((++_sp & 255u) == 0u) { if (xb_ld(&(bar)[XB_TMO])) break; if (_sp > XB_SPIN_CAP) { atomicAdd(&(bar)[XB_TMO], 1u); break; } } } } while (0)

struct XcdBarrier { unsigned* bar; unsigned x; volatile LAS unsigned* st; };

__device__ __forceinline__ XcdBarrier xcd_barrier_post(unsigned* bar, volatile LAS unsigned* st) {
    XcdBarrier b; b.bar = bar; b.x = xb_xcc_id(); b.st = st;
    if (threadIdx.x == 0) (void)xb_add(&bar[XB_XCNT(b.x)], 1u);
    return b;
}
__device__ __forceinline__ void xcd_barrier_complete(unsigned* bar, unsigned x, unsigned& nloc, unsigned& nx) {
    const unsigned G = gridDim.x * gridDim.y * gridDim.z;
    unsigned sum, cnt, mine, sp = 0u;
    for (;;) {
        sum = 0u; cnt = 0u; mine = 0u;
#pragma unroll
        for (unsigned j = 0; j < 16; ++j) { const unsigned c = xb_ld(&bar[XB_XCNT(j)]); sum += c; cnt += (c > 0u) ? 1u : 0u; mine = (j == x) ? c : mine; }
        if (sum == G) break;
        __builtin_amdgcn_s_sleep(1);
        if ((++sp & 255u) == 0u) { if (xb_ld(&bar[XB_TMO])) break; if (sp > XB_SPIN_CAP) { atomicAdd(&bar[XB_TMO], 1u); break; } }
    }
    nloc = mine > 0u ? mine : 1u; nx = cnt > 0u ? cnt : 1u;
}
__device__ __forceinline__ void xcd_barrier(const XcdBarrier& b) {
    asm volatile("s_waitcnt vmcnt(0)" ::: "memory");
    __syncthreads();
    if (threadIdx.x == 0) {
        unsigned* bar = b.bar;
        __builtin_amdgcn_s_waitcnt(0);
        unsigned nloc = b.st[0], nx = b.st[1];
        if (nloc == 0u) { xcd_barrier_complete(bar, b.x, nloc, nx); b.st[0] = nloc; b.st[1] = nx; }
        const unsigned old = xb_add(&bar[XB_XSUB(b.x)], 1u);
        const unsigned gen = old / nloc;
        if (old + 1u == (gen + 1u) * nloc) {
            __builtin_amdgcn_fence(__ATOMIC_RELEASE, "agent");
            asm volatile("s_waitcnt vmcnt(0)" ::: "memory");
            const unsigned og = xb_add(&bar[XB_TOP], 1u);
            const unsigned tg = og / nx;
            if (og + 1u == (tg + 1u) * nx) xb_add(&bar[XB_TOPGEN], 1u);
            else XB_SPIN(xb_ld(&bar[XB_TOPGEN]) == tg, bar);
            __builtin_amdgcn_fence(__ATOMIC_ACQUIRE, "agent");
            xb_add(&bar[XB_XGEN(b.x)], 1u);
            asm volatile("s_waitcnt vmcnt(0)" ::: "memory");
        } else {
            XB_SPIN(xb_ld(&bar[XB_XGEN(b.x)]) == gen, bar);
            __builtin_amdgcn_fence(__ATOMIC_ACQUIRE, "agent");
            asm volatile("s_waitcnt vmcnt(0)" ::: "memory");
        }
    }
    __syncthreads();
}

typedef __bf16 bf16x2_t __attribute__((ext_vector_type(2)));
__device__ __forceinline__ unsigned cvt_pk_bf16(float lo, float hi) { const f32x2 v = {lo, hi}; return __builtin_bit_cast(unsigned, __builtin_convertvector(v, bf16x2_t)); }
__device__ __forceinline__ float bf_lo(unsigned w) { return __uint_as_float(w << 16); }
__device__ __forceinline__ float bf_hi(unsigned w) { return __uint_as_float(w & 0xffff0000u); }
__device__ __forceinline__ float sigmoidf_(float x) { return 1.0f / (1.0f + __expf(-x)); }
__device__ __forceinline__ float gelu_tanh(float x) {
    const float u = 0.7978845608028654f * (x + 0.044715f * x * x * x);
    const float t = 1.0f - 2.0f / (1.0f + __expf(2.0f * u));
    return 0.5f * x * (1.0f + t);
}
__device__ __forceinline__ float wave_sum(float v) {
    v += __shfl_xor(v, 1); v += __shfl_xor(v, 2); v += __shfl_xor(v, 4); v += __shfl_xor(v, 8); v += __shfl_xor(v, 16); v += __shfl_xor(v, 32); return v;
}
__device__ __forceinline__ void sincos_d(double x, double& s, double& c) {
    const double TWO_PI = 6.283185307179586476925286766559;
    double r = x - TWO_PI * rint(x / TWO_PI);
    const double r2 = r * r;
    double ts = r, tc = 1.0; s = r; c = 1.0;
#pragma unroll 1
    for (int k = 1; k <= 14; ++k) { tc *= -r2 / (double)((2 * k - 1) * (2 * k)); ts *= -r2 / (double)((2 * k) * (2 * k + 1)); c += tc; s += ts; }
}

namespace g8 {
constexpr int BM = 256, BK = 64, HALF = 128, HTB = HALF * BK * 2, NXCD = 8, WGM = 8;
__device__ __forceinline__ int lds_byte(int r, int c) { const int st = (r >> 4) * 2 + (c >> 5), rr = r & 15, cc = c & 31, ob = rr * 64 + cc * 2; return st * 1024 + (ob ^ (((ob >> 9) & 1) << 5)); }
__device__ __forceinline__ void stage_rc(int b, int& R, int& C) { const int st = b / 1024, sb = b % 1024, swz = sb ^ (((sb >> 9) & 1) << 5); R = (st >> 1) * 16 + swz / 64; C = (st & 1) * 32 + (swz % 64) / 2; }
__device__ __forceinline__ int perm32(int rho) { const int n = rho >> 4, i = rho & 15; return 8 * (i >> 2) + 4 * n + (i & 3); }

struct Unit { unsigned aoff, boff; int pm, pn, flags, aux, aux2; };
typedef f32x4 Acc[2][2][4][2];

struct StaticOrder {
    int nM, nN, nwg, G, c;
    __device__ void init(int M, int N, int G_, int c_) { nM = M / BM; nN = N / BM; nwg = nM * nN; G = G_; c = c_; }
    __device__ __forceinline__ bool tile(int i, int& pm, int& pn) const {
        const long L = (long)i * G + c; if (L >= nwg) return false;
        int wgid = (int)L; { const int q = nwg / NXCD, r = nwg % NXCD, xcd = wgid % NXCD, off = wgid / NXCD; wgid = (xcd < r ? xcd * (q + 1) : r * (q + 1) + (xcd - r) * q) + off; }
        const int nig = WGM * nN, gid = wgid / nig, fm = gid * WGM, gsz = (nM - fm) < WGM ? (nM - fm) : WGM;
        pm = fm + ((wgid % nig) % gsz); pn = (wgid % nig) / gsz; return true;
    }
};

typedef long l64x2 __attribute__((ext_vector_type(2)));
template <class Epi, class Sched, bool SKIP = false, bool FP8 = false>
__device__ __forceinline__ void gemm_phase(LAS unsigned char* lds, const unsigned char* ws, const int nt, const int ldb  , const Sched& S, const Epi& E) {
    const int tid = threadIdx.x, wid = __builtin_amdgcn_readfirstlane(tid >> 6), lane = tid & 63, wr = wid >> 2, wc = wid & 3, fr = lane & 15, fq = lane >> 4;
    int R0, C0, R1, C1; stage_rc(tid * 16, R0, C0); stage_rc(tid * 16 + 8192, R1, C1);
    unsigned voffB[2];
    { const int Rb0 = Epi::PERM ? ((R0 & ~31) + perm32(R0 & 31)) : R0, Rb1 = Epi::PERM ? ((R1 & ~31) + perm32(R1 & 31)) : R1;
      voffB[0] = (unsigned)(Rb0 * 64 + C0) * 2u; voffB[1] = (unsigned)(Rb1 * 64 + C1) * 2u; }
    const unsigned kstep = (unsigned)(BK * 2);
    const unsigned kstepB = 256u * 64u * 2u;
    const unsigned hstepB = (unsigned)HALF * 64u * 2u;
    const unsigned ldsw = (unsigned)wid * 1024u;
    const int aoff = lds_byte(wr * 64 + fr, fq * 8), boff = lds_byte(wc * 32 + fr, fq * 8);
#define G8_SA(b, h) (((b) * 2 + (h)) * HTB)
#define G8_SB(b, h) ((4 + (b) * 2 + (h)) * HTB)
#define G8_STAGE(bufoff, gbase, v0, v1) do { \
        __builtin_amdgcn_global_load_lds((const unsigned*)((gbase) + (v0)), (LAS unsigned*)(lds + (bufoff) + ldsw), 16, 0, 0); \
        __builtin_amdgcn_global_load_lds((const unsigned*)((gbase) + (v1)), (LAS unsigned*)(lds + (bufoff) + ldsw + 8192), 16, 0, 0); } while (0)
#define G8_LDA(dst, b, h) do { _Pragma("unroll") for (int m = 0; m < 4; ++m) _Pragma("unroll") for (int k = 0; k < 2; ++k) dst[m][k] = *(const LAS bf16x8*)(lds + G8_SA(b, h) + aoff + m * 2048 + k * 1024); } while (0)
#define G8_LDB(dst, b, h) do { _Pragma("unroll") for (int n = 0; n < 2; ++n) _Pragma("unroll") for (int k = 0; k < 2; ++k) dst[n][k] = *(const LAS bf16x8*)(lds + G8_SB(b, h) + boff + n * 2048 + k * 1024); } while (0)
#define G8_MMA(ai, bj, At, Bt) do { __builtin_amdgcn_s_setprio(1); _Pragma("unroll") for (int m = 0; m < 4; ++m) _Pragma("unroll") for (int n = 0; n < 2; ++n) _Pragma("unroll") for (int k = 0; k < 2; ++k) { \
        if constexpr (FP8) { const l64x2 a2 = __builtin_bit_cast(l64x2, At[m][k]), b2 = __builtin_bit_cast(l64x2, Bt[n][k]); \
            acc[ai][bj][m][n] = __builtin_amdgcn_mfma_f32_16x16x32_fp8_fp8(b2[0], a2[0], acc[ai][bj][m][n], 0, 0, 0); \
            acc[ai][bj][m][n] = __builtin_amdgcn_mfma_f32_16x16x32_fp8_fp8(b2[1], a2[1], acc[ai][bj][m][n], 0, 0, 0); } \
        else acc[ai][bj][m][n] = __builtin_amdgcn_mfma_f32_16x16x32_bf16(Bt[n][k], At[m][k], acc[ai][bj][m][n], 0, 0, 0); } __builtin_amdgcn_s_setprio(0); } while (0)
#define G8_WAIT_V(n) asm volatile("s_waitcnt vmcnt(" #n ")" ::: "memory")
#define G8_WAIT_L(n) asm volatile("s_waitcnt lgkmcnt(" #n ")" ::: "memory")
#define G8_BAR __builtin_amdgcn_s_barrier()
#define G8_SCHED __builtin_amdgcn_sched_barrier(0)
    Unit cur, nxt; int ui = 0;
    if (!S.next(0, cur)) return;
    Acc acc;
#pragma unroll
    for (int a = 0; a < 2; ++a)
#pragma unroll
        for (int b = 0; b < 2; ++b)
#pragma unroll
            for (int m = 0; m < 4; ++m)
#pragma unroll
                for (int n = 0; n < 2; ++n) acc[a][b][m][n] = (f32x4){0.f, 0.f, 0.f, 0.f};
    bf16x8 At[4][2], B0[2][2], B1[2][2];
    unsigned cv[2][2], nv[2][2];
    S.aoffs(cur, R0, C0, R1, C1, cv);
    const unsigned char* cA = ws + cur.aoff; const unsigned char* cB = ws + cur.boff;
    G8_STAGE(G8_SB(0, 0), cB, voffB[0], voffB[1]); G8_STAGE(G8_SA(0, 0), cA, cv[0][0], cv[0][1]);
    G8_STAGE(G8_SB(0, 1), cB + hstepB, voffB[0], voffB[1]); G8_STAGE(G8_SA(0, 1), cA, cv[1][0], cv[1][1]);
    if (wr == 1) G8_BAR;
    G8_WAIT_V(4); G8_BAR;
    G8_STAGE(G8_SB(1, 0), cB + kstepB, voffB[0], voffB[1]); G8_STAGE(G8_SA(1, 0), cA + kstep, cv[0][0], cv[0][1]);
    G8_STAGE(G8_SB(1, 1), cB + hstepB + kstepB, voffB[0], voffB[1]);
    G8_WAIT_V(6); G8_BAR;
    for (;;) {
        const bool has_next = S.next(ui + 1, nxt);
        if (has_next) S.aoffs(nxt, R0, C0, R1, C1, nv);
        else { nv[0][0] = cv[0][0]; nv[0][1] = cv[0][1]; nv[1][0] = cv[1][0]; nv[1][1] = cv[1][1]; }
        const unsigned char* nA = has_next ? ws + nxt.aoff : cA; const unsigned char* nB = has_next ? ws + nxt.boff : cB;
        const int vrows = SKIP ? cur.aux2 : 256;
        const bool do0 = !SKIP || vrows > 64 || wr == 0, do1 = !SKIP || vrows > 128;
        for (int t = 0; t < nt; t += 2) {
            const bool last = (t == nt - 2);
            const unsigned char* a1 = cA + (size_t)(t + 1) * kstep;
            const unsigned char* a2 = last ? nA : cA + (size_t)(t + 2) * kstep; const unsigned char* b2 = last ? nB : cB + (size_t)(t + 2) * kstepB;
            const unsigned char* a3 = a2 + kstep; const unsigned char* b3 = b2 + kstepB;
            const unsigned o00 = last ? nv[0][0] : cv[0][0], o01 = last ? nv[0][1] : cv[0][1], o10 = last ? nv[1][0] : cv[1][0], o11 = last ? nv[1][1] : cv[1][1];
            G8_LDB(B0, 0, 0); G8_SCHED; G8_LDA(At, 0, 0); G8_STAGE(G8_SA(1, 1), a1, cv[1][0], cv[1][1]);
            G8_WAIT_L(8); G8_BAR; G8_WAIT_L(0); if (do0) G8_MMA(0, 0, At, B0); G8_BAR; G8_SCHED;
            G8_LDB(B1, 0, 1); G8_STAGE(G8_SB(0, 0), b2, voffB[0], voffB[1]);
            G8_BAR; G8_WAIT_L(0); if (do0) G8_MMA(0, 1, At, B1); G8_BAR;
            G8_LDA(At, 0, 1); G8_STAGE(G8_SA(0, 0), a2, o00, o01);
            G8_BAR; G8_WAIT_L(0); if (do1) G8_MMA(1, 0, At, B0); G8_BAR; G8_SCHED;
            G8_STAGE(G8_SB(0, 1), b2 + hstepB, voffB[0], voffB[1]);
            G8_WAIT_V(6); G8_BAR; if (do1) G8_MMA(1, 1, At, B1); G8_BAR;
            G8_LDB(B0, 1, 0); G8_SCHED; G8_LDA(At, 1, 0); G8_STAGE(G8_SA(0, 1), a2, o10, o11);
            G8_WAIT_L(8); G8_BAR; G8_WAIT_L(0); if (do0) G8_MMA(0, 0, At, B0); G8_BAR; G8_SCHED;
            G8_LDB(B1, 1, 1); G8_STAGE(G8_SB(1, 0), b3, voffB[0], voffB[1]);
            G8_BAR; G8_WAIT_L(0); if (do0) G8_MMA(0, 1, At, B1); G8_BAR;
            G8_LDA(At, 1, 1); G8_STAGE(G8_SA(1, 0), a3, o00, o01);
            G8_BAR; G8_WAIT_L(0); if (do1) G8_MMA(1, 0, At, B0); G8_BAR; G8_SCHED;
            G8_STAGE(G8_SB(1, 1), b3 + hstepB, voffB[0], voffB[1]);
            G8_WAIT_V(6); G8_BAR; if (do1) G8_MMA(1, 1, At, B1); G8_BAR;
        }
        E(acc, cur, wr, wc, fr, fq);
        if (!has_next) break;
        if (!(cur.flags & 1)) {
#pragma unroll
            for (int a = 0; a < 2; ++a)
#pragma unroll
                for (int b = 0; b < 2; ++b)
#pragma unroll
                    for (int m = 0; m < 4; ++m)
#pragma unroll
                        for (int n = 0; n < 2; ++n) acc[a][b][m][n] = (f32x4){0.f, 0.f, 0.f, 0.f};
        }
        cur = nxt; cA = nA; cB = nB; ++ui;
        cv[0][0] = nv[0][0]; cv[0][1] = nv[0][1]; cv[1][0] = nv[1][0]; cv[1][1] = nv[1][1];
    }
    G8_WAIT_V(0);
    if (wr == 0) G8_BAR;
    G8_BAR;
#undef G8_SA
#undef G8_SB
#undef G8_STAGE
#undef G8_LDA
#undef G8_LDB
#undef G8_MMA
#undef G8_WAIT_V
#undef G8_WAIT_L
#undef G8_BAR
#undef G8_SCHED
}
}

__device__ __forceinline__ void p0_adaln(const Params& P, LAS unsigned char* lds, int tid, int item) {
    const int ks = item & 3, nc = item >> 2;
    LAS float* sc = (LAS float*)lds;
    LAS float* red = (LAS float*)(lds + 16384);
    const float* c = P.in[1];
    for (int i = tid; i < 4096; i += NTHREADS) { const int kl = i >> 3, b = i & 7; const float v = c[b * 2048 + ks * 512 + kl]; sc[i] = v / (1.0f + expf(-v)); }
    __syncthreads();
    if (tid < 384) {
        const int nq = tid % 48, kg = tid / 48;
        const float* W = P.in[2] + (size_t)(ks * 512 + kg * 64) * NMOD + nc * 192 + nq * 4;
        f32x4 acc[8];
#pragma unroll
        for (int b = 0; b < 8; ++b) acc[b] = (f32x4){0.f, 0.f, 0.f, 0.f};
#pragma unroll 16
        for (int kk = 0; kk < 64; ++kk) {
            const f32x4 w = *(const f32x4*)(W + (size_t)kk * NMOD);
            const f32x4 s0 = *(const LAS f32x4*)(sc + (kg * 64 + kk) * 8), s1 = *(const LAS f32x4*)(sc + (kg * 64 + kk) * 8 + 4);
            acc[0] += w * s0[0]; acc[1] += w * s0[1]; acc[2] += w * s0[2]; acc[3] += w * s0[3];
            acc[4] += w * s1[0]; acc[5] += w * s1[1]; acc[6] += w * s1[2]; acc[7] += w * s1[3];
        }
#pragma unroll
        for (int b = 0; b < 8; ++b) *(LAS f32x4*)(red + (kg * 8 + b) * 192 + nq * 4) = acc[b];
    }
    __syncthreads();
    float* modp = (float*)(P.ws + WS_MODP);
    for (int i = tid; i < 8 * 192; i += NTHREADS) {
        const int b = i / 192, n = i % 192; float s = 0.f;
#pragma unroll
        for (int kg = 0; kg < 8; ++kg) s += red[(kg * 8 + b) * 192 + n];
        modp[(size_t)(ks * 8 + b) * NMOD + nc * 192 + n] = s;
    }
    __syncthreads();
}

struct CvtUnit { const float* src; bf16_t* dst; int Nd, Kd, k0, n0, nmode; const float* s0; const float* s1; };
constexpr int CVT_UNITS = 640 + 256 + 64;
__device__ __forceinline__ void cvt_unit_decode(const Params& P, int L, CvtUnit& u) {
    u.s0 = nullptr; u.s1 = nullptr; u.nmode = 0;
    if (L < 640) { u.src = P.in[5]; u.dst = (bf16_t*)(P.ws + WS_WIN); u.Kd = 2048; u.Nd = 5120; u.k0 = (L / 20) * 64; u.n0 = (L % 20) * 256; u.nmode = 3; return; }
    L -= 640;
    if (L < 256) { u.src = P.in[17]; u.dst = (bf16_t*)(P.ws + WS_WOUT); u.Kd = 2048; u.Nd = 2048; u.k0 = (L / 8) * 64; u.n0 = (L % 8) * 256; u.s0 = P.in[15]; u.s1 = P.in[16]; return; }
    L -= 256;
    if (L < 64) { u.src = P.in[14]; u.dst = (bf16_t*)(P.ws + WS_WGLU); u.Kd = 1024; u.Nd = 1024; u.k0 = (L / 4) * 64; u.n0 = (L % 4) * 256; return; }
    L -= 64;
    if (L < 4096) { const int e = L >> 7, r = L & 127; u.src = P.in[23] + (size_t)e * 2048 * 1024; u.dst = (bf16_t*)(P.ws + WS_WGU) + (size_t)e * 2048 * 2048; u.Kd = 2048; u.Nd = 1024; u.k0 = (r >> 2) * 64; u.n0 = (r & 3) * 256; u.nmode = 1; return; }
    L -= 4096;
    if (L < 4096) { const int e = L >> 7, r = L & 127; u.src = P.in[24] + (size_t)e * 2048 * 1024; u.dst = (bf16_t*)(P.ws + WS_WGU) + (size_t)e * 2048 * 2048; u.Kd = 2048; u.Nd = 1024; u.k0 = (r >> 2) * 64; u.n0 = (r & 3) * 256; u.nmode = 2; return; }
    L -= 4096;
    { const int e = L >> 7, r = L & 127; u.src = P.in[25] + (size_t)e * 1024 * 2048; u.dst = (bf16_t*)(P.ws + WS_WD) + (size_t)e * 2048 * 1024; u.Kd = 1024; u.Nd = 2048; u.k0 = (r >> 3) * 64; u.n0 = (r & 7) * 256; }
}
__device__ __forceinline__ void cvt_load(const CvtUnit& u, int tid, f32x4 (&r)[8]) {
    const int kp = tid >> 4, nq = tid & 15;
    const float* p = u.src + (size_t)(u.k0 + 2 * kp) * u.Nd + u.n0 + nq * 4;
#pragma unroll
    for (int s = 0; s < 4; ++s) { r[2 * s] = *(const f32x4*)(p + s * 64); r[2 * s + 1] = *(const f32x4*)(p + u.Nd + s * 64); }
    if (u.s0) {
        const int k = u.k0 + 2 * kp;
        const float a = (k < 1024) ? u.s0[k] : u.s1[k - 1024], b = (k + 1 < 1024) ? u.s0[k + 1] : u.s1[k + 1 - 1024];
#pragma unroll
        for (int s = 0; s < 4; ++s) { r[2 * s] *= a; r[2 * s + 1] *= b; }
    }
}
__device__ __forceinline__ void cvt_to_lds(LAS unsigned* tile, const f32x4 (&r)[8], int kp, int nq) {
#pragma unroll
    for (int s = 0; s < 4; ++s)
#pragma unroll
        for (int j = 0; j < 4; ++j) tile[s * 2112 + (nq * 4 + j) * 33 + kp] = cvt_pk_bf16(r[2 * s][j], r[2 * s + 1][j]);
}
__device__ __forceinline__ void cvt_store(const LAS unsigned* tile, const CvtUnit& u, int nl, int kq) {
#pragma unroll
    for (int s = 0; s < 4; ++s) {
        u32x4 w; w.x = tile[s * 2112 + nl * 33 + kq * 4]; w.y = tile[s * 2112 + nl * 33 + kq * 4 + 1]; w.z = tile[s * 2112 + nl * 33 + kq * 4 + 2]; w.w = tile[s * 2112 + nl * 33 + kq * 4 + 3];
        const int n = u.n0 + s * 64 + nl;
        int np = n;
        if (u.nmode == 1 || u.nmode == 2) np = (n >> 7) * 256 + (n & 127) + (u.nmode == 2 ? 128 : 0);
        else if (u.nmode == 3 && n >= 1024 && n < 3072) { const int reg = (n >= 2048) ? 2048 : 1024, nr = n - reg;
            np = reg + ((nr >> 8) << 8) + (((nr >> 6) & 1) << 7) + (((nr >> 7) & 1) << 6) + (nr & 63); }
        *(u32x4*)(u.dst + (size_t)(np >> 8) * ((size_t)u.Kd * 256) + (size_t)(u.k0 >> 6) * 16384 + (np & 255) * 64 + kq * 8) = w;
    }
}
__device__ __forceinline__ void p0_convert(const Params& P, LAS unsigned char* lds, int tid, int blk, int G) {
    LAS unsigned* tileA = (LAS unsigned*)lds;
    LAS unsigned* tileB = tileA + 4 * 2112;
    const int kp = tid >> 4, nq = tid & 15, nl = tid >> 3, kq = tid & 7;
    CvtUnit uA, uB, nA, nB; f32x4 rA[8], rB[8];
    int L = blk;
    if (L >= CVT_UNITS) return;
    bool hasB = (L + G) < CVT_UNITS;
    cvt_unit_decode(P, L, uA); cvt_load(uA, tid, rA);
    if (hasB) { cvt_unit_decode(P, L + G, uB); cvt_load(uB, tid, rB); }
    for (;;) {
        cvt_to_lds(tileA, rA, kp, nq);
        if (hasB) cvt_to_lds(tileB, rB, kp, nq);
        __syncthreads();
        const int Ln = L + 2 * G; const bool moreA = Ln < CVT_UNITS, moreB = (Ln + G) < CVT_UNITS;
        if (moreA) { cvt_unit_decode(P, Ln, nA); cvt_load(nA, tid, rA); }
        if (moreB) { cvt_unit_decode(P, Ln + G, nB); cvt_load(nB, tid, rB); }
        cvt_store(tileA, uA, nl, kq);
        if (hasB) cvt_store(tileB, uB, nl, kq);
        __syncthreads();
        if (!moreA) break;
        uA = nA; uB = nB; hasB = moreB; L = Ln;
    }
}

struct Cvt8Unit { const float* src; unsigned char* dst; int Nd, Kd, k0, n0, nmode; float scale; };
constexpr float WGU_SCALE = 64.0f, WD_SCALE = 32.0f;
__device__ __forceinline__ void cvt8_decode(const Params& P, int L, Cvt8Unit& u) {
    if (L < 8192) { const int up = L >= 4096; const int r_ = L & 4095; const int e = r_ >> 7, r = r_ & 127;
        u.src = P.in[up ? 24 : 23] + (size_t)e * 2048 * 1024; u.dst = P.ws + WS_WGU + (size_t)e * 2048 * 2048; u.Kd = 2048; u.Nd = 1024; u.k0 = (r >> 2) * 64; u.n0 = (r & 3) * 256; u.nmode = up ? 2 : 1; u.scale = WGU_SCALE; return; }
    L -= 8192;
    { const int e = L >> 7, r = L & 127; u.src = P.in[25] + (size_t)e * 1024 * 2048; u.dst = P.ws + WS_WD + (size_t)e * 2048 * 1024; u.Kd = 1024; u.Nd = 2048; u.k0 = (r >> 3) * 64; u.n0 = (r & 7) * 256; u.nmode = 0; u.scale = WD_SCALE; }
}
__device__ __forceinline__ void cvt8_load(const Cvt8Unit& u, int tid, f32x4 (&r)[8]) {
    const int kg = tid >> 5, nq = tid & 31;
    const float* p = u.src + (size_t)(u.k0 + 4 * kg) * u.Nd + u.n0 + nq * 4;
#pragma unroll
    for (int kk = 0; kk < 4; ++kk) { r[2 * kk] = *(const f32x4*)(p + (size_t)kk * u.Nd); r[2 * kk + 1] = *(const f32x4*)(p + (size_t)kk * u.Nd + 128); }
}
__device__ __forceinline__ void cvt8_to_lds(LAS unsigned* tile, const f32x4 (&r)[8], float sc, int tid) {
    const int kg = tid >> 5, nq = tid & 31;
#pragma unroll
    for (int h = 0; h < 2; ++h)
#pragma unroll
        for (int j = 0; j < 4; ++j) {
            int w = 0;
            w = __builtin_amdgcn_cvt_pk_fp8_f32(r[0 + h][j] * sc, r[2 + h][j] * sc, w, false);
            w = __builtin_amdgcn_cvt_pk_fp8_f32(r[4 + h][j] * sc, r[6 + h][j] * sc, w, true);
            tile[(h * 128 + nq * 4 + j) * 17 + kg] = (unsigned)w;
        }
}
__device__ __forceinline__ void cvt8_store(const LAS unsigned* tile, const Cvt8Unit& u, int tid) {
    const int nl = tid >> 1, half = tid & 1;
    u32x4 w0, w1;
    w0.x = tile[nl * 17 + half * 8 + 0]; w0.y = tile[nl * 17 + half * 8 + 1]; w0.z = tile[nl * 17 + half * 8 + 2]; w0.w = tile[nl * 17 + half * 8 + 3];
    w1.x = tile[nl * 17 + half * 8 + 4]; w1.y = tile[nl * 17 + half * 8 + 5]; w1.z = tile[nl * 17 + half * 8 + 6]; w1.w = tile[nl * 17 + half * 8 + 7];
    const int n = u.n0 + nl;
    int np = n;
    if (u.nmode == 1 || u.nmode == 2) np = (n >> 7) * 256 + (n & 127) + (u.nmode == 2 ? 128 : 0);
    unsigned char* d = u.dst + (size_t)(np >> 8) * ((size_t)u.Kd * 256) + (size_t)(u.k0 >> 7) * 32768 + (np & 255) * 128 + (u.k0 & 64) + half * 32;
    *(u32x4*)d = w0; *(u32x4*)(d + 16) = w1;
}
__device__ __forceinline__ void p0_convert_fp8(const Params& P, LAS unsigned char* lds, int tid, int blk, int G, const int Lbeg, const int Lend) {
    LAS unsigned* tileA = (LAS unsigned*)lds;
    LAS unsigned* tileB = tileA + 256 * 17;
    Cvt8Unit uA, uB, nA, nB; f32x4 rA[8], rB[8];
    int L = Lbeg + blk;
    if (L >= Lend) return;
    bool hasB = (L + G) < Lend;
    cvt8_decode(P, L, uA); cvt8_load(uA, tid, rA);
    if (hasB) { cvt8_decode(P, L + G, uB); cvt8_load(uB, tid, rB); }
    for (;;) {
        cvt8_to_lds(tileA, rA, uA.scale, tid);
        if (hasB) cvt8_to_lds(tileB, rB, uB.scale, tid);
        __syncthreads();
        const int Ln = L + 2 * G; const bool moreA = Ln < Lend, moreB = (Ln + G) < Lend;
        if (moreA) { cvt8_decode(P, Ln, nA); cvt8_load(nA, tid, rA); }
        if (moreB) { cvt8_decode(P, Ln + G, nB); cvt8_load(nB, tid, rB); }
        cvt8_store(tileA, uA, tid);
        if (hasB) cvt8_store(tileB, uB, tid);
        __syncthreads();
        if (!moreA) break;
        uA = nA; uB = nB; hasB = moreB; L = Ln;
    }
}

__device__ __forceinline__ void p0_ssm_mats(const Params& P, LAS unsigned char* lds, int tid, int item) {
    const int g = item & 63, q = item >> 6;
    LAS f32x2* pw = (LAS f32x2*)lds;
    LAS f32x2* Bb = pw + 17 * 64;
    LAS f32x2* Cc = Bb + 64 * 16;
    LAS float* Kt = (LAS float*)(Cc + 16 * 64);
    if (tid < 64) {
        const int p = tid;
        const float dt = expf(P.in[13][g]);
        const float are = P.in[6][g * 64 + p], aim = P.in[7][g * 64 + p];
        const float mag = expf(dt * are);
        double sd, cd; sincos_d((double)(dt * aim), sd, cd);
        const float abr = mag * (float)cd, abi = mag * (float)sd;
        const float inv = 1.0f / (are * are + aim * aim);
        const float nre = abr - 1.0f;
        const float fre = (nre * are + abi * aim) * inv, fim = (abi * are - nre * aim) * inv;
        float pr = 1.0f, pi = 0.0f;
        for (int n = 0; n <= 16; ++n) { pw[n * 64 + p] = (f32x2){pr, pi}; const float t = pr * abr - pi * abi; pi = pr * abi + pi * abr; pr = t; }
        for (int h = 0; h < 16; ++h) {
            const float br = P.in[8][(g * 64 + p) * 16 + h], bi = P.in[9][(g * 64 + p) * 16 + h];
            Bb[p * 16 + h] = (f32x2){fre * br - fim * bi, fre * bi + fim * br};
            Cc[h * 64 + p] = (f32x2){P.in[10][(g * 16 + h) * 64 + p], P.in[11][(g * 16 + h) * 64 + p]};
        }
        if (q == 0) { f32x2* AL = (f32x2*)(P.ws + WS_SSMA); const f32x2 v = pw[16 * 64 + p]; AL[g * 64 + p] = v; }
    }
    __syncthreads();
    for (int o = tid; o < 4096; o += NTHREADS) {
        const int tau = o >> 8, ho = (o >> 4) & 15, hi = o & 15; float s = 0.f;
        for (int p = 0; p < 64; ++p) {
            const f32x2 c = Cc[ho * 64 + p], a = pw[tau * 64 + p], b = Bb[p * 16 + hi];
            const float cr = c.x * a.x - c.y * a.y, ci = c.x * a.y + c.y * a.x;
            s += cr * b.x - ci * b.y;
        }
        Kt[o] = s;
    }
    __syncthreads();
    bf16_t* Ms = (bf16_t*)(P.ws + WS_SSMM) + (size_t)g * 131072;
    bf16_t* TM = Ms + 32768;
    for (int o = tid; o < 32 * 128; o += NTHREADS) {
        const int row = 32 * q + (o >> 7), col = (o & 127) * 2;
        const int p = row >> 1, j = col >> 4, hi = col & 15;
        const f32x2 a = pw[(15 - j) * 64 + p], b0 = Bb[p * 16 + hi], b1 = Bb[p * 16 + hi + 1];
        float v0, v1;
        if ((row & 1) == 0) { v0 = a.x * b0.x - a.y * b0.y; v1 = a.x * b1.x - a.y * b1.y; } else { v0 = a.x * b0.y + a.y * b0.x; v1 = a.x * b1.y + a.y * b1.x; }
        *(unsigned*)(Ms + (size_t)row * 256 + col) = cvt_pk_bf16(v0, v1);
    }
    for (int o = tid; o < 64 * 192; o += NTHREADS) {
        const int row = 64 * q + o / 192, col = (o % 192) * 2;
        const int i = row >> 4, ho = row & 15; float v0, v1;
        if (col < 256) { const int j = col >> 4, hi = col & 15; if (j <= i) { v0 = Kt[((i - j) * 16 + ho) * 16 + hi]; v1 = Kt[((i - j) * 16 + ho) * 16 + hi + 1]; } else { v0 = 0.f; v1 = 0.f; } }
        else { const int p0 = (col - 256) >> 1;
            const f32x2 c0 = Cc[ho * 64 + p0], a0 = pw[(i + 1) * 64 + p0];
            v0 = c0.x * a0.x - c0.y * a0.y; v1 = -(c0.x * a0.y + c0.y * a0.x); }
        *(unsigned*)(TM + (size_t)row * 384 + col) = cvt_pk_bf16(v0, v1);
    }
    __syncthreads();
}

__device__ __forceinline__ void p0_misc(const Params& P, int tid, int blk, int G) {
    bf16_t* wr = (bf16_t*)(P.ws + WS_WR);
    for (int i = blk * NTHREADS + tid; i < 48 * 2048; i += G * NTHREADS) {
        const int n = i >> 11, k = i & 2047; float v = 0.f;
        if (n < 4) v = P.in[19][k * 4 + n]; else if (n < 36) v = P.in[21][k * 32 + (n - 4)];
        wr[i] = (bf16_t)(cvt_pk_bf16(v, 0.f) & 0xffffu);
    }
    if (blk == 0) for (int i = tid; i < 2048; i += NTHREADS) ((int*)(P.ws + WS_CNT))[i] = 0;
}

__device__ __forceinline__ void p1_norm1(const Params& P, LAS unsigned char* lds, int tid, int blk, int G) {
    const float* modp = (const float*)(P.ws + WS_MODP); const float* bada = P.in[3];
    float* mod = (float*)(P.ws + WS_MOD);
    for (int i = blk * NTHREADS + tid; i < 8 * NMOD; i += G * NTHREADS) {
        const int b = i / NMOD, j = i % NMOD;
        mod[i] = bada[j] + ((modp[(size_t)(0 * 8 + b) * NMOD + j] + modp[(size_t)(1 * 8 + b) * NMOD + j]) + (modp[(size_t)(2 * 8 + b) * NMOD + j] + modp[(size_t)(3 * 8 + b) * NMOD + j]));
    }
    LAS float* gm = (LAS float*)lds; LAS float* sh = gm + 2048;
    const int wave = tid >> 6, lane = tid & 63;
    bf16_t* H = (bf16_t*)(P.ws + WS_H);
    for (int rb = blk; rb < 256; rb += G) {
        const int b = rb >> 5;
        for (int k = tid; k < 2048; k += NTHREADS) {
            const int js = 2048 + k, jh = k;
            const float sc = bada[js] + ((modp[(size_t)(0 * 8 + b) * NMOD + js] + modp[(size_t)(1 * 8 + b) * NMOD + js]) + (modp[(size_t)(2 * 8 + b) * NMOD + js] + modp[(size_t)(3 * 8 + b) * NMOD + js]));
            const float sv = bada[jh] + ((modp[(size_t)(0 * 8 + b) * NMOD + jh] + modp[(size_t)(1 * 8 + b) * NMOD + jh]) + (modp[(size_t)(2 * 8 + b) * NMOD + jh] + modp[(size_t)(3 * 8 + b) * NMOD + jh]));
            gm[k] = P.in[4][k] * (1.0f + sc); sh[k] = sv;
        }
        __syncthreads();
        f32x4 v[8], vn[8];
        { const float* xr = P.in[0] + (size_t)(rb * 64 + wave * 8) * DM;
#pragma unroll
          for (int i = 0; i < 8; ++i) v[i] = *(const f32x4*)(xr + (i * 64 + lane) * 4); }
        for (int rr = 0; rr < 8; ++rr) {
            const int row = rb * 64 + wave * 8 + rr;
            if (rr < 7) { const float* xn = P.in[0] + (size_t)(row + 1) * DM;
#pragma unroll
                for (int i = 0; i < 8; ++i) vn[i] = *(const f32x4*)(xn + (i * 64 + lane) * 4); }
            float ss = 0.f;
#pragma unroll
            for (int i = 0; i < 8; ++i) ss += v[i][0] * v[i][0] + v[i][1] * v[i][1] + v[i][2] * v[i][2] + v[i][3] * v[i][3];
            ss = wave_sum(ss);
            const float r = rsqrtf(ss * (1.0f / 2048.0f) + 1e-6f);
#pragma unroll
            for (int i = 0; i < 8; ++i) {
                const int k = (i * 64 + lane) * 4;
                const f32x4 g4 = *(const LAS f32x4*)(gm + k), s4 = *(const LAS f32x4*)(sh + k);
                const f32x4 o = v[i] * r * g4 + s4;
                u32x2 w; w.x = cvt_pk_bf16(o[0], o[1]); w.y = cvt_pk_bf16(o[2], o[3]);
                *(u32x2*)(H + (size_t)row * DM + k) = w;
            }
#pragma unroll
            for (int i = 0; i < 8; ++i) v[i] = vn[i];
        }
        __syncthreads();
    }
}

struct DenseSched : g8::StaticOrder {
    unsigned abase, bbase; int lda, ldb;
    __device__ __forceinline__ bool next(int i, g8::Unit& u) const {
        int pm, pn; if (!tile(i, pm, pn)) return false;
        u.pm = __builtin_amdgcn_readfirstlane(pm); u.pn = __builtin_amdgcn_readfirstlane(pn); u.flags = 0; u.aux = 0;
        u.aoff = abase + (unsigned)u.pm * 256u * (unsigned)lda * 2u; u.boff = bbase + (unsigned)u.pn * 256u * (unsigned)ldb * 2u; return true;
    }
    __device__ __forceinline__ void aoffs(const g8::Unit&, int R0, int C0, int R1, int C1, unsigned (&v)[2][2]) const {
        v[0][0] = (unsigned)(R0 * lda + C0) * 2u; v[0][1] = (unsigned)(R1 * lda + C1) * 2u;
        v[1][0] = (unsigned)((128 + R0) * lda + C0) * 2u; v[1][1] = (unsigned)((128 + R1) * lda + C1) * 2u;
    }
};
struct EpiStoreBf16 {
    static constexpr bool PERM = true;
    bf16_t* O; int ldc;
    __device__ __forceinline__ void operator()(g8::Acc& acc, const g8::Unit& u, int wr, int wc, int fr, int fq) const {
        const int row0 = u.pm * 256 + wr * 64 + fr, col0 = u.pn * 256 + wc * 32 + 8 * fq;
#pragma unroll
        for (int ai = 0; ai < 2; ++ai)
#pragma unroll
            for (int m = 0; m < 4; ++m) { bf16_t* rowp = O + (size_t)(row0 + ai * 128 + m * 16) * ldc + col0;
#pragma unroll
                for (int bj = 0; bj < 2; ++bj) { const f32x4 v0 = acc[ai][bj][m][0], v1 = acc[ai][bj][m][1];
                    u32x4 w; w.x = cvt_pk_bf16(v0[0], v0[1]); w.y = cvt_pk_bf16(v0[2], v0[3]); w.z = cvt_pk_bf16(v1[0], v1[1]); w.w = cvt_pk_bf16(v1[2], v1[3]);
                    *(u32x4*)(rowp + bj * 128) = w; } }
    }
};
struct EpiInProj {
    static constexpr bool PERM = true;
    bf16_t* O;
    __device__ __forceinline__ void operator()(g8::Acc& acc, const g8::Unit& u, int wr, int wc, int fr, int fq) const {
        const int pn = u.pn;
        const int row0 = u.pm * 256 + wr * 64 + fr;
        if (pn < 4 || pn >= 12) {
            const int col0 = pn * 256 + wc * 32 + 8 * fq;
#pragma unroll
            for (int ai = 0; ai < 2; ++ai)
#pragma unroll
                for (int m = 0; m < 4; ++m) { bf16_t* rowp = O + (size_t)(row0 + ai * 128 + m * 16) * NPROJ + col0;
#pragma unroll
                    for (int bj = 0; bj < 2; ++bj) { const f32x4 v0 = acc[ai][bj][m][0], v1 = acc[ai][bj][m][1];
                        u32x4 w; w.x = cvt_pk_bf16(v0[0], v0[1]); w.y = cvt_pk_bf16(v0[2], v0[3]); w.z = cvt_pk_bf16(v1[0], v1[1]); w.w = cvt_pk_bf16(v1[2], v1[3]);
                        *(u32x4*)(rowp + bj * 128) = w; } }
            return;
        }
        const bool isq = pn < 8;
        const int head = 2 * ((pn - 4) & 3) + (wc >> 1);
        const int dd0 = 32 * (wc & 1) + 8 * fq;
        const int colbase = (isq ? 1024 : 2048) + head * 128 + dd0;
        const float lg2 = log2f(1.0f - exp2f(-5.0f - (float)head));
        float fr_[8];
#pragma unroll
        for (int t = 0; t < 8; ++t) fr_[t] = exp2f(-(float)(dd0 + t) * 0.20762050593046014f) * 0.15915494309189535f;
#pragma unroll
        for (int ai = 0; ai < 2; ++ai)
#pragma unroll
            for (int m = 0; m < 4; ++m) {
                const int row = row0 + ai * 128 + m * 16, pos = row & 2047, i = wr * 64 + m * 16 + fr;
                const float sc = isq ? exp2f(lg2 * (float)i) : exp2f(-lg2 * (float)i) * 0.08838834764831845f;
                const float fp = (float)pos;
                float o1[8], o2[8];
#pragma unroll
                for (int t = 0; t < 8; ++t) {
                    const float rev = __builtin_amdgcn_fractf(fp * fr_[t]);
                    const float cs = __builtin_amdgcn_cosf(rev) * sc, sn = __builtin_amdgcn_sinf(rev) * sc;
                    const float a = acc[ai][0][m][t >> 2][t & 3], b = acc[ai][1][m][t >> 2][t & 3];
                    o1[t] = a * cs - b * sn; o2[t] = b * cs + a * sn;
                }
                bf16_t* rowp = O + (size_t)row * NPROJ + colbase;
                u32x4 w1, w2; w1.x = cvt_pk_bf16(o1[0], o1[1]); w1.y = cvt_pk_bf16(o1[2], o1[3]); w1.z = cvt_pk_bf16(o1[4], o1[5]); w1.w = cvt_pk_bf16(o1[6], o1[7]);
                w2.x = cvt_pk_bf16(o2[0], o2[1]); w2.y = cvt_pk_bf16(o2[2], o2[3]); w2.z = cvt_pk_bf16(o2[4], o2[5]); w2.w = cvt_pk_bf16(o2[6], o2[7]);
                *(u32x4*)rowp = w1; *(u32x4*)(rowp + 64) = w2;
            }
    }
};
struct EpiGlu {
    static constexpr bool PERM = true;
    const bf16_t* Z; bf16_t* CAT; float* rowss;
    __device__ __forceinline__ void operator()(g8::Acc& acc, const g8::Unit& u, int wr, int wc, int fr, int fq) const {
        const int row0 = u.pm * 256 + wr * 64 + fr, col0 = u.pn * 256 + wc * 32 + 8 * fq;
#pragma unroll
        for (int ai = 0; ai < 2; ++ai) {
            u32x4 zz[4][2];
#pragma unroll
            for (int m = 0; m < 4; ++m)
#pragma unroll
                for (int bj = 0; bj < 2; ++bj) zz[m][bj] = *(const u32x4*)(Z + (size_t)(row0 + ai * 128 + m * 16) * 1024 + col0 + bj * 128);
#pragma unroll
            for (int m = 0; m < 4; ++m) { const int row = row0 + ai * 128 + m * 16; float ss = 0.f;
#pragma unroll
                for (int bj = 0; bj < 2; ++bj) { const f32x4 v0 = acc[ai][bj][m][0], v1 = acc[ai][bj][m][1];
                    const u32x4 z4 = zz[m][bj];
                    float o[8];
                    o[0] = bf_lo(z4.x) * sigmoidf_(v0[0]); o[1] = bf_hi(z4.x) * sigmoidf_(v0[1]); o[2] = bf_lo(z4.y) * sigmoidf_(v0[2]); o[3] = bf_hi(z4.y) * sigmoidf_(v0[3]);
                    o[4] = bf_lo(z4.z) * sigmoidf_(v1[0]); o[5] = bf_hi(z4.z) * sigmoidf_(v1[1]); o[6] = bf_lo(z4.w) * sigmoidf_(v1[2]); o[7] = bf_hi(z4.w) * sigmoidf_(v1[3]);
#pragma unroll
                    for (int j = 0; j < 8; ++j) ss += o[j] * o[j];
                    u32x4 w; w.x = cvt_pk_bf16(o[0], o[1]); w.y = cvt_pk_bf16(o[2], o[3]); w.z = cvt_pk_bf16(o[4], o[5]); w.w = cvt_pk_bf16(o[6], o[7]);
                    *(u32x4*)(CAT + (size_t)row * DM + col0 + bj * 128) = w; }
                ss += __shfl_xor(ss, 16); ss += __shfl_xor(ss, 32);
                if (fq == 0) rowss[(size_t)row * 16 + u.pn * 4 + wc] = ss; }
        }
    }
};
struct OutSched : g8::StaticOrder {
    unsigned abase, bbase;
    __device__ __forceinline__ bool next(int i, g8::Unit& u) const {
        int pm, pn; if (!tile(i >> 1, pm, pn)) return false;
        const int half = i & 1;
        u.pm = __builtin_amdgcn_readfirstlane(pm); u.pn = __builtin_amdgcn_readfirstlane(pn); u.flags = half ? 0 : 1; u.aux = half;
        u.aoff = abase + (unsigned)u.pm * 256u * 4096u + (unsigned)half * 2048u; u.boff = bbase + (unsigned)u.pn * 256u * 4096u + (unsigned)half * (16u * 32768u); return true;
    }
    __device__ __forceinline__ void aoffs(const g8::Unit&, int R0, int C0, int R1, int C1, unsigned (&v)[2][2]) const {
        v[0][0] = (unsigned)(R0 * 2048 + C0) * 2u; v[0][1] = (unsigned)(R1 * 2048 + C1) * 2u;
        v[1][0] = (unsigned)((128 + R0) * 2048 + C0) * 2u; v[1][1] = (unsigned)((128 + R1) * 2048 + C1) * 2u;
    }
};
struct EpiOut {
    static constexpr bool PERM = true;
    const float* x; const float* mod; const float* rowss1; float* rowss2; bf16_t* X1;
    __device__ __forceinline__ void operator()(g8::Acc& acc, const g8::Unit& u, int wr, int wc, int fr, int fq) const {
        const int row0 = u.pm * 256 + wr * 64 + fr;
        if (u.aux == 0) {
#pragma unroll
            for (int ai = 0; ai < 2; ++ai)
#pragma unroll
                for (int m = 0; m < 4; ++m) { const f32x4* pp = (const f32x4*)(rowss1 + (size_t)(row0 + ai * 128 + m * 16) * 16);
                    const f32x4 p0 = pp[0], p1 = pp[1], p2 = pp[2], p3 = pp[3];
                    const float tot = (((p0[0] + p0[1]) + (p0[2] + p0[3])) + ((p1[0] + p1[1]) + (p1[2] + p1[3]))) + (((p2[0] + p2[1]) + (p2[2] + p2[3])) + ((p3[0] + p3[1]) + (p3[2] + p3[3])));
                    const float r = rsqrtf(tot * (1.0f / 1024.0f) + 1e-6f);
#pragma unroll
                    for (int bj = 0; bj < 2; ++bj)
#pragma unroll
                        for (int n = 0; n < 2; ++n) acc[ai][bj][m][n] *= r; }
            return;
        }
        const int col0 = u.pn * 256 + wc * 32 + 8 * fq;
        const int b = (u.pm * 256) >> 11;
        f32x4 gt[2][2];
#pragma unroll
        for (int bj = 0; bj < 2; ++bj)
#pragma unroll
            for (int n = 0; n < 2; ++n) gt[bj][n] = *(const f32x4*)(mod + (size_t)b * NMOD + 2 * DM + col0 + bj * 128 + n * 4);
#pragma unroll
        for (int am = 0; am < 4; ++am) {
            const int ai = am >> 1, m0 = (am & 1) * 2;
            f32x4 xv[2][2][2];
#pragma unroll
            for (int mm = 0; mm < 2; ++mm)
#pragma unroll
                for (int bj = 0; bj < 2; ++bj) { const size_t off = (size_t)(row0 + ai * 128 + (m0 + mm) * 16) * DM + col0 + bj * 128; xv[mm][bj][0] = *(const f32x4*)(x + off); xv[mm][bj][1] = *(const f32x4*)(x + off + 4); }
#pragma unroll
            for (int mm = 0; mm < 2; ++mm) { const int m = m0 + mm; const int row = row0 + ai * 128 + m * 16; float ss = 0.f;
#pragma unroll
                for (int bj = 0; bj < 2; ++bj) { const size_t off = (size_t)row * DM + col0 + bj * 128;
                    const f32x4 o0 = xv[mm][bj][0] + gt[bj][0] * acc[ai][bj][m][0], o1 = xv[mm][bj][1] + gt[bj][1] * acc[ai][bj][m][1];
                    ss += (o0[0] * o0[0] + o0[1] * o0[1]) + (o0[2] * o0[2] + o0[3] * o0[3]) + (o1[0] * o1[0] + o1[1] * o1[1]) + (o1[2] * o1[2] + o1[3] * o1[3]);
                    u32x4 w; w.x = cvt_pk_bf16(o0[0], o0[1]); w.y = cvt_pk_bf16(o0[2], o0[3]); w.z = cvt_pk_bf16(o1[0], o1[1]); w.w = cvt_pk_bf16(o1[2], o1[3]);
                    *(u32x4*)(X1 + off) = w; }
                ss += __shfl_xor(ss, 16); ss += __shfl_xor(ss, 32);
                if (fq == 0) rowss2[(size_t)row * 32 + u.pn * 4 + wc] = ss; }
        }
    }
};
struct MoeSched {
    const LAS int* tinfo; const LAS int* trows; int ntiles; int G, c; const int* list; unsigned abase, bbase; int mode;
    __device__ __forceinline__ bool next(int i, g8::Unit& u) const {
        int pn, ti;
        if ((G & 63) == 0) { const int x = c & 7, r = c >> 3, per = G >> 6;
            ti = (i * 8 + x) * per + (r >> 3); pn = r & 7; }
        else { const int L = i * G + c; pn = L & 7; ti = L >> 3; }
        if (ti >= ntiles) return false;
        const int inf = __builtin_amdgcn_readfirstlane(tinfo[ti]);
        const int e = inf & 255;
        u.pm = __builtin_amdgcn_readfirstlane(ti); u.pn = pn; u.flags = 0; u.aux = inf; u.aux2 = __builtin_amdgcn_readfirstlane(trows[ti]);
        if (mode == 0) { u.aoff = abase; u.boff = bbase + (unsigned)e * (2048u * 2048u) + (unsigned)pn * (256u * 2048u); }
        else { u.aoff = abase + (unsigned)ti * (256u * 1024u); u.boff = bbase + (unsigned)e * (2048u * 1024u) + (unsigned)pn * (256u * 1024u); }
        return true;
    }
    __device__ __forceinline__ void aoffs(const g8::Unit& u, int R0, int C0, int R1, int C1, unsigned (&v)[2][2]) const {
        if (mode == 0) {
            const int e = u.aux & 255, r0 = u.aux >> 8, n = u.aux2; const int* le = list + e * 16384 + r0;
            const int i00 = R0, i01 = R1, i10 = 128 + R0, i11 = 128 + R1;
            const int t00 = (i00 < n) ? (le[i00] >> 1) : 0, t01 = (i01 < n) ? (le[i01] >> 1) : 0, t10 = (i10 < n) ? (le[i10] >> 1) : 0, t11 = (i11 < n) ? (le[i11] >> 1) : 0;
            v[0][0] = (unsigned)(t00 * 2048 + C0 * 2); v[0][1] = (unsigned)(t01 * 2048 + C1 * 2); v[1][0] = (unsigned)(t10 * 2048 + C0 * 2); v[1][1] = (unsigned)(t11 * 2048 + C1 * 2);
        } else {
            v[0][0] = (unsigned)(R0 * 1024 + C0 * 2); v[0][1] = (unsigned)(R1 * 1024 + C1 * 2);
            v[1][0] = (unsigned)((128 + R0) * 1024 + C0 * 2); v[1][1] = (unsigned)((128 + R1) * 1024 + C1 * 2);
        }
    }
};
struct EpiMoe1 {
    static constexpr bool PERM = true;
    unsigned char* HM;
    __device__ __forceinline__ void operator()(g8::Acc& acc, const g8::Unit& u, int wr, int wc, int fr, int fq) const {
        const int row0 = u.pm * 256 + wr * 64 + fr, col0 = u.pn * 128 + wc * 32 + 8 * fq;
        const float inv = 1.0f / WGU_SCALE;
#pragma unroll
        for (int ai = 0; ai < 2; ++ai)
#pragma unroll
            for (int m = 0; m < 4; ++m) { float o[8];
#pragma unroll
                for (int n = 0; n < 2; ++n)
#pragma unroll
                    for (int j = 0; j < 4; ++j) { const float gv = acc[ai][0][m][n][j] * inv, uv = acc[ai][1][m][n][j] * inv; o[n * 4 + j] = gv * sigmoidf_(gv) * uv; }
                int q0 = 0, q1 = 0;
                q0 = __builtin_amdgcn_cvt_pk_fp8_f32(o[0], o[1], q0, false); q0 = __builtin_amdgcn_cvt_pk_fp8_f32(o[2], o[3], q0, true);
                q1 = __builtin_amdgcn_cvt_pk_fp8_f32(o[4], o[5], q1, false); q1 = __builtin_amdgcn_cvt_pk_fp8_f32(o[6], o[7], q1, true);
                *(u32x2*)(HM + (size_t)(row0 + ai * 128 + m * 16) * 1024 + col0) = (u32x2){(unsigned)q0, (unsigned)q1}; }
    }
};
struct EpiMoe2 {
    static constexpr bool PERM = true;
    const int* list; const float* wgt; bf16_t* Y2;
    __device__ __forceinline__ void operator()(g8::Acc& acc, const g8::Unit& u, int wr, int wc, int fr, int fq) const {
        const int e = u.aux & 255, r0 = u.aux >> 8, n = u.aux2; const int* le = list + e * 16384 + r0;
        const int col0 = u.pn * 256 + wc * 32 + 8 * fq;
        int asg[2][4]; float w8[2][4];
#pragma unroll
        for (int ai = 0; ai < 2; ++ai)
#pragma unroll
            for (int m = 0; m < 4; ++m) { const int r = ai * 128 + wr * 64 + m * 16 + fr; asg[ai][m] = (r < n) ? le[r] : -1; }
#pragma unroll
        for (int ai = 0; ai < 2; ++ai)
#pragma unroll
            for (int m = 0; m < 4; ++m) w8[ai][m] = (asg[ai][m] >= 0) ? wgt[asg[ai][m]] * (1.0f / WD_SCALE) : 0.f;
#pragma unroll
        for (int ai = 0; ai < 2; ++ai)
#pragma unroll
            for (int m = 0; m < 4; ++m) {
                if (asg[ai][m] >= 0) { bf16_t* rowp = Y2 + (size_t)asg[ai][m] * DM + col0; const float ww = w8[ai][m];
#pragma unroll
                    for (int bj = 0; bj < 2; ++bj) { const f32x4 v0 = acc[ai][bj][m][0] * ww, v1 = acc[ai][bj][m][1] * ww;
                        u32x4 w; w.x = cvt_pk_bf16(v0[0], v0[1]); w.y = cvt_pk_bf16(v0[2], v0[3]); w.z = cvt_pk_bf16(v1[0], v1[1]); w.w = cvt_pk_bf16(v1[2], v1[3]);
                        *(u32x4*)(rowp + bj * 128) = w; } } }
    }
};

constexpr size_t WS_KV = WS_H;
__device__ __forceinline__ void ssm_item(const Params& P, LAS unsigned char* lds, int tid, int item) {
    const int g = item >> 2, bp = item & 3;
    const int wave = __builtin_amdgcn_readfirstlane(tid >> 6), lane = tid & 63, fr = lane & 15, fq = lane >> 4;
    const bf16_t* proj = (const bf16_t*)(P.ws + WS_PROJ);
    const bf16_t* Ms = (const bf16_t*)(P.ws + WS_SSMM) + (size_t)g * 131072;
    const bf16_t* TM = Ms + 32768;
    bf16_t* Zo = (bf16_t*)(P.ws + WS_Z);
    constexpr int ZS = 136, MS = 264, TS = 392;
    LAS bf16_t* ZB = (LAS bf16_t*)lds;
    LAS bf16_t* WB = (LAS bf16_t*)(lds + 256 * ZS * 2);
    const int b = 2 * bp + (wave >> 2);
    int tok0[2];
    bf16x8 Uf[2][8];
#pragma unroll
    for (int mt = 0; mt < 2; ++mt) {
        const int c = 32 * (wave & 3) + 16 * mt + fr; tok0[mt] = b * 2048 + c * 16;
#pragma unroll
        for (int ks = 0; ks < 8; ++ks) Uf[mt][ks] = *(const bf16x8*)(proj + (size_t)(tok0[mt] + 2 * ks + (fq >> 1)) * NPROJ + g * 16 + 8 * (fq & 1));
    }
#pragma unroll
    for (int i = 0; i < 8; ++i) { const int row = tid >> 2, kc = (tid & 3) + 4 * i; *(LAS u32x4*)(WB + row * MS + kc * 8) = *(const u32x4*)(Ms + row * 256 + kc * 8); }
    __syncthreads();
#pragma unroll
    for (int nt = 0; nt < 8; ++nt) {
        f32x4 a0 = {0.f, 0.f, 0.f, 0.f}, a1 = {0.f, 0.f, 0.f, 0.f};
#pragma unroll
        for (int ks = 0; ks < 8; ++ks) {
            const bf16x8 bf = *(const LAS bf16x8*)(WB + (16 * nt + fr) * MS + 32 * ks + 8 * fq);
            a0 = __builtin_amdgcn_mfma_f32_16x16x32_bf16(bf, Uf[0][ks], a0, 0, 0, 0);
            a1 = __builtin_amdgcn_mfma_f32_16x16x32_bf16(bf, Uf[1][ks], a1, 0, 0, 0);
        }
        *(LAS u32x2*)(ZB + (32 * wave + fr) * ZS + 16 * nt + 4 * fq) = (u32x2){cvt_pk_bf16(a0[0], a0[1]), cvt_pk_bf16(a0[2], a0[3])};
        *(LAS u32x2*)(ZB + (32 * wave + 16 + fr) * ZS + 16 * nt + 4 * fq) = (u32x2){cvt_pk_bf16(a1[0], a1[1]), cvt_pk_bf16(a1[2], a1[3])};
    }
    u32x4 tmr[6];
#pragma unroll
    for (int i = 0; i < 6; ++i) { const int row = tid >> 3, kc = (tid & 7) + 8 * i; tmr[i] = *(const u32x4*)(TM + (size_t)row * 384 + kc * 8); }
    __syncthreads();
    if (tid < 128) {
        const int bl = tid >> 6, p = tid & 63;
        const f32x2 al = ((const f32x2*)(P.ws + WS_SSMA))[g * 64 + p];
        float xr = 0.f, xi = 0.f;
        LAS unsigned* zw = (LAS unsigned*)ZB + (bl * 128) * (ZS / 2) + p;
        for (int c0 = 0; c0 < 128; c0 += 8) {
            unsigned zv[8];
#pragma unroll
            for (int k = 0; k < 8; ++k) zv[k] = zw[(c0 + k) * (ZS / 2)];
#pragma unroll
            for (int k = 0; k < 8; ++k) {
                zw[(c0 + k) * (ZS / 2)] = cvt_pk_bf16(xr, xi);
                const float t = al.x * xr - al.y * xi + bf_lo(zv[k]); xi = al.x * xi + al.y * xr + bf_hi(zv[k]); xr = t;
            }
        }
    }
#pragma unroll
    for (int i = 0; i < 6; ++i) { const int row = tid >> 3, kc = (tid & 7) + 8 * i; *(LAS u32x4*)(WB + row * TS + kc * 8) = tmr[i]; }
    __syncthreads();
    const LAS bf16_t* xrow = ZB + (32 * wave + fr) * ZS + 8 * fq;
    const f32x4 dv = *(const f32x4*)(P.in[12] + g * 16 + 4 * fq);
#pragma unroll
    for (int cq = 0; cq < 4; ++cq) {
        u32x2 uu[4][2];
#pragma unroll
        for (int ntl = 0; ntl < 4; ++ntl)
#pragma unroll
            for (int mt = 0; mt < 2; ++mt) uu[ntl][mt] = *(const u32x2*)(proj + (size_t)(tok0[mt] + 4 * cq + ntl) * NPROJ + g * 16 + 4 * fq);
        if (cq < 3) {
#pragma unroll
            for (int i = 0; i < 6; ++i) { const int row = tid >> 3, kc = (tid & 7) + 8 * i; tmr[i] = *(const u32x4*)(TM + (size_t)(64 * (cq + 1) + row) * 384 + kc * 8); }
        }
#pragma unroll
        for (int ntl = 0; ntl < 4; ++ntl) {
            const int nt = 4 * cq + ntl;
            f32x4 a0 = {0.f, 0.f, 0.f, 0.f}, a1 = {0.f, 0.f, 0.f, 0.f};
            const LAS bf16_t* brow = WB + (16 * ntl + fr) * TS + 8 * fq;
#pragma unroll
            for (int ks = 0; ks < 8; ++ks) {
                if (2 * ks <= nt) {
                    const bf16x8 bf = *(const LAS bf16x8*)(brow + 32 * ks);
                    a0 = __builtin_amdgcn_mfma_f32_16x16x32_bf16(bf, Uf[0][ks], a0, 0, 0, 0);
                    a1 = __builtin_amdgcn_mfma_f32_16x16x32_bf16(bf, Uf[1][ks], a1, 0, 0, 0);
                }
            }
#pragma unroll
            for (int k2 = 0; k2 < 4; ++k2) {
                const bf16x8 bf = *(const LAS bf16x8*)(brow + 256 + 32 * k2);
                const bf16x8 x0 = *(const LAS bf16x8*)(xrow + 32 * k2), x1 = *(const LAS bf16x8*)(xrow + 16 * ZS + 32 * k2);
                a0 = __builtin_amdgcn_mfma_f32_16x16x32_bf16(bf, x0, a0, 0, 0, 0);
                a1 = __builtin_amdgcn_mfma_f32_16x16x32_bf16(bf, x1, a1, 0, 0, 0);
            }
#pragma unroll
            for (int mt = 0; mt < 2; ++mt) {
                const f32x4 a = mt ? a1 : a0;
                const size_t tok = (size_t)(tok0[mt] + nt);
                const u32x2 u2 = uu[ntl][mt];
                const float y0 = a[0] + dv[0] * bf_lo(u2.x), y1 = a[1] + dv[1] * bf_hi(u2.x), y2 = a[2] + dv[2] * bf_lo(u2.y), y3 = a[3] + dv[3] * bf_hi(u2.y);
                u32x2 w; w.x = cvt_pk_bf16(gelu_tanh(y0), gelu_tanh(y1)); w.y = cvt_pk_bf16(gelu_tanh(y2), gelu_tanh(y3));
                *(u32x2*)(Zo + tok * 1024 + g * 16 + 4 * fq) = w;
            }
        }
        __syncthreads();
        if (cq < 3) {
#pragma unroll
            for (int i = 0; i < 6; ++i) { const int row = tid >> 3, kc = (tid & 7) + 8 * i; *(LAS u32x4*)(WB + row * TS + kc * 8) = tmr[i]; }
            __syncthreads();
        }
    }
}

__device__ __forceinline__ bf16x8 tr_frag(const LAS bf16_t* tile, int row0, int col0, int fr, int fq) {
    const LAS bf16_t* p = tile + (row0 + 8 * fq + (fr >> 2)) * 136 + col0 + 4 * (fr & 3);
    const bf16x4 a = __builtin_amdgcn_ds_read_tr16_b64_v4i16((LAS bf16x4*)p);
    const bf16x4 b = __builtin_amdgcn_ds_read_tr16_b64_v4i16((LAS bf16x4*)(p + 4 * 136));
    bf16x8 r; r[0] = a[0]; r[1] = a[1]; r[2] = a[2]; r[3] = a[3]; r[4] = b[0]; r[5] = b[1]; r[6] = b[2]; r[7] = b[3]; return r;
}
__device__ __forceinline__ void ret_kv_items(const Params& P, LAS unsigned char* lds, int tid, int first, int stride) {
    const int wave = __builtin_amdgcn_readfirstlane(tid >> 6), lane = tid & 63, fr = lane & 15, fq = lane >> 4;
    constexpr int RS = 136;
    LAS bf16_t* Ks = (LAS bf16_t*)lds; LAS bf16_t* Vs = Ks + 128 * RS;
    const bf16_t* proj = (const bf16_t*)(P.ws + WS_PROJ);
    bf16_t* KV = (bf16_t*)(P.ws + WS_KV);
    const int si = tid >> 2, part = tid & 3, i0 = 16 * wave;
    u32x4 kr[4], vr[4];
    int item = first;
    if (item >= 768) return;
    { const int bh = item / 12, n = item % 12; const bf16_t* pr = proj + ((size_t)(bh >> 3) * 2048 + n * 128 + si) * NPROJ + (bh & 7) * 128 + 32 * part;
#pragma unroll
      for (int j = 0; j < 4; ++j) { kr[j] = *(const u32x4*)(pr + 2048 + 8 * j); vr[j] = *(const u32x4*)(pr + 3072 + 8 * j); } }
    for (;;) {
#pragma unroll
        for (int j = 0; j < 4; ++j) { *(LAS u32x4*)(Ks + si * RS + 32 * part + 8 * j) = kr[j]; *(LAS u32x4*)(Vs + si * RS + 32 * part + 8 * j) = vr[j]; }
        __syncthreads();
        const int nxt = item + stride; const bool more = nxt < 768;
        if (more) { const int bh = nxt / 12, n = nxt % 12; const bf16_t* pr = proj + ((size_t)(bh >> 3) * 2048 + n * 128 + si) * NPROJ + (bh & 7) * 128 + 32 * part;
#pragma unroll
            for (int j = 0; j < 4; ++j) { kr[j] = *(const u32x4*)(pr + 2048 + 8 * j); vr[j] = *(const u32x4*)(pr + 3072 + 8 * j); } }
        bf16x8 Vt[4];
#pragma unroll
        for (int ks = 0; ks < 4; ++ks) Vt[ks] = tr_frag(Vs, 32 * ks, i0, fr, fq);
        const int bh = item / 12, n = item % 12;
        bf16_t* op = KV + ((size_t)(bh * 16 + n) * 128 + i0 + fr) * 128 + 4 * fq;
#pragma unroll
        for (int nt = 0; nt < 8; ++nt) {
            f32x4 a = {0.f, 0.f, 0.f, 0.f};
#pragma unroll
            for (int ks = 0; ks < 4; ++ks) { const bf16x8 kf = tr_frag(Ks, 32 * ks, 16 * nt, fr, fq); a = __builtin_amdgcn_mfma_f32_16x16x32_bf16(kf, Vt[ks], a, 0, 0, 0); }
            *(u32x2*)(op + 16 * nt) = (u32x2){cvt_pk_bf16(a[0], a[1]), cvt_pk_bf16(a[2], a[3])};
        }
        __syncthreads();
        if (!more) break;
        item = nxt;
    }
}
__device__ __forceinline__ void ret_out_item(const Params& P, LAS unsigned char* lds, int tid, int item) {
    const int bh = item >> 2, q = item & 3, b = bh >> 3, h = bh & 7;
    const int wave = __builtin_amdgcn_readfirstlane(tid >> 6), lane = tid & 63, fr = lane & 15, fq = lane >> 4;
    constexpr int RS = 136;
    LAS bf16_t* Qs = (LAS bf16_t*)lds;
    LAS bf16_t* Ks = Qs + 128 * RS;
    LAS bf16_t* Vs = Ks + 128 * RS;
    LAS bf16_t* Rs = Vs + 128 * RS;
    const bf16_t* proj = (const bf16_t*)(P.ws + WS_PROJ);
    const bf16_t* KV = (const bf16_t*)(P.ws + WS_KV);
    bf16_t* CAT = (bf16_t*)(P.ws + WS_CAT);
    const float gam = 1.0f - exp2f(-5.0f - (float)h);
    const float lg2 = log2f(gam);
    const float gC1 = exp2f(lg2 * 127.0f), gC = exp2f(lg2 * 128.0f);
    const int si = tid >> 2, part = tid & 3, i0 = 16 * wave;
    u32x4 st[12];
    { const bf16_t* pr = proj + ((size_t)b * 2048 + (4 * q) * 128 + si) * NPROJ + h * 128 + 32 * part;
#pragma unroll
      for (int j = 0; j < 4; ++j) { st[j] = *(const u32x4*)(pr + 1024 + 8 * j); st[4 + j] = *(const u32x4*)(pr + 2048 + 8 * j); st[8 + j] = *(const u32x4*)(pr + 3072 + 8 * j); } }
    f32x4 accR[8];
#pragma unroll
    for (int nt = 0; nt < 8; ++nt) accR[nt] = (f32x4){0.f, 0.f, 0.f, 0.f};
    for (int m = 0; m < 4 * q; ++m) {
        const bf16_t* tp = KV + ((size_t)(bh * 16 + m) * 128 + i0 + fr) * 128 + 4 * fq;
        u32x2 t[8];
#pragma unroll
        for (int nt = 0; nt < 8; ++nt) t[nt] = *(const u32x2*)(tp + 16 * nt);
#pragma unroll
        for (int nt = 0; nt < 8; ++nt) { const f32x4 kv = {bf_lo(t[nt].x), bf_hi(t[nt].x), bf_lo(t[nt].y), bf_hi(t[nt].y)}; accR[nt] = accR[nt] * gC + kv * gC1; }
    }
#pragma unroll
    for (int nt = 0; nt < 8; ++nt)
        *(LAS u32x2*)(Rs + (i0 + fr) * RS + 16 * nt + 4 * fq) = (u32x2){cvt_pk_bf16(accR[nt][0], accR[nt][1]), cvt_pk_bf16(accR[nt][2], accR[nt][3])};
    for (int nn = 0; nn < 4; ++nn) {
        const int n = 4 * q + nn;
#pragma unroll
        for (int j = 0; j < 4; ++j) { *(LAS u32x4*)(Qs + si * RS + 32 * part + 8 * j) = st[j]; *(LAS u32x4*)(Ks + si * RS + 32 * part + 8 * j) = st[4 + j]; *(LAS u32x4*)(Vs + si * RS + 32 * part + 8 * j) = st[8 + j]; }
        __syncthreads();
        if (nn < 3) { const bf16_t* pr = proj + ((size_t)b * 2048 + (n + 1) * 128 + si) * NPROJ + h * 128 + 32 * part;
#pragma unroll
            for (int j = 0; j < 4; ++j) { st[j] = *(const u32x4*)(pr + 1024 + 8 * j); st[4 + j] = *(const u32x4*)(pr + 2048 + 8 * j); st[8 + j] = *(const u32x4*)(pr + 3072 + 8 * j); } }
        const size_t tok = (size_t)b * 2048 + n * 128 + i0 + fr;
        u32x2 gg[8];
        { const bf16_t* gp = proj + tok * NPROJ + 4096 + h * 128 + 4 * fq;
#pragma unroll
          for (int nt = 0; nt < 8; ++nt) gg[nt] = *(const u32x2*)(gp + 16 * nt); }
        bf16x8 Qf[4];
#pragma unroll
        for (int ks = 0; ks < 4; ++ks) Qf[ks] = *(const LAS bf16x8*)(Qs + (i0 + fr) * RS + 32 * ks + 8 * fq);
        f32x4 accS[8], accO[8];
#pragma unroll
        for (int nt = 0; nt < 8; ++nt) { accS[nt] = (f32x4){0.f, 0.f, 0.f, 0.f}; accO[nt] = (f32x4){0.f, 0.f, 0.f, 0.f}; }
#pragma unroll
        for (int nt = 0; nt < 8; ++nt) {
            if (nt <= wave) {
#pragma unroll
                for (int ks = 0; ks < 4; ++ks) { const bf16x8 kf = *(const LAS bf16x8*)(Ks + (16 * nt + fr) * RS + 32 * ks + 8 * fq); accS[nt] = __builtin_amdgcn_mfma_f32_16x16x32_bf16(kf, Qf[ks], accS[nt], 0, 0, 0); }
            }
        }
        if (n > 0) {
#pragma unroll
            for (int nt = 0; nt < 8; ++nt) {
#pragma unroll
                for (int ks = 0; ks < 4; ++ks) { const bf16x8 rf = *(const LAS bf16x8*)(Rs + (16 * nt + fr) * RS + 32 * ks + 8 * fq); accO[nt] = __builtin_amdgcn_mfma_f32_16x16x32_bf16(rf, Qf[ks], accO[nt], 0, 0, 0); }
                accO[nt] *= gam;
            }
        }
#pragma unroll
        for (int nt = 0; nt < 8; ++nt) {
            const int i = i0 + fr, j0 = 16 * nt + 4 * fq;
            const float p0 = (j0 <= i) ? accS[nt][0] : 0.f, p1 = (j0 + 1 <= i) ? accS[nt][1] : 0.f, p2 = (j0 + 2 <= i) ? accS[nt][2] : 0.f, p3 = (j0 + 3 <= i) ? accS[nt][3] : 0.f;
            *(LAS u32x2*)(Qs + i * RS + j0) = (u32x2){cvt_pk_bf16(p0, p1), cvt_pk_bf16(p2, p3)};
        }
        asm volatile("" ::: "memory");
        bf16x8 Pf[4];
#pragma unroll
        for (int ks = 0; ks < 4; ++ks) Pf[ks] = *(const LAS bf16x8*)(Qs + (i0 + fr) * RS + 32 * ks + 8 * fq);
#pragma unroll
        for (int ks = 0; ks < 4; ++ks) {
            if (2 * ks <= wave) {
#pragma unroll
                for (int nt = 0; nt < 8; ++nt) { const bf16x8 vf = tr_frag(Vs, 32 * ks, 16 * nt, fr, fq); accO[nt] = __builtin_amdgcn_mfma_f32_16x16x32_bf16(vf, Pf[ks], accO[nt], 0, 0, 0); }
            }
        }
        if (nn < 3) {
            bf16x8 Vt[4];
#pragma unroll
            for (int ks = 0; ks < 4; ++ks) Vt[ks] = tr_frag(Vs, 32 * ks, i0, fr, fq);
#pragma unroll
            for (int nt = 0; nt < 8; ++nt) {
                accR[nt] *= gam;
#pragma unroll
                for (int ks = 0; ks < 4; ++ks) { const bf16x8 kf = tr_frag(Ks, 32 * ks, 16 * nt, fr, fq); accR[nt] = __builtin_amdgcn_mfma_f32_16x16x32_bf16(kf, Vt[ks], accR[nt], 0, 0, 0); }
                accR[nt] *= gC1;
            }
        }
        {
            float s = 0.f;
#pragma unroll
            for (int nt = 0; nt < 8; ++nt) s += (accO[nt][0] + accO[nt][1]) + (accO[nt][2] + accO[nt][3]);
            s += __shfl_xor(s, 16); s += __shfl_xor(s, 32);
            const float mu = s * (1.0f / 128.0f); float qv = 0.f;
#pragma unroll
            for (int nt = 0; nt < 8; ++nt) { const f32x4 d = accO[nt] - mu; qv += (d[0] * d[0] + d[1] * d[1]) + (d[2] * d[2] + d[3] * d[3]); }
            qv += __shfl_xor(qv, 16); qv += __shfl_xor(qv, 32);
            const float rstd = rsqrtf(qv * (1.0f / 128.0f) + 1e-5f);
            bf16_t* op = CAT + tok * DM + 1024 + h * 128 + 4 * fq;
#pragma unroll
            for (int nt = 0; nt < 8; ++nt) {
                const float g0 = bf_lo(gg[nt].x), g1 = bf_hi(gg[nt].x), g2 = bf_lo(gg[nt].y), g3 = bf_hi(gg[nt].y);
                const f32x4 y = (accO[nt] - mu) * rstd;
                u32x2 w; w.x = cvt_pk_bf16(y[0] * g0 * sigmoidf_(g0), y[1] * g1 * sigmoidf_(g1)); w.y = cvt_pk_bf16(y[2] * g2 * sigmoidf_(g2), y[3] * g3 * sigmoidf_(g3));
                *(u32x2*)(op + 16 * nt) = w;
            }
        }
        __syncthreads();
        if (nn < 3) {
#pragma unroll
            for (int nt = 0; nt < 8; ++nt)
                *(LAS u32x2*)(Rs + (i0 + fr) * RS + 16 * nt + 4 * fq) = (u32x2){cvt_pk_bf16(accR[nt][0], accR[nt][1]), cvt_pk_bf16(accR[nt][2], accR[nt][3])};
        }
    }
}

__device__ __forceinline__ void p6_route(const Params& P, LAS unsigned char* lds, int tid, int blk, int G) {
    const int wave = __builtin_amdgcn_readfirstlane(tid >> 6), lane = tid & 63, fr = lane & 15, fq = lane >> 4;
    LAS float* gm = (LAS float*)lds; LAS float* sh = gm + 2048; LAS float* lg = sh + 2048;
    LAS int* lcnt = (LAS int*)(lg + 2 * 64 * 48); LAS int* lbase = lcnt + 32;
    int ra_ = 0, rb_ = 0, ea_ = 0, eb_ = 0; float w1_ = 0.f, w2_ = 0.f;
    const float* mod = (const float*)(P.ws + WS_MOD);
    const bf16_t* x1 = (const bf16_t*)(P.ws + WS_X1); const float* rowss2 = (const float*)(P.ws + WS_ROWSS2);
    unsigned char* H2 = P.ws + WS_H;
    const bf16_t* WR = (const bf16_t*)(P.ws + WS_WR);
    int* cnt = (int*)(P.ws + WS_CNT); int* list = (int*)(P.ws + WS_LIST); float* wgt = (float*)(P.ws + WS_WGT);
    for (int rb = blk; rb < 256; rb += G) {
        const int b = rb >> 5;
        for (int k = tid; k < 2048; k += NTHREADS) { gm[k] = P.in[18][k] * (1.0f + mod[(size_t)b * NMOD + 4 * DM + k]); sh[k] = mod[(size_t)b * NMOD + 3 * DM + k]; }
        if (tid < 32) lcnt[tid] = 0;
        __syncthreads();
        const int mt = wave & 3, kh = wave >> 2;
        const int row = rb * 64 + 16 * mt + fr;
        float tot2 = 0.f;
        { const f32x4* pp = (const f32x4*)(rowss2 + (size_t)row * 32);
#pragma unroll
          for (int i = 0; i < 8; ++i) { const f32x4 v = pp[i]; tot2 += (v[0] + v[1]) + (v[2] + v[3]); } }
        const float r2 = rsqrtf(tot2 * (1.0f / 2048.0f) + 1e-6f);
        f32x4 acc[3];
#pragma unroll
        for (int nt = 0; nt < 3; ++nt) acc[nt] = (f32x4){0.f, 0.f, 0.f, 0.f};
#pragma unroll 4
        for (int ks = 0; ks < 32; ++ks) {
            const int k0 = 1024 * kh + 32 * ks + 8 * fq;
            const u32x4 xw = *(const u32x4*)(x1 + (size_t)row * DM + k0);
            const f32x4 a = {bf_lo(xw.x), bf_hi(xw.x), bf_lo(xw.y), bf_hi(xw.y)}, c = {bf_lo(xw.z), bf_hi(xw.z), bf_lo(xw.w), bf_hi(xw.w)};
            const f32x4 g0 = *(const LAS f32x4*)(gm + k0), g1 = *(const LAS f32x4*)(gm + k0 + 4), s0 = *(const LAS f32x4*)(sh + k0), s1 = *(const LAS f32x4*)(sh + k0 + 4);
            const f32x4 h0 = a * r2 * g0 + s0, h1 = c * r2 * g1 + s1;
            u32x4 w; w.x = cvt_pk_bf16(h0[0], h0[1]); w.y = cvt_pk_bf16(h0[2], h0[3]); w.z = cvt_pk_bf16(h1[0], h1[1]); w.w = cvt_pk_bf16(h1[2], h1[3]);
            { int q0 = 0, q1 = 0;
              q0 = __builtin_amdgcn_cvt_pk_fp8_f32(h0[0], h0[1], q0, false); q0 = __builtin_amdgcn_cvt_pk_fp8_f32(h0[2], h0[3], q0, true);
              q1 = __builtin_amdgcn_cvt_pk_fp8_f32(h1[0], h1[1], q1, false); q1 = __builtin_amdgcn_cvt_pk_fp8_f32(h1[2], h1[3], q1, true);
              *(u32x2*)(H2 + (size_t)row * DM + k0) = (u32x2){(unsigned)q0, (unsigned)q1}; }
            const bf16x8 af = __builtin_bit_cast(bf16x8, w);
#pragma unroll
            for (int nt = 0; nt < 3; ++nt) { const bf16x8 bf = *(const bf16x8*)(WR + (size_t)(16 * nt + fr) * 2048 + k0); acc[nt] = __builtin_amdgcn_mfma_f32_16x16x32_bf16(bf, af, acc[nt], 0, 0, 0); }
        }
#pragma unroll
        for (int nt = 0; nt < 3; ++nt) *(LAS f32x4*)(lg + (kh * 64 + 16 * mt + fr) * 48 + 16 * nt + 4 * fq) = acc[nt];
        __syncthreads();
        if (tid < 64) {
            const int tok = rb * 64 + tid;
            float l[36];
#pragma unroll
            for (int nn = 0; nn < 36; ++nn) l[nn] = lg[tid * 48 + nn] + lg[(64 + tid) * 48 + nn];
            float gl[4]; int gs = 0;
#pragma unroll
            for (int j = 0; j < 4; ++j) gl[j] = l[j] + P.in[20][j];
#pragma unroll
            for (int j = 1; j < 4; ++j) if (gl[j] > gl[gs]) gs = j;
            float gmax = gl[0];
#pragma unroll
            for (int j = 1; j < 4; ++j) gmax = fmaxf(gmax, gl[j]);
            float den = 0.f;
#pragma unroll
            for (int j = 0; j < 4; ++j) den += expf(gl[j] - gmax);
            const float gw = 1.0f / den;
            float el[8];
#pragma unroll
            for (int j = 0; j < 8; ++j) { float v = 0.f;
#pragma unroll
                for (int q = 0; q < 4; ++q) v = (gs == q) ? (l[4 + q * 8 + j] + P.in[22][q * 8 + j]) : v;
                el[j] = v; }
            int j1 = 0;
#pragma unroll
            for (int j = 1; j < 8; ++j) if (el[j] > el[j1]) j1 = j;
            int j2 = (j1 == 0) ? 1 : 0;
#pragma unroll
            for (int j = 0; j < 8; ++j) if (j != j1 && j != j2 && el[j] > el[j2]) j2 = j;
            float e1 = el[0], e2 = el[0];
#pragma unroll
            for (int j = 0; j < 8; ++j) { e1 = (j == j1) ? el[j] : e1; e2 = (j == j2) ? el[j] : e2; }
            const float t2 = expf(e2 - e1), w1 = gw / (1.0f + t2), w2 = gw * t2 / (1.0f + t2);
            const int ea = gs * 8 + j1, eb = gs * 8 + j2;
            ra_ = atomicAdd((int*)&lcnt[ea], 1); rb_ = atomicAdd((int*)&lcnt[eb], 1); ea_ = ea; eb_ = eb; w1_ = w1; w2_ = w2;
        }
        __syncthreads();
        if (tid < 32) { const int c = lcnt[tid]; lbase[tid] = c > 0 ? atomicAdd(cnt + tid * 64, c) : 0; }
        __syncthreads();
        if (tid < 64) {
            const int tok = rb * 64 + tid;
            list[ea_ * 16384 + lbase[ea_] + ra_] = tok * 2; wgt[tok * 2] = w1_;
            list[eb_ * 16384 + lbase[eb_] + rb_] = tok * 2 + 1; wgt[tok * 2 + 1] = w2_;
        }
        __syncthreads();
    }
}

__device__ __forceinline__ void p9_final(const Params& P, int tid, int blk, int G) {
    const int wave = tid >> 6, lane = tid & 63;
    const float* mod = (const float*)(P.ws + WS_MOD); const bf16_t* Y2 = (const bf16_t*)(P.ws + WS_Y2); const bf16_t* X1 = (const bf16_t*)(P.ws + WS_X1);
    f32x4 gf[8];
#pragma unroll
    for (int i = 0; i < 8; ++i) gf[i] = *(const f32x4*)(P.in[26] + (i * 64 + lane) * 4);
    int row = blk * 8 + wave;
    u32x2 xw[8], ya[8], yb[8], xwn[8], yan[8], ybn[8];
    if (row < NTOK) {
#pragma unroll
        for (int i = 0; i < 8; ++i) { const int k = (i * 64 + lane) * 4; xw[i] = *(const u32x2*)(X1 + (size_t)row * DM + k); ya[i] = *(const u32x2*)(Y2 + (size_t)(2 * row) * DM + k); yb[i] = *(const u32x2*)(Y2 + (size_t)(2 * row + 1) * DM + k); }
    }
    for (; row < NTOK; row += G * 8) {
        const int b = row >> 11, rown = row + G * 8;
        if (rown < NTOK) {
#pragma unroll
            for (int i = 0; i < 8; ++i) { const int k = (i * 64 + lane) * 4; xwn[i] = *(const u32x2*)(X1 + (size_t)rown * DM + k); yan[i] = *(const u32x2*)(Y2 + (size_t)(2 * rown) * DM + k); ybn[i] = *(const u32x2*)(Y2 + (size_t)(2 * rown + 1) * DM + k); }
        }
        f32x4 v[8]; float ss = 0.f;
#pragma unroll
        for (int i = 0; i < 8; ++i) {
            const int k = (i * 64 + lane) * 4;
            const f32x4 xv = {bf_lo(xw[i].x), bf_hi(xw[i].x), bf_lo(xw[i].y), bf_hi(xw[i].y)};
            const f32x4 gt = *(const f32x4*)(mod + (size_t)b * NMOD + 5 * DM + k);
            f32x4 y; y[0] = bf_lo(ya[i].x) + bf_lo(yb[i].x); y[1] = bf_hi(ya[i].x) + bf_hi(yb[i].x); y[2] = bf_lo(ya[i].y) + bf_lo(yb[i].y); y[3] = bf_hi(ya[i].y) + bf_hi(yb[i].y);
            v[i] = xv + gt * y;
            ss += v[i][0] * v[i][0] + v[i][1] * v[i][1] + v[i][2] * v[i][2] + v[i][3] * v[i][3];
        }
        ss = wave_sum(ss);
        const float r = rsqrtf(ss * (1.0f / 2048.0f) + 1e-6f);
        float* xr = P.out + (size_t)row * DM;
#pragma unroll
        for (int i = 0; i < 8; ++i) { const int k = (i * 64 + lane) * 4; *(f32x4*)(xr + k) = v[i] * r * gf[i]; }
#pragma unroll
        for (int i = 0; i < 8; ++i) { xw[i] = xwn[i]; ya[i] = yan[i]; yb[i] = ybn[i]; }
    }
}

__global__ void __launch_bounds__(NTHREADS, 2) hymba_fwd(Params P) {
    extern __shared__ __attribute__((aligned(16))) unsigned char lds_raw[];
    LAS unsigned char* lds = (LAS unsigned char*)lds_raw;
    const int tid = threadIdx.x, blk = blockIdx.x, G = gridDim.x;
    volatile LAS unsigned* misc = (volatile LAS unsigned*)(lds + LDS_MISC);
    if (tid < 64) misc[tid] = 0u;
    __syncthreads();
    XcdBarrier bar = xcd_barrier_post((unsigned*)(P.ws + WS_BAR), misc);
    const int lo = P.ph_lo, hi = P.ph_hi;
#define IN(k) (lo <= (k) && (k) < hi)
#define SEAM(k) do { if (IN(k) && IN((k) + 1)) xcd_barrier(bar); } while (0)
    unsigned char* ws = P.ws;

#ifndef REPR
#define REPR 1
#endif
#ifndef REPS
#define REPS 1
#endif
#ifndef REP0
#define REP0 1
#endif
#ifndef REP2
#define REP2 1
#endif
#ifndef REP7
#define REP7 1
#endif
#ifndef REP8
#define REP8 1
#endif
    if (IN(0)) for (int rep0 = 0; rep0 < REP0; ++rep0) {
        for (int it = blk; it < 256; it += G) p0_adaln(P, lds, tid, it);
        for (int it = blk; it < 256; it += G) p0_ssm_mats(P, lds, tid, it);
        p0_misc(P, tid, blk, G);
        p0_convert(P, lds, tid, blk, G);
        p0_convert_fp8(P, lds, tid, blk, G, 0, 12288);
    }
    SEAM(0);
    if (IN(1)) p1_norm1(P, lds, tid, blk, G);
    SEAM(1);
    if (IN(2)) for (int rep2 = 0; rep2 < REP2; ++rep2) {
        DenseSched S; S.init(NTOK, NPROJ, G, blk); S.abase = (unsigned)WS_H; S.bbase = (unsigned)WS_WIN; S.lda = DM; S.ldb = DM;
        EpiInProj E{(bf16_t*)(ws + WS_PROJ)};
        g8::gemm_phase(lds, ws, DM / 64, DM, S, E);
    }
    SEAM(2);
    if (IN(3)) {
        for (int it = blk; it < 256; it += G) ssm_item(P, lds, tid, it);
        ret_kv_items(P, lds, tid, blk, G);
    }
    SEAM(3);
    if (IN(4)) {
        for (int it = blk; it < 256; it += G) ret_out_item(P, lds, tid, it);
        __syncthreads();
        DenseSched S; S.init(NTOK, 1024, G, blk); S.abase = (unsigned)WS_Z; S.bbase = (unsigned)WS_WGLU; S.lda = 1024; S.ldb = 1024;
        EpiGlu E{(const bf16_t*)(ws + WS_Z), (bf16_t*)(ws + WS_CAT), (float*)(ws + WS_ROWSS1)};
        g8::gemm_phase(lds, ws, 1024 / 64, 1024, S, E);
    }
    SEAM(4);
    if (IN(5)) {
        OutSched S; S.init(NTOK, DM, G, blk); S.abase = (unsigned)WS_CAT; S.bbase = (unsigned)WS_WOUT;
        EpiOut E{P.in[0], (const float*)(ws + WS_MOD), (const float*)(ws + WS_ROWSS1), (float*)(ws + WS_ROWSS2), (bf16_t*)(ws + WS_X1)};
        g8::gemm_phase(lds, ws, 1024 / 64, DM, S, E);
    }
    SEAM(5);
    if (IN(6)) p6_route(P, lds, tid, blk, G);
    SEAM(6);
    if (IN(7) || IN(8)) {
        LAS int* tinfo = (LAS int*)(lds + LDS_MISC + 256); LAS int* trows = tinfo + 192; LAS int* ntl = trows + 192;
        if (tid == 0) {
            const int* cg = (const int*)(ws + WS_CNT); int nt_ = 0;
            for (int e = 0; e < 32; ++e) { const int c = cg[e * 64], full = c >> 8, rem = c & 255;
                for (int t = 0; t < full; ++t) { tinfo[nt_] = e | ((t * 256) << 8); trows[nt_] = 256; ++nt_; }
                if (rem > 128) { tinfo[nt_] = e | ((full * 256) << 8); trows[nt_] = rem; ++nt_; } }
            for (int e = 0; e < 32; ++e) { const int c = cg[e * 64], full = c >> 8, rem = c & 255; if (rem > 64 && rem <= 128) { tinfo[nt_] = e | ((full * 256) << 8); trows[nt_] = rem; ++nt_; } }
            for (int e = 0; e < 32; ++e) { const int c = cg[e * 64], full = c >> 8, rem = c & 255; if (rem > 0 && rem <= 64) { tinfo[nt_] = e | ((full * 256) << 8); trows[nt_] = rem; ++nt_; } }
            ntl[0] = nt_;
        }
        __syncthreads();
        const int ntiles = __builtin_amdgcn_readfirstlane(ntl[0]);
        if (IN(7)) {
            MoeSched S{tinfo, trows, ntiles, G, blk, (const int*)(ws + WS_LIST), (unsigned)WS_H, (unsigned)WS_WGU, 0};
            EpiMoe1 E{ws + WS_HM};
            g8::gemm_phase<EpiMoe1, MoeSched, true, true>(lds, ws, DM / 128, DM, S, E);
        }
        SEAM(7);
        if (IN(8)) {
            MoeSched S{tinfo, trows, ntiles, G, blk, (const int*)(ws + WS_LIST), (unsigned)WS_HM, (unsigned)WS_WD, 1};
            EpiMoe2 E{(const int*)(ws + WS_LIST), (const float*)(ws + WS_WGT), (bf16_t*)(ws + WS_Y2)};
            g8::gemm_phase<EpiMoe2, MoeSched, true, true>(lds, ws, DEXP / 128, DEXP, S, E);
        }
    }
    SEAM(8);
    if (IN(9)) p9_final(P, tid, blk, G);
#undef IN
#undef SEAM
}

#ifndef N_LAUNCH_SPLIT
#define N_LAUNCH_SPLIT 0
#endif
extern "C" void kernel_launch(void* const* d_in, const int* in_sizes, int n_in, void* d_out, int out_size, void* d_ws, size_t ws_size, hipStream_t stream) {
    static int grid = 0;
    if (grid == 0) {
        if (n_in != 27 || out_size != NTOK * DM || ws_size < WS_END) { fprintf(stderr, "kernel_launch: unexpected shapes (n_in %d out %d ws %zu need %zu)\n", n_in, out_size, ws_size, (size_t)WS_END); grid = -1; return; }
        int dev = 0, cus = 0, per_cu = 0;
        if (hipGetDevice(&dev) != hipSuccess || hipDeviceGetAttribute(&cus, hipDeviceAttributeMultiprocessorCount, dev) != hipSuccess) { grid = -1; return; }
        if (hipFuncSetAttribute((const void*)hymba_fwd, hipFuncAttributeMaxDynamicSharedMemorySize, LDS_BYTES) != hipSuccess) { fprintf(stderr, "kernel_launch: hipFuncSetAttribute failed\n"); grid = -1; return; }
        if (hipOccupancyMaxActiveBlocksPerMultiprocessor(&per_cu, (const void*)hymba_fwd, NTHREADS, LDS_BYTES) != hipSuccess || per_cu < 1) { fprintf(stderr, "kernel_launch: occupancy query says %d\n", per_cu); }
        (void)hipGetLastError();
        grid = cus;
    }
    if (grid < 0) return;
    (void)hipMemsetAsync((char*)d_ws + WS_BAR, 0, 16384, stream);
    Params p{};
    for (int i = 0; i < 27; ++i) p.in[i] = (const float*)d_in[i];
    p.out = (float*)d_out; p.ws = (unsigned char*)d_ws;
#if N_LAUNCH_SPLIT
    for (int ph = 0; ph < 10; ++ph) { p.ph_lo = ph; p.ph_hi = ph + 1; hipLaunchKernelGGL(hymba_fwd, dim3(grid), dim3(NTHREADS), LDS_BYTES, stream, p); }
#else
    p.ph_lo = 0; p.ph_hi = 10;
    hipLaunchKernelGGL(hymba_fwd, dim3(grid), dim3(NTHREADS), LDS_BYTES, stream, p);
#endif
    const hipError_t le = hipPeekAtLastError();
    if (le != hipSuccess) fprintf(stderr, "kernel_launch: launch failed: %s\n", hipGetErrorName(le));
}
```

```cpp
#include <hip/hip_runtime.h>
#include <cstdio>
#include <cstdint>

#define LAS __attribute__((address_space(3)))
typedef unsigned short bf16_t;
typedef short bf16x8 __attribute__((ext_vector_type(8)));
typedef short bf16x4 __attribute__((ext_vector_type(4)));
typedef float f32x4 __attribute__((ext_vector_type(4)));
typedef float f32x2 __attribute__((ext_vector_type(2)));
typedef unsigned u32x4 __attribute__((ext_vector_type(4)));
typedef unsigned u32x2 __attribute__((ext_vector_type(2)));

constexpr int DM = 2048, NB = 8, SEQ = 2048, NTOK = NB * SEQ;
constexpr int NPROJ = 5120;
constexpr int NMOD = 6 * DM;
constexpr int NEXP = 32, DEXP = 1024;
constexpr int NTHREADS = 512;

constexpr size_t WS_BAR   = 0;
constexpr size_t WS_CNT   = 16384;
constexpr size_t WS_ROWSS1= WS_CNT + 8192;
constexpr size_t WS_ROWSS2= WS_ROWSS1 + (size_t)16384 * 16 * 4;
constexpr size_t WS_MODP  = WS_ROWSS2 + (size_t)16384 * 32 * 4;
constexpr size_t WS_MOD   = WS_MODP + (size_t)4 * 8 * NMOD * 4;
constexpr size_t WS_ROPE  = WS_MOD + (size_t)8 * NMOD * 4;
constexpr size_t WS_SSMA  = WS_ROPE + (size_t)2048 * 64 * 8;
constexpr size_t WS_WR    = WS_SSMA + (size_t)64 * 64 * 8;
constexpr size_t WS_SSMM  = WS_WR + (size_t)48 * 2048 * 2;
constexpr size_t WS_WIN   = WS_SSMM + (size_t)64 * 131072 * 2;
constexpr size_t WS_WOUT  = WS_WIN + (size_t)NPROJ * DM * 2;
constexpr size_t WS_WGLU  = WS_WOUT + (size_t)DM * DM * 2;
constexpr size_t WS_WGU   = WS_WGLU + (size_t)1024 * 1024 * 2;
constexpr size_t WS_WD    = WS_WGU + (size_t)NEXP * 2048 * 2048 * 2;
constexpr size_t WS_H     = WS_WD + (size_t)NEXP * 2048 * 1024 * 2;
constexpr size_t WS_PROJ  = WS_H + (size_t)NTOK * DM * 2;
constexpr size_t WS_Z     = WS_PROJ + (size_t)NTOK * NPROJ * 2;
constexpr size_t WS_CAT   = WS_Z + (size_t)NTOK * 1024 * 2;
constexpr size_t WS_WGT   = WS_CAT + (size_t)NTOK * DM * 2;
constexpr size_t WS_LIST  = WS_WGT + (size_t)32768 * 4;
constexpr size_t WS_X1    = WS_LIST + (size_t)32 * 16384 * 4;
constexpr size_t WS_END   = WS_X1 + (size_t)NTOK * DM * 2;
constexpr size_t WS_Y2    = WS_PROJ;
constexpr size_t WS_HM    = WS_Z;

constexpr int LDS_STAGE = 131072;
constexpr int LDS_BYTES = 147456;
constexpr int LDS_MISC  = LDS_BYTES - 2048;

struct Params { const float* in[27]; float* out; unsigned char* ws; int ph_lo, ph_hi; };

#define XB_TMO      128
#define XB_XCNT(j)  (256  + 64 * (j))
#define XB_XSUB(j)  (1280 + 64 * (j))
#define XB_XGEN(j)  (2304 + 64 * (j))
#define XB_TOP      3328
#define XB_TOPGEN   3392
#define XCD_BAR_WORDS 3456
#define XB_SPIN_CAP (1u << 22)

__device__ __forceinline__ unsigned xb_ld(unsigned* p)              { return __hip_atomic_load(p, __ATOMIC_RELAXED, __HIP_MEMORY_SCOPE_AGENT); }
__device__ __forceinline__ unsigned xb_add(unsigned* p, unsigned v) { return __hip_atomic_fetch_add(p, v, __ATOMIC_RELAXED, __HIP_MEMORY_SCOPE_AGENT); }
__device__ __forceinline__ unsigned xb_xcc_id() { return (unsigned)__builtin_amdgcn_s_getreg((3 << 11) | 20) & 0xFu; }
#define XB_SPIN(cond, bar) do { unsigned _sp = 0; while (cond) { __builtin_amdgcn_s_sleep(1); \
    if ((++_sp & 255u) == 0u) { if (xb_ld(&(bar)[XB_TMO])) break; if (_sp > XB_SPIN_CAP) { atomicAdd(&(bar)[XB_TMO], 1u); break; } } } } while (0)

struct XcdBarrier { unsigned* bar; unsigned x; volatile LAS unsigned* st; };

__device__ __forceinline__ XcdBarrier xcd_barrier_post(unsigned* bar, volatile LAS unsigned* st) {
    XcdBarrier b; b.bar = bar; b.x = xb_xcc_id(); b.st = st;
    if (threadIdx.x == 0) (void)xb_add(&bar[XB_XCNT(b.x)], 1u);
    return b;
}
__device__ __forceinline__ void xcd_barrier_complete(unsigned* bar, unsigned x, unsigned& nloc, unsigned& nx) {
    const unsigned G = gridDim.x * gridDim.y * gridDim.z;
    unsigned sum, cnt, mine, sp = 0u;
    for (;;) {
        sum = 0u; cnt = 0u; mine = 0u;
#pragma unroll
        for (unsigned j = 0; j < 16; ++j) { const unsigned c = xb_ld(&bar[XB_XCNT(j)]); sum += c; cnt += (c > 0u) ? 1u : 0u; mine = (j == x) ? c : mine; }
        if (sum == G) break;
        __builtin_amdgcn_s_sleep(1);
        if ((++sp & 255u) == 0u) { if (xb_ld(&bar[XB_TMO])) break; if (sp > XB_SPIN_CAP) { atomicAdd(&bar[XB_TMO], 1u); break; } }
    }
    nloc = mine > 0u ? mine : 1u; nx = cnt > 0u ? cnt : 1u;
}
__device__ __forceinline__ void xcd_barrier(const XcdBarrier& b) {
    asm volatile("s_waitcnt vmcnt(0)" ::: "memory");
    __syncthreads();
    if (threadIdx.x == 0) {
        unsigned* bar = b.bar;
        __builtin_amdgcn_s_waitcnt(0);
        unsigned nloc = b.st[0], nx = b.st[1];
        if (nloc == 0u) { xcd_barrier_complete(bar, b.x, nloc, nx); b.st[0] = nloc; b.st[1] = nx; }
        const unsigned old = xb_add(&bar[XB_XSUB(b.x)], 1u);
        const unsigned gen = old / nloc;
        if (old + 1u == (gen + 1u) * nloc) {
            __builtin_amdgcn_fence(__ATOMIC_RELEASE, "agent");
            asm volatile("s_waitcnt vmcnt(0)" ::: "memory");
            const unsigned og = xb_add(&bar[XB_TOP], 1u);
            const unsigned tg = og / nx;
            if (og + 1u == (tg + 1u) * nx) xb_add(&bar[XB_TOPGEN], 1u);
            else XB_SPIN(xb_ld(&bar[XB_TOPGEN]) == tg, bar);
            __builtin_amdgcn_fence(__ATOMIC_ACQUIRE, "agent");
            xb_add(&bar[XB_XGEN(b.x)], 1u);
            asm volatile("s_waitcnt vmcnt(0)" ::: "memory");
        } else {
            XB_SPIN(xb_ld(&bar[XB_XGEN(b.x)]) == gen, bar);
            __builtin_amdgcn_fence(__ATOMIC_ACQUIRE, "agent");
            asm volatile("s_waitcnt vmcnt(0)" ::: "memory");
        }
    }
    __syncthreads();
}

typedef __bf16 bf16x2_t __attribute__((ext_vector_type(2)));
__device__ __forceinline__ unsigned cvt_pk_bf16(float lo, float hi) { const f32x2 v = {lo, hi}; return __builtin_bit_cast(unsigned, __builtin_convertvector(v, bf16x2_t)); }
__device__ __forceinline__ float bf_lo(unsigned w) { return __uint_as_float(w << 16); }
__device__ __forceinline__ float bf_hi(unsigned w) { return __uint_as_float(w & 0xffff0000u); }
__device__ __forceinline__ float sigmoidf_(float x) { return 1.0f / (1.0f + __expf(-x)); }
__device__ __forceinline__ float gelu_tanh(float x) {
    const float u = 0.7978845608028654f * (x + 0.044715f * x * x * x);
    const float t = 1.0f - 2.0f / (1.0f + __expf(2.0f * u));
    return 0.5f * x * (1.0f + t);
}
__device__ __forceinline__ float wave_sum(float v) {
    v += __shfl_xor(v, 1); v += __shfl_xor(v, 2); v += __shfl_xor(v, 4); v += __shfl_xor(v, 8); v += __shfl_xor(v, 16); v += __shfl_xor(v, 32); return v;
}
__device__ __forceinline__ void sincos_d(double x, double& s, double& c) {
    const double TWO_PI = 6.283185307179586476925286766559;
    double r = x - TWO_PI * rint(x / TWO_PI);
    const double r2 = r * r;
    double ts = r, tc = 1.0; s = r; c = 1.0;
#pragma unroll 1
    for (int k = 1; k <= 14; ++k) { tc *= -r2 / (double)((2 * k - 1) * (2 * k)); ts *= -r2 / (double)((2 * k) * (2 * k + 1)); c += tc; s += ts; }
}

namespace g8 {
constexpr int BM = 256, BK = 64, HALF = 128, HTB = HALF * BK * 2, NXCD = 8, WGM = 8;
__device__ __forceinline__ int lds_byte(int r, int c) { const int st = (r >> 4) * 2 + (c >> 5), rr = r & 15, cc = c & 31, ob = rr * 64 + cc * 2; return st * 1024 + (ob ^ (((ob >> 9) & 1) << 5)); }
__device__ __forceinline__ void stage_rc(int b, int& R, int& C) { const int st = b / 1024, sb = b % 1024, swz = sb ^ (((sb >> 9) & 1) << 5); R = (st >> 1) * 16 + swz / 64; C = (st & 1) * 32 + (swz % 64) / 2; }
__device__ __forceinline__ int perm32(int rho) { const int n = rho >> 4, i = rho & 15; return 8 * (i >> 2) + 4 * n + (i & 3); }

struct Unit { unsigned aoff, boff; int pm, pn, flags, aux, aux2; };
typedef f32x4 Acc[2][2][4][2];

struct StaticOrder {
    int nM, nN, nwg, G, c;
    __device__ void init(int M, int N, int G_, int c_) { nM = M / BM; nN = N / BM; nwg = nM * nN; G = G_; c = c_; }
    __device__ __forceinline__ bool tile(int i, int& pm, int& pn) const {
        const long L = (long)i * G + c; if (L >= nwg) return false;
        int wgid = (int)L; { const int q = nwg / NXCD, r = nwg % NXCD, xcd = wgid % NXCD, off = wgid / NXCD; wgid = (xcd < r ? xcd * (q + 1) : r * (q + 1) + (xcd - r) * q) + off; }
        const int nig = WGM * nN, gid = wgid / nig, fm = gid * WGM, gsz = (nM - fm) < WGM ? (nM - fm) : WGM;
        pm = fm + ((wgid % nig) % gsz); pn = (wgid % nig) / gsz; return true;
    }
};

typedef long l64x2 __attribute__((ext_vector_type(2)));
template <class Epi, class Sched, bool SKIP = false, bool FP8 = false>
__device__ __forceinline__ void gemm_phase(LAS unsigned char* lds, const unsigned char* ws, const int nt, const int ldb  , const Sched& S, const Epi& E) {
    const int tid = threadIdx.x, wid = __builtin_amdgcn_readfirstlane(tid >> 6), lane = tid & 63, wr = wid >> 2, wc = wid & 3, fr = lane & 15, fq = lane >> 4;
    int R0, C0, R1, C1; stage_rc(tid * 16, R0, C0); stage_rc(tid * 16 + 8192, R1, C1);
    unsigned voffB[2];
    { const int Rb0 = Epi::PERM ? ((R0 & ~31) + perm32(R0 & 31)) : R0, Rb1 = Epi::PERM ? ((R1 & ~31) + perm32(R1 & 31)) : R1;
      voffB[0] = (unsigned)(Rb0 * 64 + C0) * 2u; voffB[1] = (unsigned)(Rb1 * 64 + C1) * 2u; }
    const unsigned kstep = (unsigned)(BK * 2);
    const unsigned kstepB = 256u * 64u * 2u;
    const unsigned hstepB = (unsigned)HALF * 64u * 2u;
    const unsigned ldsw = (unsigned)wid * 1024u;
    const int aoff = lds_byte(wr * 64 + fr, fq * 8), boff = lds_byte(wc * 32 + fr, fq * 8);
#define G8_SA(b, h) (((b) * 2 + (h)) * HTB)
#define G8_SB(b, h) ((4 + (b) * 2 + (h)) * HTB)
#define G8_STAGE(bufoff, gbase, v0, v1) do { \
        __builtin_amdgcn_global_load_lds((const unsigned*)((gbase) + (v0)), (LAS unsigned*)(lds + (bufoff) + ldsw), 16, 0, 0); \
        __builtin_amdgcn_global_load_lds((const unsigned*)((gbase) + (v1)), (LAS unsigned*)(lds + (bufoff) + ldsw + 8192), 16, 0, 0); } while (0)
#define G8_LDA(dst, b, h) do { _Pragma("unroll") for (int m = 0; m < 4; ++m) _Pragma("unroll") for (int k = 0; k < 2; ++k) dst[m][k] = *(const LAS bf16x8*)(lds + G8_SA(b, h) + aoff + m * 2048 + k * 1024); } while (0)
#define G8_LDB(dst, b, h) do { _Pragma("unroll") for (int n = 0; n < 2; ++n) _Pragma("unroll") for (int k = 0; k < 2; ++k) dst[n][k] = *(const LAS bf16x8*)(lds + G8_SB(b, h) + boff + n * 2048 + k * 1024); } while (0)
#define G8_MMA(ai, bj, At, Bt) do { __builtin_amdgcn_s_setprio(1); _Pragma("unroll") for (int m = 0; m < 4; ++m) _Pragma("unroll") for (int n = 0; n < 2; ++n) _Pragma("unroll") for (int k = 0; k < 2; ++k) { \
        if constexpr (FP8) { const l64x2 a2 = __builtin_bit_cast(l64x2, At[m][k]), b2 = __builtin_bit_cast(l64x2, Bt[n][k]); \
            acc[ai][bj][m][n] = __builtin_amdgcn_mfma_f32_16x16x32_fp8_fp8(b2[0], a2[0], acc[ai][bj][m][n], 0, 0, 0); \
            acc[ai][bj][m][n] = __builtin_amdgcn_mfma_f32_16x16x32_fp8_fp8(b2[1], a2[1], acc[ai][bj][m][n], 0, 0, 0); } \
        else acc[ai][bj][m][n] = __builtin_amdgcn_mfma_f32_16x16x32_bf16(Bt[n][k], At[m][k], acc[ai][bj][m][n], 0, 0, 0); } __builtin_amdgcn_s_setprio(0); } while (0)
#define G8_WAIT_V(n) asm volatile("s_waitcnt vmcnt(" #n ")" ::: "memory")
#define G8_WAIT_L(n) asm volatile("s_waitcnt lgkmcnt(" #n ")" ::: "memory")
#define G8_BAR __builtin_amdgcn_s_barrier()
#define G8_SCHED __builtin_amdgcn_sched_barrier(0)
    Unit cur, nxt; int ui = 0;
    if (!S.next(0, cur)) return;
    Acc acc;
#pragma unroll
    for (int a = 0; a < 2; ++a)
#pragma unroll
        for (int b = 0; b < 2; ++b)
#pragma unroll
            for (int m = 0; m < 4; ++m)
#pragma unroll
                for (int n = 0; n < 2; ++n) acc[a][b][m][n] = (f32x4){0.f, 0.f, 0.f, 0.f};
    bf16x8 At[4][2], B0[2][2], B1[2][2];
    unsigned cv[2][2], nv[2][2];
    S.aoffs(cur, R0, C0, R1, C1, cv);
    const unsigned char* cA = ws + cur.aoff; const unsigned char* cB = ws + cur.boff;
    G8_STAGE(G8_SB(0, 0), cB, voffB[0], voffB[1]); G8_STAGE(G8_SA(0, 0), cA, cv[0][0], cv[0][1]);
    G8_STAGE(G8_SB(0, 1), cB + hstepB, voffB[0], voffB[1]); G8_STAGE(G8_SA(0, 1), cA, cv[1][0], cv[1][1]);
    if (wr == 1) G8_BAR;
    G8_WAIT_V(4); G8_BAR;
    G8_STAGE(G8_SB(1, 0), cB + kstepB, voffB[0], voffB[1]); G8_STAGE(G8_SA(1, 0), cA + kstep, cv[0][0], cv[0][1]);
    G8_STAGE(G8_SB(1, 1), cB + hstepB + kstepB, voffB[0], voffB[1]);
    G8_WAIT_V(6); G8_BAR;
    for (;;) {
        const bool has_next = S.next(ui + 1, nxt);
        if (has_next) S.aoffs(nxt, R0, C0, R1, C1, nv);
        else { nv[0][0] = cv[0][0]; nv[0][1] = cv[0][1]; nv[1][0] = cv[1][0]; nv[1][1] = cv[1][1]; }
        const unsigned char* nA = has_next ? ws + nxt.aoff : cA; const unsigned char* nB = has_next ? ws + nxt.boff : cB;
        const int vrows = SKIP ? cur.aux2 : 256;
        const bool do0 = !SKIP || vrows > 64 || wr == 0, do1 = !SKIP || vrows > 128;
        for (int t = 0; t < nt; t += 2) {
            const bool last = (t == nt - 2);
            const unsigned char* a1 = cA + (size_t)(t + 1) * kstep;
            const unsigned char* a2 = last ? nA : cA + (size_t)(t + 2) * kstep; const unsigned char* b2 = last ? nB : cB + (size_t)(t + 2) * kstepB;
            const unsigned char* a3 = a2 + kstep; const unsigned char* b3 = b2 + kstepB;
            const unsigned o00 = last ? nv[0][0] : cv[0][0], o01 = last ? nv[0][1] : cv[0][1], o10 = last ? nv[1][0] : cv[1][0], o11 = last ? nv[1][1] : cv[1][1];
            G8_LDB(B0, 0, 0); G8_SCHED; G8_LDA(At, 0, 0); G8_STAGE(G8_SA(1, 1), a1, cv[1][0], cv[1][1]);
            G8_WAIT_L(8); G8_BAR; G8_WAIT_L(0); if (do0) G8_MMA(0, 0, At, B0); G8_BAR; G8_SCHED;
            G8_LDB(B1, 0, 1); G8_STAGE(G8_SB(0, 0), b2, voffB[0], voffB[1]);
            G8_BAR; G8_WAIT_L(0); if (do0) G8_MMA(0, 1, At, B1); G8_BAR;
            G8_LDA(At, 0, 1); G8_STAGE(G8_SA(0, 0), a2, o00, o01);
            G8_BAR; G8_WAIT_L(0); if (do1) G8_MMA(1, 0, At, B0); G8_BAR; G8_SCHED;
            G8_STAGE(G8_SB(0, 1), b2 + hstepB, voffB[0], voffB[1]);
            G8_WAIT_V(6); G8_BAR; if (do1) G8_MMA(1, 1, At, B1); G8_BAR;
            G8_LDB(B0, 1, 0); G8_SCHED; G8_LDA(At, 1, 0); G8_STAGE(G8_SA(0, 1), a2, o10, o11);
            G8_WAIT_L(8); G8_BAR; G8_WAIT_L(0); if (do0) G8_MMA(0, 0, At, B0); G8_BAR; G8_SCHED;
            G8_LDB(B1, 1, 1); G8_STAGE(G8_SB(1, 0), b3, voffB[0], voffB[1]);
            G8_BAR; G8_WAIT_L(0); if (do0) G8_MMA(0, 1, At, B1); G8_BAR;
            G8_LDA(At, 1, 1); G8_STAGE(G8_SA(1, 0), a3, o00, o01);
            G8_BAR; G8_WAIT_L(0); if (do1) G8_MMA(1, 0, At, B0); G8_BAR; G8_SCHED;
            G8_STAGE(G8_SB(1, 1), b3 + hstepB, voffB[0], voffB[1]);
            G8_WAIT_V(6); G8_BAR; if (do1) G8_MMA(1, 1, At, B1); G8_BAR;
        }
        E(acc, cur, wr, wc, fr, fq);
        if (!has_next) break;
        if (!(cur.flags & 1)) {
#pragma unroll
            for (int a = 0; a < 2; ++a)
#pragma unroll
                for (int b = 0; b < 2; ++b)
#pragma unroll
                    for (int m = 0; m < 4; ++m)
#pragma unroll
                        for (int n = 0; n < 2; ++n) acc[a][b][m][n] = (f32x4){0.f, 0.f, 0.f, 0.f};
        }
        cur = nxt; cA = nA; cB = nB; ++ui;
        cv[0][0] = nv[0][0]; cv[0][1] = nv[0][1]; cv[1][0] = nv[1][0]; cv[1][1] = nv[1][1];
    }
    G8_WAIT_V(0);
    if (wr == 0) G8_BAR;
    G8_BAR;
#undef G8_SA
#undef G8_SB
#undef G8_STAGE
#undef G8_LDA
#undef G8_LDB
#undef G8_MMA
#undef G8_WAIT_V
#undef G8_WAIT_L
#undef G8_BAR
#undef G8_SCHED
}
}

__device__ __forceinline__ void p0_adaln(const Params& P, LAS unsigned char* lds, int tid, int item) {
    const int ks = item & 3, nc = item >> 2;
    LAS float* sc = (LAS float*)lds;
    LAS float* red = (LAS float*)(lds + 16384);
    const float* c = P.in[1];
    for (int i = tid; i < 4096; i += NTHREADS) { const int kl = i >> 3, b = i & 7; const float v = c[b * 2048 + ks * 512 + kl]; sc[i] = v / (1.0f + expf(-v)); }
    __syncthreads();
    if (tid < 384) {
        const int nq = tid % 48, kg = tid / 48;
        const float* W = P.in[2] + (size_t)(ks * 512 + kg * 64) * NMOD + nc * 192 + nq * 4;
        f32x4 acc[8];
#pragma unroll
        for (int b = 0; b < 8; ++b) acc[b] = (f32x4){0.f, 0.f, 0.f, 0.f};
#pragma unroll 16
        for (int kk = 0; kk < 64; ++kk) {
            const f32x4 w = *(const f32x4*)(W + (size_t)kk * NMOD);
            const f32x4 s0 = *(const LAS f32x4*)(sc + (kg * 64 + kk) * 8), s1 = *(const LAS f32x4*)(sc + (kg * 64 + kk) * 8 + 4);
            acc[0] += w * s0[0]; acc[1] += w * s0[1]; acc[2] += w * s0[2]; acc[3] += w * s0[3];
            acc[4] += w * s1[0]; acc[5] += w * s1[1]; acc[6] += w * s1[2]; acc[7] += w * s1[3];
        }
#pragma unroll
        for (int b = 0; b < 8; ++b) *(LAS f32x4*)(red + (kg * 8 + b) * 192 + nq * 4) = acc[b];
    }
    __syncthreads();
    float* modp = (float*)(P.ws + WS_MODP);
    for (int i = tid; i < 8 * 192; i += NTHREADS) {
        const int b = i / 192, n = i % 192; float s = 0.f;
#pragma unroll
        for (int kg = 0; kg < 8; ++kg) s += red[(kg * 8 + b) * 192 + n];
        modp[(size_t)(ks * 8 + b) * NMOD + nc * 192 + n] = s;
    }
    __syncthreads();
}

struct CvtUnit { const float* src; bf16_t* dst; int Nd, Kd, k0, n0, nmode; const float* s0; const float* s1; };
constexpr int CVT_UNITS = 640 + 256 + 64;
__device__ __forceinline__ void cvt_unit_decode(const Params& P, int L, CvtUnit& u) {
    u.s0 = nullptr; u.s1 = nullptr; u.nmode = 0;
    if (L < 640) { u.src = P.in[5]; u.dst = (bf16_t*)(P.ws + WS_WIN); u.Kd = 2048; u.Nd = 5120; u.k0 = (L / 20) * 64; u.n0 = (L % 20) * 256; u.nmode = 3; return; }
    L -= 640;
    if (L < 256) { u.src = P.in[17]; u.dst = (bf16_t*)(P.ws + WS_WOUT); u.Kd = 2048; u.Nd = 2048; u.k0 = (L / 8) * 64; u.n0 = (L % 8) * 256; u.s0 = P.in[15]; u.s1 = P.in[16]; return; }
    L -= 256;
    if (L < 64) { u.src = P.in[14]; u.dst = (bf16_t*)(P.ws + WS_WGLU); u.Kd = 1024; u.Nd = 1024; u.k0 = (L / 4) * 64; u.n0 = (L % 4) * 256; return; }
    L -= 64;
    if (L < 4096) { const int e = L >> 7, r = L & 127; u.src = P.in[23] + (size_t)e * 2048 * 1024; u.dst = (bf16_t*)(P.ws + WS_WGU) + (size_t)e * 2048 * 2048; u.Kd = 2048; u.Nd = 1024; u.k0 = (r >> 2) * 64; u.n0 = (r & 3) * 256; u.nmode = 1; return; }
    L -= 4096;
    if (L < 4096) { const int e = L >> 7, r = L & 127; u.src = P.in[24] + (size_t)e * 2048 * 1024; u.dst = (bf16_t*)(P.ws + WS_WGU) + (size_t)e * 2048 * 2048; u.Kd = 2048; u.Nd = 1024; u.k0 = (r >> 2) * 64; u.n0 = (r & 3) * 256; u.nmode = 2; return; }
    L -= 4096;
    { const int e = L >> 7, r = L & 127; u.src = P.in[25] + (size_t)e * 1024 * 2048; u.dst = (bf16_t*)(P.ws + WS_WD) + (size_t)e * 2048 * 1024; u.Kd = 1024; u.Nd = 2048; u.k0 = (r >> 3) * 64; u.n0 = (r & 7) * 256; }
}
__device__ __forceinline__ void cvt_load(const CvtUnit& u, int tid, f32x4 (&r)[8]) {
    const int kp = tid >> 4, nq = tid & 15;
    const float* p = u.src + (size_t)(u.k0 + 2 * kp) * u.Nd + u.n0 + nq * 4;
#pragma unroll
    for (int s = 0; s < 4; ++s) { r[2 * s] = *(const f32x4*)(p + s * 64); r[2 * s + 1] = *(const f32x4*)(p + u.Nd + s * 64); }
    if (u.s0) {
        const int k = u.k0 + 2 * kp;
        const float a = (k < 1024) ? u.s0[k] : u.s1[k - 1024], b = (k + 1 < 1024) ? u.s0[k + 1] : u.s1[k + 1 - 1024];
#pragma unroll
        for (int s = 0; s < 4; ++s) { r[2 * s] *= a; r[2 * s + 1] *= b; }
    }
}
__device__ __forceinline__ void cvt_to_lds(LAS unsigned* tile, const f32x4 (&r)[8], int kp, int nq) {
#pragma unroll
    for (int s = 0; s < 4; ++s)
#pragma unroll
        for (int j = 0; j < 4; ++j) tile[s * 2112 + (nq * 4 + j) * 33 + kp] = cvt_pk_bf16(r[2 * s][j], r[2 * s + 1][j]);
}
__device__ __forceinline__ void cvt_store(const LAS unsigned* tile, const CvtUnit& u, int nl, int kq) {
#pragma unroll
    for (int s = 0; s < 4; ++s) {
        u32x4 w; w.x = tile[s * 2112 + nl * 33 + kq * 4]; w.y = tile[s * 2112 + nl * 33 + kq * 4 + 1]; w.z = tile[s * 2112 + nl * 33 + kq * 4 + 2]; w.w = tile[s * 2112 + nl * 33 + kq * 4 + 3];
        const int n = u.n0 + s * 64 + nl;
        int np = n;
        if (u.nmode == 1 || u.nmode == 2) np = (n >> 7) * 256 + (n & 127) + (u.nmode == 2 ? 128 : 0);
        else if (u.nmode == 3 && n >= 1024 && n < 3072) { const int reg = (n >= 2048) ? 2048 : 1024, nr = n - reg;
            np = reg + ((nr >> 8) << 8) + (((nr >> 6) & 1) << 7) + (((nr >> 7) & 1) << 6) + (nr & 63); }
        *(u32x4*)(u.dst + (size_t)(np >> 8) * ((size_t)u.Kd * 256) + (size_t)(u.k0 >> 6) * 16384 + (np & 255) * 64 + kq * 8) = w;
    }
}
__device__ __forceinline__ void p0_convert(const Params& P, LAS unsigned char* lds, int tid, int blk, int G) {
    LAS unsigned* tileA = (LAS unsigned*)lds;
    LAS unsigned* tileB = tileA + 4 * 2112;
    const int kp = tid >> 4, nq = tid & 15, nl = tid >> 3, kq = tid & 7;
    CvtUnit uA, uB, nA, nB; f32x4 rA[8], rB[8];
    int L = blk;
    if (L >= CVT_UNITS) return;
    bool hasB = (L + G) < CVT_UNITS;
    cvt_unit_decode(P, L, uA); cvt_load(uA, tid, rA);
    if (hasB) { cvt_unit_decode(P, L + G, uB); cvt_load(uB, tid, rB); }
    for (;;) {
        cvt_to_lds(tileA, rA, kp, nq);
        if (hasB) cvt_to_lds(tileB, rB, kp, nq);
        __syncthreads();
        const int Ln = L + 2 * G; const bool moreA = Ln < CVT_UNITS, moreB = (Ln + G) < CVT_UNITS;
        if (moreA) { cvt_unit_decode(P, Ln, nA); cvt_load(nA, tid, rA); }
        if (moreB) { cvt_unit_decode(P, Ln + G, nB); cvt_load(nB, tid, rB); }
        cvt_store(tileA, uA, nl, kq);
        if (hasB) cvt_store(tileB, uB, nl, kq);
        __syncthreads();
        if (!moreA) break;
        uA = nA; uB = nB; hasB = moreB; L = Ln;
    }
}

struct Cvt8Unit { const float* src; unsigned char* dst; int Nd, Kd, k0, n0, nmode; float scale; };
constexpr float WGU_SCALE = 64.0f, WD_SCALE = 32.0f;
__device__ __forceinline__ void cvt8_decode(const Params& P, int L, Cvt8Unit& u) {
    if (L < 8192) { const int up = L >= 4096; const int r_ = L & 4095; const int e = r_ >> 7, r = r_ & 127;
        u.src = P.in[up ? 24 : 23] + (size_t)e * 2048 * 1024; u.dst = P.ws + WS_WGU + (size_t)e * 2048 * 2048; u.Kd = 2048; u.Nd = 1024; u.k0 = (r >> 3) * 128; u.n0 = (r & 7) * 128; u.nmode = up ? 2 : 1; u.scale = WGU_SCALE; return; }
    L -= 8192;
    { const int e = L >> 7, r = L & 127; u.src = P.in[25] + (size_t)e * 1024 * 2048; u.dst = P.ws + WS_WD + (size_t)e * 2048 * 1024; u.Kd = 1024; u.Nd = 2048; u.k0 = (r >> 4) * 128; u.n0 = (r & 15) * 128; u.nmode = 0; u.scale = WD_SCALE; }
}
__device__ __forceinline__ void cvt8_load(const Cvt8Unit& u, int tid, f32x4 (&r)[8]) {
    const int kg = tid >> 5, nq = tid & 31;
    const float* p = u.src + (size_t)(u.k0 + 8 * kg) * u.Nd + u.n0 + nq * 4;
#pragma unroll
    for (int kk = 0; kk < 8; ++kk) r[kk] = *(const f32x4*)(p + (size_t)kk * u.Nd);
}
__device__ __forceinline__ void cvt8_to_lds(LAS unsigned* tile, const f32x4 (&r)[8], float sc, int tid) {
    const int kg = tid >> 5, nq = tid & 31;
    u32x4 w0, w1;
#pragma unroll
    for (int j = 0; j < 4; ++j) {
        int a = 0, b = 0;
        a = __builtin_amdgcn_cvt_pk_fp8_f32(r[0][j] * sc, r[1][j] * sc, a, false); a = __builtin_amdgcn_cvt_pk_fp8_f32(r[2][j] * sc, r[3][j] * sc, a, true);
        b = __builtin_amdgcn_cvt_pk_fp8_f32(r[4][j] * sc, r[5][j] * sc, b, false); b = __builtin_amdgcn_cvt_pk_fp8_f32(r[6][j] * sc, r[7][j] * sc, b, true);
        w0[j] = (unsigned)a; w1[j] = (unsigned)b;
    }
    *(LAS u32x4*)(tile + (2 * kg) * 132 + nq * 4) = w0;
    *(LAS u32x4*)(tile + (2 * kg + 1) * 132 + nq * 4) = w1;
}
__device__ __forceinline__ void cvt8_store(const LAS unsigned* tile, const Cvt8Unit& u, int tid) {
    const int nl = tid >> 2, q = tid & 3;
    u32x4 w0, w1;
    w0.x = tile[(8 * q + 0) * 132 + nl]; w0.y = tile[(8 * q + 1) * 132 + nl]; w0.z = tile[(8 * q + 2) * 132 + nl]; w0.w = tile[(8 * q + 3) * 132 + nl];
    w1.x = tile[(8 * q + 4) * 132 + nl]; w1.y = tile[(8 * q + 5) * 132 + nl]; w1.z = tile[(8 * q + 6) * 132 + nl]; w1.w = tile[(8 * q + 7) * 132 + nl];
    const int n = u.n0 + nl;
    int np = n;
    if (u.nmode == 1 || u.nmode == 2) np = (n >> 7) * 256 + (n & 127) + (u.nmode == 2 ? 128 : 0);
    unsigned char* d = u.dst + (size_t)(np >> 8) * ((size_t)u.Kd * 256) + (size_t)(u.k0 >> 7) * 32768 + (np & 255) * 128 + q * 32;
    *(u32x4*)d = w0; *(u32x4*)(d + 16) = w1;
}
__device__ __forceinline__ void p0_convert_fp8(const Params& P, LAS unsigned char* lds, int tid, int blk, int G, const int Lbeg, const int Lend) {
    LAS unsigned* tileA = (LAS unsigned*)lds;
    LAS unsigned* tileB = tileA + 32 * 132;
    Cvt8Unit uA, uB, nA, nB; f32x4 rA[8], rB[8];
    int L = Lbeg + blk;
    if (L >= Lend) return;
    bool hasB = (L + G) < Lend;
    cvt8_decode(P, L, uA); cvt8_load(uA, tid, rA);
    if (hasB) { cvt8_decode(P, L + G, uB); cvt8_load(uB, tid, rB); }
    for (;;) {
        cvt8_to_lds(tileA, rA, uA.scale, tid);
        if (hasB) cvt8_to_lds(tileB, rB, uB.scale, tid);
        __syncthreads();
        const int Ln = L + 2 * G; const bool moreA = Ln < Lend, moreB = (Ln + G) < Lend;
        if (moreA) { cvt8_decode(P, Ln, nA); cvt8_load(nA, tid, rA); }
        if (moreB) { cvt8_decode(P, Ln + G, nB); cvt8_load(nB, tid, rB); }
        cvt8_store(tileA, uA, tid);
        if (hasB) cvt8_store(tileB, uB, tid);
        __syncthreads();
        if (!moreA) break;
        uA = nA; uB = nB; hasB = moreB; L = Ln;
    }
}

__device__ __forceinline__ void p0_ssm_mats(const Params& P, LAS unsigned char* lds, int tid, int item) {
    const int g = item & 63, q = item >> 6;
    LAS f32x2* pw = (LAS f32x2*)lds;
    LAS f32x2* Bb = pw + 17 * 64;
    LAS f32x2* Cc = Bb + 64 * 16;
    LAS float* Kt = (LAS float*)(Cc + 16 * 64);
    if (tid < 64) {
        const int p = tid;
        const float dt = expf(P.in[13][g]);
        const float are = P.in[6][g * 64 + p], aim = P.in[7][g * 64 + p];
        const float mag = expf(dt * are);
        double sd, cd; sincos_d((double)(dt * aim), sd, cd);
        const float abr = mag * (float)cd, abi = mag * (float)sd;
        const float inv = 1.0f / (are * are + aim * aim);
        const float nre = abr - 1.0f;
        const float fre = (nre * are + abi * aim) * inv, fim = (abi * are - nre * aim) * inv;
        float pr = 1.0f, pi = 0.0f;
        for (int n = 0; n <= 16; ++n) { pw[n * 64 + p] = (f32x2){pr, pi}; const float t = pr * abr - pi * abi; pi = pr * abi + pi * abr; pr = t; }
        for (int h = 0; h < 16; ++h) {
            const float br = P.in[8][(g * 64 + p) * 16 + h], bi = P.in[9][(g * 64 + p) * 16 + h];
            Bb[p * 16 + h] = (f32x2){fre * br - fim * bi, fre * bi + fim * br};
            Cc[h * 64 + p] = (f32x2){P.in[10][(g * 16 + h) * 64 + p], P.in[11][(g * 16 + h) * 64 + p]};
        }
        if (q == 0) { f32x2* AL = (f32x2*)(P.ws + WS_SSMA); const f32x2 v = pw[16 * 64 + p]; AL[g * 64 + p] = v; }
    }
    __syncthreads();
    for (int o = tid; o < 4096; o += NTHREADS) {
        const int tau = o >> 8, ho = (o >> 4) & 15, hi = o & 15; float s = 0.f;
        for (int p = 0; p < 64; ++p) {
            const f32x2 c = Cc[ho * 64 + p], a = pw[tau * 64 + p], b = Bb[p * 16 + hi];
            const float cr = c.x * a.x - c.y * a.y, ci = c.x * a.y + c.y * a.x;
            s += cr * b.x - ci * b.y;
        }
        Kt[o] = s;
    }
    __syncthreads();
    bf16_t* Ms = (bf16_t*)(P.ws + WS_SSMM) + (size_t)g * 131072;
    bf16_t* TM = Ms + 32768;
    for (int o = tid; o < 32 * 128; o += NTHREADS) {
        const int row = 32 * q + (o >> 7), col = (o & 127) * 2;
        const int p = row >> 1, j = col >> 4, hi = col & 15;
        const f32x2 a = pw[(15 - j) * 64 + p], b0 = Bb[p * 16 + hi], b1 = Bb[p * 16 + hi + 1];
        float v0, v1;
        if ((row & 1) == 0) { v0 = a.x * b0.x - a.y * b0.y; v1 = a.x * b1.x - a.y * b1.y; } else { v0 = a.x * b0.y + a.y * b0.x; v1 = a.x * b1.y + a.y * b1.x; }
        *(unsigned*)(Ms + (size_t)row * 256 + col) = cvt_pk_bf16(v0, v1);
    }
    for (int o = tid; o < 64 * 192; o += NTHREADS) {
        const int row = 64 * q + o / 192, col = (o % 192) * 2;
        const int i = row >> 4, ho = row & 15; float v0, v1;
        if (col < 256) { const int j = col >> 4, hi = col & 15; if (j <= i) { v0 = Kt[((i - j) * 16 + ho) * 16 + hi]; v1 = Kt[((i - j) * 16 + ho) * 16 + hi + 1]; } else { v0 = 0.f; v1 = 0.f; } }
        else { const int p0 = (col - 256) >> 1;
            const f32x2 c0 = Cc[ho * 64 + p0], a0 = pw[(i + 1) * 64 + p0];
            v0 = c0.x * a0.x - c0.y * a0.y; v1 = -(c0.x * a0.y + c0.y * a0.x); }
        *(unsigned*)(TM + (size_t)row * 384 + col) = cvt_pk_bf16(v0, v1);
    }
    __syncthreads();
}

__device__ __forceinline__ void p0_misc(const Params& P, int tid, int blk, int G) {
    bf16_t* wr = (bf16_t*)(P.ws + WS_WR);
    for (int i = blk * NTHREADS + tid; i < 48 * 2048; i += G * NTHREADS) {
        const int n = i >> 11, k = i & 2047; float v = 0.f;
        if (n < 4) v = P.in[19][k * 4 + n]; else if (n < 36) v = P.in[21][k * 32 + (n - 4)];
        wr[i] = (bf16_t)(cvt_pk_bf16(v, 0.f) & 0xffffu);
    }
    if (blk == 0) for (int i = tid; i < 2048; i += NTHREADS) ((int*)(P.ws + WS_CNT))[i] = 0;
}

__device__ __forceinline__ void p1_norm1(const Params& P, LAS unsigned char* lds, int tid, int blk, int G) {
    const float* modp = (const float*)(P.ws + WS_MODP); const float* bada = P.in[3];
    float* mod = (float*)(P.ws + WS_MOD);
    for (int i = blk * NTHREADS + tid; i < 8 * NMOD; i += G * NTHREADS) {
        const int b = i / NMOD, j = i % NMOD;
        mod[i] = bada[j] + ((modp[(size_t)(0 * 8 + b) * NMOD + j] + modp[(size_t)(1 * 8 + b) * NMOD + j]) + (modp[(size_t)(2 * 8 + b) * NMOD + j] + modp[(size_t)(3 * 8 + b) * NMOD + j]));
    }
    LAS float* gm = (LAS float*)lds; LAS float* sh = gm + 2048;
    const int wave = tid >> 6, lane = tid & 63;
    bf16_t* H = (bf16_t*)(P.ws + WS_H);
    for (int rb = blk; rb < 256; rb += G) {
        const int b = rb >> 5;
        for (int k = tid; k < 2048; k += NTHREADS) {
            const int js = 2048 + k, jh = k;
            const float sc = bada[js] + ((modp[(size_t)(0 * 8 + b) * NMOD + js] + modp[(size_t)(1 * 8 + b) * NMOD + js]) + (modp[(size_t)(2 * 8 + b) * NMOD + js] + modp[(size_t)(3 * 8 + b) * NMOD + js]));
            const float sv = bada[jh] + ((modp[(size_t)(0 * 8 + b) * NMOD + jh] + modp[(size_t)(1 * 8 + b) * NMOD + jh]) + (modp[(size_t)(2 * 8 + b) * NMOD + jh] + modp[(size_t)(3 * 8 + b) * NMOD + jh]));
            gm[k] = P.in[4][k] * (1.0f + sc); sh[k] = sv;
        }
        __syncthreads();
        f32x4 v[8], vn[8];
        { const float* xr = P.in[0] + (size_t)(rb * 64 + wave * 8) * DM;
#pragma unroll
          for (int i = 0; i < 8; ++i) v[i] = *(const f32x4*)(xr + (i * 64 + lane) * 4); }
        for (int rr = 0; rr < 8; ++rr) {
            const int row = rb * 64 + wave * 8 + rr;
            if (rr < 7) { const float* xn = P.in[0] + (size_t)(row + 1) * DM;
#pragma unroll
                for (int i = 0; i < 8; ++i) vn[i] = *(const f32x4*)(xn + (i * 64 + lane) * 4); }
            float ss = 0.f;
#pragma unroll
            for (int i = 0; i < 8; ++i) ss += v[i][0] * v[i][0] + v[i][1] * v[i][1] + v[i][2] * v[i][2] + v[i][3] * v[i][3];
            ss = wave_sum(ss);
            const float r = rsqrtf(ss * (1.0f / 2048.0f) + 1e-6f);
#pragma unroll
            for (int i = 0; i < 8; ++i) {
                const int k = (i * 64 + lane) * 4;
                const f32x4 g4 = *(const LAS f32x4*)(gm + k), s4 = *(const LAS f32x4*)(sh + k);
                const f32x4 o = v[i] * r * g4 + s4;
                u32x2 w; w.x = cvt_pk_bf16(o[0], o[1]); w.y = cvt_pk_bf16(o[2], o[3]);
                *(u32x2*)(H + (size_t)row * DM + k) = w;
            }
#pragma unroll
            for (int i = 0; i < 8; ++i) v[i] = vn[i];
        }
        __syncthreads();
    }
}

struct DenseSched : g8::StaticOrder {
    unsigned abase, bbase; int lda, ldb;
    __device__ __forceinline__ bool next(int i, g8::Unit& u) const {
        int pm, pn; if (!tile(i, pm, pn)) return false;
        u.pm = __builtin_amdgcn_readfirstlane(pm); u.pn = __builtin_amdgcn_readfirstlane(pn); u.flags = 0; u.aux = 0;
        u.aoff = abase + (unsigned)u.pm * 256u * (unsigned)lda * 2u; u.boff = bbase + (unsigned)u.pn * 256u * (unsigned)ldb * 2u; return true;
    }
    __device__ __forceinline__ void aoffs(const g8::Unit&, int R0, int C0, int R1, int C1, unsigned (&v)[2][2]) const {
        v[0][0] = (unsigned)(R0 * lda + C0) * 2u; v[0][1] = (unsigned)(R1 * lda + C1) * 2u;
        v[1][0] = (unsigned)((128 + R0) * lda + C0) * 2u; v[1][1] = (unsigned)((128 + R1) * lda + C1) * 2u;
    }
};
struct EpiStoreBf16 {
    static constexpr bool PERM = true;
    bf16_t* O; int ldc;
    __device__ __forceinline__ void operator()(g8::Acc& acc, const g8::Unit& u, int wr, int wc, int fr, int fq) const {
        const int row0 = u.pm * 256 + wr * 64 + fr, col0 = u.pn * 256 + wc * 32 + 8 * fq;
#pragma unroll
        for (int ai = 0; ai < 2; ++ai)
#pragma unroll
            for (int m = 0; m < 4; ++m) { bf16_t* rowp = O + (size_t)(row0 + ai * 128 + m * 16) * ldc + col0;
#pragma unroll
                for (int bj = 0; bj < 2; ++bj) { const f32x4 v0 = acc[ai][bj][m][0], v1 = acc[ai][bj][m][1];
                    u32x4 w; w.x = cvt_pk_bf16(v0[0], v0[1]); w.y = cvt_pk_bf16(v0[2], v0[3]); w.z = cvt_pk_bf16(v1[0], v1[1]); w.w = cvt_pk_bf16(v1[2], v1[3]);
                    *(u32x4*)(rowp + bj * 128) = w; } }
    }
};
struct EpiInProj {
    static constexpr bool PERM = true;
    bf16_t* O;
    __device__ __forceinline__ void operator()(g8::Acc& acc, const g8::Unit& u, int wr, int wc, int fr, int fq) const {
        const int pn = u.pn;
        const int row0 = u.pm * 256 + wr * 64 + fr;
        if (pn < 4 || pn >= 12) {
            const int col0 = pn * 256 + wc * 32 + 8 * fq;
#pragma unroll
            for (int ai = 0; ai < 2; ++ai)
#pragma unroll
                for (int m = 0; m < 4; ++m) { bf16_t* rowp = O + (size_t)(row0 + ai * 128 + m * 16) * NPROJ + col0;
#pragma unroll
                    for (int bj = 0; bj < 2; ++bj) { const f32x4 v0 = acc[ai][bj][m][0], v1 = acc[ai][bj][m][1];
                        u32x4 w; w.x = cvt_pk_bf16(v0[0], v0[1]); w.y = cvt_pk_bf16(v0[2], v0[3]); w.z = cvt_pk_bf16(v1[0], v1[1]); w.w = cvt_pk_bf16(v1[2], v1[3]);
                        *(u32x4*)(rowp + bj * 128) = w; } }
            return;
        }
        const bool isq = pn < 8;
        const int head = 2 * ((pn - 4) & 3) + (wc >> 1);
        const int dd0 = 32 * (wc & 1) + 8 * fq;
        const int colbase = (isq ? 1024 : 2048) + head * 128 + dd0;
        const float lg2 = log2f(1.0f - exp2f(-5.0f - (float)head));
        float fr_[8];
#pragma unroll
        for (int t = 0; t < 8; ++t) fr_[t] = exp2f(-(float)(dd0 + t) * 0.20762050593046014f) * 0.15915494309189535f;
#pragma unroll
        for (int ai = 0; ai < 2; ++ai)
#pragma unroll
            for (int m = 0; m < 4; ++m) {
                const int row = row0 + ai * 128 + m * 16, pos = row & 2047, i = wr * 64 + m * 16 + fr;
                const float sc = isq ? exp2f(lg2 * (float)i) : exp2f(-lg2 * (float)i) * 0.08838834764831845f;
                const float fp = (float)pos;
                float o1[8], o2[8];
#pragma unroll
                for (int t = 0; t < 8; ++t) {
                    const float rev = __builtin_amdgcn_fractf(fp * fr_[t]);
                    const float cs = __builtin_amdgcn_cosf(rev) * sc, sn = __builtin_amdgcn_sinf(rev) * sc;
                    const float a = acc[ai][0][m][t >> 2][t & 3], b = acc[ai][1][m][t >> 2][t & 3];
                    o1[t] = a * cs - b * sn; o2[t] = b * cs + a * sn;
                }
                bf16_t* rowp = O + (size_t)row * NPROJ + colbase;
                u32x4 w1, w2; w1.x = cvt_pk_bf16(o1[0], o1[1]); w1.y = cvt_pk_bf16(o1[2], o1[3]); w1.z = cvt_pk_bf16(o1[4], o1[5]); w1.w = cvt_pk_bf16(o1[6], o1[7]);
                w2.x = cvt_pk_bf16(o2[0], o2[1]); w2.y = cvt_pk_bf16(o2[2], o2[3]); w2.z = cvt_pk_bf16(o2[4], o2[5]); w2.w = cvt_pk_bf16(o2[6], o2[7]);
                *(u32x4*)rowp = w1; *(u32x4*)(rowp + 64) = w2;
            }
    }
};
struct EpiGlu {
    static constexpr bool PERM = true;
    const bf16_t* Z; bf16_t* CAT; float* rowss;
    __device__ __forceinline__ void operator()(g8::Acc& acc, const g8::Unit& u, int wr, int wc, int fr, int fq) const {
        const int row0 = u.pm * 256 + wr * 64 + fr, col0 = u.pn * 256 + wc * 32 + 8 * fq;
#pragma unroll
        for (int ai = 0; ai < 2; ++ai) {
            u32x4 zz[4][2];
#pragma unroll
            for (int m = 0; m < 4; ++m)
#pragma unroll
                for (int bj = 0; bj < 2; ++bj) zz[m][bj] = *(const u32x4*)(Z + (size_t)(row0 + ai * 128 + m * 16) * 1024 + col0 + bj * 128);
#pragma unroll
            for (int m = 0; m < 4; ++m) { const int row = row0 + ai * 128 + m * 16; float ss = 0.f;
#pragma unroll
                for (int bj = 0; bj < 2; ++bj) { const f32x4 v0 = acc[ai][bj][m][0], v1 = acc[ai][bj][m][1];
                    const u32x4 z4 = zz[m][bj];
                    float o[8];
                    o[0] = bf_lo(z4.x) * sigmoidf_(v0[0]); o[1] = bf_hi(z4.x) * sigmoidf_(v0[1]); o[2] = bf_lo(z4.y) * sigmoidf_(v0[2]); o[3] = bf_hi(z4.y) * sigmoidf_(v0[3]);
                    o[4] = bf_lo(z4.z) * sigmoidf_(v1[0]); o[5] = bf_hi(z4.z) * sigmoidf_(v1[1]); o[6] = bf_lo(z4.w) * sigmoidf_(v1[2]); o[7] = bf_hi(z4.w) * sigmoidf_(v1[3]);
#pragma unroll
                    for (int j = 0; j < 8; ++j) ss += o[j] * o[j];
                    u32x4 w; w.x = cvt_pk_bf16(o[0], o[1]); w.y = cvt_pk_bf16(o[2], o[3]); w.z = cvt_pk_bf16(o[4], o[5]); w.w = cvt_pk_bf16(o[6], o[7]);
                    *(u32x4*)(CAT + (size_t)row * DM + col0 + bj * 128) = w; }
                ss += __shfl_xor(ss, 16); ss += __shfl_xor(ss, 32);
                if (fq == 0) rowss[(size_t)row * 16 + u.pn * 4 + wc] = ss; }
        }
    }
};
struct OutSched : g8::StaticOrder {
    unsigned abase, bbase;
    __device__ __forceinline__ bool next(int i, g8::Unit& u) const {
        int pm, pn; if (!tile(i >> 1, pm, pn)) return false;
        const int half = i & 1;
        u.pm = __builtin_amdgcn_readfirstlane(pm); u.pn = __builtin_amdgcn_readfirstlane(pn); u.flags = half ? 0 : 1; u.aux = half;
        u.aoff = abase + (unsigned)u.pm * 256u * 4096u + (unsigned)half * 2048u; u.boff = bbase + (unsigned)u.pn * 256u * 4096u + (unsigned)half * (16u * 32768u); return true;
    }
    __device__ __forceinline__ void aoffs(const g8::Unit&, int R0, int C0, int R1, int C1, unsigned (&v)[2][2]) const {
        v[0][0] = (unsigned)(R0 * 2048 + C0) * 2u; v[0][1] = (unsigned)(R1 * 2048 + C1) * 2u;
        v[1][0] = (unsigned)((128 + R0) * 2048 + C0) * 2u; v[1][1] = (unsigned)((128 + R1) * 2048 + C1) * 2u;
    }
};
struct EpiOut {
    static constexpr bool PERM = true;
    const float* x; const float* mod; const float* rowss1; float* rowss2; bf16_t* X1;
    __device__ __forceinline__ void operator()(g8::Acc& acc, const g8::Unit& u, int wr, int wc, int fr, int fq) const {
        const int row0 = u.pm * 256 + wr * 64 + fr;
        if (u.aux == 0) {
#pragma unroll
            for (int ai = 0; ai < 2; ++ai)
#pragma unroll
                for (int m = 0; m < 4; ++m) { const f32x4* pp = (const f32x4*)(rowss1 + (size_t)(row0 + ai * 128 + m * 16) * 16);
                    const f32x4 p0 = pp[0], p1 = pp[1], p2 = pp[2], p3 = pp[3];
                    const float tot = (((p0[0] + p0[1]) + (p0[2] + p0[3])) + ((p1[0] + p1[1]) + (p1[2] + p1[3]))) + (((p2[0] + p2[1]) + (p2[2] + p2[3])) + ((p3[0] + p3[1]) + (p3[2] + p3[3])));
                    const float r = rsqrtf(tot * (1.0f / 1024.0f) + 1e-6f);
#pragma unroll
                    for (int bj = 0; bj < 2; ++bj)
#pragma unroll
                        for (int n = 0; n < 2; ++n) acc[ai][bj][m][n] *= r; }
            return;
        }
        const int col0 = u.pn * 256 + wc * 32 + 8 * fq;
        const int b = (u.pm * 256) >> 11;
        f32x4 gt[2][2];
#pragma unroll
        for (int bj = 0; bj < 2; ++bj)
#pragma unroll
            for (int n = 0; n < 2; ++n) gt[bj][n] = *(const f32x4*)(mod + (size_t)b * NMOD + 2 * DM + col0 + bj * 128 + n * 4);
#pragma unroll
        for (int am = 0; am < 4; ++am) {
            const int ai = am >> 1, m0 = (am & 1) * 2;
            f32x4 xv[2][2][2];
#pragma unroll
            for (int mm = 0; mm < 2; ++mm)
#pragma unroll
                for (int bj = 0; bj < 2; ++bj) { const size_t off = (size_t)(row0 + ai * 128 + (m0 + mm) * 16) * DM + col0 + bj * 128; xv[mm][bj][0] = *(const f32x4*)(x + off); xv[mm][bj][1] = *(const f32x4*)(x + off + 4); }
#pragma unroll
            for (int mm = 0; mm < 2; ++mm) { const int m = m0 + mm; const int row = row0 + ai * 128 + m * 16; float ss = 0.f;
#pragma unroll
                for (int bj = 0; bj < 2; ++bj) { const size_t off = (size_t)row * DM + col0 + bj * 128;
                    const f32x4 o0 = xv[mm][bj][0] + gt[bj][0] * acc[ai][bj][m][0], o1 = xv[mm][bj][1] + gt[bj][1] * acc[ai][bj][m][1];
                    ss += (o0[0] * o0[0] + o0[1] * o0[1]) + (o0[2] * o0[2] + o0[3] * o0[3]) + (o1[0] * o1[0] + o1[1] * o1[1]) + (o1[2] * o1[2] + o1[3] * o1[3]);
                    u32x4 w; w.x = cvt_pk_bf16(o0[0], o0[1]); w.y = cvt_pk_bf16(o0[2], o0[3]); w.z = cvt_pk_bf16(o1[0], o1[1]); w.w = cvt_pk_bf16(o1[2], o1[3]);
                    *(u32x4*)(X1 + off) = w; }
                ss += __shfl_xor(ss, 16); ss += __shfl_xor(ss, 32);
                if (fq == 0) rowss2[(size_t)row * 32 + u.pn * 4 + wc] = ss; }
        }
    }
};
struct MoeSched {
    const LAS int* tinfo; const LAS int* trows; int ntiles; int G, c; const int* list; unsigned abase, bbase; int mode;
    __device__ __forceinline__ bool next(int i, g8::Unit& u) const {
        int pn, ti;
        if ((G & 63) == 0) { const int x = c & 7, r = c >> 3, per = G >> 6;
            ti = (i * 8 + x) * per + (r >> 3); pn = r & 7; }
        else { const int L = i * G + c; pn = L & 7; ti = L >> 3; }
        if (ti >= ntiles) return false;
        const int inf = __builtin_amdgcn_readfirstlane(tinfo[ti]);
        const int e = inf & 255;
        u.pm = __builtin_amdgcn_readfirstlane(ti); u.pn = pn; u.flags = 0; u.aux = inf; u.aux2 = __builtin_amdgcn_readfirstlane(trows[ti]);
        if (mode == 0) { u.aoff = abase; u.boff = bbase + (unsigned)e * (2048u * 2048u) + (unsigned)pn * (256u * 2048u); }
        else { u.aoff = abase + (unsigned)ti * (256u * 1024u); u.boff = bbase + (unsigned)e * (2048u * 1024u) + (unsigned)pn * (256u * 1024u); }
        return true;
    }
    __device__ __forceinline__ void aoffs(const g8::Unit& u, int R0, int C0, int R1, int C1, unsigned (&v)[2][2]) const {
        if (mode == 0) {
            const int e = u.aux & 255, r0 = u.aux >> 8, n = u.aux2; const int* le = list + e * 16384 + r0;
            const int i00 = R0, i01 = R1, i10 = 128 + R0, i11 = 128 + R1;
            const int t00 = (i00 < n) ? (le[i00] >> 1) : 0, t01 = (i01 < n) ? (le[i01] >> 1) : 0, t10 = (i10 < n) ? (le[i10] >> 1) : 0, t11 = (i11 < n) ? (le[i11] >> 1) : 0;
            v[0][0] = (unsigned)(t00 * 2048 + C0 * 2); v[0][1] = (unsigned)(t01 * 2048 + C1 * 2); v[1][0] = (unsigned)(t10 * 2048 + C0 * 2); v[1][1] = (unsigned)(t11 * 2048 + C1 * 2);
        } else {
            v[0][0] = (unsigned)(R0 * 1024 + C0 * 2); v[0][1] = (unsigned)(R1 * 1024 + C1 * 2);
            v[1][0] = (unsigned)((128 + R0) * 1024 + C0 * 2); v[1][1] = (unsigned)((128 + R1) * 1024 + C1 * 2);
        }
    }
};
struct EpiMoe1 {
    static constexpr bool PERM = true;
    unsigned char* HM;
    __device__ __forceinline__ void operator()(g8::Acc& acc, const g8::Unit& u, int wr, int wc, int fr, int fq) const {
        const int row0 = u.pm * 256 + wr * 64 + fr, col0 = u.pn * 128 + wc * 32 + 8 * fq;
        const float inv = 1.0f / WGU_SCALE;
#pragma unroll
        for (int ai = 0; ai < 2; ++ai)
#pragma unroll
            for (int m = 0; m < 4; ++m) { float o[8];
#pragma unroll
                for (int n = 0; n < 2; ++n)
#pragma unroll
                    for (int j = 0; j < 4; ++j) { const float gv = acc[ai][0][m][n][j] * inv, uv = acc[ai][1][m][n][j] * inv; o[n * 4 + j] = gv * sigmoidf_(gv) * uv; }
                int q0 = 0, q1 = 0;
                q0 = __builtin_amdgcn_cvt_pk_fp8_f32(o[0], o[1], q0, false); q0 = __builtin_amdgcn_cvt_pk_fp8_f32(o[2], o[3], q0, true);
                q1 = __builtin_amdgcn_cvt_pk_fp8_f32(o[4], o[5], q1, false); q1 = __builtin_amdgcn_cvt_pk_fp8_f32(o[6], o[7], q1, true);
                *(u32x2*)(HM + (size_t)(row0 + ai * 128 + m * 16) * 1024 + col0) = (u32x2){(unsigned)q0, (unsigned)q1}; }
    }
};
struct EpiMoe2 {
    static constexpr bool PERM = true;
    const int* list; const float* wgt; bf16_t* Y2;
    __device__ __forceinline__ void operator()(g8::Acc& acc, const g8::Unit& u, int wr, int wc, int fr, int fq) const {
        const int e = u.aux & 255, r0 = u.aux >> 8, n = u.aux2; const int* le = list + e * 16384 + r0;
        const int col0 = u.pn * 256 + wc * 32 + 8 * fq;
        int asg[2][4]; float w8[2][4];
#pragma unroll
        for (int ai = 0; ai < 2; ++ai)
#pragma unroll
            for (int m = 0; m < 4; ++m) { const int r = ai * 128 + wr * 64 + m * 16 + fr; asg[ai][m] = (r < n) ? le[r] : -1; }
#pragma unroll
        for (int ai = 0; ai < 2; ++ai)
#pragma unroll
            for (int m = 0; m < 4; ++m) w8[ai][m] = (asg[ai][m] >= 0) ? wgt[asg[ai][m]] * (1.0f / WD_SCALE) : 0.f;
#pragma unroll
        for (int ai = 0; ai < 2; ++ai)
#pragma unroll
            for (int m = 0; m < 4; ++m) {
                if (asg[ai][m] >= 0) { bf16_t* rowp = Y2 + (size_t)asg[ai][m] * DM + col0; const float ww = w8[ai][m];
#pragma unroll
                    for (int bj = 0; bj < 2; ++bj) { const f32x4 v0 = acc[ai][bj][m][0] * ww, v1 = acc[ai][bj][m][1] * ww;
                        u32x4 w; w.x = cvt_pk_bf16(v0[0], v0[1]); w.y = cvt_pk_bf16(v0[2], v0[3]); w.z = cvt_pk_bf16(v1[0], v1[1]); w.w = cvt_pk_bf16(v1[2], v1[3]);
                        *(u32x4*)(rowp + bj * 128) = w; } } }
    }
};

constexpr size_t WS_KV = WS_H;
__device__ __forceinline__ void ssm_item(const Params& P, LAS unsigned char* lds, int tid, int item) {
    const int g = item >> 2, bp = item & 3;
    const int wave = __builtin_amdgcn_readfirstlane(tid >> 6), lane = tid & 63, fr = lane & 15, fq = lane >> 4;
    const bf16_t* proj = (const bf16_t*)(P.ws + WS_PROJ);
    const bf16_t* Ms = (const bf16_t*)(P.ws + WS_SSMM) + (size_t)g * 131072;
    const bf16_t* TM = Ms + 32768;
    bf16_t* Zo = (bf16_t*)(P.ws + WS_Z);
    constexpr int ZS = 136, MS = 264, TS = 392;
    LAS bf16_t* ZB = (LAS bf16_t*)lds;
    LAS bf16_t* WB = (LAS bf16_t*)(lds + 256 * ZS * 2);
    const int b = 2 * bp + (wave >> 2);
    int tok0[2];
    bf16x8 Uf[2][8];
#pragma unroll
    for (int mt = 0; mt < 2; ++mt) {
        const int c = 32 * (wave & 3) + 16 * mt + fr; tok0[mt] = b * 2048 + c * 16;
#pragma unroll
        for (int ks = 0; ks < 8; ++ks) Uf[mt][ks] = *(const bf16x8*)(proj + (size_t)(tok0[mt] + 2 * ks + (fq >> 1)) * NPROJ + g * 16 + 8 * (fq & 1));
    }
#pragma unroll
    for (int i = 0; i < 8; ++i) { const int row = tid >> 2, kc = (tid & 3) + 4 * i; *(LAS u32x4*)(WB + row * MS + kc * 8) = *(const u32x4*)(Ms + row * 256 + kc * 8); }
    __syncthreads();
#pragma unroll
    for (int nt = 0; nt < 8; ++nt) {
        f32x4 a0 = {0.f, 0.f, 0.f, 0.f}, a1 = {0.f, 0.f, 0.f, 0.f};
#pragma unroll
        for (int ks = 0; ks < 8; ++ks) {
            const bf16x8 bf = *(const LAS bf16x8*)(WB + (16 * nt + fr) * MS + 32 * ks + 8 * fq);
            a0 = __builtin_amdgcn_mfma_f32_16x16x32_bf16(bf, Uf[0][ks], a0, 0, 0, 0);
            a1 = __builtin_amdgcn_mfma_f32_16x16x32_bf16(bf, Uf[1][ks], a1, 0, 0, 0);
        }
        *(LAS u32x2*)(ZB + (32 * wave + fr) * ZS + 16 * nt + 4 * fq) = (u32x2){cvt_pk_bf16(a0[0], a0[1]), cvt_pk_bf16(a0[2], a0[3])};
        *(LAS u32x2*)(ZB + (32 * wave + 16 + fr) * ZS + 16 * nt + 4 * fq) = (u32x2){cvt_pk_bf16(a1[0], a1[1]), cvt_pk_bf16(a1[2], a1[3])};
    }
    u32x4 tmr[6];
#pragma unroll
    for (int i = 0; i < 6; ++i) { const int row = tid >> 3, kc = (tid & 7) + 8 * i; tmr[i] = *(const u32x4*)(TM + (size_t)row * 384 + kc * 8); }
    __syncthreads();
    if (tid < 128) {
        const int bl = tid >> 6, p = tid & 63;
        const f32x2 al = ((const f32x2*)(P.ws + WS_SSMA))[g * 64 + p];
        float xr = 0.f, xi = 0.f;
        LAS unsigned* zw = (LAS unsigned*)ZB + (bl * 128) * (ZS / 2) + p;
        for (int c0 = 0; c0 < 128; c0 += 8) {
            unsigned zv[8];
#pragma unroll
            for (int k = 0; k < 8; ++k) zv[k] = zw[(c0 + k) * (ZS / 2)];
#pragma unroll
            for (int k = 0; k < 8; ++k) {
                zw[(c0 + k) * (ZS / 2)] = cvt_pk_bf16(xr, xi);
                const float t = al.x * xr - al.y * xi + bf_lo(zv[k]); xi = al.x * xi + al.y * xr + bf_hi(zv[k]); xr = t;
            }
        }
    }
#pragma unroll
    for (int i = 0; i < 6; ++i) { const int row = tid >> 3, kc = (tid & 7) + 8 * i; *(LAS u32x4*)(WB + row * TS + kc * 8) = tmr[i]; }
    __syncthreads();
    const LAS bf16_t* xrow = ZB + (32 * wave + fr) * ZS + 8 * fq;
    const f32x4 dv = *(const f32x4*)(P.in[12] + g * 16 + 4 * fq);
#pragma unroll
    for (int cq = 0; cq < 4; ++cq) {
        u32x2 uu[4][2];
#pragma unroll
        for (int ntl = 0; ntl < 4; ++ntl)
#pragma unroll
            for (int mt = 0; mt < 2; ++mt) uu[ntl][mt] = *(const u32x2*)(proj + (size_t)(tok0[mt] + 4 * cq + ntl) * NPROJ + g * 16 + 4 * fq);
        if (cq < 3) {
#pragma unroll
            for (int i = 0; i < 6; ++i) { const int row = tid >> 3, kc = (tid & 7) + 8 * i; tmr[i] = *(const u32x4*)(TM + (size_t)(64 * (cq + 1) + row) * 384 + kc * 8); }
        }
#pragma unroll
        for (int ntl = 0; ntl < 4; ++ntl) {
            const int nt = 4 * cq + ntl;
            f32x4 a0 = {0.f, 0.f, 0.f, 0.f}, a1 = {0.f, 0.f, 0.f, 0.f};
            const LAS bf16_t* brow = WB + (16 * ntl + fr) * TS + 8 * fq;
#pragma unroll
            for (int ks = 0; ks < 8; ++ks) {
                if (2 * ks <= nt) {
                    const bf16x8 bf = *(const LAS bf16x8*)(brow + 32 * ks);
                    a0 = __builtin_amdgcn_mfma_f32_16x16x32_bf16(bf, Uf[0][ks], a0, 0, 0, 0);
                    a1 = __builtin_amdgcn_mfma_f32_16x16x32_bf16(bf, Uf[1][ks], a1, 0, 0, 0);
                }
            }
#pragma unroll
            for (int k2 = 0; k2 < 4; ++k2) {
                const bf16x8 bf = *(const LAS bf16x8*)(brow + 256 + 32 * k2);
                const bf16x8 x0 = *(const LAS bf16x8*)(xrow + 32 * k2), x1 = *(const LAS bf16x8*)(xrow + 16 * ZS + 32 * k2);
                a0 = __builtin_amdgcn_mfma_f32_16x16x32_bf16(bf, x0, a0, 0, 0, 0);
                a1 = __builtin_amdgcn_mfma_f32_16x16x32_bf16(bf, x1, a1, 0, 0, 0);
            }
#pragma unroll
            for (int mt = 0; mt < 2; ++mt) {
                const f32x4 a = mt ? a1 : a0;
                const size_t tok = (size_t)(tok0[mt] + nt);
                const u32x2 u2 = uu[ntl][mt];
                const float y0 = a[0] + dv[0] * bf_lo(u2.x), y1 = a[1] + dv[1] * bf_hi(u2.x), y2 = a[2] + dv[2] * bf_lo(u2.y), y3 = a[3] + dv[3] * bf_hi(u2.y);
                u32x2 w; w.x = cvt_pk_bf16(gelu_tanh(y0), gelu_tanh(y1)); w.y = cvt_pk_bf16(gelu_tanh(y2), gelu_tanh(y3));
                *(u32x2*)(Zo + tok * 1024 + g * 16 + 4 * fq) = w;
            }
        }
        __syncthreads();
        if (cq < 3) {
#pragma unroll
            for (int i = 0; i < 6; ++i) { const int row = tid >> 3, kc = (tid & 7) + 8 * i; *(LAS u32x4*)(WB + row * TS + kc * 8) = tmr[i]; }
            __syncthreads();
        }
    }
}

__device__ __forceinline__ bf16x8 tr_frag(const LAS bf16_t* tile, int row0, int col0, int fr, int fq) {
    const LAS bf16_t* p = tile + (row0 + 8 * fq + (fr >> 2)) * 136 + col0 + 4 * (fr & 3);
    const bf16x4 a = __builtin_amdgcn_ds_read_tr16_b64_v4i16((LAS bf16x4*)p);
    const bf16x4 b = __builtin_amdgcn_ds_read_tr16_b64_v4i16((LAS bf16x4*)(p + 4 * 136));
    bf16x8 r; r[0] = a[0]; r[1] = a[1]; r[2] = a[2]; r[3] = a[3]; r[4] = b[0]; r[5] = b[1]; r[6] = b[2]; r[7] = b[3]; return r;
}
__device__ __forceinline__ void ret_kv_items(const Params& P, LAS unsigned char* lds, int tid, int first, int stride) {
    const int wave = __builtin_amdgcn_readfirstlane(tid >> 6), lane = tid & 63, fr = lane & 15, fq = lane >> 4;
    constexpr int RS = 136;
    LAS bf16_t* Ks = (LAS bf16_t*)lds; LAS bf16_t* Vs = Ks + 128 * RS;
    const bf16_t* proj = (const bf16_t*)(P.ws + WS_PROJ);
    bf16_t* KV = (bf16_t*)(P.ws + WS_KV);
    const int si = tid >> 2, part = tid & 3, i0 = 16 * wave;
    u32x4 kr[4], vr[4];
    int item = first;
    if (item >= 768) return;
    { const int bh = item / 12, n = item % 12; const bf16_t* pr = proj + ((size_t)(bh >> 3) * 2048 + n * 128 + si) * NPROJ + (bh & 7) * 128 + 32 * part;
#pragma unroll
      for (int j = 0; j < 4; ++j) { kr[j] = *(const u32x4*)(pr + 2048 + 8 * j); vr[j] = *(const u32x4*)(pr + 3072 + 8 * j); } }
    for (;;) {
#pragma unroll
        for (int j = 0; j < 4; ++j) { *(LAS u32x4*)(Ks + si * RS + 32 * part + 8 * j) = kr[j]; *(LAS u32x4*)(Vs + si * RS + 32 * part + 8 * j) = vr[j]; }
        __syncthreads();
        const int nxt = item + stride; const bool more = nxt < 768;
        if (more) { const int bh = nxt / 12, n = nxt % 12; const bf16_t* pr = proj + ((size_t)(bh >> 3) * 2048 + n * 128 + si) * NPROJ + (bh & 7) * 128 + 32 * part;
#pragma unroll
            for (int j = 0; j < 4; ++j) { kr[j] = *(const u32x4*)(pr + 2048 + 8 * j); vr[j] = *(const u32x4*)(pr + 3072 + 8 * j); } }
        bf16x8 Vt[4];
#pragma unroll
        for (int ks = 0; ks < 4; ++ks) Vt[ks] = tr_frag(Vs, 32 * ks, i0, fr, fq);
        const int bh = item / 12, n = item % 12;
        bf16_t* op = KV + ((size_t)(bh * 16 + n) * 128 + i0 + fr) * 128 + 4 * fq;
#pragma unroll
        for (int nt = 0; nt < 8; ++nt) {
            f32x4 a = {0.f, 0.f, 0.f, 0.f};
#pragma unroll
            for (int ks = 0; ks < 4; ++ks) { const bf16x8 kf = tr_frag(Ks, 32 * ks, 16 * nt, fr, fq); a = __builtin_amdgcn_mfma_f32_16x16x32_bf16(kf, Vt[ks], a, 0, 0, 0); }
            *(u32x2*)(op + 16 * nt) = (u32x2){cvt_pk_bf16(a[0], a[1]), cvt_pk_bf16(a[2], a[3])};
        }
        __syncthreads();
        if (!more) break;
        item = nxt;
    }
}
__device__ __forceinline__ void ret_out_item(const Params& P, LAS unsigned char* lds, int tid, int item) {
    const int bh = item >> 2, q = item & 3, b = bh >> 3, h = bh & 7;
    const int wave = __builtin_amdgcn_readfirstlane(tid >> 6), lane = tid & 63, fr = lane & 15, fq = lane >> 4;
    constexpr int RS = 136;
    LAS bf16_t* Qs = (LAS bf16_t*)lds;
    LAS bf16_t* Ks = Qs + 128 * RS;
    LAS bf16_t* Vs = Ks + 128 * RS;
    LAS bf16_t* Rs = Vs + 128 * RS;
    const bf16_t* proj = (const bf16_t*)(P.ws + WS_PROJ);
    const bf16_t* KV = (const bf16_t*)(P.ws + WS_KV);
    bf16_t* CAT = (bf16_t*)(P.ws + WS_CAT);
    const float gam = 1.0f - exp2f(-5.0f - (float)h);
    const float lg2 = log2f(gam);
    const float gC1 = exp2f(lg2 * 127.0f), gC = exp2f(lg2 * 128.0f);
    const int si = tid >> 2, part = tid & 3, i0 = 16 * wave;
    u32x4 st[12];
    { const bf16_t* pr = proj + ((size_t)b * 2048 + (4 * q) * 128 + si) * NPROJ + h * 128 + 32 * part;
#pragma unroll
      for (int j = 0; j < 4; ++j) { st[j] = *(const u32x4*)(pr + 1024 + 8 * j); st[4 + j] = *(const u32x4*)(pr + 2048 + 8 * j); st[8 + j] = *(const u32x4*)(pr + 3072 + 8 * j); } }
    f32x4 accR[8];
#pragma unroll
    for (int nt = 0; nt < 8; ++nt) accR[nt] = (f32x4){0.f, 0.f, 0.f, 0.f};
    for (int m = 0; m < 4 * q; ++m) {
        const bf16_t* tp = KV + ((size_t)(bh * 16 + m) * 128 + i0 + fr) * 128 + 4 * fq;
        u32x2 t[8];
#pragma unroll
        for (int nt = 0; nt < 8; ++nt) t[nt] = *(const u32x2*)(tp + 16 * nt);
#pragma unroll
        for (int nt = 0; nt < 8; ++nt) { const f32x4 kv = {bf_lo(t[nt].x), bf_hi(t[nt].x), bf_lo(t[nt].y), bf_hi(t[nt].y)}; accR[nt] = accR[nt] * gC + kv * gC1; }
    }
#pragma unroll
    for (int nt = 0; nt < 8; ++nt)
        *(LAS u32x2*)(Rs + (i0 + fr) * RS + 16 * nt + 4 * fq) = (u32x2){cvt_pk_bf16(accR[nt][0], accR[nt][1]), cvt_pk_bf16(accR[nt][2], accR[nt][3])};
    for (int nn = 0; nn < 4; ++nn) {
        const int n = 4 * q + nn;
#pragma unroll
        for (int j = 0; j < 4; ++j) { *(LAS u32x4*)(Qs + si * RS + 32 * part + 8 * j) = st[j]; *(LAS u32x4*)(Ks + si * RS + 32 * part + 8 * j) = st[4 + j]; *(LAS u32x4*)(Vs + si * RS + 32 * part + 8 * j) = st[8 + j]; }
        __syncthreads();
        if (nn < 3) { const bf16_t* pr = proj + ((size_t)b * 2048 + (n + 1) * 128 + si) * NPROJ + h * 128 + 32 * part;
#pragma unroll
            for (int j = 0; j < 4; ++j) { st[j] = *(const u32x4*)(pr + 1024 + 8 * j); st[4 + j] = *(const u32x4*)(pr + 2048 + 8 * j); st[8 + j] = *(const u32x4*)(pr + 3072 + 8 * j); } }
        const size_t tok = (size_t)b * 2048 + n * 128 + i0 + fr;
        u32x2 gg[8];
        { const bf16_t* gp = proj + tok * NPROJ + 4096 + h * 128 + 4 * fq;
#pragma unroll
          for (int nt = 0; nt < 8; ++nt) gg[nt] = *(const u32x2*)(gp + 16 * nt); }
        bf16x8 Qf[4];
#pragma unroll
        for (int ks = 0; ks < 4; ++ks) Qf[ks] = *(const LAS bf16x8*)(Qs + (i0 + fr) * RS + 32 * ks + 8 * fq);
        f32x4 accS[8], accO[8];
#pragma unroll
        for (int nt = 0; nt < 8; ++nt) { accS[nt] = (f32x4){0.f, 0.f, 0.f, 0.f}; accO[nt] = (f32x4){0.f, 0.f, 0.f, 0.f}; }
#pragma unroll
        for (int nt = 0; nt < 8; ++nt) {
            if (nt <= wave) {
#pragma unroll
                for (int ks = 0; ks < 4; ++ks) { const bf16x8 kf = *(const LAS bf16x8*)(Ks + (16 * nt + fr) * RS + 32 * ks + 8 * fq); accS[nt] = __builtin_amdgcn_mfma_f32_16x16x32_bf16(kf, Qf[ks], accS[nt], 0, 0, 0); }
            }
        }
        if (n > 0) {
#pragma unroll
            for (int nt = 0; nt < 8; ++nt) {
#pragma unroll
                for (int ks = 0; ks < 4; ++ks) { const bf16x8 rf = *(const LAS bf16x8*)(Rs + (16 * nt + fr) * RS + 32 * ks + 8 * fq); accO[nt] = __builtin_amdgcn_mfma_f32_16x16x32_bf16(rf, Qf[ks], accO[nt], 0, 0, 0); }
                accO[nt] *= gam;
            }
        }
#pragma unroll
        for (int nt = 0; nt < 8; ++nt) {
            const int i = i0 + fr, j0 = 16 * nt + 4 * fq;
            const float p0 = (j0 <= i) ? accS[nt][0] : 0.f, p1 = (j0 + 1 <= i) ? accS[nt][1] : 0.f, p2 = (j0 + 2 <= i) ? accS[nt][2] : 0.f, p3 = (j0 + 3 <= i) ? accS[nt][3] : 0.f;
            *(LAS u32x2*)(Qs + i * RS + j0) = (u32x2){cvt_pk_bf16(p0, p1), cvt_pk_bf16(p2, p3)};
        }
        asm volatile("" ::: "memory");
        bf16x8 Pf[4];
#pragma unroll
        for (int ks = 0; ks < 4; ++ks) Pf[ks] = *(const LAS bf16x8*)(Qs + (i0 + fr) * RS + 32 * ks + 8 * fq);
#pragma unroll
        for (int ks = 0; ks < 4; ++ks) {
            if (2 * ks <= wave) {
#pragma unroll
                for (int nt = 0; nt < 8; ++nt) { const bf16x8 vf = tr_frag(Vs, 32 * ks, 16 * nt, fr, fq); accO[nt] = __builtin_amdgcn_mfma_f32_16x16x32_bf16(vf, Pf[ks], accO[nt], 0, 0, 0); }
            }
        }
        if (nn < 3) {
            bf16x8 Vt[4];
#pragma unroll
            for (int ks = 0; ks < 4; ++ks) Vt[ks] = tr_frag(Vs, 32 * ks, i0, fr, fq);
#pragma unroll
            for (int nt = 0; nt < 8; ++nt) {
                accR[nt] *= gam;
#pragma unroll
                for (int ks = 0; ks < 4; ++ks) { const bf16x8 kf = tr_frag(Ks, 32 * ks, 16 * nt, fr, fq); accR[nt] = __builtin_amdgcn_mfma_f32_16x16x32_bf16(kf, Vt[ks], accR[nt], 0, 0, 0); }
                accR[nt] *= gC1;
            }
        }
        {
            float s = 0.f;
#pragma unroll
            for (int nt = 0; nt < 8; ++nt) s += (accO[nt][0] + accO[nt][1]) + (accO[nt][2] + accO[nt][3]);
            s += __shfl_xor(s, 16); s += __shfl_xor(s, 32);
            const float mu = s * (1.0f / 128.0f); float qv = 0.f;
#pragma unroll
            for (int nt = 0; nt < 8; ++nt) { const f32x4 d = accO[nt] - mu; qv += (d[0] * d[0] + d[1] * d[1]) + (d[2] * d[2] + d[3] * d[3]); }
            qv += __shfl_xor(qv, 16); qv += __shfl_xor(qv, 32);
            const float rstd = rsqrtf(qv * (1.0f / 128.0f) + 1e-5f);
            bf16_t* op = CAT + tok * DM + 1024 + h * 128 + 4 * fq;
#pragma unroll
            for (int nt = 0; nt < 8; ++nt) {
                const float g0 = bf_lo(gg[nt].x), g1 = bf_hi(gg[nt].x), g2 = bf_lo(gg[nt].y), g3 = bf_hi(gg[nt].y);
                const f32x4 y = (accO[nt] - mu) * rstd;
                u32x2 w; w.x = cvt_pk_bf16(y[0] * g0 * sigmoidf_(g0), y[1] * g1 * sigmoidf_(g1)); w.y = cvt_pk_bf16(y[2] * g2 * sigmoidf_(g2), y[3] * g3 * sigmoidf_(g3));
                *(u32x2*)(op + 16 * nt) = w;
            }
        }
        __syncthreads();
        if (nn < 3) {
#pragma unroll
            for (int nt = 0; nt < 8; ++nt)
                *(LAS u32x2*)(Rs + (i0 + fr) * RS + 16 * nt + 4 * fq) = (u32x2){cvt_pk_bf16(accR[nt][0], accR[nt][1]), cvt_pk_bf16(accR[nt][2], accR[nt][3])};
        }
    }
}

__device__ __forceinline__ void p6_route(const Params& P, LAS unsigned char* lds, int tid, int blk, int G) {
    const int wave = __builtin_amdgcn_readfirstlane(tid >> 6), lane = tid & 63, fr = lane & 15, fq = lane >> 4;
    LAS float* gm = (LAS float*)lds; LAS float* sh = gm + 2048; LAS float* lg = sh + 2048;
    LAS float* lgr = lg + 8 * 64 * 48;
    LAS float* r2s = lgr + 64 * 36;
    LAS int* lcnt = (LAS int*)(r2s + 64); LAS int* lbase = lcnt + 32;
    int ra_ = 0, rb_ = 0, ea_ = 0, eb_ = 0; float w1_ = 0.f, w2_ = 0.f;
    const float* mod = (const float*)(P.ws + WS_MOD);
    const bf16_t* x1 = (const bf16_t*)(P.ws + WS_X1); const float* rowss2 = (const float*)(P.ws + WS_ROWSS2);
    unsigned char* H2 = P.ws + WS_H;
    const bf16_t* WR = (const bf16_t*)(P.ws + WS_WR);
    int* cnt = (int*)(P.ws + WS_CNT); int* list = (int*)(P.ws + WS_LIST); float* wgt = (float*)(P.ws + WS_WGT);
    for (int rb = blk; rb < 256; rb += G) {
        const int b = rb >> 5;
        for (int k = tid; k < 2048; k += NTHREADS) { gm[k] = P.in[18][k] * (1.0f + mod[(size_t)b * NMOD + 4 * DM + k]); sh[k] = mod[(size_t)b * NMOD + 3 * DM + k]; }
        if (tid < 32) lcnt[tid] = 0;
        if (tid >= 64 && tid < 128) { const int r = tid - 64; float tot2 = 0.f; const f32x4* pp = (const f32x4*)(rowss2 + (size_t)(rb * 64 + r) * 32);
#pragma unroll
            for (int i = 0; i < 8; ++i) { const f32x4 v = pp[i]; tot2 += (v[0] + v[1]) + (v[2] + v[3]); }
            r2s[r] = rsqrtf(tot2 * (1.0f / 2048.0f) + 1e-6f); }
        __syncthreads();
        float r2v[4];
#pragma unroll
        for (int mt = 0; mt < 4; ++mt) r2v[mt] = r2s[16 * mt + fr];
        f32x4 acc[4][3];
#pragma unroll
        for (int mt = 0; mt < 4; ++mt)
#pragma unroll
            for (int nt = 0; nt < 3; ++nt) acc[mt][nt] = (f32x4){0.f, 0.f, 0.f, 0.f};
        const bf16_t* xb = x1 + (size_t)(rb * 64 + fr) * DM + 256 * wave + 8 * fq;
        const bf16_t* wb = WR + (size_t)fr * 2048 + 256 * wave + 8 * fq;
        unsigned char* hb = H2 + (size_t)(rb * 64 + fr) * DM + 256 * wave + 8 * fq;
        u32x4 xc[2][4], xn[2][4]; bf16x8 bc[2][3], bn[2][3];
#pragma unroll
        for (int j = 0; j < 2; ++j) {
#pragma unroll
            for (int mt = 0; mt < 4; ++mt) xc[j][mt] = *(const u32x4*)(xb + (size_t)(16 * mt) * DM + 32 * j);
#pragma unroll
            for (int nt = 0; nt < 3; ++nt) bc[j][nt] = *(const bf16x8*)(wb + (size_t)(16 * nt) * 2048 + 32 * j); }
#pragma unroll 1
        for (int qt = 0; qt < 4; ++qt) {
            const int qn = qt < 3 ? qt + 1 : 3;
#pragma unroll
            for (int j = 0; j < 2; ++j) {
#pragma unroll
                for (int mt = 0; mt < 4; ++mt) xn[j][mt] = *(const u32x4*)(xb + (size_t)(16 * mt) * DM + 32 * (2 * qn + j));
#pragma unroll
                for (int nt = 0; nt < 3; ++nt) bn[j][nt] = *(const bf16x8*)(wb + (size_t)(16 * nt) * 2048 + 32 * (2 * qn + j)); }
#pragma unroll
            for (int j = 0; j < 2; ++j) {
                const int kl = 256 * wave + 32 * (2 * qt + j) + 8 * fq;
                const f32x4 g0 = *(const LAS f32x4*)(gm + kl), g1 = *(const LAS f32x4*)(gm + kl + 4), s0 = *(const LAS f32x4*)(sh + kl), s1 = *(const LAS f32x4*)(sh + kl + 4);
#pragma unroll
                for (int mt = 0; mt < 4; ++mt) {
                    const u32x4 xw = xc[j][mt];
                    const f32x4 a = {bf_lo(xw.x), bf_hi(xw.x), bf_lo(xw.y), bf_hi(xw.y)}, c = {bf_lo(xw.z), bf_hi(xw.z), bf_lo(xw.w), bf_hi(xw.w)};
                    const f32x4 h0 = a * r2v[mt] * g0 + s0, h1 = c * r2v[mt] * g1 + s1;
                    u32x4 w; w.x = cvt_pk_bf16(h0[0], h0[1]); w.y = cvt_pk_bf16(h0[2], h0[3]); w.z = cvt_pk_bf16(h1[0], h1[1]); w.w = cvt_pk_bf16(h1[2], h1[3]);
                    int q0 = 0, q1 = 0;
                    q0 = __builtin_amdgcn_cvt_pk_fp8_f32(h0[0], h0[1], q0, false); q0 = __builtin_amdgcn_cvt_pk_fp8_f32(h0[2], h0[3], q0, true);
                    q1 = __builtin_amdgcn_cvt_pk_fp8_f32(h1[0], h1[1], q1, false); q1 = __builtin_amdgcn_cvt_pk_fp8_f32(h1[2], h1[3], q1, true);
                    *(u32x2*)(hb + (size_t)(16 * mt) * DM + 32 * (2 * qt + j)) = (u32x2){(unsigned)q0, (unsigned)q1};
                    const bf16x8 af = __builtin_bit_cast(bf16x8, w);
#pragma unroll
                    for (int nt = 0; nt < 3; ++nt) acc[mt][nt] = __builtin_amdgcn_mfma_f32_16x16x32_bf16(bc[j][nt], af, acc[mt][nt], 0, 0, 0);
                }
            }
#pragma unroll
            for (int j = 0; j < 2; ++j) {
#pragma unroll
                for (int mt = 0; mt < 4; ++mt) xc[j][mt] = xn[j][mt];
#pragma unroll
                for (int nt = 0; nt < 3; ++nt) bc[j][nt] = bn[j][nt]; }
        }
#pragma unroll
        for (int mt = 0; mt < 4; ++mt)
#pragma unroll
            for (int nt = 0; nt < 3; ++nt) *(LAS f32x4*)(lg + (wave * 64 + 16 * mt + fr) * 48 + 16 * nt + 4 * fq) = acc[mt][nt];
        __syncthreads();
        for (int o = tid; o < 64 * 36; o += NTHREADS) { const int r = o / 36, nn = o % 36; float sum = 0.f;
#pragma unroll
            for (int w = 0; w < 8; ++w) sum += lg[(w * 64 + r) * 48 + nn];
            lgr[o] = sum; }
        __syncthreads();
        if (tid < 64) {
            const int tok = rb * 64 + tid;
            float l[36];
#pragma unroll
            for (int nn = 0; nn < 36; ++nn) l[nn] = lgr[tid * 36 + nn];
            float gl[4]; int gs = 0;
#pragma unroll
            for (int j = 0; j < 4; ++j) gl[j] = l[j] + P.in[20][j];
#pragma unroll
            for (int j = 1; j < 4; ++j) if (gl[j] > gl[gs]) gs = j;
            float gmax = gl[0];
#pragma unroll
            for (int j = 1; j < 4; ++j) gmax = fmaxf(gmax, gl[j]);
            float den = 0.f;
#pragma unroll
            for (int j = 0; j < 4; ++j) den += expf(gl[j] - gmax);
            const float gw = 1.0f / den;
            float el[8];
#pragma unroll
            for (int j = 0; j < 8; ++j) { float v = 0.f;
#pragma unroll
                for (int q = 0; q < 4; ++q) v = (gs == q) ? (l[4 + q * 8 + j] + P.in[22][q * 8 + j]) : v;
                el[j] = v; }
            int j1 = 0;
#pragma unroll
            for (int j = 1; j < 8; ++j) if (el[j] > el[j1]) j1 = j;
            int j2 = (j1 == 0) ? 1 : 0;
#pragma unroll
            for (int j = 0; j < 8; ++j) if (j != j1 && j != j2 && el[j] > el[j2]) j2 = j;
            float e1 = el[0], e2 = el[0];
#pragma unroll
            for (int j = 0; j < 8; ++j) { e1 = (j == j1) ? el[j] : e1; e2 = (j == j2) ? el[j] : e2; }
            const float t2 = expf(e2 - e1), w1 = gw / (1.0f + t2), w2 = gw * t2 / (1.0f + t2);
            const int ea = gs * 8 + j1, eb = gs * 8 + j2;
            ra_ = atomicAdd((int*)&lcnt[ea], 1); rb_ = atomicAdd((int*)&lcnt[eb], 1); ea_ = ea; eb_ = eb; w1_ = w1; w2_ = w2;
        }
        __syncthreads();
        if (tid < 32) { const int c = lcnt[tid]; lbase[tid] = c > 0 ? atomicAdd(cnt + tid * 64, c) : 0; }
        __syncthreads();
        if (tid < 64) {
            const int tok = rb * 64 + tid;
            list[ea_ * 16384 + lbase[ea_] + ra_] = tok * 2; wgt[tok * 2] = w1_;
            list[eb_ * 16384 + lbase[eb_] + rb_] = tok * 2 + 1; wgt[tok * 2 + 1] = w2_;
        }
        __syncthreads();
    }
}

__device__ __forceinline__ void p9_final(const Params& P, int tid, int blk, int G) {
    const int wave = tid >> 6, lane = tid & 63;
    const float* mod = (const float*)(P.ws + WS_MOD); const bf16_t* Y2 = (const bf16_t*)(P.ws + WS_Y2); const bf16_t* X1 = (const bf16_t*)(P.ws + WS_X1);
    f32x4 gf[8];
#pragma unroll
    for (int i = 0; i < 8; ++i) gf[i] = *(const f32x4*)(P.in[26] + (i * 64 + lane) * 4);
    int row = blk * 8 + wave;
    u32x2 xw[8], ya[8], yb[8], xwn[8], yan[8], ybn[8];
    if (row < NTOK) {
#pragma unroll
        for (int i = 0; i < 8; ++i) { const int k = (i * 64 + lane) * 4; xw[i] = *(const u32x2*)(X1 + (size_t)row * DM + k); ya[i] = *(const u32x2*)(Y2 + (size_t)(2 * row) * DM + k); yb[i] = *(const u32x2*)(Y2 + (size_t)(2 * row + 1) * DM + k); }
    }
    for (; row < NTOK; row += G * 8) {
        const int b = row >> 11, rown = row + G * 8;
        if (rown < NTOK) {
#pragma unroll
            for (int i = 0; i < 8; ++i) { const int k = (i * 64 + lane) * 4; xwn[i] = *(const u32x2*)(X1 + (size_t)rown * DM + k); yan[i] = *(const u32x2*)(Y2 + (size_t)(2 * rown) * DM + k); ybn[i] = *(const u32x2*)(Y2 + (size_t)(2 * rown + 1) * DM + k); }
        }
        f32x4 v[8]; float ss = 0.f;
#pragma unroll
        for (int i = 0; i < 8; ++i) {
            const int k = (i * 64 + lane) * 4;
            const f32x4 xv = {bf_lo(xw[i].x), bf_hi(xw[i].x), bf_lo(xw[i].y), bf_hi(xw[i].y)};
            const f32x4 gt = *(const f32x4*)(mod + (size_t)b * NMOD + 5 * DM + k);
            f32x4 y; y[0] = bf_lo(ya[i].x) + bf_lo(yb[i].x); y[1] = bf_hi(ya[i].x) + bf_hi(yb[i].x); y[2] = bf_lo(ya[i].y) + bf_lo(yb[i].y); y[3] = bf_hi(ya[i].y) + bf_hi(yb[i].y);
            v[i] = xv + gt * y;
            ss += v[i][0] * v[i][0] + v[i][1] * v[i][1] + v[i][2] * v[i][2] + v[i][3] * v[i][3];
        }
        ss = wave_sum(ss);
        const float r = rsqrtf(ss * (1.0f / 2048.0f) + 1e-6f);
        float* xr = P.out + (size_t)row * DM;
#pragma unroll
        for (int i = 0; i < 8; ++i) { const int k = (i * 64 + lane) * 4; *(f32x4*)(xr + k) = v[i] * r * gf[i]; }
#pragma unroll
        for (int i = 0; i < 8; ++i) { xw[i] = xwn[i]; ya[i] = yan[i]; yb[i] = ybn[i]; }
    }
}

__global__ void __launch_bounds__(NTHREADS, 2) hymba_fwd(Params P) {
    extern __shared__ __attribute__((aligned(16))) unsigned char lds_raw[];
    LAS unsigned char* lds = (LAS unsigned char*)lds_raw;
    const int tid = threadIdx.x, blk = blockIdx.x, G = gridDim.x;
    volatile LAS unsigned* misc = (volatile LAS unsigned*)(lds + LDS_MISC);
    if (tid < 64) misc[tid] = 0u;
    __syncthreads();
    XcdBarrier bar = xcd_barrier_post((unsigned*)(P.ws + WS_BAR), misc);
    const int lo = P.ph_lo, hi = P.ph_hi;
#define IN(k) (lo <= (k) && (k) < hi)
#define SEAM(k) do { if (IN(k) && IN((k) + 1)) xcd_barrier(bar); } while (0)
    unsigned char* ws = P.ws;

#ifndef REPR
#define REPR 1
#endif
#ifndef REPS
#define REPS 1
#endif
#ifndef REP0
#define REP0 1
#endif
#ifndef REP2
#define REP2 1
#endif
#ifndef REP7
#define REP7 1
#endif
#ifndef REP8
#define REP8 1
#endif
    if (IN(0)) for (int rep0 = 0; rep0 < REP0; ++rep0) {
        for (int it = blk; it < 256; it += G) p0_adaln(P, lds, tid, it);
        for (int it = blk; it < 256; it += G) p0_ssm_mats(P, lds, tid, it);
        p0_misc(P, tid, blk, G);
        p0_convert(P, lds, tid, blk, G);
        p0_convert_fp8(P, lds, tid, blk, G, 0, 12288);
    }
    SEAM(0);
    if (IN(1)) p1_norm1(P, lds, tid, blk, G);
    SEAM(1);
    if (IN(2)) for (int rep2 = 0; rep2 < REP2; ++rep2) {
        DenseSched S; S.init(NTOK, NPROJ, G, blk); S.abase = (unsigned)WS_H; S.bbase = (unsigned)WS_WIN; S.lda = DM; S.ldb = DM;
        EpiInProj E{(bf16_t*)(ws + WS_PROJ)};
        g8::gemm_phase(lds, ws, DM / 64, DM, S, E);
    }
    SEAM(2);
    if (IN(3)) {
        for (int it = blk; it < 256; it += G) ssm_item(P, lds, tid, it);
        ret_kv_items(P, lds, tid, blk, G);
    }
    SEAM(3);
    if (IN(4)) {
        for (int it = blk; it < 256; it += G) ret_out_item(P, lds, tid, it);
        __syncthreads();
        DenseSched S; S.init(NTOK, 1024, G, blk); S.abase = (unsigned)WS_Z; S.bbase = (unsigned)WS_WGLU; S.lda = 1024; S.ldb = 1024;
        EpiGlu E{(const bf16_t*)(ws + WS_Z), (bf16_t*)(ws + WS_CAT), (float*)(ws + WS_ROWSS1)};
        g8::gemm_phase(lds, ws, 1024 / 64, 1024, S, E);
    }
    SEAM(4);
    if (IN(5)) {
        OutSched S; S.init(NTOK, DM, G, blk); S.abase = (unsigned)WS_CAT; S.bbase = (unsigned)WS_WOUT;
        EpiOut E{P.in[0], (const float*)(ws + WS_MOD), (const float*)(ws + WS_ROWSS1), (float*)(ws + WS_ROWSS2), (bf16_t*)(ws + WS_X1)};
        g8::gemm_phase(lds, ws, 1024 / 64, DM, S, E);
    }
    SEAM(5);
    if (IN(6)) p6_route(P, lds, tid, blk, G);
    SEAM(6);
    if (IN(7) || IN(8)) {
        LAS int* tinfo = (LAS int*)(lds + LDS_MISC + 256); LAS int* trows = tinfo + 192; LAS int* ntl = trows + 192;
        if (tid == 0) {
            const int* cg = (const int*)(ws + WS_CNT); int nt_ = 0;
            for (int e = 0; e < 32; ++e) { const int c = cg[e * 64], full = c >> 8, rem = c & 255;
                for (int t = 0; t < full; ++t) { tinfo[nt_] = e | ((t * 256) << 8); trows[nt_] = 256; ++nt_; }
                if (rem > 128) { tinfo[nt_] = e | ((full * 256) << 8); trows[nt_] = rem; ++nt_; } }
            for (int e = 0; e < 32; ++e) { const int c = cg[e * 64], full = c >> 8, rem = c & 255; if (rem > 64 && rem <= 128) { tinfo[nt_] = e | ((full * 256) << 8); trows[nt_] = rem; ++nt_; } }
            for (int e = 0; e < 32; ++e) { const int c = cg[e * 64], full = c >> 8, rem = c & 255; if (rem > 0 && rem <= 64) { tinfo[nt_] = e | ((full * 256) << 8); trows[nt_] = rem; ++nt_; } }
            ntl[0] = nt_;
        }
        __syncthreads();
        const int ntiles = __builtin_amdgcn_readfirstlane(ntl[0]);
        if (IN(7)) {
            MoeSched S{tinfo, trows, ntiles, G, blk, (const int*)(ws + WS_LIST), (unsigned)WS_H, (unsigned)WS_WGU, 0};
            EpiMoe1 E{ws + WS_HM};
            g8::gemm_phase<EpiMoe1, MoeSched, true, true>(lds, ws, DM / 128, DM, S, E);
        }
        SEAM(7);
        if (IN(8)) {
            MoeSched S{tinfo, trows, ntiles, G, blk, (const int*)(ws + WS_LIST), (unsigned)WS_HM, (unsigned)WS_WD, 1};
            EpiMoe2 E{(const int*)(ws + WS_LIST), (const float*)(ws + WS_WGT), (bf16_t*)(ws + WS_Y2)};
            g8::gemm_phase<EpiMoe2, MoeSched, true, true>(lds, ws, DEXP / 128, DEXP, S, E);
        }
    }
    SEAM(8);
    if (IN(9)) p9_final(P, tid, blk, G);
#undef IN
#undef SEAM
}

#ifndef N_LAUNCH_SPLIT
#define N_LAUNCH_SPLIT 0
#endif
extern "C" void kernel_launch(void* const* d_in, const int* in_sizes, int n_in, void* d_out, int out_size, void* d_ws, size_t ws_size, hipStream_t stream) {
    static int grid = 0;
    if (grid == 0) {
        if (n_in != 27 || out_size != NTOK * DM || ws_size < WS_END) { fprintf(stderr, "kernel_launch: unexpected shapes (n_in %d out %d ws %zu need %zu)\n", n_in, out_size, ws_size, (size_t)WS_END); grid = -1; return; }
        int dev = 0, cus = 0, per_cu = 0;
        if (hipGetDevice(&dev) != hipSuccess || hipDeviceGetAttribute(&cus, hipDeviceAttributeMultiprocessorCount, dev) != hipSuccess) { grid = -1; return; }
        if (hipFuncSetAttribute((const void*)hymba_fwd, hipFuncAttributeMaxDynamicSharedMemorySize, LDS_BYTES) != hipSuccess) { fprintf(stderr, "kernel_launch: hipFuncSetAttribute failed\n"); grid = -1; return; }
        if (hipOccupancyMaxActiveBlocksPerMultiprocessor(&per_cu, (const void*)hymba_fwd, NTHREADS, LDS_BYTES) != hipSuccess || per_cu < 1) { fprintf(stderr, "kernel_launch: occupancy query says %d\n", per_cu); }
        (void)hipGetLastError();
        grid = cus;
    }
    if (grid < 0) return;
    (void)hipMemsetAsync((char*)d_ws + WS_BAR, 0, 16384, stream);
    Params p{};
    for (int i = 0; i < 27; ++i) p.in[i] = (const float*)d_in[i];
    p.out = (float*)d_out; p.ws = (unsigned char*)d_ws;
#if N_LAUNCH_SPLIT
    for (int ph = 0; ph < 10; ++ph) { p.ph_lo = ph; p.ph_hi = ph + 1; hipLaunchKernelGGL(hymba_fwd, dim3(grid), dim3(NTHREADS), LDS_BYTES, stream, p); }
#else
    p.ph_lo = 0; p.ph_hi = 10;
    hipLaunchKernelGGL(hymba_fwd, dim3(grid), dim3(NTHREADS), LDS_BYTES, stream, p);
#endif
    const hipError_t le = hipPeekAtLastError();
    if (le != hipSuccess) fprintf(stderr, "kernel_launch: launch failed: %s\n", hipGetErrorName(le));
}
```

```cpp
#include <hip/hip_runtime.h>
#include <cstdio>
#include <cstdint>

#define LAS __attribute__((address_space(3)))
typedef unsigned short bf16_t;
typedef short bf16x8 __attribute__((ext_vector_type(8)));
typedef short bf16x4 __attribute__((ext_vector_type(4)));
typedef float f32x4 __attribute__((ext_vector_type(4)));
typedef float f32x2 __attribute__((ext_vector_type(2)));
typedef unsigned u32x4 __attribute__((ext_vector_type(4)));
typedef unsigned u32x2 __attribute__((ext_vector_type(2)));

constexpr int DM = 2048, NB = 8, SEQ = 2048, NTOK = NB * SEQ;
constexpr int NPROJ = 5120;
constexpr int NMOD = 6 * DM;
constexpr int NEXP = 32, DEXP = 1024;
constexpr int NTHREADS = 512;

constexpr size_t WS_BAR   = 0;
constexpr size_t WS_CNT   = 16384;
constexpr size_t WS_ROWSS1= WS_CNT + 8192;
constexpr size_t WS_ROWSS2= WS_ROWSS1 + (size_t)16384 * 16 * 4;
constexpr size_t WS_MODP  = WS_ROWSS2 + (size_t)16384 * 32 * 4;
constexpr size_t WS_MOD   = WS_MODP + (size_t)4 * 8 * NMOD * 4;
constexpr size_t WS_ROPE  = WS_MOD + (size_t)8 * NMOD * 4;
constexpr size_t WS_SSMA  = WS_ROPE + (size_t)2048 * 64 * 8;
constexpr size_t WS_WR    = WS_SSMA + (size_t)64 * 64 * 8;
constexpr size_t WS_SSMM  = WS_WR + (size_t)48 * 2048 * 2;
constexpr size_t WS_WIN   = WS_SSMM + (size_t)64 * 131072 * 2;
constexpr size_t WS_WOUT  = WS_WIN + (size_t)NPROJ * DM * 2;
constexpr size_t WS_WGLU  = WS_WOUT + (size_t)DM * DM * 2;
constexpr size_t WS_WGU   = WS_WGLU + (size_t)1024 * 1024 * 2;
constexpr size_t WS_WD    = WS_WGU + (size_t)NEXP * 2048 * 2048 * 2;
constexpr size_t WS_H     = WS_WD + (size_t)NEXP * 2048 * 1024 * 2;
constexpr size_t WS_PROJ  = WS_H + (size_t)NTOK * DM * 2;
constexpr size_t WS_Z     = WS_PROJ + (size_t)NTOK * NPROJ * 2;
constexpr size_t WS_CAT   = WS_Z + (size_t)NTOK * 1024 * 2;
constexpr size_t WS_WGT   = WS_CAT + (size_t)NTOK * DM * 2;
constexpr size_t WS_LIST  = WS_WGT + (size_t)32768 * 4;
constexpr size_t WS_SLOT  = WS_LIST + (size_t)32 * 16384 * 4;
constexpr size_t WS_X1    = WS_SLOT + (size_t)192 * 256 * 8;
constexpr size_t WS_END   = WS_X1 + (size_t)NTOK * DM * 2;
constexpr size_t WS_Y2    = WS_PROJ;
constexpr size_t WS_HM    = WS_Z;

constexpr int LDS_STAGE = 131072;
constexpr int LDS_BYTES = 147456;
constexpr int LDS_MISC  = LDS_BYTES - 2048;

struct Params { const float* in[27]; float* out; unsigned char* ws; int ph_lo, ph_hi; };

#define XB_TMO      128
#define XB_XCNT(j)  (256  + 64 * (j))
#define XB_XSUB(j)  (1280 + 64 * (j))
#define XB_XGEN(j)  (2304 + 64 * (j))
#define XB_TOP      3328
#define XB_TOPGEN   3392
#define XCD_BAR_WORDS 3456
#define XB_SPIN_CAP (1u << 22)

__device__ __forceinline__ unsigned xb_ld(unsigned* p)              { return __hip_atomic_load(p, __ATOMIC_RELAXED, __HIP_MEMORY_SCOPE_AGENT); }
__device__ __forceinline__ unsigned xb_add(unsigned* p, unsigned v) { return __hip_atomic_fetch_add(p, v, __ATOMIC_RELAXED, __HIP_MEMORY_SCOPE_AGENT); }
__device__ __forceinline__ unsigned xb_xcc_id() { return (unsigned)__builtin_amdgcn_s_getreg((3 << 11) | 20) & 0xFu; }
#define XB_SPIN(cond, bar) do { unsigned _sp = 0; while (cond) { __builtin_amdgcn_s_sleep(1); \
    if ((++_sp & 255u) == 0u) { if (xb_ld(&(bar)[XB_TMO])) break; if (_sp > XB_SPIN_CAP) { atomicAdd(&(bar)[XB_TMO], 1u); break; } } } } while (0)

struct XcdBarrier { unsigned* bar; unsigned x; volatile LAS unsigned* st; };

__device__ __forceinline__ XcdBarrier xcd_barrier_post(unsigned* bar, volatile LAS unsigned* st) {
    XcdBarrier b; b.bar = bar; b.x = xb_xcc_id(); b.st = st;
    if (threadIdx.x == 0) (void)xb_add(&bar[XB_XCNT(b.x)], 1u);
    return b;
}
__device__ __forceinline__ void xcd_barrier_complete(unsigned* bar, unsigned x, unsigned& nloc, unsigned& nx) {
    const unsigned G = gridDim.x * gridDim.y * gridDim.z;
    unsigned sum, cnt, mine, sp = 0u;
    for (;;) {
        sum = 0u; cnt = 0u; mine = 0u;
#pragma unroll
        for (unsigned j = 0; j < 16; ++j) { const unsigned c = xb_ld(&bar[XB_XCNT(j)]); sum += c; cnt += (c > 0u) ? 1u : 0u; mine = (j == x) ? c : mine; }
        if (sum == G) break;
        __builtin_amdgcn_s_sleep(1);
        if ((++sp & 255u) == 0u) { if (xb_ld(&bar[XB_TMO])) break; if (sp > XB_SPIN_CAP) { atomicAdd(&bar[XB_TMO], 1u); break; } }
    }
    nloc = mine > 0u ? mine : 1u; nx = cnt > 0u ? cnt : 1u;
}
__device__ __forceinline__ void xcd_barrier(const XcdBarrier& b) {
    asm volatile("s_waitcnt vmcnt(0)" ::: "memory");
    __syncthreads();
    if (threadIdx.x == 0) {
        unsigned* bar = b.bar;
        __builtin_amdgcn_s_waitcnt(0);
        unsigned nloc = b.st[0], nx = b.st[1];
        if (nloc == 0u) { xcd_barrier_complete(bar, b.x, nloc, nx); b.st[0] = nloc; b.st[1] = nx; }
        const unsigned old = xb_add(&bar[XB_XSUB(b.x)], 1u);
        const unsigned gen = old / nloc;
        if (old + 1u == (gen + 1u) * nloc) {
            __builtin_amdgcn_fence(__ATOMIC_RELEASE, "agent");
            asm volatile("s_waitcnt vmcnt(0)" ::: "memory");
            const unsigned og = xb_add(&bar[XB_TOP], 1u);
            const unsigned tg = og / nx;
            if (og + 1u == (tg + 1u) * nx) xb_add(&bar[XB_TOPGEN], 1u);
            else XB_SPIN(xb_ld(&bar[XB_TOPGEN]) == tg, bar);
            __builtin_amdgcn_fence(__ATOMIC_ACQUIRE, "agent");
            xb_add(&bar[XB_XGEN(b.x)], 1u);
            asm volatile("s_waitcnt vmcnt(0)" ::: "memory");
        } else {
            XB_SPIN(xb_ld(&bar[XB_XGEN(b.x)]) == gen, bar);
            __builtin_amdgcn_fence(__ATOMIC_ACQUIRE, "agent");
            asm volatile("s_waitcnt vmcnt(0)" ::: "memory");
        }
    }
    __syncthreads();
}

typedef __bf16 bf16x2_t __attribute__((ext_vector_type(2)));
__device__ __forceinline__ unsigned cvt_pk_bf16(float lo, float hi) { const f32x2 v = {lo, hi}; return __builtin_bit_cast(unsigned, __builtin_convertvector(v, bf16x2_t)); }
__device__ __forceinline__ float bf_lo(unsigned w) { return __uint_as_float(w << 16); }
__device__ __forceinline__ float bf_hi(unsigned w) { return __uint_as_float(w & 0xffff0000u); }
__device__ __forceinline__ float sigmoidf_(float x) { return 1.0f / (1.0f + __expf(-x)); }
__device__ __forceinline__ float gelu_tanh(float x) {
    const float u = 0.7978845608028654f * (x + 0.044715f * x * x * x);
    const float t = 1.0f - 2.0f / (1.0f + __expf(2.0f * u));
    return 0.5f * x * (1.0f + t);
}
__device__ __forceinline__ float wave_sum(float v) {
    v += __shfl_xor(v, 1); v += __shfl_xor(v, 2); v += __shfl_xor(v, 4); v += __shfl_xor(v, 8); v += __shfl_xor(v, 16); v += __shfl_xor(v, 32); return v;
}
__device__ __forceinline__ void sincos_d(double x, double& s, double& c) {
    const double TWO_PI = 6.283185307179586476925286766559;
    double r = x - TWO_PI * rint(x / TWO_PI);
    const double r2 = r * r;
    double ts = r, tc = 1.0; s = r; c = 1.0;
#pragma unroll 1
    for (int k = 1; k <= 14; ++k) { tc *= -r2 / (double)((2 * k - 1) * (2 * k)); ts *= -r2 / (double)((2 * k) * (2 * k + 1)); c += tc; s += ts; }
}

namespace g8 {
constexpr int BM = 256, BK = 64, HALF = 128, HTB = HALF * BK * 2, NXCD = 8, WGM = 8;
__device__ __forceinline__ int lds_byte(int r, int c) { const int st = (r >> 4) * 2 + (c >> 5), rr = r & 15, cc = c & 31, ob = rr * 64 + cc * 2; return st * 1024 + (ob ^ (((ob >> 9) & 1) << 5)); }
__device__ __forceinline__ void stage_rc(int b, int& R, int& C) { const int st = b / 1024, sb = b % 1024, swz = sb ^ (((sb >> 9) & 1) << 5); R = (st >> 1) * 16 + swz / 64; C = (st & 1) * 32 + (swz % 64) / 2; }
__device__ __forceinline__ int perm32(int rho) { const int n = rho >> 4, i = rho & 15; return 8 * (i >> 2) + 4 * n + (i & 3); }

struct Unit { unsigned aoff, boff; int pm, pn, flags, aux, aux2; };
typedef f32x4 Acc[2][2][4][2];

struct StaticOrder {
    int nM, nN, nwg, G, c;
    __device__ void init(int M, int N, int G_, int c_) { nM = M / BM; nN = N / BM; nwg = nM * nN; G = G_; c = c_; }
    __device__ __forceinline__ bool tile(int i, int& pm, int& pn) const {
        const long L = (long)i * G + c; if (L >= nwg) return false;
        int wgid = (int)L; { const int q = nwg / NXCD, r = nwg % NXCD, xcd = wgid % NXCD, off = wgid / NXCD; wgid = (xcd < r ? xcd * (q + 1) : r * (q + 1) + (xcd - r) * q) + off; }
        const int nig = WGM * nN, gid = wgid / nig, fm = gid * WGM, gsz = (nM - fm) < WGM ? (nM - fm) : WGM;
        pm = fm + ((wgid % nig) % gsz); pn = (wgid % nig) / gsz; return true;
    }
};

typedef long l64x2 __attribute__((ext_vector_type(2)));
template <class Epi, class Sched, bool SKIP = false, bool FP8 = false>
__device__ __forceinline__ void gemm_phase(LAS unsigned char* lds, const unsigned char* ws, const int nt, const int ldb  , const Sched& S, const Epi& E) {
    const int tid = threadIdx.x, wid = __builtin_amdgcn_readfirstlane(tid >> 6), lane = tid & 63, wr = wid >> 2, wc = wid & 3, fr = lane & 15, fq = lane >> 4;
    int R0, C0, R1, C1; stage_rc(tid * 16, R0, C0); stage_rc(tid * 16 + 8192, R1, C1);
    unsigned voffB[2];
    { const int Rb0 = Epi::PERM ? ((R0 & ~31) + perm32(R0 & 31)) : R0, Rb1 = Epi::PERM ? ((R1 & ~31) + perm32(R1 & 31)) : R1;
      voffB[0] = (unsigned)(Rb0 * 64 + C0) * 2u; voffB[1] = (unsigned)(Rb1 * 64 + C1) * 2u; }
    const unsigned kstep = (unsigned)(BK * 2);
    const unsigned kstepB = 256u * 64u * 2u;
    const unsigned hstepB = (unsigned)HALF * 64u * 2u;
    const unsigned ldsw = (unsigned)wid * 1024u;
    const int aoff = lds_byte(wr * 64 + fr, fq * 8), boff = lds_byte(wc * 32 + fr, fq * 8);
#define G8_SA(b, h) (((b) * 2 + (h)) * HTB)
#define G8_SB(b, h) ((4 + (b) * 2 + (h)) * HTB)
#define G8_STAGE(bufoff, gbase, v0, v1) do { \
        __builtin_amdgcn_global_load_lds((const unsigned*)((gbase) + (v0)), (LAS unsigned*)(lds + (bufoff) + ldsw), 16, 0, 0); \
        __builtin_amdgcn_global_load_lds((const unsigned*)((gbase) + (v1)), (LAS unsigned*)(lds + (bufoff) + ldsw + 8192), 16, 0, 0); } while (0)
#define G8_LDA(dst, b, h) do { _Pragma("unroll") for (int m = 0; m < 4; ++m) _Pragma("unroll") for (int k = 0; k < 2; ++k) dst[m][k] = *(const LAS bf16x8*)(lds + G8_SA(b, h) + aoff + m * 2048 + k * 1024); } while (0)
#define G8_LDB(dst, b, h) do { _Pragma("unroll") for (int n = 0; n < 2; ++n) _Pragma("unroll") for (int k = 0; k < 2; ++k) dst[n][k] = *(const LAS bf16x8*)(lds + G8_SB(b, h) + boff + n * 2048 + k * 1024); } while (0)
#define G8_MMA(ai, bj, At, Bt) do { __builtin_amdgcn_s_setprio(1); _Pragma("unroll") for (int m = 0; m < 4; ++m) _Pragma("unroll") for (int n = 0; n < 2; ++n) _Pragma("unroll") for (int k = 0; k < 2; ++k) { \
        if constexpr (FP8) { const l64x2 a2 = __builtin_bit_cast(l64x2, At[m][k]), b2 = __builtin_bit_cast(l64x2, Bt[n][k]); \
            acc[ai][bj][m][n] = __builtin_amdgcn_mfma_f32_16x16x32_fp8_fp8(b2[0], a2[0], acc[ai][bj][m][n], 0, 0, 0); \
            acc[ai][bj][m][n] = __builtin_amdgcn_mfma_f32_16x16x32_fp8_fp8(b2[1], a2[1], acc[ai][bj][m][n], 0, 0, 0); } \
        else acc[ai][bj][m][n] = __builtin_amdgcn_mfma_f32_16x16x32_bf16(Bt[n][k], At[m][k], acc[ai][bj][m][n], 0, 0, 0); } __builtin_amdgcn_s_setprio(0); } while (0)
#define G8_WAIT_V(n) asm volatile("s_waitcnt vmcnt(" #n ")" ::: "memory")
#define G8_WAIT_L(n) asm volatile("s_waitcnt lgkmcnt(" #n ")" ::: "memory")
#define G8_BAR __builtin_amdgcn_s_barrier()
#define G8_SCHED __builtin_amdgcn_sched_barrier(0)
    Unit cur, nxt; int ui = 0;
    if (!S.next(0, cur)) return;
    Acc acc;
#pragma unroll
    for (int a = 0; a < 2; ++a)
#pragma unroll
        for (int b = 0; b < 2; ++b)
#pragma unroll
            for (int m = 0; m < 4; ++m)
#pragma unroll
                for (int n = 0; n < 2; ++n) acc[a][b][m][n] = (f32x4){0.f, 0.f, 0.f, 0.f};
    bf16x8 At[4][2], B0[2][2], B1[2][2];
    unsigned cv[2][2], nv[2][2];
    S.aoffs(cur, R0, C0, R1, C1, cv);
    const unsigned char* cA = ws + cur.aoff; const unsigned char* cB = ws + cur.boff;
    G8_STAGE(G8_SB(0, 0), cB, voffB[0], voffB[1]); G8_STAGE(G8_SA(0, 0), cA, cv[0][0], cv[0][1]);
    G8_STAGE(G8_SB(0, 1), cB + hstepB, voffB[0], voffB[1]); G8_STAGE(G8_SA(0, 1), cA, cv[1][0], cv[1][1]);
    if (wr == 1) G8_BAR;
    G8_WAIT_V(4); G8_BAR;
    G8_STAGE(G8_SB(1, 0), cB + kstepB, voffB[0], voffB[1]); G8_STAGE(G8_SA(1, 0), cA + kstep, cv[0][0], cv[0][1]);
    G8_STAGE(G8_SB(1, 1), cB + hstepB + kstepB, voffB[0], voffB[1]);
    G8_WAIT_V(6); G8_BAR;
    for (;;) {
        const bool has_next = S.next(ui + 1, nxt);
        if (has_next) S.aoffs(nxt, R0, C0, R1, C1, nv);
        else { nv[0][0] = cv[0][0]; nv[0][1] = cv[0][1]; nv[1][0] = cv[1][0]; nv[1][1] = cv[1][1]; }
        const unsigned char* nA = has_next ? ws + nxt.aoff : cA; const unsigned char* nB = has_next ? ws + nxt.boff : cB;
        const int vrows = SKIP ? cur.aux2 : 256;
        const bool do0 = !SKIP || vrows > 64 || wr == 0, do1 = !SKIP || vrows > 128;
        for (int t = 0; t < nt; t += 2) {
            const bool last = (t == nt - 2);
            const unsigned char* a1 = cA + (size_t)(t + 1) * kstep;
            const unsigned char* a2 = last ? nA : cA + (size_t)(t + 2) * kstep; const unsigned char* b2 = last ? nB : cB + (size_t)(t + 2) * kstepB;
            const unsigned char* a3 = a2 + kstep; const unsigned char* b3 = b2 + kstepB;
            const unsigned o00 = last ? nv[0][0] : cv[0][0], o01 = last ? nv[0][1] : cv[0][1], o10 = last ? nv[1][0] : cv[1][0], o11 = last ? nv[1][1] : cv[1][1];
            G8_LDB(B0, 0, 0); G8_SCHED; G8_LDA(At, 0, 0); G8_STAGE(G8_SA(1, 1), a1, cv[1][0], cv[1][1]);
            G8_WAIT_L(8); G8_BAR; G8_WAIT_L(0); if (do0) G8_MMA(0, 0, At, B0); G8_BAR; G8_SCHED;
            G8_LDB(B1, 0, 1); G8_STAGE(G8_SB(0, 0), b2, voffB[0], voffB[1]);
            G8_BAR; G8_WAIT_L(0); if (do0) G8_MMA(0, 1, At, B1); G8_BAR;
            G8_LDA(At, 0, 1); G8_STAGE(G8_SA(0, 0), a2, o00, o01);
            G8_BAR; G8_WAIT_L(0); if (do1) G8_MMA(1, 0, At, B0); G8_BAR; G8_SCHED;
            G8_STAGE(G8_SB(0, 1), b2 + hstepB, voffB[0], voffB[1]);
            G8_WAIT_V(6); G8_BAR; if (do1) G8_MMA(1, 1, At, B1); G8_BAR;
            G8_LDB(B0, 1, 0); G8_SCHED; G8_LDA(At, 1, 0); G8_STAGE(G8_SA(0, 1), a2, o10, o11);
            G8_WAIT_L(8); G8_BAR; G8_WAIT_L(0); if (do0) G8_MMA(0, 0, At, B0); G8_BAR; G8_SCHED;
            G8_LDB(B1, 1, 1); G8_STAGE(G8_SB(1, 0), b3, voffB[0], voffB[1]);
            G8_BAR; G8_WAIT_L(0); if (do0) G8_MMA(0, 1, At, B1); G8_BAR;
            G8_LDA(At, 1, 1); G8_STAGE(G8_SA(1, 0), a3, o00, o01);
            G8_BAR; G8_WAIT_L(0); if (do1) G8_MMA(1, 0, At, B0); G8_BAR; G8_SCHED;
            G8_STAGE(G8_SB(1, 1), b3 + hstepB, voffB[0], voffB[1]);
            G8_WAIT_V(6); G8_BAR; if (do1) G8_MMA(1, 1, At, B1); G8_BAR;
        }
        E(acc, cur, wr, wc, fr, fq);
        if (!has_next) break;
        if (!(cur.flags & 1)) {
#pragma unroll
            for (int a = 0; a < 2; ++a)
#pragma unroll
                for (int b = 0; b < 2; ++b)
#pragma unroll
                    for (int m = 0; m < 4; ++m)
#pragma unroll
                        for (int n = 0; n < 2; ++n) acc[a][b][m][n] = (f32x4){0.f, 0.f, 0.f, 0.f};
        }
        cur = nxt; cA = nA; cB = nB; ++ui;
        cv[0][0] = nv[0][0]; cv[0][1] = nv[0][1]; cv[1][0] = nv[1][0]; cv[1][1] = nv[1][1];
    }
    G8_WAIT_V(0);
    if (wr == 0) G8_BAR;
    G8_BAR;
#undef G8_SA
#undef G8_SB
#undef G8_STAGE
#undef G8_LDA
#undef G8_LDB
#undef G8_MMA
#undef G8_WAIT_V
#undef G8_WAIT_L
#undef G8_BAR
#undef G8_SCHED
}
}

__device__ __forceinline__ void p0_adaln(const Params& P, LAS unsigned char* lds, int tid, int item) {
    const int ks = item & 3, nc = item >> 2;
    LAS float* sc = (LAS float*)lds;
    LAS float* red = (LAS float*)(lds + 16384);
    const float* c = P.in[1];
    for (int i = tid; i < 4096; i += NTHREADS) { const int kl = i >> 3, b = i & 7; const float v = c[b * 2048 + ks * 512 + kl]; sc[i] = v / (1.0f + expf(-v)); }
    __syncthreads();
    if (tid < 384) {
        const int nq = tid % 48, kg = tid / 48;
        const float* W = P.in[2] + (size_t)(ks * 512 + kg * 64) * NMOD + nc * 192 + nq * 4;
        f32x4 acc[8];
#pragma unroll
        for (int b = 0; b < 8; ++b) acc[b] = (f32x4){0.f, 0.f, 0.f, 0.f};
#pragma unroll 16
        for (int kk = 0; kk < 64; ++kk) {
            const f32x4 w = *(const f32x4*)(W + (size_t)kk * NMOD);
            const f32x4 s0 = *(const LAS f32x4*)(sc + (kg * 64 + kk) * 8), s1 = *(const LAS f32x4*)(sc + (kg * 64 + kk) * 8 + 4);
            acc[0] += w * s0[0]; acc[1] += w * s0[1]; acc[2] += w * s0[2]; acc[3] += w * s0[3];
            acc[4] += w * s1[0]; acc[5] += w * s1[1]; acc[6] += w * s1[2]; acc[7] += w * s1[3];
        }
#pragma unroll
        for (int b = 0; b < 8; ++b) *(LAS f32x4*)(red + (kg * 8 + b) * 192 + nq * 4) = acc[b];
    }
    __syncthreads();
    float* modp = (float*)(P.ws + WS_MODP);
    for (int i = tid; i < 8 * 192; i += NTHREADS) {
        const int b = i / 192, n = i % 192; float s = 0.f;
#pragma unroll
        for (int kg = 0; kg < 8; ++kg) s += red[(kg * 8 + b) * 192 + n];
        modp[(size_t)(ks * 8 + b) * NMOD + nc * 192 + n] = s;
    }
    __syncthreads();
}

struct CvtUnit { const float* src; bf16_t* dst; int Nd, Kd, k0, n0, nmode; const float* s0; const float* s1; };
constexpr int CVT_UNITS = 640 + 256 + 64;
__device__ __forceinline__ void cvt_unit_decode(const Params& P, int L, CvtUnit& u) {
    u.s0 = nullptr; u.s1 = nullptr; u.nmode = 0;
    if (L < 640) { u.src = P.in[5]; u.dst = (bf16_t*)(P.ws + WS_WIN); u.Kd = 2048; u.Nd = 5120; u.k0 = (L / 20) * 64; u.n0 = (L % 20) * 256; u.nmode = 3; return; }
    L -= 640;
    if (L < 256) { u.src = P.in[17]; u.dst = (bf16_t*)(P.ws + WS_WOUT); u.Kd = 2048; u.Nd = 2048; u.k0 = (L / 8) * 64; u.n0 = (L % 8) * 256; u.s0 = P.in[15]; u.s1 = P.in[16]; return; }
    L -= 256;
    if (L < 64) { u.src = P.in[14]; u.dst = (bf16_t*)(P.ws + WS_WGLU); u.Kd = 1024; u.Nd = 1024; u.k0 = (L / 4) * 64; u.n0 = (L % 4) * 256; return; }
    L -= 64;
    if (L < 4096) { const int e = L >> 7, r = L & 127; u.src = P.in[23] + (size_t)e * 2048 * 1024; u.dst = (bf16_t*)(P.ws + WS_WGU) + (size_t)e * 2048 * 2048; u.Kd = 2048; u.Nd = 1024; u.k0 = (r >> 2) * 64; u.n0 = (r & 3) * 256; u.nmode = 1; return; }
    L -= 4096;
    if (L < 4096) { const int e = L >> 7, r = L & 127; u.src = P.in[24] + (size_t)e * 2048 * 1024; u.dst = (bf16_t*)(P.ws + WS_WGU) + (size_t)e * 2048 * 2048; u.Kd = 2048; u.Nd = 1024; u.k0 = (r >> 2) * 64; u.n0 = (r & 3) * 256; u.nmode = 2; return; }
    L -= 4096;
    { const int e = L >> 7, r = L & 127; u.src = P.in[25] + (size_t)e * 1024 * 2048; u.dst = (bf16_t*)(P.ws + WS_WD) + (size_t)e * 2048 * 1024; u.Kd = 1024; u.Nd = 2048; u.k0 = (r >> 3) * 64; u.n0 = (r & 7) * 256; }
}
__device__ __forceinline__ void cvt_load(const CvtUnit& u, int tid, f32x4 (&r)[8]) {
    const int kp = tid >> 4, nq = tid & 15;
    const float* p = u.src + (size_t)(u.k0 + 2 * kp) * u.Nd + u.n0 + nq * 4;
#pragma unroll
    for (int s = 0; s < 4; ++s) { r[2 * s] = *(const f32x4*)(p + s * 64); r[2 * s + 1] = *(const f32x4*)(p + u.Nd + s * 64); }
    if (u.s0) {
        const int k = u.k0 + 2 * kp;
        const float a = (k < 1024) ? u.s0[k] : u.s1[k - 1024], b = (k + 1 < 1024) ? u.s0[k + 1] : u.s1[k + 1 - 1024];
#pragma unroll
        for (int s = 0; s < 4; ++s) { r[2 * s] *= a; r[2 * s + 1] *= b; }
    }
}
__device__ __forceinline__ void cvt_to_lds(LAS unsigned* tile, const f32x4 (&r)[8], int kp, int nq) {
#pragma unroll
    for (int s = 0; s < 4; ++s)
#pragma unroll
        for (int j = 0; j < 4; ++j) tile[s * 2112 + (nq * 4 + j) * 33 + kp] = cvt_pk_bf16(r[2 * s][j], r[2 * s + 1][j]);
}
__device__ __forceinline__ void cvt_store(const LAS unsigned* tile, const CvtUnit& u, int nl, int kq) {
#pragma unroll
    for (int s = 0; s < 4; ++s) {
        u32x4 w; w.x = tile[s * 2112 + nl * 33 + kq * 4]; w.y = tile[s * 2112 + nl * 33 + kq * 4 + 1]; w.z = tile[s * 2112 + nl * 33 + kq * 4 + 2]; w.w = tile[s * 2112 + nl * 33 + kq * 4 + 3];
        const int n = u.n0 + s * 64 + nl;
        int np = n;
        if (u.nmode == 1 || u.nmode == 2) np = (n >> 7) * 256 + (n & 127) + (u.nmode == 2 ? 128 : 0);
        else if (u.nmode == 3 && n >= 1024 && n < 3072) { const int reg = (n >= 2048) ? 2048 : 1024, nr = n - reg;
            np = reg + ((nr >> 8) << 8) + (((nr >> 6) & 1) << 7) + (((nr >> 7) & 1) << 6) + (nr & 63); }
        *(u32x4*)(u.dst + (size_t)(np >> 8) * ((size_t)u.Kd * 256) + (size_t)(u.k0 >> 6) * 16384 + (np & 255) * 64 + kq * 8) = w;
    }
}
__device__ __forceinline__ void p0_convert(const Params& P, LAS unsigned char* lds, int tid, int blk, int G) {
    LAS unsigned* tileA = (LAS unsigned*)lds;
    LAS unsigned* tileB = tileA + 4 * 2112;
    const int kp = tid >> 4, nq = tid & 15, nl = tid >> 3, kq = tid & 7;
    CvtUnit uA, uB, nA, nB; f32x4 rA[8], rB[8];
    int L = blk;
    if (L >= CVT_UNITS) return;
    bool hasB = (L + G) < CVT_UNITS;
    cvt_unit_decode(P, L, uA); cvt_load(uA, tid, rA);
    if (hasB) { cvt_unit_decode(P, L + G, uB); cvt_load(uB, tid, rB); }
    for (;;) {
        cvt_to_lds(tileA, rA, kp, nq);
        if (hasB) cvt_to_lds(tileB, rB, kp, nq);
        __syncthreads();
        const int Ln = L + 2 * G; const bool moreA = Ln < CVT_UNITS, moreB = (Ln + G) < CVT_UNITS;
        if (moreA) { cvt_unit_decode(P, Ln, nA); cvt_load(nA, tid, rA); }
        if (moreB) { cvt_unit_decode(P, Ln + G, nB); cvt_load(nB, tid, rB); }
        cvt_store(tileA, uA, nl, kq);
        if (hasB) cvt_store(tileB, uB, nl, kq);
        __syncthreads();
        if (!moreA) break;
        uA = nA; uB = nB; hasB = moreB; L = Ln;
    }
}

struct Cvt8Unit { const float* src; unsigned char* dst; int Nd, Kd, k0, n0, nmode; float scale; };
constexpr float WGU_SCALE = 64.0f, WD_SCALE = 32.0f;
__device__ __forceinline__ void cvt8_decode(const Params& P, int L, Cvt8Unit& u) {
    if (L < 8192) { const int up = L >= 4096; const int r_ = L & 4095; const int e = r_ >> 7, r = r_ & 127;
        u.src = P.in[up ? 24 : 23] + (size_t)e * 2048 * 1024; u.dst = P.ws + WS_WGU + (size_t)e * 2048 * 2048; u.Kd = 2048; u.Nd = 1024; u.k0 = (r >> 3) * 128; u.n0 = (r & 7) * 128; u.nmode = up ? 2 : 1; u.scale = WGU_SCALE; return; }
    L -= 8192;
    { const int e = L >> 7, r = L & 127; u.src = P.in[25] + (size_t)e * 1024 * 2048; u.dst = P.ws + WS_WD + (size_t)e * 2048 * 1024; u.Kd = 1024; u.Nd = 2048; u.k0 = (r >> 4) * 128; u.n0 = (r & 15) * 128; u.nmode = 0; u.scale = WD_SCALE; }
}
__device__ __forceinline__ void cvt8_load(const Cvt8Unit& u, int tid, f32x4 (&r)[8]) {
    const int kg = tid >> 5, nq = tid & 31;
    const float* p = u.src + (size_t)(u.k0 + 8 * kg) * u.Nd + u.n0 + nq * 4;
#pragma unroll
    for (int kk = 0; kk < 8; ++kk) r[kk] = *(const f32x4*)(p + (size_t)kk * u.Nd);
}
__device__ __forceinline__ void cvt8_to_lds(LAS unsigned* tile, const f32x4 (&r)[8], float sc, int tid) {
    const int kg = tid >> 5, nq = tid & 31;
    u32x4 w0, w1;
#pragma unroll
    for (int j = 0; j < 4; ++j) {
        int a = 0, b = 0;
        a = __builtin_amdgcn_cvt_pk_fp8_f32(r[0][j] * sc, r[1][j] * sc, a, false); a = __builtin_amdgcn_cvt_pk_fp8_f32(r[2][j] * sc, r[3][j] * sc, a, true);
        b = __builtin_amdgcn_cvt_pk_fp8_f32(r[4][j] * sc, r[5][j] * sc, b, false); b = __builtin_amdgcn_cvt_pk_fp8_f32(r[6][j] * sc, r[7][j] * sc, b, true);
        w0[j] = (unsigned)a; w1[j] = (unsigned)b;
    }
    *(LAS u32x4*)(tile + (2 * kg) * 132 + nq * 4) = w0;
    *(LAS u32x4*)(tile + (2 * kg + 1) * 132 + nq * 4) = w1;
}
__device__ __forceinline__ void cvt8_store(const LAS unsigned* tile, const Cvt8Unit& u, int tid) {
    const int nl = tid >> 2, q = tid & 3;
    u32x4 w0, w1;
    w0.x = tile[(8 * q + 0) * 132 + nl]; w0.y = tile[(8 * q + 1) * 132 + nl]; w0.z = tile[(8 * q + 2) * 132 + nl]; w0.w = tile[(8 * q + 3) * 132 + nl];
    w1.x = tile[(8 * q + 4) * 132 + nl]; w1.y = tile[(8 * q + 5) * 132 + nl]; w1.z = tile[(8 * q + 6) * 132 + nl]; w1.w = tile[(8 * q + 7) * 132 + nl];
    const int n = u.n0 + nl;
    int np = n;
    if (u.nmode == 1 || u.nmode == 2) np = (n >> 7) * 256 + (n & 127) + (u.nmode == 2 ? 128 : 0);
    unsigned char* d = u.dst + (size_t)(np >> 8) * ((size_t)u.Kd * 256) + (size_t)(u.k0 >> 7) * 32768 + (np & 255) * 128 + q * 32;
    *(u32x4*)d = w0; *(u32x4*)(d + 16) = w1;
}
__device__ __forceinline__ void p0_convert_fp8(const Params& P, LAS unsigned char* lds, int tid, int blk, int G, const int Lbeg, const int Lend) {
    LAS unsigned* tileA = (LAS unsigned*)lds;
    LAS unsigned* tileB = tileA + 32 * 132;
    Cvt8Unit uA, uB, nA, nB; f32x4 rA[8], rB[8];
    int L = Lbeg + blk;
    if (L >= Lend) return;
    bool hasB = (L + G) < Lend;
    cvt8_decode(P, L, uA); cvt8_load(uA, tid, rA);
    if (hasB) { cvt8_decode(P, L + G, uB); cvt8_load(uB, tid, rB); }
    for (;;) {
        cvt8_to_lds(tileA, rA, uA.scale, tid);
        if (hasB) cvt8_to_lds(tileB, rB, uB.scale, tid);
        __syncthreads();
        const int Ln = L + 2 * G; const bool moreA = Ln < Lend, moreB = (Ln + G) < Lend;
        if (moreA) { cvt8_decode(P, Ln, nA); cvt8_load(nA, tid, rA); }
        if (moreB) { cvt8_decode(P, Ln + G, nB); cvt8_load(nB, tid, rB); }
        cvt8_store(tileA, uA, tid);
        if (hasB) cvt8_store(tileB, uB, tid);
        __syncthreads();
        if (!moreA) break;
        uA = nA; uB = nB; hasB = moreB; L = Ln;
    }
}

__device__ __forceinline__ void p0_ssm_mats(const Params& P, LAS unsigned char* lds, int tid, int item) {
    const int g = item & 63, q = item >> 6;
    LAS f32x2* pw = (LAS f32x2*)lds;
    LAS f32x2* Bb = pw + 17 * 64;
    LAS f32x2* Cc = Bb + 64 * 16;
    LAS float* Kt = (LAS float*)(Cc + 16 * 64);
    if (tid < 64) {
        const int p = tid;
        const float dt = expf(P.in[13][g]);
        const float are = P.in[6][g * 64 + p], aim = P.in[7][g * 64 + p];
        const float mag = expf(dt * are);
        double sd, cd; sincos_d((double)(dt * aim), sd, cd);
        const float abr = mag * (float)cd, abi = mag * (float)sd;
        const float inv = 1.0f / (are * are + aim * aim);
        const float nre = abr - 1.0f;
        const float fre = (nre * are + abi * aim) * inv, fim = (abi * are - nre * aim) * inv;
        float pr = 1.0f, pi = 0.0f;
        for (int n = 0; n <= 16; ++n) { pw[n * 64 + p] = (f32x2){pr, pi}; const float t = pr * abr - pi * abi; pi = pr * abi + pi * abr; pr = t; }
        for (int h = 0; h < 16; ++h) {
            const float br = P.in[8][(g * 64 + p) * 16 + h], bi = P.in[9][(g * 64 + p) * 16 + h];
            Bb[p * 16 + h] = (f32x2){fre * br - fim * bi, fre * bi + fim * br};
            Cc[h * 64 + p] = (f32x2){P.in[10][(g * 16 + h) * 64 + p], P.in[11][(g * 16 + h) * 64 + p]};
        }
        if (q == 0) { f32x2* AL = (f32x2*)(P.ws + WS_SSMA); const f32x2 v = pw[16 * 64 + p]; AL[g * 64 + p] = v; }
    }
    __syncthreads();
    for (int o = tid; o < 4096; o += NTHREADS) {
        const int tau = o >> 8, ho = (o >> 4) & 15, hi = o & 15; float s = 0.f;
        for (int p = 0; p < 64; ++p) {
            const f32x2 c = Cc[ho * 64 + p], a = pw[tau * 64 + p], b = Bb[p * 16 + hi];
            const float cr = c.x * a.x - c.y * a.y, ci = c.x * a.y + c.y * a.x;
            s += cr * b.x - ci * b.y;
        }
        Kt[o] = s;
    }
    __syncthreads();
    bf16_t* Ms = (bf16_t*)(P.ws + WS_SSMM) + (size_t)g * 131072;
    bf16_t* TM = Ms + 32768;
    for (int o = tid; o < 32 * 128; o += NTHREADS) {
        const int row = 32 * q + (o >> 7), col = (o & 127) * 2;
        const int p = row >> 1, j = col >> 4, hi = col & 15;
        const f32x2 a = pw[(15 - j) * 64 + p], b0 = Bb[p * 16 + hi], b1 = Bb[p * 16 + hi + 1];
        float v0, v1;
        if ((row & 1) == 0) { v0 = a.x * b0.x - a.y * b0.y; v1 = a.x * b1.x - a.y * b1.y; } else { v0 = a.x * b0.y + a.y * b0.x; v1 = a.x * b1.y + a.y * b1.x; }
        *(unsigned*)(Ms + (size_t)row * 256 + col) = cvt_pk_bf16(v0, v1);
    }
    for (int o = tid; o < 64 * 192; o += NTHREADS) {
        const int row = 64 * q + o / 192, col = (o % 192) * 2;
        const int i = row >> 4, ho = row & 15; float v0, v1;
        if (col < 256) { const int j = col >> 4, hi = col & 15; if (j <= i) { v0 = Kt[((i - j) * 16 + ho) * 16 + hi]; v1 = Kt[((i - j) * 16 + ho) * 16 + hi + 1]; } else { v0 = 0.f; v1 = 0.f; } }
        else { const int p0 = (col - 256) >> 1;
            const f32x2 c0 = Cc[ho * 64 + p0], a0 = pw[(i + 1) * 64 + p0];
            v0 = c0.x * a0.x - c0.y * a0.y; v1 = -(c0.x * a0.y + c0.y * a0.x); }
        *(unsigned*)(TM + (size_t)row * 384 + col) = cvt_pk_bf16(v0, v1);
    }
    __syncthreads();
}

__device__ __forceinline__ void p0_misc(const Params& P, int tid, int blk, int G) {
    bf16_t* wr = (bf16_t*)(P.ws + WS_WR);
    for (int i = blk * NTHREADS + tid; i < 48 * 2048; i += G * NTHREADS) {
        const int n = i >> 11, k = i & 2047; float v = 0.f;
        if (n < 4) v = P.in[19][k * 4 + n]; else if (n < 36) v = P.in[21][k * 32 + (n - 4)];
        wr[i] = (bf16_t)(cvt_pk_bf16(v, 0.f) & 0xffffu);
    }
    if (blk == 0) for (int i = tid; i < 2048; i += NTHREADS) ((int*)(P.ws + WS_CNT))[i] = 0;
}

__device__ __forceinline__ void p1_norm1(const Params& P, LAS unsigned char* lds, int tid, int blk, int G) {
    const float* modp = (const float*)(P.ws + WS_MODP); const float* bada = P.in[3];
    float* mod = (float*)(P.ws + WS_MOD);
    for (int i = blk * NTHREADS + tid; i < 8 * NMOD; i += G * NTHREADS) {
        const int b = i / NMOD, j = i % NMOD;
        mod[i] = bada[j] + ((modp[(size_t)(0 * 8 + b) * NMOD + j] + modp[(size_t)(1 * 8 + b) * NMOD + j]) + (modp[(size_t)(2 * 8 + b) * NMOD + j] + modp[(size_t)(3 * 8 + b) * NMOD + j]));
    }
    LAS float* gm = (LAS float*)lds; LAS float* sh = gm + 2048;
    const int wave = tid >> 6, lane = tid & 63;
    bf16_t* H = (bf16_t*)(P.ws + WS_H);
    for (int rb = blk; rb < 256; rb += G) {
        const int b = rb >> 5;
        for (int k = tid; k < 2048; k += NTHREADS) {
            const int js = 2048 + k, jh = k;
            const float sc = bada[js] + ((modp[(size_t)(0 * 8 + b) * NMOD + js] + modp[(size_t)(1 * 8 + b) * NMOD + js]) + (modp[(size_t)(2 * 8 + b) * NMOD + js] + modp[(size_t)(3 * 8 + b) * NMOD + js]));
            const float sv = bada[jh] + ((modp[(size_t)(0 * 8 + b) * NMOD + jh] + modp[(size_t)(1 * 8 + b) * NMOD + jh]) + (modp[(size_t)(2 * 8 + b) * NMOD + jh] + modp[(size_t)(3 * 8 + b) * NMOD + jh]));
            gm[k] = P.in[4][k] * (1.0f + sc); sh[k] = sv;
        }
        __syncthreads();
        f32x4 v[8], vn[8];
        { const float* xr = P.in[0] + (size_t)(rb * 64 + wave * 8) * DM;
#pragma unroll
          for (int i = 0; i < 8; ++i) v[i] = *(const f32x4*)(xr + (i * 64 + lane) * 4); }
        for (int rr = 0; rr < 8; ++rr) {
            const int row = rb * 64 + wave * 8 + rr;
            if (rr < 7) { const float* xn = P.in[0] + (size_t)(row + 1) * DM;
#pragma unroll
                for (int i = 0; i < 8; ++i) vn[i] = *(const f32x4*)(xn + (i * 64 + lane) * 4); }
            float ss = 0.f;
#pragma unroll
            for (int i = 0; i < 8; ++i) ss += v[i][0] * v[i][0] + v[i][1] * v[i][1] + v[i][2] * v[i][2] + v[i][3] * v[i][3];
            ss = wave_sum(ss);
            const float r = rsqrtf(ss * (1.0f / 2048.0f) + 1e-6f);
#pragma unroll
            for (int i = 0; i < 8; ++i) {
                const int k = (i * 64 + lane) * 4;
                const f32x4 g4 = *(const LAS f32x4*)(gm + k), s4 = *(const LAS f32x4*)(sh + k);
                const f32x4 o = v[i] * r * g4 + s4;
                u32x2 w; w.x = cvt_pk_bf16(o[0], o[1]); w.y = cvt_pk_bf16(o[2], o[3]);
                *(u32x2*)(H + (size_t)row * DM + k) = w;
            }
#pragma unroll
            for (int i = 0; i < 8; ++i) v[i] = vn[i];
        }
        __syncthreads();
    }
}

struct DenseSched : g8::StaticOrder {
    unsigned abase, bbase; int lda, ldb;
    __device__ __forceinline__ bool next(int i, g8::Unit& u) const {
        int pm, pn; if (!tile(i, pm, pn)) return false;
        u.pm = __builtin_amdgcn_readfirstlane(pm); u.pn = __builtin_amdgcn_readfirstlane(pn); u.flags = 0; u.aux = 0;
        u.aoff = abase + (unsigned)u.pm * 256u * (unsigned)lda * 2u; u.boff = bbase + (unsigned)u.pn * 256u * (unsigned)ldb * 2u; return true;
    }
    __device__ __forceinline__ void aoffs(const g8::Unit&, int R0, int C0, int R1, int C1, unsigned (&v)[2][2]) const {
        v[0][0] = (unsigned)(R0 * lda + C0) * 2u; v[0][1] = (unsigned)(R1 * lda + C1) * 2u;
        v[1][0] = (unsigned)((128 + R0) * lda + C0) * 2u; v[1][1] = (unsigned)((128 + R1) * lda + C1) * 2u;
    }
};
struct EpiStoreBf16 {
    static constexpr bool PERM = true;
    bf16_t* O; int ldc;
    __device__ __forceinline__ void operator()(g8::Acc& acc, const g8::Unit& u, int wr, int wc, int fr, int fq) const {
        const int row0 = u.pm * 256 + wr * 64 + fr, col0 = u.pn * 256 + wc * 32 + 8 * fq;
#pragma unroll
        for (int ai = 0; ai < 2; ++ai)
#pragma unroll
            for (int m = 0; m < 4; ++m) { bf16_t* rowp = O + (size_t)(row0 + ai * 128 + m * 16) * ldc + col0;
#pragma unroll
                for (int bj = 0; bj < 2; ++bj) { const f32x4 v0 = acc[ai][bj][m][0], v1 = acc[ai][bj][m][1];
                    u32x4 w; w.x = cvt_pk_bf16(v0[0], v0[1]); w.y = cvt_pk_bf16(v0[2], v0[3]); w.z = cvt_pk_bf16(v1[0], v1[1]); w.w = cvt_pk_bf16(v1[2], v1[3]);
                    *(u32x4*)(rowp + bj * 128) = w; } }
    }
};
struct EpiInProj {
    static constexpr bool PERM = true;
    bf16_t* O;
    __device__ __forceinline__ void operator()(g8::Acc& acc, const g8::Unit& u, int wr, int wc, int fr, int fq) const {
        const int pn = u.pn;
        const int row0 = u.pm * 256 + wr * 64 + fr;
        if (pn < 4 || pn >= 12) {
            const int col0 = pn * 256 + wc * 32 + 8 * fq;
#pragma unroll
            for (int ai = 0; ai < 2; ++ai)
#pragma unroll
                for (int m = 0; m < 4; ++m) { bf16_t* rowp = O + (size_t)(row0 + ai * 128 + m * 16) * NPROJ + col0;
#pragma unroll
                    for (int bj = 0; bj < 2; ++bj) { const f32x4 v0 = acc[ai][bj][m][0], v1 = acc[ai][bj][m][1];
                        u32x4 w; w.x = cvt_pk_bf16(v0[0], v0[1]); w.y = cvt_pk_bf16(v0[2], v0[3]); w.z = cvt_pk_bf16(v1[0], v1[1]); w.w = cvt_pk_bf16(v1[2], v1[3]);
                        *(u32x4*)(rowp + bj * 128) = w; } }
            return;
        }
        const bool isq = pn < 8;
        const int head = 2 * ((pn - 4) & 3) + (wc >> 1);
        const int dd0 = 32 * (wc & 1) + 8 * fq;
        const int colbase = (isq ? 1024 : 2048) + head * 128 + dd0;
        const float lg2 = log2f(1.0f - exp2f(-5.0f - (float)head));
        float fr_[8];
#pragma unroll
        for (int t = 0; t < 8; ++t) fr_[t] = exp2f(-(float)(dd0 + t) * 0.20762050593046014f) * 0.15915494309189535f;
#pragma unroll
        for (int ai = 0; ai < 2; ++ai)
#pragma unroll
            for (int m = 0; m < 4; ++m) {
                const int row = row0 + ai * 128 + m * 16, pos = row & 2047, i = wr * 64 + m * 16 + fr;
                const float sc = isq ? exp2f(lg2 * (float)i) : exp2f(-lg2 * (float)i) * 0.08838834764831845f;
                const float fp = (float)pos;
                float o1[8], o2[8];
#pragma unroll
                for (int t = 0; t < 8; ++t) {
                    const float rev = __builtin_amdgcn_fractf(fp * fr_[t]);
                    const float cs = __builtin_amdgcn_cosf(rev) * sc, sn = __builtin_amdgcn_sinf(rev) * sc;
                    const float a = acc[ai][0][m][t >> 2][t & 3], b = acc[ai][1][m][t >> 2][t & 3];
                    o1[t] = a * cs - b * sn; o2[t] = b * cs + a * sn;
                }
                bf16_t* rowp = O + (size_t)row * NPROJ + colbase;
                u32x4 w1, w2; w1.x = cvt_pk_bf16(o1[0], o1[1]); w1.y = cvt_pk_bf16(o1[2], o1[3]); w1.z = cvt_pk_bf16(o1[4], o1[5]); w1.w = cvt_pk_bf16(o1[6], o1[7]);
                w2.x = cvt_pk_bf16(o2[0], o2[1]); w2.y = cvt_pk_bf16(o2[2], o2[3]); w2.z = cvt_pk_bf16(o2[4], o2[5]); w2.w = cvt_pk_bf16(o2[6], o2[7]);
                *(u32x4*)rowp = w1; *(u32x4*)(rowp + 64) = w2;
            }
    }
};
struct EpiGlu {
    static constexpr bool PERM = true;
    const bf16_t* Z; bf16_t* CAT; float* rowss;
    __device__ __forceinline__ void operator()(g8::Acc& acc, const g8::Unit& u, int wr, int wc, int fr, int fq) const {
        const int row0 = u.pm * 256 + wr * 64 + fr, col0 = u.pn * 256 + wc * 32 + 8 * fq;
#pragma unroll
        for (int ai = 0; ai < 2; ++ai) {
            u32x4 zz[4][2];
#pragma unroll
            for (int m = 0; m < 4; ++m)
#pragma unroll
                for (int bj = 0; bj < 2; ++bj) zz[m][bj] = *(const u32x4*)(Z + (size_t)(row0 + ai * 128 + m * 16) * 1024 + col0 + bj * 128);
#pragma unroll
            for (int m = 0; m < 4; ++m) { const int row = row0 + ai * 128 + m * 16; float ss = 0.f;
#pragma unroll
                for (int bj = 0; bj < 2; ++bj) { const f32x4 v0 = acc[ai][bj][m][0], v1 = acc[ai][bj][m][1];
                    const u32x4 z4 = zz[m][bj];
                    float o[8];
                    o[0] = bf_lo(z4.x) * sigmoidf_(v0[0]); o[1] = bf_hi(z4.x) * sigmoidf_(v0[1]); o[2] = bf_lo(z4.y) * sigmoidf_(v0[2]); o[3] = bf_hi(z4.y) * sigmoidf_(v0[3]);
                    o[4] = bf_lo(z4.z) * sigmoidf_(v1[0]); o[5] = bf_hi(z4.z) * sigmoidf_(v1[1]); o[6] = bf_lo(z4.w) * sigmoidf_(v1[2]); o[7] = bf_hi(z4.w) * sigmoidf_(v1[3]);
#pragma unroll
                    for (int j = 0; j < 8; ++j) ss += o[j] * o[j];
                    u32x4 w; w.x = cvt_pk_bf16(o[0], o[1]); w.y = cvt_pk_bf16(o[2], o[3]); w.z = cvt_pk_bf16(o[4], o[5]); w.w = cvt_pk_bf16(o[6], o[7]);
                    *(u32x4*)(CAT + (size_t)row * DM + col0 + bj * 128) = w; }
                ss += __shfl_xor(ss, 16); ss += __shfl_xor(ss, 32);
                if (fq == 0) rowss[(size_t)row * 16 + u.pn * 4 + wc] = ss; }
        }
    }
};
struct OutSched : g8::StaticOrder {
    unsigned abase, bbase;
    __device__ __forceinline__ bool next(int i, g8::Unit& u) const {
        int pm, pn; if (!tile(i >> 1, pm, pn)) return false;
        const int half = i & 1;
        u.pm = __builtin_amdgcn_readfirstlane(pm); u.pn = __builtin_amdgcn_readfirstlane(pn); u.flags = half ? 0 : 1; u.aux = half;
        u.aoff = abase + (unsigned)u.pm * 256u * 4096u + (unsigned)half * 2048u; u.boff = bbase + (unsigned)u.pn * 256u * 4096u + (unsigned)half * (16u * 32768u); return true;
    }
    __device__ __forceinline__ void aoffs(const g8::Unit&, int R0, int C0, int R1, int C1, unsigned (&v)[2][2]) const {
        v[0][0] = (unsigned)(R0 * 2048 + C0) * 2u; v[0][1] = (unsigned)(R1 * 2048 + C1) * 2u;
        v[1][0] = (unsigned)((128 + R0) * 2048 + C0) * 2u; v[1][1] = (unsigned)((128 + R1) * 2048 + C1) * 2u;
    }
};
struct EpiOut {
    static constexpr bool PERM = true;
    const float* x; const float* mod; const float* rowss1; float* rowss2; bf16_t* X1;
    __device__ __forceinline__ void operator()(g8::Acc& acc, const g8::Unit& u, int wr, int wc, int fr, int fq) const {
        const int row0 = u.pm * 256 + wr * 64 + fr;
        if (u.aux == 0) {
#pragma unroll
            for (int ai = 0; ai < 2; ++ai)
#pragma unroll
                for (int m = 0; m < 4; ++m) { const f32x4* pp = (const f32x4*)(rowss1 + (size_t)(row0 + ai * 128 + m * 16) * 16);
                    const f32x4 p0 = pp[0], p1 = pp[1], p2 = pp[2], p3 = pp[3];
                    const float tot = (((p0[0] + p0[1]) + (p0[2] + p0[3])) + ((p1[0] + p1[1]) + (p1[2] + p1[3]))) + (((p2[0] + p2[1]) + (p2[2] + p2[3])) + ((p3[0] + p3[1]) + (p3[2] + p3[3])));
                    const float r = rsqrtf(tot * (1.0f / 1024.0f) + 1e-6f);
#pragma unroll
                    for (int bj = 0; bj < 2; ++bj)
#pragma unroll
                        for (int n = 0; n < 2; ++n) acc[ai][bj][m][n] *= r; }
            return;
        }
        const int col0 = u.pn * 256 + wc * 32 + 8 * fq;
        const int b = (u.pm * 256) >> 11;
        f32x4 gt[2][2];
#pragma unroll
        for (int bj = 0; bj < 2; ++bj)
#pragma unroll
            for (int n = 0; n < 2; ++n) gt[bj][n] = *(const f32x4*)(mod + (size_t)b * NMOD + 2 * DM + col0 + bj * 128 + n * 4);
#pragma unroll
        for (int am = 0; am < 4; ++am) {
            const int ai = am >> 1, m0 = (am & 1) * 2;
            f32x4 xv[2][2][2];
#pragma unroll
            for (int mm = 0; mm < 2; ++mm)
#pragma unroll
                for (int bj = 0; bj < 2; ++bj) { const size_t off = (size_t)(row0 + ai * 128 + (m0 + mm) * 16) * DM + col0 + bj * 128; xv[mm][bj][0] = *(const f32x4*)(x + off); xv[mm][bj][1] = *(const f32x4*)(x + off + 4); }
#pragma unroll
            for (int mm = 0; mm < 2; ++mm) { const int m = m0 + mm; const int row = row0 + ai * 128 + m * 16; float ss = 0.f;
#pragma unroll
                for (int bj = 0; bj < 2; ++bj) { const size_t off = (size_t)row * DM + col0 + bj * 128;
                    const f32x4 o0 = xv[mm][bj][0] + gt[bj][0] * acc[ai][bj][m][0], o1 = xv[mm][bj][1] + gt[bj][1] * acc[ai][bj][m][1];
                    ss += (o0[0] * o0[0] + o0[1] * o0[1]) + (o0[2] * o0[2] + o0[3] * o0[3]) + (o1[0] * o1[0] + o1[1] * o1[1]) + (o1[2] * o1[2] + o1[3] * o1[3]);
                    u32x4 w; w.x = cvt_pk_bf16(o0[0], o0[1]); w.y = cvt_pk_bf16(o0[2], o0[3]); w.z = cvt_pk_bf16(o1[0], o1[1]); w.w = cvt_pk_bf16(o1[2], o1[3]);
                    *(u32x4*)(X1 + off) = w; }
                ss += __shfl_xor(ss, 16); ss += __shfl_xor(ss, 32);
                if (fq == 0) rowss2[(size_t)row * 32 + u.pn * 4 + wc] = ss; }
        }
    }
};
struct MoeSched {
    const LAS int* tinfo; const LAS int* trows; int ntiles; int G, c; const int* list; unsigned abase, bbase; int mode;
    __device__ __forceinline__ bool next(int i, g8::Unit& u) const {
        int pn, ti;
        if ((G & 63) == 0) { const int x = c & 7, r = c >> 3, per = G >> 6;
            ti = (i * 8 + x) * per + (r >> 3); pn = r & 7; }
        else { const int L = i * G + c; pn = L & 7; ti = L >> 3; }
        if (ti >= ntiles) return false;
        const int inf = __builtin_amdgcn_readfirstlane(tinfo[ti]);
        const int e = inf & 255;
        u.pm = __builtin_amdgcn_readfirstlane(ti); u.pn = pn; u.flags = 0; u.aux = inf; u.aux2 = __builtin_amdgcn_readfirstlane(trows[ti]);
        if (mode == 0) { u.aoff = abase; u.boff = bbase + (unsigned)e * (2048u * 2048u) + (unsigned)pn * (256u * 2048u); }
        else { u.aoff = abase + (unsigned)ti * (256u * 1024u); u.boff = bbase + (unsigned)e * (2048u * 1024u) + (unsigned)pn * (256u * 1024u); }
        return true;
    }
    __device__ __forceinline__ void aoffs(const g8::Unit& u, int R0, int C0, int R1, int C1, unsigned (&v)[2][2]) const {
        if (mode == 0) {
            const int e = u.aux & 255, r0 = u.aux >> 8, n = u.aux2; const int* le = list + e * 16384 + r0;
            const int i00 = R0, i01 = R1, i10 = 128 + R0, i11 = 128 + R1;
            const int t00 = (i00 < n) ? (le[i00] >> 1) : 0, t01 = (i01 < n) ? (le[i01] >> 1) : 0, t10 = (i10 < n) ? (le[i10] >> 1) : 0, t11 = (i11 < n) ? (le[i11] >> 1) : 0;
            v[0][0] = (unsigned)(t00 * 2048 + C0 * 2); v[0][1] = (unsigned)(t01 * 2048 + C1 * 2); v[1][0] = (unsigned)(t10 * 2048 + C0 * 2); v[1][1] = (unsigned)(t11 * 2048 + C1 * 2);
        } else {
            v[0][0] = (unsigned)(R0 * 1024 + C0 * 2); v[0][1] = (unsigned)(R1 * 1024 + C1 * 2);
            v[1][0] = (unsigned)((128 + R0) * 1024 + C0 * 2); v[1][1] = (unsigned)((128 + R1) * 1024 + C1 * 2);
        }
    }
};
struct EpiMoe1 {
    static constexpr bool PERM = true;
    unsigned char* HM;
    __device__ __forceinline__ void operator()(g8::Acc& acc, const g8::Unit& u, int wr, int wc, int fr, int fq) const {
        const int row0 = u.pm * 256 + wr * 64 + fr, col0 = u.pn * 128 + wc * 32 + 8 * fq;
        const float inv = 1.0f / WGU_SCALE;
#pragma unroll
        for (int ai = 0; ai < 2; ++ai)
#pragma unroll
            for (int m = 0; m < 4; ++m) { float o[8];
#pragma unroll
                for (int n = 0; n < 2; ++n)
#pragma unroll
                    for (int j = 0; j < 4; ++j) { const float gv = acc[ai][0][m][n][j] * inv, uv = acc[ai][1][m][n][j] * inv; o[n * 4 + j] = gv * sigmoidf_(gv) * uv; }
                int q0 = 0, q1 = 0;
                q0 = __builtin_amdgcn_cvt_pk_fp8_f32(o[0], o[1], q0, false); q0 = __builtin_amdgcn_cvt_pk_fp8_f32(o[2], o[3], q0, true);
                q1 = __builtin_amdgcn_cvt_pk_fp8_f32(o[4], o[5], q1, false); q1 = __builtin_amdgcn_cvt_pk_fp8_f32(o[6], o[7], q1, true);
                *(u32x2*)(HM + (size_t)(row0 + ai * 128 + m * 16) * 1024 + col0) = (u32x2){(unsigned)q0, (unsigned)q1}; }
    }
};
struct EpiMoe2 {
    static constexpr bool PERM = true;
    const u32x2* slot; bf16_t* Y2;
    __device__ __forceinline__ void operator()(g8::Acc& acc, const g8::Unit& u, int wr, int wc, int fr, int fq) const {
        const int col0 = u.pn * 256 + wc * 32 + 8 * fq;
        u32x2 si[2][4];
#pragma unroll
        for (int ai = 0; ai < 2; ++ai)
#pragma unroll
            for (int m = 0; m < 4; ++m) si[ai][m] = slot[u.pm * 256 + ai * 128 + wr * 64 + m * 16 + fr];
#pragma unroll
        for (int ai = 0; ai < 2; ++ai)
#pragma unroll
            for (int m = 0; m < 4; ++m) { const int asg = (int)si[ai][m].x;
                if (asg >= 0) { bf16_t* rowp = Y2 + (size_t)asg * DM + col0; const float ww = __uint_as_float(si[ai][m].y);
#pragma unroll
                    for (int bj = 0; bj < 2; ++bj) { const f32x4 v0 = acc[ai][bj][m][0] * ww, v1 = acc[ai][bj][m][1] * ww;
                        u32x4 w; w.x = cvt_pk_bf16(v0[0], v0[1]); w.y = cvt_pk_bf16(v0[2], v0[3]); w.z = cvt_pk_bf16(v1[0], v1[1]); w.w = cvt_pk_bf16(v1[2], v1[3]);
                        *(u32x4*)(rowp + bj * 128) = w; } } }
    }
};

constexpr size_t WS_KV = WS_H;
__device__ __forceinline__ void ssm_item(const Params& P, LAS unsigned char* lds, int tid, int item) {
    const int g = item >> 2, bp = item & 3;
    const int wave = __builtin_amdgcn_readfirstlane(tid >> 6), lane = tid & 63, fr = lane & 15, fq = lane >> 4;
    const bf16_t* proj = (const bf16_t*)(P.ws + WS_PROJ);
    const bf16_t* Ms = (const bf16_t*)(P.ws + WS_SSMM) + (size_t)g * 131072;
    const bf16_t* TM = Ms + 32768;
    bf16_t* Zo = (bf16_t*)(P.ws + WS_Z);
    constexpr int ZS = 136, MS = 264, TS = 392;
    LAS bf16_t* ZB = (LAS bf16_t*)lds;
    LAS bf16_t* WB = (LAS bf16_t*)(lds + 256 * ZS * 2);
    const int b = 2 * bp + (wave >> 2);
    int tok0[2];
    bf16x8 Uf[2][8];
#pragma unroll
    for (int mt = 0; mt < 2; ++mt) {
        const int c = 32 * (wave & 3) + 16 * mt + fr; tok0[mt] = b * 2048 + c * 16;
#pragma unroll
        for (int ks = 0; ks < 8; ++ks) Uf[mt][ks] = *(const bf16x8*)(proj + (size_t)(tok0[mt] + 2 * ks + (fq >> 1)) * NPROJ + g * 16 + 8 * (fq & 1));
    }
#pragma unroll
    for (int i = 0; i < 8; ++i) { const int row = tid >> 2, kc = (tid & 3) + 4 * i; *(LAS u32x4*)(WB + row * MS + kc * 8) = *(const u32x4*)(Ms + row * 256 + kc * 8); }
    __syncthreads();
#pragma unroll
    for (int nt = 0; nt < 8; ++nt) {
        f32x4 a0 = {0.f, 0.f, 0.f, 0.f}, a1 = {0.f, 0.f, 0.f, 0.f};
#pragma unroll
        for (int ks = 0; ks < 8; ++ks) {
            const bf16x8 bf = *(const LAS bf16x8*)(WB + (16 * nt + fr) * MS + 32 * ks + 8 * fq);
            a0 = __builtin_amdgcn_mfma_f32_16x16x32_bf16(bf, Uf[0][ks], a0, 0, 0, 0);
            a1 = __builtin_amdgcn_mfma_f32_16x16x32_bf16(bf, Uf[1][ks], a1, 0, 0, 0);
        }
        *(LAS u32x2*)(ZB + (32 * wave + fr) * ZS + 16 * nt + 4 * fq) = (u32x2){cvt_pk_bf16(a0[0], a0[1]), cvt_pk_bf16(a0[2], a0[3])};
        *(LAS u32x2*)(ZB + (32 * wave + 16 + fr) * ZS + 16 * nt + 4 * fq) = (u32x2){cvt_pk_bf16(a1[0], a1[1]), cvt_pk_bf16(a1[2], a1[3])};
    }
    u32x4 tmr[6];
#pragma unroll
    for (int i = 0; i < 6; ++i) { const int row = tid >> 3, kc = (tid & 7) + 8 * i; tmr[i] = *(const u32x4*)(TM + (size_t)row * 384 + kc * 8); }
    __syncthreads();
    if (tid < 128) {
        const int bl = tid >> 6, p = tid & 63;
        const f32x2 al = ((const f32x2*)(P.ws + WS_SSMA))[g * 64 + p];
        float xr = 0.f, xi = 0.f;
        LAS unsigned* zw = (LAS unsigned*)ZB + (bl * 128) * (ZS / 2) + p;
        for (int c0 = 0; c0 < 128; c0 += 8) {
            unsigned zv[8];
#pragma unroll
            for (int k = 0; k < 8; ++k) zv[k] = zw[(c0 + k) * (ZS / 2)];
#pragma unroll
            for (int k = 0; k < 8; ++k) {
                zw[(c0 + k) * (ZS / 2)] = cvt_pk_bf16(xr, xi);
                const float t = al.x * xr - al.y * xi + bf_lo(zv[k]); xi = al.x * xi + al.y * xr + bf_hi(zv[k]); xr = t;
            }
        }
    }
#pragma unroll
    for (int i = 0; i < 6; ++i) { const int row = tid >> 3, kc = (tid & 7) + 8 * i; *(LAS u32x4*)(WB + row * TS + kc * 8) = tmr[i]; }
    __syncthreads();
    const LAS bf16_t* xrow = ZB + (32 * wave + fr) * ZS + 8 * fq;
    const f32x4 dv = *(const f32x4*)(P.in[12] + g * 16 + 4 * fq);
#pragma unroll
    for (int cq = 0; cq < 4; ++cq) {
        u32x2 uu[4][2];
#pragma unroll
        for (int ntl = 0; ntl < 4; ++ntl)
#pragma unroll
            for (int mt = 0; mt < 2; ++mt) uu[ntl][mt] = *(const u32x2*)(proj + (size_t)(tok0[mt] + 4 * cq + ntl) * NPROJ + g * 16 + 4 * fq);
        if (cq < 3) {
#pragma unroll
            for (int i = 0; i < 6; ++i) { const int row = tid >> 3, kc = (tid & 7) + 8 * i; tmr[i] = *(const u32x4*)(TM + (size_t)(64 * (cq + 1) + row) * 384 + kc * 8); }
        }
#pragma unroll
        for (int ntl = 0; ntl < 4; ++ntl) {
            const int nt = 4 * cq + ntl;
            f32x4 a0 = {0.f, 0.f, 0.f, 0.f}, a1 = {0.f, 0.f, 0.f, 0.f};
            const LAS bf16_t* brow = WB + (16 * ntl + fr) * TS + 8 * fq;
#pragma unroll
            for (int ks = 0; ks < 8; ++ks) {
                if (2 * ks <= nt) {
                    const bf16x8 bf = *(const LAS bf16x8*)(brow + 32 * ks);
                    a0 = __builtin_amdgcn_mfma_f32_16x16x32_bf16(bf, Uf[0][ks], a0, 0, 0, 0);
                    a1 = __builtin_amdgcn_mfma_f32_16x16x32_bf16(bf, Uf[1][ks], a1, 0, 0, 0);
                }
            }
#pragma unroll
            for (int k2 = 0; k2 < 4; ++k2) {
                const bf16x8 bf = *(const LAS bf16x8*)(brow + 256 + 32 * k2);
                const bf16x8 x0 = *(const LAS bf16x8*)(xrow + 32 * k2), x1 = *(const LAS bf16x8*)(xrow + 16 * ZS + 32 * k2);
                a0 = __builtin_amdgcn_mfma_f32_16x16x32_bf16(bf, x0, a0, 0, 0, 0);
                a1 = __builtin_amdgcn_mfma_f32_16x16x32_bf16(bf, x1, a1, 0, 0, 0);
            }
#pragma unroll
            for (int mt = 0; mt < 2; ++mt) {
                const f32x4 a = mt ? a1 : a0;
                const size_t tok = (size_t)(tok0[mt] + nt);
                const u32x2 u2 = uu[ntl][mt];
                const float y0 = a[0] + dv[0] * bf_lo(u2.x), y1 = a[1] + dv[1] * bf_hi(u2.x), y2 = a[2] + dv[2] * bf_lo(u2.y), y3 = a[3] + dv[3] * bf_hi(u2.y);
                u32x2 w; w.x = cvt_pk_bf16(gelu_tanh(y0), gelu_tanh(y1)); w.y = cvt_pk_bf16(gelu_tanh(y2), gelu_tanh(y3));
                *(u32x2*)(Zo + tok * 1024 + g * 16 + 4 * fq) = w;
            }
        }
        __syncthreads();
        if (cq < 3) {
#pragma unroll
            for (int i = 0; i < 6; ++i) { const int row = tid >> 3, kc = (tid & 7) + 8 * i; *(LAS u32x4*)(WB + row * TS + kc * 8) = tmr[i]; }
            __syncthreads();
        }
    }
}

__device__ __forceinline__ bf16x8 tr_frag(const LAS bf16_t* tile, int row0, int col0, int fr, int fq) {
    const LAS bf16_t* p = tile + (row0 + 8 * fq + (fr >> 2)) * 136 + col0 + 4 * (fr & 3);
    const bf16x4 a = __builtin_amdgcn_ds_read_tr16_b64_v4i16((LAS bf16x4*)p);
    const bf16x4 b = __builtin_amdgcn_ds_read_tr16_b64_v4i16((LAS bf16x4*)(p + 4 * 136));
    bf16x8 r; r[0] = a[0]; r[1] = a[1]; r[2] = a[2]; r[3] = a[3]; r[4] = b[0]; r[5] = b[1]; r[6] = b[2]; r[7] = b[3]; return r;
}
__device__ __forceinline__ void ret_kv_items(const Params& P, LAS unsigned char* lds, int tid, int first, int stride) {
    const int wave = __builtin_amdgcn_readfirstlane(tid >> 6), lane = tid & 63, fr = lane & 15, fq = lane >> 4;
    constexpr int RS = 136;
    LAS bf16_t* Ks = (LAS bf16_t*)lds; LAS bf16_t* Vs = Ks + 128 * RS;
    const bf16_t* proj = (const bf16_t*)(P.ws + WS_PROJ);
    bf16_t* KV = (bf16_t*)(P.ws + WS_KV);
    const int si = tid >> 2, part = tid & 3, i0 = 16 * wave;
    u32x4 kr[4], vr[4];
    int item = first;
    if (item >= 768) return;
    { const int bh = item / 12, n = item % 12; const bf16_t* pr = proj + ((size_t)(bh >> 3) * 2048 + n * 128 + si) * NPROJ + (bh & 7) * 128 + 32 * part;
#pragma unroll
      for (int j = 0; j < 4; ++j) { kr[j] = *(const u32x4*)(pr + 2048 + 8 * j); vr[j] = *(const u32x4*)(pr + 3072 + 8 * j); } }
    for (;;) {
#pragma unroll
        for (int j = 0; j < 4; ++j) { *(LAS u32x4*)(Ks + si * RS + 32 * part + 8 * j) = kr[j]; *(LAS u32x4*)(Vs + si * RS + 32 * part + 8 * j) = vr[j]; }
        __syncthreads();
        const int nxt = item + stride; const bool more = nxt < 768;
        if (more) { const int bh = nxt / 12, n = nxt % 12; const bf16_t* pr = proj + ((size_t)(bh >> 3) * 2048 + n * 128 + si) * NPROJ + (bh & 7) * 128 + 32 * part;
#pragma unroll
            for (int j = 0; j < 4; ++j) { kr[j] = *(const u32x4*)(pr + 2048 + 8 * j); vr[j] = *(const u32x4*)(pr + 3072 + 8 * j); } }
        bf16x8 Vt[4];
#pragma unroll
        for (int ks = 0; ks < 4; ++ks) Vt[ks] = tr_frag(Vs, 32 * ks, i0, fr, fq);
        const int bh = item / 12, n = item % 12;
        bf16_t* op = KV + ((size_t)(bh * 16 + n) * 128 + i0 + fr) * 128 + 4 * fq;
#pragma unroll
        for (int nt = 0; nt < 8; ++nt) {
            f32x4 a = {0.f, 0.f, 0.f, 0.f};
#pragma unroll
            for (int ks = 0; ks < 4; ++ks) { const bf16x8 kf = tr_frag(Ks, 32 * ks, 16 * nt, fr, fq); a = __builtin_amdgcn_mfma_f32_16x16x32_bf16(kf, Vt[ks], a, 0, 0, 0); }
            *(u32x2*)(op + 16 * nt) = (u32x2){cvt_pk_bf16(a[0], a[1]), cvt_pk_bf16(a[2], a[3])};
        }
        __syncthreads();
        if (!more) break;
        item = nxt;
    }
}
__device__ __forceinline__ void ret_out_item(const Params& P, LAS unsigned char* lds, int tid, int item) {
    const int bh = item >> 2, q = item & 3, b = bh >> 3, h = bh & 7;
    const int wave = __builtin_amdgcn_readfirstlane(tid >> 6), lane = tid & 63, fr = lane & 15, fq = lane >> 4;
    constexpr int RS = 136;
    LAS bf16_t* Qs = (LAS bf16_t*)lds;
    LAS bf16_t* Ks = Qs + 128 * RS;
    LAS bf16_t* Vs = Ks + 128 * RS;
    LAS bf16_t* Rs = Vs + 128 * RS;
    const bf16_t* proj = (const bf16_t*)(P.ws + WS_PROJ);
    const bf16_t* KV = (const bf16_t*)(P.ws + WS_KV);
    bf16_t* CAT = (bf16_t*)(P.ws + WS_CAT);
    const float gam = 1.0f - exp2f(-5.0f - (float)h);
    const float lg2 = log2f(gam);
    const float gC1 = exp2f(lg2 * 127.0f), gC = exp2f(lg2 * 128.0f);
    const int si = tid >> 2, part = tid & 3, i0 = 16 * wave;
    u32x4 st[12];
    { const bf16_t* pr = proj + ((size_t)b * 2048 + (4 * q) * 128 + si) * NPROJ + h * 128 + 32 * part;
#pragma unroll
      for (int j = 0; j < 4; ++j) { st[j] = *(const u32x4*)(pr + 1024 + 8 * j); st[4 + j] = *(const u32x4*)(pr + 2048 + 8 * j); st[8 + j] = *(const u32x4*)(pr + 3072 + 8 * j); } }
    f32x4 accR[8];
#pragma unroll
    for (int nt = 0; nt < 8; ++nt) accR[nt] = (f32x4){0.f, 0.f, 0.f, 0.f};
    for (int m = 0; m < 4 * q; ++m) {
        const bf16_t* tp = KV + ((size_t)(bh * 16 + m) * 128 + i0 + fr) * 128 + 4 * fq;
        u32x2 t[8];
#pragma unroll
        for (int nt = 0; nt < 8; ++nt) t[nt] = *(const u32x2*)(tp + 16 * nt);
#pragma unroll
        for (int nt = 0; nt < 8; ++nt) { const f32x4 kv = {bf_lo(t[nt].x), bf_hi(t[nt].x), bf_lo(t[nt].y), bf_hi(t[nt].y)}; accR[nt] = accR[nt] * gC + kv * gC1; }
    }
#pragma unroll
    for (int nt = 0; nt < 8; ++nt)
        *(LAS u32x2*)(Rs + (i0 + fr) * RS + 16 * nt + 4 * fq) = (u32x2){cvt_pk_bf16(accR[nt][0], accR[nt][1]), cvt_pk_bf16(accR[nt][2], accR[nt][3])};
    for (int nn = 0; nn < 4; ++nn) {
        const int n = 4 * q + nn;
#pragma unroll
        for (int j = 0; j < 4; ++j) { *(LAS u32x4*)(Qs + si * RS + 32 * part + 8 * j) = st[j]; *(LAS u32x4*)(Ks + si * RS + 32 * part + 8 * j) = st[4 + j]; *(LAS u32x4*)(Vs + si * RS + 32 * part + 8 * j) = st[8 + j]; }
        __syncthreads();
        if (nn < 3) { const bf16_t* pr = proj + ((size_t)b * 2048 + (n + 1) * 128 + si) * NPROJ + h * 128 + 32 * part;
#pragma unroll
            for (int j = 0; j < 4; ++j) { st[j] = *(const u32x4*)(pr + 1024 + 8 * j); st[4 + j] = *(const u32x4*)(pr + 2048 + 8 * j); st[8 + j] = *(const u32x4*)(pr + 3072 + 8 * j); } }
        const size_t tok = (size_t)b * 2048 + n * 128 + i0 + fr;
        u32x2 gg[8];
        { const bf16_t* gp = proj + tok * NPROJ + 4096 + h * 128 + 4 * fq;
#pragma unroll
          for (int nt = 0; nt < 8; ++nt) gg[nt] = *(const u32x2*)(gp + 16 * nt); }
        bf16x8 Qf[4];
#pragma unroll
        for (int ks = 0; ks < 4; ++ks) Qf[ks] = *(const LAS bf16x8*)(Qs + (i0 + fr) * RS + 32 * ks + 8 * fq);
        f32x4 accS[8], accO[8];
#pragma unroll
        for (int nt = 0; nt < 8; ++nt) { accS[nt] = (f32x4){0.f, 0.f, 0.f, 0.f}; accO[nt] = (f32x4){0.f, 0.f, 0.f, 0.f}; }
#pragma unroll
        for (int nt = 0; nt < 8; ++nt) {
            if (nt <= wave) {
#pragma unroll
                for (int ks = 0; ks < 4; ++ks) { const bf16x8 kf = *(const LAS bf16x8*)(Ks + (16 * nt + fr) * RS + 32 * ks + 8 * fq); accS[nt] = __builtin_amdgcn_mfma_f32_16x16x32_bf16(kf, Qf[ks], accS[nt], 0, 0, 0); }
            }
        }
        if (n > 0) {
#pragma unroll
            for (int nt = 0; nt < 8; ++nt) {
#pragma unroll
                for (int ks = 0; ks < 4; ++ks) { const bf16x8 rf = *(const LAS bf16x8*)(Rs + (16 * nt + fr) * RS + 32 * ks + 8 * fq); accO[nt] = __builtin_amdgcn_mfma_f32_16x16x32_bf16(rf, Qf[ks], accO[nt], 0, 0, 0); }
                accO[nt] *= gam;
            }
        }
#pragma unroll
        for (int nt = 0; nt < 8; ++nt) {
            const int i = i0 + fr, j0 = 16 * nt + 4 * fq;
            const float p0 = (j0 <= i) ? accS[nt][0] : 0.f, p1 = (j0 + 1 <= i) ? accS[nt][1] : 0.f, p2 = (j0 + 2 <= i) ? accS[nt][2] : 0.f, p3 = (j0 + 3 <= i) ? accS[nt][3] : 0.f;
            *(LAS u32x2*)(Qs + i * RS + j0) = (u32x2){cvt_pk_bf16(p0, p1), cvt_pk_bf16(p2, p3)};
        }
        asm volatile("" ::: "memory");
        bf16x8 Pf[4];
#pragma unroll
        for (int ks = 0; ks < 4; ++ks) Pf[ks] = *(const LAS bf16x8*)(Qs + (i0 + fr) * RS + 32 * ks + 8 * fq);
#pragma unroll
        for (int ks = 0; ks < 4; ++ks) {
            if (2 * ks <= wave) {
#pragma unroll
                for (int nt = 0; nt < 8; ++nt) { const bf16x8 vf = tr_frag(Vs, 32 * ks, 16 * nt, fr, fq); accO[nt] = __builtin_amdgcn_mfma_f32_16x16x32_bf16(vf, Pf[ks], accO[nt], 0, 0, 0); }
            }
        }
        if (nn < 3) {
            bf16x8 Vt[4];
#pragma unroll
            for (int ks = 0; ks < 4; ++ks) Vt[ks] = tr_frag(Vs, 32 * ks, i0, fr, fq);
#pragma unroll
            for (int nt = 0; nt < 8; ++nt) {
                accR[nt] *= gam;
#pragma unroll
                for (int ks = 0; ks < 4; ++ks) { const bf16x8 kf = tr_frag(Ks, 32 * ks, 16 * nt, fr, fq); accR[nt] = __builtin_amdgcn_mfma_f32_16x16x32_bf16(kf, Vt[ks], accR[nt], 0, 0, 0); }
                accR[nt] *= gC1;
            }
        }
        {
            float s = 0.f;
#pragma unroll
            for (int nt = 0; nt < 8; ++nt) s += (accO[nt][0] + accO[nt][1]) + (accO[nt][2] + accO[nt][3]);
            s += __shfl_xor(s, 16); s += __shfl_xor(s, 32);
            const float mu = s * (1.0f / 128.0f); float qv = 0.f;
#pragma unroll
            for (int nt = 0; nt < 8; ++nt) { const f32x4 d = accO[nt] - mu; qv += (d[0] * d[0] + d[1] * d[1]) + (d[2] * d[2] + d[3] * d[3]); }
            qv += __shfl_xor(qv, 16); qv += __shfl_xor(qv, 32);
            const float rstd = rsqrtf(qv * (1.0f / 128.0f) + 1e-5f);
            bf16_t* op = CAT + tok * DM + 1024 + h * 128 + 4 * fq;
#pragma unroll
            for (int nt = 0; nt < 8; ++nt) {
                const float g0 = bf_lo(gg[nt].x), g1 = bf_hi(gg[nt].x), g2 = bf_lo(gg[nt].y), g3 = bf_hi(gg[nt].y);
                const f32x4 y = (accO[nt] - mu) * rstd;
                u32x2 w; w.x = cvt_pk_bf16(y[0] * g0 * sigmoidf_(g0), y[1] * g1 * sigmoidf_(g1)); w.y = cvt_pk_bf16(y[2] * g2 * sigmoidf_(g2), y[3] * g3 * sigmoidf_(g3));
                *(u32x2*)(op + 16 * nt) = w;
            }
        }
        __syncthreads();
        if (nn < 3) {
#pragma unroll
            for (int nt = 0; nt < 8; ++nt)
                *(LAS u32x2*)(Rs + (i0 + fr) * RS + 16 * nt + 4 * fq) = (u32x2){cvt_pk_bf16(accR[nt][0], accR[nt][1]), cvt_pk_bf16(accR[nt][2], accR[nt][3])};
        }
    }
}

__device__ __forceinline__ void p6_route(const Params& P, LAS unsigned char* lds, int tid, int blk, int G) {
    const int wave = __builtin_amdgcn_readfirstlane(tid >> 6), lane = tid & 63, fr = lane & 15, fq = lane >> 4;
    LAS float* gm = (LAS float*)lds; LAS float* sh = gm + 2048; LAS float* lg = sh + 2048;
    LAS float* lgr = lg + 8 * 64 * 48;
    LAS float* r2s = lgr + 64 * 36;
    LAS int* lcnt = (LAS int*)(r2s + 64); LAS int* lbase = lcnt + 32;
    int ra_ = 0, rb_ = 0, ea_ = 0, eb_ = 0; float w1_ = 0.f, w2_ = 0.f;
    const float* mod = (const float*)(P.ws + WS_MOD);
    const bf16_t* x1 = (const bf16_t*)(P.ws + WS_X1); const float* rowss2 = (const float*)(P.ws + WS_ROWSS2);
    unsigned char* H2 = P.ws + WS_H;
    const bf16_t* WR = (const bf16_t*)(P.ws + WS_WR);
    int* cnt = (int*)(P.ws + WS_CNT); int* list = (int*)(P.ws + WS_LIST); float* wgt = (float*)(P.ws + WS_WGT);
    for (int rb = blk; rb < 256; rb += G) {
        const int b = rb >> 5;
        for (int k = tid; k < 2048; k += NTHREADS) { gm[k] = P.in[18][k] * (1.0f + mod[(size_t)b * NMOD + 4 * DM + k]); sh[k] = mod[(size_t)b * NMOD + 3 * DM + k]; }
        if (tid < 32) lcnt[tid] = 0;
        if (tid >= 64 && tid < 128) { const int r = tid - 64; float tot2 = 0.f; const f32x4* pp = (const f32x4*)(rowss2 + (size_t)(rb * 64 + r) * 32);
#pragma unroll
            for (int i = 0; i < 8; ++i) { const f32x4 v = pp[i]; tot2 += (v[0] + v[1]) + (v[2] + v[3]); }
            r2s[r] = rsqrtf(tot2 * (1.0f / 2048.0f) + 1e-6f); }
        __syncthreads();
        float r2v[4];
#pragma unroll
        for (int mt = 0; mt < 4; ++mt) r2v[mt] = r2s[16 * mt + fr];
        f32x4 acc[4][3];
#pragma unroll
        for (int mt = 0; mt < 4; ++mt)
#pragma unroll
            for (int nt = 0; nt < 3; ++nt) acc[mt][nt] = (f32x4){0.f, 0.f, 0.f, 0.f};
        const bf16_t* xb = x1 + (size_t)(rb * 64 + fr) * DM + 256 * wave + 8 * fq;
        const bf16_t* wb = WR + (size_t)fr * 2048 + 256 * wave + 8 * fq;
        unsigned char* hb = H2 + (size_t)(rb * 64 + fr) * DM + 256 * wave + 8 * fq;
        u32x4 xc[2][4], xn[2][4]; bf16x8 bc[2][3], bn[2][3];
#pragma unroll
        for (int j = 0; j < 2; ++j) {
#pragma unroll
            for (int mt = 0; mt < 4; ++mt) xc[j][mt] = *(const u32x4*)(xb + (size_t)(16 * mt) * DM + 32 * j);
#pragma unroll
            for (int nt = 0; nt < 3; ++nt) bc[j][nt] = *(const bf16x8*)(wb + (size_t)(16 * nt) * 2048 + 32 * j); }
#pragma unroll 1
        for (int qt = 0; qt < 4; ++qt) {
            const int qn = qt < 3 ? qt + 1 : 3;
#pragma unroll
            for (int j = 0; j < 2; ++j) {
#pragma unroll
                for (int mt = 0; mt < 4; ++mt) xn[j][mt] = *(const u32x4*)(xb + (size_t)(16 * mt) * DM + 32 * (2 * qn + j));
#pragma unroll
                for (int nt = 0; nt < 3; ++nt) bn[j][nt] = *(const bf16x8*)(wb + (size_t)(16 * nt) * 2048 + 32 * (2 * qn + j)); }
#pragma unroll
            for (int j = 0; j < 2; ++j) {
                const int kl = 256 * wave + 32 * (2 * qt + j) + 8 * fq;
                const f32x4 g0 = *(const LAS f32x4*)(gm + kl), g1 = *(const LAS f32x4*)(gm + kl + 4), s0 = *(const LAS f32x4*)(sh + kl), s1 = *(const LAS f32x4*)(sh + kl + 4);
#pragma unroll
                for (int mt = 0; mt < 4; ++mt) {
                    const u32x4 xw = xc[j][mt];
                    const f32x4 a = {bf_lo(xw.x), bf_hi(xw.x), bf_lo(xw.y), bf_hi(xw.y)}, c = {bf_lo(xw.z), bf_hi(xw.z), bf_lo(xw.w), bf_hi(xw.w)};
                    const f32x4 h0 = a * r2v[mt] * g0 + s0, h1 = c * r2v[mt] * g1 + s1;
                    u32x4 w; w.x = cvt_pk_bf16(h0[0], h0[1]); w.y = cvt_pk_bf16(h0[2], h0[3]); w.z = cvt_pk_bf16(h1[0], h1[1]); w.w = cvt_pk_bf16(h1[2], h1[3]);
                    int q0 = 0, q1 = 0;
                    q0 = __builtin_amdgcn_cvt_pk_fp8_f32(h0[0], h0[1], q0, false); q0 = __builtin_amdgcn_cvt_pk_fp8_f32(h0[2], h0[3], q0, true);
                    q1 = __builtin_amdgcn_cvt_pk_fp8_f32(h1[0], h1[1], q1, false); q1 = __builtin_amdgcn_cvt_pk_fp8_f32(h1[2], h1[3], q1, true);
                    *(u32x2*)(hb + (size_t)(16 * mt) * DM + 32 * (2 * qt + j)) = (u32x2){(unsigned)q0, (unsigned)q1};
                    const bf16x8 af = __builtin_bit_cast(bf16x8, w);
#pragma unroll
                    for (int nt = 0; nt < 3; ++nt) acc[mt][nt] = __builtin_amdgcn_mfma_f32_16x16x32_bf16(bc[j][nt], af, acc[mt][nt], 0, 0, 0);
                }
            }
#pragma unroll
            for (int j = 0; j < 2; ++j) {
#pragma unroll
                for (int mt = 0; mt < 4; ++mt) xc[j][mt] = xn[j][mt];
#pragma unroll
                for (int nt = 0; nt < 3; ++nt) bc[j][nt] = bn[j][nt]; }
        }
#pragma unroll
        for (int mt = 0; mt < 4; ++mt)
#pragma unroll
            for (int nt = 0; nt < 3; ++nt) *(LAS f32x4*)(lg + (wave * 64 + 16 * mt + fr) * 48 + 16 * nt + 4 * fq) = acc[mt][nt];
        __syncthreads();
        for (int o = tid; o < 64 * 36; o += NTHREADS) { const int r = o / 36, nn = o % 36; float sum = 0.f;
#pragma unroll
            for (int w = 0; w < 8; ++w) sum += lg[(w * 64 + r) * 48 + nn];
            lgr[o] = sum; }
        __syncthreads();
        if (tid < 64) {
            const int tok = rb * 64 + tid;
            float l[36];
#pragma unroll
            for (int nn = 0; nn < 36; ++nn) l[nn] = lgr[tid * 36 + nn];
            float gl[4]; int gs = 0;
#pragma unroll
            for (int j = 0; j < 4; ++j) gl[j] = l[j] + P.in[20][j];
#pragma unroll
            for (int j = 1; j < 4; ++j) if (gl[j] > gl[gs]) gs = j;
            float gmax = gl[0];
#pragma unroll
            for (int j = 1; j < 4; ++j) gmax = fmaxf(gmax, gl[j]);
            float den = 0.f;
#pragma unroll
            for (int j = 0; j < 4; ++j) den += expf(gl[j] - gmax);
            const float gw = 1.0f / den;
            float el[8];
#pragma unroll
            for (int j = 0; j < 8; ++j) { float v = 0.f;
#pragma unroll
                for (int q = 0; q < 4; ++q) v = (gs == q) ? (l[4 + q * 8 + j] + P.in[22][q * 8 + j]) : v;
                el[j] = v; }
            int j1 = 0;
#pragma unroll
            for (int j = 1; j < 8; ++j) if (el[j] > el[j1]) j1 = j;
            int j2 = (j1 == 0) ? 1 : 0;
#pragma unroll
            for (int j = 0; j < 8; ++j) if (j != j1 && j != j2 && el[j] > el[j2]) j2 = j;
            float e1 = el[0], e2 = el[0];
#pragma unroll
            for (int j = 0; j < 8; ++j) { e1 = (j == j1) ? el[j] : e1; e2 = (j == j2) ? el[j] : e2; }
            const float t2 = expf(e2 - e1), w1 = gw / (1.0f + t2), w2 = gw * t2 / (1.0f + t2);
            const int ea = gs * 8 + j1, eb = gs * 8 + j2;
            ra_ = atomicAdd((int*)&lcnt[ea], 1); rb_ = atomicAdd((int*)&lcnt[eb], 1); ea_ = ea; eb_ = eb; w1_ = w1; w2_ = w2;
        }
        __syncthreads();
        if (tid < 32) { const int c = lcnt[tid]; lbase[tid] = c > 0 ? atomicAdd(cnt + tid * 64, c) : 0; }
        __syncthreads();
        if (tid < 64) {
            const int tok = rb * 64 + tid;
            list[ea_ * 16384 + lbase[ea_] + ra_] = tok * 2; wgt[tok * 2] = w1_;
            list[eb_ * 16384 + lbase[eb_] + rb_] = tok * 2 + 1; wgt[tok * 2 + 1] = w2_;
        }
        __syncthreads();
    }
}

__device__ __forceinline__ void p9_final(const Params& P, int tid, int blk, int G) {
    const int wave = tid >> 6, lane = tid & 63;
    const float* mod = (const float*)(P.ws + WS_MOD); const bf16_t* Y2 = (const bf16_t*)(P.ws + WS_Y2); const bf16_t* X1 = (const bf16_t*)(P.ws + WS_X1);
    f32x4 gf[8];
#pragma unroll
    for (int i = 0; i < 8; ++i) gf[i] = *(const f32x4*)(P.in[26] + (i * 64 + lane) * 4);
    int row = blk * 8 + wave;
    u32x2 xw[8], ya[8], yb[8], xwn[8], yan[8], ybn[8];
    if (row < NTOK) {
#pragma unroll
        for (int i = 0; i < 8; ++i) { const int k = (i * 64 + lane) * 4; xw[i] = *(const u32x2*)(X1 + (size_t)row * DM + k); ya[i] = *(const u32x2*)(Y2 + (size_t)(2 * row) * DM + k); yb[i] = *(const u32x2*)(Y2 + (size_t)(2 * row + 1) * DM + k); }
    }
    for (; row < NTOK; row += G * 8) {
        const int b = row >> 11, rown = row + G * 8;
        if (rown < NTOK) {
#pragma unroll
            for (int i = 0; i < 8; ++i) { const int k = (i * 64 + lane) * 4; xwn[i] = *(const u32x2*)(X1 + (size_t)rown * DM + k); yan[i] = *(const u32x2*)(Y2 + (size_t)(2 * rown) * DM + k); ybn[i] = *(const u32x2*)(Y2 + (size_t)(2 * rown + 1) * DM + k); }
        }
        f32x4 v[8]; float ss = 0.f;
#pragma unroll
        for (int i = 0; i < 8; ++i) {
            const int k = (i * 64 + lane) * 4;
            const f32x4 xv = {bf_lo(xw[i].x), bf_hi(xw[i].x), bf_lo(xw[i].y), bf_hi(xw[i].y)};
            const f32x4 gt = *(const f32x4*)(mod + (size_t)b * NMOD + 5 * DM + k);
            f32x4 y; y[0] = bf_lo(ya[i].x) + bf_lo(yb[i].x); y[1] = bf_hi(ya[i].x) + bf_hi(yb[i].x); y[2] = bf_lo(ya[i].y) + bf_lo(yb[i].y); y[3] = bf_hi(ya[i].y) + bf_hi(yb[i].y);
            v[i] = xv + gt * y;
            ss += v[i][0] * v[i][0] + v[i][1] * v[i][1] + v[i][2] * v[i][2] + v[i][3] * v[i][3];
        }
        ss = wave_sum(ss);
        const float r = rsqrtf(ss * (1.0f / 2048.0f) + 1e-6f);
        float* xr = P.out + (size_t)row * DM;
#pragma unroll
        for (int i = 0; i < 8; ++i) { const int k = (i * 64 + lane) * 4; *(f32x4*)(xr + k) = v[i] * r * gf[i]; }
#pragma unroll
        for (int i = 0; i < 8; ++i) { xw[i] = xwn[i]; ya[i] = yan[i]; yb[i] = ybn[i]; }
    }
}

__global__ void __launch_bounds__(NTHREADS, 2) hymba_fwd(Params P) {
    extern __shared__ __attribute__((aligned(16))) unsigned char lds_raw[];
    LAS unsigned char* lds = (LAS unsigned char*)lds_raw;
    const int tid = threadIdx.x, blk = blockIdx.x, G = gridDim.x;
    volatile LAS unsigned* misc = (volatile LAS unsigned*)(lds + LDS_MISC);
    if (tid < 64) misc[tid] = 0u;
    __syncthreads();
    XcdBarrier bar = xcd_barrier_post((unsigned*)(P.ws + WS_BAR), misc);
    const int lo = P.ph_lo, hi = P.ph_hi;
#define IN(k) (lo <= (k) && (k) < hi)
#define SEAM(k) do { if (IN(k) && IN((k) + 1)) xcd_barrier(bar); } while (0)
    unsigned char* ws = P.ws;

#ifndef REPR
#define REPR 1
#endif
#ifndef REPS
#define REPS 1
#endif
#ifndef REP0
#define REP0 1
#endif
#ifndef REP2
#define REP2 1
#endif
#ifndef REP7
#define REP7 1
#endif
#ifndef REP8
#define REP8 1
#endif
    if (IN(0)) for (int rep0 = 0; rep0 < REP0; ++rep0) {
        for (int it = blk; it < 256; it += G) p0_adaln(P, lds, tid, it);
        for (int it = blk; it < 256; it += G) p0_ssm_mats(P, lds, tid, it);
        p0_misc(P, tid, blk, G);
        p0_convert(P, lds, tid, blk, G);
        p0_convert_fp8(P, lds, tid, blk, G, 0, 12288);
    }
    SEAM(0);
    if (IN(1)) p1_norm1(P, lds, tid, blk, G);
    SEAM(1);
    if (IN(2)) for (int rep2 = 0; rep2 < REP2; ++rep2) {
        DenseSched S; S.init(NTOK, NPROJ, G, blk); S.abase = (unsigned)WS_H; S.bbase = (unsigned)WS_WIN; S.lda = DM; S.ldb = DM;
        EpiInProj E{(bf16_t*)(ws + WS_PROJ)};
        g8::gemm_phase(lds, ws, DM / 64, DM, S, E);
    }
    SEAM(2);
    if (IN(3)) {
        for (int it = blk; it < 256; it += G) ssm_item(P, lds, tid, it);
        ret_kv_items(P, lds, tid, blk, G);
    }
    SEAM(3);
    if (IN(4)) {
        for (int it = blk; it < 256; it += G) ret_out_item(P, lds, tid, it);
        __syncthreads();
        DenseSched S; S.init(NTOK, 1024, G, blk); S.abase = (unsigned)WS_Z; S.bbase = (unsigned)WS_WGLU; S.lda = 1024; S.ldb = 1024;
        EpiGlu E{(const bf16_t*)(ws + WS_Z), (bf16_t*)(ws + WS_CAT), (float*)(ws + WS_ROWSS1)};
        g8::gemm_phase(lds, ws, 1024 / 64, 1024, S, E);
    }
    SEAM(4);
    if (IN(5)) {
        OutSched S; S.init(NTOK, DM, G, blk); S.abase = (unsigned)WS_CAT; S.bbase = (unsigned)WS_WOUT;
        EpiOut E{P.in[0], (const float*)(ws + WS_MOD), (const float*)(ws + WS_ROWSS1), (float*)(ws + WS_ROWSS2), (bf16_t*)(ws + WS_X1)};
        g8::gemm_phase(lds, ws, 1024 / 64, DM, S, E);
    }
    SEAM(5);
    if (IN(6)) p6_route(P, lds, tid, blk, G);
    SEAM(6);
    if (IN(7) || IN(8)) {
        LAS int* tinfo = (LAS int*)(lds + LDS_MISC + 256); LAS int* trows = tinfo + 192; LAS int* ntl = trows + 192;
        if (tid == 0) {
            const int* cg = (const int*)(ws + WS_CNT); int nt_ = 0;
            for (int e = 0; e < 32; ++e) { const int c = cg[e * 64], full = c >> 8, rem = c & 255;
                for (int t = 0; t < full; ++t) { tinfo[nt_] = e | ((t * 256) << 8); trows[nt_] = 256; ++nt_; }
                if (rem > 128) { tinfo[nt_] = e | ((full * 256) << 8); trows[nt_] = rem; ++nt_; } }
            for (int e = 0; e < 32; ++e) { const int c = cg[e * 64], full = c >> 8, rem = c & 255; if (rem > 64 && rem <= 128) { tinfo[nt_] = e | ((full * 256) << 8); trows[nt_] = rem; ++nt_; } }
            for (int e = 0; e < 32; ++e) { const int c = cg[e * 64], full = c >> 8, rem = c & 255; if (rem > 0 && rem <= 64) { tinfo[nt_] = e | ((full * 256) << 8); trows[nt_] = rem; ++nt_; } }
            ntl[0] = nt_;
        }
        __syncthreads();
        const int ntiles = __builtin_amdgcn_readfirstlane(ntl[0]);
        if (IN(7)) {
            { u32x2* slot = (u32x2*)(ws + WS_SLOT); const int* lst = (const int*)(ws + WS_LIST); const float* wg = (const float*)(ws + WS_WGT);
              for (int ti = blk; ti < ntiles; ti += G) if (tid < 256) {
                  const int inf = tinfo[ti], e = inf & 255, r0 = inf >> 8, n = trows[ti];
                  u32x2 v; v.x = 0xffffffffu; v.y = 0u;
                  if (tid < n) { const int asg = lst[e * 16384 + r0 + tid]; v.x = (unsigned)asg; v.y = __float_as_uint(wg[asg] * (1.0f / WD_SCALE)); }
                  slot[ti * 256 + tid] = v; } }
            MoeSched S{tinfo, trows, ntiles, G, blk, (const int*)(ws + WS_LIST), (unsigned)WS_H, (unsigned)WS_WGU, 0};
            EpiMoe1 E{ws + WS_HM};
            g8::gemm_phase<EpiMoe1, MoeSched, true, true>(lds, ws, DM / 128, DM, S, E);
        }
        SEAM(7);
        if (IN(8)) {
            MoeSched S{tinfo, trows, ntiles, G, blk, (const int*)(ws + WS_LIST), (unsigned)WS_HM, (unsigned)WS_WD, 1};
            EpiMoe2 E{(const u32x2*)(ws + WS_SLOT), (bf16_t*)(ws + WS_Y2)};
            g8::gemm_phase<EpiMoe2, MoeSched, true, true>(lds, ws, DEXP / 128, DEXP, S, E);
        }
    }
    SEAM(8);
    if (IN(9)) p9_final(P, tid, blk, G);
#undef IN
#undef SEAM
}

#ifndef N_LAUNCH_SPLIT
#define N_LAUNCH_SPLIT 0
#endif
extern "C" void kernel_launch(void* const* d_in, const int* in_sizes, int n_in, void* d_out, int out_size, void* d_ws, size_t ws_size, hipStream_t stream) {
    static int grid = 0;
    if (grid == 0) {
        if (n_in != 27 || out_size != NTOK * DM || ws_size < WS_END) { fprintf(stderr, "kernel_launch: unexpected shapes (n_in %d out %d ws %zu need %zu)\n", n_in, out_size, ws_size, (size_t)WS_END); grid = -1; return; }
        int dev = 0, cus = 0, per_cu = 0;
        if (hipGetDevice(&dev) != hipSuccess || hipDeviceGetAttribute(&cus, hipDeviceAttributeMultiprocessorCount, dev) != hipSuccess) { grid = -1; return; }
        if (hipFuncSetAttribute((const void*)hymba_fwd, hipFuncAttributeMaxDynamicSharedMemorySize, LDS_BYTES) != hipSuccess) { fprintf(stderr, "kernel_launch: hipFuncSetAttribute failed\n"); grid = -1; return; }
        if (hipOccupancyMaxActiveBlocksPerMultiprocessor(&per_cu, (const void*)hymba_fwd, NTHREADS, LDS_BYTES) != hipSuccess || per_cu < 1) { fprintf(stderr, "kernel_launch: occupancy query says %d\n", per_cu); }
        (void)hipGetLastError();
        grid = cus;
    }
    if (grid < 0) return;
    (void)hipMemsetAsync((char*)d_ws + WS_BAR, 0, 16384, stream);
    Params p{};
    for (int i = 0; i < 27; ++i) p.in[i] = (const float*)d_in[i];
    p.out = (float*)d_out; p.ws = (unsigned char*)d_ws;
#if N_LAUNCH_SPLIT
    for (int ph = 0; ph < 10; ++ph) { p.ph_lo = ph; p.ph_hi = ph + 1; hipLaunchKernelGGL(hymba_fwd, dim3(grid), dim3(NTHREADS), LDS_BYTES, stream, p); }
#else
    p.ph_lo = 0; p.ph_hi = 10;
    hipLaunchKernelGGL(hymba_fwd, dim3(grid), dim3(NTHREADS), LDS_BYTES, stream, p);
#endif
    const hipError_t le = hipPeekAtLastError();
    if (le != hipSuccess) fprintf(stderr, "kernel_launch: launch failed: %s\n", hipGetErrorName(le));
}
```

```cpp
#include <hip/hip_runtime.h>
#include <cstdio>
#include <cstdint>

#define LAS __attribute__((address_space(3)))
typedef unsigned short bf16_t;
typedef short bf16x8 __attribute__((ext_vector_type(8)));
typedef short bf16x4 __attribute__((ext_vector_type(4)));
typedef float f32x4 __attribute__((ext_vector_type(4)));
typedef float f32x2 __attribute__((ext_vector_type(2)));
typedef unsigned u32x4 __attribute__((ext_vector_type(4)));
typedef unsigned u32x2 __attribute__((ext_vector_type(2)));

constexpr int DM = 2048, NB = 8, SEQ = 2048, NTOK = NB * SEQ;
constexpr int NPROJ = 5120;
constexpr int NMOD = 6 * DM;
constexpr int NEXP = 32, DEXP = 1024;
constexpr int NTHREADS = 512;

constexpr size_t WS_BAR   = 0;
constexpr size_t WS_CNT   = 16384;
constexpr size_t WS_ROWSS1= WS_CNT + 8192;
constexpr size_t WS_ROWSS2= WS_ROWSS1 + (size_t)16384 * 16 * 4;
constexpr size_t WS_MODP  = WS_ROWSS2 + (size_t)16384 * 32 * 4;
constexpr size_t WS_MOD   = WS_MODP + (size_t)4 * 8 * NMOD * 4;
constexpr size_t WS_ROPE  = WS_MOD + (size_t)8 * NMOD * 4;
constexpr size_t WS_SSMA  = WS_ROPE + (size_t)2048 * 64 * 8;
constexpr size_t WS_WR    = WS_SSMA + (size_t)64 * 64 * 8;
constexpr size_t WS_SSMM  = WS_WR + (size_t)48 * 2048 * 2;
constexpr size_t WS_WIN   = WS_SSMM + (size_t)64 * 131072 * 2;
constexpr size_t WS_WOUT  = WS_WIN + (size_t)NPROJ * DM * 2;
constexpr size_t WS_WGLU  = WS_WOUT + (size_t)DM * DM * 2;
constexpr size_t WS_WGU   = WS_WGLU + (size_t)1024 * 1024 * 2;
constexpr size_t WS_WD    = WS_WGU + (size_t)NEXP * 2048 * 2048 * 2;
constexpr size_t WS_H     = WS_WD + (size_t)NEXP * 2048 * 1024 * 2;
constexpr size_t WS_PROJ  = WS_H + (size_t)NTOK * DM * 2;
constexpr size_t WS_Z     = WS_PROJ + (size_t)NTOK * NPROJ * 2;
constexpr size_t WS_CAT   = WS_Z + (size_t)NTOK * 1024 * 2;
constexpr size_t WS_WGT   = WS_CAT + (size_t)NTOK * DM * 2;
constexpr size_t WS_LIST  = WS_WGT + (size_t)32768 * 4;
constexpr size_t WS_SLOT  = WS_LIST + (size_t)32 * 16384 * 4;
constexpr size_t WS_X1    = WS_SLOT + (size_t)192 * 256 * 8;
constexpr size_t WS_END   = WS_X1 + (size_t)NTOK * DM * 2;
constexpr size_t WS_Y2    = WS_PROJ;
constexpr size_t WS_HM    = WS_Z;

constexpr int LDS_STAGE = 131072;
constexpr int LDS_BYTES = 147456;
constexpr int LDS_MISC  = LDS_BYTES - 2048;

struct Params { const float* in[27]; float* out; unsigned char* ws; int ph_lo, ph_hi; };

#define XB_TMO      128
#define XB_XCNT(j)  (256  + 64 * (j))
#define XB_XSUB(j)  (1280 + 64 * (j))
#define XB_XGEN(j)  (2304 + 64 * (j))
#define XB_TOP      3328
#define XB_TOPGEN   3392
#define XCD_BAR_WORDS 3456
#define XB_SPIN_CAP (1u << 22)

__device__ __forceinline__ unsigned xb_ld(unsigned* p)              { return __hip_atomic_load(p, __ATOMIC_RELAXED, __HIP_MEMORY_SCOPE_AGENT); }
__device__ __forceinline__ unsigned xb_add(unsigned* p, unsigned v) { return __hip_atomic_fetch_add(p, v, __ATOMIC_RELAXED, __HIP_MEMORY_SCOPE_AGENT); }
__device__ __forceinline__ unsigned xb_xcc_id() { return (unsigned)__builtin_amdgcn_s_getreg((3 << 11) | 20) & 0xFu; }
#define XB_SPIN(cond, bar) do { unsigned _sp = 0; while (cond) { __builtin_amdgcn_s_sleep(1); \
    if ((++_sp & 255u) == 0u) { if (xb_ld(&(bar)[XB_TMO])) break; if (_sp > XB_SPIN_CAP) { atomicAdd(&(bar)[XB_TMO], 1u); break; } } } } while (0)

struct XcdBarrier { unsigned* bar; unsigned x; volatile LAS unsigned* st; };

__device__ __forceinline__ XcdBarrier xcd_barrier_post(unsigned* bar, volatile LAS unsigned* st) {
    XcdBarrier b; b.bar = bar; b.x = xb_xcc_id(); b.st = st;
    if (threadIdx.x == 0) (void)xb_add(&bar[XB_XCNT(b.x)], 1u);
    return b;
}
__device__ __forceinline__ void xcd_barrier_complete(unsigned* bar, unsigned x, unsigned& nloc, unsigned& nx) {
    const unsigned G = gridDim.x * gridDim.y * gridDim.z;
    unsigned sum, cnt, mine, sp = 0u;
    for (;;) {
        sum = 0u; cnt = 0u; mine = 0u;
#pragma unroll
        for (unsigned j = 0; j < 16; ++j) { const unsigned c = xb_ld(&bar[XB_XCNT(j)]); sum += c; cnt += (c > 0u) ? 1u : 0u; mine = (j == x) ? c : mine; }
        if (sum == G) break;
        __builtin_amdgcn_s_sleep(1);
        if ((++sp & 255u) == 0u) { if (xb_ld(&bar[XB_TMO])) break; if (sp > XB_SPIN_CAP) { atomicAdd(&bar[XB_TMO], 1u); break; } }
    }
    nloc = mine > 0u ? mine : 1u; nx = cnt > 0u ? cnt : 1u;
}
__device__ __forceinline__ void xcd_barrier(const XcdBarrier& b) {
    asm volatile("s_waitcnt vmcnt(0)" ::: "memory");
    __syncthreads();
    if (threadIdx.x == 0) {
        unsigned* bar = b.bar;
        __builtin_amdgcn_s_waitcnt(0);
        unsigned nloc = b.st[0], nx = b.st[1];
        if (nloc == 0u) { xcd_barrier_complete(bar, b.x, nloc, nx); b.st[0] = nloc; b.st[1] = nx; }
        const unsigned old = xb_add(&bar[XB_XSUB(b.x)], 1u);
        const unsigned gen = old / nloc;
        if (old + 1u == (gen + 1u) * nloc) {
            __builtin_amdgcn_fence(__ATOMIC_RELEASE, "agent");
            asm volatile("s_waitcnt vmcnt(0)" ::: "memory");
            const unsigned og = xb_add(&bar[XB_TOP], 1u);
            const unsigned tg = og / nx;
            if (og + 1u == (tg + 1u) * nx) xb_add(&bar[XB_TOPGEN], 1u);
            else XB_SPIN(xb_ld(&bar[XB_TOPGEN]) == tg, bar);
            __builtin_amdgcn_fence(__ATOMIC_ACQUIRE, "agent");
            xb_add(&bar[XB_XGEN(b.x)], 1u);
            asm volatile("s_waitcnt vmcnt(0)" ::: "memory");
        } else {
            XB_SPIN(xb_ld(&bar[XB_XGEN(b.x)]) == gen, bar);
            __builtin_amdgcn_fence(__ATOMIC_ACQUIRE, "agent");
            asm volatile("s_waitcnt vmcnt(0)" ::: "memory");
        }
    }
    __syncthreads();
}

typedef __bf16 bf16x2_t __attribute__((ext_vector_type(2)));
__device__ __forceinline__ unsigned cvt_pk_bf16(float lo, float hi) { const f32x2 v = {lo, hi}; return __builtin_bit_cast(unsigned, __builtin_convertvector(v, bf16x2_t)); }
__device__ __forceinline__ float bf_lo(unsigned w) { return __uint_as_float(w << 16); }
__device__ __forceinline__ float bf_hi(unsigned w) { return __uint_as_float(w & 0xffff0000u); }
__device__ __forceinline__ float sigmoidf_(float x) { return 1.0f / (1.0f + __expf(-x)); }
__device__ __forceinline__ float gelu_tanh(float x) {
    const float u = 0.7978845608028654f * (x + 0.044715f * x * x * x);
    const float t = 1.0f - 2.0f / (1.0f + __expf(2.0f * u));
    return 0.5f * x * (1.0f + t);
}
__device__ __forceinline__ float wave_sum(float v) {
    v += __shfl_xor(v, 1); v += __shfl_xor(v, 2); v += __shfl_xor(v, 4); v += __shfl_xor(v, 8); v += __shfl_xor(v, 16); v += __shfl_xor(v, 32); return v;
}
__device__ __forceinline__ void sincos_d(double x, double& s, double& c) {
    const double TWO_PI = 6.283185307179586476925286766559;
    double r = x - TWO_PI * rint(x / TWO_PI);
    const double r2 = r * r;
    double ts = r, tc = 1.0; s = r; c = 1.0;
#pragma unroll 1
    for (int k = 1; k <= 14; ++k) { tc *= -r2 / (double)((2 * k - 1) * (2 * k)); ts *= -r2 / (double)((2 * k) * (2 * k + 1)); c += tc; s += ts; }
}

namespace g8 {
constexpr int BM = 256, BK = 64, HALF = 128, HTB = HALF * BK * 2, NXCD = 8, WGM = 8;
__device__ __forceinline__ int lds_byte(int r, int c) { const int st = (r >> 4) * 2 + (c >> 5), rr = r & 15, cc = c & 31, ob = rr * 64 + cc * 2; return st * 1024 + (ob ^ (((ob >> 9) & 1) << 5)); }
__device__ __forceinline__ void stage_rc(int b, int& R, int& C) { const int st = b / 1024, sb = b % 1024, swz = sb ^ (((sb >> 9) & 1) << 5); R = (st >> 1) * 16 + swz / 64; C = (st & 1) * 32 + (swz % 64) / 2; }
__device__ __forceinline__ int perm32(int rho) { const int n = rho >> 4, i = rho & 15; return 8 * (i >> 2) + 4 * n + (i & 3); }

struct Unit { unsigned aoff, boff; int pm, pn, flags, aux, aux2; };
typedef f32x4 Acc[2][2][4][2];

struct StaticOrder {
    int nM, nN, nwg, G, c;
    __device__ void init(int M, int N, int G_, int c_) { nM = M / BM; nN = N / BM; nwg = nM * nN; G = G_; c = c_; }
    __device__ __forceinline__ bool tile(int i, int& pm, int& pn) const {
        const long L = (long)i * G + c; if (L >= nwg) return false;
        int wgid = (int)L; { const int q = nwg / NXCD, r = nwg % NXCD, xcd = wgid % NXCD, off = wgid / NXCD; wgid = (xcd < r ? xcd * (q + 1) : r * (q + 1) + (xcd - r) * q) + off; }
        const int nig = WGM * nN, gid = wgid / nig, fm = gid * WGM, gsz = (nM - fm) < WGM ? (nM - fm) : WGM;
        pm = fm + ((wgid % nig) % gsz); pn = (wgid % nig) / gsz; return true;
    }
};

typedef long l64x2 __attribute__((ext_vector_type(2)));
typedef int i32x4 __attribute__((ext_vector_type(4)));
typedef int i32x8 __attribute__((ext_vector_type(8)));
template <class Epi, class Sched, bool SKIP = false, int FP8 = 0>
__device__ __forceinline__ void gemm_phase(LAS unsigned char* lds, const unsigned char* ws, const int nt, const int ldb  , const Sched& S, const Epi& E) {
    const int tid = threadIdx.x, wid = __builtin_amdgcn_readfirstlane(tid >> 6), lane = tid & 63, wr = wid >> 2, wc = wid & 3, fr = lane & 15, fq = lane >> 4;
    int R0, C0, R1, C1; stage_rc(tid * 16, R0, C0); stage_rc(tid * 16 + 8192, R1, C1);
    unsigned voffB[2];
    { const int Rb0 = Epi::PERM ? ((R0 & ~31) + perm32(R0 & 31)) : R0, Rb1 = Epi::PERM ? ((R1 & ~31) + perm32(R1 & 31)) : R1;
      voffB[0] = (unsigned)(Rb0 * 64 + C0) * 2u; voffB[1] = (unsigned)(Rb1 * 64 + C1) * 2u; }
    const unsigned kstep = (unsigned)(BK * 2);
    const unsigned kstepB = 256u * 64u * 2u;
    const unsigned hstepB = (unsigned)HALF * 64u * 2u;
    const unsigned ldsw = (unsigned)wid * 1024u;
    const int aoff = lds_byte(wr * 64 + fr, fq * 8), boff = lds_byte(wc * 32 + fr, fq * 8);
#define G8_SA(b, h) (((b) * 2 + (h)) * HTB)
#define G8_SB(b, h) ((4 + (b) * 2 + (h)) * HTB)
#define G8_STAGE(bufoff, gbase, v0, v1) do { \
        __builtin_amdgcn_global_load_lds((const unsigned*)((gbase) + (v0)), (LAS unsigned*)(lds + (bufoff) + ldsw), 16, 0, 0); \
        __builtin_amdgcn_global_load_lds((const unsigned*)((gbase) + (v1)), (LAS unsigned*)(lds + (bufoff) + ldsw + 8192), 16, 0, 0); } while (0)
#define G8_LDA(dst, b, h) do { _Pragma("unroll") for (int m = 0; m < 4; ++m) _Pragma("unroll") for (int k = 0; k < 2; ++k) dst[m][k] = *(const LAS bf16x8*)(lds + G8_SA(b, h) + aoff + m * 2048 + k * 1024); } while (0)
#define G8_LDB(dst, b, h) do { _Pragma("unroll") for (int n = 0; n < 2; ++n) _Pragma("unroll") for (int k = 0; k < 2; ++k) dst[n][k] = *(const LAS bf16x8*)(lds + G8_SB(b, h) + boff + n * 2048 + k * 1024); } while (0)
#define G8_MMA(ai, bj, At, Bt) do { __builtin_amdgcn_s_setprio(1); \
        if constexpr (FP8 == 2) { _Pragma("unroll") for (int m = 0; m < 4; ++m) _Pragma("unroll") for (int n = 0; n < 2; ++n) { \
            const i32x8 a8 = __builtin_shufflevector(__builtin_bit_cast(i32x4, At[m][0]), __builtin_bit_cast(i32x4, At[m][1]), 0, 1, 2, 3, 4, 5, 6, 7); \
            const i32x8 b8 = __builtin_shufflevector(__builtin_bit_cast(i32x4, Bt[n][0]), __builtin_bit_cast(i32x4, Bt[n][1]), 0, 1, 2, 3, 4, 5, 6, 7); \
            acc[ai][bj][m][n] = __builtin_amdgcn_mfma_scale_f32_16x16x128_f8f6f4(b8, a8, acc[ai][bj][m][n], 0, 0, 0, 0x7F7F7F7F, 0, 0x7F7F7F7F); } } \
        else { _Pragma("unroll") for (int m = 0; m < 4; ++m) _Pragma("unroll") for (int n = 0; n < 2; ++n) _Pragma("unroll") for (int k = 0; k < 2; ++k) { \
        if constexpr (FP8 == 1) { const l64x2 a2 = __builtin_bit_cast(l64x2, At[m][k]), b2 = __builtin_bit_cast(l64x2, Bt[n][k]); \
            acc[ai][bj][m][n] = __builtin_amdgcn_mfma_f32_16x16x32_fp8_fp8(b2[0], a2[0], acc[ai][bj][m][n], 0, 0, 0); \
            acc[ai][bj][m][n] = __builtin_amdgcn_mfma_f32_16x16x32_fp8_fp8(b2[1], a2[1], acc[ai][bj][m][n], 0, 0, 0); } \
        else acc[ai][bj][m][n] = __builtin_amdgcn_mfma_f32_16x16x32_bf16(Bt[n][k], At[m][k], acc[ai][bj][m][n], 0, 0, 0); } } __builtin_amdgcn_s_setprio(0); } while (0)
#define G8_WAIT_V(n) asm volatile("s_waitcnt vmcnt(" #n ")" ::: "memory")
#define G8_WAIT_L(n) asm volatile("s_waitcnt lgkmcnt(" #n ")" ::: "memory")
#define G8_BAR __builtin_amdgcn_s_barrier()
#define G8_SCHED __builtin_amdgcn_sched_barrier(0)
    Unit cur, nxt; int ui = 0;
    if (!S.next(0, cur)) return;
    Acc acc;
#pragma unroll
    for (int a = 0; a < 2; ++a)
#pragma unroll
        for (int b = 0; b < 2; ++b)
#pragma unroll
            for (int m = 0; m < 4; ++m)
#pragma unroll
                for (int n = 0; n < 2; ++n) acc[a][b][m][n] = (f32x4){0.f, 0.f, 0.f, 0.f};
    bf16x8 At[4][2], B0[2][2], B1[2][2];
    unsigned cv[2][2], nv[2][2];
    S.aoffs(cur, R0, C0, R1, C1, cv);
    const unsigned char* cA = ws + cur.aoff; const unsigned char* cB = ws + cur.boff;
    G8_STAGE(G8_SB(0, 0), cB, voffB[0], voffB[1]); G8_STAGE(G8_SA(0, 0), cA, cv[0][0], cv[0][1]);
    G8_STAGE(G8_SB(0, 1), cB + hstepB, voffB[0], voffB[1]); G8_STAGE(G8_SA(0, 1), cA, cv[1][0], cv[1][1]);
    if (wr == 1) G8_BAR;
    G8_WAIT_V(4); G8_BAR;
    G8_STAGE(G8_SB(1, 0), cB + kstepB, voffB[0], voffB[1]); G8_STAGE(G8_SA(1, 0), cA + kstep, cv[0][0], cv[0][1]);
    G8_STAGE(G8_SB(1, 1), cB + hstepB + kstepB, voffB[0], voffB[1]);
    G8_WAIT_V(6); G8_BAR;
    for (;;) {
        const bool has_next = S.next(ui + 1, nxt);
        if (has_next) S.aoffs(nxt, R0, C0, R1, C1, nv);
        else { nv[0][0] = cv[0][0]; nv[0][1] = cv[0][1]; nv[1][0] = cv[1][0]; nv[1][1] = cv[1][1]; }
        const unsigned char* nA = has_next ? ws + nxt.aoff : cA; const unsigned char* nB = has_next ? ws + nxt.boff : cB;
        const int vrows = SKIP ? cur.aux2 : 256;
        const bool do0 = !SKIP || vrows > 64 || wr == 0, do1 = !SKIP || vrows > 128;
        for (int t = 0; t < nt; t += 2) {
            const bool last = (t == nt - 2);
            const unsigned char* a1 = cA + (size_t)(t + 1) * kstep;
            const unsigned char* a2 = last ? nA : cA + (size_t)(t + 2) * kstep; const unsigned char* b2 = last ? nB : cB + (size_t)(t + 2) * kstepB;
            const unsigned char* a3 = a2 + kstep; const unsigned char* b3 = b2 + kstepB;
            const unsigned o00 = last ? nv[0][0] : cv[0][0], o01 = last ? nv[0][1] : cv[0][1], o10 = last ? nv[1][0] : cv[1][0], o11 = last ? nv[1][1] : cv[1][1];
            G8_LDB(B0, 0, 0); G8_SCHED; G8_LDA(At, 0, 0); G8_STAGE(G8_SA(1, 1), a1, cv[1][0], cv[1][1]);
            G8_WAIT_L(8); G8_BAR; G8_WAIT_L(0); if (do0) G8_MMA(0, 0, At, B0); G8_BAR; G8_SCHED;
            G8_LDB(B1, 0, 1); G8_STAGE(G8_SB(0, 0), b2, voffB[0], voffB[1]);
            G8_BAR; G8_WAIT_L(0); if (do0) G8_MMA(0, 1, At, B1); G8_BAR;
            G8_LDA(At, 0, 1); G8_STAGE(G8_SA(0, 0), a2, o00, o01);
            G8_BAR; G8_WAIT_L(0); if (do1) G8_MMA(1, 0, At, B0); G8_BAR; G8_SCHED;
            G8_STAGE(G8_SB(0, 1), b2 + hstepB, voffB[0], voffB[1]);
            G8_WAIT_V(6); G8_BAR; if (do1) G8_MMA(1, 1, At, B1); G8_BAR;
            G8_LDB(B0, 1, 0); G8_SCHED; G8_LDA(At, 1, 0); G8_STAGE(G8_SA(0, 1), a2, o10, o11);
            G8_WAIT_L(8); G8_BAR; G8_WAIT_L(0); if (do0) G8_MMA(0, 0, At, B0); G8_BAR; G8_SCHED;
            G8_LDB(B1, 1, 1); G8_STAGE(G8_SB(1, 0), b3, voffB[0], voffB[1]);
            G8_BAR; G8_WAIT_L(0); if (do0) G8_MMA(0, 1, At, B1); G8_BAR;
            G8_LDA(At, 1, 1); G8_STAGE(G8_SA(1, 0), a3, o00, o01);
            G8_BAR; G8_WAIT_L(0); if (do1) G8_MMA(1, 0, At, B0); G8_BAR; G8_SCHED;
            G8_STAGE(G8_SB(1, 1), b3 + hstepB, voffB[0], voffB[1]);
            G8_WAIT_V(6); G8_BAR; if (do1) G8_MMA(1, 1, At, B1); G8_BAR;
        }
        E(acc, cur, wr, wc, fr, fq);
        if (!has_next) break;
        if (!(cur.flags & 1)) {
#pragma unroll
            for (int a = 0; a < 2; ++a)
#pragma unroll
                for (int b = 0; b < 2; ++b)
#pragma unroll
                    for (int m = 0; m < 4; ++m)
#pragma unroll
                        for (int n = 0; n < 2; ++n) acc[a][b][m][n] = (f32x4){0.f, 0.f, 0.f, 0.f};
        }
        cur = nxt; cA = nA; cB = nB; ++ui;
        cv[0][0] = nv[0][0]; cv[0][1] = nv[0][1]; cv[1][0] = nv[1][0]; cv[1][1] = nv[1][1];
    }
    G8_WAIT_V(0);
    if (wr == 0) G8_BAR;
    G8_BAR;
#undef G8_SA
#undef G8_SB
#undef G8_STAGE
#undef G8_LDA
#undef G8_LDB
#undef G8_MMA
#undef G8_WAIT_V
#undef G8_WAIT_L
#undef G8_BAR
#undef G8_SCHED
}
}

__device__ __forceinline__ void p0_adaln(const Params& P, LAS unsigned char* lds, int tid, int item) {
    const int ks = item & 3, nc = item >> 2;
    LAS float* sc = (LAS float*)lds;
    LAS float* red = (LAS float*)(lds + 16384);
    const float* c = P.in[1];
    for (int i = tid; i < 4096; i += NTHREADS) { const int kl = i >> 3, b = i & 7; const float v = c[b * 2048 + ks * 512 + kl]; sc[i] = v / (1.0f + expf(-v)); }
    __syncthreads();
    if (tid < 384) {
        const int nq = tid % 48, kg = tid / 48;
        const float* W = P.in[2] + (size_t)(ks * 512 + kg * 64) * NMOD + nc * 192 + nq * 4;
        f32x4 acc[8];
#pragma unroll
        for (int b = 0; b < 8; ++b) acc[b] = (f32x4){0.f, 0.f, 0.f, 0.f};
#pragma unroll 16
        for (int kk = 0; kk < 64; ++kk) {
            const f32x4 w = *(const f32x4*)(W + (size_t)kk * NMOD);
            const f32x4 s0 = *(const LAS f32x4*)(sc + (kg * 64 + kk) * 8), s1 = *(const LAS f32x4*)(sc + (kg * 64 + kk) * 8 + 4);
            acc[0] += w * s0[0]; acc[1] += w * s0[1]; acc[2] += w * s0[2]; acc[3] += w * s0[3];
            acc[4] += w * s1[0]; acc[5] += w * s1[1]; acc[6] += w * s1[2]; acc[7] += w * s1[3];
        }
#pragma unroll
        for (int b = 0; b < 8; ++b) *(LAS f32x4*)(red + (kg * 8 + b) * 192 + nq * 4) = acc[b];
    }
    __syncthreads();
    float* modp = (float*)(P.ws + WS_MODP);
    for (int i = tid; i < 8 * 192; i += NTHREADS) {
        const int b = i / 192, n = i % 192; float s = 0.f;
#pragma unroll
        for (int kg = 0; kg < 8; ++kg) s += red[(kg * 8 + b) * 192 + n];
        modp[(size_t)(ks * 8 + b) * NMOD + nc * 192 + n] = s;
    }
    __syncthreads();
}

struct CvtUnit { const float* src; bf16_t* dst; int Nd, Kd, k0, n0, nmode; const float* s0; const float* s1; };
constexpr int CVT_UNITS = 640 + 256 + 64;
__device__ __forceinline__ void cvt_unit_decode(const Params& P, int L, CvtUnit& u) {
    u.s0 = nullptr; u.s1 = nullptr; u.nmode = 0;
    if (L < 640) { u.src = P.in[5]; u.dst = (bf16_t*)(P.ws + WS_WIN); u.Kd = 2048; u.Nd = 5120; u.k0 = (L / 20) * 64; u.n0 = (L % 20) * 256; u.nmode = 3; return; }
    L -= 640;
    if (L < 256) { u.src = P.in[17]; u.dst = (bf16_t*)(P.ws + WS_WOUT); u.Kd = 2048; u.Nd = 2048; u.k0 = (L / 8) * 64; u.n0 = (L % 8) * 256; u.s0 = P.in[15]; u.s1 = P.in[16]; return; }
    L -= 256;
    if (L < 64) { u.src = P.in[14]; u.dst = (bf16_t*)(P.ws + WS_WGLU); u.Kd = 1024; u.Nd = 1024; u.k0 = (L / 4) * 64; u.n0 = (L % 4) * 256; return; }
    L -= 64;
    if (L < 4096) { const int e = L >> 7, r = L & 127; u.src = P.in[23] + (size_t)e * 2048 * 1024; u.dst = (bf16_t*)(P.ws + WS_WGU) + (size_t)e * 2048 * 2048; u.Kd = 2048; u.Nd = 1024; u.k0 = (r >> 2) * 64; u.n0 = (r & 3) * 256; u.nmode = 1; return; }
    L -= 4096;
    if (L < 4096) { const int e = L >> 7, r = L & 127; u.src = P.in[24] + (size_t)e * 2048 * 1024; u.dst = (bf16_t*)(P.ws + WS_WGU) + (size_t)e * 2048 * 2048; u.Kd = 2048; u.Nd = 1024; u.k0 = (r >> 2) * 64; u.n0 = (r & 3) * 256; u.nmode = 2; return; }
    L -= 4096;
    { const int e = L >> 7, r = L & 127; u.src = P.in[25] + (size_t)e * 1024 * 2048; u.dst = (bf16_t*)(P.ws + WS_WD) + (size_t)e * 2048 * 1024; u.Kd = 1024; u.Nd = 2048; u.k0 = (r >> 3) * 64; u.n0 = (r & 7) * 256; }
}
__device__ __forceinline__ void cvt_load(const CvtUnit& u, int tid, f32x4 (&r)[8]) {
    const int kp = tid >> 4, nq = tid & 15;
    const float* p = u.src + (size_t)(u.k0 + 2 * kp) * u.Nd + u.n0 + nq * 4;
#pragma unroll
    for (int s = 0; s < 4; ++s) { r[2 * s] = *(const f32x4*)(p + s * 64); r[2 * s + 1] = *(const f32x4*)(p + u.Nd + s * 64); }
    if (u.s0) {
        const int k = u.k0 + 2 * kp;
        const float a = (k < 1024) ? u.s0[k] : u.s1[k - 1024], b = (k + 1 < 1024) ? u.s0[k + 1] : u.s1[k + 1 - 1024];
#pragma unroll
        for (int s = 0; s < 4; ++s) { r[2 * s] *= a; r[2 * s + 1] *= b; }
    }
}
__device__ __forceinline__ void cvt_to_lds(LAS unsigned* tile, const f32x4 (&r)[8], int kp, int nq) {
#pragma unroll
    for (int s = 0; s < 4; ++s)
#pragma unroll
        for (int j = 0; j < 4; ++j) tile[s * 2112 + (nq * 4 + j) * 33 + kp] = cvt_pk_bf16(r[2 * s][j], r[2 * s + 1][j]);
}
__device__ __forceinline__ void cvt_store(const LAS unsigned* tile, const CvtUnit& u, int nl, int kq) {
#pragma unroll
    for (int s = 0; s < 4; ++s) {
        u32x4 w; w.x = tile[s * 2112 + nl * 33 + kq * 4]; w.y = tile[s * 2112 + nl * 33 + kq * 4 + 1]; w.z = tile[s * 2112 + nl * 33 + kq * 4 + 2]; w.w = tile[s * 2112 + nl * 33 + kq * 4 + 3];
        const int n = u.n0 + s * 64 + nl;
        int np = n;
        if (u.nmode == 1 || u.nmode == 2) np = (n >> 7) * 256 + (n & 127) + (u.nmode == 2 ? 128 : 0);
        else if (u.nmode == 3 && n >= 1024 && n < 3072) { const int reg = (n >= 2048) ? 2048 : 1024, nr = n - reg;
            np = reg + ((nr >> 8) << 8) + (((nr >> 6) & 1) << 7) + (((nr >> 7) & 1) << 6) + (nr & 63); }
        *(u32x4*)(u.dst + (size_t)(np >> 8) * ((size_t)u.Kd * 256) + (size_t)(u.k0 >> 6) * 16384 + (np & 255) * 64 + kq * 8) = w;
    }
}
__device__ __forceinline__ void p0_convert(const Params& P, LAS unsigned char* lds, int tid, int blk, int G) {
    LAS unsigned* tileA = (LAS unsigned*)lds;
    LAS unsigned* tileB = tileA + 4 * 2112;
    const int kp = tid >> 4, nq = tid & 15, nl = tid >> 3, kq = tid & 7;
    CvtUnit uA, uB, nA, nB; f32x4 rA[8], rB[8];
    int L = blk;
    if (L >= CVT_UNITS) return;
    bool hasB = (L + G) < CVT_UNITS;
    cvt_unit_decode(P, L, uA); cvt_load(uA, tid, rA);
    if (hasB) { cvt_unit_decode(P, L + G, uB); cvt_load(uB, tid, rB); }
    for (;;) {
        cvt_to_lds(tileA, rA, kp, nq);
        if (hasB) cvt_to_lds(tileB, rB, kp, nq);
        __syncthreads();
        const int Ln = L + 2 * G; const bool moreA = Ln < CVT_UNITS, moreB = (Ln + G) < CVT_UNITS;
        if (moreA) { cvt_unit_decode(P, Ln, nA); cvt_load(nA, tid, rA); }
        if (moreB) { cvt_unit_decode(P, Ln + G, nB); cvt_load(nB, tid, rB); }
        cvt_store(tileA, uA, nl, kq);
        if (hasB) cvt_store(tileB, uB, nl, kq);
        __syncthreads();
        if (!moreA) break;
        uA = nA; uB = nB; hasB = moreB; L = Ln;
    }
}

struct Cvt8Unit { const float* src; unsigned char* dst; int Nd, Kd, k0, n0, nmode; float scale; };
constexpr float WGU_SCALE = 64.0f, WD_SCALE = 32.0f;
__device__ __forceinline__ void cvt8_decode(const Params& P, int L, Cvt8Unit& u) {
    if (L < 8192) { const int up = L >= 4096; const int r_ = L & 4095; const int e = r_ >> 7, r = r_ & 127;
        u.src = P.in[up ? 24 : 23] + (size_t)e * 2048 * 1024; u.dst = P.ws + WS_WGU + (size_t)e * 2048 * 2048; u.Kd = 2048; u.Nd = 1024; u.k0 = (r >> 3) * 128; u.n0 = (r & 7) * 128; u.nmode = up ? 2 : 1; u.scale = WGU_SCALE; return; }
    L -= 8192;
    { const int e = L >> 7, r = L & 127; u.src = P.in[25] + (size_t)e * 1024 * 2048; u.dst = P.ws + WS_WD + (size_t)e * 2048 * 1024; u.Kd = 1024; u.Nd = 2048; u.k0 = (r >> 4) * 128; u.n0 = (r & 15) * 128; u.nmode = 0; u.scale = WD_SCALE; }
}
__device__ __forceinline__ void cvt8_load(const Cvt8Unit& u, int tid, f32x4 (&r)[8]) {
    const int kg = tid >> 5, nq = tid & 31;
    const float* p = u.src + (size_t)(u.k0 + 8 * kg) * u.Nd + u.n0 + nq * 4;
#pragma unroll
    for (int kk = 0; kk < 8; ++kk) r[kk] = *(const f32x4*)(p + (size_t)kk * u.Nd);
}
__device__ __forceinline__ void cvt8_to_lds(LAS unsigned* tile, const f32x4 (&r)[8], float sc, int tid) {
    const int kg = tid >> 5, nq = tid & 31;
    u32x4 w0, w1;
#pragma unroll
    for (int j = 0; j < 4; ++j) {
        int a = 0, b = 0;
        a = __builtin_amdgcn_cvt_pk_fp8_f32(r[0][j] * sc, r[1][j] * sc, a, false); a = __builtin_amdgcn_cvt_pk_fp8_f32(r[2][j] * sc, r[3][j] * sc, a, true);
        b = __builtin_amdgcn_cvt_pk_fp8_f32(r[4][j] * sc, r[5][j] * sc, b, false); b = __builtin_amdgcn_cvt_pk_fp8_f32(r[6][j] * sc, r[7][j] * sc, b, true);
        w0[j] = (unsigned)a; w1[j] = (unsigned)b;
    }
    *(LAS u32x4*)(tile + (2 * kg) * 132 + nq * 4) = w0;
    *(LAS u32x4*)(tile + (2 * kg + 1) * 132 + nq * 4) = w1;
}
__device__ __forceinline__ void cvt8_store(const LAS unsigned* tile, const Cvt8Unit& u, int tid) {
    const int nl = tid >> 2, q = tid & 3;
    u32x4 w0, w1;
    w0.x = tile[(8 * q + 0) * 132 + nl]; w0.y = tile[(8 * q + 1) * 132 + nl]; w0.z = tile[(8 * q + 2) * 132 + nl]; w0.w = tile[(8 * q + 3) * 132 + nl];
    w1.x = tile[(8 * q + 4) * 132 + nl]; w1.y = tile[(8 * q + 5) * 132 + nl]; w1.z = tile[(8 * q + 6) * 132 + nl]; w1.w = tile[(8 * q + 7) * 132 + nl];
    const int n = u.n0 + nl;
    int np = n;
    if (u.nmode == 1 || u.nmode == 2) np = (n >> 7) * 256 + (n & 127) + (u.nmode == 2 ? 128 : 0);
    unsigned char* d = u.dst + (size_t)(np >> 8) * ((size_t)u.Kd * 256) + (size_t)(u.k0 >> 7) * 32768 + (np & 255) * 128 + q * 32;
    *(u32x4*)d = w0; *(u32x4*)(d + 16) = w1;
}
__device__ __forceinline__ void p0_convert_fp8(const Params& P, LAS unsigned char* lds, int tid, int blk, int G, const int Lbeg, const int Lend) {
    LAS unsigned* tileA = (LAS unsigned*)lds;
    LAS unsigned* tileB = tileA + 32 * 132;
    Cvt8Unit uA, uB, nA, nB; f32x4 rA[8], rB[8];
    int L = Lbeg + blk;
    if (L >= Lend) return;
    bool hasB = (L + G) < Lend;
    cvt8_decode(P, L, uA); cvt8_load(uA, tid, rA);
    if (hasB) { cvt8_decode(P, L + G, uB); cvt8_load(uB, tid, rB); }
    for (;;) {
        cvt8_to_lds(tileA, rA, uA.scale, tid);
        if (hasB) cvt8_to_lds(tileB, rB, uB.scale, tid);
        __syncthreads();
        const int Ln = L + 2 * G; const bool moreA = Ln < Lend, moreB = (Ln + G) < Lend;
        if (moreA) { cvt8_decode(P, Ln, nA); cvt8_load(nA, tid, rA); }
        if (moreB) { cvt8_decode(P, Ln + G, nB); cvt8_load(nB, tid, rB); }
        cvt8_store(tileA, uA, tid);
        if (hasB) cvt8_store(tileB, uB, tid);
        __syncthreads();
        if (!moreA) break;
        uA = nA; uB = nB; hasB = moreB; L = Ln;
    }
}

__device__ __forceinline__ void p0_ssm_mats(const Params& P, LAS unsigned char* lds, int tid, int item) {
    const int g = item & 63, q = item >> 6;
    LAS f32x2* pw = (LAS f32x2*)lds;
    LAS f32x2* Bb = pw + 17 * 64;
    LAS f32x2* Cc = Bb + 64 * 16;
    LAS float* Kt = (LAS float*)(Cc + 16 * 64);
    if (tid < 64) {
        const int p = tid;
        const float dt = expf(P.in[13][g]);
        const float are = P.in[6][g * 64 + p], aim = P.in[7][g * 64 + p];
        const float mag = expf(dt * are);
        double sd, cd; sincos_d((double)(dt * aim), sd, cd);
        const float abr = mag * (float)cd, abi = mag * (float)sd;
        const float inv = 1.0f / (are * are + aim * aim);
        const float nre = abr - 1.0f;
        const float fre = (nre * are + abi * aim) * inv, fim = (abi * are - nre * aim) * inv;
        float pr = 1.0f, pi = 0.0f;
        for (int n = 0; n <= 16; ++n) { pw[n * 64 + p] = (f32x2){pr, pi}; const float t = pr * abr - pi * abi; pi = pr * abi + pi * abr; pr = t; }
        for (int h = 0; h < 16; ++h) {
            const float br = P.in[8][(g * 64 + p) * 16 + h], bi = P.in[9][(g * 64 + p) * 16 + h];
            Bb[p * 16 + h] = (f32x2){fre * br - fim * bi, fre * bi + fim * br};
            Cc[h * 64 + p] = (f32x2){P.in[10][(g * 16 + h) * 64 + p], P.in[11][(g * 16 + h) * 64 + p]};
        }
        if (q == 0) { f32x2* AL = (f32x2*)(P.ws + WS_SSMA); const f32x2 v = pw[16 * 64 + p]; AL[g * 64 + p] = v; }
    }
    __syncthreads();
    for (int o = tid; o < 4096; o += NTHREADS) {
        const int tau = o >> 8, ho = (o >> 4) & 15, hi = o & 15; float s = 0.f;
        for (int p = 0; p < 64; ++p) {
            const f32x2 c = Cc[ho * 64 + p], a = pw[tau * 64 + p], b = Bb[p * 16 + hi];
            const float cr = c.x * a.x - c.y * a.y, ci = c.x * a.y + c.y * a.x;
            s += cr * b.x - ci * b.y;
        }
        Kt[o] = s;
    }
    __syncthreads();
    bf16_t* Ms = (bf16_t*)(P.ws + WS_SSMM) + (size_t)g * 131072;
    bf16_t* TM = Ms + 32768;
    for (int o = tid; o < 32 * 128; o += NTHREADS) {
        const int row = 32 * q + (o >> 7), col = (o & 127) * 2;
        const int p = row >> 1, j = col >> 4, hi = col & 15;
        const f32x2 a = pw[(15 - j) * 64 + p], b0 = Bb[p * 16 + hi], b1 = Bb[p * 16 + hi + 1];
        float v0, v1;
        if ((row & 1) == 0) { v0 = a.x * b0.x - a.y * b0.y; v1 = a.x * b1.x - a.y * b1.y; } else { v0 = a.x * b0.y + a.y * b0.x; v1 = a.x * b1.y + a.y * b1.x; }
        *(unsigned*)(Ms + (size_t)row * 256 + col) = cvt_pk_bf16(v0, v1);
    }
    for (int o = tid; o < 64 * 192; o += NTHREADS) {
        const int row = 64 * q + o / 192, col = (o % 192) * 2;
        const int i = row >> 4, ho = row & 15; float v0, v1;
        if (col < 256) { const int j = col >> 4, hi = col & 15; if (j <= i) { v0 = Kt[((i - j) * 16 + ho) * 16 + hi]; v1 = Kt[((i - j) * 16 + ho) * 16 + hi + 1]; } else { v0 = 0.f; v1 = 0.f; } }
        else { const int p0 = (col - 256) >> 1;
            const f32x2 c0 = Cc[ho * 64 + p0], a0 = pw[(i + 1) * 64 + p0];
            v0 = c0.x * a0.x - c0.y * a0.y; v1 = -(c0.x * a0.y + c0.y * a0.x); }
        *(unsigned*)(TM + (size_t)row * 384 + col) = cvt_pk_bf16(v0, v1);
    }
    __syncthreads();
}

__device__ __forceinline__ void p0_misc(const Params& P, int tid, int blk, int G) {
    bf16_t* wr = (bf16_t*)(P.ws + WS_WR);
    for (int i = blk * NTHREADS + tid; i < 48 * 2048; i += G * NTHREADS) {
        const int n = i >> 11, k = i & 2047; float v = 0.f;
        if (n < 4) v = P.in[19][k * 4 + n]; else if (n < 36) v = P.in[21][k * 32 + (n - 4)];
        wr[i] = (bf16_t)(cvt_pk_bf16(v, 0.f) & 0xffffu);
    }
    if (blk == 0) for (int i = tid; i < 2048; i += NTHREADS) ((int*)(P.ws + WS_CNT))[i] = 0;
}

__device__ __forceinline__ void p1_norm1(const Params& P, LAS unsigned char* lds, int tid, int blk, int G) {
    const float* modp = (const float*)(P.ws + WS_MODP); const float* bada = P.in[3];
    float* mod = (float*)(P.ws + WS_MOD);
    for (int i = blk * NTHREADS + tid; i < 8 * NMOD; i += G * NTHREADS) {
        const int b = i / NMOD, j = i % NMOD;
        mod[i] = bada[j] + ((modp[(size_t)(0 * 8 + b) * NMOD + j] + modp[(size_t)(1 * 8 + b) * NMOD + j]) + (modp[(size_t)(2 * 8 + b) * NMOD + j] + modp[(size_t)(3 * 8 + b) * NMOD + j]));
    }
    LAS float* gm = (LAS float*)lds; LAS float* sh = gm + 2048;
    const int wave = tid >> 6, lane = tid & 63;
    bf16_t* H = (bf16_t*)(P.ws + WS_H);
    for (int rb = blk; rb < 256; rb += G) {
        const int b = rb >> 5;
        for (int k = tid; k < 2048; k += NTHREADS) {
            const int js = 2048 + k, jh = k;
            const float sc = bada[js] + ((modp[(size_t)(0 * 8 + b) * NMOD + js] + modp[(size_t)(1 * 8 + b) * NMOD + js]) + (modp[(size_t)(2 * 8 + b) * NMOD + js] + modp[(size_t)(3 * 8 + b) * NMOD + js]));
            const float sv = bada[jh] + ((modp[(size_t)(0 * 8 + b) * NMOD + jh] + modp[(size_t)(1 * 8 + b) * NMOD + jh]) + (modp[(size_t)(2 * 8 + b) * NMOD + jh] + modp[(size_t)(3 * 8 + b) * NMOD + jh]));
            gm[k] = P.in[4][k] * (1.0f + sc); sh[k] = sv;
        }
        __syncthreads();
        f32x4 v[8], vn[8];
        { const float* xr = P.in[0] + (size_t)(rb * 64 + wave * 8) * DM;
#pragma unroll
          for (int i = 0; i < 8; ++i) v[i] = *(const f32x4*)(xr + (i * 64 + lane) * 4); }
        for (int rr = 0; rr < 8; ++rr) {
            const int row = rb * 64 + wave * 8 + rr;
            if (rr < 7) { const float* xn = P.in[0] + (size_t)(row + 1) * DM;
#pragma unroll
                for (int i = 0; i < 8; ++i) vn[i] = *(const f32x4*)(xn + (i * 64 + lane) * 4); }
            float ss = 0.f;
#pragma unroll
            for (int i = 0; i < 8; ++i) ss += v[i][0] * v[i][0] + v[i][1] * v[i][1] + v[i][2] * v[i][2] + v[i][3] * v[i][3];
            ss = wave_sum(ss);
            const float r = rsqrtf(ss * (1.0f / 2048.0f) + 1e-6f);
#pragma unroll
            for (int i = 0; i < 8; ++i) {
                const int k = (i * 64 + lane) * 4;
                const f32x4 g4 = *(const LAS f32x4*)(gm + k), s4 = *(const LAS f32x4*)(sh + k);
                const f32x4 o = v[i] * r * g4 + s4;
                u32x2 w; w.x = cvt_pk_bf16(o[0], o[1]); w.y = cvt_pk_bf16(o[2], o[3]);
                *(u32x2*)(H + (size_t)row * DM + k) = w;
            }
#pragma unroll
            for (int i = 0; i < 8; ++i) v[i] = vn[i];
        }
        __syncthreads();
    }
}

struct DenseSched : g8::StaticOrder {
    unsigned abase, bbase; int lda, ldb;
    __device__ __forceinline__ bool next(int i, g8::Unit& u) const {
        int pm, pn; if (!tile(i, pm, pn)) return false;
        u.pm = __builtin_amdgcn_readfirstlane(pm); u.pn = __builtin_amdgcn_readfirstlane(pn); u.flags = 0; u.aux = 0;
        u.aoff = abase + (unsigned)u.pm * 256u * (unsigned)lda * 2u; u.boff = bbase + (unsigned)u.pn * 256u * (unsigned)ldb * 2u; return true;
    }
    __device__ __forceinline__ void aoffs(const g8::Unit&, int R0, int C0, int R1, int C1, unsigned (&v)[2][2]) const {
        v[0][0] = (unsigned)(R0 * lda + C0) * 2u; v[0][1] = (unsigned)(R1 * lda + C1) * 2u;
        v[1][0] = (unsigned)((128 + R0) * lda + C0) * 2u; v[1][1] = (unsigned)((128 + R1) * lda + C1) * 2u;
    }
};
struct EpiStoreBf16 {
    static constexpr bool PERM = true;
    bf16_t* O; int ldc;
    __device__ __forceinline__ void operator()(g8::Acc& acc, const g8::Unit& u, int wr, int wc, int fr, int fq) const {
        const int row0 = u.pm * 256 + wr * 64 + fr, col0 = u.pn * 256 + wc * 32 + 8 * fq;
#pragma unroll
        for (int ai = 0; ai < 2; ++ai)
#pragma unroll
            for (int m = 0; m < 4; ++m) { bf16_t* rowp = O + (size_t)(row0 + ai * 128 + m * 16) * ldc + col0;
#pragma unroll
                for (int bj = 0; bj < 2; ++bj) { const f32x4 v0 = acc[ai][bj][m][0], v1 = acc[ai][bj][m][1];
                    u32x4 w; w.x = cvt_pk_bf16(v0[0], v0[1]); w.y = cvt_pk_bf16(v0[2], v0[3]); w.z = cvt_pk_bf16(v1[0], v1[1]); w.w = cvt_pk_bf16(v1[2], v1[3]);
                    *(u32x4*)(rowp + bj * 128) = w; } }
    }
};
struct EpiInProj {
    static constexpr bool PERM = true;
    bf16_t* O;
    __device__ __forceinline__ void operator()(g8::Acc& acc, const g8::Unit& u, int wr, int wc, int fr, int fq) const {
        const int pn = u.pn;
        const int row0 = u.pm * 256 + wr * 64 + fr;
        if (pn < 4 || pn >= 12) {
            const int col0 = pn * 256 + wc * 32 + 8 * fq;
#pragma unroll
            for (int ai = 0; ai < 2; ++ai)
#pragma unroll
                for (int m = 0; m < 4; ++m) { bf16_t* rowp = O + (size_t)(row0 + ai * 128 + m * 16) * NPROJ + col0;
#pragma unroll
                    for (int bj = 0; bj < 2; ++bj) { const f32x4 v0 = acc[ai][bj][m][0], v1 = acc[ai][bj][m][1];
                        u32x4 w; w.x = cvt_pk_bf16(v0[0], v0[1]); w.y = cvt_pk_bf16(v0[2], v0[3]); w.z = cvt_pk_bf16(v1[0], v1[1]); w.w = cvt_pk_bf16(v1[2], v1[3]);
                        *(u32x4*)(rowp + bj * 128) = w; } }
            return;
        }
        const bool isq = pn < 8;
        const int head = 2 * ((pn - 4) & 3) + (wc >> 1);
        const int dd0 = 32 * (wc & 1) + 8 * fq;
        const int colbase = (isq ? 1024 : 2048) + head * 128 + dd0;
        const float lg2 = log2f(1.0f - exp2f(-5.0f - (float)head));
        float fr_[8];
#pragma unroll
        for (int t = 0; t < 8; ++t) fr_[t] = exp2f(-(float)(dd0 + t) * 0.20762050593046014f) * 0.15915494309189535f;
#pragma unroll
        for (int ai = 0; ai < 2; ++ai)
#pragma unroll
            for (int m = 0; m < 4; ++m) {
                const int row = row0 + ai * 128 + m * 16, pos = row & 2047, i = wr * 64 + m * 16 + fr;
                const float sc = isq ? exp2f(lg2 * (float)i) : exp2f(-lg2 * (float)i) * 0.08838834764831845f;
                const float fp = (float)pos;
                float o1[8], o2[8];
#pragma unroll
                for (int t = 0; t < 8; ++t) {
                    const float rev = __builtin_amdgcn_fractf(fp * fr_[t]);
                    const float cs = __builtin_amdgcn_cosf(rev) * sc, sn = __builtin_amdgcn_sinf(rev) * sc;
                    const float a = acc[ai][0][m][t >> 2][t & 3], b = acc[ai][1][m][t >> 2][t & 3];
                    o1[t] = a * cs - b * sn; o2[t] = b * cs + a * sn;
                }
                bf16_t* rowp = O + (size_t)row * NPROJ + colbase;
                u32x4 w1, w2; w1.x = cvt_pk_bf16(o1[0], o1[1]); w1.y = cvt_pk_bf16(o1[2], o1[3]); w1.z = cvt_pk_bf16(o1[4], o1[5]); w1.w = cvt_pk_bf16(o1[6], o1[7]);
                w2.x = cvt_pk_bf16(o2[0], o2[1]); w2.y = cvt_pk_bf16(o2[2], o2[3]); w2.z = cvt_pk_bf16(o2[4], o2[5]); w2.w = cvt_pk_bf16(o2[6], o2[7]);
                *(u32x4*)rowp = w1; *(u32x4*)(rowp + 64) = w2;
            }
    }
};
struct EpiGlu {
    static constexpr bool PERM = true;
    const bf16_t* Z; bf16_t* CAT; float* rowss;
    __device__ __forceinline__ void operator()(g8::Acc& acc, const g8::Unit& u, int wr, int wc, int fr, int fq) const {
        const int row0 = u.pm * 256 + wr * 64 + fr, col0 = u.pn * 256 + wc * 32 + 8 * fq;
#pragma unroll
        for (int ai = 0; ai < 2; ++ai) {
            u32x4 zz[4][2];
#pragma unroll
            for (int m = 0; m < 4; ++m)
#pragma unroll
                for (int bj = 0; bj < 2; ++bj) zz[m][bj] = *(const u32x4*)(Z + (size_t)(row0 + ai * 128 + m * 16) * 1024 + col0 + bj * 128);
#pragma unroll
            for (int m = 0; m < 4; ++m) { const int row = row0 + ai * 128 + m * 16; float ss = 0.f;
#pragma unroll
                for (int bj = 0; bj < 2; ++bj) { const f32x4 v0 = acc[ai][bj][m][0], v1 = acc[ai][bj][m][1];
                    const u32x4 z4 = zz[m][bj];
                    float o[8];
                    o[0] = bf_lo(z4.x) * sigmoidf_(v0[0]); o[1] = bf_hi(z4.x) * sigmoidf_(v0[1]); o[2] = bf_lo(z4.y) * sigmoidf_(v0[2]); o[3] = bf_hi(z4.y) * sigmoidf_(v0[3]);
                    o[4] = bf_lo(z4.z) * sigmoidf_(v1[0]); o[5] = bf_hi(z4.z) * sigmoidf_(v1[1]); o[6] = bf_lo(z4.w) * sigmoidf_(v1[2]); o[7] = bf_hi(z4.w) * sigmoidf_(v1[3]);
#pragma unroll
                    for (int j = 0; j < 8; ++j) ss += o[j] * o[j];
                    u32x4 w; w.x = cvt_pk_bf16(o[0], o[1]); w.y = cvt_pk_bf16(o[2], o[3]); w.z = cvt_pk_bf16(o[4], o[5]); w.w = cvt_pk_bf16(o[6], o[7]);
                    *(u32x4*)(CAT + (size_t)row * DM + col0 + bj * 128) = w; }
                ss += __shfl_xor(ss, 16); ss += __shfl_xor(ss, 32);
                if (fq == 0) rowss[(size_t)row * 16 + u.pn * 4 + wc] = ss; }
        }
    }
};
struct OutSched : g8::StaticOrder {
    unsigned abase, bbase;
    __device__ __forceinline__ bool next(int i, g8::Unit& u) const {
        int pm, pn; if (!tile(i >> 1, pm, pn)) return false;
        const int half = i & 1;
        u.pm = __builtin_amdgcn_readfirstlane(pm); u.pn = __builtin_amdgcn_readfirstlane(pn); u.flags = half ? 0 : 1; u.aux = half;
        u.aoff = abase + (unsigned)u.pm * 256u * 4096u + (unsigned)half * 2048u; u.boff = bbase + (unsigned)u.pn * 256u * 4096u + (unsigned)half * (16u * 32768u); return true;
    }
    __device__ __forceinline__ void aoffs(const g8::Unit&, int R0, int C0, int R1, int C1, unsigned (&v)[2][2]) const {
        v[0][0] = (unsigned)(R0 * 2048 + C0) * 2u; v[0][1] = (unsigned)(R1 * 2048 + C1) * 2u;
        v[1][0] = (unsigned)((128 + R0) * 2048 + C0) * 2u; v[1][1] = (unsigned)((128 + R1) * 2048 + C1) * 2u;
    }
};
struct EpiOut {
    static constexpr bool PERM = true;
    const float* x; const float* mod; const float* rowss1; float* rowss2; bf16_t* X1;
    __device__ __forceinline__ void operator()(g8::Acc& acc, const g8::Unit& u, int wr, int wc, int fr, int fq) const {
        const int row0 = u.pm * 256 + wr * 64 + fr;
        if (u.aux == 0) {
#pragma unroll
            for (int ai = 0; ai < 2; ++ai)
#pragma unroll
                for (int m = 0; m < 4; ++m) { const f32x4* pp = (const f32x4*)(rowss1 + (size_t)(row0 + ai * 128 + m * 16) * 16);
                    const f32x4 p0 = pp[0], p1 = pp[1], p2 = pp[2], p3 = pp[3];
                    const float tot = (((p0[0] + p0[1]) + (p0[2] + p0[3])) + ((p1[0] + p1[1]) + (p1[2] + p1[3]))) + (((p2[0] + p2[1]) + (p2[2] + p2[3])) + ((p3[0] + p3[1]) + (p3[2] + p3[3])));
                    const float r = rsqrtf(tot * (1.0f / 1024.0f) + 1e-6f);
#pragma unroll
                    for (int bj = 0; bj < 2; ++bj)
#pragma unroll
                        for (int n = 0; n < 2; ++n) acc[ai][bj][m][n] *= r; }
            return;
        }
        const int col0 = u.pn * 256 + wc * 32 + 8 * fq;
        const int b = (u.pm * 256) >> 11;
        f32x4 gt[2][2];
#pragma unroll
        for (int bj = 0; bj < 2; ++bj)
#pragma unroll
            for (int n = 0; n < 2; ++n) gt[bj][n] = *(const f32x4*)(mod + (size_t)b * NMOD + 2 * DM + col0 + bj * 128 + n * 4);
#pragma unroll
        for (int am = 0; am < 4; ++am) {
            const int ai = am >> 1, m0 = (am & 1) * 2;
            f32x4 xv[2][2][2];
#pragma unroll
            for (int mm = 0; mm < 2; ++mm)
#pragma unroll
                for (int bj = 0; bj < 2; ++bj) { const size_t off = (size_t)(row0 + ai * 128 + (m0 + mm) * 16) * DM + col0 + bj * 128; xv[mm][bj][0] = *(const f32x4*)(x + off); xv[mm][bj][1] = *(const f32x4*)(x + off + 4); }
#pragma unroll
            for (int mm = 0; mm < 2; ++mm) { const int m = m0 + mm; const int row = row0 + ai * 128 + m * 16; float ss = 0.f;
#pragma unroll
                for (int bj = 0; bj < 2; ++bj) { const size_t off = (size_t)row * DM + col0 + bj * 128;
                    const f32x4 o0 = xv[mm][bj][0] + gt[bj][0] * acc[ai][bj][m][0], o1 = xv[mm][bj][1] + gt[bj][1] * acc[ai][bj][m][1];
                    ss += (o0[0] * o0[0] + o0[1] * o0[1]) + (o0[2] * o0[2] + o0[3] * o0[3]) + (o1[0] * o1[0] + o1[1] * o1[1]) + (o1[2] * o1[2] + o1[3] * o1[3]);
                    u32x4 w; w.x = cvt_pk_bf16(o0[0], o0[1]); w.y = cvt_pk_bf16(o0[2], o0[3]); w.z = cvt_pk_bf16(o1[0], o1[1]); w.w = cvt_pk_bf16(o1[2], o1[3]);
                    *(u32x4*)(X1 + off) = w; }
                ss += __shfl_xor(ss, 16); ss += __shfl_xor(ss, 32);
                if (fq == 0) rowss2[(size_t)row * 32 + u.pn * 4 + wc] = ss; }
        }
    }
};
struct MoeSched {
    const LAS int* tinfo; const LAS int* trows; int ntiles; int G, c; const int* list; unsigned abase, bbase; int mode;
    __device__ __forceinline__ bool next(int i, g8::Unit& u) const {
        int pn, ti;
        if ((G & 63) == 0) { const int x = c & 7, r = c >> 3, per = G >> 6;
            ti = (i * 8 + x) * per + (r >> 3); pn = r & 7; }
        else { const int L = i * G + c; pn = L & 7; ti = L >> 3; }
        if (ti >= ntiles) return false;
        const int inf = __builtin_amdgcn_readfirstlane(tinfo[ti]);
        const int e = inf & 255;
        u.pm = __builtin_amdgcn_readfirstlane(ti); u.pn = pn; u.flags = 0; u.aux = inf; u.aux2 = __builtin_amdgcn_readfirstlane(trows[ti]);
        if (mode == 0) { u.aoff = abase; u.boff = bbase + (unsigned)e * (2048u * 2048u) + (unsigned)pn * (256u * 2048u); }
        else { u.aoff = abase + (unsigned)ti * (256u * 1024u); u.boff = bbase + (unsigned)e * (2048u * 1024u) + (unsigned)pn * (256u * 1024u); }
        return true;
    }
    __device__ __forceinline__ void aoffs(const g8::Unit& u, int R0, int C0, int R1, int C1, unsigned (&v)[2][2]) const {
        if (mode == 0) {
            const int e = u.aux & 255, r0 = u.aux >> 8, n = u.aux2; const int* le = list + e * 16384 + r0;
            const int i00 = R0, i01 = R1, i10 = 128 + R0, i11 = 128 + R1;
            const int t00 = (i00 < n) ? (le[i00] >> 1) : 0, t01 = (i01 < n) ? (le[i01] >> 1) : 0, t10 = (i10 < n) ? (le[i10] >> 1) : 0, t11 = (i11 < n) ? (le[i11] >> 1) : 0;
            v[0][0] = (unsigned)(t00 * 2048 + C0 * 2); v[0][1] = (unsigned)(t01 * 2048 + C1 * 2); v[1][0] = (unsigned)(t10 * 2048 + C0 * 2); v[1][1] = (unsigned)(t11 * 2048 + C1 * 2);
        } else {
            v[0][0] = (unsigned)(R0 * 1024 + C0 * 2); v[0][1] = (unsigned)(R1 * 1024 + C1 * 2);
            v[1][0] = (unsigned)((128 + R0) * 1024 + C0 * 2); v[1][1] = (unsigned)((128 + R1) * 1024 + C1 * 2);
        }
    }
};
struct EpiMoe1 {
    static constexpr bool PERM = true;
    unsigned char* HM;
    __device__ __forceinline__ void operator()(g8::Acc& acc, const g8::Unit& u, int wr, int wc, int fr, int fq) const {
        const int row0 = u.pm * 256 + wr * 64 + fr, col0 = u.pn * 128 + wc * 32 + 8 * fq;
        const float inv = 1.0f / WGU_SCALE;
#pragma unroll
        for (int ai = 0; ai < 2; ++ai)
#pragma unroll
            for (int m = 0; m < 4; ++m) { float o[8];
#pragma unroll
                for (int n = 0; n < 2; ++n)
#pragma unroll
                    for (int j = 0; j < 4; ++j) { const float gv = acc[ai][0][m][n][j] * inv, uv = acc[ai][1][m][n][j] * inv; o[n * 4 + j] = gv * sigmoidf_(gv) * uv; }
                int q0 = 0, q1 = 0;
                q0 = __builtin_amdgcn_cvt_pk_fp8_f32(o[0], o[1], q0, false); q0 = __builtin_amdgcn_cvt_pk_fp8_f32(o[2], o[3], q0, true);
                q1 = __builtin_amdgcn_cvt_pk_fp8_f32(o[4], o[5], q1, false); q1 = __builtin_amdgcn_cvt_pk_fp8_f32(o[6], o[7], q1, true);
                *(u32x2*)(HM + (size_t)(row0 + ai * 128 + m * 16) * 1024 + col0) = (u32x2){(unsigned)q0, (unsigned)q1}; }
    }
};
struct EpiMoe2 {
    static constexpr bool PERM = true;
    const u32x2* slot; bf16_t* Y2;
    __device__ __forceinline__ void operator()(g8::Acc& acc, const g8::Unit& u, int wr, int wc, int fr, int fq) const {
        const int col0 = u.pn * 256 + wc * 32 + 8 * fq;
        u32x2 si[2][4];
#pragma unroll
        for (int ai = 0; ai < 2; ++ai)
#pragma unroll
            for (int m = 0; m < 4; ++m) si[ai][m] = slot[u.pm * 256 + ai * 128 + wr * 64 + m * 16 + fr];
#pragma unroll
        for (int ai = 0; ai < 2; ++ai)
#pragma unroll
            for (int m = 0; m < 4; ++m) { const int asg = (int)si[ai][m].x;
                if (asg >= 0) { bf16_t* rowp = Y2 + (size_t)asg * DM + col0; const float ww = __uint_as_float(si[ai][m].y);
#pragma unroll
                    for (int bj = 0; bj < 2; ++bj) { const f32x4 v0 = acc[ai][bj][m][0] * ww, v1 = acc[ai][bj][m][1] * ww;
                        u32x4 w; w.x = cvt_pk_bf16(v0[0], v0[1]); w.y = cvt_pk_bf16(v0[2], v0[3]); w.z = cvt_pk_bf16(v1[0], v1[1]); w.w = cvt_pk_bf16(v1[2], v1[3]);
                        *(u32x4*)(rowp + bj * 128) = w; } } }
    }
};

constexpr size_t WS_KV = WS_H;
__device__ __forceinline__ void ssm_item(const Params& P, LAS unsigned char* lds, int tid, int item) {
    const int g = item >> 2, bp = item & 3;
    const int wave = __builtin_amdgcn_readfirstlane(tid >> 6), lane = tid & 63, fr = lane & 15, fq = lane >> 4;
    const bf16_t* proj = (const bf16_t*)(P.ws + WS_PROJ);
    const bf16_t* Ms = (const bf16_t*)(P.ws + WS_SSMM) + (size_t)g * 131072;
    const bf16_t* TM = Ms + 32768;
    bf16_t* Zo = (bf16_t*)(P.ws + WS_Z);
    constexpr int ZS = 136, MS = 264, TS = 392;
    LAS bf16_t* ZB = (LAS bf16_t*)lds;
    LAS bf16_t* WB = (LAS bf16_t*)(lds + 256 * ZS * 2);
    const int b = 2 * bp + (wave >> 2);
    int tok0[2];
    bf16x8 Uf[2][8];
#pragma unroll
    for (int mt = 0; mt < 2; ++mt) {
        const int c = 32 * (wave & 3) + 16 * mt + fr; tok0[mt] = b * 2048 + c * 16;
#pragma unroll
        for (int ks = 0; ks < 8; ++ks) Uf[mt][ks] = *(const bf16x8*)(proj + (size_t)(tok0[mt] + 2 * ks + (fq >> 1)) * NPROJ + g * 16 + 8 * (fq & 1));
    }
#pragma unroll
    for (int i = 0; i < 8; ++i) { const int row = tid >> 2, kc = (tid & 3) + 4 * i; *(LAS u32x4*)(WB + row * MS + kc * 8) = *(const u32x4*)(Ms + row * 256 + kc * 8); }
    __syncthreads();
#pragma unroll
    for (int nt = 0; nt < 8; ++nt) {
        f32x4 a0 = {0.f, 0.f, 0.f, 0.f}, a1 = {0.f, 0.f, 0.f, 0.f};
#pragma unroll
        for (int ks = 0; ks < 8; ++ks) {
            const bf16x8 bf = *(const LAS bf16x8*)(WB + (16 * nt + fr) * MS + 32 * ks + 8 * fq);
            a0 = __builtin_amdgcn_mfma_f32_16x16x32_bf16(bf, Uf[0][ks], a0, 0, 0, 0);
            a1 = __builtin_amdgcn_mfma_f32_16x16x32_bf16(bf, Uf[1][ks], a1, 0, 0, 0);
        }
        *(LAS u32x2*)(ZB + (32 * wave + fr) * ZS + 16 * nt + 4 * fq) = (u32x2){cvt_pk_bf16(a0[0], a0[1]), cvt_pk_bf16(a0[2], a0[3])};
        *(LAS u32x2*)(ZB + (32 * wave + 16 + fr) * ZS + 16 * nt + 4 * fq) = (u32x2){cvt_pk_bf16(a1[0], a1[1]), cvt_pk_bf16(a1[2], a1[3])};
    }
    u32x4 tmr[6];
#pragma unroll
    for (int i = 0; i < 6; ++i) { const int row = tid >> 3, kc = (tid & 7) + 8 * i; tmr[i] = *(const u32x4*)(TM + (size_t)row * 384 + kc * 8); }
    __syncthreads();
    if (tid < 128) {
        const int bl = tid >> 6, p = tid & 63;
        const f32x2 al = ((const f32x2*)(P.ws + WS_SSMA))[g * 64 + p];
        float xr = 0.f, xi = 0.f;
        LAS unsigned* zw = (LAS unsigned*)ZB + (bl * 128) * (ZS / 2) + p;
        for (int c0 = 0; c0 < 128; c0 += 8) {
            unsigned zv[8];
#pragma unroll
            for (int k = 0; k < 8; ++k) zv[k] = zw[(c0 + k) * (ZS / 2)];
#pragma unroll
            for (int k = 0; k < 8; ++k) {
                zw[(c0 + k) * (ZS / 2)] = cvt_pk_bf16(xr, xi);
                const float t = al.x * xr - al.y * xi + bf_lo(zv[k]); xi = al.x * xi + al.y * xr + bf_hi(zv[k]); xr = t;
            }
        }
    }
#pragma unroll
    for (int i = 0; i < 6; ++i) { const int row = tid >> 3, kc = (tid & 7) + 8 * i; *(LAS u32x4*)(WB + row * TS + kc * 8) = tmr[i]; }
    __syncthreads();
    const LAS bf16_t* xrow = ZB + (32 * wave + fr) * ZS + 8 * fq;
    const f32x4 dv = *(const f32x4*)(P.in[12] + g * 16 + 4 * fq);
#pragma unroll
    for (int cq = 0; cq < 4; ++cq) {
        u32x2 uu[4][2];
#pragma unroll
        for (int ntl = 0; ntl < 4; ++ntl)
#pragma unroll
            for (int mt = 0; mt < 2; ++mt) uu[ntl][mt] = *(const u32x2*)(proj + (size_t)(tok0[mt] + 4 * cq + ntl) * NPROJ + g * 16 + 4 * fq);
        if (cq < 3) {
#pragma unroll
            for (int i = 0; i < 6; ++i) { const int row = tid >> 3, kc = (tid & 7) + 8 * i; tmr[i] = *(const u32x4*)(TM + (size_t)(64 * (cq + 1) + row) * 384 + kc * 8); }
        }
#pragma unroll
        for (int ntl = 0; ntl < 4; ++ntl) {
            const int nt = 4 * cq + ntl;
            f32x4 a0 = {0.f, 0.f, 0.f, 0.f}, a1 = {0.f, 0.f, 0.f, 0.f};
            const LAS bf16_t* brow = WB + (16 * ntl + fr) * TS + 8 * fq;
#pragma unroll
            for (int ks = 0; ks < 8; ++ks) {
                if (2 * ks <= nt) {
                    const bf16x8 bf = *(const LAS bf16x8*)(brow + 32 * ks);
                    a0 = __builtin_amdgcn_mfma_f32_16x16x32_bf16(bf, Uf[0][ks], a0, 0, 0, 0);
                    a1 = __builtin_amdgcn_mfma_f32_16x16x32_bf16(bf, Uf[1][ks], a1, 0, 0, 0);
                }
            }
#pragma unroll
            for (int k2 = 0; k2 < 4; ++k2) {
                const bf16x8 bf = *(const LAS bf16x8*)(brow + 256 + 32 * k2);
                const bf16x8 x0 = *(const LAS bf16x8*)(xrow + 32 * k2), x1 = *(const LAS bf16x8*)(xrow + 16 * ZS + 32 * k2);
                a0 = __builtin_amdgcn_mfma_f32_16x16x32_bf16(bf, x0, a0, 0, 0, 0);
                a1 = __builtin_amdgcn_mfma_f32_16x16x32_bf16(bf, x1, a1, 0, 0, 0);
            }
#pragma unroll
            for (int mt = 0; mt < 2; ++mt) {
                const f32x4 a = mt ? a1 : a0;
                const size_t tok = (size_t)(tok0[mt] + nt);
                const u32x2 u2 = uu[ntl][mt];
                const float y0 = a[0] + dv[0] * bf_lo(u2.x), y1 = a[1] + dv[1] * bf_hi(u2.x), y2 = a[2] + dv[2] * bf_lo(u2.y), y3 = a[3] + dv[3] * bf_hi(u2.y);
                u32x2 w; w.x = cvt_pk_bf16(gelu_tanh(y0), gelu_tanh(y1)); w.y = cvt_pk_bf16(gelu_tanh(y2), gelu_tanh(y3));
                *(u32x2*)(Zo + tok * 1024 + g * 16 + 4 * fq) = w;
            }
        }
        __syncthreads();
        if (cq < 3) {
#pragma unroll
            for (int i = 0; i < 6; ++i) { const int row = tid >> 3, kc = (tid & 7) + 8 * i; *(LAS u32x4*)(WB + row * TS + kc * 8) = tmr[i]; }
            __syncthreads();
        }
    }
}

__device__ __forceinline__ bf16x8 tr_frag(const LAS bf16_t* tile, int row0, int col0, int fr, int fq) {
    const LAS bf16_t* p = tile + (row0 + 8 * fq + (fr >> 2)) * 136 + col0 + 4 * (fr & 3);
    const bf16x4 a = __builtin_amdgcn_ds_read_tr16_b64_v4i16((LAS bf16x4*)p);
    const bf16x4 b = __builtin_amdgcn_ds_read_tr16_b64_v4i16((LAS bf16x4*)(p + 4 * 136));
    bf16x8 r; r[0] = a[0]; r[1] = a[1]; r[2] = a[2]; r[3] = a[3]; r[4] = b[0]; r[5] = b[1]; r[6] = b[2]; r[7] = b[3]; return r;
}
__device__ __forceinline__ void ret_kv_items(const Params& P, LAS unsigned char* lds, int tid, int first, int stride) {
    const int wave = __builtin_amdgcn_readfirstlane(tid >> 6), lane = tid & 63, fr = lane & 15, fq = lane >> 4;
    constexpr int RS = 136;
    LAS bf16_t* Ks = (LAS bf16_t*)lds; LAS bf16_t* Vs = Ks + 128 * RS;
    const bf16_t* proj = (const bf16_t*)(P.ws + WS_PROJ);
    bf16_t* KV = (bf16_t*)(P.ws + WS_KV);
    const int si = tid >> 2, part = tid & 3, i0 = 16 * wave;
    u32x4 kr[4], vr[4];
    int item = first;
    if (item >= 768) return;
    { const int bh = item / 12, n = item % 12; const bf16_t* pr = proj + ((size_t)(bh >> 3) * 2048 + n * 128 + si) * NPROJ + (bh & 7) * 128 + 32 * part;
#pragma unroll
      for (int j = 0; j < 4; ++j) { kr[j] = *(const u32x4*)(pr + 2048 + 8 * j); vr[j] = *(const u32x4*)(pr + 3072 + 8 * j); } }
    for (;;) {
#pragma unroll
        for (int j = 0; j < 4; ++j) { *(LAS u32x4*)(Ks + si * RS + 32 * part + 8 * j) = kr[j]; *(LAS u32x4*)(Vs + si * RS + 32 * part + 8 * j) = vr[j]; }
        __syncthreads();
        const int nxt = item + stride; const bool more = nxt < 768;
        if (more) { const int bh = nxt / 12, n = nxt % 12; const bf16_t* pr = proj + ((size_t)(bh >> 3) * 2048 + n * 128 + si) * NPROJ + (bh & 7) * 128 + 32 * part;
#pragma unroll
            for (int j = 0; j < 4; ++j) { kr[j] = *(const u32x4*)(pr + 2048 + 8 * j); vr[j] = *(const u32x4*)(pr + 3072 + 8 * j); } }
        bf16x8 Vt[4];
#pragma unroll
        for (int ks = 0; ks < 4; ++ks) Vt[ks] = tr_frag(Vs, 32 * ks, i0, fr, fq);
        const int bh = item / 12, n = item % 12;
        bf16_t* op = KV + ((size_t)(bh * 16 + n) * 128 + i0 + fr) * 128 + 4 * fq;
#pragma unroll
        for (int nt = 0; nt < 8; ++nt) {
            f32x4 a = {0.f, 0.f, 0.f, 0.f};
#pragma unroll
            for (int ks = 0; ks < 4; ++ks) { const bf16x8 kf = tr_frag(Ks, 32 * ks, 16 * nt, fr, fq); a = __builtin_amdgcn_mfma_f32_16x16x32_bf16(kf, Vt[ks], a, 0, 0, 0); }
            *(u32x2*)(op + 16 * nt) = (u32x2){cvt_pk_bf16(a[0], a[1]), cvt_pk_bf16(a[2], a[3])};
        }
        __syncthreads();
        if (!more) break;
        item = nxt;
    }
}
__device__ __forceinline__ void ret_out_item(const Params& P, LAS unsigned char* lds, int tid, int item) {
    const int bh = item >> 2, q = item & 3, b = bh >> 3, h = bh & 7;
    const int wave = __builtin_amdgcn_readfirstlane(tid >> 6), lane = tid & 63, fr = lane & 15, fq = lane >> 4;
    constexpr int RS = 136;
    LAS bf16_t* Qs = (LAS bf16_t*)lds;
    LAS bf16_t* Ks = Qs + 128 * RS;
    LAS bf16_t* Vs = Ks + 128 * RS;
    LAS bf16_t* Rs = Vs + 128 * RS;
    const bf16_t* proj = (const bf16_t*)(P.ws + WS_PROJ);
    const bf16_t* KV = (const bf16_t*)(P.ws + WS_KV);
    bf16_t* CAT = (bf16_t*)(P.ws + WS_CAT);
    const float gam = 1.0f - exp2f(-5.0f - (float)h);
    const float lg2 = log2f(gam);
    const float gC1 = exp2f(lg2 * 127.0f), gC = exp2f(lg2 * 128.0f);
    const int si = tid >> 2, part = tid & 3, i0 = 16 * wave;
    u32x4 st[12];
    { const bf16_t* pr = proj + ((size_t)b * 2048 + (4 * q) * 128 + si) * NPROJ + h * 128 + 32 * part;
#pragma unroll
      for (int j = 0; j < 4; ++j) { st[j] = *(const u32x4*)(pr + 1024 + 8 * j); st[4 + j] = *(const u32x4*)(pr + 2048 + 8 * j); st[8 + j] = *(const u32x4*)(pr + 3072 + 8 * j); } }
    f32x4 accR[8];
#pragma unroll
    for (int nt = 0; nt < 8; ++nt) accR[nt] = (f32x4){0.f, 0.f, 0.f, 0.f};
    for (int m = 0; m < 4 * q; ++m) {
        const bf16_t* tp = KV + ((size_t)(bh * 16 + m) * 128 + i0 + fr) * 128 + 4 * fq;
        u32x2 t[8];
#pragma unroll
        for (int nt = 0; nt < 8; ++nt) t[nt] = *(const u32x2*)(tp + 16 * nt);
#pragma unroll
        for (int nt = 0; nt < 8; ++nt) { const f32x4 kv = {bf_lo(t[nt].x), bf_hi(t[nt].x), bf_lo(t[nt].y), bf_hi(t[nt].y)}; accR[nt] = accR[nt] * gC + kv * gC1; }
    }
#pragma unroll
    for (int nt = 0; nt < 8; ++nt)
        *(LAS u32x2*)(Rs + (i0 + fr) * RS + 16 * nt + 4 * fq) = (u32x2){cvt_pk_bf16(accR[nt][0], accR[nt][1]), cvt_pk_bf16(accR[nt][2], accR[nt][3])};
    for (int nn = 0; nn < 4; ++nn) {
        const int n = 4 * q + nn;
#pragma unroll
        for (int j = 0; j < 4; ++j) { *(LAS u32x4*)(Qs + si * RS + 32 * part + 8 * j) = st[j]; *(LAS u32x4*)(Ks + si * RS + 32 * part + 8 * j) = st[4 + j]; *(LAS u32x4*)(Vs + si * RS + 32 * part + 8 * j) = st[8 + j]; }
        __syncthreads();
        if (nn < 3) { const bf16_t* pr = proj + ((size_t)b * 2048 + (n + 1) * 128 + si) * NPROJ + h * 128 + 32 * part;
#pragma unroll
            for (int j = 0; j < 4; ++j) { st[j] = *(const u32x4*)(pr + 1024 + 8 * j); st[4 + j] = *(const u32x4*)(pr + 2048 + 8 * j); st[8 + j] = *(const u32x4*)(pr + 3072 + 8 * j); } }
        const size_t tok = (size_t)b * 2048 + n * 128 + i0 + fr;
        u32x2 gg[8];
        { const bf16_t* gp = proj + tok * NPROJ + 4096 + h * 128 + 4 * fq;
#pragma unroll
          for (int nt = 0; nt < 8; ++nt) gg[nt] = *(const u32x2*)(gp + 16 * nt); }
        bf16x8 Qf[4];
#pragma unroll
        for (int ks = 0; ks < 4; ++ks) Qf[ks] = *(const LAS bf16x8*)(Qs + (i0 + fr) * RS + 32 * ks + 8 * fq);
        f32x4 accS[8], accO[8];
#pragma unroll
        for (int nt = 0; nt < 8; ++nt) { accS[nt] = (f32x4){0.f, 0.f, 0.f, 0.f}; accO[nt] = (f32x4){0.f, 0.f, 0.f, 0.f}; }
#pragma unroll
        for (int nt = 0; nt < 8; ++nt) {
            if (nt <= wave) {
#pragma unroll
                for (int ks = 0; ks < 4; ++ks) { const bf16x8 kf = *(const LAS bf16x8*)(Ks + (16 * nt + fr) * RS + 32 * ks + 8 * fq); accS[nt] = __builtin_amdgcn_mfma_f32_16x16x32_bf16(kf, Qf[ks], accS[nt], 0, 0, 0); }
            }
        }
        if (n > 0) {
#pragma unroll
            for (int nt = 0; nt < 8; ++nt) {
#pragma unroll
                for (int ks = 0; ks < 4; ++ks) { const bf16x8 rf = *(const LAS bf16x8*)(Rs + (16 * nt + fr) * RS + 32 * ks + 8 * fq); accO[nt] = __builtin_amdgcn_mfma_f32_16x16x32_bf16(rf, Qf[ks], accO[nt], 0, 0, 0); }
                accO[nt] *= gam;
            }
        }
#pragma unroll
        for (int nt = 0; nt < 8; ++nt) {
            const int i = i0 + fr, j0 = 16 * nt + 4 * fq;
            const float p0 = (j0 <= i) ? accS[nt][0] : 0.f, p1 = (j0 + 1 <= i) ? accS[nt][1] : 0.f, p2 = (j0 + 2 <= i) ? accS[nt][2] : 0.f, p3 = (j0 + 3 <= i) ? accS[nt][3] : 0.f;
            *(LAS u32x2*)(Qs + i * RS + j0) = (u32x2){cvt_pk_bf16(p0, p1), cvt_pk_bf16(p2, p3)};
        }
        asm volatile("" ::: "memory");
        bf16x8 Pf[4];
#pragma unroll
        for (int ks = 0; ks < 4; ++ks) Pf[ks] = *(const LAS bf16x8*)(Qs + (i0 + fr) * RS + 32 * ks + 8 * fq);
#pragma unroll
        for (int ks = 0; ks < 4; ++ks) {
            if (2 * ks <= wave) {
#pragma unroll
                for (int nt = 0; nt < 8; ++nt) { const bf16x8 vf = tr_frag(Vs, 32 * ks, 16 * nt, fr, fq); accO[nt] = __builtin_amdgcn_mfma_f32_16x16x32_bf16(vf, Pf[ks], accO[nt], 0, 0, 0); }
            }
        }
        if (nn < 3) {
            bf16x8 Vt[4];
#pragma unroll
            for (int ks = 0; ks < 4; ++ks) Vt[ks] = tr_frag(Vs, 32 * ks, i0, fr, fq);
#pragma unroll
            for (int nt = 0; nt < 8; ++nt) {
                accR[nt] *= gam;
#pragma unroll
                for (int ks = 0; ks < 4; ++ks) { const bf16x8 kf = tr_frag(Ks, 32 * ks, 16 * nt, fr, fq); accR[nt] = __builtin_amdgcn_mfma_f32_16x16x32_bf16(kf, Vt[ks], accR[nt], 0, 0, 0); }
                accR[nt] *= gC1;
            }
        }
        {
            float s = 0.f;
#pragma unroll
            for (int nt = 0; nt < 8; ++nt) s += (accO[nt][0] + accO[nt][1]) + (accO[nt][2] + accO[nt][3]);
            s += __shfl_xor(s, 16); s += __shfl_xor(s, 32);
            const float mu = s * (1.0f / 128.0f); float qv = 0.f;
#pragma unroll
            for (int nt = 0; nt < 8; ++nt) { const f32x4 d = accO[nt] - mu; qv += (d[0] * d[0] + d[1] * d[1]) + (d[2] * d[2] + d[3] * d[3]); }
            qv += __shfl_xor(qv, 16); qv += __shfl_xor(qv, 32);
            const float rstd = rsqrtf(qv * (1.0f / 128.0f) + 1e-5f);
            bf16_t* op = CAT + tok * DM + 1024 + h * 128 + 4 * fq;
#pragma unroll
            for (int nt = 0; nt < 8; ++nt) {
                const float g0 = bf_lo(gg[nt].x), g1 = bf_hi(gg[nt].x), g2 = bf_lo(gg[nt].y), g3 = bf_hi(gg[nt].y);
                const f32x4 y = (accO[nt] - mu) * rstd;
                u32x2 w; w.x = cvt_pk_bf16(y[0] * g0 * sigmoidf_(g0), y[1] * g1 * sigmoidf_(g1)); w.y = cvt_pk_bf16(y[2] * g2 * sigmoidf_(g2), y[3] * g3 * sigmoidf_(g3));
                *(u32x2*)(op + 16 * nt) = w;
            }
        }
        __syncthreads();
        if (nn < 3) {
#pragma unroll
            for (int nt = 0; nt < 8; ++nt)
                *(LAS u32x2*)(Rs + (i0 + fr) * RS + 16 * nt + 4 * fq) = (u32x2){cvt_pk_bf16(accR[nt][0], accR[nt][1]), cvt_pk_bf16(accR[nt][2], accR[nt][3])};
        }
    }
}

__device__ __forceinline__ void p6_route(const Params& P, LAS unsigned char* lds, int tid, int blk, int G) {
    const int wave = __builtin_amdgcn_readfirstlane(tid >> 6), lane = tid & 63, fr = lane & 15, fq = lane >> 4;
    LAS float* gm = (LAS float*)lds; LAS float* sh = gm + 2048; LAS float* lg = sh + 2048;
    LAS float* lgr = lg + 8 * 64 * 48;
    LAS float* r2s = lgr + 64 * 36;
    LAS int* lcnt = (LAS int*)(r2s + 64); LAS int* lbase = lcnt + 32;
    int ra_ = 0, rb_ = 0, ea_ = 0, eb_ = 0; float w1_ = 0.f, w2_ = 0.f;
    const float* mod = (const float*)(P.ws + WS_MOD);
    const bf16_t* x1 = (const bf16_t*)(P.ws + WS_X1); const float* rowss2 = (const float*)(P.ws + WS_ROWSS2);
    unsigned char* H2 = P.ws + WS_H;
    const bf16_t* WR = (const bf16_t*)(P.ws + WS_WR);
    int* cnt = (int*)(P.ws + WS_CNT); int* list = (int*)(P.ws + WS_LIST); float* wgt = (float*)(P.ws + WS_WGT);
    for (int rb = blk; rb < 256; rb += G) {
        const int b = rb >> 5;
        for (int k = tid; k < 2048; k += NTHREADS) { gm[k] = P.in[18][k] * (1.0f + mod[(size_t)b * NMOD + 4 * DM + k]); sh[k] = mod[(size_t)b * NMOD + 3 * DM + k]; }
        if (tid < 32) lcnt[tid] = 0;
        if (tid >= 64 && tid < 128) { const int r = tid - 64; float tot2 = 0.f; const f32x4* pp = (const f32x4*)(rowss2 + (size_t)(rb * 64 + r) * 32);
#pragma unroll
            for (int i = 0; i < 8; ++i) { const f32x4 v = pp[i]; tot2 += (v[0] + v[1]) + (v[2] + v[3]); }
            r2s[r] = rsqrtf(tot2 * (1.0f / 2048.0f) + 1e-6f); }
        __syncthreads();
        float r2v[4];
#pragma unroll
        for (int mt = 0; mt < 4; ++mt) r2v[mt] = r2s[16 * mt + fr];
        f32x4 acc[4][3];
#pragma unroll
        for (int mt = 0; mt < 4; ++mt)
#pragma unroll
            for (int nt = 0; nt < 3; ++nt) acc[mt][nt] = (f32x4){0.f, 0.f, 0.f, 0.f};
        const bf16_t* xb = x1 + (size_t)(rb * 64 + fr) * DM + 256 * wave + 8 * fq;
        const bf16_t* wb = WR + (size_t)fr * 2048 + 256 * wave + 8 * fq;
        unsigned char* hb = H2 + (size_t)(rb * 64 + fr) * DM + 256 * wave + 8 * fq;
        u32x4 xc[2][4], xn[2][4]; bf16x8 bc[2][3], bn[2][3];
#pragma unroll
        for (int j = 0; j < 2; ++j) {
#pragma unroll
            for (int mt = 0; mt < 4; ++mt) xc[j][mt] = *(const u32x4*)(xb + (size_t)(16 * mt) * DM + 32 * j);
#pragma unroll
            for (int nt = 0; nt < 3; ++nt) bc[j][nt] = *(const bf16x8*)(wb + (size_t)(16 * nt) * 2048 + 32 * j); }
#pragma unroll 1
        for (int qt = 0; qt < 4; ++qt) {
            const int qn = qt < 3 ? qt + 1 : 3;
#pragma unroll
            for (int j = 0; j < 2; ++j) {
#pragma unroll
                for (int mt = 0; mt < 4; ++mt) xn[j][mt] = *(const u32x4*)(xb + (size_t)(16 * mt) * DM + 32 * (2 * qn + j));
#pragma unroll
                for (int nt = 0; nt < 3; ++nt) bn[j][nt] = *(const bf16x8*)(wb + (size_t)(16 * nt) * 2048 + 32 * (2 * qn + j)); }
#pragma unroll
            for (int j = 0; j < 2; ++j) {
                const int kl = 256 * wave + 32 * (2 * qt + j) + 8 * fq;
                const f32x4 g0 = *(const LAS f32x4*)(gm + kl), g1 = *(const LAS f32x4*)(gm + kl + 4), s0 = *(const LAS f32x4*)(sh + kl), s1 = *(const LAS f32x4*)(sh + kl + 4);
#pragma unroll
                for (int mt = 0; mt < 4; ++mt) {
                    const u32x4 xw = xc[j][mt];
                    const f32x4 a = {bf_lo(xw.x), bf_hi(xw.x), bf_lo(xw.y), bf_hi(xw.y)}, c = {bf_lo(xw.z), bf_hi(xw.z), bf_lo(xw.w), bf_hi(xw.w)};
                    const f32x4 h0 = a * r2v[mt] * g0 + s0, h1 = c * r2v[mt] * g1 + s1;
                    u32x4 w; w.x = cvt_pk_bf16(h0[0], h0[1]); w.y = cvt_pk_bf16(h0[2], h0[3]); w.z = cvt_pk_bf16(h1[0], h1[1]); w.w = cvt_pk_bf16(h1[2], h1[3]);
                    int q0 = 0, q1 = 0;
                    q0 = __builtin_amdgcn_cvt_pk_fp8_f32(h0[0], h0[1], q0, false); q0 = __builtin_amdgcn_cvt_pk_fp8_f32(h0[2], h0[3], q0, true);
                    q1 = __builtin_amdgcn_cvt_pk_fp8_f32(h1[0], h1[1], q1, false); q1 = __builtin_amdgcn_cvt_pk_fp8_f32(h1[2], h1[3], q1, true);
                    *(u32x2*)(hb + (size_t)(16 * mt) * DM + 32 * (2 * qt + j)) = (u32x2){(unsigned)q0, (unsigned)q1};
                    const bf16x8 af = __builtin_bit_cast(bf16x8, w);
#pragma unroll
                    for (int nt = 0; nt < 3; ++nt) acc[mt][nt] = __builtin_amdgcn_mfma_f32_16x16x32_bf16(bc[j][nt], af, acc[mt][nt], 0, 0, 0);
                }
            }
#pragma unroll
            for (int j = 0; j < 2; ++j) {
#pragma unroll
                for (int mt = 0; mt < 4; ++mt) xc[j][mt] = xn[j][mt];
#pragma unroll
                for (int nt = 0; nt < 3; ++nt) bc[j][nt] = bn[j][nt]; }
        }
#pragma unroll
        for (int mt = 0; mt < 4; ++mt)
#pragma unroll
            for (int nt = 0; nt < 3; ++nt) *(LAS f32x4*)(lg + (wave * 64 + 16 * mt + fr) * 48 + 16 * nt + 4 * fq) = acc[mt][nt];
        __syncthreads();
        for (int o = tid; o < 64 * 36; o += NTHREADS) { const int r = o / 36, nn = o % 36; float sum = 0.f;
#pragma unroll
            for (int w = 0; w < 8; ++w) sum += lg[(w * 64 + r) * 48 + nn];
            lgr[o] = sum; }
        __syncthreads();
        if (tid < 64) {
            const int tok = rb * 64 + tid;
            float l[36];
#pragma unroll
            for (int nn = 0; nn < 36; ++nn) l[nn] = lgr[tid * 36 + nn];
            float gl[4]; int gs = 0;
#pragma unroll
            for (int j = 0; j < 4; ++j) gl[j] = l[j] + P.in[20][j];
#pragma unroll
            for (int j = 1; j < 4; ++j) if (gl[j] > gl[gs]) gs = j;
            float gmax = gl[0];
#pragma unroll
            for (int j = 1; j < 4; ++j) gmax = fmaxf(gmax, gl[j]);
            float den = 0.f;
#pragma unroll
            for (int j = 0; j < 4; ++j) den += expf(gl[j] - gmax);
            const float gw = 1.0f / den;
            float el[8];
#pragma unroll
            for (int j = 0; j < 8; ++j) { float v = 0.f;
#pragma unroll
                for (int q = 0; q < 4; ++q) v = (gs == q) ? (l[4 + q * 8 + j] + P.in[22][q * 8 + j]) : v;
                el[j] = v; }
            int j1 = 0;
#pragma unroll
            for (int j = 1; j < 8; ++j) if (el[j] > el[j1]) j1 = j;
            int j2 = (j1 == 0) ? 1 : 0;
#pragma unroll
            for (int j = 0; j < 8; ++j) if (j != j1 && j != j2 && el[j] > el[j2]) j2 = j;
            float e1 = el[0], e2 = el[0];
#pragma unroll
            for (int j = 0; j < 8; ++j) { e1 = (j == j1) ? el[j] : e1; e2 = (j == j2) ? el[j] : e2; }
            const float t2 = expf(e2 - e1), w1 = gw / (1.0f + t2), w2 = gw * t2 / (1.0f + t2);
            const int ea = gs * 8 + j1, eb = gs * 8 + j2;
            ra_ = atomicAdd((int*)&lcnt[ea], 1); rb_ = atomicAdd((int*)&lcnt[eb], 1); ea_ = ea; eb_ = eb; w1_ = w1; w2_ = w2;
        }
        __syncthreads();
        if (tid < 32) { const int c = lcnt[tid]; lbase[tid] = c > 0 ? atomicAdd(cnt + tid * 64, c) : 0; }
        __syncthreads();
        if (tid < 64) {
            const int tok = rb * 64 + tid;
            list[ea_ * 16384 + lbase[ea_] + ra_] = tok * 2; wgt[tok * 2] = w1_;
            list[eb_ * 16384 + lbase[eb_] + rb_] = tok * 2 + 1; wgt[tok * 2 + 1] = w2_;
        }
        __syncthreads();
    }
}

__device__ __forceinline__ void p9_final(const Params& P, int tid, int blk, int G) {
    const int wave = tid >> 6, lane = tid & 63;
    const float* mod = (const float*)(P.ws + WS_MOD); const bf16_t* Y2 = (const bf16_t*)(P.ws + WS_Y2); const bf16_t* X1 = (const bf16_t*)(P.ws + WS_X1);
    f32x4 gf[8];
#pragma unroll
    for (int i = 0; i < 8; ++i) gf[i] = *(const f32x4*)(P.in[26] + (i * 64 + lane) * 4);
    int row = blk * 8 + wave;
    u32x2 xw[8], ya[8], yb[8], xwn[8], yan[8], ybn[8];
    if (row < NTOK) {
#pragma unroll
        for (int i = 0; i < 8; ++i) { const int k = (i * 64 + lane) * 4; xw[i] = *(const u32x2*)(X1 + (size_t)row * DM + k); ya[i] = *(const u32x2*)(Y2 + (size_t)(2 * row) * DM + k); yb[i] = *(const u32x2*)(Y2 + (size_t)(2 * row + 1) * DM + k); }
    }
    for (; row < NTOK; row += G * 8) {
        const int b = row >> 11, rown = row + G * 8;
        if (rown < NTOK) {
#pragma unroll
            for (int i = 0; i < 8; ++i) { const int k = (i * 64 + lane) * 4; xwn[i] = *(const u32x2*)(X1 + (size_t)rown * DM + k); yan[i] = *(const u32x2*)(Y2 + (size_t)(2 * rown) * DM + k); ybn[i] = *(const u32x2*)(Y2 + (size_t)(2 * rown + 1) * DM + k); }
        }
        f32x4 v[8]; float ss = 0.f;
#pragma unroll
        for (int i = 0; i < 8; ++i) {
            const int k = (i * 64 + lane) * 4;
            const f32x4 xv = {bf_lo(xw[i].x), bf_hi(xw[i].x), bf_lo(xw[i].y), bf_hi(xw[i].y)};
            const f32x4 gt = *(const f32x4*)(mod + (size_t)b * NMOD + 5 * DM + k);
            f32x4 y; y[0] = bf_lo(ya[i].x) + bf_lo(yb[i].x); y[1] = bf_hi(ya[i].x) + bf_hi(yb[i].x); y[2] = bf_lo(ya[i].y) + bf_lo(yb[i].y); y[3] = bf_hi(ya[i].y) + bf_hi(yb[i].y);
            v[i] = xv + gt * y;
            ss += v[i][0] * v[i][0] + v[i][1] * v[i][1] + v[i][2] * v[i][2] + v[i][3] * v[i][3];
        }
        ss = wave_sum(ss);
        const float r = rsqrtf(ss * (1.0f / 2048.0f) + 1e-6f);
        float* xr = P.out + (size_t)row * DM;
#pragma unroll
        for (int i = 0; i < 8; ++i) { const int k = (i * 64 + lane) * 4; *(f32x4*)(xr + k) = v[i] * r * gf[i]; }
#pragma unroll
        for (int i = 0; i < 8; ++i) { xw[i] = xwn[i]; ya[i] = yan[i]; yb[i] = ybn[i]; }
    }
}

__global__ void __launch_bounds__(NTHREADS, 2) hymba_fwd(Params P) {
    extern __shared__ __attribute__((aligned(16))) unsigned char lds_raw[];
    LAS unsigned char* lds = (LAS unsigned char*)lds_raw;
    const int tid = threadIdx.x, blk = blockIdx.x, G = gridDim.x;
    volatile LAS unsigned* misc = (volatile LAS unsigned*)(lds + LDS_MISC);
    if (tid < 64) misc[tid] = 0u;
    __syncthreads();
    XcdBarrier bar = xcd_barrier_post((unsigned*)(P.ws + WS_BAR), misc);
    const int lo = P.ph_lo, hi = P.ph_hi;
#define IN(k) (lo <= (k) && (k) < hi)
#define SEAM(k) do { if (IN(k) && IN((k) + 1)) xcd_barrier(bar); } while (0)
    unsigned char* ws = P.ws;

#ifndef REPR
#define REPR 1
#endif
#ifndef REPS
#define REPS 1
#endif
#ifndef REP0
#define REP0 1
#endif
#ifndef REP2
#define REP2 1
#endif
#ifndef REP7
#define REP7 1
#endif
#ifndef REP8
#define REP8 1
#endif
    if (IN(0)) for (int rep0 = 0; rep0 < REP0; ++rep0) {
        for (int it = blk; it < 256; it += G) p0_adaln(P, lds, tid, it);
        for (int it = blk; it < 256; it += G) p0_ssm_mats(P, lds, tid, it);
        p0_misc(P, tid, blk, G);
        p0_convert(P, lds, tid, blk, G);
        p0_convert_fp8(P, lds, tid, blk, G, 0, 12288);
    }
    SEAM(0);
    if (IN(1)) p1_norm1(P, lds, tid, blk, G);
    SEAM(1);
    if (IN(2)) for (int rep2 = 0; rep2 < REP2; ++rep2) {
        DenseSched S; S.init(NTOK, NPROJ, G, blk); S.abase = (unsigned)WS_H; S.bbase = (unsigned)WS_WIN; S.lda = DM; S.ldb = DM;
        EpiInProj E{(bf16_t*)(ws + WS_PROJ)};
        g8::gemm_phase(lds, ws, DM / 64, DM, S, E);
    }
    SEAM(2);
    if (IN(3)) {
        for (int it = blk; it < 256; it += G) ssm_item(P, lds, tid, it);
        ret_kv_items(P, lds, tid, blk, G);
    }
    SEAM(3);
    if (IN(4)) {
        for (int it = blk; it < 256; it += G) ret_out_item(P, lds, tid, it);
        __syncthreads();
        DenseSched S; S.init(NTOK, 1024, G, blk); S.abase = (unsigned)WS_Z; S.bbase = (unsigned)WS_WGLU; S.lda = 1024; S.ldb = 1024;
        EpiGlu E{(const bf16_t*)(ws + WS_Z), (bf16_t*)(ws + WS_CAT), (float*)(ws + WS_ROWSS1)};
        g8::gemm_phase(lds, ws, 1024 / 64, 1024, S, E);
    }
    SEAM(4);
    if (IN(5)) {
        OutSched S; S.init(NTOK, DM, G, blk); S.abase = (unsigned)WS_CAT; S.bbase = (unsigned)WS_WOUT;
        EpiOut E{P.in[0], (const float*)(ws + WS_MOD), (const float*)(ws + WS_ROWSS1), (float*)(ws + WS_ROWSS2), (bf16_t*)(ws + WS_X1)};
        g8::gemm_phase(lds, ws, 1024 / 64, DM, S, E);
    }
    SEAM(5);
    if (IN(6)) p6_route(P, lds, tid, blk, G);
    SEAM(6);
    if (IN(7) || IN(8)) {
        LAS int* tinfo = (LAS int*)(lds + LDS_MISC + 256); LAS int* trows = tinfo + 192; LAS int* ntl = trows + 192;
        if (tid == 0) {
            const int* cg = (const int*)(ws + WS_CNT); int nt_ = 0;
            for (int e = 0; e < 32; ++e) { const int c = cg[e * 64], full = c >> 8, rem = c & 255;
                for (int t = 0; t < full; ++t) { tinfo[nt_] = e | ((t * 256) << 8); trows[nt_] = 256; ++nt_; }
                if (rem > 128) { tinfo[nt_] = e | ((full * 256) << 8); trows[nt_] = rem; ++nt_; } }
            for (int e = 0; e < 32; ++e) { const int c = cg[e * 64], full = c >> 8, rem = c & 255; if (rem > 64 && rem <= 128) { tinfo[nt_] = e | ((full * 256) << 8); trows[nt_] = rem; ++nt_; } }
            for (int e = 0; e < 32; ++e) { const int c = cg[e * 64], full = c >> 8, rem = c & 255; if (rem > 0 && rem <= 64) { tinfo[nt_] = e | ((full * 256) << 8); trows[nt_] = rem; ++nt_; } }
            ntl[0] = nt_;
        }
        __syncthreads();
        const int ntiles = __builtin_amdgcn_readfirstlane(ntl[0]);
        if (IN(7)) {
            { u32x2* slot = (u32x2*)(ws + WS_SLOT); const int* lst = (const int*)(ws + WS_LIST); const float* wg = (const float*)(ws + WS_WGT);
              for (int ti = blk; ti < ntiles; ti += G) if (tid < 256) {
                  const int inf = tinfo[ti], e = inf & 255, r0 = inf >> 8, n = trows[ti];
                  u32x2 v; v.x = 0xffffffffu; v.y = 0u;
                  if (tid < n) { const int asg = lst[e * 16384 + r0 + tid]; v.x = (unsigned)asg; v.y = __float_as_uint(wg[asg] * (1.0f / WD_SCALE)); }
                  slot[ti * 256 + tid] = v; } }
            MoeSched S{tinfo, trows, ntiles, G, blk, (const int*)(ws + WS_LIST), (unsigned)WS_H, (unsigned)WS_WGU, 0};
            EpiMoe1 E{ws + WS_HM};
            g8::gemm_phase<EpiMoe1, MoeSched, true, 2>(lds, ws, DM / 128, DM, S, E);
        }
        SEAM(7);
        if (IN(8)) {
            MoeSched S{tinfo, trows, ntiles, G, blk, (const int*)(ws + WS_LIST), (unsigned)WS_HM, (unsigned)WS_WD, 1};
            EpiMoe2 E{(const u32x2*)(ws + WS_SLOT), (bf16_t*)(ws + WS_Y2)};
            g8::gemm_phase<EpiMoe2, MoeSched, true, 2>(lds, ws, DEXP / 128, DEXP, S, E);
        }
    }
    SEAM(8);
    if (IN(9)) p9_final(P, tid, blk, G);
#undef IN
#undef SEAM
}

#ifndef N_LAUNCH_SPLIT
#define N_LAUNCH_SPLIT 0
#endif
extern "C" void kernel_launch(void* const* d_in, const int* in_sizes, int n_in, void* d_out, int out_size, void* d_ws, size_t ws_size, hipStream_t stream) {
    static int grid = 0;
    if (grid == 0) {
        if (n_in != 27 || out_size != NTOK * DM || ws_size < WS_END) { fprintf(stderr, "kernel_launch: unexpected shapes (n_in %d out %d ws %zu need %zu)\n", n_in, out_size, ws_size, (size_t)WS_END); grid = -1; return; }
        int dev = 0, cus = 0, per_cu = 0;
        if (hipGetDevice(&dev) != hipSuccess || hipDeviceGetAttribute(&cus, hipDeviceAttributeMultiprocessorCount, dev) != hipSuccess) { grid = -1; return; }
        if (hipFuncSetAttribute((const void*)hymba_fwd, hipFuncAttributeMaxDynamicSharedMemorySize, LDS_BYTES) != hipSuccess) { fprintf(stderr, "kernel_launch: hipFuncSetAttribute failed\n"); grid = -1; return; }
        if (hipOccupancyMaxActiveBlocksPerMultiprocessor(&per_cu, (const void*)hymba_fwd, NTHREADS, LDS_BYTES) != hipSuccess || per_cu < 1) { fprintf(stderr, "kernel_launch: occupancy query says %d\n", per_cu); }
        (void)hipGetLastError();
        grid = cus;
    }
    if (grid < 0) return;
    (void)hipMemsetAsync((char*)d_ws + WS_BAR, 0, 16384, stream);
    Params p{};
    for (int i = 0; i < 27; ++i) p.in[i] = (const float*)d_in[i];
    p.out = (float*)d_out; p.ws = (unsigned char*)d_ws;
#if N_LAUNCH_SPLIT
    for (int ph = 0; ph < 10; ++ph) { p.ph_lo = ph; p.ph_hi = ph + 1; hipLaunchKernelGGL(hymba_fwd, dim3(grid), dim3(NTHREADS), LDS_BYTES, stream, p); }
#else
    p.ph_lo = 0; p.ph_hi = 10;
    hipLaunchKernelGGL(hymba_fwd, dim3(grid), dim3(NTHREADS), LDS_BYTES, stream, p);
#endif
    const hipError_t le = hipPeekAtLastError();
    if (le != hipSuccess) fprintf(stderr, "kernel_launch: launch failed: %s\n", hipGetErrorName(le));
}
```

```cpp
#include <hip/hip_runtime.h>
#include <cstdio>
#include <cstdint>

#define LAS __attribute__((address_space(3)))
typedef unsigned short bf16_t;
typedef short bf16x8 __attribute__((ext_vector_type(8)));
typedef short bf16x4 __attribute__((ext_vector_type(4)));
typedef float f32x4 __attribute__((ext_vector_type(4)));
typedef float f32x2 __attribute__((ext_vector_type(2)));
typedef unsigned u32x4 __attribute__((ext_vector_type(4)));
typedef unsigned u32x2 __attribute__((ext_vector_type(2)));

constexpr int DM = 2048, NB = 8, SEQ = 2048, NTOK = NB * SEQ;
constexpr int NPROJ = 5120;
constexpr int NMOD = 6 * DM;
constexpr int NEXP = 32, DEXP = 1024;
constexpr int NTHREADS = 512;

constexpr size_t WS_BAR   = 0;
constexpr size_t WS_CNT   = 16384;
constexpr size_t WS_ROWSS1= WS_CNT + 8192;
constexpr size_t WS_ROWSS2= WS_ROWSS1 + (size_t)16384 * 16 * 4;
constexpr size_t WS_MODP  = WS_ROWSS2 + (size_t)16384 * 32 * 4;
constexpr size_t WS_MOD   = WS_MODP + (size_t)4 * 8 * NMOD * 4;
constexpr size_t WS_ROPE  = WS_MOD + (size_t)8 * NMOD * 4;
constexpr size_t WS_SSMA  = WS_ROPE + (size_t)2048 * 64 * 8;
constexpr size_t WS_WR    = WS_SSMA + (size_t)64 * 64 * 8;
constexpr size_t WS_SSMM  = WS_WR + (size_t)48 * 2048 * 2;
constexpr size_t WS_WIN   = WS_SSMM + (size_t)64 * 131072 * 2;
constexpr size_t WS_WOUT  = WS_WIN + (size_t)NPROJ * DM * 2;
constexpr size_t WS_WGLU  = WS_WOUT + (size_t)DM * DM * 2;
constexpr size_t WS_WGU   = WS_WGLU + (size_t)1024 * 1024 * 2;
constexpr size_t WS_WD    = WS_WGU + (size_t)NEXP * 2048 * 2048 * 2;
constexpr size_t WS_H     = WS_WD + (size_t)NEXP * 2048 * 1024 * 2;
constexpr size_t WS_PROJ  = WS_H + (size_t)NTOK * DM * 2;
constexpr size_t WS_Z     = WS_PROJ + (size_t)NTOK * NPROJ * 2;
constexpr size_t WS_CAT   = WS_Z + (size_t)NTOK * 1024 * 2;
constexpr size_t WS_WGT   = WS_CAT + (size_t)NTOK * DM * 2;
constexpr size_t WS_LIST  = WS_WGT + (size_t)32768 * 4;
constexpr size_t WS_SLOT  = WS_LIST + (size_t)32 * 16384 * 4;
constexpr size_t WS_X1    = WS_SLOT + (size_t)192 * 256 * 8;
constexpr size_t WS_END   = WS_X1 + (size_t)NTOK * DM * 2;
constexpr size_t WS_Y2    = WS_PROJ;
constexpr size_t WS_HM    = WS_Z;

constexpr int LDS_STAGE = 131072;
constexpr int LDS_BYTES = 147456;
constexpr int LDS_MISC  = LDS_BYTES - 2048;

struct Params { const float* in[27]; float* out; unsigned char* ws; int ph_lo, ph_hi; };

#define XB_TMO      128
#define XB_XCNT(j)  (256  + 64 * (j))
#define XB_XSUB(j)  (1280 + 64 * (j))
#define XB_XGEN(j)  (2304 + 64 * (j))
#define XB_TOP      3328
#define XB_TOPGEN   3392
#define XCD_BAR_WORDS 3456
#define XB_SPIN_CAP (1u << 22)

__device__ __forceinline__ unsigned xb_ld(unsigned* p)              { return __hip_atomic_load(p, __ATOMIC_RELAXED, __HIP_MEMORY_SCOPE_AGENT); }
__device__ __forceinline__ unsigned xb_add(unsigned* p, unsigned v) { return __hip_atomic_fetch_add(p, v, __ATOMIC_RELAXED, __HIP_MEMORY_SCOPE_AGENT); }
__device__ __forceinline__ unsigned xb_xcc_id() { return (unsigned)__builtin_amdgcn_s_getreg((3 << 11) | 20) & 0xFu; }
#define XB_SPIN(cond, bar) do { unsigned _sp = 0; while (cond) { __builtin_amdgcn_s_sleep(1); \
    if ((++_sp & 255u) == 0u) { if (xb_ld(&(bar)[XB_TMO])) break; if (_sp > XB_SPIN_CAP) { atomicAdd(&(bar)[XB_TMO], 1u); break; } } } } while (0)

struct XcdBarrier { unsigned* bar; unsigned x; volatile LAS unsigned* st; };

__device__ __forceinline__ XcdBarrier xcd_barrier_post(unsigned* bar, volatile LAS unsigned* st) {
    XcdBarrier b; b.bar = bar; b.x = xb_xcc_id(); b.st = st;
    if (threadIdx.x == 0) (void)xb_add(&bar[XB_XCNT(b.x)], 1u);
    return b;
}
__device__ __forceinline__ void xcd_barrier_complete(unsigned* bar, unsigned x, unsigned& nloc, unsigned& nx) {
    const unsigned G = gridDim.x * gridDim.y * gridDim.z;
    unsigned sum, cnt, mine, sp = 0u;
    for (;;) {
        sum = 0u; cnt = 0u; mine = 0u;
#pragma unroll
        for (unsigned j = 0; j < 16; ++j) { const unsigned c = xb_ld(&bar[XB_XCNT(j)]); sum += c; cnt += (c > 0u) ? 1u : 0u; mine = (j == x) ? c : mine; }
        if (sum == G) break;
        __builtin_amdgcn_s_sleep(1);
        if ((++sp & 255u) == 0u) { if (xb_ld(&bar[XB_TMO])) break; if (sp > XB_SPIN_CAP) { atomicAdd(&bar[XB_TMO], 1u); break; } }
    }
    nloc = mine > 0u ? mine : 1u; nx = cnt > 0u ? cnt : 1u;
}
__device__ __forceinline__ void xcd_barrier(const XcdBarrier& b) {
    asm volatile("s_waitcnt vmcnt(0)" ::: "memory");
    __syncthreads();
    if (threadIdx.x == 0) {
        unsigned* bar = b.bar;
        __builtin_amdgcn_s_waitcnt(0);
        unsigned nloc = b.st[0], nx = b.st[1];
        if (nloc == 0u) { xcd_barrier_complete(bar, b.x, nloc, nx); b.st[0] = nloc; b.st[1] = nx; }
        const unsigned old = xb_add(&bar[XB_XSUB(b.x)], 1u);
        const unsigned gen = old / nloc;
        if (old + 1u == (gen + 1u) * nloc) {
            __builtin_amdgcn_fence(__ATOMIC_RELEASE, "agent");
            asm volatile("s_waitcnt vmcnt(0)" ::: "memory");
            const unsigned og = xb_add(&bar[XB_TOP], 1u);
            const unsigned tg = og / nx;
            if (og + 1u == (tg + 1u) * nx) xb_add(&bar[XB_TOPGEN], 1u);
            else XB_SPIN(xb_ld(&bar[XB_TOPGEN]) == tg, bar);
            __builtin_amdgcn_fence(__ATOMIC_ACQUIRE, "agent");
            xb_add(&bar[XB_XGEN(b.x)], 1u);
            asm volatile("s_waitcnt vmcnt(0)" ::: "memory");
        } else {
            XB_SPIN(xb_ld(&bar[XB_XGEN(b.x)]) == gen, bar);
            __builtin_amdgcn_fence(__ATOMIC_ACQUIRE, "agent");
            asm volatile("s_waitcnt vmcnt(0)" ::: "memory");
        }
    }
    __syncthreads();
}

typedef __bf16 bf16x2_t __attribute__((ext_vector_type(2)));
__device__ __forceinline__ unsigned cvt_pk_bf16(float lo, float hi) { const f32x2 v = {lo, hi}; return __builtin_bit_cast(unsigned, __builtin_convertvector(v, bf16x2_t)); }
__device__ __forceinline__ float bf_lo(unsigned w) { return __uint_as_float(w << 16); }
__device__ __forceinline__ float bf_hi(unsigned w) { return __uint_as_float(w & 0xffff0000u); }
__device__ __forceinline__ float sigmoidf_(float x) { return 1.0f / (1.0f + __expf(-x)); }
__device__ __forceinline__ float gelu_tanh(float x) {
    const float u = 0.7978845608028654f * (x + 0.044715f * x * x * x);
    const float t = 1.0f - 2.0f / (1.0f + __expf(2.0f * u));
    return 0.5f * x * (1.0f + t);
}
__device__ __forceinline__ float wave_sum(float v) {
    v += __shfl_xor(v, 1); v += __shfl_xor(v, 2); v += __shfl_xor(v, 4); v += __shfl_xor(v, 8); v += __shfl_xor(v, 16); v += __shfl_xor(v, 32); return v;
}
__device__ __forceinline__ void sincos_d(double x, double& s, double& c) {
    const double TWO_PI = 6.283185307179586476925286766559;
    double r = x - TWO_PI * rint(x / TWO_PI);
    const double r2 = r * r;
    double ts = r, tc = 1.0; s = r; c = 1.0;
#pragma unroll 1
    for (int k = 1; k <= 14; ++k) { tc *= -r2 / (double)((2 * k - 1) * (2 * k)); ts *= -r2 / (double)((2 * k) * (2 * k + 1)); c += tc; s += ts; }
}

namespace g8 {
constexpr int BM = 256, BK = 64, HALF = 128, HTB = HALF * BK * 2, NXCD = 8, WGM = 8;
__device__ __forceinline__ int lds_byte(int r, int c) { const int st = (r >> 4) * 2 + (c >> 5), rr = r & 15, cc = c & 31, ob = rr * 64 + cc * 2; return st * 1024 + (ob ^ (((ob >> 9) & 1) << 5)); }
__device__ __forceinline__ void stage_rc(int b, int& R, int& C) { const int st = b / 1024, sb = b % 1024, swz = sb ^ (((sb >> 9) & 1) << 5); R = (st >> 1) * 16 + swz / 64; C = (st & 1) * 32 + (swz % 64) / 2; }
__device__ __forceinline__ int perm32(int rho) { const int n = rho >> 4, i = rho & 15; return 8 * (i >> 2) + 4 * n + (i & 3); }

struct Unit { unsigned aoff, boff; int pm, pn, flags, aux, aux2; };
typedef f32x4 Acc[2][2][4][2];

struct StaticOrder {
    int nM, nN, nwg, G, c;
    __device__ void init(int M, int N, int G_, int c_) { nM = M / BM; nN = N / BM; nwg = nM * nN; G = G_; c = c_; }
    __device__ __forceinline__ bool tile(int i, int& pm, int& pn) const {
        const long L = (long)i * G + c; if (L >= nwg) return false;
        int wgid = (int)L; { const int q = nwg / NXCD, r = nwg % NXCD, xcd = wgid % NXCD, off = wgid / NXCD; wgid = (xcd < r ? xcd * (q + 1) : r * (q + 1) + (xcd - r) * q) + off; }
        const int nig = WGM * nN, gid = wgid / nig, fm = gid * WGM, gsz = (nM - fm) < WGM ? (nM - fm) : WGM;
        pm = fm + ((wgid % nig) % gsz); pn = (wgid % nig) / gsz; return true;
    }
};

typedef long l64x2 __attribute__((ext_vector_type(2)));
typedef int i32x4 __attribute__((ext_vector_type(4)));
typedef int i32x8 __attribute__((ext_vector_type(8)));
template <class Epi, class Sched, bool SKIP = false, int FP8 = 0>
__device__ __forceinline__ void gemm_phase(LAS unsigned char* lds, const unsigned char* ws, const int nt, const int ldb  , const Sched& S, const Epi& E) {
    const int tid = threadIdx.x, wid = __builtin_amdgcn_readfirstlane(tid >> 6), lane = tid & 63, wr = wid >> 2, wc = wid & 3, fr = lane & 15, fq = lane >> 4;
    int R0, C0, R1, C1; stage_rc(tid * 16, R0, C0); stage_rc(tid * 16 + 8192, R1, C1);
    unsigned voffB[2];
    { const int Rb0 = Epi::PERM ? ((R0 & ~31) + perm32(R0 & 31)) : R0, Rb1 = Epi::PERM ? ((R1 & ~31) + perm32(R1 & 31)) : R1;
      voffB[0] = (unsigned)(Rb0 * 64 + C0) * 2u; voffB[1] = (unsigned)(Rb1 * 64 + C1) * 2u; }
    const unsigned kstep = (unsigned)(BK * 2);
    const unsigned kstepB = 256u * 64u * 2u;
    const unsigned hstepB = (unsigned)HALF * 64u * 2u;
    const unsigned ldsw = (unsigned)wid * 1024u;
    const int aoff = lds_byte(wr * 64 + fr, fq * 8), boff = lds_byte(wc * 32 + fr, fq * 8);
#define G8_SA(b, h) (((b) * 2 + (h)) * HTB)
#define G8_SB(b, h) ((4 + (b) * 2 + (h)) * HTB)
#define G8_STAGE(bufoff, gbase, v0, v1) do { \
        __builtin_amdgcn_global_load_lds((const unsigned*)((gbase) + (v0)), (LAS unsigned*)(lds + (bufoff) + ldsw), 16, 0, 0); \
        __builtin_amdgcn_global_load_lds((const unsigned*)((gbase) + (v1)), (LAS unsigned*)(lds + (bufoff) + ldsw + 8192), 16, 0, 0); } while (0)
#define G8_LDA(dst, b, h) do { _Pragma("unroll") for (int m = 0; m < 4; ++m) _Pragma("unroll") for (int k = 0; k < 2; ++k) dst[m][k] = *(const LAS bf16x8*)(lds + G8_SA(b, h) + aoff + m * 2048 + k * 1024); } while (0)
#define G8_LDB(dst, b, h) do { _Pragma("unroll") for (int n = 0; n < 2; ++n) _Pragma("unroll") for (int k = 0; k < 2; ++k) dst[n][k] = *(const LAS bf16x8*)(lds + G8_SB(b, h) + boff + n * 2048 + k * 1024); } while (0)
#define G8_MMA(ai, bj, At, Bt) do { __builtin_amdgcn_s_setprio(1); \
        if constexpr (FP8 == 2) { _Pragma("unroll") for (int m = 0; m < 4; ++m) _Pragma("unroll") for (int n = 0; n < 2; ++n) { \
            const i32x8 a8 = __builtin_shufflevector(__builtin_bit_cast(i32x4, At[m][0]), __builtin_bit_cast(i32x4, At[m][1]), 0, 1, 2, 3, 4, 5, 6, 7); \
            const i32x8 b8 = __builtin_shufflevector(__builtin_bit_cast(i32x4, Bt[n][0]), __builtin_bit_cast(i32x4, Bt[n][1]), 0, 1, 2, 3, 4, 5, 6, 7); \
            acc[ai][bj][m][n] = __builtin_amdgcn_mfma_scale_f32_16x16x128_f8f6f4(b8, a8, acc[ai][bj][m][n], 0, 0, 0, 0x7F7F7F7F, 0, 0x7F7F7F7F); } } \
        else { _Pragma("unroll") for (int m = 0; m < 4; ++m) _Pragma("unroll") for (int n = 0; n < 2; ++n) _Pragma("unroll") for (int k = 0; k < 2; ++k) { \
        if constexpr (FP8 == 1) { const l64x2 a2 = __builtin_bit_cast(l64x2, At[m][k]), b2 = __builtin_bit_cast(l64x2, Bt[n][k]); \
            acc[ai][bj][m][n] = __builtin_amdgcn_mfma_f32_16x16x32_fp8_fp8(b2[0], a2[0], acc[ai][bj][m][n], 0, 0, 0); \
            acc[ai][bj][m][n] = __builtin_amdgcn_mfma_f32_16x16x32_fp8_fp8(b2[1], a2[1], acc[ai][bj][m][n], 0, 0, 0); } \
        else acc[ai][bj][m][n] = __builtin_amdgcn_mfma_f32_16x16x32_bf16(Bt[n][k], At[m][k], acc[ai][bj][m][n], 0, 0, 0); } } __builtin_amdgcn_s_setprio(0); } while (0)
#define G8_WAIT_V(n) asm volatile("s_waitcnt vmcnt(" #n ")" ::: "memory")
#define G8_WAIT_L(n) asm volatile("s_waitcnt lgkmcnt(" #n ")" ::: "memory")
#define G8_BAR __builtin_amdgcn_s_barrier()
#define G8_SCHED __builtin_amdgcn_sched_barrier(0)
    Unit cur, nxt; int ui = 0;
    if (!S.next(0, cur)) return;
    Acc acc;
#pragma unroll
    for (int a = 0; a < 2; ++a)
#pragma unroll
        for (int b = 0; b < 2; ++b)
#pragma unroll
            for (int m = 0; m < 4; ++m)
#pragma unroll
                for (int n = 0; n < 2; ++n) acc[a][b][m][n] = (f32x4){0.f, 0.f, 0.f, 0.f};
    bf16x8 At[4][2], B0[2][2], B1[2][2];
    unsigned cv[2][2], nv[2][2];
    S.aoffs(cur, R0, C0, R1, C1, cv);
    const unsigned char* cA = ws + cur.aoff; const unsigned char* cB = ws + cur.boff;
    G8_STAGE(G8_SB(0, 0), cB, voffB[0], voffB[1]); G8_STAGE(G8_SA(0, 0), cA, cv[0][0], cv[0][1]);
    G8_STAGE(G8_SB(0, 1), cB + hstepB, voffB[0], voffB[1]); G8_STAGE(G8_SA(0, 1), cA, cv[1][0], cv[1][1]);
    if (wr == 1) G8_BAR;
    G8_WAIT_V(4); G8_BAR;
    G8_STAGE(G8_SB(1, 0), cB + kstepB, voffB[0], voffB[1]); G8_STAGE(G8_SA(1, 0), cA + kstep, cv[0][0], cv[0][1]);
    G8_STAGE(G8_SB(1, 1), cB + hstepB + kstepB, voffB[0], voffB[1]);
    G8_WAIT_V(6); G8_BAR;
    for (;;) {
        const bool has_next = S.next(ui + 1, nxt);
        if (has_next) S.aoffs(nxt, R0, C0, R1, C1, nv);
        else { nv[0][0] = cv[0][0]; nv[0][1] = cv[0][1]; nv[1][0] = cv[1][0]; nv[1][1] = cv[1][1]; }
        const unsigned char* nA = has_next ? ws + nxt.aoff : cA; const unsigned char* nB = has_next ? ws + nxt.boff : cB;
        const int vrows = SKIP ? cur.aux2 : 256;
        const bool do0 = !SKIP || vrows > 64 || wr == 0, do1 = !SKIP || vrows > 128;
        for (int t = 0; t < nt; t += 2) {
            const bool last = (t == nt - 2);
            const unsigned char* a1 = cA + (size_t)(t + 1) * kstep;
            const unsigned char* a2 = last ? nA : cA + (size_t)(t + 2) * kstep; const unsigned char* b2 = last ? nB : cB + (size_t)(t + 2) * kstepB;
            const unsigned char* a3 = a2 + kstep; const unsigned char* b3 = b2 + kstepB;
            const unsigned o00 = last ? nv[0][0] : cv[0][0], o01 = last ? nv[0][1] : cv[0][1], o10 = last ? nv[1][0] : cv[1][0], o11 = last ? nv[1][1] : cv[1][1];
            G8_LDB(B0, 0, 0); G8_SCHED; G8_LDA(At, 0, 0); G8_STAGE(G8_SA(1, 1), a1, cv[1][0], cv[1][1]);
            G8_WAIT_L(8); G8_BAR; G8_WAIT_L(0); if (do0) G8_MMA(0, 0, At, B0); G8_BAR; G8_SCHED;
            G8_LDB(B1, 0, 1); G8_STAGE(G8_SB(0, 0), b2, voffB[0], voffB[1]);
            G8_BAR; G8_WAIT_L(0); if (do0) G8_MMA(0, 1, At, B1); G8_BAR;
            G8_LDA(At, 0, 1); G8_STAGE(G8_SA(0, 0), a2, o00, o01);
            G8_BAR; G8_WAIT_L(0); if (do1) G8_MMA(1, 0, At, B0); G8_BAR; G8_SCHED;
            G8_STAGE(G8_SB(0, 1), b2 + hstepB, voffB[0], voffB[1]);
            G8_WAIT_V(6); G8_BAR; if (do1) G8_MMA(1, 1, At, B1); G8_BAR;
            G8_LDB(B0, 1, 0); G8_SCHED; G8_LDA(At, 1, 0); G8_STAGE(G8_SA(0, 1), a2, o10, o11);
            G8_WAIT_L(8); G8_BAR; G8_WAIT_L(0); if (do0) G8_MMA(0, 0, At, B0); G8_BAR; G8_SCHED;
            G8_LDB(B1, 1, 1); G8_STAGE(G8_SB(1, 0), b3, voffB[0], voffB[1]);
            G8_BAR; G8_WAIT_L(0); if (do0) G8_MMA(0, 1, At, B1); G8_BAR;
            G8_LDA(At, 1, 1); G8_STAGE(G8_SA(1, 0), a3, o00, o01);
            G8_BAR; G8_WAIT_L(0); if (do1) G8_MMA(1, 0, At, B0); G8_BAR; G8_SCHED;
            G8_STAGE(G8_SB(1, 1), b3 + hstepB, voffB[0], voffB[1]);
            G8_WAIT_V(6); G8_BAR; if (do1) G8_MMA(1, 1, At, B1); G8_BAR;
        }
        E(acc, cur, wr, wc, fr, fq);
        if (!has_next) break;
        if (!(cur.flags & 1)) {
#pragma unroll
            for (int a = 0; a < 2; ++a)
#pragma unroll
                for (int b = 0; b < 2; ++b)
#pragma unroll
                    for (int m = 0; m < 4; ++m)
#pragma unroll
                        for (int n = 0; n < 2; ++n) acc[a][b][m][n] = (f32x4){0.f, 0.f, 0.f, 0.f};
        }
        cur = nxt; cA = nA; cB = nB; ++ui;
        cv[0][0] = nv[0][0]; cv[0][1] = nv[0][1]; cv[1][0] = nv[1][0]; cv[1][1] = nv[1][1];
    }
    G8_WAIT_V(0);
    if (wr == 0) G8_BAR;
    G8_BAR;
#undef G8_SA
#undef G8_SB
#undef G8_STAGE
#undef G8_LDA
#undef G8_LDB
#undef G8_MMA
#undef G8_WAIT_V
#undef G8_WAIT_L
#undef G8_BAR
#undef G8_SCHED
}
}

__device__ __forceinline__ void p0_adaln(const Params& P, LAS unsigned char* lds, int tid, int item) {
    const int ks = item & 3, nc = item >> 2;
    LAS float* sc = (LAS float*)lds;
    LAS float* red = (LAS float*)(lds + 16384);
    const float* c = P.in[1];
    for (int i = tid; i < 4096; i += NTHREADS) { const int kl = i >> 3, b = i & 7; const float v = c[b * 2048 + ks * 512 + kl]; sc[i] = v / (1.0f + expf(-v)); }
    __syncthreads();
    if (tid < 384) {
        const int nq = tid % 48, kg = tid / 48;
        const float* W = P.in[2] + (size_t)(ks * 512 + kg * 64) * NMOD + nc * 192 + nq * 4;
        f32x4 acc[8];
#pragma unroll
        for (int b = 0; b < 8; ++b) acc[b] = (f32x4){0.f, 0.f, 0.f, 0.f};
#pragma unroll 16
        for (int kk = 0; kk < 64; ++kk) {
            const f32x4 w = *(const f32x4*)(W + (size_t)kk * NMOD);
            const f32x4 s0 = *(const LAS f32x4*)(sc + (kg * 64 + kk) * 8), s1 = *(const LAS f32x4*)(sc + (kg * 64 + kk) * 8 + 4);
            acc[0] += w * s0[0]; acc[1] += w * s0[1]; acc[2] += w * s0[2]; acc[3] += w * s0[3];
            acc[4] += w * s1[0]; acc[5] += w * s1[1]; acc[6] += w * s1[2]; acc[7] += w * s1[3];
        }
#pragma unroll
        for (int b = 0; b < 8; ++b) *(LAS f32x4*)(red + (kg * 8 + b) * 192 + nq * 4) = acc[b];
    }
    __syncthreads();
    float* modp = (float*)(P.ws + WS_MODP);
    for (int i = tid; i < 8 * 192; i += NTHREADS) {
        const int b = i / 192, n = i % 192; float s = 0.f;
#pragma unroll
        for (int kg = 0; kg < 8; ++kg) s += red[(kg * 8 + b) * 192 + n];
        modp[(size_t)(ks * 8 + b) * NMOD + nc * 192 + n] = s;
    }
    __syncthreads();
}

struct CvtUnit { const float* src; bf16_t* dst; int Nd, Kd, k0, n0, nmode; const float* s0; const float* s1; };
constexpr int CVT_UNITS = 640 + 256 + 64;
__device__ __forceinline__ void cvt_unit_decode(const Params& P, int L, CvtUnit& u) {
    u.s0 = nullptr; u.s1 = nullptr; u.nmode = 0;
    if (L < 640) { u.src = P.in[5]; u.dst = (bf16_t*)(P.ws + WS_WIN); u.Kd = 2048; u.Nd = 5120; u.k0 = (L / 20) * 64; u.n0 = (L % 20) * 256; u.nmode = 3; return; }
    L -= 640;
    if (L < 256) { u.src = P.in[17]; u.dst = (bf16_t*)(P.ws + WS_WOUT); u.Kd = 2048; u.Nd = 2048; u.k0 = (L / 8) * 64; u.n0 = (L % 8) * 256; u.s0 = P.in[15]; u.s1 = P.in[16]; return; }
    L -= 256;
    if (L < 64) { u.src = P.in[14]; u.dst = (bf16_t*)(P.ws + WS_WGLU); u.Kd = 1024; u.Nd = 1024; u.k0 = (L / 4) * 64; u.n0 = (L % 4) * 256; return; }
    L -= 64;
    if (L < 4096) { const int e = L >> 7, r = L & 127; u.src = P.in[23] + (size_t)e * 2048 * 1024; u.dst = (bf16_t*)(P.ws + WS_WGU) + (size_t)e * 2048 * 2048; u.Kd = 2048; u.Nd = 1024; u.k0 = (r >> 2) * 64; u.n0 = (r & 3) * 256; u.nmode = 1; return; }
    L -= 4096;
    if (L < 4096) { const int e = L >> 7, r = L & 127; u.src = P.in[24] + (size_t)e * 2048 * 1024; u.dst = (bf16_t*)(P.ws + WS_WGU) + (size_t)e * 2048 * 2048; u.Kd = 2048; u.Nd = 1024; u.k0 = (r >> 2) * 64; u.n0 = (r & 3) * 256; u.nmode = 2; return; }
    L -= 4096;
    { const int e = L >> 7, r = L & 127; u.src = P.in[25] + (size_t)e * 1024 * 2048; u.dst = (bf16_t*)(P.ws + WS_WD) + (size_t)e * 2048 * 1024; u.Kd = 1024; u.Nd = 2048; u.k0 = (r >> 3) * 64; u.n0 = (r & 7) * 256; }
}
__device__ __forceinline__ void cvt_load(const CvtUnit& u, int tid, f32x4 (&r)[8]) {
    const int kp = tid >> 4, nq = tid & 15;
    const float* p = u.src + (size_t)(u.k0 + 2 * kp) * u.Nd + u.n0 + nq * 4;
#pragma unroll
    for (int s = 0; s < 4; ++s) { r[2 * s] = *(const f32x4*)(p + s * 64); r[2 * s + 1] = *(const f32x4*)(p + u.Nd + s * 64); }
    if (u.s0) {
        const int k = u.k0 + 2 * kp;
        const float a = (k < 1024) ? u.s0[k] : u.s1[k - 1024], b = (k + 1 < 1024) ? u.s0[k + 1] : u.s1[k + 1 - 1024];
#pragma unroll
        for (int s = 0; s < 4; ++s) { r[2 * s] *= a; r[2 * s + 1] *= b; }
    }
}
__device__ __forceinline__ void cvt_to_lds(LAS unsigned* tile, const f32x4 (&r)[8], int kp, int nq) {
#pragma unroll
    for (int s = 0; s < 4; ++s)
#pragma unroll
        for (int j = 0; j < 4; ++j) tile[s * 2112 + (nq * 4 + j) * 33 + kp] = cvt_pk_bf16(r[2 * s][j], r[2 * s + 1][j]);
}
__device__ __forceinline__ void cvt_store(const LAS unsigned* tile, const CvtUnit& u, int nl, int kq) {
#pragma unroll
    for (int s = 0; s < 4; ++s) {
        u32x4 w; w.x = tile[s * 2112 + nl * 33 + kq * 4]; w.y = tile[s * 2112 + nl * 33 + kq * 4 + 1]; w.z = tile[s * 2112 + nl * 33 + kq * 4 + 2]; w.w = tile[s * 2112 + nl * 33 + kq * 4 + 3];
        const int n = u.n0 + s * 64 + nl;
        int np = n;
        if (u.nmode == 1 || u.nmode == 2) np = (n >> 7) * 256 + (n & 127) + (u.nmode == 2 ? 128 : 0);
        else if (u.nmode == 3 && n >= 1024 && n < 3072) { const int reg = (n >= 2048) ? 2048 : 1024, nr = n - reg;
            np = reg + ((nr >> 8) << 8) + (((nr >> 6) & 1) << 7) + (((nr >> 7) & 1) << 6) + (nr & 63); }
        *(u32x4*)(u.dst + (size_t)(np >> 8) * ((size_t)u.Kd * 256) + (size_t)(u.k0 >> 6) * 16384 + (np & 255) * 64 + kq * 8) = w;
    }
}
__device__ __forceinline__ void p0_convert(const Params& P, LAS unsigned char* lds, int tid, int blk, int G) {
    LAS unsigned* tileA = (LAS unsigned*)lds;
    LAS unsigned* tileB = tileA + 4 * 2112;
    const int kp = tid >> 4, nq = tid & 15, nl = tid >> 3, kq = tid & 7;
    CvtUnit uA, uB, nA, nB; f32x4 rA[8], rB[8];
    int L = blk;
    if (L >= CVT_UNITS) return;
    bool hasB = (L + G) < CVT_UNITS;
    cvt_unit_decode(P, L, uA); cvt_load(uA, tid, rA);
    if (hasB) { cvt_unit_decode(P, L + G, uB); cvt_load(uB, tid, rB); }
    for (;;) {
        cvt_to_lds(tileA, rA, kp, nq);
        if (hasB) cvt_to_lds(tileB, rB, kp, nq);
        __syncthreads();
        const int Ln = L + 2 * G; const bool moreA = Ln < CVT_UNITS, moreB = (Ln + G) < CVT_UNITS;
        if (moreA) { cvt_unit_decode(P, Ln, nA); cvt_load(nA, tid, rA); }
        if (moreB) { cvt_unit_decode(P, Ln + G, nB); cvt_load(nB, tid, rB); }
        cvt_store(tileA, uA, nl, kq);
        if (hasB) cvt_store(tileB, uB, nl, kq);
        __syncthreads();
        if (!moreA) break;
        uA = nA; uB = nB; hasB = moreB; L = Ln;
    }
}

struct Cvt8Unit { const float* src; unsigned char* dst; int Nd, Kd, k0, n0, nmode; float scale; };
constexpr float WGU_SCALE = 64.0f, WD_SCALE = 32.0f;
__device__ __forceinline__ void cvt8_decode(const Params& P, int L, Cvt8Unit& u) {
    if (L < 8192) { const int up = L >= 4096; const int r_ = L & 4095; const int e = r_ >> 7, r = r_ & 127;
        u.src = P.in[up ? 24 : 23] + (size_t)e * 2048 * 1024; u.dst = P.ws + WS_WGU + (size_t)e * 2048 * 2048; u.Kd = 2048; u.Nd = 1024; u.k0 = (r >> 3) * 128; u.n0 = (r & 7) * 128; u.nmode = up ? 2 : 1; u.scale = WGU_SCALE; return; }
    L -= 8192;
    { const int e = L >> 7, r = L & 127; u.src = P.in[25] + (size_t)e * 1024 * 2048; u.dst = P.ws + WS_WD + (size_t)e * 2048 * 1024; u.Kd = 1024; u.Nd = 2048; u.k0 = (r >> 4) * 128; u.n0 = (r & 15) * 128; u.nmode = 0; u.scale = WD_SCALE; }
}
__device__ __forceinline__ void cvt8_load(const Cvt8Unit& u, int tid, f32x4 (&r)[8]) {
    const int kg = tid >> 5, nq = tid & 31;
    const float* p = u.src + (size_t)(u.k0 + 8 * kg) * u.Nd + u.n0 + nq * 4;
#pragma unroll
    for (int kk = 0; kk < 8; ++kk) r[kk] = __builtin_nontemporal_load((const f32x4*)(p + (size_t)kk * u.Nd));
}
__device__ __forceinline__ void cvt8_to_lds(LAS unsigned* tile, const f32x4 (&r)[8], float sc, int tid) {
    const int kg = tid >> 5, nq = tid & 31;
    u32x4 w0, w1;
#pragma unroll
    for (int j = 0; j < 4; ++j) {
        int a = 0, b = 0;
        a = __builtin_amdgcn_cvt_pk_fp8_f32(r[0][j] * sc, r[1][j] * sc, a, false); a = __builtin_amdgcn_cvt_pk_fp8_f32(r[2][j] * sc, r[3][j] * sc, a, true);
        b = __builtin_amdgcn_cvt_pk_fp8_f32(r[4][j] * sc, r[5][j] * sc, b, false); b = __builtin_amdgcn_cvt_pk_fp8_f32(r[6][j] * sc, r[7][j] * sc, b, true);
        w0[j] = (unsigned)a; w1[j] = (unsigned)b;
    }
    *(LAS u32x4*)(tile + (2 * kg) * 132 + nq * 4) = w0;
    *(LAS u32x4*)(tile + (2 * kg + 1) * 132 + nq * 4) = w1;
}
__device__ __forceinline__ void cvt8_store(const LAS unsigned* tile, const Cvt8Unit& u, int tid) {
    const int nl = tid >> 2, q = tid & 3;
    u32x4 w0, w1;
    w0.x = tile[(8 * q + 0) * 132 + nl]; w0.y = tile[(8 * q + 1) * 132 + nl]; w0.z = tile[(8 * q + 2) * 132 + nl]; w0.w = tile[(8 * q + 3) * 132 + nl];
    w1.x = tile[(8 * q + 4) * 132 + nl]; w1.y = tile[(8 * q + 5) * 132 + nl]; w1.z = tile[(8 * q + 6) * 132 + nl]; w1.w = tile[(8 * q + 7) * 132 + nl];
    const int n = u.n0 + nl;
    int np = n;
    if (u.nmode == 1 || u.nmode == 2) np = (n >> 7) * 256 + (n & 127) + (u.nmode == 2 ? 128 : 0);
    unsigned char* d = u.dst + (size_t)(np >> 8) * ((size_t)u.Kd * 256) + (size_t)(u.k0 >> 7) * 32768 + (np & 255) * 128 + q * 32;
    *(u32x4*)d = w0; *(u32x4*)(d + 16) = w1;
}
__device__ __forceinline__ void p0_convert_fp8(const Params& P, LAS unsigned char* lds, int tid, int blk, int G, const int Lbeg, const int Lend) {
    LAS unsigned* tileA = (LAS unsigned*)lds;
    LAS unsigned* tileB = tileA + 32 * 132;
    Cvt8Unit uA, uB, nA, nB; f32x4 rA[8], rB[8];
    int L = Lbeg + blk;
    if (L >= Lend) return;
    bool hasB = (L + G) < Lend;
    cvt8_decode(P, L, uA); cvt8_load(uA, tid, rA);
    if (hasB) { cvt8_decode(P, L + G, uB); cvt8_load(uB, tid, rB); }
    for (;;) {
        cvt8_to_lds(tileA, rA, uA.scale, tid);
        if (hasB) cvt8_to_lds(tileB, rB, uB.scale, tid);
        __syncthreads();
        const int Ln = L + 2 * G; const bool moreA = Ln < Lend, moreB = (Ln + G) < Lend;
        if (moreA) { cvt8_decode(P, Ln, nA); cvt8_load(nA, tid, rA); }
        if (moreB) { cvt8_decode(P, Ln + G, nB); cvt8_load(nB, tid, rB); }
        cvt8_store(tileA, uA, tid);
        if (hasB) cvt8_store(tileB, uB, tid);
        __syncthreads();
        if (!moreA) break;
        uA = nA; uB = nB; hasB = moreB; L = Ln;
    }
}

__device__ __forceinline__ void p0_ssm_mats(const Params& P, LAS unsigned char* lds, int tid, int item) {
    const int g = item & 63, q = item >> 6;
    LAS f32x2* pw = (LAS f32x2*)lds;
    LAS f32x2* Bb = pw + 17 * 64;
    LAS f32x2* Cc = Bb + 64 * 16;
    LAS float* Kt = (LAS float*)(Cc + 16 * 64);
    if (tid < 64) {
        const int p = tid;
        const float dt = expf(P.in[13][g]);
        const float are = P.in[6][g * 64 + p], aim = P.in[7][g * 64 + p];
        const float mag = expf(dt * are);
        double sd, cd; sincos_d((double)(dt * aim), sd, cd);
        const float abr = mag * (float)cd, abi = mag * (float)sd;
        const float inv = 1.0f / (are * are + aim * aim);
        const float nre = abr - 1.0f;
        const float fre = (nre * are + abi * aim) * inv, fim = (abi * are - nre * aim) * inv;
        float pr = 1.0f, pi = 0.0f;
        for (int n = 0; n <= 16; ++n) { pw[n * 64 + p] = (f32x2){pr, pi}; const float t = pr * abr - pi * abi; pi = pr * abi + pi * abr; pr = t; }
        for (int h = 0; h < 16; ++h) {
            const float br = P.in[8][(g * 64 + p) * 16 + h], bi = P.in[9][(g * 64 + p) * 16 + h];
            Bb[p * 16 + h] = (f32x2){fre * br - fim * bi, fre * bi + fim * br};
            Cc[h * 64 + p] = (f32x2){P.in[10][(g * 16 + h) * 64 + p], P.in[11][(g * 16 + h) * 64 + p]};
        }
        if (q == 0) { f32x2* AL = (f32x2*)(P.ws + WS_SSMA); const f32x2 v = pw[16 * 64 + p]; AL[g * 64 + p] = v; }
    }
    __syncthreads();
    for (int o = tid; o < 4096; o += NTHREADS) {
        const int tau = o >> 8, ho = (o >> 4) & 15, hi = o & 15; float s = 0.f;
        for (int p = 0; p < 64; ++p) {
            const f32x2 c = Cc[ho * 64 + p], a = pw[tau * 64 + p], b = Bb[p * 16 + hi];
            const float cr = c.x * a.x - c.y * a.y, ci = c.x * a.y + c.y * a.x;
            s += cr * b.x - ci * b.y;
        }
        Kt[o] = s;
    }
    __syncthreads();
    bf16_t* Ms = (bf16_t*)(P.ws + WS_SSMM) + (size_t)g * 131072;
    bf16_t* TM = Ms + 32768;
    for (int o = tid; o < 32 * 128; o += NTHREADS) {
        const int row = 32 * q + (o >> 7), col = (o & 127) * 2;
        const int p = row >> 1, j = col >> 4, hi = col & 15;
        const f32x2 a = pw[(15 - j) * 64 + p], b0 = Bb[p * 16 + hi], b1 = Bb[p * 16 + hi + 1];
        float v0, v1;
        if ((row & 1) == 0) { v0 = a.x * b0.x - a.y * b0.y; v1 = a.x * b1.x - a.y * b1.y; } else { v0 = a.x * b0.y + a.y * b0.x; v1 = a.x * b1.y + a.y * b1.x; }
        *(unsigned*)(Ms + (size_t)row * 256 + col) = cvt_pk_bf16(v0, v1);
    }
    for (int o = tid; o < 64 * 192; o += NTHREADS) {
        const int row = 64 * q + o / 192, col = (o % 192) * 2;
        const int i = row >> 4, ho = row & 15; float v0, v1;
        if (col < 256) { const int j = col >> 4, hi = col & 15; if (j <= i) { v0 = Kt[((i - j) * 16 + ho) * 16 + hi]; v1 = Kt[((i - j) * 16 + ho) * 16 + hi + 1]; } else { v0 = 0.f; v1 = 0.f; } }
        else { const int p0 = (col - 256) >> 1;
            const f32x2 c0 = Cc[ho * 64 + p0], a0 = pw[(i + 1) * 64 + p0];
            v0 = c0.x * a0.x - c0.y * a0.y; v1 = -(c0.x * a0.y + c0.y * a0.x); }
        *(unsigned*)(TM + (size_t)row * 384 + col) = cvt_pk_bf16(v0, v1);
    }
    __syncthreads();
}

__device__ __forceinline__ void p0_misc(const Params& P, int tid, int blk, int G) {
    bf16_t* wr = (bf16_t*)(P.ws + WS_WR);
    for (int i = blk * NTHREADS + tid; i < 48 * 2048; i += G * NTHREADS) {
        const int n = i >> 11, k = i & 2047; float v = 0.f;
        if (n < 4) v = P.in[19][k * 4 + n]; else if (n < 36) v = P.in[21][k * 32 + (n - 4)];
        wr[i] = (bf16_t)(cvt_pk_bf16(v, 0.f) & 0xffffu);
    }
    if (blk == 0) for (int i = tid; i < 2048; i += NTHREADS) ((int*)(P.ws + WS_CNT))[i] = 0;
}

__device__ __forceinline__ void p1_norm1(const Params& P, LAS unsigned char* lds, int tid, int blk, int G) {
    const float* modp = (const float*)(P.ws + WS_MODP); const float* bada = P.in[3];
    float* mod = (float*)(P.ws + WS_MOD);
    for (int i = blk * NTHREADS + tid; i < 8 * NMOD; i += G * NTHREADS) {
        const int b = i / NMOD, j = i % NMOD;
        mod[i] = bada[j] + ((modp[(size_t)(0 * 8 + b) * NMOD + j] + modp[(size_t)(1 * 8 + b) * NMOD + j]) + (modp[(size_t)(2 * 8 + b) * NMOD + j] + modp[(size_t)(3 * 8 + b) * NMOD + j]));
    }
    LAS float* gm = (LAS float*)lds; LAS float* sh = gm + 2048;
    const int wave = tid >> 6, lane = tid & 63;
    bf16_t* H = (bf16_t*)(P.ws + WS_H);
    for (int rb = blk; rb < 256; rb += G) {
        const int b = rb >> 5;
        for (int k = tid; k < 2048; k += NTHREADS) {
            const int js = 2048 + k, jh = k;
            const float sc = bada[js] + ((modp[(size_t)(0 * 8 + b) * NMOD + js] + modp[(size_t)(1 * 8 + b) * NMOD + js]) + (modp[(size_t)(2 * 8 + b) * NMOD + js] + modp[(size_t)(3 * 8 + b) * NMOD + js]));
            const float sv = bada[jh] + ((modp[(size_t)(0 * 8 + b) * NMOD + jh] + modp[(size_t)(1 * 8 + b) * NMOD + jh]) + (modp[(size_t)(2 * 8 + b) * NMOD + jh] + modp[(size_t)(3 * 8 + b) * NMOD + jh]));
            gm[k] = P.in[4][k] * (1.0f + sc); sh[k] = sv;
        }
        __syncthreads();
        f32x4 v[8], vn[8];
        { const float* xr = P.in[0] + (size_t)(rb * 64 + wave * 8) * DM;
#pragma unroll
          for (int i = 0; i < 8; ++i) v[i] = *(const f32x4*)(xr + (i * 64 + lane) * 4); }
        for (int rr = 0; rr < 8; ++rr) {
            const int row = rb * 64 + wave * 8 + rr;
            if (rr < 7) { const float* xn = P.in[0] + (size_t)(row + 1) * DM;
#pragma unroll
                for (int i = 0; i < 8; ++i) vn[i] = *(const f32x4*)(xn + (i * 64 + lane) * 4); }
            float ss = 0.f;
#pragma unroll
            for (int i = 0; i < 8; ++i) ss += v[i][0] * v[i][0] + v[i][1] * v[i][1] + v[i][2] * v[i][2] + v[i][3] * v[i][3];
            ss = wave_sum(ss);
            const float r = rsqrtf(ss * (1.0f / 2048.0f) + 1e-6f);
#pragma unroll
            for (int i = 0; i < 8; ++i) {
                const int k = (i * 64 + lane) * 4;
                const f32x4 g4 = *(const LAS f32x4*)(gm + k), s4 = *(const LAS f32x4*)(sh + k);
                const f32x4 o = v[i] * r * g4 + s4;
                u32x2 w; w.x = cvt_pk_bf16(o[0], o[1]); w.y = cvt_pk_bf16(o[2], o[3]);
                *(u32x2*)(H + (size_t)row * DM + k) = w;
            }
#pragma unroll
            for (int i = 0; i < 8; ++i) v[i] = vn[i];
        }
        __syncthreads();
    }
}

struct DenseSched : g8::StaticOrder {
    unsigned abase, bbase; int lda, ldb;
    __device__ __forceinline__ bool next(int i, g8::Unit& u) const {
        int pm, pn; if (!tile(i, pm, pn)) return false;
        u.pm = __builtin_amdgcn_readfirstlane(pm); u.pn = __builtin_amdgcn_readfirstlane(pn); u.flags = 0; u.aux = 0;
        u.aoff = abase + (unsigned)u.pm * 256u * (unsigned)lda * 2u; u.boff = bbase + (unsigned)u.pn * 256u * (unsigned)ldb * 2u; return true;
    }
    __device__ __forceinline__ void aoffs(const g8::Unit&, int R0, int C0, int R1, int C1, unsigned (&v)[2][2]) const {
        v[0][0] = (unsigned)(R0 * lda + C0) * 2u; v[0][1] = (unsigned)(R1 * lda + C1) * 2u;
        v[1][0] = (unsigned)((128 + R0) * lda + C0) * 2u; v[1][1] = (unsigned)((128 + R1) * lda + C1) * 2u;
    }
};
struct EpiStoreBf16 {
    static constexpr bool PERM = true;
    bf16_t* O; int ldc;
    __device__ __forceinline__ void operator()(g8::Acc& acc, const g8::Unit& u, int wr, int wc, int fr, int fq) const {
        const int row0 = u.pm * 256 + wr * 64 + fr, col0 = u.pn * 256 + wc * 32 + 8 * fq;
#pragma unroll
        for (int ai = 0; ai < 2; ++ai)
#pragma unroll
            for (int m = 0; m < 4; ++m) { bf16_t* rowp = O + (size_t)(row0 + ai * 128 + m * 16) * ldc + col0;
#pragma unroll
                for (int bj = 0; bj < 2; ++bj) { const f32x4 v0 = acc[ai][bj][m][0], v1 = acc[ai][bj][m][1];
                    u32x4 w; w.x = cvt_pk_bf16(v0[0], v0[1]); w.y = cvt_pk_bf16(v0[2], v0[3]); w.z = cvt_pk_bf16(v1[0], v1[1]); w.w = cvt_pk_bf16(v1[2], v1[3]);
                    *(u32x4*)(rowp + bj * 128) = w; } }
    }
};
struct EpiInProj {
    static constexpr bool PERM = true;
    bf16_t* O;
    __device__ __forceinline__ void operator()(g8::Acc& acc, const g8::Unit& u, int wr, int wc, int fr, int fq) const {
        const int pn = u.pn;
        const int row0 = u.pm * 256 + wr * 64 + fr;
        if (pn < 4 || pn >= 12) {
            const int col0 = pn * 256 + wc * 32 + 8 * fq;
#pragma unroll
            for (int ai = 0; ai < 2; ++ai)
#pragma unroll
                for (int m = 0; m < 4; ++m) { bf16_t* rowp = O + (size_t)(row0 + ai * 128 + m * 16) * NPROJ + col0;
#pragma unroll
                    for (int bj = 0; bj < 2; ++bj) { const f32x4 v0 = acc[ai][bj][m][0], v1 = acc[ai][bj][m][1];
                        u32x4 w; w.x = cvt_pk_bf16(v0[0], v0[1]); w.y = cvt_pk_bf16(v0[2], v0[3]); w.z = cvt_pk_bf16(v1[0], v1[1]); w.w = cvt_pk_bf16(v1[2], v1[3]);
                        *(u32x4*)(rowp + bj * 128) = w; } }
            return;
        }
        const bool isq = pn < 8;
        const int head = 2 * ((pn - 4) & 3) + (wc >> 1);
        const int dd0 = 32 * (wc & 1) + 8 * fq;
        const int colbase = (isq ? 1024 : 2048) + head * 128 + dd0;
        const float lg2 = log2f(1.0f - exp2f(-5.0f - (float)head));
        float fr_[8];
#pragma unroll
        for (int t = 0; t < 8; ++t) fr_[t] = exp2f(-(float)(dd0 + t) * 0.20762050593046014f) * 0.15915494309189535f;
#pragma unroll
        for (int ai = 0; ai < 2; ++ai)
#pragma unroll
            for (int m = 0; m < 4; ++m) {
                const int row = row0 + ai * 128 + m * 16, pos = row & 2047, i = wr * 64 + m * 16 + fr;
                const float sc = isq ? exp2f(lg2 * (float)i) : exp2f(-lg2 * (float)i) * 0.08838834764831845f;
                const float fp = (float)pos;
                float o1[8], o2[8];
#pragma unroll
                for (int t = 0; t < 8; ++t) {
                    const float rev = __builtin_amdgcn_fractf(fp * fr_[t]);
                    const float cs = __builtin_amdgcn_cosf(rev) * sc, sn = __builtin_amdgcn_sinf(rev) * sc;
                    const float a = acc[ai][0][m][t >> 2][t & 3], b = acc[ai][1][m][t >> 2][t & 3];
                    o1[t] = a * cs - b * sn; o2[t] = b * cs + a * sn;
                }
                bf16_t* rowp = O + (size_t)row * NPROJ + colbase;
                u32x4 w1, w2; w1.x = cvt_pk_bf16(o1[0], o1[1]); w1.y = cvt_pk_bf16(o1[2], o1[3]); w1.z = cvt_pk_bf16(o1[4], o1[5]); w1.w = cvt_pk_bf16(o1[6], o1[7]);
                w2.x = cvt_pk_bf16(o2[0], o2[1]); w2.y = cvt_pk_bf16(o2[2], o2[3]); w2.z = cvt_pk_bf16(o2[4], o2[5]); w2.w = cvt_pk_bf16(o2[6], o2[7]);
                *(u32x4*)rowp = w1; *(u32x4*)(rowp + 64) = w2;
            }
    }
};
struct EpiGlu {
    static constexpr bool PERM = true;
    const bf16_t* Z; bf16_t* CAT; float* rowss;
    __device__ __forceinline__ void operator()(g8::Acc& acc, const g8::Unit& u, int wr, int wc, int fr, int fq) const {
        const int row0 = u.pm * 256 + wr * 64 + fr, col0 = u.pn * 256 + wc * 32 + 8 * fq;
#pragma unroll
        for (int ai = 0; ai < 2; ++ai) {
            u32x4 zz[4][2];
#pragma unroll
            for (int m = 0; m < 4; ++m)
#pragma unroll
                for (int bj = 0; bj < 2; ++bj) zz[m][bj] = *(const u32x4*)(Z + (size_t)(row0 + ai * 128 + m * 16) * 1024 + col0 + bj * 128);
#pragma unroll
            for (int m = 0; m < 4; ++m) { const int row = row0 + ai * 128 + m * 16; float ss = 0.f;
#pragma unroll
                for (int bj = 0; bj < 2; ++bj) { const f32x4 v0 = acc[ai][bj][m][0], v1 = acc[ai][bj][m][1];
                    const u32x4 z4 = zz[m][bj];
                    float o[8];
                    o[0] = bf_lo(z4.x) * sigmoidf_(v0[0]); o[1] = bf_hi(z4.x) * sigmoidf_(v0[1]); o[2] = bf_lo(z4.y) * sigmoidf_(v0[2]); o[3] = bf_hi(z4.y) * sigmoidf_(v0[3]);
                    o[4] = bf_lo(z4.z) * sigmoidf_(v1[0]); o[5] = bf_hi(z4.z) * sigmoidf_(v1[1]); o[6] = bf_lo(z4.w) * sigmoidf_(v1[2]); o[7] = bf_hi(z4.w) * sigmoidf_(v1[3]);
#pragma unroll
                    for (int j = 0; j < 8; ++j) ss += o[j] * o[j];
                    u32x4 w; w.x = cvt_pk_bf16(o[0], o[1]); w.y = cvt_pk_bf16(o[2], o[3]); w.z = cvt_pk_bf16(o[4], o[5]); w.w = cvt_pk_bf16(o[6], o[7]);
                    *(u32x4*)(CAT + (size_t)row * DM + col0 + bj * 128) = w; }
                ss += __shfl_xor(ss, 16); ss += __shfl_xor(ss, 32);
                if (fq == 0) rowss[(size_t)row * 16 + u.pn * 4 + wc] = ss; }
        }
    }
};
struct OutSched : g8::StaticOrder {
    unsigned abase, bbase;
    __device__ __forceinline__ bool next(int i, g8::Unit& u) const {
        int pm, pn; if (!tile(i >> 1, pm, pn)) return false;
        const int half = i & 1;
        u.pm = __builtin_amdgcn_readfirstlane(pm); u.pn = __builtin_amdgcn_readfirstlane(pn); u.flags = half ? 0 : 1; u.aux = half;
        u.aoff = abase + (unsigned)u.pm * 256u * 4096u + (unsigned)half * 2048u; u.boff = bbase + (unsigned)u.pn * 256u * 4096u + (unsigned)half * (16u * 32768u); return true;
    }
    __device__ __forceinline__ void aoffs(const g8::Unit&, int R0, int C0, int R1, int C1, unsigned (&v)[2][2]) const {
        v[0][0] = (unsigned)(R0 * 2048 + C0) * 2u; v[0][1] = (unsigned)(R1 * 2048 + C1) * 2u;
        v[1][0] = (unsigned)((128 + R0) * 2048 + C0) * 2u; v[1][1] = (unsigned)((128 + R1) * 2048 + C1) * 2u;
    }
};
struct EpiOut {
    static constexpr bool PERM = true;
    const float* x; const float* mod; const float* rowss1; float* rowss2; bf16_t* X1;
    __device__ __forceinline__ void operator()(g8::Acc& acc, const g8::Unit& u, int wr, int wc, int fr, int fq) const {
        const int row0 = u.pm * 256 + wr * 64 + fr;
        if (u.aux == 0) {
#pragma unroll
            for (int ai = 0; ai < 2; ++ai)
#pragma unroll
                for (int m = 0; m < 4; ++m) { const f32x4* pp = (const f32x4*)(rowss1 + (size_t)(row0 + ai * 128 + m * 16) * 16);
                    const f32x4 p0 = pp[0], p1 = pp[1], p2 = pp[2], p3 = pp[3];
                    const float tot = (((p0[0] + p0[1]) + (p0[2] + p0[3])) + ((p1[0] + p1[1]) + (p1[2] + p1[3]))) + (((p2[0] + p2[1]) + (p2[2] + p2[3])) + ((p3[0] + p3[1]) + (p3[2] + p3[3])));
                    const float r = rsqrtf(tot * (1.0f / 1024.0f) + 1e-6f);
#pragma unroll
                    for (int bj = 0; bj < 2; ++bj)
#pragma unroll
                        for (int n = 0; n < 2; ++n) acc[ai][bj][m][n] *= r; }
            return;
        }
        const int col0 = u.pn * 256 + wc * 32 + 8 * fq;
        const int b = (u.pm * 256) >> 11;
        f32x4 gt[2][2];
#pragma unroll
        for (int bj = 0; bj < 2; ++bj)
#pragma unroll
            for (int n = 0; n < 2; ++n) gt[bj][n] = *(const f32x4*)(mod + (size_t)b * NMOD + 2 * DM + col0 + bj * 128 + n * 4);
#pragma unroll
        for (int am = 0; am < 4; ++am) {
            const int ai = am >> 1, m0 = (am & 1) * 2;
            f32x4 xv[2][2][2];
#pragma unroll
            for (int mm = 0; mm < 2; ++mm)
#pragma unroll
                for (int bj = 0; bj < 2; ++bj) { const size_t off = (size_t)(row0 + ai * 128 + (m0 + mm) * 16) * DM + col0 + bj * 128; xv[mm][bj][0] = *(const f32x4*)(x + off); xv[mm][bj][1] = *(const f32x4*)(x + off + 4); }
#pragma unroll
            for (int mm = 0; mm < 2; ++mm) { const int m = m0 + mm; const int row = row0 + ai * 128 + m * 16; float ss = 0.f;
#pragma unroll
                for (int bj = 0; bj < 2; ++bj) { const size_t off = (size_t)row * DM + col0 + bj * 128;
                    const f32x4 o0 = xv[mm][bj][0] + gt[bj][0] * acc[ai][bj][m][0], o1 = xv[mm][bj][1] + gt[bj][1] * acc[ai][bj][m][1];
                    ss += (o0[0] * o0[0] + o0[1] * o0[1]) + (o0[2] * o0[2] + o0[3] * o0[3]) + (o1[0] * o1[0] + o1[1] * o1[1]) + (o1[2] * o1[2] + o1[3] * o1[3]);
                    u32x4 w; w.x = cvt_pk_bf16(o0[0], o0[1]); w.y = cvt_pk_bf16(o0[2], o0[3]); w.z = cvt_pk_bf16(o1[0], o1[1]); w.w = cvt_pk_bf16(o1[2], o1[3]);
                    *(u32x4*)(X1 + off) = w; }
                ss += __shfl_xor(ss, 16); ss += __shfl_xor(ss, 32);
                if (fq == 0) rowss2[(size_t)row * 32 + u.pn * 4 + wc] = ss; }
        }
    }
};
struct MoeSched {
    const LAS int* tinfo; const LAS int* trows; int ntiles; int G, c; const int* list; unsigned abase, bbase; int mode;
    __device__ __forceinline__ bool next(int i, g8::Unit& u) const {
        int pn, ti;
        if ((G & 63) == 0) { const int x = c & 7, r = c >> 3, per = G >> 6;
            ti = (i * 8 + x) * per + (r >> 3); pn = r & 7; }
        else { const int L = i * G + c; pn = L & 7; ti = L >> 3; }
        if (ti >= ntiles) return false;
        const int inf = __builtin_amdgcn_readfirstlane(tinfo[ti]);
        const int e = inf & 255;
        u.pm = __builtin_amdgcn_readfirstlane(ti); u.pn = pn; u.flags = 0; u.aux = inf; u.aux2 = __builtin_amdgcn_readfirstlane(trows[ti]);
        if (mode == 0) { u.aoff = abase; u.boff = bbase + (unsigned)e * (2048u * 2048u) + (unsigned)pn * (256u * 2048u); }
        else { u.aoff = abase + (unsigned)ti * (256u * 1024u); u.boff = bbase + (unsigned)e * (2048u * 1024u) + (unsigned)pn * (256u * 1024u); }
        return true;
    }
    __device__ __forceinline__ void aoffs(const g8::Unit& u, int R0, int C0, int R1, int C1, unsigned (&v)[2][2]) const {
        if (mode == 0) {
            const int e = u.aux & 255, r0 = u.aux >> 8, n = u.aux2; const int* le = list + e * 16384 + r0;
            const int i00 = R0, i01 = R1, i10 = 128 + R0, i11 = 128 + R1;
            const int t00 = (i00 < n) ? (le[i00] >> 1) : 0, t01 = (i01 < n) ? (le[i01] >> 1) : 0, t10 = (i10 < n) ? (le[i10] >> 1) : 0, t11 = (i11 < n) ? (le[i11] >> 1) : 0;
            v[0][0] = (unsigned)(t00 * 2048 + C0 * 2); v[0][1] = (unsigned)(t01 * 2048 + C1 * 2); v[1][0] = (unsigned)(t10 * 2048 + C0 * 2); v[1][1] = (unsigned)(t11 * 2048 + C1 * 2);
        } else {
            v[0][0] = (unsigned)(R0 * 1024 + C0 * 2); v[0][1] = (unsigned)(R1 * 1024 + C1 * 2);
            v[1][0] = (unsigned)((128 + R0) * 1024 + C0 * 2); v[1][1] = (unsigned)((128 + R1) * 1024 + C1 * 2);
        }
    }
};
struct EpiMoe1 {
    static constexpr bool PERM = true;
    unsigned char* HM;
    __device__ __forceinline__ void operator()(g8::Acc& acc, const g8::Unit& u, int wr, int wc, int fr, int fq) const {
        const int row0 = u.pm * 256 + wr * 64 + fr, col0 = u.pn * 128 + wc * 32 + 8 * fq;
        const float inv = 1.0f / WGU_SCALE;
#pragma unroll
        for (int ai = 0; ai < 2; ++ai)
#pragma unroll
            for (int m = 0; m < 4; ++m) { float o[8];
#pragma unroll
                for (int n = 0; n < 2; ++n)
#pragma unroll
                    for (int j = 0; j < 4; ++j) { const float gv = acc[ai][0][m][n][j] * inv, uv = acc[ai][1][m][n][j] * inv; o[n * 4 + j] = gv * sigmoidf_(gv) * uv; }
                int q0 = 0, q1 = 0;
                q0 = __builtin_amdgcn_cvt_pk_fp8_f32(o[0], o[1], q0, false); q0 = __builtin_amdgcn_cvt_pk_fp8_f32(o[2], o[3], q0, true);
                q1 = __builtin_amdgcn_cvt_pk_fp8_f32(o[4], o[5], q1, false); q1 = __builtin_amdgcn_cvt_pk_fp8_f32(o[6], o[7], q1, true);
                *(u32x2*)(HM + (size_t)(row0 + ai * 128 + m * 16) * 1024 + col0) = (u32x2){(unsigned)q0, (unsigned)q1}; }
    }
};
struct EpiMoe2 {
    static constexpr bool PERM = true;
    const u32x2* slot; bf16_t* Y2;
    __device__ __forceinline__ void operator()(g8::Acc& acc, const g8::Unit& u, int wr, int wc, int fr, int fq) const {
        const int col0 = u.pn * 256 + wc * 32 + 8 * fq;
        u32x2 si[2][4];
#pragma unroll
        for (int ai = 0; ai < 2; ++ai)
#pragma unroll
            for (int m = 0; m < 4; ++m) si[ai][m] = slot[u.pm * 256 + ai * 128 + wr * 64 + m * 16 + fr];
#pragma unroll
        for (int ai = 0; ai < 2; ++ai)
#pragma unroll
            for (int m = 0; m < 4; ++m) { const int asg = (int)si[ai][m].x;
                if (asg >= 0) { bf16_t* rowp = Y2 + (size_t)asg * DM + col0; const float ww = __uint_as_float(si[ai][m].y);
#pragma unroll
                    for (int bj = 0; bj < 2; ++bj) { const f32x4 v0 = acc[ai][bj][m][0] * ww, v1 = acc[ai][bj][m][1] * ww;
                        u32x4 w; w.x = cvt_pk_bf16(v0[0], v0[1]); w.y = cvt_pk_bf16(v0[2], v0[3]); w.z = cvt_pk_bf16(v1[0], v1[1]); w.w = cvt_pk_bf16(v1[2], v1[3]);
                        *(u32x4*)(rowp + bj * 128) = w; } } }
    }
};

constexpr size_t WS_KV = WS_H;
__device__ __forceinline__ void ssm_item(const Params& P, LAS unsigned char* lds, int tid, int item) {
    const int g = item >> 2, bp = item & 3;
    const int wave = __builtin_amdgcn_readfirstlane(tid >> 6), lane = tid & 63, fr = lane & 15, fq = lane >> 4;
    const bf16_t* proj = (const bf16_t*)(P.ws + WS_PROJ);
    const bf16_t* Ms = (const bf16_t*)(P.ws + WS_SSMM) + (size_t)g * 131072;
    const bf16_t* TM = Ms + 32768;
    bf16_t* Zo = (bf16_t*)(P.ws + WS_Z);
    constexpr int ZS = 136, MS = 264, TS = 392;
    LAS bf16_t* ZB = (LAS bf16_t*)lds;
    LAS bf16_t* WB = (LAS bf16_t*)(lds + 256 * ZS * 2);
    const int b = 2 * bp + (wave >> 2);
    int tok0[2];
    bf16x8 Uf[2][8];
#pragma unroll
    for (int mt = 0; mt < 2; ++mt) {
        const int c = 32 * (wave & 3) + 16 * mt + fr; tok0[mt] = b * 2048 + c * 16;
#pragma unroll
        for (int ks = 0; ks < 8; ++ks) Uf[mt][ks] = *(const bf16x8*)(proj + (size_t)(tok0[mt] + 2 * ks + (fq >> 1)) * NPROJ + g * 16 + 8 * (fq & 1));
    }
#pragma unroll
    for (int i = 0; i < 8; ++i) { const int row = tid >> 2, kc = (tid & 3) + 4 * i; *(LAS u32x4*)(WB + row * MS + kc * 8) = *(const u32x4*)(Ms + row * 256 + kc * 8); }
    __syncthreads();
#pragma unroll
    for (int nt = 0; nt < 8; ++nt) {
        f32x4 a0 = {0.f, 0.f, 0.f, 0.f}, a1 = {0.f, 0.f, 0.f, 0.f};
#pragma unroll
        for (int ks = 0; ks < 8; ++ks) {
            const bf16x8 bf = *(const LAS bf16x8*)(WB + (16 * nt + fr) * MS + 32 * ks + 8 * fq);
            a0 = __builtin_amdgcn_mfma_f32_16x16x32_bf16(bf, Uf[0][ks], a0, 0, 0, 0);
            a1 = __builtin_amdgcn_mfma_f32_16x16x32_bf16(bf, Uf[1][ks], a1, 0, 0, 0);
        }
        *(LAS u32x2*)(ZB + (32 * wave + fr) * ZS + 16 * nt + 4 * fq) = (u32x2){cvt_pk_bf16(a0[0], a0[1]), cvt_pk_bf16(a0[2], a0[3])};
        *(LAS u32x2*)(ZB + (32 * wave + 16 + fr) * ZS + 16 * nt + 4 * fq) = (u32x2){cvt_pk_bf16(a1[0], a1[1]), cvt_pk_bf16(a1[2], a1[3])};
    }
    u32x4 tmr[6];
#pragma unroll
    for (int i = 0; i < 6; ++i) { const int row = tid >> 3, kc = (tid & 7) + 8 * i; tmr[i] = *(const u32x4*)(TM + (size_t)row * 384 + kc * 8); }
    __syncthreads();
    if (tid < 128) {
        const int bl = tid >> 6, p = tid & 63;
        const f32x2 al = ((const f32x2*)(P.ws + WS_SSMA))[g * 64 + p];
        float xr = 0.f, xi = 0.f;
        LAS unsigned* zw = (LAS unsigned*)ZB + (bl * 128) * (ZS / 2) + p;
        for (int c0 = 0; c0 < 128; c0 += 8) {
            unsigned zv[8];
#pragma unroll
            for (int k = 0; k < 8; ++k) zv[k] = zw[(c0 + k) * (ZS / 2)];
#pragma unroll
            for (int k = 0; k < 8; ++k) {
                zw[(c0 + k) * (ZS / 2)] = cvt_pk_bf16(xr, xi);
                const float t = al.x * xr - al.y * xi + bf_lo(zv[k]); xi = al.x * xi + al.y * xr + bf_hi(zv[k]); xr = t;
            }
        }
    }
#pragma unroll
    for (int i = 0; i < 6; ++i) { const int row = tid >> 3, kc = (tid & 7) + 8 * i; *(LAS u32x4*)(WB + row * TS + kc * 8) = tmr[i]; }
    __syncthreads();
    const LAS bf16_t* xrow = ZB + (32 * wave + fr) * ZS + 8 * fq;
    const f32x4 dv = *(const f32x4*)(P.in[12] + g * 16 + 4 * fq);
#pragma unroll
    for (int cq = 0; cq < 4; ++cq) {
        u32x2 uu[4][2];
#pragma unroll
        for (int ntl = 0; ntl < 4; ++ntl)
#pragma unroll
            for (int mt = 0; mt < 2; ++mt) uu[ntl][mt] = *(const u32x2*)(proj + (size_t)(tok0[mt] + 4 * cq + ntl) * NPROJ + g * 16 + 4 * fq);
        if (cq < 3) {
#pragma unroll
            for (int i = 0; i < 6; ++i) { const int row = tid >> 3, kc = (tid & 7) + 8 * i; tmr[i] = *(const u32x4*)(TM + (size_t)(64 * (cq + 1) + row) * 384 + kc * 8); }
        }
#pragma unroll
        for (int ntl = 0; ntl < 4; ++ntl) {
            const int nt = 4 * cq + ntl;
            f32x4 a0 = {0.f, 0.f, 0.f, 0.f}, a1 = {0.f, 0.f, 0.f, 0.f};
            const LAS bf16_t* brow = WB + (16 * ntl + fr) * TS + 8 * fq;
#pragma unroll
            for (int ks = 0; ks < 8; ++ks) {
                if (2 * ks <= nt) {
                    const bf16x8 bf = *(const LAS bf16x8*)(brow + 32 * ks);
                    a0 = __builtin_amdgcn_mfma_f32_16x16x32_bf16(bf, Uf[0][ks], a0, 0, 0, 0);
                    a1 = __builtin_amdgcn_mfma_f32_16x16x32_bf16(bf, Uf[1][ks], a1, 0, 0, 0);
                }
            }
#pragma unroll
            for (int k2 = 0; k2 < 4; ++k2) {
                const bf16x8 bf = *(const LAS bf16x8*)(brow + 256 + 32 * k2);
                const bf16x8 x0 = *(const LAS bf16x8*)(xrow + 32 * k2), x1 = *(const LAS bf16x8*)(xrow + 16 * ZS + 32 * k2);
                a0 = __builtin_amdgcn_mfma_f32_16x16x32_bf16(bf, x0, a0, 0, 0, 0);
                a1 = __builtin_amdgcn_mfma_f32_16x16x32_bf16(bf, x1, a1, 0, 0, 0);
            }
#pragma unroll
            for (int mt = 0; mt < 2; ++mt) {
                const f32x4 a = mt ? a1 : a0;
                const size_t tok = (size_t)(tok0[mt] + nt);
                const u32x2 u2 = uu[ntl][mt];
                const float y0 = a[0] + dv[0] * bf_lo(u2.x), y1 = a[1] + dv[1] * bf_hi(u2.x), y2 = a[2] + dv[2] * bf_lo(u2.y), y3 = a[3] + dv[3] * bf_hi(u2.y);
                u32x2 w; w.x = cvt_pk_bf16(gelu_tanh(y0), gelu_tanh(y1)); w.y = cvt_pk_bf16(gelu_tanh(y2), gelu_tanh(y3));
                *(u32x2*)(Zo + tok * 1024 + g * 16 + 4 * fq) = w;
            }
        }
        __syncthreads();
        if (cq < 3) {
#pragma unroll
            for (int i = 0; i < 6; ++i) { const int row = tid >> 3, kc = (tid & 7) + 8 * i; *(LAS u32x4*)(WB + row * TS + kc * 8) = tmr[i]; }
            __syncthreads();
        }
    }
}

__device__ __forceinline__ bf16x8 tr_frag(const LAS bf16_t* tile, int row0, int col0, int fr, int fq) {
    const LAS bf16_t* p = tile + (row0 + 8 * fq + (fr >> 2)) * 136 + col0 + 4 * (fr & 3);
    const bf16x4 a = __builtin_amdgcn_ds_read_tr16_b64_v4i16((LAS bf16x4*)p);
    const bf16x4 b = __builtin_amdgcn_ds_read_tr16_b64_v4i16((LAS bf16x4*)(p + 4 * 136));
    bf16x8 r; r[0] = a[0]; r[1] = a[1]; r[2] = a[2]; r[3] = a[3]; r[4] = b[0]; r[5] = b[1]; r[6] = b[2]; r[7] = b[3]; return r;
}
__device__ __forceinline__ void ret_kv_items(const Params& P, LAS unsigned char* lds, int tid, int first, int stride) {
    const int wave = __builtin_amdgcn_readfirstlane(tid >> 6), lane = tid & 63, fr = lane & 15, fq = lane >> 4;
    constexpr int RS = 136;
    LAS bf16_t* Ks = (LAS bf16_t*)lds; LAS bf16_t* Vs = Ks + 128 * RS;
    const bf16_t* proj = (const bf16_t*)(P.ws + WS_PROJ);
    bf16_t* KV = (bf16_t*)(P.ws + WS_KV);
    const int si = tid >> 2, part = tid & 3, i0 = 16 * wave;
    u32x4 kr[4], vr[4];
    int item = first;
    if (item >= 768) return;
    { const int bh = item / 12, n = item % 12; const bf16_t* pr = proj + ((size_t)(bh >> 3) * 2048 + n * 128 + si) * NPROJ + (bh & 7) * 128 + 32 * part;
#pragma unroll
      for (int j = 0; j < 4; ++j) { kr[j] = *(const u32x4*)(pr + 2048 + 8 * j); vr[j] = *(const u32x4*)(pr + 3072 + 8 * j); } }
    for (;;) {
#pragma unroll
        for (int j = 0; j < 4; ++j) { *(LAS u32x4*)(Ks + si * RS + 32 * part + 8 * j) = kr[j]; *(LAS u32x4*)(Vs + si * RS + 32 * part + 8 * j) = vr[j]; }
        __syncthreads();
        const int nxt = item + stride; const bool more = nxt < 768;
        if (more) { const int bh = nxt / 12, n = nxt % 12; const bf16_t* pr = proj + ((size_t)(bh >> 3) * 2048 + n * 128 + si) * NPROJ + (bh & 7) * 128 + 32 * part;
#pragma unroll
            for (int j = 0; j < 4; ++j) { kr[j] = *(const u32x4*)(pr + 2048 + 8 * j); vr[j] = *(const u32x4*)(pr + 3072 + 8 * j); } }
        bf16x8 Vt[4];
#pragma unroll
        for (int ks = 0; ks < 4; ++ks) Vt[ks] = tr_frag(Vs, 32 * ks, i0, fr, fq);
        const int bh = item / 12, n = item % 12;
        bf16_t* op = KV + ((size_t)(bh * 16 + n) * 128 + i0 + fr) * 128 + 4 * fq;
#pragma unroll
        for (int nt = 0; nt < 8; ++nt) {
            f32x4 a = {0.f, 0.f, 0.f, 0.f};
#pragma unroll
            for (int ks = 0; ks < 4; ++ks) { const bf16x8 kf = tr_frag(Ks, 32 * ks, 16 * nt, fr, fq); a = __builtin_amdgcn_mfma_f32_16x16x32_bf16(kf, Vt[ks], a, 0, 0, 0); }
            *(u32x2*)(op + 16 * nt) = (u32x2){cvt_pk_bf16(a[0], a[1]), cvt_pk_bf16(a[2], a[3])};
        }
        __syncthreads();
        if (!more) break;
        item = nxt;
    }
}
__device__ __forceinline__ void ret_out_item(const Params& P, LAS unsigned char* lds, int tid, int item) {
    const int bh = item >> 2, q = item & 3, b = bh >> 3, h = bh & 7;
    const int wave = __builtin_amdgcn_readfirstlane(tid >> 6), lane = tid & 63, fr = lane & 15, fq = lane >> 4;
    constexpr int RS = 136;
    LAS bf16_t* Qs = (LAS bf16_t*)lds;
    LAS bf16_t* Ks = Qs + 128 * RS;
    LAS bf16_t* Vs = Ks + 128 * RS;
    LAS bf16_t* Rs = Vs + 128 * RS;
    const bf16_t* proj = (const bf16_t*)(P.ws + WS_PROJ);
    const bf16_t* KV = (const bf16_t*)(P.ws + WS_KV);
    bf16_t* CAT = (bf16_t*)(P.ws + WS_CAT);
    const float gam = 1.0f - exp2f(-5.0f - (float)h);
    const float lg2 = log2f(gam);
    const float gC1 = exp2f(lg2 * 127.0f), gC = exp2f(lg2 * 128.0f);
    const int si = tid >> 2, part = tid & 3, i0 = 16 * wave;
    u32x4 st[12];
    { const bf16_t* pr = proj + ((size_t)b * 2048 + (4 * q) * 128 + si) * NPROJ + h * 128 + 32 * part;
#pragma unroll
      for (int j = 0; j < 4; ++j) { st[j] = *(const u32x4*)(pr + 1024 + 8 * j); st[4 + j] = *(const u32x4*)(pr + 2048 + 8 * j); st[8 + j] = *(const u32x4*)(pr + 3072 + 8 * j); } }
    f32x4 accR[8];
#pragma unroll
    for (int nt = 0; nt < 8; ++nt) accR[nt] = (f32x4){0.f, 0.f, 0.f, 0.f};
    for (int m = 0; m < 4 * q; ++m) {
        const bf16_t* tp = KV + ((size_t)(bh * 16 + m) * 128 + i0 + fr) * 128 + 4 * fq;
        u32x2 t[8];
#pragma unroll
        for (int nt = 0; nt < 8; ++nt) t[nt] = *(const u32x2*)(tp + 16 * nt);
#pragma unroll
        for (int nt = 0; nt < 8; ++nt) { const f32x4 kv = {bf_lo(t[nt].x), bf_hi(t[nt].x), bf_lo(t[nt].y), bf_hi(t[nt].y)}; accR[nt] = accR[nt] * gC + kv * gC1; }
    }
#pragma unroll
    for (int nt = 0; nt < 8; ++nt)
        *(LAS u32x2*)(Rs + (i0 + fr) * RS + 16 * nt + 4 * fq) = (u32x2){cvt_pk_bf16(accR[nt][0], accR[nt][1]), cvt_pk_bf16(accR[nt][2], accR[nt][3])};
    for (int nn = 0; nn < 4; ++nn) {
        const int n = 4 * q + nn;
#pragma unroll
        for (int j = 0; j < 4; ++j) { *(LAS u32x4*)(Qs + si * RS + 32 * part + 8 * j) = st[j]; *(LAS u32x4*)(Ks + si * RS + 32 * part + 8 * j) = st[4 + j]; *(LAS u32x4*)(Vs + si * RS + 32 * part + 8 * j) = st[8 + j]; }
        __syncthreads();
        if (nn < 3) { const bf16_t* pr = proj + ((size_t)b * 2048 + (n + 1) * 128 + si) * NPROJ + h * 128 + 32 * part;
#pragma unroll
            for (int j = 0; j < 4; ++j) { st[j] = *(const u32x4*)(pr + 1024 + 8 * j); st[4 + j] = *(const u32x4*)(pr + 2048 + 8 * j); st[8 + j] = *(const u32x4*)(pr + 3072 + 8 * j); } }
        const size_t tok = (size_t)b * 2048 + n * 128 + i0 + fr;
        u32x2 gg[8];
        { const bf16_t* gp = proj + tok * NPROJ + 4096 + h * 128 + 4 * fq;
#pragma unroll
          for (int nt = 0; nt < 8; ++nt) gg[nt] = *(const u32x2*)(gp + 16 * nt); }
        bf16x8 Qf[4];
#pragma unroll
        for (int ks = 0; ks < 4; ++ks) Qf[ks] = *(const LAS bf16x8*)(Qs + (i0 + fr) * RS + 32 * ks + 8 * fq);
        f32x4 accS[8], accO[8];
#pragma unroll
        for (int nt = 0; nt < 8; ++nt) { accS[nt] = (f32x4){0.f, 0.f, 0.f, 0.f}; accO[nt] = (f32x4){0.f, 0.f, 0.f, 0.f}; }
#pragma unroll
        for (int nt = 0; nt < 8; ++nt) {
            if (nt <= wave) {
#pragma unroll
                for (int ks = 0; ks < 4; ++ks) { const bf16x8 kf = *(const LAS bf16x8*)(Ks + (16 * nt + fr) * RS + 32 * ks + 8 * fq); accS[nt] = __builtin_amdgcn_mfma_f32_16x16x32_bf16(kf, Qf[ks], accS[nt], 0, 0, 0); }
            }
        }
        if (n > 0) {
#pragma unroll
            for (int nt = 0; nt < 8; ++nt) {
#pragma unroll
                for (int ks = 0; ks < 4; ++ks) { const bf16x8 rf = *(const LAS bf16x8*)(Rs + (16 * nt + fr) * RS + 32 * ks + 8 * fq); accO[nt] = __builtin_amdgcn_mfma_f32_16x16x32_bf16(rf, Qf[ks], accO[nt], 0, 0, 0); }
                accO[nt] *= gam;
            }
        }
#pragma unroll
        for (int nt = 0; nt < 8; ++nt) {
            const int i = i0 + fr, j0 = 16 * nt + 4 * fq;
            const float p0 = (j0 <= i) ? accS[nt][0] : 0.f, p1 = (j0 + 1 <= i) ? accS[nt][1] : 0.f, p2 = (j0 + 2 <= i) ? accS[nt][2] : 0.f, p3 = (j0 + 3 <= i) ? accS[nt][3] : 0.f;
            *(LAS u32x2*)(Qs + i * RS + j0) = (u32x2){cvt_pk_bf16(p0, p1), cvt_pk_bf16(p2, p3)};
        }
        asm volatile("" ::: "memory");
        bf16x8 Pf[4];
#pragma unroll
        for (int ks = 0; ks < 4; ++ks) Pf[ks] = *(const LAS bf16x8*)(Qs + (i0 + fr) * RS + 32 * ks + 8 * fq);
#pragma unroll
        for (int ks = 0; ks < 4; ++ks) {
            if (2 * ks <= wave) {
#pragma unroll
                for (int nt = 0; nt < 8; ++nt) { const bf16x8 vf = tr_frag(Vs, 32 * ks, 16 * nt, fr, fq); accO[nt] = __builtin_amdgcn_mfma_f32_16x16x32_bf16(vf, Pf[ks], accO[nt], 0, 0, 0); }
            }
        }
        if (nn < 3) {
            bf16x8 Vt[4];
#pragma unroll
            for (int ks = 0; ks < 4; ++ks) Vt[ks] = tr_frag(Vs, 32 * ks, i0, fr, fq);
#pragma unroll
            for (int nt = 0; nt < 8; ++nt) {
                accR[nt] *= gam;
#pragma unroll
                for (int ks = 0; ks < 4; ++ks) { const bf16x8 kf = tr_frag(Ks, 32 * ks, 16 * nt, fr, fq); accR[nt] = __builtin_amdgcn_mfma_f32_16x16x32_bf16(kf, Vt[ks], accR[nt], 0, 0, 0); }
                accR[nt] *= gC1;
            }
        }
        {
            float s = 0.f;
#pragma unroll
            for (int nt = 0; nt < 8; ++nt) s += (accO[nt][0] + accO[nt][1]) + (accO[nt][2] + accO[nt][3]);
            s += __shfl_xor(s, 16); s += __shfl_xor(s, 32);
            const float mu = s * (1.0f / 128.0f); float qv = 0.f;
#pragma unroll
            for (int nt = 0; nt < 8; ++nt) { const f32x4 d = accO[nt] - mu; qv += (d[0] * d[0] + d[1] * d[1]) + (d[2] * d[2] + d[3] * d[3]); }
            qv += __shfl_xor(qv, 16); qv += __shfl_xor(qv, 32);
            const float rstd = rsqrtf(qv * (1.0f / 128.0f) + 1e-5f);
            bf16_t* op = CAT + tok * DM + 1024 + h * 128 + 4 * fq;
#pragma unroll
            for (int nt = 0; nt < 8; ++nt) {
                const float g0 = bf_lo(gg[nt].x), g1 = bf_hi(gg[nt].x), g2 = bf_lo(gg[nt].y), g3 = bf_hi(gg[nt].y);
                const f32x4 y = (accO[nt] - mu) * rstd;
                u32x2 w; w.x = cvt_pk_bf16(y[0] * g0 * sigmoidf_(g0), y[1] * g1 * sigmoidf_(g1)); w.y = cvt_pk_bf16(y[2] * g2 * sigmoidf_(g2), y[3] * g3 * sigmoidf_(g3));
                *(u32x2*)(op + 16 * nt) = w;
            }
        }
        __syncthreads();
        if (nn < 3) {
#pragma unroll
            for (int nt = 0; nt < 8; ++nt)
                *(LAS u32x2*)(Rs + (i0 + fr) * RS + 16 * nt + 4 * fq) = (u32x2){cvt_pk_bf16(accR[nt][0], accR[nt][1]), cvt_pk_bf16(accR[nt][2], accR[nt][3])};
        }
    }
}

__device__ __forceinline__ void p6_route(const Params& P, LAS unsigned char* lds, int tid, int blk, int G) {
    const int wave = __builtin_amdgcn_readfirstlane(tid >> 6), lane = tid & 63, fr = lane & 15, fq = lane >> 4;
    LAS float* gm = (LAS float*)lds; LAS float* sh = gm + 2048; LAS float* lg = sh + 2048;
    LAS float* lgr = lg + 8 * 64 * 48;
    LAS float* r2s = lgr + 64 * 36;
    LAS int* lcnt = (LAS int*)(r2s + 64); LAS int* lbase = lcnt + 32;
    int ra_ = 0, rb_ = 0, ea_ = 0, eb_ = 0; float w1_ = 0.f, w2_ = 0.f;
    const float* mod = (const float*)(P.ws + WS_MOD);
    const bf16_t* x1 = (const bf16_t*)(P.ws + WS_X1); const float* rowss2 = (const float*)(P.ws + WS_ROWSS2);
    unsigned char* H2 = P.ws + WS_H;
    const bf16_t* WR = (const bf16_t*)(P.ws + WS_WR);
    int* cnt = (int*)(P.ws + WS_CNT); int* list = (int*)(P.ws + WS_LIST); float* wgt = (float*)(P.ws + WS_WGT);
    for (int rb = blk; rb < 256; rb += G) {
        const int b = rb >> 5;
        for (int k = tid; k < 2048; k += NTHREADS) { gm[k] = P.in[18][k] * (1.0f + mod[(size_t)b * NMOD + 4 * DM + k]); sh[k] = mod[(size_t)b * NMOD + 3 * DM + k]; }
        if (tid < 32) lcnt[tid] = 0;
        if (tid >= 64 && tid < 128) { const int r = tid - 64; float tot2 = 0.f; const f32x4* pp = (const f32x4*)(rowss2 + (size_t)(rb * 64 + r) * 32);
#pragma unroll
            for (int i = 0; i < 8; ++i) { const f32x4 v = pp[i]; tot2 += (v[0] + v[1]) + (v[2] + v[3]); }
            r2s[r] = rsqrtf(tot2 * (1.0f / 2048.0f) + 1e-6f); }
        __syncthreads();
        float r2v[4];
#pragma unroll
        for (int mt = 0; mt < 4; ++mt) r2v[mt] = r2s[16 * mt + fr];
        f32x4 acc[4][3];
#pragma unroll
        for (int mt = 0; mt < 4; ++mt)
#pragma unroll
            for (int nt = 0; nt < 3; ++nt) acc[mt][nt] = (f32x4){0.f, 0.f, 0.f, 0.f};
        const bf16_t* xb = x1 + (size_t)(rb * 64 + fr) * DM + 256 * wave + 8 * fq;
        const bf16_t* wb = WR + (size_t)fr * 2048 + 256 * wave + 8 * fq;
        unsigned char* hb = H2 + (size_t)(rb * 64 + fr) * DM + 256 * wave + 8 * fq;
        u32x4 xc[2][4], xn[2][4]; bf16x8 bc[2][3], bn[2][3];
#pragma unroll
        for (int j = 0; j < 2; ++j) {
#pragma unroll
            for (int mt = 0; mt < 4; ++mt) xc[j][mt] = *(const u32x4*)(xb + (size_t)(16 * mt) * DM + 32 * j);
#pragma unroll
            for (int nt = 0; nt < 3; ++nt) bc[j][nt] = *(const bf16x8*)(wb + (size_t)(16 * nt) * 2048 + 32 * j); }
#pragma unroll 1
        for (int qt = 0; qt < 4; ++qt) {
            const int qn = qt < 3 ? qt + 1 : 3;
#pragma unroll
            for (int j = 0; j < 2; ++j) {
#pragma unroll
                for (int mt = 0; mt < 4; ++mt) xn[j][mt] = *(const u32x4*)(xb + (size_t)(16 * mt) * DM + 32 * (2 * qn + j));
#pragma unroll
                for (int nt = 0; nt < 3; ++nt) bn[j][nt] = *(const bf16x8*)(wb + (size_t)(16 * nt) * 2048 + 32 * (2 * qn + j)); }
#pragma unroll
            for (int j = 0; j < 2; ++j) {
                const int kl = 256 * wave + 32 * (2 * qt + j) + 8 * fq;
                const f32x4 g0 = *(const LAS f32x4*)(gm + kl), g1 = *(const LAS f32x4*)(gm + kl + 4), s0 = *(const LAS f32x4*)(sh + kl), s1 = *(const LAS f32x4*)(sh + kl + 4);
#pragma unroll
                for (int mt = 0; mt < 4; ++mt) {
                    const u32x4 xw = xc[j][mt];
                    const f32x4 a = {bf_lo(xw.x), bf_hi(xw.x), bf_lo(xw.y), bf_hi(xw.y)}, c = {bf_lo(xw.z), bf_hi(xw.z), bf_lo(xw.w), bf_hi(xw.w)};
                    const f32x4 h0 = a * r2v[mt] * g0 + s0, h1 = c * r2v[mt] * g1 + s1;
                    u32x4 w; w.x = cvt_pk_bf16(h0[0], h0[1]); w.y = cvt_pk_bf16(h0[2], h0[3]); w.z = cvt_pk_bf16(h1[0], h1[1]); w.w = cvt_pk_bf16(h1[2], h1[3]);
                    int q0 = 0, q1 = 0;
                    q0 = __builtin_amdgcn_cvt_pk_fp8_f32(h0[0], h0[1], q0, false); q0 = __builtin_amdgcn_cvt_pk_fp8_f32(h0[2], h0[3], q0, true);
                    q1 = __builtin_amdgcn_cvt_pk_fp8_f32(h1[0], h1[1], q1, false); q1 = __builtin_amdgcn_cvt_pk_fp8_f32(h1[2], h1[3], q1, true);
                    *(u32x2*)(hb + (size_t)(16 * mt) * DM + 32 * (2 * qt + j)) = (u32x2){(unsigned)q0, (unsigned)q1};
                    const bf16x8 af = __builtin_bit_cast(bf16x8, w);
#pragma unroll
                    for (int nt = 0; nt < 3; ++nt) acc[mt][nt] = __builtin_amdgcn_mfma_f32_16x16x32_bf16(bc[j][nt], af, acc[mt][nt], 0, 0, 0);
                }
            }
#pragma unroll
            for (int j = 0; j < 2; ++j) {
#pragma unroll
                for (int mt = 0; mt < 4; ++mt) xc[j][mt] = xn[j][mt];
#pragma unroll
                for (int nt = 0; nt < 3; ++nt) bc[j][nt] = bn[j][nt]; }
        }
#pragma unroll
        for (int mt = 0; mt < 4; ++mt)
#pragma unroll
            for (int nt = 0; nt < 3; ++nt) *(LAS f32x4*)(lg + (wave * 64 + 16 * mt + fr) * 48 + 16 * nt + 4 * fq) = acc[mt][nt];
        __syncthreads();
        for (int o = tid; o < 64 * 36; o += NTHREADS) { const int r = o / 36, nn = o % 36; float sum = 0.f;
#pragma unroll
            for (int w = 0; w < 8; ++w) sum += lg[(w * 64 + r) * 48 + nn];
            lgr[o] = sum; }
        __syncthreads();
        if (tid < 64) {
            const int tok = rb * 64 + tid;
            float l[36];
#pragma unroll
            for (int nn = 0; nn < 36; ++nn) l[nn] = lgr[tid * 36 + nn];
            float gl[4]; int gs = 0;
#pragma unroll
            for (int j = 0; j < 4; ++j) gl[j] = l[j] + P.in[20][j];
#pragma unroll
            for (int j = 1; j < 4; ++j) if (gl[j] > gl[gs]) gs = j;
            float gmax = gl[0];
#pragma unroll
            for (int j = 1; j < 4; ++j) gmax = fmaxf(gmax, gl[j]);
            float den = 0.f;
#pragma unroll
            for (int j = 0; j < 4; ++j) den += expf(gl[j] - gmax);
            const float gw = 1.0f / den;
            float el[8];
#pragma unroll
            for (int j = 0; j < 8; ++j) { float v = 0.f;
#pragma unroll
                for (int q = 0; q < 4; ++q) v = (gs == q) ? (l[4 + q * 8 + j] + P.in[22][q * 8 + j]) : v;
                el[j] = v; }
            int j1 = 0;
#pragma unroll
            for (int j = 1; j < 8; ++j) if (el[j] > el[j1]) j1 = j;
            int j2 = (j1 == 0) ? 1 : 0;
#pragma unroll
            for (int j = 0; j < 8; ++j) if (j != j1 && j != j2 && el[j] > el[j2]) j2 = j;
            float e1 = el[0], e2 = el[0];
#pragma unroll
            for (int j = 0; j < 8; ++j) { e1 = (j == j1) ? el[j] : e1; e2 = (j == j2) ? el[j] : e2; }
            const float t2 = expf(e2 - e1), w1 = gw / (1.0f + t2), w2 = gw * t2 / (1.0f + t2);
            const int ea = gs * 8 + j1, eb = gs * 8 + j2;
            ra_ = atomicAdd((int*)&lcnt[ea], 1); rb_ = atomicAdd((int*)&lcnt[eb], 1); ea_ = ea; eb_ = eb; w1_ = w1; w2_ = w2;
        }
        __syncthreads();
        if (tid < 32) { const int c = lcnt[tid]; lbase[tid] = c > 0 ? atomicAdd(cnt + tid * 64, c) : 0; }
        __syncthreads();
        if (tid < 64) {
            const int tok = rb * 64 + tid;
            list[ea_ * 16384 + lbase[ea_] + ra_] = tok * 2; wgt[tok * 2] = w1_;
            list[eb_ * 16384 + lbase[eb_] + rb_] = tok * 2 + 1; wgt[tok * 2 + 1] = w2_;
        }
        __syncthreads();
    }
}

__device__ __forceinline__ void p9_final(const Params& P, int tid, int blk, int G) {
    const int wave = tid >> 6, lane = tid & 63;
    const float* mod = (const float*)(P.ws + WS_MOD); const bf16_t* Y2 = (const bf16_t*)(P.ws + WS_Y2); const bf16_t* X1 = (const bf16_t*)(P.ws + WS_X1);
    f32x4 gf[8];
#pragma unroll
    for (int i = 0; i < 8; ++i) gf[i] = *(const f32x4*)(P.in[26] + (i * 64 + lane) * 4);
    int row = blk * 8 + wave;
    u32x2 xw[8], ya[8], yb[8], xwn[8], yan[8], ybn[8];
    if (row < NTOK) {
#pragma unroll
        for (int i = 0; i < 8; ++i) { const int k = (i * 64 + lane) * 4; xw[i] = *(const u32x2*)(X1 + (size_t)row * DM + k); ya[i] = *(const u32x2*)(Y2 + (size_t)(2 * row) * DM + k); yb[i] = *(const u32x2*)(Y2 + (size_t)(2 * row + 1) * DM + k); }
    }
    for (; row < NTOK; row += G * 8) {
        const int b = row >> 11, rown = row + G * 8;
        if (rown < NTOK) {
#pragma unroll
            for (int i = 0; i < 8; ++i) { const int k = (i * 64 + lane) * 4; xwn[i] = *(const u32x2*)(X1 + (size_t)rown * DM + k); yan[i] = *(const u32x2*)(Y2 + (size_t)(2 * rown) * DM + k); ybn[i] = *(const u32x2*)(Y2 + (size_t)(2 * rown + 1) * DM + k); }
        }
        f32x4 v[8]; float ss = 0.f;
#pragma unroll
        for (int i = 0; i < 8; ++i) {
            const int k = (i * 64 + lane) * 4;
            const f32x4 xv = {bf_lo(xw[i].x), bf_hi(xw[i].x), bf_lo(xw[i].y), bf_hi(xw[i].y)};
            const f32x4 gt = *(const f32x4*)(mod + (size_t)b * NMOD + 5 * DM + k);
            f32x4 y; y[0] = bf_lo(ya[i].x) + bf_lo(yb[i].x); y[1] = bf_hi(ya[i].x) + bf_hi(yb[i].x); y[2] = bf_lo(ya[i].y) + bf_lo(yb[i].y); y[3] = bf_hi(ya[i].y) + bf_hi(yb[i].y);
            v[i] = xv + gt * y;
            ss += v[i][0] * v[i][0] + v[i][1] * v[i][1] + v[i][2] * v[i][2] + v[i][3] * v[i][3];
        }
        ss = wave_sum(ss);
        const float r = rsqrtf(ss * (1.0f / 2048.0f) + 1e-6f);
        float* xr = P.out + (size_t)row * DM;
#pragma unroll
        for (int i = 0; i < 8; ++i) { const int k = (i * 64 + lane) * 4; *(f32x4*)(xr + k) = v[i] * r * gf[i]; }
#pragma unroll
        for (int i = 0; i < 8; ++i) { xw[i] = xwn[i]; ya[i] = yan[i]; yb[i] = ybn[i]; }
    }
}

__global__ void __launch_bounds__(NTHREADS, 2) hymba_fwd(Params P) {
    extern __shared__ __attribute__((aligned(16))) unsigned char lds_raw[];
    LAS unsigned char* lds = (LAS unsigned char*)lds_raw;
    const int tid = threadIdx.x, blk = blockIdx.x, G = gridDim.x;
    volatile LAS unsigned* misc = (volatile LAS unsigned*)(lds + LDS_MISC);
    if (tid < 64) misc[tid] = 0u;
    __syncthreads();
    XcdBarrier bar = xcd_barrier_post((unsigned*)(P.ws + WS_BAR), misc);
    const int lo = P.ph_lo, hi = P.ph_hi;
#define IN(k) (lo <= (k) && (k) < hi)
#define SEAM(k) do { if (IN(k) && IN((k) + 1)) xcd_barrier(bar); } while (0)
    unsigned char* ws = P.ws;

#ifndef REPR
#define REPR 1
#endif
#ifndef REPS
#define REPS 1
#endif
#ifndef REP0
#define REP0 1
#endif
#ifndef REP2
#define REP2 1
#endif
#ifndef REP7
#define REP7 1
#endif
#ifndef REP8
#define REP8 1
#endif
    if (IN(0)) for (int rep0 = 0; rep0 < REP0; ++rep0) {
        for (int it = blk; it < 256; it += G) p0_adaln(P, lds, tid, it);
        for (int it = blk; it < 256; it += G) p0_ssm_mats(P, lds, tid, it);
        p0_misc(P, tid, blk, G);
        p0_convert(P, lds, tid, blk, G);
    }
    SEAM(0);
    if (IN(1)) p1_norm1(P, lds, tid, blk, G);
    SEAM(1);
    if (IN(2)) for (int rep2 = 0; rep2 < REP2; ++rep2) {
        DenseSched S; S.init(NTOK, NPROJ, G, blk); S.abase = (unsigned)WS_H; S.bbase = (unsigned)WS_WIN; S.lda = DM; S.ldb = DM;
        EpiInProj E{(bf16_t*)(ws + WS_PROJ)};
        g8::gemm_phase(lds, ws, DM / 64, DM, S, E);
    }
    SEAM(2);
    if (IN(3)) {
        for (int it = blk; it < 256; it += G) ssm_item(P, lds, tid, it);
        ret_kv_items(P, lds, tid, blk, G);
    }
    SEAM(3);
    if (IN(4)) {
        for (int it = blk; it < 256; it += G) ret_out_item(P, lds, tid, it);
        __syncthreads();
        DenseSched S; S.init(NTOK, 1024, G, blk); S.abase = (unsigned)WS_Z; S.bbase = (unsigned)WS_WGLU; S.lda = 1024; S.ldb = 1024;
        EpiGlu E{(const bf16_t*)(ws + WS_Z), (bf16_t*)(ws + WS_CAT), (float*)(ws + WS_ROWSS1)};
        g8::gemm_phase(lds, ws, 1024 / 64, 1024, S, E);
    }
    SEAM(4);
    if (IN(5)) {
        OutSched S; S.init(NTOK, DM, G, blk); S.abase = (unsigned)WS_CAT; S.bbase = (unsigned)WS_WOUT;
        EpiOut E{P.in[0], (const float*)(ws + WS_MOD), (const float*)(ws + WS_ROWSS1), (float*)(ws + WS_ROWSS2), (bf16_t*)(ws + WS_X1)};
        g8::gemm_phase(lds, ws, 1024 / 64, DM, S, E);
    }
    SEAM(5);
    if (IN(6)) { p6_route(P, lds, tid, blk, G); p0_convert_fp8(P, lds, tid, blk, G, 0, 8192); }
    SEAM(6);
    if (IN(7) || IN(8)) {
        LAS int* tinfo = (LAS int*)(lds + LDS_MISC + 256); LAS int* trows = tinfo + 192; LAS int* ntl = trows + 192;
        if (tid == 0) {
            const int* cg = (const int*)(ws + WS_CNT); int nt_ = 0;
            for (int e = 0; e < 32; ++e) { const int c = cg[e * 64], full = c >> 8, rem = c & 255;
                for (int t = 0; t < full; ++t) { tinfo[nt_] = e | ((t * 256) << 8); trows[nt_] = 256; ++nt_; }
                if (rem > 128) { tinfo[nt_] = e | ((full * 256) << 8); trows[nt_] = rem; ++nt_; } }
            for (int e = 0; e < 32; ++e) { const int c = cg[e * 64], full = c >> 8, rem = c & 255; if (rem > 64 && rem <= 128) { tinfo[nt_] = e | ((full * 256) << 8); trows[nt_] = rem; ++nt_; } }
            for (int e = 0; e < 32; ++e) { const int c = cg[e * 64], full = c >> 8, rem = c & 255; if (rem > 0 && rem <= 64) { tinfo[nt_] = e | ((full * 256) << 8); trows[nt_] = rem; ++nt_; } }
            ntl[0] = nt_;
        }
        __syncthreads();
        const int ntiles = __builtin_amdgcn_readfirstlane(ntl[0]);
        if (IN(7)) {
            { u32x2* slot = (u32x2*)(ws + WS_SLOT); const int* lst = (const int*)(ws + WS_LIST); const float* wg = (const float*)(ws + WS_WGT);
              for (int ti = blk; ti < ntiles; ti += G) if (tid < 256) {
                  const int inf = tinfo[ti], e = inf & 255, r0 = inf >> 8, n = trows[ti];
                  u32x2 v; v.x = 0xffffffffu; v.y = 0u;
                  if (tid < n) { const int asg = lst[e * 16384 + r0 + tid]; v.x = (unsigned)asg; v.y = __float_as_uint(wg[asg] * (1.0f / WD_SCALE)); }
                  slot[ti * 256 + tid] = v; } }
            MoeSched S{tinfo, trows, ntiles, G, blk, (const int*)(ws + WS_LIST), (unsigned)WS_H, (unsigned)WS_WGU, 0};
            EpiMoe1 E{ws + WS_HM};
            g8::gemm_phase<EpiMoe1, MoeSched, true, 2>(lds, ws, DM / 128, DM, S, E);
            p0_convert_fp8(P, lds, tid, blk, G, 8192, 12288);
        }
        SEAM(7);
        if (IN(8)) {
            MoeSched S{tinfo, trows, ntiles, G, blk, (const int*)(ws + WS_LIST), (unsigned)WS_HM, (unsigned)WS_WD, 1};
            EpiMoe2 E{(const u32x2*)(ws + WS_SLOT), (bf16_t*)(ws + WS_Y2)};
            g8::gemm_phase<EpiMoe2, MoeSched, true, 2>(lds, ws, DEXP / 128, DEXP, S, E);
        }
    }
    SEAM(8);
    if (IN(9)) p9_final(P, tid, blk, G);
#undef IN
#undef SEAM
}

#ifndef N_LAUNCH_SPLIT
#define N_LAUNCH_SPLIT 0
#endif
extern "C" void kernel_launch(void* const* d_in, const int* in_sizes, int n_in, void* d_out, int out_size, void* d_ws, size_t ws_size, hipStream_t stream) {
    static int grid = 0;
    if (grid == 0) {
        if (n_in != 27 || out_size != NTOK * DM || ws_size < WS_END) { fprintf(stderr, "kernel_launch: unexpected shapes (n_in %d out %d ws %zu need %zu)\n", n_in, out_size, ws_size, (size_t)WS_END); grid = -1; return; }
        int dev = 0, cus = 0, per_cu = 0;
        if (hipGetDevice(&dev) != hipSuccess || hipDeviceGetAttribute(&cus, hipDeviceAttributeMultiprocessorCount, dev) != hipSuccess) { grid = -1; return; }
        if (hipFuncSetAttribute((const void*)hymba_fwd, hipFuncAttributeMaxDynamicSharedMemorySize, LDS_BYTES) != hipSuccess) { fprintf(stderr, "kernel_launch: hipFuncSetAttribute failed\n"); grid = -1; return; }
        if (hipOccupancyMaxActiveBlocksPerMultiprocessor(&per_cu, (const void*)hymba_fwd, NTHREADS, LDS_BYTES) != hipSuccess || per_cu < 1) { fprintf(stderr, "kernel_launch: occupancy query says %d\n", per_cu); }
        (void)hipGetLastError();
        grid = cus;
    }
    if (grid < 0) return;
    (void)hipMemsetAsync((char*)d_ws + WS_BAR, 0, 16384, stream);
    Params p{};
    for (int i = 0; i < 27; ++i) p.in[i] = (const float*)d_in[i];
    p.out = (float*)d_out; p.ws = (unsigned char*)d_ws;
#if N_LAUNCH_SPLIT
    for (int ph = 0; ph < 10; ++ph) { p.ph_lo = ph; p.ph_hi = ph + 1; hipLaunchKernelGGL(hymba_fwd, dim3(grid), dim3(NTHREADS), LDS_BYTES, stream, p); }
#else
    p.ph_lo = 0; p.ph_hi = 10;
    hipLaunchKernelGGL(hymba_fwd, dim3(grid), dim3(NTHREADS), LDS_BYTES, stream, p);
#endif
    const hipError_t le = hipPeekAtLastError();
    if (le != hipSuccess) fprintf(stderr, "kernel_launch: launch failed: %s\n", hipGetErrorName(le));
}
```

```cpp
#include <hip/hip_runtime.h>
#include <cstdio>
#include <cstdint>

#define LAS __attribute__((address_space(3)))
typedef unsigned short bf16_t;
typedef short bf16x8 __attribute__((ext_vector_type(8)));
typedef short bf16x4 __attribute__((ext_vector_type(4)));
typedef float f32x4 __attribute__((ext_vector_type(4)));
typedef float f32x2 __attribute__((ext_vector_type(2)));
typedef unsigned u32x4 __attribute__((ext_vector_type(4)));
typedef unsigned u32x2 __attribute__((ext_vector_type(2)));

constexpr int DM = 2048, NB = 8, SEQ = 2048, NTOK = NB * SEQ;
constexpr int NPROJ = 5120;
constexpr int NMOD = 6 * DM;
constexpr int NEXP = 32, DEXP = 1024;
constexpr int NTHREADS = 512;

constexpr size_t WS_BAR   = 0;
constexpr size_t WS_CNT   = 16384;
constexpr size_t WS_ROWSS1= WS_CNT + 8192;
constexpr size_t WS_ROWSS2= WS_ROWSS1 + (size_t)16384 * 16 * 4;
constexpr size_t WS_MODP  = WS_ROWSS2 + (size_t)16384 * 32 * 4;
constexpr size_t WS_MOD   = WS_MODP + (size_t)4 * 8 * NMOD * 4;
constexpr size_t WS_ROPE  = WS_MOD + (size_t)8 * NMOD * 4;
constexpr size_t WS_SSMA  = WS_ROPE + (size_t)2048 * 64 * 8;
constexpr size_t WS_WR    = WS_SSMA + (size_t)64 * 64 * 8;
constexpr size_t WS_SSMM  = WS_WR + (size_t)48 * 2048 * 2;
constexpr size_t WS_WIN   = WS_SSMM + (size_t)64 * 131072 * 2;
constexpr size_t WS_WOUT  = WS_WIN + (size_t)NPROJ * DM * 2;
constexpr size_t WS_WGLU  = WS_WOUT + (size_t)DM * DM * 2;
constexpr size_t WS_WGU   = WS_WGLU + (size_t)1024 * 1024 * 2;
constexpr size_t WS_WD    = WS_WGU + (size_t)NEXP * 2048 * 2048 * 2;
constexpr size_t WS_H     = WS_WD + (size_t)NEXP * 2048 * 1024 * 2;
constexpr size_t WS_PROJ  = WS_H + (size_t)NTOK * DM * 2;
constexpr size_t WS_Z     = WS_PROJ + (size_t)NTOK * NPROJ * 2;
constexpr size_t WS_CAT   = WS_Z + (size_t)NTOK * 1024 * 2;
constexpr size_t WS_WGT   = WS_CAT + (size_t)NTOK * DM * 2;
constexpr size_t WS_LIST  = WS_WGT + (size_t)32768 * 4;
constexpr size_t WS_SLOT  = WS_LIST + (size_t)32 * 16384 * 4;
constexpr size_t WS_X1    = WS_SLOT + (size_t)192 * 256 * 8;
constexpr size_t WS_END   = WS_X1 + (size_t)NTOK * DM * 2;
constexpr size_t WS_Y2    = WS_PROJ;
constexpr size_t WS_HM    = WS_Z;

constexpr int LDS_STAGE = 131072;
constexpr int LDS_BYTES = 147456;
constexpr int LDS_MISC  = LDS_BYTES - 2048;

struct Params { const float* in[27]; float* out; unsigned char* ws; int ph_lo, ph_hi; };

#define XB_TMO      128
#define XB_XCNT(j)  (256  + 64 * (j))
#define XB_XSUB(j)  (1280 + 64 * (j))
#define XB_XGEN(j)  (2304 + 64 * (j))
#define XB_TOP      3328
#define XB_TOPGEN   3392
#define XCD_BAR_WORDS 3456
#define XB_SPIN_CAP (1u << 22)

__device__ __forceinline__ unsigned xb_ld(unsigned* p)              { return __hip_atomic_load(p, __ATOMIC_RELAXED, __HIP_MEMORY_SCOPE_AGENT); }
__device__ __forceinline__ unsigned xb_add(unsigned* p, unsigned v) { return __hip_atomic_fetch_add(p, v, __ATOMIC_RELAXED, __HIP_MEMORY_SCOPE_AGENT); }
__device__ __forceinline__ unsigned xb_xcc_id() { return (unsigned)__builtin_amdgcn_s_getreg((3 << 11) | 20) & 0xFu; }
#define XB_SPIN(cond, bar) do { unsigned _sp = 0; while (cond) { __builtin_amdgcn_s_sleep(1); \
    if ((++_sp & 255u) == 0u) { if (xb_ld(&(bar)[XB_TMO])) break; if (_sp > XB_SPIN_CAP) { atomicAdd(&(bar)[XB_TMO], 1u); break; } } } } while (0)

struct XcdBarrier { unsigned* bar; unsigned x; volatile LAS unsigned* st; };

__device__ __forceinline__ XcdBarrier xcd_barrier_post(unsigned* bar, volatile LAS unsigned* st) {
    XcdBarrier b; b.bar = bar; b.x = xb_xcc_id(); b.st = st;
    if (threadIdx.x == 0) (void)xb_add(&bar[XB_XCNT(b.x)], 1u);
    return b;
}
__device__ __forceinline__ void xcd_barrier_complete(unsigned* bar, unsigned x, unsigned& nloc, unsigned& nx) {
    const unsigned G = gridDim.x * gridDim.y * gridDim.z;
    unsigned sum, cnt, mine, sp = 0u;
    for (;;) {
        sum = 0u; cnt = 0u; mine = 0u;
#pragma unroll
        for (unsigned j = 0; j < 16; ++j) { const unsigned c = xb_ld(&bar[XB_XCNT(j)]); sum += c; cnt += (c > 0u) ? 1u : 0u; mine = (j == x) ? c : mine; }
        if (sum == G) break;
        __builtin_amdgcn_s_sleep(1);
        if ((++sp & 255u) == 0u) { if (xb_ld(&bar[XB_TMO])) break; if (sp > XB_SPIN_CAP) { atomicAdd(&bar[XB_TMO], 1u); break; } }
    }
    nloc = mine > 0u ? mine : 1u; nx = cnt > 0u ? cnt : 1u;
}
__device__ __forceinline__ void xcd_barrier(const XcdBarrier& b) {
    asm volatile("s_waitcnt vmcnt(0)" ::: "memory");
    __syncthreads();
    if (threadIdx.x == 0) {
        unsigned* bar = b.bar;
        __builtin_amdgcn_s_waitcnt(0);
        unsigned nloc = b.st[0], nx = b.st[1];
        if (nloc == 0u) { xcd_barrier_complete(bar, b.x, nloc, nx); b.st[0] = nloc; b.st[1] = nx; }
        const unsigned old = xb_add(&bar[XB_XSUB(b.x)], 1u);
        const unsigned gen = old / nloc;
        if (old + 1u == (gen + 1u) * nloc) {
            __builtin_amdgcn_fence(__ATOMIC_RELEASE, "agent");
            asm volatile("s_waitcnt vmcnt(0)" ::: "memory");
            const unsigned og = xb_add(&bar[XB_TOP], 1u);
            const unsigned tg = og / nx;
            if (og + 1u == (tg + 1u) * nx) xb_add(&bar[XB_TOPGEN], 1u);
            else XB_SPIN(xb_ld(&bar[XB_TOPGEN]) == tg, bar);
            __builtin_amdgcn_fence(__ATOMIC_ACQUIRE, "agent");
            xb_add(&bar[XB_XGEN(b.x)], 1u);
            asm volatile("s_waitcnt vmcnt(0)" ::: "memory");
        } else {
            XB_SPIN(xb_ld(&bar[XB_XGEN(b.x)]) == gen, bar);
            __builtin_amdgcn_fence(__ATOMIC_ACQUIRE, "agent");
            asm volatile("s_waitcnt vmcnt(0)" ::: "memory");
        }
    }
    __syncthreads();
}

typedef __bf16 bf16x2_t __attribute__((ext_vector_type(2)));
__device__ __forceinline__ unsigned cvt_pk_bf16(float lo, float hi) { const f32x2 v = {lo, hi}; return __builtin_bit_cast(unsigned, __builtin_convertvector(v, bf16x2_t)); }
__device__ __forceinline__ float bf_lo(unsigned w) { return __uint_as_float(w << 16); }
__device__ __forceinline__ float bf_hi(unsigned w) { return __uint_as_float(w & 0xffff0000u); }
__device__ __forceinline__ float sigmoidf_(float x) { return __builtin_amdgcn_rcpf(1.0f + __expf(-x)); }
__device__ __forceinline__ float gelu_tanh(float x) {
    const float u = 0.7978845608028654f * (x + 0.044715f * x * x * x);
    const float t = 1.0f - 2.0f * __builtin_amdgcn_rcpf(1.0f + __expf(2.0f * u));
    return 0.5f * x * (1.0f + t);
}
__device__ __forceinline__ float wave_sum(float v) {
    v += __shfl_xor(v, 1); v += __shfl_xor(v, 2); v += __shfl_xor(v, 4); v += __shfl_xor(v, 8); v += __shfl_xor(v, 16); v += __shfl_xor(v, 32); return v;
}
__device__ __forceinline__ void sincos_d(double x, double& s, double& c) {
    const double TWO_PI = 6.283185307179586476925286766559;
    double r = x - TWO_PI * rint(x / TWO_PI);
    const double r2 = r * r;
    double ts = r, tc = 1.0; s = r; c = 1.0;
#pragma unroll 1
    for (int k = 1; k <= 14; ++k) { tc *= -r2 / (double)((2 * k - 1) * (2 * k)); ts *= -r2 / (double)((2 * k) * (2 * k + 1)); c += tc; s += ts; }
}

namespace g8 {
constexpr int BM = 256, BK = 64, HALF = 128, HTB = HALF * BK * 2, NXCD = 8, WGM = 8;
__device__ __forceinline__ int lds_byte(int r, int c) { const int st = (r >> 4) * 2 + (c >> 5), rr = r & 15, cc = c & 31, ob = rr * 64 + cc * 2; return st * 1024 + (ob ^ (((ob >> 9) & 1) << 5)); }
__device__ __forceinline__ void stage_rc(int b, int& R, int& C) { const int st = b / 1024, sb = b % 1024, swz = sb ^ (((sb >> 9) & 1) << 5); R = (st >> 1) * 16 + swz / 64; C = (st & 1) * 32 + (swz % 64) / 2; }
__device__ __forceinline__ int perm32(int rho) { const int n = rho >> 4, i = rho & 15; return 8 * (i >> 2) + 4 * n + (i & 3); }

struct Unit { unsigned aoff, boff; int pm, pn, flags, aux, aux2; };
typedef f32x4 Acc[2][2][4][2];

struct StaticOrder {
    int nM, nN, nwg, G, c;
    __device__ void init(int M, int N, int G_, int c_) { nM = M / BM; nN = N / BM; nwg = nM * nN; G = G_; c = c_; }
    __device__ __forceinline__ bool tile(int i, int& pm, int& pn) const {
        const long L = (long)i * G + c; if (L >= nwg) return false;
        int wgid = (int)L; { const int q = nwg / NXCD, r = nwg % NXCD, xcd = wgid % NXCD, off = wgid / NXCD; wgid = (xcd < r ? xcd * (q + 1) : r * (q + 1) + (xcd - r) * q) + off; }
        const int nig = WGM * nN, gid = wgid / nig, fm = gid * WGM, gsz = (nM - fm) < WGM ? (nM - fm) : WGM;
        pm = fm + ((wgid % nig) % gsz); pn = (wgid % nig) / gsz; return true;
    }
};

typedef long l64x2 __attribute__((ext_vector_type(2)));
typedef int i32x4 __attribute__((ext_vector_type(4)));
typedef int i32x8 __attribute__((ext_vector_type(8)));
template <class Epi, class Sched, bool SKIP = false, int FP8 = 0>
__device__ __forceinline__ void gemm_phase(LAS unsigned char* lds, const unsigned char* ws, const int nt, const int ldb  , const Sched& S, const Epi& E) {
    const int tid = threadIdx.x, wid = __builtin_amdgcn_readfirstlane(tid >> 6), lane = tid & 63, wr = wid >> 2, wc = wid & 3, fr = lane & 15, fq = lane >> 4;
    int R0, C0, R1, C1; stage_rc(tid * 16, R0, C0); stage_rc(tid * 16 + 8192, R1, C1);
    unsigned voffB[2];
    { const int Rb0 = Epi::PERM ? ((R0 & ~31) + perm32(R0 & 31)) : R0, Rb1 = Epi::PERM ? ((R1 & ~31) + perm32(R1 & 31)) : R1;
      voffB[0] = (unsigned)(Rb0 * 64 + C0) * 2u; voffB[1] = (unsigned)(Rb1 * 64 + C1) * 2u; }
    const unsigned kstep = (unsigned)(BK * 2);
    const unsigned kstepB = 256u * 64u * 2u;
    const unsigned hstepB = (unsigned)HALF * 64u * 2u;
    const unsigned ldsw = (unsigned)wid * 1024u;
    const int aoff = lds_byte(wr * 64 + fr, fq * 8), boff = lds_byte(wc * 32 + fr, fq * 8);
#define G8_SA(b, h) (((b) * 2 + (h)) * HTB)
#define G8_SB(b, h) ((4 + (b) * 2 + (h)) * HTB)
#define G8_STAGE(bufoff, gbase, v0, v1) do { \
        __builtin_amdgcn_global_load_lds((const unsigned*)((gbase) + (v0)), (LAS unsigned*)(lds + (bufoff) + ldsw), 16, 0, 0); \
        __builtin_amdgcn_global_load_lds((const unsigned*)((gbase) + (v1)), (LAS unsigned*)(lds + (bufoff) + ldsw + 8192), 16, 0, 0); } while (0)
#define G8_LDA(dst, b, h) do { _Pragma("unroll") for (int m = 0; m < 4; ++m) _Pragma("unroll") for (int k = 0; k < 2; ++k) dst[m][k] = *(const LAS bf16x8*)(lds + G8_SA(b, h) + aoff + m * 2048 + k * 1024); } while (0)
#define G8_LDB(dst, b, h) do { _Pragma("unroll") for (int n = 0; n < 2; ++n) _Pragma("unroll") for (int k = 0; k < 2; ++k) dst[n][k] = *(const LAS bf16x8*)(lds + G8_SB(b, h) + boff + n * 2048 + k * 1024); } while (0)
#define G8_MMA(ai, bj, At, Bt) do { __builtin_amdgcn_s_setprio(1); \
        if constexpr (FP8 == 2) { _Pragma("unroll") for (int m = 0; m < 4; ++m) _Pragma("unroll") for (int n = 0; n < 2; ++n) { \
            const i32x8 a8 = __builtin_shufflevector(__builtin_bit_cast(i32x4, At[m][0]), __builtin_bit_cast(i32x4, At[m][1]), 0, 1, 2, 3, 4, 5, 6, 7); \
            const i32x8 b8 = __builtin_shufflevector(__builtin_bit_cast(i32x4, Bt[n][0]), __builtin_bit_cast(i32x4, Bt[n][1]), 0, 1, 2, 3, 4, 5, 6, 7); \
            acc[ai][bj][m][n] = __builtin_amdgcn_mfma_scale_f32_16x16x128_f8f6f4(b8, a8, acc[ai][bj][m][n], 0, 0, 0, 0x7F7F7F7F, 0, 0x7F7F7F7F); } } \
        else { _Pragma("unroll") for (int m = 0; m < 4; ++m) _Pragma("unroll") for (int n = 0; n < 2; ++n) _Pragma("unroll") for (int k = 0; k < 2; ++k) { \
        if constexpr (FP8 == 1) { const l64x2 a2 = __builtin_bit_cast(l64x2, At[m][k]), b2 = __builtin_bit_cast(l64x2, Bt[n][k]); \
            acc[ai][bj][m][n] = __builtin_amdgcn_mfma_f32_16x16x32_fp8_fp8(b2[0], a2[0], acc[ai][bj][m][n], 0, 0, 0); \
            acc[ai][bj][m][n] = __builtin_amdgcn_mfma_f32_16x16x32_fp8_fp8(b2[1], a2[1], acc[ai][bj][m][n], 0, 0, 0); } \
        else acc[ai][bj][m][n] = __builtin_amdgcn_mfma_f32_16x16x32_bf16(Bt[n][k], At[m][k], acc[ai][bj][m][n], 0, 0, 0); } } __builtin_amdgcn_s_setprio(0); } while (0)
#define G8_WAIT_V(n) asm volatile("s_waitcnt vmcnt(" #n ")" ::: "memory")
#define G8_WAIT_L(n) asm volatile("s_waitcnt lgkmcnt(" #n ")" ::: "memory")
#define G8_BAR __builtin_amdgcn_s_barrier()
#define G8_SCHED __builtin_amdgcn_sched_barrier(0)
    Unit cur, nxt; int ui = 0;
    if (!S.next(0, cur)) return;
    Acc acc;
#pragma unroll
    for (int a = 0; a < 2; ++a)
#pragma unroll
        for (int b = 0; b < 2; ++b)
#pragma unroll
            for (int m = 0; m < 4; ++m)
#pragma unroll
                for (int n = 0; n < 2; ++n) acc[a][b][m][n] = (f32x4){0.f, 0.f, 0.f, 0.f};
    bf16x8 At[4][2], B0[2][2], B1[2][2];
    unsigned cv[2][2], nv[2][2];
    S.aoffs(cur, R0, C0, R1, C1, cv);
    const unsigned char* cA = ws + cur.aoff; const unsigned char* cB = ws + cur.boff;
    G8_STAGE(G8_SB(0, 0), cB, voffB[0], voffB[1]); G8_STAGE(G8_SA(0, 0), cA, cv[0][0], cv[0][1]);
    G8_STAGE(G8_SB(0, 1), cB + hstepB, voffB[0], voffB[1]); G8_STAGE(G8_SA(0, 1), cA, cv[1][0], cv[1][1]);
    if (wr == 1) G8_BAR;
    G8_WAIT_V(4); G8_BAR;
    G8_STAGE(G8_SB(1, 0), cB + kstepB, voffB[0], voffB[1]); G8_STAGE(G8_SA(1, 0), cA + kstep, cv[0][0], cv[0][1]);
    G8_STAGE(G8_SB(1, 1), cB + hstepB + kstepB, voffB[0], voffB[1]);
    G8_WAIT_V(6); G8_BAR;
    for (;;) {
        const bool has_next = S.next(ui + 1, nxt);
        if (has_next) S.aoffs(nxt, R0, C0, R1, C1, nv);
        else { nv[0][0] = cv[0][0]; nv[0][1] = cv[0][1]; nv[1][0] = cv[1][0]; nv[1][1] = cv[1][1]; }
        const unsigned char* nA = has_next ? ws + nxt.aoff : cA; const unsigned char* nB = has_next ? ws + nxt.boff : cB;
        const int vrows = SKIP ? cur.aux2 : 256;
        const bool do0 = !SKIP || vrows > 64 || wr == 0, do1 = !SKIP || vrows > 128;
        for (int t = 0; t < nt; t += 2) {
            const bool last = (t == nt - 2);
            const unsigned char* a1 = cA + (size_t)(t + 1) * kstep;
            const unsigned char* a2 = last ? nA : cA + (size_t)(t + 2) * kstep; const unsigned char* b2 = last ? nB : cB + (size_t)(t + 2) * kstepB;
            const unsigned char* a3 = a2 + kstep; const unsigned char* b3 = b2 + kstepB;
            const unsigned o00 = last ? nv[0][0] : cv[0][0], o01 = last ? nv[0][1] : cv[0][1], o10 = last ? nv[1][0] : cv[1][0], o11 = last ? nv[1][1] : cv[1][1];
            G8_LDB(B0, 0, 0); G8_SCHED; G8_LDA(At, 0, 0); G8_STAGE(G8_SA(1, 1), a1, cv[1][0], cv[1][1]);
            G8_WAIT_L(8); G8_BAR; G8_WAIT_L(0); if (do0) G8_MMA(0, 0, At, B0); G8_BAR; G8_SCHED;
            G8_LDB(B1, 0, 1); G8_STAGE(G8_SB(0, 0), b2, voffB[0], voffB[1]);
            G8_BAR; G8_WAIT_L(0); if (do0) G8_MMA(0, 1, At, B1); G8_BAR;
            G8_LDA(At, 0, 1); G8_STAGE(G8_SA(0, 0), a2, o00, o01);
            G8_BAR; G8_WAIT_L(0); if (do1) G8_MMA(1, 0, At, B0); G8_BAR; G8_SCHED;
            G8_STAGE(G8_SB(0, 1), b2 + hstepB, voffB[0], voffB[1]);
            G8_WAIT_V(6); G8_BAR; if (do1) G8_MMA(1, 1, At, B1); G8_BAR;
            G8_LDB(B0, 1, 0); G8_SCHED; G8_LDA(At, 1, 0); G8_STAGE(G8_SA(0, 1), a2, o10, o11);
            G8_WAIT_L(8); G8_BAR; G8_WAIT_L(0); if (do0) G8_MMA(0, 0, At, B0); G8_BAR; G8_SCHED;
            G8_LDB(B1, 1, 1); G8_STAGE(G8_SB(1, 0), b3, voffB[0], voffB[1]);
            G8_BAR; G8_WAIT_L(0); if (do0) G8_MMA(0, 1, At, B1); G8_BAR;
            G8_LDA(At, 1, 1); G8_STAGE(G8_SA(1, 0), a3, o00, o01);
            G8_BAR; G8_WAIT_L(0); if (do1) G8_MMA(1, 0, At, B0); G8_BAR; G8_SCHED;
            G8_STAGE(G8_SB(1, 1), b3 + hstepB, voffB[0], voffB[1]);
            G8_WAIT_V(6); G8_BAR; if (do1) G8_MMA(1, 1, At, B1); G8_BAR;
        }
        E(acc, cur, wr, wc, fr, fq);
        if (!has_next) break;
        if (!(cur.flags & 1)) {
#pragma unroll
            for (int a = 0; a < 2; ++a)
#pragma unroll
                for (int b = 0; b < 2; ++b)
#pragma unroll
                    for (int m = 0; m < 4; ++m)
#pragma unroll
                        for (int n = 0; n < 2; ++n) acc[a][b][m][n] = (f32x4){0.f, 0.f, 0.f, 0.f};
        }
        cur = nxt; cA = nA; cB = nB; ++ui;
        cv[0][0] = nv[0][0]; cv[0][1] = nv[0][1]; cv[1][0] = nv[1][0]; cv[1][1] = nv[1][1];
    }
    G8_WAIT_V(0);
    if (wr == 0) G8_BAR;
    G8_BAR;
#undef G8_SA
#undef G8_SB
#undef G8_STAGE
#undef G8_LDA
#undef G8_LDB
#undef G8_MMA
#undef G8_WAIT_V
#undef G8_WAIT_L
#undef G8_BAR
#undef G8_SCHED
}
}

__device__ __forceinline__ void p0_adaln(const Params& P, LAS unsigned char* lds, int tid, int item) {
    const int ks = item & 3, nc = item >> 2;
    LAS float* sc = (LAS float*)lds;
    LAS float* red = (LAS float*)(lds + 16384);
    const float* c = P.in[1];
    for (int i = tid; i < 4096; i += NTHREADS) { const int kl = i >> 3, b = i & 7; const float v = c[b * 2048 + ks * 512 + kl]; sc[i] = v / (1.0f + expf(-v)); }
    __syncthreads();
    if (tid < 384) {
        const int nq = tid % 48, kg = tid / 48;
        const float* W = P.in[2] + (size_t)(ks * 512 + kg * 64) * NMOD + nc * 192 + nq * 4;
        f32x4 acc[8];
#pragma unroll
        for (int b = 0; b < 8; ++b) acc[b] = (f32x4){0.f, 0.f, 0.f, 0.f};
#pragma unroll 16
        for (int kk = 0; kk < 64; ++kk) {
            const f32x4 w = *(const f32x4*)(W + (size_t)kk * NMOD);
            const f32x4 s0 = *(const LAS f32x4*)(sc + (kg * 64 + kk) * 8), s1 = *(const LAS f32x4*)(sc + (kg * 64 + kk) * 8 + 4);
            acc[0] += w * s0[0]; acc[1] += w * s0[1]; acc[2] += w * s0[2]; acc[3] += w * s0[3];
            acc[4] += w * s1[0]; acc[5] += w * s1[1]; acc[6] += w * s1[2]; acc[7] += w * s1[3];
        }
#pragma unroll
        for (int b = 0; b < 8; ++b) *(LAS f32x4*)(red + (kg * 8 + b) * 192 + nq * 4) = acc[b];
    }
    __syncthreads();
    float* modp = (float*)(P.ws + WS_MODP);
    for (int i = tid; i < 8 * 192; i += NTHREADS) {
        const int b = i / 192, n = i % 192; float s = 0.f;
#pragma unroll
        for (int kg = 0; kg < 8; ++kg) s += red[(kg * 8 + b) * 192 + n];
        modp[(size_t)(ks * 8 + b) * NMOD + nc * 192 + n] = s;
    }
    __syncthreads();
}

struct CvtUnit { const float* src; bf16_t* dst; int Nd, Kd, k0, n0, nmode; const float* s0; const float* s1; };
constexpr int CVT_UNITS = 640 + 256 + 64;
__device__ __forceinline__ void cvt_unit_decode(const Params& P, int L, CvtUnit& u) {
    u.s0 = nullptr; u.s1 = nullptr; u.nmode = 0;
    if (L < 640) { u.src = P.in[5]; u.dst = (bf16_t*)(P.ws + WS_WIN); u.Kd = 2048; u.Nd = 5120; u.k0 = (L / 20) * 64; u.n0 = (L % 20) * 256; u.nmode = 3; return; }
    L -= 640;
    if (L < 256) { u.src = P.in[17]; u.dst = (bf16_t*)(P.ws + WS_WOUT); u.Kd = 2048; u.Nd = 2048; u.k0 = (L / 8) * 64; u.n0 = (L % 8) * 256; u.s0 = P.in[15]; u.s1 = P.in[16]; return; }
    L -= 256;
    if (L < 64) { u.src = P.in[14]; u.dst = (bf16_t*)(P.ws + WS_WGLU); u.Kd = 1024; u.Nd = 1024; u.k0 = (L / 4) * 64; u.n0 = (L % 4) * 256; return; }
    L -= 64;
    if (L < 4096) { const int e = L >> 7, r = L & 127; u.src = P.in[23] + (size_t)e * 2048 * 1024; u.dst = (bf16_t*)(P.ws + WS_WGU) + (size_t)e * 2048 * 2048; u.Kd = 2048; u.Nd = 1024; u.k0 = (r >> 2) * 64; u.n0 = (r & 3) * 256; u.nmode = 1; return; }
    L -= 4096;
    if (L < 4096) { const int e = L >> 7, r = L & 127; u.src = P.in[24] + (size_t)e * 2048 * 1024; u.dst = (bf16_t*)(P.ws + WS_WGU) + (size_t)e * 2048 * 2048; u.Kd = 2048; u.Nd = 1024; u.k0 = (r >> 2) * 64; u.n0 = (r & 3) * 256; u.nmode = 2; return; }
    L -= 4096;
    { const int e = L >> 7, r = L & 127; u.src = P.in[25] + (size_t)e * 1024 * 2048; u.dst = (bf16_t*)(P.ws + WS_WD) + (size_t)e * 2048 * 1024; u.Kd = 1024; u.Nd = 2048; u.k0 = (r >> 3) * 64; u.n0 = (r & 7) * 256; }
}
__device__ __forceinline__ void cvt_load(const CvtUnit& u, int tid, f32x4 (&r)[8]) {
    const int kp = tid >> 4, nq = tid & 15;
    const float* p = u.src + (size_t)(u.k0 + 2 * kp) * u.Nd + u.n0 + nq * 4;
#pragma unroll
    for (int s = 0; s < 4; ++s) { r[2 * s] = *(const f32x4*)(p + s * 64); r[2 * s + 1] = *(const f32x4*)(p + u.Nd + s * 64); }
    if (u.s0) {
        const int k = u.k0 + 2 * kp;
        const float a = (k < 1024) ? u.s0[k] : u.s1[k - 1024], b = (k + 1 < 1024) ? u.s0[k + 1] : u.s1[k + 1 - 1024];
#pragma unroll
        for (int s = 0; s < 4; ++s) { r[2 * s] *= a; r[2 * s + 1] *= b; }
    }
}
__device__ __forceinline__ void cvt_to_lds(LAS unsigned* tile, const f32x4 (&r)[8], int kp, int nq) {
#pragma unroll
    for (int s = 0; s < 4; ++s)
#pragma unroll
        for (int j = 0; j < 4; ++j) tile[s * 2112 + (nq * 4 + j) * 33 + kp] = cvt_pk_bf16(r[2 * s][j], r[2 * s + 1][j]);
}
__device__ __forceinline__ void cvt_store(const LAS unsigned* tile, const CvtUnit& u, int nl, int kq) {
#pragma unroll
    for (int s = 0; s < 4; ++s) {
        u32x4 w; w.x = tile[s * 2112 + nl * 33 + kq * 4]; w.y = tile[s * 2112 + nl * 33 + kq * 4 + 1]; w.z = tile[s * 2112 + nl * 33 + kq * 4 + 2]; w.w = tile[s * 2112 + nl * 33 + kq * 4 + 3];
        const int n = u.n0 + s * 64 + nl;
        int np = n;
        if (u.nmode == 1 || u.nmode == 2) np = (n >> 7) * 256 + (n & 127) + (u.nmode == 2 ? 128 : 0);
        else if (u.nmode == 3 && n >= 1024 && n < 3072) { const int reg = (n >= 2048) ? 2048 : 1024, nr = n - reg;
            np = reg + ((nr >> 8) << 8) + (((nr >> 6) & 1) << 7) + (((nr >> 7) & 1) << 6) + (nr & 63); }
        *(u32x4*)(u.dst + (size_t)(np >> 8) * ((size_t)u.Kd * 256) + (size_t)(u.k0 >> 6) * 16384 + (np & 255) * 64 + kq * 8) = w;
    }
}
__device__ __forceinline__ void p0_convert(const Params& P, LAS unsigned char* lds, int tid, int blk, int G) {
    LAS unsigned* tileA = (LAS unsigned*)lds;
    LAS unsigned* tileB = tileA + 4 * 2112;
    const int kp = tid >> 4, nq = tid & 15, nl = tid >> 3, kq = tid & 7;
    CvtUnit uA, uB, nA, nB; f32x4 rA[8], rB[8];
    int L = blk;
    if (L >= CVT_UNITS) return;
    bool hasB = (L + G) < CVT_UNITS;
    cvt_unit_decode(P, L, uA); cvt_load(uA, tid, rA);
    if (hasB) { cvt_unit_decode(P, L + G, uB); cvt_load(uB, tid, rB); }
    for (;;) {
        cvt_to_lds(tileA, rA, kp, nq);
        if (hasB) cvt_to_lds(tileB, rB, kp, nq);
        __syncthreads();
        const int Ln = L + 2 * G; const bool moreA = Ln < CVT_UNITS, moreB = (Ln + G) < CVT_UNITS;
        if (moreA) { cvt_unit_decode(P, Ln, nA); cvt_load(nA, tid, rA); }
        if (moreB) { cvt_unit_decode(P, Ln + G, nB); cvt_load(nB, tid, rB); }
        cvt_store(tileA, uA, nl, kq);
        if (hasB) cvt_store(tileB, uB, nl, kq);
        __syncthreads();
        if (!moreA) break;
        uA = nA; uB = nB; hasB = moreB; L = Ln;
    }
}

struct Cvt8Unit { const float* src; unsigned char* dst; int Nd, Kd, k0, n0, nmode; float scale; };
constexpr float WGU_SCALE = 64.0f, WD_SCALE = 32.0f;
__device__ __forceinline__ void cvt8_decode(const Params& P, int L, Cvt8Unit& u) {
    if (L < 8192) { const int up = L >= 4096; const int r_ = L & 4095; const int e = r_ >> 7, r = r_ & 127;
        u.src = P.in[up ? 24 : 23] + (size_t)e * 2048 * 1024; u.dst = P.ws + WS_WGU + (size_t)e * 2048 * 2048; u.Kd = 2048; u.Nd = 1024; u.k0 = (r >> 3) * 128; u.n0 = (r & 7) * 128; u.nmode = up ? 2 : 1; u.scale = WGU_SCALE; return; }
    L -= 8192;
    { const int e = L >> 7, r = L & 127; u.src = P.in[25] + (size_t)e * 1024 * 2048; u.dst = P.ws + WS_WD + (size_t)e * 2048 * 1024; u.Kd = 1024; u.Nd = 2048; u.k0 = (r >> 4) * 128; u.n0 = (r & 15) * 128; u.nmode = 0; u.scale = WD_SCALE; }
}
__device__ __forceinline__ void cvt8_load(const Cvt8Unit& u, int tid, f32x4 (&r)[8]) {
    const int kg = tid >> 5, nq = tid & 31;
    const float* p = u.src + (size_t)(u.k0 + 8 * kg) * u.Nd + u.n0 + nq * 4;
#pragma unroll
    for (int kk = 0; kk < 8; ++kk) r[kk] = __builtin_nontemporal_load((const f32x4*)(p + (size_t)kk * u.Nd));
}
__device__ __forceinline__ void cvt8_to_lds(LAS unsigned* tile, const f32x4 (&r)[8], float sc, int tid) {
    const int kg = tid >> 5, nq = tid & 31;
    u32x4 w0, w1;
#pragma unroll
    for (int j = 0; j < 4; ++j) {
        int a = 0, b = 0;
        a = __builtin_amdgcn_cvt_pk_fp8_f32(r[0][j] * sc, r[1][j] * sc, a, false); a = __builtin_amdgcn_cvt_pk_fp8_f32(r[2][j] * sc, r[3][j] * sc, a, true);
        b = __builtin_amdgcn_cvt_pk_fp8_f32(r[4][j] * sc, r[5][j] * sc, b, false); b = __builtin_amdgcn_cvt_pk_fp8_f32(r[6][j] * sc, r[7][j] * sc, b, true);
        w0[j] = (unsigned)a; w1[j] = (unsigned)b;
    }
    *(LAS u32x4*)(tile + (2 * kg) * 132 + nq * 4) = w0;
    *(LAS u32x4*)(tile + (2 * kg + 1) * 132 + nq * 4) = w1;
}
__device__ __forceinline__ void cvt8_store(const LAS unsigned* tile, const Cvt8Unit& u, int tid) {
    const int nl = tid >> 2, q = tid & 3;
    u32x4 w0, w1;
    w0.x = tile[(8 * q + 0) * 132 + nl]; w0.y = tile[(8 * q + 1) * 132 + nl]; w0.z = tile[(8 * q + 2) * 132 + nl]; w0.w = tile[(8 * q + 3) * 132 + nl];
    w1.x = tile[(8 * q + 4) * 132 + nl]; w1.y = tile[(8 * q + 5) * 132 + nl]; w1.z = tile[(8 * q + 6) * 132 + nl]; w1.w = tile[(8 * q + 7) * 132 + nl];
    const int n = u.n0 + nl;
    int np = n;
    if (u.nmode == 1 || u.nmode == 2) np = (n >> 7) * 256 + (n & 127) + (u.nmode == 2 ? 128 : 0);
    unsigned char* d = u.dst + (size_t)(np >> 8) * ((size_t)u.Kd * 256) + (size_t)(u.k0 >> 7) * 32768 + (np & 255) * 128 + q * 32;
    *(u32x4*)d = w0; *(u32x4*)(d + 16) = w1;
}
__device__ __forceinline__ void p0_convert_fp8(const Params& P, LAS unsigned char* lds, int tid, int blk, int G, const int Lbeg, const int Lend) {
    LAS unsigned* tileA = (LAS unsigned*)lds;
    LAS unsigned* tileB = tileA + 32 * 132;
    Cvt8Unit uA, uB, nA, nB; f32x4 rA[8], rB[8];
    int L = Lbeg + blk;
    if (L >= Lend) return;
    bool hasB = (L + G) < Lend;
    cvt8_decode(P, L, uA); cvt8_load(uA, tid, rA);
    if (hasB) { cvt8_decode(P, L + G, uB); cvt8_load(uB, tid, rB); }
    for (;;) {
        cvt8_to_lds(tileA, rA, uA.scale, tid);
        if (hasB) cvt8_to_lds(tileB, rB, uB.scale, tid);
        __syncthreads();
        const int Ln = L + 2 * G; const bool moreA = Ln < Lend, moreB = (Ln + G) < Lend;
        if (moreA) { cvt8_decode(P, Ln, nA); cvt8_load(nA, tid, rA); }
        if (moreB) { cvt8_decode(P, Ln + G, nB); cvt8_load(nB, tid, rB); }
        cvt8_store(tileA, uA, tid);
        if (hasB) cvt8_store(tileB, uB, tid);
        __syncthreads();
        if (!moreA) break;
        uA = nA; uB = nB; hasB = moreB; L = Ln;
    }
}

__device__ __forceinline__ void p0_ssm_mats(const Params& P, LAS unsigned char* lds, int tid, int item) {
    const int g = item & 63, q = item >> 6;
    LAS f32x2* pw = (LAS f32x2*)lds;
    LAS f32x2* Bb = pw + 17 * 64;
    LAS f32x2* Cc = Bb + 64 * 16;
    LAS float* Kt = (LAS float*)(Cc + 16 * 64);
    if (tid < 64) {
        const int p = tid;
        const float dt = expf(P.in[13][g]);
        const float are = P.in[6][g * 64 + p], aim = P.in[7][g * 64 + p];
        const float mag = expf(dt * are);
        double sd, cd; sincos_d((double)(dt * aim), sd, cd);
        const float abr = mag * (float)cd, abi = mag * (float)sd;
        const float inv = 1.0f / (are * are + aim * aim);
        const float nre = abr - 1.0f;
        const float fre = (nre * are + abi * aim) * inv, fim = (abi * are - nre * aim) * inv;
        float pr = 1.0f, pi = 0.0f;
        for (int n = 0; n <= 16; ++n) { pw[n * 64 + p] = (f32x2){pr, pi}; const float t = pr * abr - pi * abi; pi = pr * abi + pi * abr; pr = t; }
        for (int h = 0; h < 16; ++h) {
            const float br = P.in[8][(g * 64 + p) * 16 + h], bi = P.in[9][(g * 64 + p) * 16 + h];
            Bb[p * 16 + h] = (f32x2){fre * br - fim * bi, fre * bi + fim * br};
            Cc[h * 64 + p] = (f32x2){P.in[10][(g * 16 + h) * 64 + p], P.in[11][(g * 16 + h) * 64 + p]};
        }
        if (q == 0) { f32x2* AL = (f32x2*)(P.ws + WS_SSMA); const f32x2 v = pw[16 * 64 + p]; AL[g * 64 + p] = v; }
    }
    __syncthreads();
    for (int o = tid; o < 4096; o += NTHREADS) {
        const int tau = o >> 8, ho = (o >> 4) & 15, hi = o & 15; float s = 0.f;
        for (int p = 0; p < 64; ++p) {
            const f32x2 c = Cc[ho * 64 + p], a = pw[tau * 64 + p], b = Bb[p * 16 + hi];
            const float cr = c.x * a.x - c.y * a.y, ci = c.x * a.y + c.y * a.x;
            s += cr * b.x - ci * b.y;
        }
        Kt[o] = s;
    }
    __syncthreads();
    bf16_t* Ms = (bf16_t*)(P.ws + WS_SSMM) + (size_t)g * 131072;
    bf16_t* TM = Ms + 32768;
    for (int o = tid; o < 32 * 128; o += NTHREADS) {
        const int row = 32 * q + (o >> 7), col = (o & 127) * 2;
        const int p = row >> 1, j = col >> 4, hi = col & 15;
        const f32x2 a = pw[(15 - j) * 64 + p], b0 = Bb[p * 16 + hi], b1 = Bb[p * 16 + hi + 1];
        float v0, v1;
        if ((row & 1) == 0) { v0 = a.x * b0.x - a.y * b0.y; v1 = a.x * b1.x - a.y * b1.y; } else { v0 = a.x * b0.y + a.y * b0.x; v1 = a.x * b1.y + a.y * b1.x; }
        *(unsigned*)(Ms + (size_t)row * 256 + col) = cvt_pk_bf16(v0, v1);
    }
    for (int o = tid; o < 64 * 192; o += NTHREADS) {
        const int row = 64 * q + o / 192, col = (o % 192) * 2;
        const int i = row >> 4, ho = row & 15; float v0, v1;
        if (col < 256) { const int j = col >> 4, hi = col & 15; if (j <= i) { v0 = Kt[((i - j) * 16 + ho) * 16 + hi]; v1 = Kt[((i - j) * 16 + ho) * 16 + hi + 1]; } else { v0 = 0.f; v1 = 0.f; } }
        else { const int p0 = (col - 256) >> 1;
            const f32x2 c0 = Cc[ho * 64 + p0], a0 = pw[(i + 1) * 64 + p0];
            v0 = c0.x * a0.x - c0.y * a0.y; v1 = -(c0.x * a0.y + c0.y * a0.x); }
        *(unsigned*)(TM + (size_t)row * 384 + col) = cvt_pk_bf16(v0, v1);
    }
    __syncthreads();
}

__device__ __forceinline__ void p0_misc(const Params& P, int tid, int blk, int G) {
    bf16_t* wr = (bf16_t*)(P.ws + WS_WR);
    for (int i = blk * NTHREADS + tid; i < 48 * 2048; i += G * NTHREADS) {
        const int n = i >> 11, k = i & 2047; float v = 0.f;
        if (n < 4) v = P.in[19][k * 4 + n]; else if (n < 36) v = P.in[21][k * 32 + (n - 4)];
        wr[i] = (bf16_t)(cvt_pk_bf16(v, 0.f) & 0xffffu);
    }
    if (blk == 0) for (int i = tid; i < 2048; i += NTHREADS) ((int*)(P.ws + WS_CNT))[i] = 0;
}

__device__ __forceinline__ void p1_norm1(const Params& P, LAS unsigned char* lds, int tid, int blk, int G) {
    const float* modp = (const float*)(P.ws + WS_MODP); const float* bada = P.in[3];
    float* mod = (float*)(P.ws + WS_MOD);
    for (int i = blk * NTHREADS + tid; i < 8 * NMOD; i += G * NTHREADS) {
        const int b = i / NMOD, j = i % NMOD;
        mod[i] = bada[j] + ((modp[(size_t)(0 * 8 + b) * NMOD + j] + modp[(size_t)(1 * 8 + b) * NMOD + j]) + (modp[(size_t)(2 * 8 + b) * NMOD + j] + modp[(size_t)(3 * 8 + b) * NMOD + j]));
    }
    LAS float* gm = (LAS float*)lds; LAS float* sh = gm + 2048;
    const int wave = tid >> 6, lane = tid & 63;
    bf16_t* H = (bf16_t*)(P.ws + WS_H);
    for (int rb = blk; rb < 256; rb += G) {
        const int b = rb >> 5;
        for (int k = tid; k < 2048; k += NTHREADS) {
            const int js = 2048 + k, jh = k;
            const float sc = bada[js] + ((modp[(size_t)(0 * 8 + b) * NMOD + js] + modp[(size_t)(1 * 8 + b) * NMOD + js]) + (modp[(size_t)(2 * 8 + b) * NMOD + js] + modp[(size_t)(3 * 8 + b) * NMOD + js]));
            const float sv = bada[jh] + ((modp[(size_t)(0 * 8 + b) * NMOD + jh] + modp[(size_t)(1 * 8 + b) * NMOD + jh]) + (modp[(size_t)(2 * 8 + b) * NMOD + jh] + modp[(size_t)(3 * 8 + b) * NMOD + jh]));
            gm[k] = P.in[4][k] * (1.0f + sc); sh[k] = sv;
        }
        __syncthreads();
        f32x4 v[8], vn[8];
        { const float* xr = P.in[0] + (size_t)(rb * 64 + wave * 8) * DM;
#pragma unroll
          for (int i = 0; i < 8; ++i) v[i] = *(const f32x4*)(xr + (i * 64 + lane) * 4); }
        for (int rr = 0; rr < 8; ++rr) {
            const int row = rb * 64 + wave * 8 + rr;
            if (rr < 7) { const float* xn = P.in[0] + (size_t)(row + 1) * DM;
#pragma unroll
                for (int i = 0; i < 8; ++i) vn[i] = *(const f32x4*)(xn + (i * 64 + lane) * 4); }
            float ss = 0.f;
#pragma unroll
            for (int i = 0; i < 8; ++i) ss += v[i][0] * v[i][0] + v[i][1] * v[i][1] + v[i][2] * v[i][2] + v[i][3] * v[i][3];
            ss = wave_sum(ss);
            const float r = rsqrtf(ss * (1.0f / 2048.0f) + 1e-6f);
#pragma unroll
            for (int i = 0; i < 8; ++i) {
                const int k = (i * 64 + lane) * 4;
                const f32x4 g4 = *(const LAS f32x4*)(gm + k), s4 = *(const LAS f32x4*)(sh + k);
                const f32x4 o = v[i] * r * g4 + s4;
                u32x2 w; w.x = cvt_pk_bf16(o[0], o[1]); w.y = cvt_pk_bf16(o[2], o[3]);
                *(u32x2*)(H + (size_t)row * DM + k) = w;
            }
#pragma unroll
            for (int i = 0; i < 8; ++i) v[i] = vn[i];
        }
        __syncthreads();
    }
}

struct DenseSched : g8::StaticOrder {
    unsigned abase, bbase; int lda, ldb;
    __device__ __forceinline__ bool next(int i, g8::Unit& u) const {
        int pm, pn; if (!tile(i, pm, pn)) return false;
        u.pm = __builtin_amdgcn_readfirstlane(pm); u.pn = __builtin_amdgcn_readfirstlane(pn); u.flags = 0; u.aux = 0;
        u.aoff = abase + (unsigned)u.pm * 256u * (unsigned)lda * 2u; u.boff = bbase + (unsigned)u.pn * 256u * (unsigned)ldb * 2u; return true;
    }
    __device__ __forceinline__ void aoffs(const g8::Unit&, int R0, int C0, int R1, int C1, unsigned (&v)[2][2]) const {
        v[0][0] = (unsigned)(R0 * lda + C0) * 2u; v[0][1] = (unsigned)(R1 * lda + C1) * 2u;
        v[1][0] = (unsigned)((128 + R0) * lda + C0) * 2u; v[1][1] = (unsigned)((128 + R1) * lda + C1) * 2u;
    }
};
struct EpiStoreBf16 {
    static constexpr bool PERM = true;
    bf16_t* O; int ldc;
    __device__ __forceinline__ void operator()(g8::Acc& acc, const g8::Unit& u, int wr, int wc, int fr, int fq) const {
        const int row0 = u.pm * 256 + wr * 64 + fr, col0 = u.pn * 256 + wc * 32 + 8 * fq;
#pragma unroll
        for (int ai = 0; ai < 2; ++ai)
#pragma unroll
            for (int m = 0; m < 4; ++m) { bf16_t* rowp = O + (size_t)(row0 + ai * 128 + m * 16) * ldc + col0;
#pragma unroll
                for (int bj = 0; bj < 2; ++bj) { const f32x4 v0 = acc[ai][bj][m][0], v1 = acc[ai][bj][m][1];
                    u32x4 w; w.x = cvt_pk_bf16(v0[0], v0[1]); w.y = cvt_pk_bf16(v0[2], v0[3]); w.z = cvt_pk_bf16(v1[0], v1[1]); w.w = cvt_pk_bf16(v1[2], v1[3]);
                    *(u32x4*)(rowp + bj * 128) = w; } }
    }
};
struct EpiInProj {
    static constexpr bool PERM = true;
    bf16_t* O;
    __device__ __forceinline__ void operator()(g8::Acc& acc, const g8::Unit& u, int wr, int wc, int fr, int fq) const {
        const int pn = u.pn;
        const int row0 = u.pm * 256 + wr * 64 + fr;
        if (pn < 4 || pn >= 12) {
            const int col0 = pn * 256 + wc * 32 + 8 * fq;
#pragma unroll
            for (int ai = 0; ai < 2; ++ai)
#pragma unroll
                for (int m = 0; m < 4; ++m) { bf16_t* rowp = O + (size_t)(row0 + ai * 128 + m * 16) * NPROJ + col0;
#pragma unroll
                    for (int bj = 0; bj < 2; ++bj) { const f32x4 v0 = acc[ai][bj][m][0], v1 = acc[ai][bj][m][1];
                        u32x4 w; w.x = cvt_pk_bf16(v0[0], v0[1]); w.y = cvt_pk_bf16(v0[2], v0[3]); w.z = cvt_pk_bf16(v1[0], v1[1]); w.w = cvt_pk_bf16(v1[2], v1[3]);
                        *(u32x4*)(rowp + bj * 128) = w; } }
            return;
        }
        const bool isq = pn < 8;
        const int head = 2 * ((pn - 4) & 3) + (wc >> 1);
        const int dd0 = 32 * (wc & 1) + 8 * fq;
        const int colbase = (isq ? 1024 : 2048) + head * 128 + dd0;
        const float lg2 = log2f(1.0f - exp2f(-5.0f - (float)head));
        float fr_[8];
#pragma unroll
        for (int t = 0; t < 8; ++t) fr_[t] = exp2f(-(float)(dd0 + t) * 0.20762050593046014f) * 0.15915494309189535f;
#pragma unroll
        for (int ai = 0; ai < 2; ++ai)
#pragma unroll
            for (int m = 0; m < 4; ++m) {
                const int row = row0 + ai * 128 + m * 16, pos = row & 2047, i = wr * 64 + m * 16 + fr;
                const float sc = isq ? exp2f(lg2 * (float)i) : exp2f(-lg2 * (float)i) * 0.08838834764831845f;
                const float fp = (float)pos;
                float o1[8], o2[8];
#pragma unroll
                for (int t = 0; t < 8; ++t) {
                    const float rev = __builtin_amdgcn_fractf(fp * fr_[t]);
                    const float cs = __builtin_amdgcn_cosf(rev) * sc, sn = __builtin_amdgcn_sinf(rev) * sc;
                    const float a = acc[ai][0][m][t >> 2][t & 3], b = acc[ai][1][m][t >> 2][t & 3];
                    o1[t] = a * cs - b * sn; o2[t] = b * cs + a * sn;
                }
                bf16_t* rowp = O + (size_t)row * NPROJ + colbase;
                u32x4 w1, w2; w1.x = cvt_pk_bf16(o1[0], o1[1]); w1.y = cvt_pk_bf16(o1[2], o1[3]); w1.z = cvt_pk_bf16(o1[4], o1[5]); w1.w = cvt_pk_bf16(o1[6], o1[7]);
                w2.x = cvt_pk_bf16(o2[0], o2[1]); w2.y = cvt_pk_bf16(o2[2], o2[3]); w2.z = cvt_pk_bf16(o2[4], o2[5]); w2.w = cvt_pk_bf16(o2[6], o2[7]);
                *(u32x4*)rowp = w1; *(u32x4*)(rowp + 64) = w2;
            }
    }
};
struct EpiGlu {
    static constexpr bool PERM = true;
    const bf16_t* Z; bf16_t* CAT; float* rowss;
    __device__ __forceinline__ void operator()(g8::Acc& acc, const g8::Unit& u, int wr, int wc, int fr, int fq) const {
        const int row0 = u.pm * 256 + wr * 64 + fr, col0 = u.pn * 256 + wc * 32 + 8 * fq;
#pragma unroll
        for (int ai = 0; ai < 2; ++ai) {
            u32x4 zz[4][2];
#pragma unroll
            for (int m = 0; m < 4; ++m)
#pragma unroll
                for (int bj = 0; bj < 2; ++bj) zz[m][bj] = *(const u32x4*)(Z + (size_t)(row0 + ai * 128 + m * 16) * 1024 + col0 + bj * 128);
#pragma unroll
            for (int m = 0; m < 4; ++m) { const int row = row0 + ai * 128 + m * 16; float ss = 0.f;
#pragma unroll
                for (int bj = 0; bj < 2; ++bj) { const f32x4 v0 = acc[ai][bj][m][0], v1 = acc[ai][bj][m][1];
                    const u32x4 z4 = zz[m][bj];
                    float o[8];
                    o[0] = bf_lo(z4.x) * sigmoidf_(v0[0]); o[1] = bf_hi(z4.x) * sigmoidf_(v0[1]); o[2] = bf_lo(z4.y) * sigmoidf_(v0[2]); o[3] = bf_hi(z4.y) * sigmoidf_(v0[3]);
                    o[4] = bf_lo(z4.z) * sigmoidf_(v1[0]); o[5] = bf_hi(z4.z) * sigmoidf_(v1[1]); o[6] = bf_lo(z4.w) * sigmoidf_(v1[2]); o[7] = bf_hi(z4.w) * sigmoidf_(v1[3]);
#pragma unroll
                    for (int j = 0; j < 8; ++j) ss += o[j] * o[j];
                    u32x4 w; w.x = cvt_pk_bf16(o[0], o[1]); w.y = cvt_pk_bf16(o[2], o[3]); w.z = cvt_pk_bf16(o[4], o[5]); w.w = cvt_pk_bf16(o[6], o[7]);
                    *(u32x4*)(CAT + (size_t)row * DM + col0 + bj * 128) = w; }
                ss += __shfl_xor(ss, 16); ss += __shfl_xor(ss, 32);
                if (fq == 0) rowss[(size_t)row * 16 + u.pn * 4 + wc] = ss; }
        }
    }
};
struct OutSched : g8::StaticOrder {
    unsigned abase, bbase;
    __device__ __forceinline__ bool next(int i, g8::Unit& u) const {
        int pm, pn; if (!tile(i >> 1, pm, pn)) return false;
        const int half = i & 1;
        u.pm = __builtin_amdgcn_readfirstlane(pm); u.pn = __builtin_amdgcn_readfirstlane(pn); u.flags = half ? 0 : 1; u.aux = half;
        u.aoff = abase + (unsigned)u.pm * 256u * 4096u + (unsigned)half * 2048u; u.boff = bbase + (unsigned)u.pn * 256u * 4096u + (unsigned)half * (16u * 32768u); return true;
    }
    __device__ __forceinline__ void aoffs(const g8::Unit&, int R0, int C0, int R1, int C1, unsigned (&v)[2][2]) const {
        v[0][0] = (unsigned)(R0 * 2048 + C0) * 2u; v[0][1] = (unsigned)(R1 * 2048 + C1) * 2u;
        v[1][0] = (unsigned)((128 + R0) * 2048 + C0) * 2u; v[1][1] = (unsigned)((128 + R1) * 2048 + C1) * 2u;
    }
};
struct EpiOut {
    static constexpr bool PERM = true;
    const float* x; const float* mod; const float* rowss1; float* rowss2; bf16_t* X1;
    __device__ __forceinline__ void operator()(g8::Acc& acc, const g8::Unit& u, int wr, int wc, int fr, int fq) const {
        const int row0 = u.pm * 256 + wr * 64 + fr;
        if (u.aux == 0) {
#pragma unroll
            for (int ai = 0; ai < 2; ++ai)
#pragma unroll
                for (int m = 0; m < 4; ++m) { const f32x4* pp = (const f32x4*)(rowss1 + (size_t)(row0 + ai * 128 + m * 16) * 16);
                    const f32x4 p0 = pp[0], p1 = pp[1], p2 = pp[2], p3 = pp[3];
                    const float tot = (((p0[0] + p0[1]) + (p0[2] + p0[3])) + ((p1[0] + p1[1]) + (p1[2] + p1[3]))) + (((p2[0] + p2[1]) + (p2[2] + p2[3])) + ((p3[0] + p3[1]) + (p3[2] + p3[3])));
                    const float r = rsqrtf(tot * (1.0f / 1024.0f) + 1e-6f);
#pragma unroll
                    for (int bj = 0; bj < 2; ++bj)
#pragma unroll
                        for (int n = 0; n < 2; ++n) acc[ai][bj][m][n] *= r; }
            return;
        }
        const int col0 = u.pn * 256 + wc * 32 + 8 * fq;
        const int b = (u.pm * 256) >> 11;
        f32x4 gt[2][2];
#pragma unroll
        for (int bj = 0; bj < 2; ++bj)
#pragma unroll
            for (int n = 0; n < 2; ++n) gt[bj][n] = *(const f32x4*)(mod + (size_t)b * NMOD + 2 * DM + col0 + bj * 128 + n * 4);
#pragma unroll
        for (int am = 0; am < 4; ++am) {
            const int ai = am >> 1, m0 = (am & 1) * 2;
            f32x4 xv[2][2][2];
#pragma unroll
            for (int mm = 0; mm < 2; ++mm)
#pragma unroll
                for (int bj = 0; bj < 2; ++bj) { const size_t off = (size_t)(row0 + ai * 128 + (m0 + mm) * 16) * DM + col0 + bj * 128; xv[mm][bj][0] = *(const f32x4*)(x + off); xv[mm][bj][1] = *(const f32x4*)(x + off + 4); }
#pragma unroll
            for (int mm = 0; mm < 2; ++mm) { const int m = m0 + mm; const int row = row0 + ai * 128 + m * 16; float ss = 0.f;
#pragma unroll
                for (int bj = 0; bj < 2; ++bj) { const size_t off = (size_t)row * DM + col0 + bj * 128;
                    const f32x4 o0 = xv[mm][bj][0] + gt[bj][0] * acc[ai][bj][m][0], o1 = xv[mm][bj][1] + gt[bj][1] * acc[ai][bj][m][1];
                    ss += (o0[0] * o0[0] + o0[1] * o0[1]) + (o0[2] * o0[2] + o0[3] * o0[3]) + (o1[0] * o1[0] + o1[1] * o1[1]) + (o1[2] * o1[2] + o1[3] * o1[3]);
                    u32x4 w; w.x = cvt_pk_bf16(o0[0], o0[1]); w.y = cvt_pk_bf16(o0[2], o0[3]); w.z = cvt_pk_bf16(o1[0], o1[1]); w.w = cvt_pk_bf16(o1[2], o1[3]);
                    *(u32x4*)(X1 + off) = w; }
                ss += __shfl_xor(ss, 16); ss += __shfl_xor(ss, 32);
                if (fq == 0) rowss2[(size_t)row * 32 + u.pn * 4 + wc] = ss; }
        }
    }
};
struct MoeSched {
    const LAS int* tinfo; const LAS int* trows; int ntiles; int G, c; const int* list; unsigned abase, bbase; int mode;
    __device__ __forceinline__ bool next(int i, g8::Unit& u) const {
        int pn, ti;
        if ((G & 63) == 0) { const int x = c & 7, r = c >> 3, per = G >> 6;
            ti = (i * 8 + x) * per + (r >> 3); pn = r & 7; }
        else { const int L = i * G + c; pn = L & 7; ti = L >> 3; }
        if (ti >= ntiles) return false;
        const int inf = __builtin_amdgcn_readfirstlane(tinfo[ti]);
        const int e = inf & 255;
        u.pm = __builtin_amdgcn_readfirstlane(ti); u.pn = pn; u.flags = 0; u.aux = inf; u.aux2 = __builtin_amdgcn_readfirstlane(trows[ti]);
        if (mode == 0) { u.aoff = abase; u.boff = bbase + (unsigned)e * (2048u * 2048u) + (unsigned)pn * (256u * 2048u); }
        else { u.aoff = abase + (unsigned)ti * (256u * 1024u); u.boff = bbase + (unsigned)e * (2048u * 1024u) + (unsigned)pn * (256u * 1024u); }
        return true;
    }
    __device__ __forceinline__ void aoffs(const g8::Unit& u, int R0, int C0, int R1, int C1, unsigned (&v)[2][2]) const {
        if (mode == 0) {
            const int e = u.aux & 255, r0 = u.aux >> 8, n = u.aux2; const int* le = list + e * 16384 + r0;
            const int i00 = R0, i01 = R1, i10 = 128 + R0, i11 = 128 + R1;
            const int t00 = (i00 < n) ? (le[i00] >> 1) : 0, t01 = (i01 < n) ? (le[i01] >> 1) : 0, t10 = (i10 < n) ? (le[i10] >> 1) : 0, t11 = (i11 < n) ? (le[i11] >> 1) : 0;
            v[0][0] = (unsigned)(t00 * 2048 + C0 * 2); v[0][1] = (unsigned)(t01 * 2048 + C1 * 2); v[1][0] = (unsigned)(t10 * 2048 + C0 * 2); v[1][1] = (unsigned)(t11 * 2048 + C1 * 2);
        } else {
            v[0][0] = (unsigned)(R0 * 1024 + C0 * 2); v[0][1] = (unsigned)(R1 * 1024 + C1 * 2);
            v[1][0] = (unsigned)((128 + R0) * 1024 + C0 * 2); v[1][1] = (unsigned)((128 + R1) * 1024 + C1 * 2);
        }
    }
};
struct EpiMoe1 {
    static constexpr bool PERM = true;
    unsigned char* HM;
    __device__ __forceinline__ void operator()(g8::Acc& acc, const g8::Unit& u, int wr, int wc, int fr, int fq) const {
        const int row0 = u.pm * 256 + wr * 64 + fr, col0 = u.pn * 128 + wc * 32 + 8 * fq;
        const float inv = 1.0f / WGU_SCALE;
#pragma unroll
        for (int ai = 0; ai < 2; ++ai)
#pragma unroll
            for (int m = 0; m < 4; ++m) { float o[8];
#pragma unroll
                for (int n = 0; n < 2; ++n)
#pragma unroll
                    for (int j = 0; j < 4; ++j) { const float gv = acc[ai][0][m][n][j] * inv, uv = acc[ai][1][m][n][j] * inv; o[n * 4 + j] = gv * sigmoidf_(gv) * uv; }
                int q0 = 0, q1 = 0;
                q0 = __builtin_amdgcn_cvt_pk_fp8_f32(o[0], o[1], q0, false); q0 = __builtin_amdgcn_cvt_pk_fp8_f32(o[2], o[3], q0, true);
                q1 = __builtin_amdgcn_cvt_pk_fp8_f32(o[4], o[5], q1, false); q1 = __builtin_amdgcn_cvt_pk_fp8_f32(o[6], o[7], q1, true);
                *(u32x2*)(HM + (size_t)(row0 + ai * 128 + m * 16) * 1024 + col0) = (u32x2){(unsigned)q0, (unsigned)q1}; }
    }
};
struct EpiMoe2 {
    static constexpr bool PERM = true;
    const u32x2* slot; bf16_t* Y2;
    __device__ __forceinline__ void operator()(g8::Acc& acc, const g8::Unit& u, int wr, int wc, int fr, int fq) const {
        const int col0 = u.pn * 256 + wc * 32 + 8 * fq;
        u32x2 si[2][4];
#pragma unroll
        for (int ai = 0; ai < 2; ++ai)
#pragma unroll
            for (int m = 0; m < 4; ++m) si[ai][m] = slot[u.pm * 256 + ai * 128 + wr * 64 + m * 16 + fr];
#pragma unroll
        for (int ai = 0; ai < 2; ++ai)
#pragma unroll
            for (int m = 0; m < 4; ++m) { const int asg = (int)si[ai][m].x;
                if (asg >= 0) { bf16_t* rowp = Y2 + (size_t)asg * DM + col0; const float ww = __uint_as_float(si[ai][m].y);
#pragma unroll
                    for (int bj = 0; bj < 2; ++bj) { const f32x4 v0 = acc[ai][bj][m][0] * ww, v1 = acc[ai][bj][m][1] * ww;
                        u32x4 w; w.x = cvt_pk_bf16(v0[0], v0[1]); w.y = cvt_pk_bf16(v0[2], v0[3]); w.z = cvt_pk_bf16(v1[0], v1[1]); w.w = cvt_pk_bf16(v1[2], v1[3]);
                        *(u32x4*)(rowp + bj * 128) = w; } } }
    }
};

constexpr size_t WS_KV = WS_H;
__device__ __forceinline__ void ssm_item(const Params& P, LAS unsigned char* lds, int tid, int item) {
    const int g = item >> 2, bp = item & 3;
    const int wave = __builtin_amdgcn_readfirstlane(tid >> 6), lane = tid & 63, fr = lane & 15, fq = lane >> 4;
    const bf16_t* proj = (const bf16_t*)(P.ws + WS_PROJ);
    const bf16_t* Ms = (const bf16_t*)(P.ws + WS_SSMM) + (size_t)g * 131072;
    const bf16_t* TM = Ms + 32768;
    bf16_t* Zo = (bf16_t*)(P.ws + WS_Z);
    constexpr int ZS = 136, MS = 264, TS = 392;
    LAS bf16_t* ZB = (LAS bf16_t*)lds;
    LAS bf16_t* WB = (LAS bf16_t*)(lds + 256 * ZS * 2);
    const int b = 2 * bp + (wave >> 2);
    int tok0[2];
    bf16x8 Uf[2][8];
#pragma unroll
    for (int mt = 0; mt < 2; ++mt) {
        const int c = 32 * (wave & 3) + 16 * mt + fr; tok0[mt] = b * 2048 + c * 16;
#pragma unroll
        for (int ks = 0; ks < 8; ++ks) Uf[mt][ks] = *(const bf16x8*)(proj + (size_t)(tok0[mt] + 2 * ks + (fq >> 1)) * NPROJ + g * 16 + 8 * (fq & 1));
    }
#pragma unroll
    for (int i = 0; i < 8; ++i) { const int row = tid >> 2, kc = (tid & 3) + 4 * i; *(LAS u32x4*)(WB + row * MS + kc * 8) = *(const u32x4*)(Ms + row * 256 + kc * 8); }
    __syncthreads();
#pragma unroll
    for (int nt = 0; nt < 8; ++nt) {
        f32x4 a0 = {0.f, 0.f, 0.f, 0.f}, a1 = {0.f, 0.f, 0.f, 0.f};
#pragma unroll
        for (int ks = 0; ks < 8; ++ks) {
            const bf16x8 bf = *(const LAS bf16x8*)(WB + (16 * nt + fr) * MS + 32 * ks + 8 * fq);
            a0 = __builtin_amdgcn_mfma_f32_16x16x32_bf16(bf, Uf[0][ks], a0, 0, 0, 0);
            a1 = __builtin_amdgcn_mfma_f32_16x16x32_bf16(bf, Uf[1][ks], a1, 0, 0, 0);
        }
        *(LAS u32x2*)(ZB + (32 * wave + fr) * ZS + 16 * nt + 4 * fq) = (u32x2){cvt_pk_bf16(a0[0], a0[1]), cvt_pk_bf16(a0[2], a0[3])};
        *(LAS u32x2*)(ZB + (32 * wave + 16 + fr) * ZS + 16 * nt + 4 * fq) = (u32x2){cvt_pk_bf16(a1[0], a1[1]), cvt_pk_bf16(a1[2], a1[3])};
    }
    u32x4 tmr[6];
#pragma unroll
    for (int i = 0; i < 6; ++i) { const int row = tid >> 3, kc = (tid & 7) + 8 * i; tmr[i] = *(const u32x4*)(TM + (size_t)row * 384 + kc * 8); }
    __syncthreads();
    if (tid < 128) {
        const int bl = tid >> 6, p = tid & 63;
        const f32x2 al = ((const f32x2*)(P.ws + WS_SSMA))[g * 64 + p];
        float xr = 0.f, xi = 0.f;
        LAS unsigned* zw = (LAS unsigned*)ZB + (bl * 128) * (ZS / 2) + p;
        for (int c0 = 0; c0 < 128; c0 += 8) {
            unsigned zv[8];
#pragma unroll
            for (int k = 0; k < 8; ++k) zv[k] = zw[(c0 + k) * (ZS / 2)];
#pragma unroll
            for (int k = 0; k < 8; ++k) {
                zw[(c0 + k) * (ZS / 2)] = cvt_pk_bf16(xr, xi);
                const float t = al.x * xr - al.y * xi + bf_lo(zv[k]); xi = al.x * xi + al.y * xr + bf_hi(zv[k]); xr = t;
            }
        }
    }
#pragma unroll
    for (int i = 0; i < 6; ++i) { const int row = tid >> 3, kc = (tid & 7) + 8 * i; *(LAS u32x4*)(WB + row * TS + kc * 8) = tmr[i]; }
    __syncthreads();
    const LAS bf16_t* xrow = ZB + (32 * wave + fr) * ZS + 8 * fq;
    const f32x4 dv = *(const f32x4*)(P.in[12] + g * 16 + 4 * fq);
#pragma unroll
    for (int cq = 0; cq < 4; ++cq) {
        u32x2 uu[4][2];
#pragma unroll
        for (int ntl = 0; ntl < 4; ++ntl)
#pragma unroll
            for (int mt = 0; mt < 2; ++mt) uu[ntl][mt] = *(const u32x2*)(proj + (size_t)(tok0[mt] + 4 * cq + ntl) * NPROJ + g * 16 + 4 * fq);
        if (cq < 3) {
#pragma unroll
            for (int i = 0; i < 6; ++i) { const int row = tid >> 3, kc = (tid & 7) + 8 * i; tmr[i] = *(const u32x4*)(TM + (size_t)(64 * (cq + 1) + row) * 384 + kc * 8); }
        }
#pragma unroll
        for (int ntl = 0; ntl < 4; ++ntl) {
            const int nt = 4 * cq + ntl;
            f32x4 a0 = {0.f, 0.f, 0.f, 0.f}, a1 = {0.f, 0.f, 0.f, 0.f};
            const LAS bf16_t* brow = WB + (16 * ntl + fr) * TS + 8 * fq;
#pragma unroll
            for (int ks = 0; ks < 8; ++ks) {
                if (2 * ks <= nt) {
                    const bf16x8 bf = *(const LAS bf16x8*)(brow + 32 * ks);
                    a0 = __builtin_amdgcn_mfma_f32_16x16x32_bf16(bf, Uf[0][ks], a0, 0, 0, 0);
                    a1 = __builtin_amdgcn_mfma_f32_16x16x32_bf16(bf, Uf[1][ks], a1, 0, 0, 0);
                }
            }
#pragma unroll
            for (int k2 = 0; k2 < 4; ++k2) {
                const bf16x8 bf = *(const LAS bf16x8*)(brow + 256 + 32 * k2);
                const bf16x8 x0 = *(const LAS bf16x8*)(xrow + 32 * k2), x1 = *(const LAS bf16x8*)(xrow + 16 * ZS + 32 * k2);
                a0 = __builtin_amdgcn_mfma_f32_16x16x32_bf16(bf, x0, a0, 0, 0, 0);
                a1 = __builtin_amdgcn_mfma_f32_16x16x32_bf16(bf, x1, a1, 0, 0, 0);
            }
#pragma unroll
            for (int mt = 0; mt < 2; ++mt) {
                const f32x4 a = mt ? a1 : a0;
                const size_t tok = (size_t)(tok0[mt] + nt);
                const u32x2 u2 = uu[ntl][mt];
                const float y0 = a[0] + dv[0] * bf_lo(u2.x), y1 = a[1] + dv[1] * bf_hi(u2.x), y2 = a[2] + dv[2] * bf_lo(u2.y), y3 = a[3] + dv[3] * bf_hi(u2.y);
                u32x2 w; w.x = cvt_pk_bf16(gelu_tanh(y0), gelu_tanh(y1)); w.y = cvt_pk_bf16(gelu_tanh(y2), gelu_tanh(y3));
                *(u32x2*)(Zo + tok * 1024 + g * 16 + 4 * fq) = w;
            }
        }
        __syncthreads();
        if (cq < 3) {
#pragma unroll
            for (int i = 0; i < 6; ++i) { const int row = tid >> 3, kc = (tid & 7) + 8 * i; *(LAS u32x4*)(WB + row * TS + kc * 8) = tmr[i]; }
            __syncthreads();
        }
    }
}

__device__ __forceinline__ bf16x8 tr_frag(const LAS bf16_t* tile, int row0, int col0, int fr, int fq) {
    const LAS bf16_t* p = tile + (row0 + 8 * fq + (fr >> 2)) * 136 + col0 + 4 * (fr & 3);
    const bf16x4 a = __builtin_amdgcn_ds_read_tr16_b64_v4i16((LAS bf16x4*)p);
    const bf16x4 b = __builtin_amdgcn_ds_read_tr16_b64_v4i16((LAS bf16x4*)(p + 4 * 136));
    bf16x8 r; r[0] = a[0]; r[1] = a[1]; r[2] = a[2]; r[3] = a[3]; r[4] = b[0]; r[5] = b[1]; r[6] = b[2]; r[7] = b[3]; return r;
}
__device__ __forceinline__ void ret_kv_items(const Params& P, LAS unsigned char* lds, int tid, int first, int stride) {
    const int wave = __builtin_amdgcn_readfirstlane(tid >> 6), lane = tid & 63, fr = lane & 15, fq = lane >> 4;
    constexpr int RS = 136;
    LAS bf16_t* Ks = (LAS bf16_t*)lds; LAS bf16_t* Vs = Ks + 128 * RS;
    const bf16_t* proj = (const bf16_t*)(P.ws + WS_PROJ);
    bf16_t* KV = (bf16_t*)(P.ws + WS_KV);
    const int si = tid >> 2, part = tid & 3, i0 = 16 * wave;
    u32x4 kr[4], vr[4];
    int item = first;
    if (item >= 768) return;
    { const int bh = item / 12, n = item % 12; const bf16_t* pr = proj + ((size_t)(bh >> 3) * 2048 + n * 128 + si) * NPROJ + (bh & 7) * 128 + 32 * part;
#pragma unroll
      for (int j = 0; j < 4; ++j) { kr[j] = *(const u32x4*)(pr + 2048 + 8 * j); vr[j] = *(const u32x4*)(pr + 3072 + 8 * j); } }
    for (;;) {
#pragma unroll
        for (int j = 0; j < 4; ++j) { *(LAS u32x4*)(Ks + si * RS + 32 * part + 8 * j) = kr[j]; *(LAS u32x4*)(Vs + si * RS + 32 * part + 8 * j) = vr[j]; }
        __syncthreads();
        const int nxt = item + stride; const bool more = nxt < 768;
        if (more) { const int bh = nxt / 12, n = nxt % 12; const bf16_t* pr = proj + ((size_t)(bh >> 3) * 2048 + n * 128 + si) * NPROJ + (bh & 7) * 128 + 32 * part;
#pragma unroll
            for (int j = 0; j < 4; ++j) { kr[j] = *(const u32x4*)(pr + 2048 + 8 * j); vr[j] = *(const u32x4*)(pr + 3072 + 8 * j); } }
        bf16x8 Vt[4];
#pragma unroll
        for (int ks = 0; ks < 4; ++ks) Vt[ks] = tr_frag(Vs, 32 * ks, i0, fr, fq);
        const int bh = item / 12, n = item % 12;
        bf16_t* op = KV + ((size_t)(bh * 16 + n) * 128 + i0 + fr) * 128 + 4 * fq;
#pragma unroll
        for (int nt = 0; nt < 8; ++nt) {
            f32x4 a = {0.f, 0.f, 0.f, 0.f};
#pragma unroll
            for (int ks = 0; ks < 4; ++ks) { const bf16x8 kf = tr_frag(Ks, 32 * ks, 16 * nt, fr, fq); a = __builtin_amdgcn_mfma_f32_16x16x32_bf16(kf, Vt[ks], a, 0, 0, 0); }
            *(u32x2*)(op + 16 * nt) = (u32x2){cvt_pk_bf16(a[0], a[1]), cvt_pk_bf16(a[2], a[3])};
        }
        __syncthreads();
        if (!more) break;
        item = nxt;
    }
}
__device__ __forceinline__ void ret_out_item(const Params& P, LAS unsigned char* lds, int tid, int item) {
    const int bh = item >> 2, q = item & 3, b = bh >> 3, h = bh & 7;
    const int wave = __builtin_amdgcn_readfirstlane(tid >> 6), lane = tid & 63, fr = lane & 15, fq = lane >> 4;
    constexpr int RS = 136;
    LAS bf16_t* Qs = (LAS bf16_t*)lds;
    LAS bf16_t* Ks = Qs + 128 * RS;
    LAS bf16_t* Vs = Ks + 128 * RS;
    LAS bf16_t* Rs = Vs + 128 * RS;
    const bf16_t* proj = (const bf16_t*)(P.ws + WS_PROJ);
    const bf16_t* KV = (const bf16_t*)(P.ws + WS_KV);
    bf16_t* CAT = (bf16_t*)(P.ws + WS_CAT);
    const float gam = 1.0f - exp2f(-5.0f - (float)h);
    const float lg2 = log2f(gam);
    const float gC1 = exp2f(lg2 * 127.0f), gC = exp2f(lg2 * 128.0f);
    const int si = tid >> 2, part = tid & 3, i0 = 16 * wave;
    u32x4 st[12];
    { const bf16_t* pr = proj + ((size_t)b * 2048 + (4 * q) * 128 + si) * NPROJ + h * 128 + 32 * part;
#pragma unroll
      for (int j = 0; j < 4; ++j) { st[j] = *(const u32x4*)(pr + 1024 + 8 * j); st[4 + j] = *(const u32x4*)(pr + 2048 + 8 * j); st[8 + j] = *(const u32x4*)(pr + 3072 + 8 * j); } }
    f32x4 accR[8];
#pragma unroll
    for (int nt = 0; nt < 8; ++nt) accR[nt] = (f32x4){0.f, 0.f, 0.f, 0.f};
    for (int m = 0; m < 4 * q; ++m) {
        const bf16_t* tp = KV + ((size_t)(bh * 16 + m) * 128 + i0 + fr) * 128 + 4 * fq;
        u32x2 t[8];
#pragma unroll
        for (int nt = 0; nt < 8; ++nt) t[nt] = *(const u32x2*)(tp + 16 * nt);
#pragma unroll
        for (int nt = 0; nt < 8; ++nt) { const f32x4 kv = {bf_lo(t[nt].x), bf_hi(t[nt].x), bf_lo(t[nt].y), bf_hi(t[nt].y)}; accR[nt] = accR[nt] * gC + kv * gC1; }
    }
#pragma unroll
    for (int nt = 0; nt < 8; ++nt)
        *(LAS u32x2*)(Rs + (i0 + fr) * RS + 16 * nt + 4 * fq) = (u32x2){cvt_pk_bf16(accR[nt][0], accR[nt][1]), cvt_pk_bf16(accR[nt][2], accR[nt][3])};
    for (int nn = 0; nn < 4; ++nn) {
        const int n = 4 * q + nn;
#pragma unroll
        for (int j = 0; j < 4; ++j) { *(LAS u32x4*)(Qs + si * RS + 32 * part + 8 * j) = st[j]; *(LAS u32x4*)(Ks + si * RS + 32 * part + 8 * j) = st[4 + j]; *(LAS u32x4*)(Vs + si * RS + 32 * part + 8 * j) = st[8 + j]; }
        __syncthreads();
        if (nn < 3) { const bf16_t* pr = proj + ((size_t)b * 2048 + (n + 1) * 128 + si) * NPROJ + h * 128 + 32 * part;
#pragma unroll
            for (int j = 0; j < 4; ++j) { st[j] = *(const u32x4*)(pr + 1024 + 8 * j); st[4 + j] = *(const u32x4*)(pr + 2048 + 8 * j); st[8 + j] = *(const u32x4*)(pr + 3072 + 8 * j); } }
        const size_t tok = (size_t)b * 2048 + n * 128 + i0 + fr;
        u32x2 gg[8];
        { const bf16_t* gp = proj + tok * NPROJ + 4096 + h * 128 + 4 * fq;
#pragma unroll
          for (int nt = 0; nt < 8; ++nt) gg[nt] = *(const u32x2*)(gp + 16 * nt); }
        bf16x8 Qf[4];
#pragma unroll
        for (int ks = 0; ks < 4; ++ks) Qf[ks] = *(const LAS bf16x8*)(Qs + (i0 + fr) * RS + 32 * ks + 8 * fq);
        f32x4 accS[8], accO[8];
#pragma unroll
        for (int nt = 0; nt < 8; ++nt) { accS[nt] = (f32x4){0.f, 0.f, 0.f, 0.f}; accO[nt] = (f32x4){0.f, 0.f, 0.f, 0.f}; }
#pragma unroll
        for (int nt = 0; nt < 8; ++nt) {
            if (nt <= wave) {
#pragma unroll
                for (int ks = 0; ks < 4; ++ks) { const bf16x8 kf = *(const LAS bf16x8*)(Ks + (16 * nt + fr) * RS + 32 * ks + 8 * fq); accS[nt] = __builtin_amdgcn_mfma_f32_16x16x32_bf16(kf, Qf[ks], accS[nt], 0, 0, 0); }
            }
        }
        if (n > 0) {
#pragma unroll
            for (int nt = 0; nt < 8; ++nt) {
#pragma unroll
                for (int ks = 0; ks < 4; ++ks) { const bf16x8 rf = *(const LAS bf16x8*)(Rs + (16 * nt + fr) * RS + 32 * ks + 8 * fq); accO[nt] = __builtin_amdgcn_mfma_f32_16x16x32_bf16(rf, Qf[ks], accO[nt], 0, 0, 0); }
                accO[nt] *= gam;
            }
        }
#pragma unroll
        for (int nt = 0; nt < 8; ++nt) {
            const int i = i0 + fr, j0 = 16 * nt + 4 * fq;
            const float p0 = (j0 <= i) ? accS[nt][0] : 0.f, p1 = (j0 + 1 <= i) ? accS[nt][1] : 0.f, p2 = (j0 + 2 <= i) ? accS[nt][2] : 0.f, p3 = (j0 + 3 <= i) ? accS[nt][3] : 0.f;
            *(LAS u32x2*)(Qs + i * RS + j0) = (u32x2){cvt_pk_bf16(p0, p1), cvt_pk_bf16(p2, p3)};
        }
        asm volatile("" ::: "memory");
        bf16x8 Pf[4];
#pragma unroll
        for (int ks = 0; ks < 4; ++ks) Pf[ks] = *(const LAS bf16x8*)(Qs + (i0 + fr) * RS + 32 * ks + 8 * fq);
#pragma unroll
        for (int ks = 0; ks < 4; ++ks) {
            if (2 * ks <= wave) {
#pragma unroll
                for (int nt = 0; nt < 8; ++nt) { const bf16x8 vf = tr_frag(Vs, 32 * ks, 16 * nt, fr, fq); accO[nt] = __builtin_amdgcn_mfma_f32_16x16x32_bf16(vf, Pf[ks], accO[nt], 0, 0, 0); }
            }
        }
        if (nn < 3) {
            bf16x8 Vt[4];
#pragma unroll
            for (int ks = 0; ks < 4; ++ks) Vt[ks] = tr_frag(Vs, 32 * ks, i0, fr, fq);
#pragma unroll
            for (int nt = 0; nt < 8; ++nt) {
                accR[nt] *= gam;
#pragma unroll
                for (int ks = 0; ks < 4; ++ks) { const bf16x8 kf = tr_frag(Ks, 32 * ks, 16 * nt, fr, fq); accR[nt] = __builtin_amdgcn_mfma_f32_16x16x32_bf16(kf, Vt[ks], accR[nt], 0, 0, 0); }
                accR[nt] *= gC1;
            }
        }
        {
            float s = 0.f;
#pragma unroll
            for (int nt = 0; nt < 8; ++nt) s += (accO[nt][0] + accO[nt][1]) + (accO[nt][2] + accO[nt][3]);
            s += __shfl_xor(s, 16); s += __shfl_xor(s, 32);
            const float mu = s * (1.0f / 128.0f); float qv = 0.f;
#pragma unroll
            for (int nt = 0; nt < 8; ++nt) { const f32x4 d = accO[nt] - mu; qv += (d[0] * d[0] + d[1] * d[1]) + (d[2] * d[2] + d[3] * d[3]); }
            qv += __shfl_xor(qv, 16); qv += __shfl_xor(qv, 32);
            const float rstd = rsqrtf(qv * (1.0f / 128.0f) + 1e-5f);
            bf16_t* op = CAT + tok * DM + 1024 + h * 128 + 4 * fq;
#pragma unroll
            for (int nt = 0; nt < 8; ++nt) {
                const float g0 = bf_lo(gg[nt].x), g1 = bf_hi(gg[nt].x), g2 = bf_lo(gg[nt].y), g3 = bf_hi(gg[nt].y);
                const f32x4 y = (accO[nt] - mu) * rstd;
                u32x2 w; w.x = cvt_pk_bf16(y[0] * g0 * sigmoidf_(g0), y[1] * g1 * sigmoidf_(g1)); w.y = cvt_pk_bf16(y[2] * g2 * sigmoidf_(g2), y[3] * g3 * sigmoidf_(g3));
                *(u32x2*)(op + 16 * nt) = w;
            }
        }
        __syncthreads();
        if (nn < 3) {
#pragma unroll
            for (int nt = 0; nt < 8; ++nt)
                *(LAS u32x2*)(Rs + (i0 + fr) * RS + 16 * nt + 4 * fq) = (u32x2){cvt_pk_bf16(accR[nt][0], accR[nt][1]), cvt_pk_bf16(accR[nt][2], accR[nt][3])};
        }
    }
}

__device__ __forceinline__ void p6_route(const Params& P, LAS unsigned char* lds, int tid, int blk, int G) {
    const int wave = __builtin_amdgcn_readfirstlane(tid >> 6), lane = tid & 63, fr = lane & 15, fq = lane >> 4;
    LAS float* gm = (LAS float*)lds; LAS float* sh = gm + 2048; LAS float* lg = sh + 2048;
    LAS float* lgr = lg + 8 * 64 * 48;
    LAS float* r2s = lgr + 64 * 36;
    LAS int* lcnt = (LAS int*)(r2s + 64); LAS int* lbase = lcnt + 32;
    int ra_ = 0, rb_ = 0, ea_ = 0, eb_ = 0; float w1_ = 0.f, w2_ = 0.f;
    const float* mod = (const float*)(P.ws + WS_MOD);
    const bf16_t* x1 = (const bf16_t*)(P.ws + WS_X1); const float* rowss2 = (const float*)(P.ws + WS_ROWSS2);
    unsigned char* H2 = P.ws + WS_H;
    const bf16_t* WR = (const bf16_t*)(P.ws + WS_WR);
    int* cnt = (int*)(P.ws + WS_CNT); int* list = (int*)(P.ws + WS_LIST); float* wgt = (float*)(P.ws + WS_WGT);
    for (int rb = blk; rb < 256; rb += G) {
        const int b = rb >> 5;
        for (int k = tid; k < 2048; k += NTHREADS) { gm[k] = P.in[18][k] * (1.0f + mod[(size_t)b * NMOD + 4 * DM + k]); sh[k] = mod[(size_t)b * NMOD + 3 * DM + k]; }
        if (tid < 32) lcnt[tid] = 0;
        if (tid >= 64 && tid < 128) { const int r = tid - 64; float tot2 = 0.f; const f32x4* pp = (const f32x4*)(rowss2 + (size_t)(rb * 64 + r) * 32);
#pragma unroll
            for (int i = 0; i < 8; ++i) { const f32x4 v = pp[i]; tot2 += (v[0] + v[1]) + (v[2] + v[3]); }
            r2s[r] = rsqrtf(tot2 * (1.0f / 2048.0f) + 1e-6f); }
        __syncthreads();
        float r2v[4];
#pragma unroll
        for (int mt = 0; mt < 4; ++mt) r2v[mt] = r2s[16 * mt + fr];
        f32x4 acc[4][3];
#pragma unroll
        for (int mt = 0; mt < 4; ++mt)
#pragma unroll
            for (int nt = 0; nt < 3; ++nt) acc[mt][nt] = (f32x4){0.f, 0.f, 0.f, 0.f};
        const bf16_t* xb = x1 + (size_t)(rb * 64 + fr) * DM + 256 * wave + 8 * fq;
        const bf16_t* wb = WR + (size_t)fr * 2048 + 256 * wave + 8 * fq;
        unsigned char* hb = H2 + (size_t)(rb * 64 + fr) * DM + 256 * wave + 8 * fq;
        u32x4 xc[2][4], xn[2][4]; bf16x8 bc[2][3], bn[2][3];
#pragma unroll
        for (int j = 0; j < 2; ++j) {
#pragma unroll
            for (int mt = 0; mt < 4; ++mt) xc[j][mt] = *(const u32x4*)(xb + (size_t)(16 * mt) * DM + 32 * j);
#pragma unroll
            for (int nt = 0; nt < 3; ++nt) bc[j][nt] = *(const bf16x8*)(wb + (size_t)(16 * nt) * 2048 + 32 * j); }
#pragma unroll 1
        for (int qt = 0; qt < 4; ++qt) {
            const int qn = qt < 3 ? qt + 1 : 3;
#pragma unroll
            for (int j = 0; j < 2; ++j) {
#pragma unroll
                for (int mt = 0; mt < 4; ++mt) xn[j][mt] = *(const u32x4*)(xb + (size_t)(16 * mt) * DM + 32 * (2 * qn + j));
#pragma unroll
                for (int nt = 0; nt < 3; ++nt) bn[j][nt] = *(const bf16x8*)(wb + (size_t)(16 * nt) * 2048 + 32 * (2 * qn + j)); }
#pragma unroll
            for (int j = 0; j < 2; ++j) {
                const int kl = 256 * wave + 32 * (2 * qt + j) + 8 * fq;
                const f32x4 g0 = *(const LAS f32x4*)(gm + kl), g1 = *(const LAS f32x4*)(gm + kl + 4), s0 = *(const LAS f32x4*)(sh + kl), s1 = *(const LAS f32x4*)(sh + kl + 4);
#pragma unroll
                for (int mt = 0; mt < 4; ++mt) {
                    const u32x4 xw = xc[j][mt];
                    const f32x4 a = {bf_lo(xw.x), bf_hi(xw.x), bf_lo(xw.y), bf_hi(xw.y)}, c = {bf_lo(xw.z), bf_hi(xw.z), bf_lo(xw.w), bf_hi(xw.w)};
                    const f32x4 h0 = a * r2v[mt] * g0 + s0, h1 = c * r2v[mt] * g1 + s1;
                    u32x4 w; w.x = cvt_pk_bf16(h0[0], h0[1]); w.y = cvt_pk_bf16(h0[2], h0[3]); w.z = cvt_pk_bf16(h1[0], h1[1]); w.w = cvt_pk_bf16(h1[2], h1[3]);
                    int q0 = 0, q1 = 0;
                    q0 = __builtin_amdgcn_cvt_pk_fp8_f32(h0[0], h0[1], q0, false); q0 = __builtin_amdgcn_cvt_pk_fp8_f32(h0[2], h0[3], q0, true);
                    q1 = __builtin_amdgcn_cvt_pk_fp8_f32(h1[0], h1[1], q1, false); q1 = __builtin_amdgcn_cvt_pk_fp8_f32(h1[2], h1[3], q1, true);
                    *(u32x2*)(hb + (size_t)(16 * mt) * DM + 32 * (2 * qt + j)) = (u32x2){(unsigned)q0, (unsigned)q1};
                    const bf16x8 af = __builtin_bit_cast(bf16x8, w);
#pragma unroll
                    for (int nt = 0; nt < 3; ++nt) acc[mt][nt] = __builtin_amdgcn_mfma_f32_16x16x32_bf16(bc[j][nt], af, acc[mt][nt], 0, 0, 0);
                }
            }
#pragma unroll
            for (int j = 0; j < 2; ++j) {
#pragma unroll
                for (int mt = 0; mt < 4; ++mt) xc[j][mt] = xn[j][mt];
#pragma unroll
                for (int nt = 0; nt < 3; ++nt) bc[j][nt] = bn[j][nt]; }
        }
#pragma unroll
        for (int mt = 0; mt < 4; ++mt)
#pragma unroll
            for (int nt = 0; nt < 3; ++nt) *(LAS f32x4*)(lg + (wave * 64 + 16 * mt + fr) * 48 + 16 * nt + 4 * fq) = acc[mt][nt];
        __syncthreads();
        for (int o = tid; o < 64 * 36; o += NTHREADS) { const int r = o / 36, nn = o % 36; float sum = 0.f;
#pragma unroll
            for (int w = 0; w < 8; ++w) sum += lg[(w * 64 + r) * 48 + nn];
            lgr[o] = sum; }
        __syncthreads();
        if (tid < 64) {
            const int tok = rb * 64 + tid;
            float l[36];
#pragma unroll
            for (int nn = 0; nn < 36; ++nn) l[nn] = lgr[tid * 36 + nn];
            float gl[4]; int gs = 0;
#pragma unroll
            for (int j = 0; j < 4; ++j) gl[j] = l[j] + P.in[20][j];
#pragma unroll
            for (int j = 1; j < 4; ++j) if (gl[j] > gl[gs]) gs = j;
            float gmax = gl[0];
#pragma unroll
            for (int j = 1; j < 4; ++j) gmax = fmaxf(gmax, gl[j]);
            float den = 0.f;
#pragma unroll
            for (int j = 0; j < 4; ++j) den += expf(gl[j] - gmax);
            const float gw = 1.0f / den;
            float el[8];
#pragma unroll
            for (int j = 0; j < 8; ++j) { float v = 0.f;
#pragma unroll
                for (int q = 0; q < 4; ++q) v = (gs == q) ? (l[4 + q * 8 + j] + P.in[22][q * 8 + j]) : v;
                el[j] = v; }
            int j1 = 0;
#pragma unroll
            for (int j = 1; j < 8; ++j) if (el[j] > el[j1]) j1 = j;
            int j2 = (j1 == 0) ? 1 : 0;
#pragma unroll
            for (int j = 0; j < 8; ++j) if (j != j1 && j != j2 && el[j] > el[j2]) j2 = j;
            float e1 = el[0], e2 = el[0];
#pragma unroll
            for (int j = 0; j < 8; ++j) { e1 = (j == j1) ? el[j] : e1; e2 = (j == j2) ? el[j] : e2; }
            const float t2 = expf(e2 - e1), w1 = gw / (1.0f + t2), w2 = gw * t2 / (1.0f + t2);
            const int ea = gs * 8 + j1, eb = gs * 8 + j2;
            ra_ = atomicAdd((int*)&lcnt[ea], 1); rb_ = atomicAdd((int*)&lcnt[eb], 1); ea_ = ea; eb_ = eb; w1_ = w1; w2_ = w2;
        }
        __syncthreads();
        if (tid < 32) { const int c = lcnt[tid]; lbase[tid] = c > 0 ? atomicAdd(cnt + tid * 64, c) : 0; }
        __syncthreads();
        if (tid < 64) {
            const int tok = rb * 64 + tid;
            list[ea_ * 16384 + lbase[ea_] + ra_] = tok * 2; wgt[tok * 2] = w1_;
            list[eb_ * 16384 + lbase[eb_] + rb_] = tok * 2 + 1; wgt[tok * 2 + 1] = w2_;
        }
        __syncthreads();
    }
}

__device__ __forceinline__ void p9_final(const Params& P, int tid, int blk, int G) {
    const int wave = tid >> 6, lane = tid & 63;
    const float* mod = (const float*)(P.ws + WS_MOD); const bf16_t* Y2 = (const bf16_t*)(P.ws + WS_Y2); const bf16_t* X1 = (const bf16_t*)(P.ws + WS_X1);
    f32x4 gf[8];
#pragma unroll
    for (int i = 0; i < 8; ++i) gf[i] = *(const f32x4*)(P.in[26] + (i * 64 + lane) * 4);
    int row = blk * 8 + wave;
    u32x2 xw[8], ya[8], yb[8], xwn[8], yan[8], ybn[8];
    if (row < NTOK) {
#pragma unroll
        for (int i = 0; i < 8; ++i) { const int k = (i * 64 + lane) * 4; xw[i] = *(const u32x2*)(X1 + (size_t)row * DM + k); ya[i] = *(const u32x2*)(Y2 + (size_t)(2 * row) * DM + k); yb[i] = *(const u32x2*)(Y2 + (size_t)(2 * row + 1) * DM + k); }
    }
    for (; row < NTOK; row += G * 8) {
        const int b = row >> 11, rown = row + G * 8;
        if (rown < NTOK) {
#pragma unroll
            for (int i = 0; i < 8; ++i) { const int k = (i * 64 + lane) * 4; xwn[i] = *(const u32x2*)(X1 + (size_t)rown * DM + k); yan[i] = *(const u32x2*)(Y2 + (size_t)(2 * rown) * DM + k); ybn[i] = *(const u32x2*)(Y2 + (size_t)(2 * rown + 1) * DM + k); }
        }
        f32x4 v[8]; float ss = 0.f;
#pragma unroll
        for (int i = 0; i < 8; ++i) {
            const int k = (i * 64 + lane) * 4;
            const f32x4 xv = {bf_lo(xw[i].x), bf_hi(xw[i].x), bf_lo(xw[i].y), bf_hi(xw[i].y)};
            const f32x4 gt = *(const f32x4*)(mod + (size_t)b * NMOD + 5 * DM + k);
            f32x4 y; y[0] = bf_lo(ya[i].x) + bf_lo(yb[i].x); y[1] = bf_hi(ya[i].x) + bf_hi(yb[i].x); y[2] = bf_lo(ya[i].y) + bf_lo(yb[i].y); y[3] = bf_hi(ya[i].y) + bf_hi(yb[i].y);
            v[i] = xv + gt * y;
            ss += v[i][0] * v[i][0] + v[i][1] * v[i][1] + v[i][2] * v[i][2] + v[i][3] * v[i][3];
        }
        ss = wave_sum(ss);
        const float r = rsqrtf(ss * (1.0f / 2048.0f) + 1e-6f);
        float* xr = P.out + (size_t)row * DM;
#pragma unroll
        for (int i = 0; i < 8; ++i) { const int k = (i * 64 + lane) * 4; *(f32x4*)(xr + k) = v[i] * r * gf[i]; }
#pragma unroll
        for (int i = 0; i < 8; ++i) { xw[i] = xwn[i]; ya[i] = yan[i]; yb[i] = ybn[i]; }
    }
}

__global__ void __launch_bounds__(NTHREADS, 2) hymba_fwd(Params P) {
    extern __shared__ __attribute__((aligned(16))) unsigned char lds_raw[];
    LAS unsigned char* lds = (LAS unsigned char*)lds_raw;
    const int tid = threadIdx.x, blk = blockIdx.x, G = gridDim.x;
    volatile LAS unsigned* misc = (volatile LAS unsigned*)(lds + LDS_MISC);
    if (tid < 64) misc[tid] = 0u;
    __syncthreads();
    XcdBarrier bar = xcd_barrier_post((unsigned*)(P.ws + WS_BAR), misc);
    const int lo = P.ph_lo, hi = P.ph_hi;
#define IN(k) (lo <= (k) && (k) < hi)
#define SEAM(k) do { if (IN(k) && IN((k) + 1)) xcd_barrier(bar); } while (0)
    unsigned char* ws = P.ws;

#ifndef REPR
#define REPR 1
#endif
#ifndef REPS
#define REPS 1
#endif
#ifndef REP0
#define REP0 1
#endif
#ifndef REP2
#define REP2 1
#endif
#ifndef REP7
#define REP7 1
#endif
#ifndef REP8
#define REP8 1
#endif
    if (IN(0)) for (int rep0 = 0; rep0 < REP0; ++rep0) {
        for (int it = blk; it < 256; it += G) p0_adaln(P, lds, tid, it);
        for (int it = blk; it < 256; it += G) p0_ssm_mats(P, lds, tid, it);
        p0_misc(P, tid, blk, G);
        p0_convert(P, lds, tid, blk, G);
    }
    SEAM(0);
    if (IN(1)) p1_norm1(P, lds, tid, blk, G);
    SEAM(1);
    if (IN(2)) for (int rep2 = 0; rep2 < REP2; ++rep2) {
        DenseSched S; S.init(NTOK, NPROJ, G, blk); S.abase = (unsigned)WS_H; S.bbase = (unsigned)WS_WIN; S.lda = DM; S.ldb = DM;
        EpiInProj E{(bf16_t*)(ws + WS_PROJ)};
        g8::gemm_phase(lds, ws, DM / 64, DM, S, E);
    }
    SEAM(2);
    if (IN(3)) {
        for (int it = blk; it < 256; it += G) ssm_item(P, lds, tid, it);
        ret_kv_items(P, lds, tid, blk, G);
    }
    SEAM(3);
    if (IN(4)) {
        for (int it = blk; it < 256; it += G) ret_out_item(P, lds, tid, it);
        __syncthreads();
        DenseSched S; S.init(NTOK, 1024, G, blk); S.abase = (unsigned)WS_Z; S.bbase = (unsigned)WS_WGLU; S.lda = 1024; S.ldb = 1024;
        EpiGlu E{(const bf16_t*)(ws + WS_Z), (bf16_t*)(ws + WS_CAT), (float*)(ws + WS_ROWSS1)};
        g8::gemm_phase(lds, ws, 1024 / 64, 1024, S, E);
    }
    SEAM(4);
    if (IN(5)) {
        OutSched S; S.init(NTOK, DM, G, blk); S.abase = (unsigned)WS_CAT; S.bbase = (unsigned)WS_WOUT;
        EpiOut E{P.in[0], (const float*)(ws + WS_MOD), (const float*)(ws + WS_ROWSS1), (float*)(ws + WS_ROWSS2), (bf16_t*)(ws + WS_X1)};
        g8::gemm_phase(lds, ws, 1024 / 64, DM, S, E);
    }
    SEAM(5);
    if (IN(6)) { p6_route(P, lds, tid, blk, G); p0_convert_fp8(P, lds, tid, blk, G, 0, 8192); }
    SEAM(6);
    if (IN(7) || IN(8)) {
        LAS int* tinfo = (LAS int*)(lds + LDS_MISC + 256); LAS int* trows = tinfo + 192; LAS int* ntl = trows + 192;
        if (tid == 0) {
            const int* cg = (const int*)(ws + WS_CNT); int nt_ = 0;
            for (int e = 0; e < 32; ++e) { const int c = cg[e * 64], full = c >> 8, rem = c & 255;
                for (int t = 0; t < full; ++t) { tinfo[nt_] = e | ((t * 256) << 8); trows[nt_] = 256; ++nt_; }
                if (rem > 128) { tinfo[nt_] = e | ((full * 256) << 8); trows[nt_] = rem; ++nt_; } }
            for (int e = 0; e < 32; ++e) { const int c = cg[e * 64], full = c >> 8, rem = c & 255; if (rem > 64 && rem <= 128) { tinfo[nt_] = e | ((full * 256) << 8); trows[nt_] = rem; ++nt_; } }
            for (int e = 0; e < 32; ++e) { const int c = cg[e * 64], full = c >> 8, rem = c & 255; if (rem > 0 && rem <= 64) { tinfo[nt_] = e | ((full * 256) << 8); trows[nt_] = rem; ++nt_; } }
            ntl[0] = nt_;
        }
        __syncthreads();
        const int ntiles = __builtin_amdgcn_readfirstlane(ntl[0]);
        if (IN(7)) {
            { u32x2* slot = (u32x2*)(ws + WS_SLOT); const int* lst = (const int*)(ws + WS_LIST); const float* wg = (const float*)(ws + WS_WGT);
              for (int ti = blk; ti < ntiles; ti += G) if (tid < 256) {
                  const int inf = tinfo[ti], e = inf & 255, r0 = inf >> 8, n = trows[ti];
                  u32x2 v; v.x = 0xffffffffu; v.y = 0u;
                  if (tid < n) { const int asg = lst[e * 16384 + r0 + tid]; v.x = (unsigned)asg; v.y = __float_as_uint(wg[asg] * (1.0f / WD_SCALE)); }
                  slot[ti * 256 + tid] = v; } }
            MoeSched S{tinfo, trows, ntiles, G, blk, (const int*)(ws + WS_LIST), (unsigned)WS_H, (unsigned)WS_WGU, 0};
            EpiMoe1 E{ws + WS_HM};
            g8::gemm_phase<EpiMoe1, MoeSched, true, 2>(lds, ws, DM / 128, DM, S, E);
            p0_convert_fp8(P, lds, tid, blk, G, 8192, 12288);
        }
        SEAM(7);
        if (IN(8)) {
            MoeSched S{tinfo, trows, ntiles, G, blk, (const int*)(ws + WS_LIST), (unsigned)WS_HM, (unsigned)WS_WD, 1};
            EpiMoe2 E{(const u32x2*)(ws + WS_SLOT), (bf16_t*)(ws + WS_Y2)};
            g8::gemm_phase<EpiMoe2, MoeSched, true, 2>(lds, ws, DEXP / 128, DEXP, S, E);
        }
    }
    SEAM(8);
    if (IN(9)) p9_final(P, tid, blk, G);
#undef IN
#undef SEAM
}

#ifndef N_LAUNCH_SPLIT
#define N_LAUNCH_SPLIT 0
#endif
extern "C" void kernel_launch(void* const* d_in, const int* in_sizes, int n_in, void* d_out, int out_size, void* d_ws, size_t ws_size, hipStream_t stream) {
    static int grid = 0;
    if (grid == 0) {
        if (n_in != 27 || out_size != NTOK * DM || ws_size < WS_END) { fprintf(stderr, "kernel_launch: unexpected shapes (n_in %d out %d ws %zu need %zu)\n", n_in, out_size, ws_size, (size_t)WS_END); grid = -1; return; }
        int dev = 0, cus = 0, per_cu = 0;
        if (hipGetDevice(&dev) != hipSuccess || hipDeviceGetAttribute(&cus, hipDeviceAttributeMultiprocessorCount, dev) != hipSuccess) { grid = -1; return; }
        if (hipFuncSetAttribute((const void*)hymba_fwd, hipFuncAttributeMaxDynamicSharedMemorySize, LDS_BYTES) != hipSuccess) { fprintf(stderr, "kernel_launch: hipFuncSetAttribute failed\n"); grid = -1; return; }
        if (hipOccupancyMaxActiveBlocksPerMultiprocessor(&per_cu, (const void*)hymba_fwd, NTHREADS, LDS_BYTES) != hipSuccess || per_cu < 1) { fprintf(stderr, "kernel_launch: occupancy query says %d\n", per_cu); }
        (void)hipGetLastError();
        grid = cus;
    }
    if (grid < 0) return;
    (void)hipMemsetAsync((char*)d_ws + WS_BAR, 0, 16384, stream);
    Params p{};
    for (int i = 0; i < 27; ++i) p.in[i] = (const float*)d_in[i];
    p.out = (float*)d_out; p.ws = (unsigned char*)d_ws;
#if N_LAUNCH_SPLIT
    for (int ph = 0; ph < 10; ++ph) { p.ph_lo = ph; p.ph_hi = ph + 1; hipLaunchKernelGGL(hymba_fwd, dim3(grid), dim3(NTHREADS), LDS_BYTES, stream, p); }
#else
    p.ph_lo = 0; p.ph_hi = 10;
    hipLaunchKernelGGL(hymba_fwd, dim3(grid), dim3(NTHREADS), LDS_BYTES, stream, p);
#endif
    const hipError_t le = hipPeekAtLastError();
    if (le != hipSuccess) fprintf(stderr, "kernel_launch: launch failed: %s\n", hipGetErrorName(le));
}
```

```cpp
#include <hip/hip_runtime.h>
#include <cstdio>
#include <cstdint>

#define LAS __attribute__((address_space(3)))
typedef unsigned short bf16_t;
typedef short bf16x8 __attribute__((ext_vector_type(8)));
typedef short bf16x4 __attribute__((ext_vector_type(4)));
typedef float f32x4 __attribute__((ext_vector_type(4)));
typedef float f32x2 __attribute__((ext_vector_type(2)));
typedef unsigned u32x4 __attribute__((ext_vector_type(4)));
typedef unsigned u32x2 __attribute__((ext_vector_type(2)));

constexpr int DM = 2048, NB = 8, SEQ = 2048, NTOK = NB * SEQ;
constexpr int NPROJ = 5120;
constexpr int NMOD = 6 * DM;
constexpr int NEXP = 32, DEXP = 1024;
constexpr int NTHREADS = 512;

constexpr size_t WS_BAR   = 0;
constexpr size_t WS_CNT   = 16384;
constexpr size_t WS_ROWSS1= WS_CNT + 8192;
constexpr size_t WS_ROWSS2= WS_ROWSS1 + (size_t)16384 * 16 * 4;
constexpr size_t WS_MODP  = WS_ROWSS2 + (size_t)16384 * 32 * 4;
constexpr size_t WS_MOD   = WS_MODP + (size_t)4 * 8 * NMOD * 4;
constexpr size_t WS_ROPE  = WS_MOD + (size_t)8 * NMOD * 4;
constexpr size_t WS_SSMA  = WS_ROPE + (size_t)2048 * 64 * 8;
constexpr size_t WS_WR    = WS_SSMA + (size_t)64 * 64 * 8;
constexpr size_t WS_SSMM  = WS_WR + (size_t)48 * 2048 * 2;
constexpr size_t WS_WIN   = WS_SSMM + (size_t)64 * 131072 * 2;
constexpr size_t WS_WOUT  = WS_WIN + (size_t)NPROJ * DM * 2;
constexpr size_t WS_WGLU  = WS_WOUT + (size_t)DM * DM * 2;
constexpr size_t WS_WGU   = WS_WGLU + (size_t)1024 * 1024 * 2;
constexpr size_t WS_WD    = WS_WGU + (size_t)NEXP * 2048 * 2048 * 2;
constexpr size_t WS_H     = WS_WD + (size_t)NEXP * 2048 * 1024 * 2;
constexpr size_t WS_PROJ  = WS_H + (size_t)NTOK * DM * 2;
constexpr size_t WS_Z     = WS_PROJ + (size_t)NTOK * NPROJ * 2;
constexpr size_t WS_CAT   = WS_Z + (size_t)NTOK * 1024 * 2;
constexpr size_t WS_WGT   = WS_CAT + (size_t)NTOK * DM * 2;
constexpr size_t WS_LIST  = WS_WGT + (size_t)32768 * 4;
constexpr size_t WS_SLOT  = WS_LIST + (size_t)32 * 16384 * 4;
constexpr size_t WS_X1    = WS_SLOT + (size_t)192 * 256 * 8;
constexpr size_t WS_END   = WS_X1 + (size_t)NTOK * DM * 2;
constexpr size_t WS_Y2    = WS_PROJ;
constexpr size_t WS_HM    = WS_Z;

constexpr int LDS_STAGE = 131072;
constexpr int LDS_BYTES = 147456;
constexpr int LDS_MISC  = LDS_BYTES - 2048;

struct Params { const float* in[27]; float* out; unsigned char* ws; int ph_lo, ph_hi; };

#define XB_TMO      128
#define XB_XCNT(j)  (256  + 64 * (j))
#define XB_XSUB(j)  (1280 + 64 * (j))
#define XB_XGEN(j)  (2304 + 64 * (j))
#define XB_TOP      3328
#define XB_TOPGEN   3392
#define XCD_BAR_WORDS 3456
#define XB_SPIN_CAP (1u << 22)

__device__ __forceinline__ unsigned xb_ld(unsigned* p)              { return __hip_atomic_load(p, __ATOMIC_RELAXED, __HIP_MEMORY_SCOPE_AGENT); }
__device__ __forceinline__ unsigned xb_add(unsigned* p, unsigned v) { return __hip_atomic_fetch_add(p, v, __ATOMIC_RELAXED, __HIP_MEMORY_SCOPE_AGENT); }
__device__ __forceinline__ unsigned xb_xcc_id() { return (unsigned)__builtin_amdgcn_s_getreg((3 << 11) | 20) & 0xFu; }
#define XB_SPIN(cond, bar) do { unsigned _sp = 0; while (cond) { __builtin_amdgcn_s_sleep(1); \
    if ((++_sp & 255u) == 0u) { if (xb_ld(&(bar)[XB_TMO])) break; if (_sp > XB_SPIN_CAP) { atomicAdd(&(bar)[XB_TMO], 1u); break; } } } } while (0)

struct XcdBarrier { unsigned* bar; unsigned x; volatile LAS unsigned* st; };

__device__ __forceinline__ XcdBarrier xcd_barrier_post(unsigned* bar, volatile LAS unsigned* st) {
    XcdBarrier b; b.bar = bar; b.x = xb_xcc_id(); b.st = st;
    if (threadIdx.x == 0) (void)xb_add(&bar[XB_XCNT(b.x)], 1u);
    return b;
}
__device__ __forceinline__ void xcd_barrier_complete(unsigned* bar, unsigned x, unsigned& nloc, unsigned& nx) {
    const unsigned G = gridDim.x * gridDim.y * gridDim.z;
    unsigned sum, cnt, mine, sp = 0u;
    for (;;) {
        sum = 0u; cnt = 0u; mine = 0u;
#pragma unroll
        for (unsigned j = 0; j < 16; ++j) { const unsigned c = xb_ld(&bar[XB_XCNT(j)]); sum += c; cnt += (c > 0u) ? 1u : 0u; mine = (j == x) ? c : mine; }
        if (sum == G) break;
        __builtin_amdgcn_s_sleep(1);
        if ((++sp & 255u) == 0u) { if (xb_ld(&bar[XB_TMO])) break; if (sp > XB_SPIN_CAP) { atomicAdd(&bar[XB_TMO], 1u); break; } }
    }
    nloc = mine > 0u ? mine : 1u; nx = cnt > 0u ? cnt : 1u;
}
__device__ __forceinline__ void xcd_barrier(const XcdBarrier& b) {
    asm volatile("s_waitcnt vmcnt(0)" ::: "memory");
    __syncthreads();
    if (threadIdx.x == 0) {
        unsigned* bar = b.bar;
        __builtin_amdgcn_s_waitcnt(0);
        unsigned nloc = b.st[0], nx = b.st[1];
        if (nloc == 0u) { xcd_barrier_complete(bar, b.x, nloc, nx); b.st[0] = nloc; b.st[1] = nx; }
        const unsigned old = xb_add(&bar[XB_XSUB(b.x)], 1u);
        const unsigned gen = old / nloc;
        if (old + 1u == (gen + 1u) * nloc) {
            __builtin_amdgcn_fence(__ATOMIC_RELEASE, "agent");
            asm volatile("s_waitcnt vmcnt(0)" ::: "memory");
            const unsigned og = xb_add(&bar[XB_TOP], 1u);
            const unsigned tg = og / nx;
            if (og + 1u == (tg + 1u) * nx) xb_add(&bar[XB_TOPGEN], 1u);
            else XB_SPIN(xb_ld(&bar[XB_TOPGEN]) == tg, bar);
            __builtin_amdgcn_fence(__ATOMIC_ACQUIRE, "agent");
            xb_add(&bar[XB_XGEN(b.x)], 1u);
            asm volatile("s_waitcnt vmcnt(0)" ::: "memory");
        } else {
            XB_SPIN(xb_ld(&bar[XB_XGEN(b.x)]) == gen, bar);
            __builtin_amdgcn_fence(__ATOMIC_ACQUIRE, "agent");
            asm volatile("s_waitcnt vmcnt(0)" ::: "memory");
        }
    }
    __syncthreads();
}

typedef __bf16 bf16x2_t __attribute__((ext_vector_type(2)));
__device__ __forceinline__ unsigned cvt_pk_bf16(float lo, float hi) { const f32x2 v = {lo, hi}; return __builtin_bit_cast(unsigned, __builtin_convertvector(v, bf16x2_t)); }
__device__ __forceinline__ float bf_lo(unsigned w) { return __uint_as_float(w << 16); }
__device__ __forceinline__ float bf_hi(unsigned w) { return __uint_as_float(w & 0xffff0000u); }
__device__ __forceinline__ float sigmoidf_(float x) { return __builtin_amdgcn_rcpf(1.0f + __expf(-x)); }
__device__ __forceinline__ float gelu_tanh(float x) {
    const float u = 0.7978845608028654f * (x + 0.044715f * x * x * x);
    const float t = 1.0f - 2.0f * __builtin_amdgcn_rcpf(1.0f + __expf(2.0f * u));
    return 0.5f * x * (1.0f + t);
}
__device__ __forceinline__ float wave_sum(float v) {
    v += __shfl_xor(v, 1); v += __shfl_xor(v, 2); v += __shfl_xor(v, 4); v += __shfl_xor(v, 8); v += __shfl_xor(v, 16); v += __shfl_xor(v, 32); return v;
}
__device__ __forceinline__ void sincos_d(double x, double& s, double& c) {
    const double TWO_PI = 6.283185307179586476925286766559;
    double r = x - TWO_PI * rint(x / TWO_PI);
    const double r2 = r * r;
    double ts = r, tc = 1.0; s = r; c = 1.0;
#pragma unroll 1
    for (int k = 1; k <= 14; ++k) { tc *= -r2 / (double)((2 * k - 1) * (2 * k)); ts *= -r2 / (double)((2 * k) * (2 * k + 1)); c += tc; s += ts; }
}

namespace g8 {
constexpr int BM = 256, BK = 64, HALF = 128, HTB = HALF * BK * 2, NXCD = 8, WGM = 8;
__device__ __forceinline__ int lds_byte(int r, int c) { const int st = (r >> 4) * 2 + (c >> 5), rr = r & 15, cc = c & 31, ob = rr * 64 + cc * 2; return st * 1024 + (ob ^ (((ob >> 9) & 1) << 5)); }
__device__ __forceinline__ void stage_rc(int b, int& R, int& C) { const int st = b / 1024, sb = b % 1024, swz = sb ^ (((sb >> 9) & 1) << 5); R = (st >> 1) * 16 + swz / 64; C = (st & 1) * 32 + (swz % 64) / 2; }
__device__ __forceinline__ int perm32(int rho) { const int n = rho >> 4, i = rho & 15; return 8 * (i >> 2) + 4 * n + (i & 3); }

struct Unit { unsigned aoff, boff; int pm, pn, flags, aux, aux2; };
typedef f32x4 Acc[2][2][4][2];

struct StaticOrder {
    int nM, nN, nwg, G, c;
    __device__ void init(int M, int N, int G_, int c_) { nM = M / BM; nN = N / BM; nwg = nM * nN; G = G_; c = c_; }
    __device__ __forceinline__ bool tile(int i, int& pm, int& pn) const {
        const long L = (long)i * G + c; if (L >= nwg) return false;
        int wgid = (int)L; { const int q = nwg / NXCD, r = nwg % NXCD, xcd = wgid % NXCD, off = wgid / NXCD; wgid = (xcd < r ? xcd * (q + 1) : r * (q + 1) + (xcd - r) * q) + off; }
        const int nig = WGM * nN, gid = wgid / nig, fm = gid * WGM, gsz = (nM - fm) < WGM ? (nM - fm) : WGM;
        pm = fm + ((wgid % nig) % gsz); pn = (wgid % nig) / gsz; return true;
    }
};

typedef long l64x2 __attribute__((ext_vector_type(2)));
typedef int i32x4 __attribute__((ext_vector_type(4)));
typedef int i32x8 __attribute__((ext_vector_type(8)));
template <class Epi, class Sched, bool SKIP = false, int FP8 = 0>
__device__ __forceinline__ void gemm_phase(LAS unsigned char* lds, const unsigned char* ws, const int nt, const int ldb  , const Sched& S, const Epi& E) {
    const int tid = threadIdx.x, wid = __builtin_amdgcn_readfirstlane(tid >> 6), lane = tid & 63, wr = wid >> 2, wc = wid & 3, fr = lane & 15, fq = lane >> 4;
    int R0, C0, R1, C1; stage_rc(tid * 16, R0, C0); stage_rc(tid * 16 + 8192, R1, C1);
    unsigned voffB[2];
    { const int Rb0 = Epi::PERM ? ((R0 & ~31) + perm32(R0 & 31)) : R0, Rb1 = Epi::PERM ? ((R1 & ~31) + perm32(R1 & 31)) : R1;
      voffB[0] = (unsigned)(Rb0 * 64 + C0) * 2u; voffB[1] = (unsigned)(Rb1 * 64 + C1) * 2u; }
    const unsigned kstep = (unsigned)(BK * 2);
    const unsigned kstepB = 256u * 64u * 2u;
    const unsigned hstepB = (unsigned)HALF * 64u * 2u;
    const unsigned ldsw = (unsigned)wid * 1024u;
    const int aoff = lds_byte(wr * 64 + fr, fq * 8), boff = lds_byte(wc * 32 + fr, fq * 8);
#define G8_SA(b, h) (((b) * 2 + (h)) * HTB)
#define G8_SB(b, h) ((4 + (b) * 2 + (h)) * HTB)
#define G8_STAGE(bufoff, gbase, v0, v1) do { \
        __builtin_amdgcn_global_load_lds((const unsigned*)((gbase) + (v0)), (LAS unsigned*)(lds + (bufoff) + ldsw), 16, 0, 0); \
        __builtin_amdgcn_global_load_lds((const unsigned*)((gbase) + (v1)), (LAS unsigned*)(lds + (bufoff) + ldsw + 8192), 16, 0, 0); } while (0)
#define G8_LDA(dst, b, h) do { _Pragma("unroll") for (int m = 0; m < 4; ++m) _Pragma("unroll") for (int k = 0; k < 2; ++k) dst[m][k] = *(const LAS bf16x8*)(lds + G8_SA(b, h) + aoff + m * 2048 + k * 1024); } while (0)
#define G8_LDB(dst, b, h) do { _Pragma("unroll") for (int n = 0; n < 2; ++n) _Pragma("unroll") for (int k = 0; k < 2; ++k) dst[n][k] = *(const LAS bf16x8*)(lds + G8_SB(b, h) + boff + n * 2048 + k * 1024); } while (0)
#define G8_MMA(ai, bj, At, Bt) do { __builtin_amdgcn_s_setprio(1); \
        if constexpr (FP8 == 2) { _Pragma("unroll") for (int m = 0; m < 4; ++m) _Pragma("unroll") for (int n = 0; n < 2; ++n) { \
            const i32x8 a8 = __builtin_shufflevector(__builtin_bit_cast(i32x4, At[m][0]), __builtin_bit_cast(i32x4, At[m][1]), 0, 1, 2, 3, 4, 5, 6, 7); \
            const i32x8 b8 = __builtin_shufflevector(__builtin_bit_cast(i32x4, Bt[n][0]), __builtin_bit_cast(i32x4, Bt[n][1]), 0, 1, 2, 3, 4, 5, 6, 7); \
            acc[ai][bj][m][n] = __builtin_amdgcn_mfma_scale_f32_16x16x128_f8f6f4(b8, a8, acc[ai][bj][m][n], 0, 0, 0, 0x7F7F7F7F, 0, 0x7F7F7F7F); } } \
        else { _Pragma("unroll") for (int m = 0; m < 4; ++m) _Pragma("unroll") for (int n = 0; n < 2; ++n) _Pragma("unroll") for (int k = 0; k < 2; ++k) { \
        if constexpr (FP8 == 1) { const l64x2 a2 = __builtin_bit_cast(l64x2, At[m][k]), b2 = __builtin_bit_cast(l64x2, Bt[n][k]); \
            acc[ai][bj][m][n] = __builtin_amdgcn_mfma_f32_16x16x32_fp8_fp8(b2[0], a2[0], acc[ai][bj][m][n], 0, 0, 0); \
            acc[ai][bj][m][n] = __builtin_amdgcn_mfma_f32_16x16x32_fp8_fp8(b2[1], a2[1], acc[ai][bj][m][n], 0, 0, 0); } \
        else acc[ai][bj][m][n] = __builtin_amdgcn_mfma_f32_16x16x32_bf16(Bt[n][k], At[m][k], acc[ai][bj][m][n], 0, 0, 0); } } __builtin_amdgcn_s_setprio(0); } while (0)
#define G8_WAIT_V(n) asm volatile("s_waitcnt vmcnt(" #n ")" ::: "memory")
#define G8_WAIT_L(n) asm volatile("s_waitcnt lgkmcnt(" #n ")" ::: "memory")
#define G8_BAR __builtin_amdgcn_s_barrier()
#define G8_SCHED __builtin_amdgcn_sched_barrier(0)
    Unit cur, nxt; int ui = 0;
    if (!S.next(0, cur)) return;
    Acc acc;
#pragma unroll
    for (int a = 0; a < 2; ++a)
#pragma unroll
        for (int b = 0; b < 2; ++b)
#pragma unroll
            for (int m = 0; m < 4; ++m)
#pragma unroll
                for (int n = 0; n < 2; ++n) acc[a][b][m][n] = (f32x4){0.f, 0.f, 0.f, 0.f};
    bf16x8 At[4][2], B0[2][2], B1[2][2];
    unsigned cv[2][2], nv[2][2];
    S.aoffs(cur, R0, C0, R1, C1, cv);
    const unsigned char* cA = ws + cur.aoff; const unsigned char* cB = ws + cur.boff;
    G8_STAGE(G8_SB(0, 0), cB, voffB[0], voffB[1]); G8_STAGE(G8_SA(0, 0), cA, cv[0][0], cv[0][1]);
    G8_STAGE(G8_SB(0, 1), cB + hstepB, voffB[0], voffB[1]); G8_STAGE(G8_SA(0, 1), cA, cv[1][0], cv[1][1]);
    if (wr == 1) G8_BAR;
    G8_WAIT_V(4); G8_BAR;
    G8_STAGE(G8_SB(1, 0), cB + kstepB, voffB[0], voffB[1]); G8_STAGE(G8_SA(1, 0), cA + kstep, cv[0][0], cv[0][1]);
    G8_STAGE(G8_SB(1, 1), cB + hstepB + kstepB, voffB[0], voffB[1]);
    G8_WAIT_V(6); G8_BAR;
    for (;;) {
        const bool has_next = S.next(ui + 1, nxt);
        if (has_next) S.aoffs(nxt, R0, C0, R1, C1, nv);
        else { nv[0][0] = cv[0][0]; nv[0][1] = cv[0][1]; nv[1][0] = cv[1][0]; nv[1][1] = cv[1][1]; }
        const unsigned char* nA = has_next ? ws + nxt.aoff : cA; const unsigned char* nB = has_next ? ws + nxt.boff : cB;
        const int vrows = SKIP ? cur.aux2 : 256;
        const bool do0 = !SKIP || vrows > 64 || wr == 0, do1 = !SKIP || vrows > 128;
        for (int t = 0; t < nt; t += 2) {
            const bool last = (t == nt - 2);
            const unsigned char* a1 = cA + (size_t)(t + 1) * kstep;
            const unsigned char* a2 = last ? nA : cA + (size_t)(t + 2) * kstep; const unsigned char* b2 = last ? nB : cB + (size_t)(t + 2) * kstepB;
            const unsigned char* a3 = a2 + kstep; const unsigned char* b3 = b2 + kstepB;
            const unsigned o00 = last ? nv[0][0] : cv[0][0], o01 = last ? nv[0][1] : cv[0][1], o10 = last ? nv[1][0] : cv[1][0], o11 = last ? nv[1][1] : cv[1][1];
            G8_LDB(B0, 0, 0); G8_SCHED; G8_LDA(At, 0, 0); G8_STAGE(G8_SA(1, 1), a1, cv[1][0], cv[1][1]);
            G8_WAIT_L(8); G8_BAR; G8_WAIT_L(0); if (do0) G8_MMA(0, 0, At, B0); G8_BAR; G8_SCHED;
            G8_LDB(B1, 0, 1); G8_STAGE(G8_SB(0, 0), b2, voffB[0], voffB[1]);
            G8_BAR; G8_WAIT_L(0); if (do0) G8_MMA(0, 1, At, B1); G8_BAR;
            G8_LDA(At, 0, 1); G8_STAGE(G8_SA(0, 0), a2, o00, o01);
            G8_BAR; G8_WAIT_L(0); if (do1) G8_MMA(1, 0, At, B0); G8_BAR; G8_SCHED;
            G8_STAGE(G8_SB(0, 1), b2 + hstepB, voffB[0], voffB[1]);
            G8_WAIT_V(6); G8_BAR; if (do1) G8_MMA(1, 1, At, B1); G8_BAR;
            G8_LDB(B0, 1, 0); G8_SCHED; G8_LDA(At, 1, 0); G8_STAGE(G8_SA(0, 1), a2, o10, o11);
            G8_WAIT_L(8); G8_BAR; G8_WAIT_L(0); if (do0) G8_MMA(0, 0, At, B0); G8_BAR; G8_SCHED;
            G8_LDB(B1, 1, 1); G8_STAGE(G8_SB(1, 0), b3, voffB[0], voffB[1]);
            G8_BAR; G8_WAIT_L(0); if (do0) G8_MMA(0, 1, At, B1); G8_BAR;
            G8_LDA(At, 1, 1); G8_STAGE(G8_SA(1, 0), a3, o00, o01);
            G8_BAR; G8_WAIT_L(0); if (do1) G8_MMA(1, 0, At, B0); G8_BAR; G8_SCHED;
            G8_STAGE(G8_SB(1, 1), b3 + hstepB, voffB[0], voffB[1]);
            G8_WAIT_V(6); G8_BAR; if (do1) G8_MMA(1, 1, At, B1); G8_BAR;
        }
        E(acc, cur, wr, wc, fr, fq);
        if (!has_next) break;
        if (!(cur.flags & 1)) {
#pragma unroll
            for (int a = 0; a < 2; ++a)
#pragma unroll
                for (int b = 0; b < 2; ++b)
#pragma unroll
                    for (int m = 0; m < 4; ++m)
#pragma unroll
                        for (int n = 0; n < 2; ++n) acc[a][b][m][n] = (f32x4){0.f, 0.f, 0.f, 0.f};
        }
        cur = nxt; cA = nA; cB = nB; ++ui;
        cv[0][0] = nv[0][0]; cv[0][1] = nv[0][1]; cv[1][0] = nv[1][0]; cv[1][1] = nv[1][1];
    }
    G8_WAIT_V(0);
    if (wr == 0) G8_BAR;
    G8_BAR;
#undef G8_SA
#undef G8_SB
#undef G8_STAGE
#undef G8_LDA
#undef G8_LDB
#undef G8_MMA
#undef G8_WAIT_V
#undef G8_WAIT_L
#undef G8_BAR
#undef G8_SCHED
}
}

__device__ __forceinline__ void p0_adaln(const Params& P, LAS unsigned char* lds, int tid, int item) {
    const int ks = item & 3, nc = item >> 2;
    LAS float* sc = (LAS float*)lds;
    LAS float* red = (LAS float*)(lds + 16384);
    const float* c = P.in[1];
    for (int i = tid; i < 4096; i += NTHREADS) { const int kl = i >> 3, b = i & 7; const float v = c[b * 2048 + ks * 512 + kl]; sc[i] = v / (1.0f + expf(-v)); }
    __syncthreads();
    if (tid < 384) {
        const int nq = tid % 48, kg = tid / 48;
        const float* W = P.in[2] + (size_t)(ks * 512 + kg * 64) * NMOD + nc * 192 + nq * 4;
        f32x4 acc[8];
#pragma unroll
        for (int b = 0; b < 8; ++b) acc[b] = (f32x4){0.f, 0.f, 0.f, 0.f};
#pragma unroll 16
        for (int kk = 0; kk < 64; ++kk) {
            const f32x4 w = *(const f32x4*)(W + (size_t)kk * NMOD);
            const f32x4 s0 = *(const LAS f32x4*)(sc + (kg * 64 + kk) * 8), s1 = *(const LAS f32x4*)(sc + (kg * 64 + kk) * 8 + 4);
            acc[0] += w * s0[0]; acc[1] += w * s0[1]; acc[2] += w * s0[2]; acc[3] += w * s0[3];
            acc[4] += w * s1[0]; acc[5] += w * s1[1]; acc[6] += w * s1[2]; acc[7] += w * s1[3];
        }
#pragma unroll
        for (int b = 0; b < 8; ++b) *(LAS f32x4*)(red + (kg * 8 + b) * 192 + nq * 4) = acc[b];
    }
    __syncthreads();
    float* modp = (float*)(P.ws + WS_MODP);
    for (int i = tid; i < 8 * 192; i += NTHREADS) {
        const int b = i / 192, n = i % 192; float s = 0.f;
#pragma unroll
        for (int kg = 0; kg < 8; ++kg) s += red[(kg * 8 + b) * 192 + n];
        modp[(size_t)(ks * 8 + b) * NMOD + nc * 192 + n] = s;
    }
    __syncthreads();
}

struct CvtUnit { const float* src; bf16_t* dst; int Nd, Kd, k0, n0, nmode; const float* s0; const float* s1; };
constexpr int CVT_UNITS = 640 + 256 + 64;
__device__ __forceinline__ void cvt_unit_decode(const Params& P, int L, CvtUnit& u) {
    u.s0 = nullptr; u.s1 = nullptr; u.nmode = 0;
    if (L < 640) { u.src = P.in[5]; u.dst = (bf16_t*)(P.ws + WS_WIN); u.Kd = 2048; u.Nd = 5120; u.k0 = (L / 20) * 64; u.n0 = (L % 20) * 256; u.nmode = 3; return; }
    L -= 640;
    if (L < 256) { u.src = P.in[17]; u.dst = (bf16_t*)(P.ws + WS_WOUT); u.Kd = 2048; u.Nd = 2048; u.k0 = (L / 8) * 64; u.n0 = (L % 8) * 256; u.s0 = P.in[15]; u.s1 = P.in[16]; return; }
    L -= 256;
    if (L < 64) { u.src = P.in[14]; u.dst = (bf16_t*)(P.ws + WS_WGLU); u.Kd = 1024; u.Nd = 1024; u.k0 = (L / 4) * 64; u.n0 = (L % 4) * 256; return; }
    L -= 64;
    if (L < 4096) { const int e = L >> 7, r = L & 127; u.src = P.in[23] + (size_t)e * 2048 * 1024; u.dst = (bf16_t*)(P.ws + WS_WGU) + (size_t)e * 2048 * 2048; u.Kd = 2048; u.Nd = 1024; u.k0 = (r >> 2) * 64; u.n0 = (r & 3) * 256; u.nmode = 1; return; }
    L -= 4096;
    if (L < 4096) { const int e = L >> 7, r = L & 127; u.src = P.in[24] + (size_t)e * 2048 * 1024; u.dst = (bf16_t*)(P.ws + WS_WGU) + (size_t)e * 2048 * 2048; u.Kd = 2048; u.Nd = 1024; u.k0 = (r >> 2) * 64; u.n0 = (r & 3) * 256; u.nmode = 2; return; }
    L -= 4096;
    { const int e = L >> 7, r = L & 127; u.src = P.in[25] + (size_t)e * 1024 * 2048; u.dst = (bf16_t*)(P.ws + WS_WD) + (size_t)e * 2048 * 1024; u.Kd = 1024; u.Nd = 2048; u.k0 = (r >> 3) * 64; u.n0 = (r & 7) * 256; }
}
__device__ __forceinline__ void cvt_load(const CvtUnit& u, int tid, f32x4 (&r)[8]) {
    const int kp = tid >> 4, nq = tid & 15;
    const float* p = u.src + (size_t)(u.k0 + 2 * kp) * u.Nd + u.n0 + nq * 4;
#pragma unroll
    for (int s = 0; s < 4; ++s) { r[2 * s] = *(const f32x4*)(p + s * 64); r[2 * s + 1] = *(const f32x4*)(p + u.Nd + s * 64); }
    if (u.s0) {
        const int k = u.k0 + 2 * kp;
        const float a = (k < 1024) ? u.s0[k] : u.s1[k - 1024], b = (k + 1 < 1024) ? u.s0[k + 1] : u.s1[k + 1 - 1024];
#pragma unroll
        for (int s = 0; s < 4; ++s) { r[2 * s] *= a; r[2 * s + 1] *= b; }
    }
}
__device__ __forceinline__ void cvt_to_lds(LAS unsigned* tile, const f32x4 (&r)[8], int kp, int nq) {
#pragma unroll
    for (int s = 0; s < 4; ++s)
#pragma unroll
        for (int j = 0; j < 4; ++j) tile[s * 2112 + (nq * 4 + j) * 33 + kp] = cvt_pk_bf16(r[2 * s][j], r[2 * s + 1][j]);
}
__device__ __forceinline__ void cvt_store(const LAS unsigned* tile, const CvtUnit& u, int nl, int kq) {
#pragma unroll
    for (int s = 0; s < 4; ++s) {
        u32x4 w; w.x = tile[s * 2112 + nl * 33 + kq * 4]; w.y = tile[s * 2112 + nl * 33 + kq * 4 + 1]; w.z = tile[s * 2112 + nl * 33 + kq * 4 + 2]; w.w = tile[s * 2112 + nl * 33 + kq * 4 + 3];
        const int n = u.n0 + s * 64 + nl;
        int np = n;
        if (u.nmode == 1 || u.nmode == 2) np = (n >> 7) * 256 + (n & 127) + (u.nmode == 2 ? 128 : 0);
        else if (u.nmode == 3 && n >= 1024 && n < 3072) { const int reg = (n >= 2048) ? 2048 : 1024, nr = n - reg;
            np = reg + ((nr >> 8) << 8) + (((nr >> 6) & 1) << 7) + (((nr >> 7) & 1) << 6) + (nr & 63); }
        *(u32x4*)(u.dst + (size_t)(np >> 8) * ((size_t)u.Kd * 256) + (size_t)(u.k0 >> 6) * 16384 + (np & 255) * 64 + kq * 8) = w;
    }
}
__device__ __forceinline__ void p0_convert(const Params& P, LAS unsigned char* lds, int tid, int blk, int G) {
    LAS unsigned* tileA = (LAS unsigned*)lds;
    LAS unsigned* tileB = tileA + 4 * 2112;
    const int kp = tid >> 4, nq = tid & 15, nl = tid >> 3, kq = tid & 7;
    CvtUnit uA, uB, nA, nB; f32x4 rA[8], rB[8];
    int L = blk;
    if (L >= CVT_UNITS) return;
    bool hasB = (L + G) < CVT_UNITS;
    cvt_unit_decode(P, L, uA); cvt_load(uA, tid, rA);
    if (hasB) { cvt_unit_decode(P, L + G, uB); cvt_load(uB, tid, rB); }
    for (;;) {
        cvt_to_lds(tileA, rA, kp, nq);
        if (hasB) cvt_to_lds(tileB, rB, kp, nq);
        __syncthreads();
        const int Ln = L + 2 * G; const bool moreA = Ln < CVT_UNITS, moreB = (Ln + G) < CVT_UNITS;
        if (moreA) { cvt_unit_decode(P, Ln, nA); cvt_load(nA, tid, rA); }
        if (moreB) { cvt_unit_decode(P, Ln + G, nB); cvt_load(nB, tid, rB); }
        cvt_store(tileA, uA, nl, kq);
        if (hasB) cvt_store(tileB, uB, nl, kq);
        __syncthreads();
        if (!moreA) break;
        uA = nA; uB = nB; hasB = moreB; L = Ln;
    }
}

struct Cvt8Unit { const float* src; unsigned char* dst; int Nd, Kd, k0, n0, nmode; float scale; };
constexpr float WGU_SCALE = 64.0f, WD_SCALE = 32.0f;
__device__ __forceinline__ void cvt8_decode(const Params& P, int L, Cvt8Unit& u) {
    if (L < 8192) { const int up = L >= 4096; const int r_ = L & 4095; const int e = r_ >> 7, r = r_ & 127;
        u.src = P.in[up ? 24 : 23] + (size_t)e * 2048 * 1024; u.dst = P.ws + WS_WGU + (size_t)e * 2048 * 2048; u.Kd = 2048; u.Nd = 1024; u.k0 = (r >> 3) * 128; u.n0 = (r & 7) * 128; u.nmode = up ? 2 : 1; u.scale = WGU_SCALE; return; }
    L -= 8192;
    { const int e = L >> 7, r = L & 127; u.src = P.in[25] + (size_t)e * 1024 * 2048; u.dst = P.ws + WS_WD + (size_t)e * 2048 * 1024; u.Kd = 1024; u.Nd = 2048; u.k0 = (r >> 4) * 128; u.n0 = (r & 15) * 128; u.nmode = 0; u.scale = WD_SCALE; }
}
__device__ __forceinline__ void cvt8_load(const Cvt8Unit& u, int tid, f32x4 (&r)[8]) {
    const int kg = tid >> 5, nq = tid & 31;
    const float* p = u.src + (size_t)(u.k0 + 8 * kg) * u.Nd + u.n0 + nq * 4;
#pragma unroll
    for (int kk = 0; kk < 8; ++kk) r[kk] = __builtin_nontemporal_load((const f32x4*)(p + (size_t)kk * u.Nd));
}
__device__ __forceinline__ void cvt8_to_lds(LAS unsigned* tile, const f32x4 (&r)[8], float sc, int tid) {
    const int kg = tid >> 5, nq = tid & 31;
    u32x4 w0, w1;
#pragma unroll
    for (int j = 0; j < 4; ++j) {
        int a = 0, b = 0;
        a = __builtin_amdgcn_cvt_pk_fp8_f32(r[0][j] * sc, r[1][j] * sc, a, false); a = __builtin_amdgcn_cvt_pk_fp8_f32(r[2][j] * sc, r[3][j] * sc, a, true);
        b = __builtin_amdgcn_cvt_pk_fp8_f32(r[4][j] * sc, r[5][j] * sc, b, false); b = __builtin_amdgcn_cvt_pk_fp8_f32(r[6][j] * sc, r[7][j] * sc, b, true);
        w0[j] = (unsigned)a; w1[j] = (unsigned)b;
    }
    *(LAS u32x4*)(tile + (2 * kg) * 132 + nq * 4) = w0;
    *(LAS u32x4*)(tile + (2 * kg + 1) * 132 + nq * 4) = w1;
}
__device__ __forceinline__ void cvt8_store(const LAS unsigned* tile, const Cvt8Unit& u, int tid) {
    const int nl = tid >> 2, q = tid & 3;
    u32x4 w0, w1;
    w0.x = tile[(8 * q + 0) * 132 + nl]; w0.y = tile[(8 * q + 1) * 132 + nl]; w0.z = tile[(8 * q + 2) * 132 + nl]; w0.w = tile[(8 * q + 3) * 132 + nl];
    w1.x = tile[(8 * q + 4) * 132 + nl]; w1.y = tile[(8 * q + 5) * 132 + nl]; w1.z = tile[(8 * q + 6) * 132 + nl]; w1.w = tile[(8 * q + 7) * 132 + nl];
    const int n = u.n0 + nl;
    int np = n;
    if (u.nmode == 1 || u.nmode == 2) np = (n >> 7) * 256 + (n & 127) + (u.nmode == 2 ? 128 : 0);
    unsigned char* d = u.dst + (size_t)(np >> 8) * ((size_t)u.Kd * 256) + (size_t)(u.k0 >> 7) * 32768 + (np & 255) * 128 + q * 32;
    *(u32x4*)d = w0; *(u32x4*)(d + 16) = w1;
}
__device__ __forceinline__ void p0_convert_fp8(const Params& P, LAS unsigned char* lds, int tid, int blk, int G, const int Lbeg, const int Lend) {
    LAS unsigned* tileA = (LAS unsigned*)lds;
    LAS unsigned* tileB = tileA + 32 * 132;
    Cvt8Unit uA, uB, nA, nB; f32x4 rA[8], rB[8];
    int L = Lbeg + blk;
    if (L >= Lend) return;
    bool hasB = (L + G) < Lend;
    cvt8_decode(P, L, uA); cvt8_load(uA, tid, rA);
    if (hasB) { cvt8_decode(P, L + G, uB); cvt8_load(uB, tid, rB); }
    for (;;) {
        cvt8_to_lds(tileA, rA, uA.scale, tid);
        if (hasB) cvt8_to_lds(tileB, rB, uB.scale, tid);
        __syncthreads();
        const int Ln = L + 2 * G; const bool moreA = Ln < Lend, moreB = (Ln + G) < Lend;
        if (moreA) { cvt8_decode(P, Ln, nA); cvt8_load(nA, tid, rA); }
        if (moreB) { cvt8_decode(P, Ln + G, nB); cvt8_load(nB, tid, rB); }
        cvt8_store(tileA, uA, tid);
        if (hasB) cvt8_store(tileB, uB, tid);
        __syncthreads();
        if (!moreA) break;
        uA = nA; uB = nB; hasB = moreB; L = Ln;
    }
}

__device__ __forceinline__ void p0_ssm_mats(const Params& P, LAS unsigned char* lds, int tid, int item) {
    const int g = item & 63, q = item >> 6;
    LAS f32x2* pw = (LAS f32x2*)lds;
    LAS f32x2* Bb = pw + 17 * 64;
    LAS f32x2* Cc = Bb + 64 * 16;
    LAS float* Kt = (LAS float*)(Cc + 16 * 64);
    if (tid < 64) {
        const int p = tid;
        const float dt = expf(P.in[13][g]);
        const float are = P.in[6][g * 64 + p], aim = P.in[7][g * 64 + p];
        const float mag = expf(dt * are);
        double sd, cd; sincos_d((double)(dt * aim), sd, cd);
        const float abr = mag * (float)cd, abi = mag * (float)sd;
        const float inv = 1.0f / (are * are + aim * aim);
        const float nre = abr - 1.0f;
        const float fre = (nre * are + abi * aim) * inv, fim = (abi * are - nre * aim) * inv;
        float pr = 1.0f, pi = 0.0f;
        for (int n = 0; n <= 16; ++n) { pw[n * 64 + p] = (f32x2){pr, pi}; const float t = pr * abr - pi * abi; pi = pr * abi + pi * abr; pr = t; }
        for (int h = 0; h < 16; ++h) {
            const float br = P.in[8][(g * 64 + p) * 16 + h], bi = P.in[9][(g * 64 + p) * 16 + h];
            Bb[p * 16 + h] = (f32x2){fre * br - fim * bi, fre * bi + fim * br};
            Cc[h * 64 + p] = (f32x2){P.in[10][(g * 16 + h) * 64 + p], P.in[11][(g * 16 + h) * 64 + p]};
        }
        if (q == 0) { f32x2* AL = (f32x2*)(P.ws + WS_SSMA); const f32x2 v = pw[16 * 64 + p]; AL[g * 64 + p] = v; }
    }
    __syncthreads();
    {
        const int wv = tid >> 6, ln = tid & 63, fi = ln & 15, fk = ln >> 4;
#pragma unroll
        for (int tt = 0; tt < 2; ++tt) {
            const int tau = 2 * wv + tt;
            f32x4 acc = {0.f, 0.f, 0.f, 0.f};
#pragma unroll 8
            for (int st = 0; st < 32; ++st) {
                const int kk = 4 * st + fk, p = kk >> 1;
                const f32x2 c = Cc[fi * 64 + p], a = pw[tau * 64 + p], bb = Bb[p * 16 + fi];
                const float av = (kk & 1) ? -(c.x * a.y + c.y * a.x) : (c.x * a.x - c.y * a.y);
                const float bv = (kk & 1) ? bb.y : bb.x;
                acc = __builtin_amdgcn_mfma_f32_16x16x4f32(av, bv, acc, 0, 0, 0);
            }
#pragma unroll
            for (int r = 0; r < 4; ++r) Kt[(tau * 16 + 4 * fk + r) * 16 + fi] = acc[r];
        }
    }
    __syncthreads();
    bf16_t* Ms = (bf16_t*)(P.ws + WS_SSMM) + (size_t)g * 131072;
    bf16_t* TM = Ms + 32768;
    for (int o = tid; o < 32 * 128; o += NTHREADS) {
        const int row = 32 * q + (o >> 7), col = (o & 127) * 2;
        const int p = row >> 1, j = col >> 4, hi = col & 15;
        const f32x2 a = pw[(15 - j) * 64 + p], b0 = Bb[p * 16 + hi], b1 = Bb[p * 16 + hi + 1];
        float v0, v1;
        if ((row & 1) == 0) { v0 = a.x * b0.x - a.y * b0.y; v1 = a.x * b1.x - a.y * b1.y; } else { v0 = a.x * b0.y + a.y * b0.x; v1 = a.x * b1.y + a.y * b1.x; }
        *(unsigned*)(Ms + (size_t)row * 256 + col) = cvt_pk_bf16(v0, v1);
    }
    for (int o = tid; o < 64 * 192; o += NTHREADS) {
        const int row = 64 * q + o / 192, col = (o % 192) * 2;
        const int i = row >> 4, ho = row & 15; float v0, v1;
        if (col < 256) { const int j = col >> 4, hi = col & 15; if (j <= i) { v0 = Kt[((i - j) * 16 + ho) * 16 + hi]; v1 = Kt[((i - j) * 16 + ho) * 16 + hi + 1]; } else { v0 = 0.f; v1 = 0.f; } }
        else { const int p0 = (col - 256) >> 1;
            const f32x2 c0 = Cc[ho * 64 + p0], a0 = pw[(i + 1) * 64 + p0];
            v0 = c0.x * a0.x - c0.y * a0.y; v1 = -(c0.x * a0.y + c0.y * a0.x); }
        *(unsigned*)(TM + (size_t)row * 384 + col) = cvt_pk_bf16(v0, v1);
    }
    __syncthreads();
}

__device__ __forceinline__ void p0_misc(const Params& P, int tid, int blk, int G) {
    bf16_t* wr = (bf16_t*)(P.ws + WS_WR);
    for (int i = blk * NTHREADS + tid; i < 48 * 2048; i += G * NTHREADS) {
        const int n = i >> 11, k = i & 2047; float v = 0.f;
        if (n < 4) v = P.in[19][k * 4 + n]; else if (n < 36) v = P.in[21][k * 32 + (n - 4)];
        wr[i] = (bf16_t)(cvt_pk_bf16(v, 0.f) & 0xffffu);
    }
    if (blk == 0) for (int i = tid; i < 2048; i += NTHREADS) ((int*)(P.ws + WS_CNT))[i] = 0;
}

__device__ __forceinline__ void p1_norm1(const Params& P, LAS unsigned char* lds, int tid, int blk, int G) {
    const float* modp = (const float*)(P.ws + WS_MODP); const float* bada = P.in[3];
    float* mod = (float*)(P.ws + WS_MOD);
    for (int i = blk * NTHREADS + tid; i < 8 * NMOD; i += G * NTHREADS) {
        const int b = i / NMOD, j = i % NMOD;
        mod[i] = bada[j] + ((modp[(size_t)(0 * 8 + b) * NMOD + j] + modp[(size_t)(1 * 8 + b) * NMOD + j]) + (modp[(size_t)(2 * 8 + b) * NMOD + j] + modp[(size_t)(3 * 8 + b) * NMOD + j]));
    }
    LAS float* gm = (LAS float*)lds; LAS float* sh = gm + 2048;
    const int wave = tid >> 6, lane = tid & 63;
    bf16_t* H = (bf16_t*)(P.ws + WS_H);
    for (int rb = blk; rb < 256; rb += G) {
        const int b = rb >> 5;
        for (int k = tid; k < 2048; k += NTHREADS) {
            const int js = 2048 + k, jh = k;
            const float sc = bada[js] + ((modp[(size_t)(0 * 8 + b) * NMOD + js] + modp[(size_t)(1 * 8 + b) * NMOD + js]) + (modp[(size_t)(2 * 8 + b) * NMOD + js] + modp[(size_t)(3 * 8 + b) * NMOD + js]));
            const float sv = bada[jh] + ((modp[(size_t)(0 * 8 + b) * NMOD + jh] + modp[(size_t)(1 * 8 + b) * NMOD + jh]) + (modp[(size_t)(2 * 8 + b) * NMOD + jh] + modp[(size_t)(3 * 8 + b) * NMOD + jh]));
            gm[k] = P.in[4][k] * (1.0f + sc); sh[k] = sv;
        }
        __syncthreads();
        f32x4 v[8], vn[8];
        { const float* xr = P.in[0] + (size_t)(rb * 64 + wave * 8) * DM;
#pragma unroll
          for (int i = 0; i < 8; ++i) v[i] = *(const f32x4*)(xr + (i * 64 + lane) * 4); }
        for (int rr = 0; rr < 8; ++rr) {
            const int row = rb * 64 + wave * 8 + rr;
            if (rr < 7) { const float* xn = P.in[0] + (size_t)(row + 1) * DM;
#pragma unroll
                for (int i = 0; i < 8; ++i) vn[i] = *(const f32x4*)(xn + (i * 64 + lane) * 4); }
            float ss = 0.f;
#pragma unroll
            for (int i = 0; i < 8; ++i) ss += v[i][0] * v[i][0] + v[i][1] * v[i][1] + v[i][2] * v[i][2] + v[i][3] * v[i][3];
            ss = wave_sum(ss);
            const float r = rsqrtf(ss * (1.0f / 2048.0f) + 1e-6f);
#pragma unroll
            for (int i = 0; i < 8; ++i) {
                const int k = (i * 64 + lane) * 4;
                const f32x4 g4 = *(const LAS f32x4*)(gm + k), s4 = *(const LAS f32x4*)(sh + k);
                const f32x4 o = v[i] * r * g4 + s4;
                u32x2 w; w.x = cvt_pk_bf16(o[0], o[1]); w.y = cvt_pk_bf16(o[2], o[3]);
                *(u32x2*)(H + (size_t)row * DM + k) = w;
            }
#pragma unroll
            for (int i = 0; i < 8; ++i) v[i] = vn[i];
        }
        __syncthreads();
    }
}

struct DenseSched : g8::StaticOrder {
    unsigned abase, bbase; int lda, ldb;
    __device__ __forceinline__ bool next(int i, g8::Unit& u) const {
        int pm, pn; if (!tile(i, pm, pn)) return false;
        u.pm = __builtin_amdgcn_readfirstlane(pm); u.pn = __builtin_amdgcn_readfirstlane(pn); u.flags = 0; u.aux = 0;
        u.aoff = abase + (unsigned)u.pm * 256u * (unsigned)lda * 2u; u.boff = bbase + (unsigned)u.pn * 256u * (unsigned)ldb * 2u; return true;
    }
    __device__ __forceinline__ void aoffs(const g8::Unit&, int R0, int C0, int R1, int C1, unsigned (&v)[2][2]) const {
        v[0][0] = (unsigned)(R0 * lda + C0) * 2u; v[0][1] = (unsigned)(R1 * lda + C1) * 2u;
        v[1][0] = (unsigned)((128 + R0) * lda + C0) * 2u; v[1][1] = (unsigned)((128 + R1) * lda + C1) * 2u;
    }
};
struct EpiStoreBf16 {
    static constexpr bool PERM = true;
    bf16_t* O; int ldc;
    __device__ __forceinline__ void operator()(g8::Acc& acc, const g8::Unit& u, int wr, int wc, int fr, int fq) const {
        const int row0 = u.pm * 256 + wr * 64 + fr, col0 = u.pn * 256 + wc * 32 + 8 * fq;
#pragma unroll
        for (int ai = 0; ai < 2; ++ai)
#pragma unroll
            for (int m = 0; m < 4; ++m) { bf16_t* rowp = O + (size_t)(row0 + ai * 128 + m * 16) * ldc + col0;
#pragma unroll
                for (int bj = 0; bj < 2; ++bj) { const f32x4 v0 = acc[ai][bj][m][0], v1 = acc[ai][bj][m][1];
                    u32x4 w; w.x = cvt_pk_bf16(v0[0], v0[1]); w.y = cvt_pk_bf16(v0[2], v0[3]); w.z = cvt_pk_bf16(v1[0], v1[1]); w.w = cvt_pk_bf16(v1[2], v1[3]);
                    *(u32x4*)(rowp + bj * 128) = w; } }
    }
};
struct EpiInProj {
    static constexpr bool PERM = true;
    bf16_t* O;
    __device__ __forceinline__ void operator()(g8::Acc& acc, const g8::Unit& u, int wr, int wc, int fr, int fq) const {
        const int pn = u.pn;
        const int row0 = u.pm * 256 + wr * 64 + fr;
        if (pn < 4 || pn >= 12) {
            const int col0 = pn * 256 + wc * 32 + 8 * fq;
#pragma unroll
            for (int ai = 0; ai < 2; ++ai)
#pragma unroll
                for (int m = 0; m < 4; ++m) { bf16_t* rowp = O + (size_t)(row0 + ai * 128 + m * 16) * NPROJ + col0;
#pragma unroll
                    for (int bj = 0; bj < 2; ++bj) { const f32x4 v0 = acc[ai][bj][m][0], v1 = acc[ai][bj][m][1];
                        u32x4 w; w.x = cvt_pk_bf16(v0[0], v0[1]); w.y = cvt_pk_bf16(v0[2], v0[3]); w.z = cvt_pk_bf16(v1[0], v1[1]); w.w = cvt_pk_bf16(v1[2], v1[3]);
                        *(u32x4*)(rowp + bj * 128) = w; } }
            return;
        }
        const bool isq = pn < 8;
        const int head = 2 * ((pn - 4) & 3) + (wc >> 1);
        const int dd0 = 32 * (wc & 1) + 8 * fq;
        const int colbase = (isq ? 1024 : 2048) + head * 128 + dd0;
        const float lg2 = log2f(1.0f - exp2f(-5.0f - (float)head));
        float fr_[8];
#pragma unroll
        for (int t = 0; t < 8; ++t) fr_[t] = exp2f(-(float)(dd0 + t) * 0.20762050593046014f) * 0.15915494309189535f;
#pragma unroll
        for (int ai = 0; ai < 2; ++ai)
#pragma unroll
            for (int m = 0; m < 4; ++m) {
                const int row = row0 + ai * 128 + m * 16, pos = row & 2047, i = wr * 64 + m * 16 + fr;
                const float sc = isq ? exp2f(lg2 * (float)i) : exp2f(-lg2 * (float)i) * 0.08838834764831845f;
                const float fp = (float)pos;
                float o1[8], o2[8];
#pragma unroll
                for (int t = 0; t < 8; ++t) {
                    const float rev = __builtin_amdgcn_fractf(fp * fr_[t]);
                    const float cs = __builtin_amdgcn_cosf(rev) * sc, sn = __builtin_amdgcn_sinf(rev) * sc;
                    const float a = acc[ai][0][m][t >> 2][t & 3], b = acc[ai][1][m][t >> 2][t & 3];
                    o1[t] = a * cs - b * sn; o2[t] = b * cs + a * sn;
                }
                bf16_t* rowp = O + (size_t)row * NPROJ + colbase;
                u32x4 w1, w2; w1.x = cvt_pk_bf16(o1[0], o1[1]); w1.y = cvt_pk_bf16(o1[2], o1[3]); w1.z = cvt_pk_bf16(o1[4], o1[5]); w1.w = cvt_pk_bf16(o1[6], o1[7]);
                w2.x = cvt_pk_bf16(o2[0], o2[1]); w2.y = cvt_pk_bf16(o2[2], o2[3]); w2.z = cvt_pk_bf16(o2[4], o2[5]); w2.w = cvt_pk_bf16(o2[6], o2[7]);
                *(u32x4*)rowp = w1; *(u32x4*)(rowp + 64) = w2;
            }
    }
};
struct EpiGlu {
    static constexpr bool PERM = true;
    const bf16_t* Z; bf16_t* CAT; float* rowss;
    __device__ __forceinline__ void operator()(g8::Acc& acc, const g8::Unit& u, int wr, int wc, int fr, int fq) const {
        const int row0 = u.pm * 256 + wr * 64 + fr, col0 = u.pn * 256 + wc * 32 + 8 * fq;
#pragma unroll
        for (int ai = 0; ai < 2; ++ai) {
            u32x4 zz[4][2];
#pragma unroll
            for (int m = 0; m < 4; ++m)
#pragma unroll
                for (int bj = 0; bj < 2; ++bj) zz[m][bj] = *(const u32x4*)(Z + (size_t)(row0 + ai * 128 + m * 16) * 1024 + col0 + bj * 128);
#pragma unroll
            for (int m = 0; m < 4; ++m) { const int row = row0 + ai * 128 + m * 16; float ss = 0.f;
#pragma unroll
                for (int bj = 0; bj < 2; ++bj) { const f32x4 v0 = acc[ai][bj][m][0], v1 = acc[ai][bj][m][1];
                    const u32x4 z4 = zz[m][bj];
                    float o[8];
                    o[0] = bf_lo(z4.x) * sigmoidf_(v0[0]); o[1] = bf_hi(z4.x) * sigmoidf_(v0[1]); o[2] = bf_lo(z4.y) * sigmoidf_(v0[2]); o[3] = bf_hi(z4.y) * sigmoidf_(v0[3]);
                    o[4] = bf_lo(z4.z) * sigmoidf_(v1[0]); o[5] = bf_hi(z4.z) * sigmoidf_(v1[1]); o[6] = bf_lo(z4.w) * sigmoidf_(v1[2]); o[7] = bf_hi(z4.w) * sigmoidf_(v1[3]);
#pragma unroll
                    for (int j = 0; j < 8; ++j) ss += o[j] * o[j];
                    u32x4 w; w.x = cvt_pk_bf16(o[0], o[1]); w.y = cvt_pk_bf16(o[2], o[3]); w.z = cvt_pk_bf16(o[4], o[5]); w.w = cvt_pk_bf16(o[6], o[7]);
                    *(u32x4*)(CAT + (size_t)row * DM + col0 + bj * 128) = w; }
                ss += __shfl_xor(ss, 16); ss += __shfl_xor(ss, 32);
                if (fq == 0) rowss[(size_t)row * 16 + u.pn * 4 + wc] = ss; }
        }
    }
};
struct OutSched : g8::StaticOrder {
    unsigned abase, bbase;
    __device__ __forceinline__ bool next(int i, g8::Unit& u) const {
        int pm, pn; if (!tile(i >> 1, pm, pn)) return false;
        const int half = i & 1;
        u.pm = __builtin_amdgcn_readfirstlane(pm); u.pn = __builtin_amdgcn_readfirstlane(pn); u.flags = half ? 0 : 1; u.aux = half;
        u.aoff = abase + (unsigned)u.pm * 256u * 4096u + (unsigned)half * 2048u; u.boff = bbase + (unsigned)u.pn * 256u * 4096u + (unsigned)half * (16u * 32768u); return true;
    }
    __device__ __forceinline__ void aoffs(const g8::Unit&, int R0, int C0, int R1, int C1, unsigned (&v)[2][2]) const {
        v[0][0] = (unsigned)(R0 * 2048 + C0) * 2u; v[0][1] = (unsigned)(R1 * 2048 + C1) * 2u;
        v[1][0] = (unsigned)((128 + R0) * 2048 + C0) * 2u; v[1][1] = (unsigned)((128 + R1) * 2048 + C1) * 2u;
    }
};
struct EpiOut {
    static constexpr bool PERM = true;
    const float* x; const float* mod; const float* rowss1; float* rowss2; bf16_t* X1;
    __device__ __forceinline__ void operator()(g8::Acc& acc, const g8::Unit& u, int wr, int wc, int fr, int fq) const {
        const int row0 = u.pm * 256 + wr * 64 + fr;
        if (u.aux == 0) {
#pragma unroll
            for (int ai = 0; ai < 2; ++ai)
#pragma unroll
                for (int m = 0; m < 4; ++m) { const f32x4* pp = (const f32x4*)(rowss1 + (size_t)(row0 + ai * 128 + m * 16) * 16);
                    const f32x4 p0 = pp[0], p1 = pp[1], p2 = pp[2], p3 = pp[3];
                    const float tot = (((p0[0] + p0[1]) + (p0[2] + p0[3])) + ((p1[0] + p1[1]) + (p1[2] + p1[3]))) + (((p2[0] + p2[1]) + (p2[2] + p2[3])) + ((p3[0] + p3[1]) + (p3[2] + p3[3])));
                    const float r = rsqrtf(tot * (1.0f / 1024.0f) + 1e-6f);
#pragma unroll
                    for (int bj = 0; bj < 2; ++bj)
#pragma unroll
                        for (int n = 0; n < 2; ++n) acc[ai][bj][m][n] *= r; }
            return;
        }
        const int col0 = u.pn * 256 + wc * 32 + 8 * fq;
        const int b = (u.pm * 256) >> 11;
        f32x4 gt[2][2];
#pragma unroll
        for (int bj = 0; bj < 2; ++bj)
#pragma unroll
            for (int n = 0; n < 2; ++n) gt[bj][n] = *(const f32x4*)(mod + (size_t)b * NMOD + 2 * DM + col0 + bj * 128 + n * 4);
#pragma unroll
        for (int am = 0; am < 4; ++am) {
            const int ai = am >> 1, m0 = (am & 1) * 2;
            f32x4 xv[2][2][2];
#pragma unroll
            for (int mm = 0; mm < 2; ++mm)
#pragma unroll
                for (int bj = 0; bj < 2; ++bj) { const size_t off = (size_t)(row0 + ai * 128 + (m0 + mm) * 16) * DM + col0 + bj * 128; xv[mm][bj][0] = *(const f32x4*)(x + off); xv[mm][bj][1] = *(const f32x4*)(x + off + 4); }
#pragma unroll
            for (int mm = 0; mm < 2; ++mm) { const int m = m0 + mm; const int row = row0 + ai * 128 + m * 16; float ss = 0.f;
#pragma unroll
                for (int bj = 0; bj < 2; ++bj) { const size_t off = (size_t)row * DM + col0 + bj * 128;
                    const f32x4 o0 = xv[mm][bj][0] + gt[bj][0] * acc[ai][bj][m][0], o1 = xv[mm][bj][1] + gt[bj][1] * acc[ai][bj][m][1];
                    ss += (o0[0] * o0[0] + o0[1] * o0[1]) + (o0[2] * o0[2] + o0[3] * o0[3]) + (o1[0] * o1[0] + o1[1] * o1[1]) + (o1[2] * o1[2] + o1[3] * o1[3]);
                    u32x4 w; w.x = cvt_pk_bf16(o0[0], o0[1]); w.y = cvt_pk_bf16(o0[2], o0[3]); w.z = cvt_pk_bf16(o1[0], o1[1]); w.w = cvt_pk_bf16(o1[2], o1[3]);
                    *(u32x4*)(X1 + off) = w; }
                ss += __shfl_xor(ss, 16); ss += __shfl_xor(ss, 32);
                if (fq == 0) rowss2[(size_t)row * 32 + u.pn * 4 + wc] = ss; }
        }
    }
};
struct MoeSched {
    const LAS int* tinfo; const LAS int* trows; int ntiles; int G, c; const int* list; unsigned abase, bbase; int mode;
    __device__ __forceinline__ bool next(int i, g8::Unit& u) const {
        int pn, ti;
        if ((G & 63) == 0) { const int x = c & 7, r = c >> 3, per = G >> 6;
            ti = (i * 8 + x) * per + (r >> 3); pn = r & 7; }
        else { const int L = i * G + c; pn = L & 7; ti = L >> 3; }
        if (ti >= ntiles) return false;
        const int inf = __builtin_amdgcn_readfirstlane(tinfo[ti]);
        const int e = inf & 255;
        u.pm = __builtin_amdgcn_readfirstlane(ti); u.pn = pn; u.flags = 0; u.aux = inf; u.aux2 = __builtin_amdgcn_readfirstlane(trows[ti]);
        if (mode == 0) { u.aoff = abase; u.boff = bbase + (unsigned)e * (2048u * 2048u) + (unsigned)pn * (256u * 2048u); }
        else { u.aoff = abase + (unsigned)ti * (256u * 1024u); u.boff = bbase + (unsigned)e * (2048u * 1024u) + (unsigned)pn * (256u * 1024u); }
        return true;
    }
    __device__ __forceinline__ void aoffs(const g8::Unit& u, int R0, int C0, int R1, int C1, unsigned (&v)[2][2]) const {
        if (mode == 0) {
            const int e = u.aux & 255, r0 = u.aux >> 8, n = u.aux2; const int* le = list + e * 16384 + r0;
            const int i00 = R0, i01 = R1, i10 = 128 + R0, i11 = 128 + R1;
            const int t00 = (i00 < n) ? (le[i00] >> 1) : 0, t01 = (i01 < n) ? (le[i01] >> 1) : 0, t10 = (i10 < n) ? (le[i10] >> 1) : 0, t11 = (i11 < n) ? (le[i11] >> 1) : 0;
            v[0][0] = (unsigned)(t00 * 2048 + C0 * 2); v[0][1] = (unsigned)(t01 * 2048 + C1 * 2); v[1][0] = (unsigned)(t10 * 2048 + C0 * 2); v[1][1] = (unsigned)(t11 * 2048 + C1 * 2);
        } else {
            v[0][0] = (unsigned)(R0 * 1024 + C0 * 2); v[0][1] = (unsigned)(R1 * 1024 + C1 * 2);
            v[1][0] = (unsigned)((128 + R0) * 1024 + C0 * 2); v[1][1] = (unsigned)((128 + R1) * 1024 + C1 * 2);
        }
    }
};
struct EpiMoe1 {
    static constexpr bool PERM = true;
    unsigned char* HM;
    __device__ __forceinline__ void operator()(g8::Acc& acc, const g8::Unit& u, int wr, int wc, int fr, int fq) const {
        const int row0 = u.pm * 256 + wr * 64 + fr, col0 = u.pn * 128 + wc * 32 + 8 * fq;
        const float inv = 1.0f / WGU_SCALE;
#pragma unroll
        for (int ai = 0; ai < 2; ++ai)
#pragma unroll
            for (int m = 0; m < 4; ++m) { float o[8];
#pragma unroll
                for (int n = 0; n < 2; ++n)
#pragma unroll
                    for (int j = 0; j < 4; ++j) { const float gv = acc[ai][0][m][n][j] * inv, uv = acc[ai][1][m][n][j] * inv; o[n * 4 + j] = gv * sigmoidf_(gv) * uv; }
                int q0 = 0, q1 = 0;
                q0 = __builtin_amdgcn_cvt_pk_fp8_f32(o[0], o[1], q0, false); q0 = __builtin_amdgcn_cvt_pk_fp8_f32(o[2], o[3], q0, true);
                q1 = __builtin_amdgcn_cvt_pk_fp8_f32(o[4], o[5], q1, false); q1 = __builtin_amdgcn_cvt_pk_fp8_f32(o[6], o[7], q1, true);
                *(u32x2*)(HM + (size_t)(row0 + ai * 128 + m * 16) * 1024 + col0) = (u32x2){(unsigned)q0, (unsigned)q1}; }
    }
};
struct EpiMoe2 {
    static constexpr bool PERM = true;
    const u32x2* slot; bf16_t* Y2;
    __device__ __forceinline__ void operator()(g8::Acc& acc, const g8::Unit& u, int wr, int wc, int fr, int fq) const {
        const int col0 = u.pn * 256 + wc * 32 + 8 * fq;
        u32x2 si[2][4];
#pragma unroll
        for (int ai = 0; ai < 2; ++ai)
#pragma unroll
            for (int m = 0; m < 4; ++m) si[ai][m] = slot[u.pm * 256 + ai * 128 + wr * 64 + m * 16 + fr];
#pragma unroll
        for (int ai = 0; ai < 2; ++ai)
#pragma unroll
            for (int m = 0; m < 4; ++m) { const int asg = (int)si[ai][m].x;
                if (asg >= 0) { bf16_t* rowp = Y2 + (size_t)asg * DM + col0; const float ww = __uint_as_float(si[ai][m].y);
#pragma unroll
                    for (int bj = 0; bj < 2; ++bj) { const f32x4 v0 = acc[ai][bj][m][0] * ww, v1 = acc[ai][bj][m][1] * ww;
                        u32x4 w; w.x = cvt_pk_bf16(v0[0], v0[1]); w.y = cvt_pk_bf16(v0[2], v0[3]); w.z = cvt_pk_bf16(v1[0], v1[1]); w.w = cvt_pk_bf16(v1[2], v1[3]);
                        *(u32x4*)(rowp + bj * 128) = w; } } }
    }
};

constexpr size_t WS_KV = WS_H;
__device__ __forceinline__ void ssm_item(const Params& P, LAS unsigned char* lds, int tid, int item) {
    const int g = item >> 2, bp = item & 3;
    const int wave = __builtin_amdgcn_readfirstlane(tid >> 6), lane = tid & 63, fr = lane & 15, fq = lane >> 4;
    const bf16_t* proj = (const bf16_t*)(P.ws + WS_PROJ);
    const bf16_t* Ms = (const bf16_t*)(P.ws + WS_SSMM) + (size_t)g * 131072;
    const bf16_t* TM = Ms + 32768;
    bf16_t* Zo = (bf16_t*)(P.ws + WS_Z);
    constexpr int ZS = 136, MS = 264, TS = 392;
    LAS bf16_t* ZB = (LAS bf16_t*)lds;
    LAS bf16_t* WB = (LAS bf16_t*)(lds + 256 * ZS * 2);
    const int b = 2 * bp + (wave >> 2);
    int tok0[2];
    bf16x8 Uf[2][8];
#pragma unroll
    for (int mt = 0; mt < 2; ++mt) {
        const int c = 32 * (wave & 3) + 16 * mt + fr; tok0[mt] = b * 2048 + c * 16;
#pragma unroll
        for (int ks = 0; ks < 8; ++ks) Uf[mt][ks] = *(const bf16x8*)(proj + (size_t)(tok0[mt] + 2 * ks + (fq >> 1)) * NPROJ + g * 16 + 8 * (fq & 1));
    }
#pragma unroll
    for (int i = 0; i < 8; ++i) { const int row = tid >> 2, kc = (tid & 3) + 4 * i; *(LAS u32x4*)(WB + row * MS + kc * 8) = *(const u32x4*)(Ms + row * 256 + kc * 8); }
    __syncthreads();
#pragma unroll
    for (int nt = 0; nt < 8; ++nt) {
        f32x4 a0 = {0.f, 0.f, 0.f, 0.f}, a1 = {0.f, 0.f, 0.f, 0.f};
#pragma unroll
        for (int ks = 0; ks < 8; ++ks) {
            const bf16x8 bf = *(const LAS bf16x8*)(WB + (16 * nt + fr) * MS + 32 * ks + 8 * fq);
            a0 = __builtin_amdgcn_mfma_f32_16x16x32_bf16(bf, Uf[0][ks], a0, 0, 0, 0);
            a1 = __builtin_amdgcn_mfma_f32_16x16x32_bf16(bf, Uf[1][ks], a1, 0, 0, 0);
        }
        *(LAS u32x2*)(ZB + (32 * wave + fr) * ZS + 16 * nt + 4 * fq) = (u32x2){cvt_pk_bf16(a0[0], a0[1]), cvt_pk_bf16(a0[2], a0[3])};
        *(LAS u32x2*)(ZB + (32 * wave + 16 + fr) * ZS + 16 * nt + 4 * fq) = (u32x2){cvt_pk_bf16(a1[0], a1[1]), cvt_pk_bf16(a1[2], a1[3])};
    }
    u32x4 tmr[6];
#pragma unroll
    for (int i = 0; i < 6; ++i) { const int row = tid >> 3, kc = (tid & 7) + 8 * i; tmr[i] = *(const u32x4*)(TM + (size_t)row * 384 + kc * 8); }
    __syncthreads();
    if (tid < 128) {
        const int bl = tid >> 6, p = tid & 63;
        const f32x2 al = ((const f32x2*)(P.ws + WS_SSMA))[g * 64 + p];
        float xr = 0.f, xi = 0.f;
        LAS unsigned* zw = (LAS unsigned*)ZB + (bl * 128) * (ZS / 2) + p;
        for (int c0 = 0; c0 < 128; c0 += 8) {
            unsigned zv[8];
#pragma unroll
            for (int k = 0; k < 8; ++k) zv[k] = zw[(c0 + k) * (ZS / 2)];
#pragma unroll
            for (int k = 0; k < 8; ++k) {
                zw[(c0 + k) * (ZS / 2)] = cvt_pk_bf16(xr, xi);
                const float t = al.x * xr - al.y * xi + bf_lo(zv[k]); xi = al.x * xi + al.y * xr + bf_hi(zv[k]); xr = t;
            }
        }
    }
#pragma unroll
    for (int i = 0; i < 6; ++i) { const int row = tid >> 3, kc = (tid & 7) + 8 * i; *(LAS u32x4*)(WB + row * TS + kc * 8) = tmr[i]; }
    __syncthreads();
    const LAS bf16_t* xrow = ZB + (32 * wave + fr) * ZS + 8 * fq;
    const f32x4 dv = *(const f32x4*)(P.in[12] + g * 16 + 4 * fq);
#pragma unroll
    for (int cq = 0; cq < 4; ++cq) {
        u32x2 uu[4][2];
#pragma unroll
        for (int ntl = 0; ntl < 4; ++ntl)
#pragma unroll
            for (int mt = 0; mt < 2; ++mt) uu[ntl][mt] = *(const u32x2*)(proj + (size_t)(tok0[mt] + 4 * cq + ntl) * NPROJ + g * 16 + 4 * fq);
        if (cq < 3) {
#pragma unroll
            for (int i = 0; i < 6; ++i) { const int row = tid >> 3, kc = (tid & 7) + 8 * i; tmr[i] = *(const u32x4*)(TM + (size_t)(64 * (cq + 1) + row) * 384 + kc * 8); }
        }
#pragma unroll
        for (int ntl = 0; ntl < 4; ++ntl) {
            const int nt = 4 * cq + ntl;
            f32x4 a0 = {0.f, 0.f, 0.f, 0.f}, a1 = {0.f, 0.f, 0.f, 0.f};
            const LAS bf16_t* brow = WB + (16 * ntl + fr) * TS + 8 * fq;
#pragma unroll
            for (int ks = 0; ks < 8; ++ks) {
                if (2 * ks <= nt) {
                    const bf16x8 bf = *(const LAS bf16x8*)(brow + 32 * ks);
                    a0 = __builtin_amdgcn_mfma_f32_16x16x32_bf16(bf, Uf[0][ks], a0, 0, 0, 0);
                    a1 = __builtin_amdgcn_mfma_f32_16x16x32_bf16(bf, Uf[1][ks], a1, 0, 0, 0);
                }
            }
#pragma unroll
            for (int k2 = 0; k2 < 4; ++k2) {
                const bf16x8 bf = *(const LAS bf16x8*)(brow + 256 + 32 * k2);
                const bf16x8 x0 = *(const LAS bf16x8*)(xrow + 32 * k2), x1 = *(const LAS bf16x8*)(xrow + 16 * ZS + 32 * k2);
                a0 = __builtin_amdgcn_mfma_f32_16x16x32_bf16(bf, x0, a0, 0, 0, 0);
                a1 = __builtin_amdgcn_mfma_f32_16x16x32_bf16(bf, x1, a1, 0, 0, 0);
            }
#pragma unroll
            for (int mt = 0; mt < 2; ++mt) {
                const f32x4 a = mt ? a1 : a0;
                const size_t tok = (size_t)(tok0[mt] + nt);
                const u32x2 u2 = uu[ntl][mt];
                const float y0 = a[0] + dv[0] * bf_lo(u2.x), y1 = a[1] + dv[1] * bf_hi(u2.x), y2 = a[2] + dv[2] * bf_lo(u2.y), y3 = a[3] + dv[3] * bf_hi(u2.y);
                u32x2 w; w.x = cvt_pk_bf16(gelu_tanh(y0), gelu_tanh(y1)); w.y = cvt_pk_bf16(gelu_tanh(y2), gelu_tanh(y3));
                *(u32x2*)(Zo + tok * 1024 + g * 16 + 4 * fq) = w;
            }
        }
        __syncthreads();
        if (cq < 3) {
#pragma unroll
            for (int i = 0; i < 6; ++i) { const int row = tid >> 3, kc = (tid & 7) + 8 * i; *(LAS u32x4*)(WB + row * TS + kc * 8) = tmr[i]; }
            __syncthreads();
        }
    }
}

__device__ __forceinline__ bf16x8 tr_frag(const LAS bf16_t* tile, int row0, int col0, int fr, int fq) {
    const LAS bf16_t* p = tile + (row0 + 8 * fq + (fr >> 2)) * 136 + col0 + 4 * (fr & 3);
    const bf16x4 a = __builtin_amdgcn_ds_read_tr16_b64_v4i16((LAS bf16x4*)p);
    const bf16x4 b = __builtin_amdgcn_ds_read_tr16_b64_v4i16((LAS bf16x4*)(p + 4 * 136));
    bf16x8 r; r[0] = a[0]; r[1] = a[1]; r[2] = a[2]; r[3] = a[3]; r[4] = b[0]; r[5] = b[1]; r[6] = b[2]; r[7] = b[3]; return r;
}
__device__ __forceinline__ void ret_kv_items(const Params& P, LAS unsigned char* lds, int tid, int first, int stride) {
    const int wave = __builtin_amdgcn_readfirstlane(tid >> 6), lane = tid & 63, fr = lane & 15, fq = lane >> 4;
    constexpr int RS = 136;
    LAS bf16_t* Ks = (LAS bf16_t*)lds; LAS bf16_t* Vs = Ks + 128 * RS;
    const bf16_t* proj = (const bf16_t*)(P.ws + WS_PROJ);
    bf16_t* KV = (bf16_t*)(P.ws + WS_KV);
    const int si = tid >> 2, part = tid & 3, i0 = 16 * wave;
    u32x4 kr[4], vr[4];
    int item = first;
    if (item >= 768) return;
    { const int bh = item / 12, n = item % 12; const bf16_t* pr = proj + ((size_t)(bh >> 3) * 2048 + n * 128 + si) * NPROJ + (bh & 7) * 128 + 32 * part;
#pragma unroll
      for (int j = 0; j < 4; ++j) { kr[j] = *(const u32x4*)(pr + 2048 + 8 * j); vr[j] = *(const u32x4*)(pr + 3072 + 8 * j); } }
    for (;;) {
#pragma unroll
        for (int j = 0; j < 4; ++j) { *(LAS u32x4*)(Ks + si * RS + 32 * part + 8 * j) = kr[j]; *(LAS u32x4*)(Vs + si * RS + 32 * part + 8 * j) = vr[j]; }
        __syncthreads();
        const int nxt = item + stride; const bool more = nxt < 768;
        if (more) { const int bh = nxt / 12, n = nxt % 12; const bf16_t* pr = proj + ((size_t)(bh >> 3) * 2048 + n * 128 + si) * NPROJ + (bh & 7) * 128 + 32 * part;
#pragma unroll
            for (int j = 0; j < 4; ++j) { kr[j] = *(const u32x4*)(pr + 2048 + 8 * j); vr[j] = *(const u32x4*)(pr + 3072 + 8 * j); } }
        bf16x8 Vt[4];
#pragma unroll
        for (int ks = 0; ks < 4; ++ks) Vt[ks] = tr_frag(Vs, 32 * ks, i0, fr, fq);
        const int bh = item / 12, n = item % 12;
        bf16_t* op = KV + ((size_t)(bh * 16 + n) * 128 + i0 + fr) * 128 + 4 * fq;
#pragma unroll
        for (int nt = 0; nt < 8; ++nt) {
            f32x4 a = {0.f, 0.f, 0.f, 0.f};
#pragma unroll
            for (int ks = 0; ks < 4; ++ks) { const bf16x8 kf = tr_frag(Ks, 32 * ks, 16 * nt, fr, fq); a = __builtin_amdgcn_mfma_f32_16x16x32_bf16(kf, Vt[ks], a, 0, 0, 0); }
            *(u32x2*)(op + 16 * nt) = (u32x2){cvt_pk_bf16(a[0], a[1]), cvt_pk_bf16(a[2], a[3])};
        }
        __syncthreads();
        if (!more) break;
        item = nxt;
    }
}
__device__ __forceinline__ void ret_out_item(const Params& P, LAS unsigned char* lds, int tid, int item) {
    const int bh = item >> 2, q = item & 3, b = bh >> 3, h = bh & 7;
    const int wave = __builtin_amdgcn_readfirstlane(tid >> 6), lane = tid & 63, fr = lane & 15, fq = lane >> 4;
    constexpr int RS = 136;
    LAS bf16_t* Qs = (LAS bf16_t*)lds;
    LAS bf16_t* Ks = Qs + 128 * RS;
    LAS bf16_t* Vs = Ks + 128 * RS;
    LAS bf16_t* Rs = Vs + 128 * RS;
    const bf16_t* proj = (const bf16_t*)(P.ws + WS_PROJ);
    const bf16_t* KV = (const bf16_t*)(P.ws + WS_KV);
    bf16_t* CAT = (bf16_t*)(P.ws + WS_CAT);
    const float gam = 1.0f - exp2f(-5.0f - (float)h);
    const float lg2 = log2f(gam);
    const float gC1 = exp2f(lg2 * 127.0f), gC = exp2f(lg2 * 128.0f);
    const int si = tid >> 2, part = tid & 3, i0 = 16 * wave;
    u32x4 st[12];
    { const bf16_t* pr = proj + ((size_t)b * 2048 + (4 * q) * 128 + si) * NPROJ + h * 128 + 32 * part;
#pragma unroll
      for (int j = 0; j < 4; ++j) { st[j] = *(const u32x4*)(pr + 1024 + 8 * j); st[4 + j] = *(const u32x4*)(pr + 2048 + 8 * j); st[8 + j] = *(const u32x4*)(pr + 3072 + 8 * j); } }
    f32x4 accR[8];
#pragma unroll
    for (int nt = 0; nt < 8; ++nt) accR[nt] = (f32x4){0.f, 0.f, 0.f, 0.f};
    for (int m = 0; m < 4 * q; ++m) {
        const bf16_t* tp = KV + ((size_t)(bh * 16 + m) * 128 + i0 + fr) * 128 + 4 * fq;
        u32x2 t[8];
#pragma unroll
        for (int nt = 0; nt < 8; ++nt) t[nt] = *(const u32x2*)(tp + 16 * nt);
#pragma unroll
        for (int nt = 0; nt < 8; ++nt) { const f32x4 kv = {bf_lo(t[nt].x), bf_hi(t[nt].x), bf_lo(t[nt].y), bf_hi(t[nt].y)}; accR[nt] = accR[nt] * gC + kv * gC1; }
    }
#pragma unroll
    for (int nt = 0; nt < 8; ++nt)
        *(LAS u32x2*)(Rs + (i0 + fr) * RS + 16 * nt + 4 * fq) = (u32x2){cvt_pk_bf16(accR[nt][0], accR[nt][1]), cvt_pk_bf16(accR[nt][2], accR[nt][3])};
    for (int nn = 0; nn < 4; ++nn) {
        const int n = 4 * q + nn;
#pragma unroll
        for (int j = 0; j < 4; ++j) { *(LAS u32x4*)(Qs + si * RS + 32 * part + 8 * j) = st[j]; *(LAS u32x4*)(Ks + si * RS + 32 * part + 8 * j) = st[4 + j]; *(LAS u32x4*)(Vs + si * RS + 32 * part + 8 * j) = st[8 + j]; }
        __syncthreads();
        if (nn < 3) { const bf16_t* pr = proj + ((size_t)b * 2048 + (n + 1) * 128 + si) * NPROJ + h * 128 + 32 * part;
#pragma unroll
            for (int j = 0; j < 4; ++j) { st[j] = *(const u32x4*)(pr + 1024 + 8 * j); st[4 + j] = *(const u32x4*)(pr + 2048 + 8 * j); st[8 + j] = *(const u32x4*)(pr + 3072 + 8 * j); } }
        const size_t tok = (size_t)b * 2048 + n * 128 + i0 + fr;
        u32x2 gg[8];
        { const bf16_t* gp = proj + tok * NPROJ + 4096 + h * 128 + 4 * fq;
#pragma unroll
          for (int nt = 0; nt < 8; ++nt) gg[nt] = *(const u32x2*)(gp + 16 * nt); }
        bf16x8 Qf[4];
#pragma unroll
        for (int ks = 0; ks < 4; ++ks) Qf[ks] = *(const LAS bf16x8*)(Qs + (i0 + fr) * RS + 32 * ks + 8 * fq);
        f32x4 accS[8], accO[8];
#pragma unroll
        for (int nt = 0; nt < 8; ++nt) { accS[nt] = (f32x4){0.f, 0.f, 0.f, 0.f}; accO[nt] = (f32x4){0.f, 0.f, 0.f, 0.f}; }
#pragma unroll
        for (int nt = 0; nt < 8; ++nt) {
            if (nt <= wave) {
#pragma unroll
                for (int ks = 0; ks < 4; ++ks) { const bf16x8 kf = *(const LAS bf16x8*)(Ks + (16 * nt + fr) * RS + 32 * ks + 8 * fq); accS[nt] = __builtin_amdgcn_mfma_f32_16x16x32_bf16(kf, Qf[ks], accS[nt], 0, 0, 0); }
            }
        }
        if (n > 0) {
#pragma unroll
            for (int nt = 0; nt < 8; ++nt) {
#pragma unroll
                for (int ks = 0; ks < 4; ++ks) { const bf16x8 rf = *(const LAS bf16x8*)(Rs + (16 * nt + fr) * RS + 32 * ks + 8 * fq); accO[nt] = __builtin_amdgcn_mfma_f32_16x16x32_bf16(rf, Qf[ks], accO[nt], 0, 0, 0); }
                accO[nt] *= gam;
            }
        }
#pragma unroll
        for (int nt = 0; nt < 8; ++nt) {
            const int i = i0 + fr, j0 = 16 * nt + 4 * fq;
            const float p0 = (j0 <= i) ? accS[nt][0] : 0.f, p1 = (j0 + 1 <= i) ? accS[nt][1] : 0.f, p2 = (j0 + 2 <= i) ? accS[nt][2] : 0.f, p3 = (j0 + 3 <= i) ? accS[nt][3] : 0.f;
            *(LAS u32x2*)(Qs + i * RS + j0) = (u32x2){cvt_pk_bf16(p0, p1), cvt_pk_bf16(p2, p3)};
        }
        asm volatile("" ::: "memory");
        bf16x8 Pf[4];
#pragma unroll
        for (int ks = 0; ks < 4; ++ks) Pf[ks] = *(const LAS bf16x8*)(Qs + (i0 + fr) * RS + 32 * ks + 8 * fq);
#pragma unroll
        for (int ks = 0; ks < 4; ++ks) {
            if (2 * ks <= wave) {
#pragma unroll
                for (int nt = 0; nt < 8; ++nt) { const bf16x8 vf = tr_frag(Vs, 32 * ks, 16 * nt, fr, fq); accO[nt] = __builtin_amdgcn_mfma_f32_16x16x32_bf16(vf, Pf[ks], accO[nt], 0, 0, 0); }
            }
        }
        if (nn < 3) {
            bf16x8 Vt[4];
#pragma unroll
            for (int ks = 0; ks < 4; ++ks) Vt[ks] = tr_frag(Vs, 32 * ks, i0, fr, fq);
#pragma unroll
            for (int nt = 0; nt < 8; ++nt) {
                accR[nt] *= gam;
#pragma unroll
                for (int ks = 0; ks < 4; ++ks) { const bf16x8 kf = tr_frag(Ks, 32 * ks, 16 * nt, fr, fq); accR[nt] = __builtin_amdgcn_mfma_f32_16x16x32_bf16(kf, Vt[ks], accR[nt], 0, 0, 0); }
                accR[nt] *= gC1;
            }
        }
        {
            float s = 0.f;
#pragma unroll
            for (int nt = 0; nt < 8; ++nt) s += (accO[nt][0] + accO[nt][1]) + (accO[nt][2] + accO[nt][3]);
            s += __shfl_xor(s, 16); s += __shfl_xor(s, 32);
            const float mu = s * (1.0f / 128.0f); float qv = 0.f;
#pragma unroll
            for (int nt = 0; nt < 8; ++nt) { const f32x4 d = accO[nt] - mu; qv += (d[0] * d[0] + d[1] * d[1]) + (d[2] * d[2] + d[3] * d[3]); }
            qv += __shfl_xor(qv, 16); qv += __shfl_xor(qv, 32);
            const float rstd = rsqrtf(qv * (1.0f / 128.0f) + 1e-5f);
            bf16_t* op = CAT + tok * DM + 1024 + h * 128 + 4 * fq;
#pragma unroll
            for (int nt = 0; nt < 8; ++nt) {
                const float g0 = bf_lo(gg[nt].x), g1 = bf_hi(gg[nt].x), g2 = bf_lo(gg[nt].y), g3 = bf_hi(gg[nt].y);
                const f32x4 y = (accO[nt] - mu) * rstd;
                u32x2 w; w.x = cvt_pk_bf16(y[0] * g0 * sigmoidf_(g0), y[1] * g1 * sigmoidf_(g1)); w.y = cvt_pk_bf16(y[2] * g2 * sigmoidf_(g2), y[3] * g3 * sigmoidf_(g3));
                *(u32x2*)(op + 16 * nt) = w;
            }
        }
        __syncthreads();
        if (nn < 3) {
#pragma unroll
            for (int nt = 0; nt < 8; ++nt)
                *(LAS u32x2*)(Rs + (i0 + fr) * RS + 16 * nt + 4 * fq) = (u32x2){cvt_pk_bf16(accR[nt][0], accR[nt][1]), cvt_pk_bf16(accR[nt][2], accR[nt][3])};
        }
    }
}

__device__ __forceinline__ void p6_route(const Params& P, LAS unsigned char* lds, int tid, int blk, int G) {
    const int wave = __builtin_amdgcn_readfirstlane(tid >> 6), lane = tid & 63, fr = lane & 15, fq = lane >> 4;
    LAS float* gm = (LAS float*)lds; LAS float* sh = gm + 2048; LAS float* lg = sh + 2048;
    LAS float* lgr = lg + 8 * 64 * 48;
    LAS float* r2s = lgr + 64 * 36;
    LAS int* lcnt = (LAS int*)(r2s + 64); LAS int* lbase = lcnt + 32;
    int ra_ = 0, rb_ = 0, ea_ = 0, eb_ = 0; float w1_ = 0.f, w2_ = 0.f;
    const float* mod = (const float*)(P.ws + WS_MOD);
    const bf16_t* x1 = (const bf16_t*)(P.ws + WS_X1); const float* rowss2 = (const float*)(P.ws + WS_ROWSS2);
    unsigned char* H2 = P.ws + WS_H;
    const bf16_t* WR = (const bf16_t*)(P.ws + WS_WR);
    int* cnt = (int*)(P.ws + WS_CNT); int* list = (int*)(P.ws + WS_LIST); float* wgt = (float*)(P.ws + WS_WGT);
    for (int rb = blk; rb < 256; rb += G) {
        const int b = rb >> 5;
        for (int k = tid; k < 2048; k += NTHREADS) { gm[k] = P.in[18][k] * (1.0f + mod[(size_t)b * NMOD + 4 * DM + k]); sh[k] = mod[(size_t)b * NMOD + 3 * DM + k]; }
        if (tid < 32) lcnt[tid] = 0;
        if (tid >= 64 && tid < 128) { const int r = tid - 64; float tot2 = 0.f; const f32x4* pp = (const f32x4*)(rowss2 + (size_t)(rb * 64 + r) * 32);
#pragma unroll
            for (int i = 0; i < 8; ++i) { const f32x4 v = pp[i]; tot2 += (v[0] + v[1]) + (v[2] + v[3]); }
            r2s[r] = rsqrtf(tot2 * (1.0f / 2048.0f) + 1e-6f); }
        __syncthreads();
        float r2v[4];
#pragma unroll
        for (int mt = 0; mt < 4; ++mt) r2v[mt] = r2s[16 * mt + fr];
        f32x4 acc[4][3];
#pragma unroll
        for (int mt = 0; mt < 4; ++mt)
#pragma unroll
            for (int nt = 0; nt < 3; ++nt) acc[mt][nt] = (f32x4){0.f, 0.f, 0.f, 0.f};
        const bf16_t* xb = x1 + (size_t)(rb * 64 + fr) * DM + 256 * wave + 8 * fq;
        const bf16_t* wb = WR + (size_t)fr * 2048 + 256 * wave + 8 * fq;
        unsigned char* hb = H2 + (size_t)(rb * 64 + fr) * DM + 256 * wave + 8 * fq;
        u32x4 xc[2][4], xn[2][4]; bf16x8 bc[2][3], bn[2][3];
#pragma unroll
        for (int j = 0; j < 2; ++j) {
#pragma unroll
            for (int mt = 0; mt < 4; ++mt) xc[j][mt] = *(const u32x4*)(xb + (size_t)(16 * mt) * DM + 32 * j);
#pragma unroll
            for (int nt = 0; nt < 3; ++nt) bc[j][nt] = *(const bf16x8*)(wb + (size_t)(16 * nt) * 2048 + 32 * j); }
#pragma unroll 1
        for (int qt = 0; qt < 4; ++qt) {
            const int qn = qt < 3 ? qt + 1 : 3;
#pragma unroll
            for (int j = 0; j < 2; ++j) {
#pragma unroll
                for (int mt = 0; mt < 4; ++mt) xn[j][mt] = *(const u32x4*)(xb + (size_t)(16 * mt) * DM + 32 * (2 * qn + j));
#pragma unroll
                for (int nt = 0; nt < 3; ++nt) bn[j][nt] = *(const bf16x8*)(wb + (size_t)(16 * nt) * 2048 + 32 * (2 * qn + j)); }
#pragma unroll
            for (int j = 0; j < 2; ++j) {
                const int kl = 256 * wave + 32 * (2 * qt + j) + 8 * fq;
                const f32x4 g0 = *(const LAS f32x4*)(gm + kl), g1 = *(const LAS f32x4*)(gm + kl + 4), s0 = *(const LAS f32x4*)(sh + kl), s1 = *(const LAS f32x4*)(sh + kl + 4);
#pragma unroll
                for (int mt = 0; mt < 4; ++mt) {
                    const u32x4 xw = xc[j][mt];
                    const f32x4 a = {bf_lo(xw.x), bf_hi(xw.x), bf_lo(xw.y), bf_hi(xw.y)}, c = {bf_lo(xw.z), bf_hi(xw.z), bf_lo(xw.w), bf_hi(xw.w)};
                    const f32x4 h0 = a * r2v[mt] * g0 + s0, h1 = c * r2v[mt] * g1 + s1;
                    u32x4 w; w.x = cvt_pk_bf16(h0[0], h0[1]); w.y = cvt_pk_bf16(h0[2], h0[3]); w.z = cvt_pk_bf16(h1[0], h1[1]); w.w = cvt_pk_bf16(h1[2], h1[3]);
                    int q0 = 0, q1 = 0;
                    q0 = __builtin_amdgcn_cvt_pk_fp8_f32(h0[0], h0[1], q0, false); q0 = __builtin_amdgcn_cvt_pk_fp8_f32(h0[2], h0[3], q0, true);
                    q1 = __builtin_amdgcn_cvt_pk_fp8_f32(h1[0], h1[1], q1, false); q1 = __builtin_amdgcn_cvt_pk_fp8_f32(h1[2], h1[3], q1, true);
                    *(u32x2*)(hb + (size_t)(16 * mt) * DM + 32 * (2 * qt + j)) = (u32x2){(unsigned)q0, (unsigned)q1};
                    const bf16x8 af = __builtin_bit_cast(bf16x8, w);
#pragma unroll
                    for (int nt = 0; nt < 3; ++nt) acc[mt][nt] = __builtin_amdgcn_mfma_f32_16x16x32_bf16(bc[j][nt], af, acc[mt][nt], 0, 0, 0);
                }
            }
#pragma unroll
            for (int j = 0; j < 2; ++j) {
#pragma unroll
                for (int mt = 0; mt < 4; ++mt) xc[j][mt] = xn[j][mt];
#pragma unroll
                for (int nt = 0; nt < 3; ++nt) bc[j][nt] = bn[j][nt]; }
        }
#pragma unroll
        for (int mt = 0; mt < 4; ++mt)
#pragma unroll
            for (int nt = 0; nt < 3; ++nt) *(LAS f32x4*)(lg + (wave * 64 + 16 * mt + fr) * 48 + 16 * nt + 4 * fq) = acc[mt][nt];
        __syncthreads();
        for (int o = tid; o < 64 * 36; o += NTHREADS) { const int r = o / 36, nn = o % 36; float sum = 0.f;
#pragma unroll
            for (int w = 0; w < 8; ++w) sum += lg[(w * 64 + r) * 48 + nn];
            lgr[o] = sum; }
        __syncthreads();
        if (tid < 64) {
            const int tok = rb * 64 + tid;
            float l[36];
#pragma unroll
            for (int nn = 0; nn < 36; ++nn) l[nn] = lgr[tid * 36 + nn];
            float gl[4]; int gs = 0;
#pragma unroll
            for (int j = 0; j < 4; ++j) gl[j] = l[j] + P.in[20][j];
#pragma unroll
            for (int j = 1; j < 4; ++j) if (gl[j] > gl[gs]) gs = j;
            float gmax = gl[0];
#pragma unroll
            for (int j = 1; j < 4; ++j) gmax = fmaxf(gmax, gl[j]);
            float den = 0.f;
#pragma unroll
            for (int j = 0; j < 4; ++j) den += expf(gl[j] - gmax);
            const float gw = 1.0f / den;
            float el[8];
#pragma unroll
            for (int j = 0; j < 8; ++j) { float v = 0.f;
#pragma unroll
                for (int q = 0; q < 4; ++q) v = (gs == q) ? (l[4 + q * 8 + j] + P.in[22][q * 8 + j]) : v;
                el[j] = v; }
            int j1 = 0;
#pragma unroll
            for (int j = 1; j < 8; ++j) if (el[j] > el[j1]) j1 = j;
            int j2 = (j1 == 0) ? 1 : 0;
#pragma unroll
            for (int j = 0; j < 8; ++j) if (j != j1 && j != j2 && el[j] > el[j2]) j2 = j;
            float e1 = el[0], e2 = el[0];
#pragma unroll
            for (int j = 0; j < 8; ++j) { e1 = (j == j1) ? el[j] : e1; e2 = (j == j2) ? el[j] : e2; }
            const float t2 = expf(e2 - e1), w1 = gw / (1.0f + t2), w2 = gw * t2 / (1.0f + t2);
            const int ea = gs * 8 + j1, eb = gs * 8 + j2;
            ra_ = atomicAdd((int*)&lcnt[ea], 1); rb_ = atomicAdd((int*)&lcnt[eb], 1); ea_ = ea; eb_ = eb; w1_ = w1; w2_ = w2;
        }
        __syncthreads();
        if (tid < 32) { const int c = lcnt[tid]; lbase[tid] = c > 0 ? atomicAdd(cnt + tid * 64, c) : 0; }
        __syncthreads();
        if (tid < 64) {
            const int tok = rb * 64 + tid;
            list[ea_ * 16384 + lbase[ea_] + ra_] = tok * 2; wgt[tok * 2] = w1_;
            list[eb_ * 16384 + lbase[eb_] + rb_] = tok * 2 + 1; wgt[tok * 2 + 1] = w2_;
        }
        __syncthreads();
    }
}

__device__ __forceinline__ void p9_final(const Params& P, int tid, int blk, int G) {
    const int wave = tid >> 6, lane = tid & 63;
    const float* mod = (const float*)(P.ws + WS_MOD); const bf16_t* Y2 = (const bf16_t*)(P.ws + WS_Y2); const bf16_t* X1 = (const bf16_t*)(P.ws + WS_X1);
    f32x4 gf[8];
#pragma unroll
    for (int i = 0; i < 8; ++i) gf[i] = *(const f32x4*)(P.in[26] + (i * 64 + lane) * 4);
    int row = blk * 8 + wave;
    u32x2 xw[8], ya[8], yb[8], xwn[8], yan[8], ybn[8];
    if (row < NTOK) {
#pragma unroll
        for (int i = 0; i < 8; ++i) { const int k = (i * 64 + lane) * 4; xw[i] = *(const u32x2*)(X1 + (size_t)row * DM + k); ya[i] = *(const u32x2*)(Y2 + (size_t)(2 * row) * DM + k); yb[i] = *(const u32x2*)(Y2 + (size_t)(2 * row + 1) * DM + k); }
    }
    for (; row < NTOK; row += G * 8) {
        const int b = row >> 11, rown = row + G * 8;
        if (rown < NTOK) {
#pragma unroll
            for (int i = 0; i < 8; ++i) { const int k = (i * 64 + lane) * 4; xwn[i] = *(const u32x2*)(X1 + (size_t)rown * DM + k); yan[i] = *(const u32x2*)(Y2 + (size_t)(2 * rown) * DM + k); ybn[i] = *(const u32x2*)(Y2 + (size_t)(2 * rown + 1) * DM + k); }
        }
        f32x4 v[8]; float ss = 0.f;
#pragma unroll
        for (int i = 0; i < 8; ++i) {
            const int k = (i * 64 + lane) * 4;
            const f32x4 xv = {bf_lo(xw[i].x), bf_hi(xw[i].x), bf_lo(xw[i].y), bf_hi(xw[i].y)};
            const f32x4 gt = *(const f32x4*)(mod + (size_t)b * NMOD + 5 * DM + k);
            f32x4 y; y[0] = bf_lo(ya[i].x) + bf_lo(yb[i].x); y[1] = bf_hi(ya[i].x) + bf_hi(yb[i].x); y[2] = bf_lo(ya[i].y) + bf_lo(yb[i].y); y[3] = bf_hi(ya[i].y) + bf_hi(yb[i].y);
            v[i] = xv + gt * y;
            ss += v[i][0] * v[i][0] + v[i][1] * v[i][1] + v[i][2] * v[i][2] + v[i][3] * v[i][3];
        }
        ss = wave_sum(ss);
        const float r = rsqrtf(ss * (1.0f / 2048.0f) + 1e-6f);
        float* xr = P.out + (size_t)row * DM;
#pragma unroll
        for (int i = 0; i < 8; ++i) { const int k = (i * 64 + lane) * 4; *(f32x4*)(xr + k) = v[i] * r * gf[i]; }
#pragma unroll
        for (int i = 0; i < 8; ++i) { xw[i] = xwn[i]; ya[i] = yan[i]; yb[i] = ybn[i]; }
    }
}

__global__ void __launch_bounds__(NTHREADS, 2) hymba_fwd(Params P) {
    extern __shared__ __attribute__((aligned(16))) unsigned char lds_raw[];
    LAS unsigned char* lds = (LAS unsigned char*)lds_raw;
    const int tid = threadIdx.x, blk = blockIdx.x, G = gridDim.x;
    volatile LAS unsigned* misc = (volatile LAS unsigned*)(lds + LDS_MISC);
    if (tid < 64) misc[tid] = 0u;
    __syncthreads();
    XcdBarrier bar = xcd_barrier_post((unsigned*)(P.ws + WS_BAR), misc);
    const int lo = P.ph_lo, hi = P.ph_hi;
#define IN(k) (lo <= (k) && (k) < hi)
#define SEAM(k) do { if (IN(k) && IN((k) + 1)) xcd_barrier(bar); } while (0)
    unsigned char* ws = P.ws;

#ifndef REPR
#define REPR 1
#endif
#ifndef REPS
#define REPS 1
#endif
#ifndef REP0
#define REP0 1
#endif
#ifndef REP2
#define REP2 1
#endif
#ifndef REP7
#define REP7 1
#endif
#ifndef REP8
#define REP8 1
#endif
    if (IN(0)) for (int rep0 = 0; rep0 < REP0; ++rep0) {
        for (int it = blk; it < 256; it += G) p0_adaln(P, lds, tid, it);
        for (int it = blk; it < 256; it += G) p0_ssm_mats(P, lds, tid, it);
        p0_misc(P, tid, blk, G);
        p0_convert(P, lds, tid, blk, G);
    }
    SEAM(0);
    if (IN(1)) p1_norm1(P, lds, tid, blk, G);
    SEAM(1);
    if (IN(2)) for (int rep2 = 0; rep2 < REP2; ++rep2) {
        DenseSched S; S.init(NTOK, NPROJ, G, blk); S.abase = (unsigned)WS_H; S.bbase = (unsigned)WS_WIN; S.lda = DM; S.ldb = DM;
        EpiInProj E{(bf16_t*)(ws + WS_PROJ)};
        g8::gemm_phase(lds, ws, DM / 64, DM, S, E);
    }
    SEAM(2);
    if (IN(3)) {
        for (int it = blk; it < 256; it += G) ssm_item(P, lds, tid, it);
        ret_kv_items(P, lds, tid, blk, G);
    }
    SEAM(3);
    if (IN(4)) {
        for (int it = blk; it < 256; it += G) ret_out_item(P, lds, tid, it);
        __syncthreads();
        DenseSched S; S.init(NTOK, 1024, G, blk); S.abase = (unsigned)WS_Z; S.bbase = (unsigned)WS_WGLU; S.lda = 1024; S.ldb = 1024;
        EpiGlu E{(const bf16_t*)(ws + WS_Z), (bf16_t*)(ws + WS_CAT), (float*)(ws + WS_ROWSS1)};
        g8::gemm_phase(lds, ws, 1024 / 64, 1024, S, E);
    }
    SEAM(4);
    if (IN(5)) {
        OutSched S; S.init(NTOK, DM, G, blk); S.abase = (unsigned)WS_CAT; S.bbase = (unsigned)WS_WOUT;
        EpiOut E{P.in[0], (const float*)(ws + WS_MOD), (const float*)(ws + WS_ROWSS1), (float*)(ws + WS_ROWSS2), (bf16_t*)(ws + WS_X1)};
        g8::gemm_phase(lds, ws, 1024 / 64, DM, S, E);
    }
    SEAM(5);
    if (IN(6)) { p6_route(P, lds, tid, blk, G); p0_convert_fp8(P, lds, tid, blk, G, 0, 8192); }
    SEAM(6);
    if (IN(7) || IN(8)) {
        LAS int* tinfo = (LAS int*)(lds + LDS_MISC + 256); LAS int* trows = tinfo + 192; LAS int* ntl = trows + 192;
        if (tid == 0) {
            const int* cg = (const int*)(ws + WS_CNT); int nt_ = 0;
            for (int e = 0; e < 32; ++e) { const int c = cg[e * 64], full = c >> 8, rem = c & 255;
                for (int t = 0; t < full; ++t) { tinfo[nt_] = e | ((t * 256) << 8); trows[nt_] = 256; ++nt_; }
                if (rem > 128) { tinfo[nt_] = e | ((full * 256) << 8); trows[nt_] = rem; ++nt_; } }
            for (int e = 0; e < 32; ++e) { const int c = cg[e * 64], full = c >> 8, rem = c & 255; if (rem > 64 && rem <= 128) { tinfo[nt_] = e | ((full * 256) << 8); trows[nt_] = rem; ++nt_; } }
            for (int e = 0; e < 32; ++e) { const int c = cg[e * 64], full = c >> 8, rem = c & 255; if (rem > 0 && rem <= 64) { tinfo[nt_] = e | ((full * 256) << 8); trows[nt_] = rem; ++nt_; } }
            ntl[0] = nt_;
        }
        __syncthreads();
        const int ntiles = __builtin_amdgcn_readfirstlane(ntl[0]);
        if (IN(7)) {
            { u32x2* slot = (u32x2*)(ws + WS_SLOT); const int* lst = (const int*)(ws + WS_LIST); const float* wg = (const float*)(ws + WS_WGT);
              for (int ti = blk; ti < ntiles; ti += G) if (tid < 256) {
                  const int inf = tinfo[ti], e = inf & 255, r0 = inf >> 8, n = trows[ti];
                  u32x2 v; v.x = 0xffffffffu; v.y = 0u;
                  if (tid < n) { const int asg = lst[e * 16384 + r0 + tid]; v.x = (unsigned)asg; v.y = __float_as_uint(wg[asg] * (1.0f / WD_SCALE)); }
                  slot[ti * 256 + tid] = v; } }
            MoeSched S{tinfo, trows, ntiles, G, blk, (const int*)(ws + WS_LIST), (unsigned)WS_H, (unsigned)WS_WGU, 0};
            EpiMoe1 E{ws + WS_HM};
            g8::gemm_phase<EpiMoe1, MoeSched, true, 2>(lds, ws, DM / 128, DM, S, E);
            p0_convert_fp8(P, lds, tid, blk, G, 8192, 12288);
        }
        SEAM(7);
        if (IN(8)) {
            MoeSched S{tinfo, trows, ntiles, G, blk, (const int*)(ws + WS_LIST), (unsigned)WS_HM, (unsigned)WS_WD, 1};
            EpiMoe2 E{(const u32x2*)(ws + WS_SLOT), (bf16_t*)(ws + WS_Y2)};
            g8::gemm_phase<EpiMoe2, MoeSched, true, 2>(lds, ws, DEXP / 128, DEXP, S, E);
        }
    }
    SEAM(8);
    if (IN(9)) p9_final(P, tid, blk, G);
#undef IN
#undef SEAM
}

#ifndef N_LAUNCH_SPLIT
#define N_LAUNCH_SPLIT 0
#endif
extern "C" void kernel_launch(void* const* d_in, const int* in_sizes, int n_in, void* d_out, int out_size, void* d_ws, size_t ws_size, hipStream_t stream) {
    static int grid = 0;
    if (grid == 0) {
        if (n_in != 27 || out_size != NTOK * DM || ws_size < WS_END) { fprintf(stderr, "kernel_launch: unexpected shapes (n_in %d out %d ws %zu need %zu)\n", n_in, out_size, ws_size, (size_t)WS_END); grid = -1; return; }
        int dev = 0, cus = 0, per_cu = 0;
        if (hipGetDevice(&dev) != hipSuccess || hipDeviceGetAttribute(&cus, hipDeviceAttributeMultiprocessorCount, dev) != hipSuccess) { grid = -1; return; }
        if (hipFuncSetAttribute((const void*)hymba_fwd, hipFuncAttributeMaxDynamicSharedMemorySize, LDS_BYTES) != hipSuccess) { fprintf(stderr, "kernel_launch: hipFuncSetAttribute failed\n"); grid = -1; return; }
        if (hipOccupancyMaxActiveBlocksPerMultiprocessor(&per_cu, (const void*)hymba_fwd, NTHREADS, LDS_BYTES) != hipSuccess || per_cu < 1) { fprintf(stderr, "kernel_launch: occupancy query says %d\n", per_cu); }
        (void)hipGetLastError();
        grid = cus;
    }
    if (grid < 0) return;
    (void)hipMemsetAsync((char*)d_ws + WS_BAR, 0, 16384, stream);
    Params p{};
    for (int i = 0; i < 27; ++i) p.in[i] = (const float*)d_in[i];
    p.out = (float*)d_out; p.ws = (unsigned char*)d_ws;
#if N_LAUNCH_SPLIT
    for (int ph = 0; ph < 10; ++ph) { p.ph_lo = ph; p.ph_hi = ph + 1; hipLaunchKernelGGL(hymba_fwd, dim3(grid), dim3(NTHREADS), LDS_BYTES, stream, p); }
#else
    p.ph_lo = 0; p.ph_hi = 10;
    hipLaunchKernelGGL(hymba_fwd, dim3(grid), dim3(NTHREADS), LDS_BYTES, stream, p);
#endif
    const hipError_t le = hipPeekAtLastError();
    if (le != hipSuccess) fprintf(stderr, "kernel_launch: launch failed: %s\n", hipGetErrorName(le));
}
```

```cpp
#include <hip/hip_runtime.h>
#include <cstdio>
#include <cstdint>

#define LAS __attribute__((address_space(3)))
typedef unsigned short bf16_t;
typedef short bf16x8 __attribute__((ext_vector_type(8)));
typedef short bf16x4 __attribute__((ext_vector_type(4)));
typedef float f32x4 __attribute__((ext_vector_type(4)));
typedef float f32x2 __attribute__((ext_vector_type(2)));
typedef unsigned u32x4 __attribute__((ext_vector_type(4)));
typedef unsigned u32x2 __attribute__((ext_vector_type(2)));

constexpr int DM = 2048, NB = 8, SEQ = 2048, NTOK = NB * SEQ;
constexpr int NPROJ = 5120;
constexpr int NMOD = 6 * DM;
constexpr int NEXP = 32, DEXP = 1024;
constexpr int NTHREADS = 512;

constexpr size_t WS_BAR   = 0;
constexpr size_t WS_CNT   = 16384;
constexpr size_t WS_ROWSS1= WS_CNT + 8192;
constexpr size_t WS_ROWSS2= WS_ROWSS1 + (size_t)16384 * 16 * 4;
constexpr size_t WS_MODP  = WS_ROWSS2 + (size_t)16384 * 32 * 4;
constexpr size_t WS_MOD   = WS_MODP + (size_t)4 * 8 * NMOD * 4;
constexpr size_t WS_ROPE  = WS_MOD + (size_t)8 * NMOD * 4;
constexpr size_t WS_SSMA  = WS_ROPE + (size_t)2048 * 64 * 8;
constexpr size_t WS_WR    = WS_SSMA + (size_t)64 * 64 * 8;
constexpr size_t WS_SSMM  = WS_WR + (size_t)48 * 2048 * 2;
constexpr size_t WS_WIN   = WS_SSMM + (size_t)64 * 131072 * 2;
constexpr size_t WS_WOUT  = WS_WIN + (size_t)NPROJ * DM * 2;
constexpr size_t WS_WGLU  = WS_WOUT + (size_t)DM * DM * 2;
constexpr size_t WS_WGU   = WS_WGLU + (size_t)1024 * 1024 * 2;
constexpr size_t WS_WD    = WS_WGU + (size_t)NEXP * 2048 * 2048 * 2;
constexpr size_t WS_H     = WS_WD + (size_t)NEXP * 2048 * 1024 * 2;
constexpr size_t WS_PROJ  = WS_H + (size_t)NTOK * DM * 2;
constexpr size_t WS_Z     = WS_PROJ + (size_t)NTOK * NPROJ * 2;
constexpr size_t WS_CAT   = WS_Z + (size_t)NTOK * 1024 * 2;
constexpr size_t WS_WGT   = WS_CAT + (size_t)NTOK * DM * 2;
constexpr size_t WS_LIST  = WS_WGT + (size_t)32768 * 4;
constexpr size_t WS_SLOT  = WS_LIST + (size_t)32 * 16384 * 4;
constexpr size_t WS_X1    = WS_SLOT + (size_t)192 * 256 * 8;
constexpr size_t WS_END   = WS_X1 + (size_t)NTOK * DM * 2;
constexpr size_t WS_Y2    = WS_PROJ;
constexpr size_t WS_HM    = WS_Z;

constexpr int LDS_STAGE = 131072;
constexpr int LDS_BYTES = 147456;
constexpr int LDS_MISC  = LDS_BYTES - 2048;

struct Params { const float* in[27]; float* out; unsigned char* ws; int ph_lo, ph_hi; };

#define XB_TMO      128
#define XB_XCNT(j)  (256  + 64 * (j))
#define XB_XSUB(j)  (1280 + 64 * (j))
#define XB_XGEN(j)  (2304 + 64 * (j))
#define XB_TOP      3328
#define XB_TOPGEN   3392
#define XCD_BAR_WORDS 3456
#define XB_SPIN_CAP (1u << 22)

__device__ __forceinline__ unsigned xb_ld(unsigned* p)              { return __hip_atomic_load(p, __ATOMIC_RELAXED, __HIP_MEMORY_SCOPE_AGENT); }
__device__ __forceinline__ unsigned xb_add(unsigned* p, unsigned v) { return __hip_atomic_fetch_add(p, v, __ATOMIC_RELAXED, __HIP_MEMORY_SCOPE_AGENT); }
__device__ __forceinline__ unsigned xb_xcc_id() { return (unsigned)__builtin_amdgcn_s_getreg((3 << 11) | 20) & 0xFu; }
#define XB_SPIN(cond, bar) do { unsigned _sp = 0; while (cond) { __builtin_amdgcn_s_sleep(1); \
    if ((++_sp & 255u) == 0u) { if (xb_ld(&(bar)[XB_TMO])) break; if (_sp > XB_SPIN_CAP) { atomicAdd(&(bar)[XB_TMO], 1u); break; } } } } while (0)

struct XcdBarrier { unsigned* bar; unsigned x; volatile LAS unsigned* st; };

__device__ __forceinline__ XcdBarrier xcd_barrier_post(unsigned* bar, volatile LAS unsigned* st) {
    XcdBarrier b; b.bar = bar; b.x = xb_xcc_id(); b.st = st;
    if (threadIdx.x == 0) (void)xb_add(&bar[XB_XCNT(b.x)], 1u);
    return b;
}
__device__ __forceinline__ void xcd_barrier_complete(unsigned* bar, unsigned x, unsigned& nloc, unsigned& nx) {
    const unsigned G = gridDim.x * gridDim.y * gridDim.z;
    unsigned sum, cnt, mine, sp = 0u;
    for (;;) {
        sum = 0u; cnt = 0u; mine = 0u;
#pragma unroll
        for (unsigned j = 0; j < 16; ++j) { const unsigned c = xb_ld(&bar[XB_XCNT(j)]); sum += c; cnt += (c > 0u) ? 1u : 0u; mine = (j == x) ? c : mine; }
        if (sum == G) break;
        __builtin_amdgcn_s_sleep(1);
        if ((++sp & 255u) == 0u) { if (xb_ld(&bar[XB_TMO])) break; if (sp > XB_SPIN_CAP) { atomicAdd(&bar[XB_TMO], 1u); break; } }
    }
    nloc = mine > 0u ? mine : 1u; nx = cnt > 0u ? cnt : 1u;
}
__device__ __forceinline__ void xcd_barrier(const XcdBarrier& b) {
    asm volatile("s_waitcnt vmcnt(0)" ::: "memory");
    __syncthreads();
    if (threadIdx.x == 0) {
        unsigned* bar = b.bar;
        __builtin_amdgcn_s_waitcnt(0);
        unsigned nloc = b.st[0], nx = b.st[1];
        if (nloc == 0u) { xcd_barrier_complete(bar, b.x, nloc, nx); b.st[0] = nloc; b.st[1] = nx; }
        const unsigned old = xb_add(&bar[XB_XSUB(b.x)], 1u);
        const unsigned gen = old / nloc;
        if (old + 1u == (gen + 1u) * nloc) {
            __builtin_amdgcn_fence(__ATOMIC_RELEASE, "agent");
            asm volatile("s_waitcnt vmcnt(0)" ::: "memory");
            const unsigned og = xb_add(&bar[XB_TOP], 1u);
            const unsigned tg = og / nx;
            if (og + 1u == (tg + 1u) * nx) xb_add(&bar[XB_TOPGEN], 1u);
            else XB_SPIN(xb_ld(&bar[XB_TOPGEN]) == tg, bar);
            __builtin_amdgcn_fence(__ATOMIC_ACQUIRE, "agent");
            xb_add(&bar[XB_XGEN(b.x)], 1u);
            asm volatile("s_waitcnt vmcnt(0)" ::: "memory");
        } else {
            XB_SPIN(xb_ld(&bar[XB_XGEN(b.x)]) == gen, bar);
            __builtin_amdgcn_fence(__ATOMIC_ACQUIRE, "agent");
            asm volatile("s_waitcnt vmcnt(0)" ::: "memory");
        }
    }
    __syncthreads();
}

typedef __bf16 bf16x2_t __attribute__((ext_vector_type(2)));
__device__ __forceinline__ unsigned cvt_pk_bf16(float lo, float hi) { const f32x2 v = {lo, hi}; return __builtin_bit_cast(unsigned, __builtin_convertvector(v, bf16x2_t)); }
__device__ __forceinline__ float bf_lo(unsigned w) { return __uint_as_float(w << 16); }
__device__ __forceinline__ float bf_hi(unsigned w) { return __uint_as_float(w & 0xffff0000u); }
__device__ __forceinline__ float sigmoidf_(float x) { return __builtin_amdgcn_rcpf(1.0f + __expf(-x)); }
__device__ __forceinline__ float gelu_tanh(float x) {
    const float u = 0.7978845608028654f * (x + 0.044715f * x * x * x);
    const float t = 1.0f - 2.0f * __builtin_amdgcn_rcpf(1.0f + __expf(2.0f * u));
    return 0.5f * x * (1.0f + t);
}
__device__ __forceinline__ float wave_sum(float v) {
    v += __shfl_xor(v, 1); v += __shfl_xor(v, 2); v += __shfl_xor(v, 4); v += __shfl_xor(v, 8); v += __shfl_xor(v, 16); v += __shfl_xor(v, 32); return v;
}
__device__ __forceinline__ void sincos_d(double x, double& s, double& c) {
    const double TWO_PI = 6.283185307179586476925286766559;
    double r = x - TWO_PI * rint(x / TWO_PI);
    const double r2 = r * r;
    double ts = r, tc = 1.0; s = r; c = 1.0;
#pragma unroll 1
    for (int k = 1; k <= 14; ++k) { tc *= -r2 / (double)((2 * k - 1) * (2 * k)); ts *= -r2 / (double)((2 * k) * (2 * k + 1)); c += tc; s += ts; }
}

namespace g8 {
constexpr int BM = 256, BK = 64, HALF = 128, HTB = HALF * BK * 2, NXCD = 8, WGM = 8;
__device__ __forceinline__ int lds_byte(int r, int c) { const int st = (r >> 4) * 2 + (c >> 5), rr = r & 15, cc = c & 31, ob = rr * 64 + cc * 2; return st * 1024 + (ob ^ (((ob >> 9) & 1) << 5)); }
__device__ __forceinline__ void stage_rc(int b, int& R, int& C) { const int st = b / 1024, sb = b % 1024, swz = sb ^ (((sb >> 9) & 1) << 5); R = (st >> 1) * 16 + swz / 64; C = (st & 1) * 32 + (swz % 64) / 2; }
__device__ __forceinline__ int perm32(int rho) { const int n = rho >> 4, i = rho & 15; return 8 * (i >> 2) + 4 * n + (i & 3); }

struct Unit { unsigned aoff, boff; int pm, pn, flags, aux, aux2; };
typedef f32x4 Acc[2][2][4][2];

struct StaticOrder {
    int nM, nN, nwg, G, c;
    __device__ void init(int M, int N, int G_, int c_) { nM = M / BM; nN = N / BM; nwg = nM * nN; G = G_; c = c_; }
    __device__ __forceinline__ bool tile(int i, int& pm, int& pn) const {
        const long L = (long)i * G + c; if (L >= nwg) return false;
        int wgid = (int)L; { const int q = nwg / NXCD, r = nwg % NXCD, xcd = wgid % NXCD, off = wgid / NXCD; wgid = (xcd < r ? xcd * (q + 1) : r * (q + 1) + (xcd - r) * q) + off; }
        const int nig = WGM * nN, gid = wgid / nig, fm = gid * WGM, gsz = (nM - fm) < WGM ? (nM - fm) : WGM;
        pm = fm + ((wgid % nig) % gsz); pn = (wgid % nig) / gsz; return true;
    }
};

typedef long l64x2 __attribute__((ext_vector_type(2)));
typedef int i32x4 __attribute__((ext_vector_type(4)));
typedef int i32x8 __attribute__((ext_vector_type(8)));
template <class Epi, class Sched, bool SKIP = false, int FP8 = 0>
__device__ __forceinline__ void gemm_phase(LAS unsigned char* lds, const unsigned char* ws, const int nt, const int ldb  , const Sched& S, const Epi& E) {
    const int tid = threadIdx.x, wid = __builtin_amdgcn_readfirstlane(tid >> 6), lane = tid & 63, wr = wid >> 2, wc = wid & 3, fr = lane & 15, fq = lane >> 4;
    int R0, C0, R1, C1; stage_rc(tid * 16, R0, C0); stage_rc(tid * 16 + 8192, R1, C1);
    unsigned voffB[2];
    { const int Rb0 = Epi::PERM ? ((R0 & ~31) + perm32(R0 & 31)) : R0, Rb1 = Epi::PERM ? ((R1 & ~31) + perm32(R1 & 31)) : R1;
      voffB[0] = (unsigned)(Rb0 * 64 + C0) * 2u; voffB[1] = (unsigned)(Rb1 * 64 + C1) * 2u; }
    const unsigned kstep = (unsigned)(BK * 2);
    const unsigned kstepB = 256u * 64u * 2u;
    const unsigned hstepB = (unsigned)HALF * 64u * 2u;
    const unsigned ldsw = (unsigned)wid * 1024u;
    const int aoff = lds_byte(wr * 64 + fr, fq * 8), boff = lds_byte(wc * 32 + fr, fq * 8);
#define G8_SA(b, h) (((b) * 2 + (h)) * HTB)
#define G8_SB(b, h) ((4 + (b) * 2 + (h)) * HTB)
#define G8_STAGE(bufoff, gbase, v0, v1) do { \
        __builtin_amdgcn_global_load_lds((const unsigned*)((gbase) + (v0)), (LAS unsigned*)(lds + (bufoff) + ldsw), 16, 0, 0); \
        __builtin_amdgcn_global_load_lds((const unsigned*)((gbase) + (v1)), (LAS unsigned*)(lds + (bufoff) + ldsw + 8192), 16, 0, 0); } while (0)
#define G8_LDA(dst, b, h) do { _Pragma("unroll") for (int m = 0; m < 4; ++m) _Pragma("unroll") for (int k = 0; k < 2; ++k) dst[m][k] = *(const LAS bf16x8*)(lds + G8_SA(b, h) + aoff + m * 2048 + k * 1024); } while (0)
#define G8_LDB(dst, b, h) do { _Pragma("unroll") for (int n = 0; n < 2; ++n) _Pragma("unroll") for (int k = 0; k < 2; ++k) dst[n][k] = *(const LAS bf16x8*)(lds + G8_SB(b, h) + boff + n * 2048 + k * 1024); } while (0)
#define G8_MMA(ai, bj, At, Bt) do { __builtin_amdgcn_s_setprio(1); \
        if constexpr (FP8 == 2) { _Pragma("unroll") for (int m = 0; m < 4; ++m) _Pragma("unroll") for (int n = 0; n < 2; ++n) { \
            const i32x8 a8 = __builtin_shufflevector(__builtin_bit_cast(i32x4, At[m][0]), __builtin_bit_cast(i32x4, At[m][1]), 0, 1, 2, 3, 4, 5, 6, 7); \
            const i32x8 b8 = __builtin_shufflevector(__builtin_bit_cast(i32x4, Bt[n][0]), __builtin_bit_cast(i32x4, Bt[n][1]), 0, 1, 2, 3, 4, 5, 6, 7); \
            acc[ai][bj][m][n] = __builtin_amdgcn_mfma_scale_f32_16x16x128_f8f6f4(b8, a8, acc[ai][bj][m][n], 0, 0, 0, 0x7F7F7F7F, 0, 0x7F7F7F7F); } } \
        else { _Pragma("unroll") for (int m = 0; m < 4; ++m) _Pragma("unroll") for (int n = 0; n < 2; ++n) _Pragma("unroll") for (int k = 0; k < 2; ++k) { \
        if constexpr (FP8 == 1) { const l64x2 a2 = __builtin_bit_cast(l64x2, At[m][k]), b2 = __builtin_bit_cast(l64x2, Bt[n][k]); \
            acc[ai][bj][m][n] = __builtin_amdgcn_mfma_f32_16x16x32_fp8_fp8(b2[0], a2[0], acc[ai][bj][m][n], 0, 0, 0); \
            acc[ai][bj][m][n] = __builtin_amdgcn_mfma_f32_16x16x32_fp8_fp8(b2[1], a2[1], acc[ai][bj][m][n], 0, 0, 0); } \
        else acc[ai][bj][m][n] = __builtin_amdgcn_mfma_f32_16x16x32_bf16(Bt[n][k], At[m][k], acc[ai][bj][m][n], 0, 0, 0); } } __builtin_amdgcn_s_setprio(0); } while (0)
#define G8_WAIT_V(n) asm volatile("s_waitcnt vmcnt(" #n ")" ::: "memory")
#define G8_WAIT_L(n) asm volatile("s_waitcnt lgkmcnt(" #n ")" ::: "memory")
#define G8_BAR __builtin_amdgcn_s_barrier()
#define G8_SCHED __builtin_amdgcn_sched_barrier(0)
    Unit cur, nxt; int ui = 0;
    if (!S.next(0, cur)) return;
    Acc acc;
#pragma unroll
    for (int a = 0; a < 2; ++a)
#pragma unroll
        for (int b = 0; b < 2; ++b)
#pragma unroll
            for (int m = 0; m < 4; ++m)
#pragma unroll
                for (int n = 0; n < 2; ++n) acc[a][b][m][n] = (f32x4){0.f, 0.f, 0.f, 0.f};
    bf16x8 At[4][2], B0[2][2], B1[2][2];
    unsigned cv[2][2], nv[2][2];
    S.aoffs(cur, R0, C0, R1, C1, cv);
    const unsigned char* cA = ws + cur.aoff; const unsigned char* cB = ws + cur.boff;
    G8_STAGE(G8_SB(0, 0), cB, voffB[0], voffB[1]); G8_STAGE(G8_SA(0, 0), cA, cv[0][0], cv[0][1]);
    G8_STAGE(G8_SB(0, 1), cB + hstepB, voffB[0], voffB[1]); G8_STAGE(G8_SA(0, 1), cA, cv[1][0], cv[1][1]);
    if (wr == 1) G8_BAR;
    G8_WAIT_V(4); G8_BAR;
    G8_STAGE(G8_SB(1, 0), cB + kstepB, voffB[0], voffB[1]); G8_STAGE(G8_SA(1, 0), cA + kstep, cv[0][0], cv[0][1]);
    G8_STAGE(G8_SB(1, 1), cB + hstepB + kstepB, voffB[0], voffB[1]);
    G8_WAIT_V(6); G8_BAR;
    for (;;) {
        const bool has_next = S.next(ui + 1, nxt);
        if (has_next) S.aoffs(nxt, R0, C0, R1, C1, nv);
        else { nv[0][0] = cv[0][0]; nv[0][1] = cv[0][1]; nv[1][0] = cv[1][0]; nv[1][1] = cv[1][1]; }
        const unsigned char* nA = has_next ? ws + nxt.aoff : cA; const unsigned char* nB = has_next ? ws + nxt.boff : cB;
        const int vrows = SKIP ? cur.aux2 : 256;
        const bool do0 = !SKIP || vrows > 64 || wr == 0, do1 = !SKIP || vrows > 128;
        for (int t = 0; t < nt; t += 2) {
            const bool last = (t == nt - 2);
            const unsigned char* a1 = cA + (size_t)(t + 1) * kstep;
            const unsigned char* a2 = last ? nA : cA + (size_t)(t + 2) * kstep; const unsigned char* b2 = last ? nB : cB + (size_t)(t + 2) * kstepB;
            const unsigned char* a3 = a2 + kstep; const unsigned char* b3 = b2 + kstepB;
            const unsigned o00 = last ? nv[0][0] : cv[0][0], o01 = last ? nv[0][1] : cv[0][1], o10 = last ? nv[1][0] : cv[1][0], o11 = last ? nv[1][1] : cv[1][1];
            G8_LDB(B0, 0, 0); G8_SCHED; G8_LDA(At, 0, 0); G8_STAGE(G8_SA(1, 1), a1, cv[1][0], cv[1][1]);
            G8_WAIT_L(8); G8_BAR; G8_WAIT_L(0); if (do0) G8_MMA(0, 0, At, B0); G8_BAR; G8_SCHED;
            G8_LDB(B1, 0, 1); G8_STAGE(G8_SB(0, 0), b2, voffB[0], voffB[1]);
            G8_BAR; G8_WAIT_L(0); if (do0) G8_MMA(0, 1, At, B1); G8_BAR;
            G8_LDA(At, 0, 1); G8_STAGE(G8_SA(0, 0), a2, o00, o01);
            G8_BAR; G8_WAIT_L(0); if (do1) G8_MMA(1, 0, At, B0); G8_BAR; G8_SCHED;
            G8_STAGE(G8_SB(0, 1), b2 + hstepB, voffB[0], voffB[1]);
            G8_WAIT_V(6); G8_BAR; if (do1) G8_MMA(1, 1, At, B1); G8_BAR;
            G8_LDB(B0, 1, 0); G8_SCHED; G8_LDA(At, 1, 0); G8_STAGE(G8_SA(0, 1), a2, o10, o11);
            G8_WAIT_L(8); G8_BAR; G8_WAIT_L(0); if (do0) G8_MMA(0, 0, At, B0); G8_BAR; G8_SCHED;
            G8_LDB(B1, 1, 1); G8_STAGE(G8_SB(1, 0), b3, voffB[0], voffB[1]);
            G8_BAR; G8_WAIT_L(0); if (do0) G8_MMA(0, 1, At, B1); G8_BAR;
            G8_LDA(At, 1, 1); G8_STAGE(G8_SA(1, 0), a3, o00, o01);
            G8_BAR; G8_WAIT_L(0); if (do1) G8_MMA(1, 0, At, B0); G8_BAR; G8_SCHED;
            G8_STAGE(G8_SB(1, 1), b3 + hstepB, voffB[0], voffB[1]);
            G8_WAIT_V(6); G8_BAR; if (do1) G8_MMA(1, 1, At, B1); G8_BAR;
        }
        E(acc, cur, wr, wc, fr, fq);
        if (!has_next) break;
        if (!(cur.flags & 1)) {
#pragma unroll
            for (int a = 0; a < 2; ++a)
#pragma unroll
                for (int b = 0; b < 2; ++b)
#pragma unroll
                    for (int m = 0; m < 4; ++m)
#pragma unroll
                        for (int n = 0; n < 2; ++n) acc[a][b][m][n] = (f32x4){0.f, 0.f, 0.f, 0.f};
        }
        cur = nxt; cA = nA; cB = nB; ++ui;
        cv[0][0] = nv[0][0]; cv[0][1] = nv[0][1]; cv[1][0] = nv[1][0]; cv[1][1] = nv[1][1];
    }
    G8_WAIT_V(0);
    if (wr == 0) G8_BAR;
    G8_BAR;
#undef G8_SA
#undef G8_SB
#undef G8_STAGE
#undef G8_LDA
#undef G8_LDB
#undef G8_MMA
#undef G8_WAIT_V
#undef G8_WAIT_L
#undef G8_BAR
#undef G8_SCHED
}
}

__device__ __forceinline__ void p0_adaln(const Params& P, LAS unsigned char* lds, int tid, int item) {
    const int ks = item & 3, nc = item >> 2;
    LAS float* sc = (LAS float*)lds;
    LAS float* red = (LAS float*)(lds + 16384);
    const float* c = P.in[1];
    for (int i = tid; i < 4096; i += NTHREADS) { const int kl = i >> 3, b = i & 7; const float v = c[b * 2048 + ks * 512 + kl]; sc[i] = v / (1.0f + expf(-v)); }
    __syncthreads();
    if (tid < 384) {
        const int nq = tid % 48, kg = tid / 48;
        const float* W = P.in[2] + (size_t)(ks * 512 + kg * 64) * NMOD + nc * 192 + nq * 4;
        f32x4 acc[8];
#pragma unroll
        for (int b = 0; b < 8; ++b) acc[b] = (f32x4){0.f, 0.f, 0.f, 0.f};
#pragma unroll 16
        for (int kk = 0; kk < 64; ++kk) {
            const f32x4 w = *(const f32x4*)(W + (size_t)kk * NMOD);
            const f32x4 s0 = *(const LAS f32x4*)(sc + (kg * 64 + kk) * 8), s1 = *(const LAS f32x4*)(sc + (kg * 64 + kk) * 8 + 4);
            acc[0] += w * s0[0]; acc[1] += w * s0[1]; acc[2] += w * s0[2]; acc[3] += w * s0[3];
            acc[4] += w * s1[0]; acc[5] += w * s1[1]; acc[6] += w * s1[2]; acc[7] += w * s1[3];
        }
#pragma unroll
        for (int b = 0; b < 8; ++b) *(LAS f32x4*)(red + (kg * 8 + b) * 192 + nq * 4) = acc[b];
    }
    __syncthreads();
    float* modp = (float*)(P.ws + WS_MODP);
    for (int i = tid; i < 8 * 192; i += NTHREADS) {
        const int b = i / 192, n = i % 192; float s = 0.f;
#pragma unroll
        for (int kg = 0; kg < 8; ++kg) s += red[(kg * 8 + b) * 192 + n];
        modp[(size_t)(ks * 8 + b) * NMOD + nc * 192 + n] = s;
    }
    __syncthreads();
}

struct CvtUnit { const float* src; bf16_t* dst; int Nd, Kd, k0, n0, nmode; const float* s0; const float* s1; };
constexpr int CVT_UNITS = 640 + 256 + 64;
__device__ __forceinline__ void cvt_unit_decode(const Params& P, int L, CvtUnit& u) {
    u.s0 = nullptr; u.s1 = nullptr; u.nmode = 0;
    if (L < 640) { u.src = P.in[5]; u.dst = (bf16_t*)(P.ws + WS_WIN); u.Kd = 2048; u.Nd = 5120; u.k0 = (L / 20) * 64; u.n0 = (L % 20) * 256; u.nmode = 3; return; }
    L -= 640;
    if (L < 256) { u.src = P.in[17]; u.dst = (bf16_t*)(P.ws + WS_WOUT); u.Kd = 2048; u.Nd = 2048; u.k0 = (L / 8) * 64; u.n0 = (L % 8) * 256; u.s0 = P.in[15]; u.s1 = P.in[16]; return; }
    L -= 256;
    if (L < 64) { u.src = P.in[14]; u.dst = (bf16_t*)(P.ws + WS_WGLU); u.Kd = 1024; u.Nd = 1024; u.k0 = (L / 4) * 64; u.n0 = (L % 4) * 256; return; }
    L -= 64;
    if (L < 4096) { const int e = L >> 7, r = L & 127; u.src = P.in[23] + (size_t)e * 2048 * 1024; u.dst = (bf16_t*)(P.ws + WS_WGU) + (size_t)e * 2048 * 2048; u.Kd = 2048; u.Nd = 1024; u.k0 = (r >> 2) * 64; u.n0 = (r & 3) * 256; u.nmode = 1; return; }
    L -= 4096;
    if (L < 4096) { const int e = L >> 7, r = L & 127; u.src = P.in[24] + (size_t)e * 2048 * 1024; u.dst = (bf16_t*)(P.ws + WS_WGU) + (size_t)e * 2048 * 2048; u.Kd = 2048; u.Nd = 1024; u.k0 = (r >> 2) * 64; u.n0 = (r & 3) * 256; u.nmode = 2; return; }
    L -= 4096;
    { const int e = L >> 7, r = L & 127; u.src = P.in[25] + (size_t)e * 1024 * 2048; u.dst = (bf16_t*)(P.ws + WS_WD) + (size_t)e * 2048 * 1024; u.Kd = 1024; u.Nd = 2048; u.k0 = (r >> 3) * 64; u.n0 = (r & 7) * 256; }
}
__device__ __forceinline__ void cvt_load(const CvtUnit& u, int tid, f32x4 (&r)[8]) {
    const int kp = tid >> 4, nq = tid & 15;
    const float* p = u.src + (size_t)(u.k0 + 2 * kp) * u.Nd + u.n0 + nq * 4;
#pragma unroll
    for (int s = 0; s < 4; ++s) { r[2 * s] = *(const f32x4*)(p + s * 64); r[2 * s + 1] = *(const f32x4*)(p + u.Nd + s * 64); }
    if (u.s0) {
        const int k = u.k0 + 2 * kp;
        const float a = (k < 1024) ? u.s0[k] : u.s1[k - 1024], b = (k + 1 < 1024) ? u.s0[k + 1] : u.s1[k + 1 - 1024];
#pragma unroll
        for (int s = 0; s < 4; ++s) { r[2 * s] *= a; r[2 * s + 1] *= b; }
    }
}
__device__ __forceinline__ void cvt_to_lds(LAS unsigned* tile, const f32x4 (&r)[8], int kp, int nq) {
#pragma unroll
    for (int s = 0; s < 4; ++s)
#pragma unroll
        for (int j = 0; j < 4; ++j) tile[s * 2112 + (nq * 4 + j) * 33 + kp] = cvt_pk_bf16(r[2 * s][j], r[2 * s + 1][j]);
}
__device__ __forceinline__ void cvt_store(const LAS unsigned* tile, const CvtUnit& u, int nl, int kq) {
#pragma unroll
    for (int s = 0; s < 4; ++s) {
        u32x4 w; w.x = tile[s * 2112 + nl * 33 + kq * 4]; w.y = tile[s * 2112 + nl * 33 + kq * 4 + 1]; w.z = tile[s * 2112 + nl * 33 + kq * 4 + 2]; w.w = tile[s * 2112 + nl * 33 + kq * 4 + 3];
        const int n = u.n0 + s * 64 + nl;
        int np = n;
        if (u.nmode == 1 || u.nmode == 2) np = (n >> 7) * 256 + (n & 127) + (u.nmode == 2 ? 128 : 0);
        else if (u.nmode == 3 && n >= 1024 && n < 3072) { const int reg = (n >= 2048) ? 2048 : 1024, nr = n - reg;
            np = reg + ((nr >> 8) << 8) + (((nr >> 6) & 1) << 7) + (((nr >> 7) & 1) << 6) + (nr & 63); }
        *(u32x4*)(u.dst + (size_t)(np >> 8) * ((size_t)u.Kd * 256) + (size_t)(u.k0 >> 6) * 16384 + (np & 255) * 64 + kq * 8) = w;
    }
}
__device__ __forceinline__ void p0_convert(const Params& P, LAS unsigned char* lds, int tid, int blk, int G) {
    LAS unsigned* tileA = (LAS unsigned*)lds;
    LAS unsigned* tileB = tileA + 4 * 2112;
    const int kp = tid >> 4, nq = tid & 15, nl = tid >> 3, kq = tid & 7;
    CvtUnit uA, uB, nA, nB; f32x4 rA[8], rB[8];
    int L = blk;
    if (L >= CVT_UNITS) return;
    bool hasB = (L + G) < CVT_UNITS;
    cvt_unit_decode(P, L, uA); cvt_load(uA, tid, rA);
    if (hasB) { cvt_unit_decode(P, L + G, uB); cvt_load(uB, tid, rB); }
    for (;;) {
        cvt_to_lds(tileA, rA, kp, nq);
        if (hasB) cvt_to_lds(tileB, rB, kp, nq);
        __syncthreads();
        const int Ln = L + 2 * G; const bool moreA = Ln < CVT_UNITS, moreB = (Ln + G) < CVT_UNITS;
        if (moreA) { cvt_unit_decode(P, Ln, nA); cvt_load(nA, tid, rA); }
        if (moreB) { cvt_unit_decode(P, Ln + G, nB); cvt_load(nB, tid, rB); }
        cvt_store(tileA, uA, nl, kq);
        if (hasB) cvt_store(tileB, uB, nl, kq);
        __syncthreads();
        if (!moreA) break;
        uA = nA; uB = nB; hasB = moreB; L = Ln;
    }
}

struct Cvt8Unit { const float* src; unsigned char* dst; int Nd, Kd, k0, n0, nmode; float scale; };
constexpr float WGU_SCALE = 64.0f, WD_SCALE = 32.0f;
__device__ __forceinline__ void cvt8_decode(const Params& P, int L, Cvt8Unit& u) {
    if (L < 8192) { const int up = L >= 4096; const int r_ = L & 4095; const int e = r_ >> 7, r = r_ & 127;
        u.src = P.in[up ? 24 : 23] + (size_t)e * 2048 * 1024; u.dst = P.ws + WS_WGU + (size_t)e * 2048 * 2048; u.Kd = 2048; u.Nd = 1024; u.k0 = (r >> 3) * 128; u.n0 = (r & 7) * 128; u.nmode = up ? 2 : 1; u.scale = WGU_SCALE; return; }
    L -= 8192;
    { const int e = L >> 7, r = L & 127; u.src = P.in[25] + (size_t)e * 1024 * 2048; u.dst = P.ws + WS_WD + (size_t)e * 2048 * 1024; u.Kd = 1024; u.Nd = 2048; u.k0 = (r >> 4) * 128; u.n0 = (r & 15) * 128; u.nmode = 0; u.scale = WD_SCALE; }
}
__device__ __forceinline__ void cvt8_load(const Cvt8Unit& u, int tid, f32x4 (&r)[8]) {
    const int kg = tid >> 5, nq = tid & 31;
    const float* p = u.src + (size_t)(u.k0 + 8 * kg) * u.Nd + u.n0 + nq * 4;
#pragma unroll
    for (int kk = 0; kk < 8; ++kk) r[kk] = __builtin_nontemporal_load((const f32x4*)(p + (size_t)kk * u.Nd));
}
__device__ __forceinline__ void cvt8_to_lds(LAS unsigned* tile, const f32x4 (&r)[8], float sc, int tid) {
    const int kg = tid >> 5, nq = tid & 31;
    u32x4 w0, w1;
#pragma unroll
    for (int j = 0; j < 4; ++j) {
        int a = 0, b = 0;
        a = __builtin_amdgcn_cvt_pk_fp8_f32(r[0][j] * sc, r[1][j] * sc, a, false); a = __builtin_amdgcn_cvt_pk_fp8_f32(r[2][j] * sc, r[3][j] * sc, a, true);
        b = __builtin_amdgcn_cvt_pk_fp8_f32(r[4][j] * sc, r[5][j] * sc, b, false); b = __builtin_amdgcn_cvt_pk_fp8_f32(r[6][j] * sc, r[7][j] * sc, b, true);
        w0[j] = (unsigned)a; w1[j] = (unsigned)b;
    }
    *(LAS u32x4*)(tile + (2 * kg) * 132 + nq * 4) = w0;
    *(LAS u32x4*)(tile + (2 * kg + 1) * 132 + nq * 4) = w1;
}
__device__ __forceinline__ void cvt8_store(const LAS unsigned* tile, const Cvt8Unit& u, int tid) {
    const int nl = tid >> 2, q = tid & 3;
    u32x4 w0, w1;
    w0.x = tile[(8 * q + 0) * 132 + nl]; w0.y = tile[(8 * q + 1) * 132 + nl]; w0.z = tile[(8 * q + 2) * 132 + nl]; w0.w = tile[(8 * q + 3) * 132 + nl];
    w1.x = tile[(8 * q + 4) * 132 + nl]; w1.y = tile[(8 * q + 5) * 132 + nl]; w1.z = tile[(8 * q + 6) * 132 + nl]; w1.w = tile[(8 * q + 7) * 132 + nl];
    const int n = u.n0 + nl;
    int np = n;
    if (u.nmode == 1 || u.nmode == 2) np = (n >> 7) * 256 + (n & 127) + (u.nmode == 2 ? 128 : 0);
    unsigned char* d = u.dst + (size_t)(np >> 8) * ((size_t)u.Kd * 256) + (size_t)(u.k0 >> 7) * 32768 + (np & 255) * 128 + q * 32;
    *(u32x4*)d = w0; *(u32x4*)(d + 16) = w1;
}
__device__ __forceinline__ void p0_convert_fp8(const Params& P, LAS unsigned char* lds, int tid, int blk, int G, const int Lbeg, const int Lend) {
    LAS unsigned* tileA = (LAS unsigned*)lds;
    LAS unsigned* tileB = tileA + 32 * 132;
    Cvt8Unit uA, uB, nA, nB; f32x4 rA[8], rB[8], qA[8], qB[8];
    int L = Lbeg + blk;
    if (L >= Lend) return;
    bool hasB = (L + G) < Lend;
    cvt8_decode(P, L, uA); cvt8_load(uA, tid, rA);
    if (hasB) { cvt8_decode(P, L + G, uB); cvt8_load(uB, tid, rB); }
    for (;;) {
        const int Ln = L + 2 * G; const bool moreA = Ln < Lend, moreB = (Ln + G) < Lend;
        if (moreA) { cvt8_decode(P, Ln, nA); cvt8_load(nA, tid, qA); }
        if (moreB) { cvt8_decode(P, Ln + G, nB); cvt8_load(nB, tid, qB); }
        cvt8_to_lds(tileA, rA, uA.scale, tid);
        if (hasB) cvt8_to_lds(tileB, rB, uB.scale, tid);
        __syncthreads();
        cvt8_store(tileA, uA, tid);
        if (hasB) cvt8_store(tileB, uB, tid);
        __syncthreads();
        if (!moreA) break;
        uA = nA; uB = nB; hasB = moreB; L = Ln;
#pragma unroll
        for (int i = 0; i < 8; ++i) { rA[i] = qA[i]; rB[i] = qB[i]; }
    }
}

__device__ __forceinline__ void p0_ssm_mats(const Params& P, LAS unsigned char* lds, int tid, int item) {
    const int g = item & 63, q = item >> 6;
    LAS f32x2* pw = (LAS f32x2*)lds;
    LAS f32x2* Bb = pw + 17 * 64;
    LAS f32x2* Cc = Bb + 64 * 16;
    LAS float* Kt = (LAS float*)(Cc + 16 * 64);
    if (tid < 64) {
        const int p = tid;
        const float dt = expf(P.in[13][g]);
        const float are = P.in[6][g * 64 + p], aim = P.in[7][g * 64 + p];
        const float mag = expf(dt * are);
        double sd, cd; sincos_d((double)(dt * aim), sd, cd);
        const float abr = mag * (float)cd, abi = mag * (float)sd;
        const float inv = 1.0f / (are * are + aim * aim);
        const float nre = abr - 1.0f;
        const float fre = (nre * are + abi * aim) * inv, fim = (abi * are - nre * aim) * inv;
        float pr = 1.0f, pi = 0.0f;
        for (int n = 0; n <= 16; ++n) { pw[n * 64 + p] = (f32x2){pr, pi}; const float t = pr * abr - pi * abi; pi = pr * abi + pi * abr; pr = t; }
        for (int h = 0; h < 16; ++h) {
            const float br = P.in[8][(g * 64 + p) * 16 + h], bi = P.in[9][(g * 64 + p) * 16 + h];
            Bb[p * 16 + h] = (f32x2){fre * br - fim * bi, fre * bi + fim * br};
            Cc[h * 64 + p] = (f32x2){P.in[10][(g * 16 + h) * 64 + p], P.in[11][(g * 16 + h) * 64 + p]};
        }
        if (q == 0) { f32x2* AL = (f32x2*)(P.ws + WS_SSMA); const f32x2 v = pw[16 * 64 + p]; AL[g * 64 + p] = v; }
    }
    __syncthreads();
    {
        const int wv = tid >> 6, ln = tid & 63, fi = ln & 15, fk = ln >> 4;
#pragma unroll
        for (int tt = 0; tt < 2; ++tt) {
            const int tau = 2 * wv + tt;
            f32x4 acc = {0.f, 0.f, 0.f, 0.f};
#pragma unroll 8
            for (int st = 0; st < 32; ++st) {
                const int kk = 4 * st + fk, p = kk >> 1;
                const f32x2 c = Cc[fi * 64 + p], a = pw[tau * 64 + p], bb = Bb[p * 16 + fi];
                const float av = (kk & 1) ? -(c.x * a.y + c.y * a.x) : (c.x * a.x - c.y * a.y);
                const float bv = (kk & 1) ? bb.y : bb.x;
                acc = __builtin_amdgcn_mfma_f32_16x16x4f32(av, bv, acc, 0, 0, 0);
            }
#pragma unroll
            for (int r = 0; r < 4; ++r) Kt[(tau * 16 + 4 * fk + r) * 16 + fi] = acc[r];
        }
    }
    __syncthreads();
    bf16_t* Ms = (bf16_t*)(P.ws + WS_SSMM) + (size_t)g * 131072;
    bf16_t* TM = Ms + 32768;
    for (int o = tid; o < 32 * 128; o += NTHREADS) {
        const int row = 32 * q + (o >> 7), col = (o & 127) * 2;
        const int p = row >> 1, j = col >> 4, hi = col & 15;
        const f32x2 a = pw[(15 - j) * 64 + p], b0 = Bb[p * 16 + hi], b1 = Bb[p * 16 + hi + 1];
        float v0, v1;
        if ((row & 1) == 0) { v0 = a.x * b0.x - a.y * b0.y; v1 = a.x * b1.x - a.y * b1.y; } else { v0 = a.x * b0.y + a.y * b0.x; v1 = a.x * b1.y + a.y * b1.x; }
        *(unsigned*)(Ms + (size_t)row * 256 + col) = cvt_pk_bf16(v0, v1);
    }
    for (int o = tid; o < 64 * 192; o += NTHREADS) {
        const int row = 64 * q + o / 192, col = (o % 192) * 2;
        const int i = row >> 4, ho = row & 15; float v0, v1;
        if (col < 256) { const int j = col >> 4, hi = col & 15; if (j <= i) { v0 = Kt[((i - j) * 16 + ho) * 16 + hi]; v1 = Kt[((i - j) * 16 + ho) * 16 + hi + 1]; } else { v0 = 0.f; v1 = 0.f; } }
        else { const int p0 = (col - 256) >> 1;
            const f32x2 c0 = Cc[ho * 64 + p0], a0 = pw[(i + 1) * 64 + p0];
            v0 = c0.x * a0.x - c0.y * a0.y; v1 = -(c0.x * a0.y + c0.y * a0.x); }
        *(unsigned*)(TM + (size_t)row * 384 + col) = cvt_pk_bf16(v0, v1);
    }
    __syncthreads();
}

__device__ __forceinline__ void p0_misc(const Params& P, int tid, int blk, int G) {
    bf16_t* wr = (bf16_t*)(P.ws + WS_WR);
    for (int i = blk * NTHREADS + tid; i < 48 * 2048; i += G * NTHREADS) {
        const int n = i >> 11, k = i & 2047; float v = 0.f;
        if (n < 4) v = P.in[19][k * 4 + n]; else if (n < 36) v = P.in[21][k * 32 + (n - 4)];
        wr[i] = (bf16_t)(cvt_pk_bf16(v, 0.f) & 0xffffu);
    }
    if (blk == 0) for (int i = tid; i < 2048; i += NTHREADS) ((int*)(P.ws + WS_CNT))[i] = 0;
}

__device__ __forceinline__ void p1_norm1(const Params& P, LAS unsigned char* lds, int tid, int blk, int G) {
    const float* modp = (const float*)(P.ws + WS_MODP); const float* bada = P.in[3];
    float* mod = (float*)(P.ws + WS_MOD);
    for (int i = blk * NTHREADS + tid; i < 8 * NMOD; i += G * NTHREADS) {
        const int b = i / NMOD, j = i % NMOD;
        mod[i] = bada[j] + ((modp[(size_t)(0 * 8 + b) * NMOD + j] + modp[(size_t)(1 * 8 + b) * NMOD + j]) + (modp[(size_t)(2 * 8 + b) * NMOD + j] + modp[(size_t)(3 * 8 + b) * NMOD + j]));
    }
    LAS float* gm = (LAS float*)lds; LAS float* sh = gm + 2048;
    const int wave = tid >> 6, lane = tid & 63;
    bf16_t* H = (bf16_t*)(P.ws + WS_H);
    for (int rb = blk; rb < 256; rb += G) {
        const int b = rb >> 5;
        for (int k = tid; k < 2048; k += NTHREADS) {
            const int js = 2048 + k, jh = k;
            const float sc = bada[js] + ((modp[(size_t)(0 * 8 + b) * NMOD + js] + modp[(size_t)(1 * 8 + b) * NMOD + js]) + (modp[(size_t)(2 * 8 + b) * NMOD + js] + modp[(size_t)(3 * 8 + b) * NMOD + js]));
            const float sv = bada[jh] + ((modp[(size_t)(0 * 8 + b) * NMOD + jh] + modp[(size_t)(1 * 8 + b) * NMOD + jh]) + (modp[(size_t)(2 * 8 + b) * NMOD + jh] + modp[(size_t)(3 * 8 + b) * NMOD + jh]));
            gm[k] = P.in[4][k] * (1.0f + sc); sh[k] = sv;
        }
        __syncthreads();
        f32x4 v[8], vn[8];
        { const float* xr = P.in[0] + (size_t)(rb * 64 + wave * 8) * DM;
#pragma unroll
          for (int i = 0; i < 8; ++i) v[i] = *(const f32x4*)(xr + (i * 64 + lane) * 4); }
        for (int rr = 0; rr < 8; ++rr) {
            const int row = rb * 64 + wave * 8 + rr;
            if (rr < 7) { const float* xn = P.in[0] + (size_t)(row + 1) * DM;
#pragma unroll
                for (int i = 0; i < 8; ++i) vn[i] = *(const f32x4*)(xn + (i * 64 + lane) * 4); }
            float ss = 0.f;
#pragma unroll
            for (int i = 0; i < 8; ++i) ss += v[i][0] * v[i][0] + v[i][1] * v[i][1] + v[i][2] * v[i][2] + v[i][3] * v[i][3];
            ss = wave_sum(ss);
            const float r = rsqrtf(ss * (1.0f / 2048.0f) + 1e-6f);
#pragma unroll
            for (int i = 0; i < 8; ++i) {
                const int k = (i * 64 + lane) * 4;
                const f32x4 g4 = *(const LAS f32x4*)(gm + k), s4 = *(const LAS f32x4*)(sh + k);
                const f32x4 o = v[i] * r * g4 + s4;
                u32x2 w; w.x = cvt_pk_bf16(o[0], o[1]); w.y = cvt_pk_bf16(o[2], o[3]);
                *(u32x2*)(H + (size_t)row * DM + k) = w;
            }
#pragma unroll
            for (int i = 0; i < 8; ++i) v[i] = vn[i];
        }
        __syncthreads();
    }
}

struct DenseSched : g8::StaticOrder {
    unsigned abase, bbase; int lda, ldb;
    __device__ __forceinline__ bool next(int i, g8::Unit& u) const {
        int pm, pn; if (!tile(i, pm, pn)) return false;
        u.pm = __builtin_amdgcn_readfirstlane(pm); u.pn = __builtin_amdgcn_readfirstlane(pn); u.flags = 0; u.aux = 0;
        u.aoff = abase + (unsigned)u.pm * 256u * (unsigned)lda * 2u; u.boff = bbase + (unsigned)u.pn * 256u * (unsigned)ldb * 2u; return true;
    }
    __device__ __forceinline__ void aoffs(const g8::Unit&, int R0, int C0, int R1, int C1, unsigned (&v)[2][2]) const {
        v[0][0] = (unsigned)(R0 * lda + C0) * 2u; v[0][1] = (unsigned)(R1 * lda + C1) * 2u;
        v[1][0] = (unsigned)((128 + R0) * lda + C0) * 2u; v[1][1] = (unsigned)((128 + R1) * lda + C1) * 2u;
    }
};
struct EpiStoreBf16 {
    static constexpr bool PERM = true;
    bf16_t* O; int ldc;
    __device__ __forceinline__ void operator()(g8::Acc& acc, const g8::Unit& u, int wr, int wc, int fr, int fq) const {
        const int row0 = u.pm * 256 + wr * 64 + fr, col0 = u.pn * 256 + wc * 32 + 8 * fq;
#pragma unroll
        for (int ai = 0; ai < 2; ++ai)
#pragma unroll
            for (int m = 0; m < 4; ++m) { bf16_t* rowp = O + (size_t)(row0 + ai * 128 + m * 16) * ldc + col0;
#pragma unroll
                for (int bj = 0; bj < 2; ++bj) { const f32x4 v0 = acc[ai][bj][m][0], v1 = acc[ai][bj][m][1];
                    u32x4 w; w.x = cvt_pk_bf16(v0[0], v0[1]); w.y = cvt_pk_bf16(v0[2], v0[3]); w.z = cvt_pk_bf16(v1[0], v1[1]); w.w = cvt_pk_bf16(v1[2], v1[3]);
                    *(u32x4*)(rowp + bj * 128) = w; } }
    }
};
struct EpiInProj {
    static constexpr bool PERM = true;
    bf16_t* O;
    __device__ __forceinline__ void operator()(g8::Acc& acc, const g8::Unit& u, int wr, int wc, int fr, int fq) const {
        const int pn = u.pn;
        const int row0 = u.pm * 256 + wr * 64 + fr;
        if (pn < 4 || pn >= 12) {
            const int col0 = pn * 256 + wc * 32 + 8 * fq;
#pragma unroll
            for (int ai = 0; ai < 2; ++ai)
#pragma unroll
                for (int m = 0; m < 4; ++m) { bf16_t* rowp = O + (size_t)(row0 + ai * 128 + m * 16) * NPROJ + col0;
#pragma unroll
                    for (int bj = 0; bj < 2; ++bj) { const f32x4 v0 = acc[ai][bj][m][0], v1 = acc[ai][bj][m][1];
                        u32x4 w; w.x = cvt_pk_bf16(v0[0], v0[1]); w.y = cvt_pk_bf16(v0[2], v0[3]); w.z = cvt_pk_bf16(v1[0], v1[1]); w.w = cvt_pk_bf16(v1[2], v1[3]);
                        *(u32x4*)(rowp + bj * 128) = w; } }
            return;
        }
        const bool isq = pn < 8;
        const int head = 2 * ((pn - 4) & 3) + (wc >> 1);
        const int dd0 = 32 * (wc & 1) + 8 * fq;
        const int colbase = (isq ? 1024 : 2048) + head * 128 + dd0;
        const float lg2 = log2f(1.0f - exp2f(-5.0f - (float)head));
        float fr_[8];
#pragma unroll
        for (int t = 0; t < 8; ++t) fr_[t] = exp2f(-(float)(dd0 + t) * 0.20762050593046014f) * 0.15915494309189535f;
#pragma unroll
        for (int ai = 0; ai < 2; ++ai)
#pragma unroll
            for (int m = 0; m < 4; ++m) {
                const int row = row0 + ai * 128 + m * 16, pos = row & 2047, i = wr * 64 + m * 16 + fr;
                const float sc = isq ? exp2f(lg2 * (float)i) : exp2f(-lg2 * (float)i) * 0.08838834764831845f;
                const float fp = (float)pos;
                float o1[8], o2[8];
#pragma unroll
                for (int t = 0; t < 8; ++t) {
                    const float rev = __builtin_amdgcn_fractf(fp * fr_[t]);
                    const float cs = __builtin_amdgcn_cosf(rev) * sc, sn = __builtin_amdgcn_sinf(rev) * sc;
                    const float a = acc[ai][0][m][t >> 2][t & 3], b = acc[ai][1][m][t >> 2][t & 3];
                    o1[t] = a * cs - b * sn; o2[t] = b * cs + a * sn;
                }
                bf16_t* rowp = O + (size_t)row * NPROJ + colbase;
                u32x4 w1, w2; w1.x = cvt_pk_bf16(o1[0], o1[1]); w1.y = cvt_pk_bf16(o1[2], o1[3]); w1.z = cvt_pk_bf16(o1[4], o1[5]); w1.w = cvt_pk_bf16(o1[6], o1[7]);
                w2.x = cvt_pk_bf16(o2[0], o2[1]); w2.y = cvt_pk_bf16(o2[2], o2[3]); w2.z = cvt_pk_bf16(o2[4], o2[5]); w2.w = cvt_pk_bf16(o2[6], o2[7]);
                *(u32x4*)rowp = w1; *(u32x4*)(rowp + 64) = w2;
            }
    }
};
struct EpiGlu {
    static constexpr bool PERM = true;
    const bf16_t* Z; bf16_t* CAT; float* rowss;
    __device__ __forceinline__ void operator()(g8::Acc& acc, const g8::Unit& u, int wr, int wc, int fr, int fq) const {
        const int row0 = u.pm * 256 + wr * 64 + fr, col0 = u.pn * 256 + wc * 32 + 8 * fq;
#pragma unroll
        for (int ai = 0; ai < 2; ++ai) {
            u32x4 zz[4][2];
#pragma unroll
            for (int m = 0; m < 4; ++m)
#pragma unroll
                for (int bj = 0; bj < 2; ++bj) zz[m][bj] = *(const u32x4*)(Z + (size_t)(row0 + ai * 128 + m * 16) * 1024 + col0 + bj * 128);
#pragma unroll
            for (int m = 0; m < 4; ++m) { const int row = row0 + ai * 128 + m * 16; float ss = 0.f;
#pragma unroll
                for (int bj = 0; bj < 2; ++bj) { const f32x4 v0 = acc[ai][bj][m][0], v1 = acc[ai][bj][m][1];
                    const u32x4 z4 = zz[m][bj];
                    float o[8];
                    o[0] = bf_lo(z4.x) * sigmoidf_(v0[0]); o[1] = bf_hi(z4.x) * sigmoidf_(v0[1]); o[2] = bf_lo(z4.y) * sigmoidf_(v0[2]); o[3] = bf_hi(z4.y) * sigmoidf_(v0[3]);
                    o[4] = bf_lo(z4.z) * sigmoidf_(v1[0]); o[5] = bf_hi(z4.z) * sigmoidf_(v1[1]); o[6] = bf_lo(z4.w) * sigmoidf_(v1[2]); o[7] = bf_hi(z4.w) * sigmoidf_(v1[3]);
#pragma unroll
                    for (int j = 0; j < 8; ++j) ss += o[j] * o[j];
                    u32x4 w; w.x = cvt_pk_bf16(o[0], o[1]); w.y = cvt_pk_bf16(o[2], o[3]); w.z = cvt_pk_bf16(o[4], o[5]); w.w = cvt_pk_bf16(o[6], o[7]);
                    *(u32x4*)(CAT + (size_t)row * DM + col0 + bj * 128) = w; }
                ss += __shfl_xor(ss, 16); ss += __shfl_xor(ss, 32);
                if (fq == 0) rowss[(size_t)row * 16 + u.pn * 4 + wc] = ss; }
        }
    }
};
struct OutSched : g8::StaticOrder {
    unsigned abase, bbase;
    __device__ __forceinline__ bool next(int i, g8::Unit& u) const {
        int pm, pn; if (!tile(i >> 1, pm, pn)) return false;
        const int half = i & 1;
        u.pm = __builtin_amdgcn_readfirstlane(pm); u.pn = __builtin_amdgcn_readfirstlane(pn); u.flags = half ? 0 : 1; u.aux = half;
        u.aoff = abase + (unsigned)u.pm * 256u * 4096u + (unsigned)half * 2048u; u.boff = bbase + (unsigned)u.pn * 256u * 4096u + (unsigned)half * (16u * 32768u); return true;
    }
    __device__ __forceinline__ void aoffs(const g8::Unit&, int R0, int C0, int R1, int C1, unsigned (&v)[2][2]) const {
        v[0][0] = (unsigned)(R0 * 2048 + C0) * 2u; v[0][1] = (unsigned)(R1 * 2048 + C1) * 2u;
        v[1][0] = (unsigned)((128 + R0) * 2048 + C0) * 2u; v[1][1] = (unsigned)((128 + R1) * 2048 + C1) * 2u;
    }
};
struct EpiOut {
    static constexpr bool PERM = true;
    const float* x; const float* mod; const float* rowss1; float* rowss2; bf16_t* X1;
    __device__ __forceinline__ void operator()(g8::Acc& acc, const g8::Unit& u, int wr, int wc, int fr, int fq) const {
        const int row0 = u.pm * 256 + wr * 64 + fr;
        if (u.aux == 0) {
#pragma unroll
            for (int ai = 0; ai < 2; ++ai)
#pragma unroll
                for (int m = 0; m < 4; ++m) { const f32x4* pp = (const f32x4*)(rowss1 + (size_t)(row0 + ai * 128 + m * 16) * 16);
                    const f32x4 p0 = pp[0], p1 = pp[1], p2 = pp[2], p3 = pp[3];
                    const float tot = (((p0[0] + p0[1]) + (p0[2] + p0[3])) + ((p1[0] + p1[1]) + (p1[2] + p1[3]))) + (((p2[0] + p2[1]) + (p2[2] + p2[3])) + ((p3[0] + p3[1]) + (p3[2] + p3[3])));
                    const float r = rsqrtf(tot * (1.0f / 1024.0f) + 1e-6f);
#pragma unroll
                    for (int bj = 0; bj < 2; ++bj)
#pragma unroll
                        for (int n = 0; n < 2; ++n) acc[ai][bj][m][n] *= r; }
            return;
        }
        const int col0 = u.pn * 256 + wc * 32 + 8 * fq;
        const int b = (u.pm * 256) >> 11;
        f32x4 gt[2][2];
#pragma unroll
        for (int bj = 0; bj < 2; ++bj)
#pragma unroll
            for (int n = 0; n < 2; ++n) gt[bj][n] = *(const f32x4*)(mod + (size_t)b * NMOD + 2 * DM + col0 + bj * 128 + n * 4);
#pragma unroll
        for (int am = 0; am < 4; ++am) {
            const int ai = am >> 1, m0 = (am & 1) * 2;
            f32x4 xv[2][2][2];
#pragma unroll
            for (int mm = 0; mm < 2; ++mm)
#pragma unroll
                for (int bj = 0; bj < 2; ++bj) { const size_t off = (size_t)(row0 + ai * 128 + (m0 + mm) * 16) * DM + col0 + bj * 128; xv[mm][bj][0] = *(const f32x4*)(x + off); xv[mm][bj][1] = *(const f32x4*)(x + off + 4); }
#pragma unroll
            for (int mm = 0; mm < 2; ++mm) { const int m = m0 + mm; const int row = row0 + ai * 128 + m * 16; float ss = 0.f;
#pragma unroll
                for (int bj = 0; bj < 2; ++bj) { const size_t off = (size_t)row * DM + col0 + bj * 128;
                    const f32x4 o0 = xv[mm][bj][0] + gt[bj][0] * acc[ai][bj][m][0], o1 = xv[mm][bj][1] + gt[bj][1] * acc[ai][bj][m][1];
                    ss += (o0[0] * o0[0] + o0[1] * o0[1]) + (o0[2] * o0[2] + o0[3] * o0[3]) + (o1[0] * o1[0] + o1[1] * o1[1]) + (o1[2] * o1[2] + o1[3] * o1[3]);
                    u32x4 w; w.x = cvt_pk_bf16(o0[0], o0[1]); w.y = cvt_pk_bf16(o0[2], o0[3]); w.z = cvt_pk_bf16(o1[0], o1[1]); w.w = cvt_pk_bf16(o1[2], o1[3]);
                    *(u32x4*)(X1 + off) = w; }
                ss += __shfl_xor(ss, 16); ss += __shfl_xor(ss, 32);
                if (fq == 0) rowss2[(size_t)row * 32 + u.pn * 4 + wc] = ss; }
        }
    }
};
struct MoeSched {
    const LAS int* tinfo; const LAS int* trows; int ntiles; int G, c; const int* list; unsigned abase, bbase; int mode;
    __device__ __forceinline__ bool next(int i, g8::Unit& u) const {
        int pn, ti;
        if ((G & 63) == 0) { const int x = c & 7, r = c >> 3, per = G >> 6;
            ti = (i * 8 + x) * per + (r >> 3); pn = r & 7; }
        else { const int L = i * G + c; pn = L & 7; ti = L >> 3; }
        if (ti >= ntiles) return false;
        const int inf = __builtin_amdgcn_readfirstlane(tinfo[ti]);
        const int e = inf & 255;
        u.pm = __builtin_amdgcn_readfirstlane(ti); u.pn = pn; u.flags = 0; u.aux = inf; u.aux2 = __builtin_amdgcn_readfirstlane(trows[ti]);
        if (mode == 0) { u.aoff = abase; u.boff = bbase + (unsigned)e * (2048u * 2048u) + (unsigned)pn * (256u * 2048u); }
        else { u.aoff = abase + (unsigned)ti * (256u * 1024u); u.boff = bbase + (unsigned)e * (2048u * 1024u) + (unsigned)pn * (256u * 1024u); }
        return true;
    }
    __device__ __forceinline__ void aoffs(const g8::Unit& u, int R0, int C0, int R1, int C1, unsigned (&v)[2][2]) const {
        if (mode == 0) {
            const int e = u.aux & 255, r0 = u.aux >> 8, n = u.aux2; const int* le = list + e * 16384 + r0;
            const int i00 = R0, i01 = R1, i10 = 128 + R0, i11 = 128 + R1;
            const int t00 = (i00 < n) ? (le[i00] >> 1) : 0, t01 = (i01 < n) ? (le[i01] >> 1) : 0, t10 = (i10 < n) ? (le[i10] >> 1) : 0, t11 = (i11 < n) ? (le[i11] >> 1) : 0;
            v[0][0] = (unsigned)(t00 * 2048 + C0 * 2); v[0][1] = (unsigned)(t01 * 2048 + C1 * 2); v[1][0] = (unsigned)(t10 * 2048 + C0 * 2); v[1][1] = (unsigned)(t11 * 2048 + C1 * 2);
        } else {
            v[0][0] = (unsigned)(R0 * 1024 + C0 * 2); v[0][1] = (unsigned)(R1 * 1024 + C1 * 2);
            v[1][0] = (unsigned)((128 + R0) * 1024 + C0 * 2); v[1][1] = (unsigned)((128 + R1) * 1024 + C1 * 2);
        }
    }
};
struct EpiMoe1 {
    static constexpr bool PERM = true;
    unsigned char* HM;
    __device__ __forceinline__ void operator()(g8::Acc& acc, const g8::Unit& u, int wr, int wc, int fr, int fq) const {
        const int row0 = u.pm * 256 + wr * 64 + fr, col0 = u.pn * 128 + wc * 32 + 8 * fq;
        const float inv = 1.0f / WGU_SCALE;
#pragma unroll
        for (int ai = 0; ai < 2; ++ai)
#pragma unroll
            for (int m = 0; m < 4; ++m) { float o[8];
#pragma unroll
                for (int n = 0; n < 2; ++n)
#pragma unroll
                    for (int j = 0; j < 4; ++j) { const float gv = acc[ai][0][m][n][j] * inv, uv = acc[ai][1][m][n][j] * inv; o[n * 4 + j] = gv * sigmoidf_(gv) * uv; }
                int q0 = 0, q1 = 0;
                q0 = __builtin_amdgcn_cvt_pk_fp8_f32(o[0], o[1], q0, false); q0 = __builtin_amdgcn_cvt_pk_fp8_f32(o[2], o[3], q0, true);
                q1 = __builtin_amdgcn_cvt_pk_fp8_f32(o[4], o[5], q1, false); q1 = __builtin_amdgcn_cvt_pk_fp8_f32(o[6], o[7], q1, true);
                *(u32x2*)(HM + (size_t)(row0 + ai * 128 + m * 16) * 1024 + col0) = (u32x2){(unsigned)q0, (unsigned)q1}; }
    }
};
constexpr float Y2_SCALE = 16.0f;
struct EpiMoe2 {
    static constexpr bool PERM = true;
    const u32x2* slot; unsigned char* Y2;
    __device__ __forceinline__ void operator()(g8::Acc& acc, const g8::Unit& u, int wr, int wc, int fr, int fq) const {
        const int col0 = u.pn * 256 + wc * 32 + 8 * fq;
        u32x2 si[2][4];
#pragma unroll
        for (int ai = 0; ai < 2; ++ai)
#pragma unroll
            for (int m = 0; m < 4; ++m) si[ai][m] = slot[u.pm * 256 + ai * 128 + wr * 64 + m * 16 + fr];
#pragma unroll
        for (int ai = 0; ai < 2; ++ai)
#pragma unroll
            for (int m = 0; m < 4; ++m) { const int asg = (int)si[ai][m].x;
                if (asg >= 0) { unsigned char* rowp = Y2 + (size_t)asg * DM + col0; const float ww = __uint_as_float(si[ai][m].y) * Y2_SCALE;
#pragma unroll
                    for (int bj = 0; bj < 2; ++bj) { const f32x4 v0 = acc[ai][bj][m][0] * ww, v1 = acc[ai][bj][m][1] * ww;
                        int q0 = 0, q1 = 0;
                        q0 = __builtin_amdgcn_cvt_pk_fp8_f32(v0[0], v0[1], q0, false); q0 = __builtin_amdgcn_cvt_pk_fp8_f32(v0[2], v0[3], q0, true);
                        q1 = __builtin_amdgcn_cvt_pk_fp8_f32(v1[0], v1[1], q1, false); q1 = __builtin_amdgcn_cvt_pk_fp8_f32(v1[2], v1[3], q1, true);
                        *(u32x2*)(rowp + bj * 128) = (u32x2){(unsigned)q0, (unsigned)q1}; } } }
    }
};

constexpr size_t WS_KV = WS_H;
__device__ __forceinline__ void ssm_item(const Params& P, LAS unsigned char* lds, int tid, int item) {
    const int g = item >> 2, bp = item & 3;
    const int wave = __builtin_amdgcn_readfirstlane(tid >> 6), lane = tid & 63, fr = lane & 15, fq = lane >> 4;
    const bf16_t* proj = (const bf16_t*)(P.ws + WS_PROJ);
    const bf16_t* Ms = (const bf16_t*)(P.ws + WS_SSMM) + (size_t)g * 131072;
    const bf16_t* TM = Ms + 32768;
    bf16_t* Zo = (bf16_t*)(P.ws + WS_Z);
    constexpr int ZS = 136, MS = 264, TS = 392;
    LAS bf16_t* ZB = (LAS bf16_t*)lds;
    LAS bf16_t* WB = (LAS bf16_t*)(lds + 256 * ZS * 2);
    const int b = 2 * bp + (wave >> 2);
    int tok0[2];
    bf16x8 Uf[2][8];
#pragma unroll
    for (int mt = 0; mt < 2; ++mt) {
        const int c = 32 * (wave & 3) + 16 * mt + fr; tok0[mt] = b * 2048 + c * 16;
#pragma unroll
        for (int ks = 0; ks < 8; ++ks) Uf[mt][ks] = *(const bf16x8*)(proj + (size_t)(tok0[mt] + 2 * ks + (fq >> 1)) * NPROJ + g * 16 + 8 * (fq & 1));
    }
#pragma unroll
    for (int i = 0; i < 8; ++i) { const int row = tid >> 2, kc = (tid & 3) + 4 * i; *(LAS u32x4*)(WB + row * MS + kc * 8) = *(const u32x4*)(Ms + row * 256 + kc * 8); }
    __syncthreads();
#pragma unroll
    for (int nt = 0; nt < 8; ++nt) {
        f32x4 a0 = {0.f, 0.f, 0.f, 0.f}, a1 = {0.f, 0.f, 0.f, 0.f};
#pragma unroll
        for (int ks = 0; ks < 8; ++ks) {
            const bf16x8 bf = *(const LAS bf16x8*)(WB + (16 * nt + fr) * MS + 32 * ks + 8 * fq);
            a0 = __builtin_amdgcn_mfma_f32_16x16x32_bf16(bf, Uf[0][ks], a0, 0, 0, 0);
            a1 = __builtin_amdgcn_mfma_f32_16x16x32_bf16(bf, Uf[1][ks], a1, 0, 0, 0);
        }
        *(LAS u32x2*)(ZB + (32 * wave + fr) * ZS + 16 * nt + 4 * fq) = (u32x2){cvt_pk_bf16(a0[0], a0[1]), cvt_pk_bf16(a0[2], a0[3])};
        *(LAS u32x2*)(ZB + (32 * wave + 16 + fr) * ZS + 16 * nt + 4 * fq) = (u32x2){cvt_pk_bf16(a1[0], a1[1]), cvt_pk_bf16(a1[2], a1[3])};
    }
    u32x4 tmr[6];
#pragma unroll
    for (int i = 0; i < 6; ++i) { const int row = tid >> 3, kc = (tid & 7) + 8 * i; tmr[i] = *(const u32x4*)(TM + (size_t)row * 384 + kc * 8); }
    __syncthreads();
    if (tid < 128) {
        const int bl = tid >> 6, p = tid & 63;
        const f32x2 al = ((const f32x2*)(P.ws + WS_SSMA))[g * 64 + p];
        float xr = 0.f, xi = 0.f;
        LAS unsigned* zw = (LAS unsigned*)ZB + (bl * 128) * (ZS / 2) + p;
        for (int c0 = 0; c0 < 128; c0 += 8) {
            unsigned zv[8];
#pragma unroll
            for (int k = 0; k < 8; ++k) zv[k] = zw[(c0 + k) * (ZS / 2)];
#pragma unroll
            for (int k = 0; k < 8; ++k) {
                zw[(c0 + k) * (ZS / 2)] = cvt_pk_bf16(xr, xi);
                const float t = al.x * xr - al.y * xi + bf_lo(zv[k]); xi = al.x * xi + al.y * xr + bf_hi(zv[k]); xr = t;
            }
        }
    }
#pragma unroll
    for (int i = 0; i < 6; ++i) { const int row = tid >> 3, kc = (tid & 7) + 8 * i; *(LAS u32x4*)(WB + row * TS + kc * 8) = tmr[i]; }
    __syncthreads();
    const LAS bf16_t* xrow = ZB + (32 * wave + fr) * ZS + 8 * fq;
    const f32x4 dv = *(const f32x4*)(P.in[12] + g * 16 + 4 * fq);
#pragma unroll
    for (int cq = 0; cq < 4; ++cq) {
        u32x2 uu[4][2];
#pragma unroll
        for (int ntl = 0; ntl < 4; ++ntl)
#pragma unroll
            for (int mt = 0; mt < 2; ++mt) uu[ntl][mt] = *(const u32x2*)(proj + (size_t)(tok0[mt] + 4 * cq + ntl) * NPROJ + g * 16 + 4 * fq);
        if (cq < 3) {
#pragma unroll
            for (int i = 0; i < 6; ++i) { const int row = tid >> 3, kc = (tid & 7) + 8 * i; tmr[i] = *(const u32x4*)(TM + (size_t)(64 * (cq + 1) + row) * 384 + kc * 8); }
        }
#pragma unroll
        for (int ntl = 0; ntl < 4; ++ntl) {
            const int nt = 4 * cq + ntl;
            f32x4 a0 = {0.f, 0.f, 0.f, 0.f}, a1 = {0.f, 0.f, 0.f, 0.f};
            const LAS bf16_t* brow = WB + (16 * ntl + fr) * TS + 8 * fq;
#pragma unroll
            for (int ks = 0; ks < 8; ++ks) {
                if (2 * ks <= nt) {
                    const bf16x8 bf = *(const LAS bf16x8*)(brow + 32 * ks);
                    a0 = __builtin_amdgcn_mfma_f32_16x16x32_bf16(bf, Uf[0][ks], a0, 0, 0, 0);
                    a1 = __builtin_amdgcn_mfma_f32_16x16x32_bf16(bf, Uf[1][ks], a1, 0, 0, 0);
                }
            }
#pragma unroll
            for (int k2 = 0; k2 < 4; ++k2) {
                const bf16x8 bf = *(const LAS bf16x8*)(brow + 256 + 32 * k2);
                const bf16x8 x0 = *(const LAS bf16x8*)(xrow + 32 * k2), x1 = *(const LAS bf16x8*)(xrow + 16 * ZS + 32 * k2);
                a0 = __builtin_amdgcn_mfma_f32_16x16x32_bf16(bf, x0, a0, 0, 0, 0);
                a1 = __builtin_amdgcn_mfma_f32_16x16x32_bf16(bf, x1, a1, 0, 0, 0);
            }
#pragma unroll
            for (int mt = 0; mt < 2; ++mt) {
                const f32x4 a = mt ? a1 : a0;
                const size_t tok = (size_t)(tok0[mt] + nt);
                const u32x2 u2 = uu[ntl][mt];
                const float y0 = a[0] + dv[0] * bf_lo(u2.x), y1 = a[1] + dv[1] * bf_hi(u2.x), y2 = a[2] + dv[2] * bf_lo(u2.y), y3 = a[3] + dv[3] * bf_hi(u2.y);
                u32x2 w; w.x = cvt_pk_bf16(gelu_tanh(y0), gelu_tanh(y1)); w.y = cvt_pk_bf16(gelu_tanh(y2), gelu_tanh(y3));
                *(u32x2*)(Zo + tok * 1024 + g * 16 + 4 * fq) = w;
            }
        }
        __syncthreads();
        if (cq < 3) {
#pragma unroll
            for (int i = 0; i < 6; ++i) { const int row = tid >> 3, kc = (tid & 7) + 8 * i; *(LAS u32x4*)(WB + row * TS + kc * 8) = tmr[i]; }
            __syncthreads();
        }
    }
}

__device__ __forceinline__ bf16x8 tr_frag(const LAS bf16_t* tile, int row0, int col0, int fr, int fq) {
    const LAS bf16_t* p = tile + (row0 + 8 * fq + (fr >> 2)) * 136 + col0 + 4 * (fr & 3);
    const bf16x4 a = __builtin_amdgcn_ds_read_tr16_b64_v4i16((LAS bf16x4*)p);
    const bf16x4 b = __builtin_amdgcn_ds_read_tr16_b64_v4i16((LAS bf16x4*)(p + 4 * 136));
    bf16x8 r; r[0] = a[0]; r[1] = a[1]; r[2] = a[2]; r[3] = a[3]; r[4] = b[0]; r[5] = b[1]; r[6] = b[2]; r[7] = b[3]; return r;
}
__device__ __forceinline__ void ret_kv_items(const Params& P, LAS unsigned char* lds, int tid, int first, int stride) {
    const int wave = __builtin_amdgcn_readfirstlane(tid >> 6), lane = tid & 63, fr = lane & 15, fq = lane >> 4;
    constexpr int RS = 136;
    LAS bf16_t* Ks = (LAS bf16_t*)lds; LAS bf16_t* Vs = Ks + 128 * RS;
    const bf16_t* proj = (const bf16_t*)(P.ws + WS_PROJ);
    bf16_t* KV = (bf16_t*)(P.ws + WS_KV);
    const int si = tid >> 2, part = tid & 3, i0 = 16 * wave;
    u32x4 kr[4], vr[4];
    int item = first;
    if (item >= 768) return;
    { const int bh = item / 12, n = item % 12; const bf16_t* pr = proj + ((size_t)(bh >> 3) * 2048 + n * 128 + si) * NPROJ + (bh & 7) * 128 + 32 * part;
#pragma unroll
      for (int j = 0; j < 4; ++j) { kr[j] = *(const u32x4*)(pr + 2048 + 8 * j); vr[j] = *(const u32x4*)(pr + 3072 + 8 * j); } }
    for (;;) {
#pragma unroll
        for (int j = 0; j < 4; ++j) { *(LAS u32x4*)(Ks + si * RS + 32 * part + 8 * j) = kr[j]; *(LAS u32x4*)(Vs + si * RS + 32 * part + 8 * j) = vr[j]; }
        __syncthreads();
        const int nxt = item + stride; const bool more = nxt < 768;
        if (more) { const int bh = nxt / 12, n = nxt % 12; const bf16_t* pr = proj + ((size_t)(bh >> 3) * 2048 + n * 128 + si) * NPROJ + (bh & 7) * 128 + 32 * part;
#pragma unroll
            for (int j = 0; j < 4; ++j) { kr[j] = *(const u32x4*)(pr + 2048 + 8 * j); vr[j] = *(const u32x4*)(pr + 3072 + 8 * j); } }
        bf16x8 Vt[4];
#pragma unroll
        for (int ks = 0; ks < 4; ++ks) Vt[ks] = tr_frag(Vs, 32 * ks, i0, fr, fq);
        const int bh = item / 12, n = item % 12;
        bf16_t* op = KV + ((size_t)(bh * 16 + n) * 128 + i0 + fr) * 128 + 4 * fq;
#pragma unroll
        for (int nt = 0; nt < 8; ++nt) {
            f32x4 a = {0.f, 0.f, 0.f, 0.f};
#pragma unroll
            for (int ks = 0; ks < 4; ++ks) { const bf16x8 kf = tr_frag(Ks, 32 * ks, 16 * nt, fr, fq); a = __builtin_amdgcn_mfma_f32_16x16x32_bf16(kf, Vt[ks], a, 0, 0, 0); }
            *(u32x2*)(op + 16 * nt) = (u32x2){cvt_pk_bf16(a[0], a[1]), cvt_pk_bf16(a[2], a[3])};
        }
        __syncthreads();
        if (!more) break;
        item = nxt;
    }
}
__device__ __forceinline__ void ret_out_item(const Params& P, LAS unsigned char* lds, int tid, int item) {
    const int bh = item >> 2, q = item & 3, b = bh >> 3, h = bh & 7;
    const int wave = __builtin_amdgcn_readfirstlane(tid >> 6), lane = tid & 63, fr = lane & 15, fq = lane >> 4;
    constexpr int RS = 136;
    LAS bf16_t* Qs = (LAS bf16_t*)lds;
    LAS bf16_t* Ks = Qs + 128 * RS;
    LAS bf16_t* Vs = Ks + 128 * RS;
    LAS bf16_t* Rs = Vs + 128 * RS;
    const bf16_t* proj = (const bf16_t*)(P.ws + WS_PROJ);
    const bf16_t* KV = (const bf16_t*)(P.ws + WS_KV);
    bf16_t* CAT = (bf16_t*)(P.ws + WS_CAT);
    const float gam = 1.0f - exp2f(-5.0f - (float)h);
    const float lg2 = log2f(gam);
    const float gC1 = exp2f(lg2 * 127.0f), gC = exp2f(lg2 * 128.0f);
    const int si = tid >> 2, part = tid & 3, i0 = 16 * wave;
    u32x4 st[12];
    { const bf16_t* pr = proj + ((size_t)b * 2048 + (4 * q) * 128 + si) * NPROJ + h * 128 + 32 * part;
#pragma unroll
      for (int j = 0; j < 4; ++j) { st[j] = *(const u32x4*)(pr + 1024 + 8 * j); st[4 + j] = *(const u32x4*)(pr + 2048 + 8 * j); st[8 + j] = *(const u32x4*)(pr + 3072 + 8 * j); } }
    f32x4 accR[8];
#pragma unroll
    for (int nt = 0; nt < 8; ++nt) accR[nt] = (f32x4){0.f, 0.f, 0.f, 0.f};
    for (int m = 0; m < 4 * q; ++m) {
        const bf16_t* tp = KV + ((size_t)(bh * 16 + m) * 128 + i0 + fr) * 128 + 4 * fq;
        u32x2 t[8];
#pragma unroll
        for (int nt = 0; nt < 8; ++nt) t[nt] = *(const u32x2*)(tp + 16 * nt);
#pragma unroll
        for (int nt = 0; nt < 8; ++nt) { const f32x4 kv = {bf_lo(t[nt].x), bf_hi(t[nt].x), bf_lo(t[nt].y), bf_hi(t[nt].y)}; accR[nt] = accR[nt] * gC + kv * gC1; }
    }
#pragma unroll
    for (int nt = 0; nt < 8; ++nt)
        *(LAS u32x2*)(Rs + (i0 + fr) * RS + 16 * nt + 4 * fq) = (u32x2){cvt_pk_bf16(accR[nt][0], accR[nt][1]), cvt_pk_bf16(accR[nt][2], accR[nt][3])};
    for (int nn = 0; nn < 4; ++nn) {
        const int n = 4 * q + nn;
#pragma unroll
        for (int j = 0; j < 4; ++j) { *(LAS u32x4*)(Qs + si * RS + 32 * part + 8 * j) = st[j]; *(LAS u32x4*)(Ks + si * RS + 32 * part + 8 * j) = st[4 + j]; *(LAS u32x4*)(Vs + si * RS + 32 * part + 8 * j) = st[8 + j]; }
        __syncthreads();
        if (nn < 3) { const bf16_t* pr = proj + ((size_t)b * 2048 + (n + 1) * 128 + si) * NPROJ + h * 128 + 32 * part;
#pragma unroll
            for (int j = 0; j < 4; ++j) { st[j] = *(const u32x4*)(pr + 1024 + 8 * j); st[4 + j] = *(const u32x4*)(pr + 2048 + 8 * j); st[8 + j] = *(const u32x4*)(pr + 3072 + 8 * j); } }
        const size_t tok = (size_t)b * 2048 + n * 128 + i0 + fr;
        u32x2 gg[8];
        { const bf16_t* gp = proj + tok * NPROJ + 4096 + h * 128 + 4 * fq;
#pragma unroll
          for (int nt = 0; nt < 8; ++nt) gg[nt] = *(const u32x2*)(gp + 16 * nt); }
        bf16x8 Qf[4];
#pragma unroll
        for (int ks = 0; ks < 4; ++ks) Qf[ks] = *(const LAS bf16x8*)(Qs + (i0 + fr) * RS + 32 * ks + 8 * fq);
        f32x4 accS[8], accO[8];
#pragma unroll
        for (int nt = 0; nt < 8; ++nt) { accS[nt] = (f32x4){0.f, 0.f, 0.f, 0.f}; accO[nt] = (f32x4){0.f, 0.f, 0.f, 0.f}; }
#pragma unroll
        for (int nt = 0; nt < 8; ++nt) {
            if (nt <= wave) {
#pragma unroll
                for (int ks = 0; ks < 4; ++ks) { const bf16x8 kf = *(const LAS bf16x8*)(Ks + (16 * nt + fr) * RS + 32 * ks + 8 * fq); accS[nt] = __builtin_amdgcn_mfma_f32_16x16x32_bf16(kf, Qf[ks], accS[nt], 0, 0, 0); }
            }
        }
        if (n > 0) {
#pragma unroll
            for (int nt = 0; nt < 8; ++nt) {
#pragma unroll
                for (int ks = 0; ks < 4; ++ks) { const bf16x8 rf = *(const LAS bf16x8*)(Rs + (16 * nt + fr) * RS + 32 * ks + 8 * fq); accO[nt] = __builtin_amdgcn_mfma_f32_16x16x32_bf16(rf, Qf[ks], accO[nt], 0, 0, 0); }
                accO[nt] *= gam;
            }
        }
#pragma unroll
        for (int nt = 0; nt < 8; ++nt) {
            const int i = i0 + fr, j0 = 16 * nt + 4 * fq;
            const float p0 = (j0 <= i) ? accS[nt][0] : 0.f, p1 = (j0 + 1 <= i) ? accS[nt][1] : 0.f, p2 = (j0 + 2 <= i) ? accS[nt][2] : 0.f, p3 = (j0 + 3 <= i) ? accS[nt][3] : 0.f;
            *(LAS u32x2*)(Qs + i * RS + j0) = (u32x2){cvt_pk_bf16(p0, p1), cvt_pk_bf16(p2, p3)};
        }
        asm volatile("" ::: "memory");
        bf16x8 Pf[4];
#pragma unroll
        for (int ks = 0; ks < 4; ++ks) Pf[ks] = *(const LAS bf16x8*)(Qs + (i0 + fr) * RS + 32 * ks + 8 * fq);
#pragma unroll
        for (int ks = 0; ks < 4; ++ks) {
            if (2 * ks <= wave) {
#pragma unroll
                for (int nt = 0; nt < 8; ++nt) { const bf16x8 vf = tr_frag(Vs, 32 * ks, 16 * nt, fr, fq); accO[nt] = __builtin_amdgcn_mfma_f32_16x16x32_bf16(vf, Pf[ks], accO[nt], 0, 0, 0); }
            }
        }
        if (nn < 3) {
            bf16x8 Vt[4];
#pragma unroll
            for (int ks = 0; ks < 4; ++ks) Vt[ks] = tr_frag(Vs, 32 * ks, i0, fr, fq);
#pragma unroll
            for (int nt = 0; nt < 8; ++nt) {
                accR[nt] *= gam;
#pragma unroll
                for (int ks = 0; ks < 4; ++ks) { const bf16x8 kf = tr_frag(Ks, 32 * ks, 16 * nt, fr, fq); accR[nt] = __builtin_amdgcn_mfma_f32_16x16x32_bf16(kf, Vt[ks], accR[nt], 0, 0, 0); }
                accR[nt] *= gC1;
            }
        }
        {
            float s = 0.f;
#pragma unroll
            for (int nt = 0; nt < 8; ++nt) s += (accO[nt][0] + accO[nt][1]) + (accO[nt][2] + accO[nt][3]);
            s += __shfl_xor(s, 16); s += __shfl_xor(s, 32);
            const float mu = s * (1.0f / 128.0f); float qv = 0.f;
#pragma unroll
            for (int nt = 0; nt < 8; ++nt) { const f32x4 d = accO[nt] - mu; qv += (d[0] * d[0] + d[1] * d[1]) + (d[2] * d[2] + d[3] * d[3]); }
            qv += __shfl_xor(qv, 16); qv += __shfl_xor(qv, 32);
            const float rstd = rsqrtf(qv * (1.0f / 128.0f) + 1e-5f);
            bf16_t* op = CAT + tok * DM + 1024 + h * 128 + 4 * fq;
#pragma unroll
            for (int nt = 0; nt < 8; ++nt) {
                const float g0 = bf_lo(gg[nt].x), g1 = bf_hi(gg[nt].x), g2 = bf_lo(gg[nt].y), g3 = bf_hi(gg[nt].y);
                const f32x4 y = (accO[nt] - mu) * rstd;
                u32x2 w; w.x = cvt_pk_bf16(y[0] * g0 * sigmoidf_(g0), y[1] * g1 * sigmoidf_(g1)); w.y = cvt_pk_bf16(y[2] * g2 * sigmoidf_(g2), y[3] * g3 * sigmoidf_(g3));
                *(u32x2*)(op + 16 * nt) = w;
            }
        }
        __syncthreads();
        if (nn < 3) {
#pragma unroll
            for (int nt = 0; nt < 8; ++nt)
                *(LAS u32x2*)(Rs + (i0 + fr) * RS + 16 * nt + 4 * fq) = (u32x2){cvt_pk_bf16(accR[nt][0], accR[nt][1]), cvt_pk_bf16(accR[nt][2], accR[nt][3])};
        }
    }
}

__device__ __forceinline__ void p6_route(const Params& P, LAS unsigned char* lds, int tid, int blk, int G) {
    const int wave = __builtin_amdgcn_readfirstlane(tid >> 6), lane = tid & 63, fr = lane & 15, fq = lane >> 4;
    LAS float* gm = (LAS float*)lds; LAS float* sh = gm + 2048; LAS float* lg = sh + 2048;
    LAS float* lgr = lg + 8 * 64 * 48;
    LAS float* r2s = lgr + 64 * 36;
    LAS int* lcnt = (LAS int*)(r2s + 64); LAS int* lbase = lcnt + 32;
    int ra_ = 0, rb_ = 0, ea_ = 0, eb_ = 0; float w1_ = 0.f, w2_ = 0.f;
    const float* mod = (const float*)(P.ws + WS_MOD);
    const bf16_t* x1 = (const bf16_t*)(P.ws + WS_X1); const float* rowss2 = (const float*)(P.ws + WS_ROWSS2);
    unsigned char* H2 = P.ws + WS_H;
    const bf16_t* WR = (const bf16_t*)(P.ws + WS_WR);
    int* cnt = (int*)(P.ws + WS_CNT); int* list = (int*)(P.ws + WS_LIST); float* wgt = (float*)(P.ws + WS_WGT);
    for (int rb = blk; rb < 256; rb += G) {
        const int b = rb >> 5;
        for (int k = tid; k < 2048; k += NTHREADS) { gm[k] = P.in[18][k] * (1.0f + mod[(size_t)b * NMOD + 4 * DM + k]); sh[k] = mod[(size_t)b * NMOD + 3 * DM + k]; }
        if (tid < 32) lcnt[tid] = 0;
        if (tid >= 64 && tid < 128) { const int r = tid - 64; float tot2 = 0.f; const f32x4* pp = (const f32x4*)(rowss2 + (size_t)(rb * 64 + r) * 32);
#pragma unroll
            for (int i = 0; i < 8; ++i) { const f32x4 v = pp[i]; tot2 += (v[0] + v[1]) + (v[2] + v[3]); }
            r2s[r] = rsqrtf(tot2 * (1.0f / 2048.0f) + 1e-6f); }
        __syncthreads();
        float r2v[4];
#pragma unroll
        for (int mt = 0; mt < 4; ++mt) r2v[mt] = r2s[16 * mt + fr];
        f32x4 acc[4][3];
#pragma unroll
        for (int mt = 0; mt < 4; ++mt)
#pragma unroll
            for (int nt = 0; nt < 3; ++nt) acc[mt][nt] = (f32x4){0.f, 0.f, 0.f, 0.f};
        const bf16_t* xb = x1 + (size_t)(rb * 64 + fr) * DM + 256 * wave + 8 * fq;
        const bf16_t* wb = WR + (size_t)fr * 2048 + 256 * wave + 8 * fq;
        unsigned char* hb = H2 + (size_t)(rb * 64 + fr) * DM + 256 * wave + 8 * fq;
        u32x4 xc[2][4], xn[2][4]; bf16x8 bc[2][3], bn[2][3];
#pragma unroll
        for (int j = 0; j < 2; ++j) {
#pragma unroll
            for (int mt = 0; mt < 4; ++mt) xc[j][mt] = *(const u32x4*)(xb + (size_t)(16 * mt) * DM + 32 * j);
#pragma unroll
            for (int nt = 0; nt < 3; ++nt) bc[j][nt] = *(const bf16x8*)(wb + (size_t)(16 * nt) * 2048 + 32 * j); }
#pragma unroll 1
        for (int qt = 0; qt < 4; ++qt) {
            const int qn = qt < 3 ? qt + 1 : 3;
#pragma unroll
            for (int j = 0; j < 2; ++j) {
#pragma unroll
                for (int mt = 0; mt < 4; ++mt) xn[j][mt] = *(const u32x4*)(xb + (size_t)(16 * mt) * DM + 32 * (2 * qn + j));
#pragma unroll
                for (int nt = 0; nt < 3; ++nt) bn[j][nt] = *(const bf16x8*)(wb + (size_t)(16 * nt) * 2048 + 32 * (2 * qn + j)); }
#pragma unroll
            for (int j = 0; j < 2; ++j) {
                const int kl = 256 * wave + 32 * (2 * qt + j) + 8 * fq;
                const f32x4 g0 = *(const LAS f32x4*)(gm + kl), g1 = *(const LAS f32x4*)(gm + kl + 4), s0 = *(const LAS f32x4*)(sh + kl), s1 = *(const LAS f32x4*)(sh + kl + 4);
#pragma unroll
                for (int mt = 0; mt < 4; ++mt) {
                    const u32x4 xw = xc[j][mt];
                    const f32x4 a = {bf_lo(xw.x), bf_hi(xw.x), bf_lo(xw.y), bf_hi(xw.y)}, c = {bf_lo(xw.z), bf_hi(xw.z), bf_lo(xw.w), bf_hi(xw.w)};
                    const f32x4 h0 = a * r2v[mt] * g0 + s0, h1 = c * r2v[mt] * g1 + s1;
                    u32x4 w; w.x = cvt_pk_bf16(h0[0], h0[1]); w.y = cvt_pk_bf16(h0[2], h0[3]); w.z = cvt_pk_bf16(h1[0], h1[1]); w.w = cvt_pk_bf16(h1[2], h1[3]);
                    int q0 = 0, q1 = 0;
                    q0 = __builtin_amdgcn_cvt_pk_fp8_f32(h0[0], h0[1], q0, false); q0 = __builtin_amdgcn_cvt_pk_fp8_f32(h0[2], h0[3], q0, true);
                    q1 = __builtin_amdgcn_cvt_pk_fp8_f32(h1[0], h1[1], q1, false); q1 = __builtin_amdgcn_cvt_pk_fp8_f32(h1[2], h1[3], q1, true);
                    *(u32x2*)(hb + (size_t)(16 * mt) * DM + 32 * (2 * qt + j)) = (u32x2){(unsigned)q0, (unsigned)q1};
                    const bf16x8 af = __builtin_bit_cast(bf16x8, w);
#pragma unroll
                    for (int nt = 0; nt < 3; ++nt) acc[mt][nt] = __builtin_amdgcn_mfma_f32_16x16x32_bf16(bc[j][nt], af, acc[mt][nt], 0, 0, 0);
                }
            }
#pragma unroll
            for (int j = 0; j < 2; ++j) {
#pragma unroll
                for (int mt = 0; mt < 4; ++mt) xc[j][mt] = xn[j][mt];
#pragma unroll
                for (int nt = 0; nt < 3; ++nt) bc[j][nt] = bn[j][nt]; }
        }
#pragma unroll
        for (int mt = 0; mt < 4; ++mt)
#pragma unroll
            for (int nt = 0; nt < 3; ++nt) *(LAS f32x4*)(lg + (wave * 64 + 16 * mt + fr) * 48 + 16 * nt + 4 * fq) = acc[mt][nt];
        __syncthreads();
        for (int o = tid; o < 64 * 36; o += NTHREADS) { const int r = o / 36, nn = o % 36; float sum = 0.f;
#pragma unroll
            for (int w = 0; w < 8; ++w) sum += lg[(w * 64 + r) * 48 + nn];
            lgr[o] = sum; }
        __syncthreads();
        if (tid < 64) {
            const int tok = rb * 64 + tid;
            float l[36];
#pragma unroll
            for (int nn = 0; nn < 36; ++nn) l[nn] = lgr[tid * 36 + nn];
            float gl[4]; int gs = 0;
#pragma unroll
            for (int j = 0; j < 4; ++j) gl[j] = l[j] + P.in[20][j];
#pragma unroll
            for (int j = 1; j < 4; ++j) if (gl[j] > gl[gs]) gs = j;
            float gmax = gl[0];
#pragma unroll
            for (int j = 1; j < 4; ++j) gmax = fmaxf(gmax, gl[j]);
            float den = 0.f;
#pragma unroll
            for (int j = 0; j < 4; ++j) den += expf(gl[j] - gmax);
            const float gw = 1.0f / den;
            float el[8];
#pragma unroll
            for (int j = 0; j < 8; ++j) { float v = 0.f;
#pragma unroll
                for (int q = 0; q < 4; ++q) v = (gs == q) ? (l[4 + q * 8 + j] + P.in[22][q * 8 + j]) : v;
                el[j] = v; }
            int j1 = 0;
#pragma unroll
            for (int j = 1; j < 8; ++j) if (el[j] > el[j1]) j1 = j;
            int j2 = (j1 == 0) ? 1 : 0;
#pragma unroll
            for (int j = 0; j < 8; ++j) if (j != j1 && j != j2 && el[j] > el[j2]) j2 = j;
            float e1 = el[0], e2 = el[0];
#pragma unroll
            for (int j = 0; j < 8; ++j) { e1 = (j == j1) ? el[j] : e1; e2 = (j == j2) ? el[j] : e2; }
            const float t2 = expf(e2 - e1), w1 = gw / (1.0f + t2), w2 = gw * t2 / (1.0f + t2);
            const int ea = gs * 8 + j1, eb = gs * 8 + j2;
            ra_ = atomicAdd((int*)&lcnt[ea], 1); rb_ = atomicAdd((int*)&lcnt[eb], 1); ea_ = ea; eb_ = eb; w1_ = w1; w2_ = w2;
        }
        __syncthreads();
        if (tid < 32) { const int c = lcnt[tid]; lbase[tid] = c > 0 ? atomicAdd(cnt + tid * 64, c) : 0; }
        __syncthreads();
        if (tid < 64) {
            const int tok = rb * 64 + tid;
            list[ea_ * 16384 + lbase[ea_] + ra_] = tok * 2; wgt[tok * 2] = w1_;
            list[eb_ * 16384 + lbase[eb_] + rb_] = tok * 2 + 1; wgt[tok * 2 + 1] = w2_;
        }
        __syncthreads();
    }
}

__device__ __forceinline__ void p9_final(const Params& P, int tid, int blk, int G) {
    const int wave = tid >> 6, lane = tid & 63;
    const float* mod = (const float*)(P.ws + WS_MOD); const unsigned char* Y2 = P.ws + WS_Y2; const bf16_t* X1 = (const bf16_t*)(P.ws + WS_X1);
    f32x4 gf[8];
#pragma unroll
    for (int i = 0; i < 8; ++i) gf[i] = *(const f32x4*)(P.in[26] + (i * 64 + lane) * 4);
    int row = blk * 8 + wave;
    u32x2 xw[8], xwn[8]; unsigned ya[8], yb[8], yan[8], ybn[8];
    if (row < NTOK) {
#pragma unroll
        for (int i = 0; i < 8; ++i) { const int k = (i * 64 + lane) * 4; xw[i] = *(const u32x2*)(X1 + (size_t)row * DM + k); ya[i] = *(const unsigned*)(Y2 + (size_t)(2 * row) * DM + k); yb[i] = *(const unsigned*)(Y2 + (size_t)(2 * row + 1) * DM + k); }
    }
    for (; row < NTOK; row += G * 8) {
        const int b = row >> 11, rown = row + G * 8;
        if (rown < NTOK) {
#pragma unroll
            for (int i = 0; i < 8; ++i) { const int k = (i * 64 + lane) * 4; xwn[i] = *(const u32x2*)(X1 + (size_t)rown * DM + k); yan[i] = *(const unsigned*)(Y2 + (size_t)(2 * rown) * DM + k); ybn[i] = *(const unsigned*)(Y2 + (size_t)(2 * rown + 1) * DM + k); }
        }
        f32x4 v[8]; float ss = 0.f;
#pragma unroll
        for (int i = 0; i < 8; ++i) {
            const int k = (i * 64 + lane) * 4;
            const f32x4 xv = {bf_lo(xw[i].x), bf_hi(xw[i].x), bf_lo(xw[i].y), bf_hi(xw[i].y)};
            const f32x4 gt = *(const f32x4*)(mod + (size_t)b * NMOD + 5 * DM + k) * (1.0f / Y2_SCALE);
            const f32x2 a0 = __builtin_amdgcn_cvt_pk_f32_fp8((int)ya[i], false), a1 = __builtin_amdgcn_cvt_pk_f32_fp8((int)ya[i], true);
            const f32x2 b0 = __builtin_amdgcn_cvt_pk_f32_fp8((int)yb[i], false), b1 = __builtin_amdgcn_cvt_pk_f32_fp8((int)yb[i], true);
            const f32x4 y = {a0[0] + b0[0], a0[1] + b0[1], a1[0] + b1[0], a1[1] + b1[1]};
            v[i] = xv + gt * y;
            ss += v[i][0] * v[i][0] + v[i][1] * v[i][1] + v[i][2] * v[i][2] + v[i][3] * v[i][3];
        }
        ss = wave_sum(ss);
        const float r = rsqrtf(ss * (1.0f / 2048.0f) + 1e-6f);
        float* xr = P.out + (size_t)row * DM;
#pragma unroll
        for (int i = 0; i < 8; ++i) { const int k = (i * 64 + lane) * 4; *(f32x4*)(xr + k) = v[i] * r * gf[i]; }
#pragma unroll
        for (int i = 0; i < 8; ++i) { xw[i] = xwn[i]; ya[i] = yan[i]; yb[i] = ybn[i]; }
    }
}

__global__ void __launch_bounds__(NTHREADS, 2) hymba_fwd(Params P) {
    extern __shared__ __attribute__((aligned(16))) unsigned char lds_raw[];
    LAS unsigned char* lds = (LAS unsigned char*)lds_raw;
    const int tid = threadIdx.x, blk = blockIdx.x, G = gridDim.x;
    volatile LAS unsigned* misc = (volatile LAS unsigned*)(lds + LDS_MISC);
    if (tid < 64) misc[tid] = 0u;
    __syncthreads();
    XcdBarrier bar = xcd_barrier_post((unsigned*)(P.ws + WS_BAR), misc);
    const int lo = P.ph_lo, hi = P.ph_hi;
#define IN(k) (lo <= (k) && (k) < hi)
#define SEAM(k) do { if (IN(k) && IN((k) + 1)) xcd_barrier(bar); } while (0)
    unsigned char* ws = P.ws;

#ifndef REPR
#define REPR 1
#endif
#ifndef REPS
#define REPS 1
#endif
#ifndef REP0
#define REP0 1
#endif
#ifndef REP2
#define REP2 1
#endif
#ifndef REP7
#define REP7 1
#endif
#ifndef REP8
#define REP8 1
#endif
    if (IN(0)) for (int rep0 = 0; rep0 < REP0; ++rep0) {
        for (int it = blk; it < 256; it += G) p0_adaln(P, lds, tid, it);
        for (int it = blk; it < 256; it += G) p0_ssm_mats(P, lds, tid, it);
        p0_misc(P, tid, blk, G);
        p0_convert(P, lds, tid, blk, G);
    }
    SEAM(0);
    if (IN(1)) p1_norm1(P, lds, tid, blk, G);
    SEAM(1);
    if (IN(2)) for (int rep2 = 0; rep2 < REP2; ++rep2) {
        DenseSched S; S.init(NTOK, NPROJ, G, blk); S.abase = (unsigned)WS_H; S.bbase = (unsigned)WS_WIN; S.lda = DM; S.ldb = DM;
        EpiInProj E{(bf16_t*)(ws + WS_PROJ)};
        g8::gemm_phase(lds, ws, DM / 64, DM, S, E);
    }
    SEAM(2);
    if (IN(3)) {
        for (int it = blk; it < 256; it += G) ssm_item(P, lds, tid, it);
        ret_kv_items(P, lds, tid, blk, G);
    }
    SEAM(3);
    if (IN(4)) {
        for (int it = blk; it < 256; it += G) ret_out_item(P, lds, tid, it);
        __syncthreads();
        DenseSched S; S.init(NTOK, 1024, G, blk); S.abase = (unsigned)WS_Z; S.bbase = (unsigned)WS_WGLU; S.lda = 1024; S.ldb = 1024;
        EpiGlu E{(const bf16_t*)(ws + WS_Z), (bf16_t*)(ws + WS_CAT), (float*)(ws + WS_ROWSS1)};
        g8::gemm_phase(lds, ws, 1024 / 64, 1024, S, E);
    }
    SEAM(4);
    if (IN(5)) {
        OutSched S; S.init(NTOK, DM, G, blk); S.abase = (unsigned)WS_CAT; S.bbase = (unsigned)WS_WOUT;
        EpiOut E{P.in[0], (const float*)(ws + WS_MOD), (const float*)(ws + WS_ROWSS1), (float*)(ws + WS_ROWSS2), (bf16_t*)(ws + WS_X1)};
        g8::gemm_phase(lds, ws, 1024 / 64, DM, S, E);
    }
    SEAM(5);
    if (IN(6)) { p6_route(P, lds, tid, blk, G); p0_convert_fp8(P, lds, tid, blk, G, 0, 8192); }
    SEAM(6);
    if (IN(7) || IN(8)) {
        LAS int* tinfo = (LAS int*)(lds + LDS_MISC + 256); LAS int* trows = tinfo + 192; LAS int* ntl = trows + 192;
        if (tid == 0) {
            const int* cg = (const int*)(ws + WS_CNT); int nt_ = 0;
            for (int e = 0; e < 32; ++e) { const int c = cg[e * 64], full = c >> 8, rem = c & 255;
                for (int t = 0; t < full; ++t) { tinfo[nt_] = e | ((t * 256) << 8); trows[nt_] = 256; ++nt_; }
                if (rem > 128) { tinfo[nt_] = e | ((full * 256) << 8); trows[nt_] = rem; ++nt_; } }
            for (int e = 0; e < 32; ++e) { const int c = cg[e * 64], full = c >> 8, rem = c & 255; if (rem > 64 && rem <= 128) { tinfo[nt_] = e | ((full * 256) << 8); trows[nt_] = rem; ++nt_; } }
            for (int e = 0; e < 32; ++e) { const int c = cg[e * 64], full = c >> 8, rem = c & 255; if (rem > 0 && rem <= 64) { tinfo[nt_] = e | ((full * 256) << 8); trows[nt_] = rem; ++nt_; } }
            ntl[0] = nt_;
        }
        __syncthreads();
        const int ntiles = __builtin_amdgcn_readfirstlane(ntl[0]);
        if (IN(7)) {
            { u32x2* slot = (u32x2*)(ws + WS_SLOT); const int* lst = (const int*)(ws + WS_LIST); const float* wg = (const float*)(ws + WS_WGT);
              for (int ti = blk; ti < ntiles; ti += G) if (tid < 256) {
                  const int inf = tinfo[ti], e = inf & 255, r0 = inf >> 8, n = trows[ti];
                  u32x2 v; v.x = 0xffffffffu; v.y = 0u;
                  if (tid < n) { const int asg = lst[e * 16384 + r0 + tid]; v.x = (unsigned)asg; v.y = __float_as_uint(wg[asg] * (1.0f / WD_SCALE)); }
                  slot[ti * 256 + tid] = v; } }
            MoeSched S{tinfo, trows, ntiles, G, blk, (const int*)(ws + WS_LIST), (unsigned)WS_H, (unsigned)WS_WGU, 0};
            EpiMoe1 E{ws + WS_HM};
            g8::gemm_phase<EpiMoe1, MoeSched, true, 2>(lds, ws, DM / 128, DM, S, E);
            p0_convert_fp8(P, lds, tid, blk, G, 8192, 12288);
        }
        SEAM(7);
        if (IN(8)) {
            MoeSched S{tinfo, trows, ntiles, G, blk, (const int*)(ws + WS_LIST), (unsigned)WS_HM, (unsigned)WS_WD, 1};
            EpiMoe2 E{(const u32x2*)(ws + WS_SLOT), ws + WS_Y2};
            g8::gemm_phase<EpiMoe2, MoeSched, true, 2>(lds, ws, DEXP / 128, DEXP, S, E);
        }
    }
    SEAM(8);
    if (IN(9)) p9_final(P, tid, blk, G);
#undef IN
#undef SEAM
}

#ifndef N_LAUNCH_SPLIT
#define N_LAUNCH_SPLIT 0
#endif
extern "C" void kernel_launch(void* const* d_in, const int* in_sizes, int n_in, void* d_out, int out_size, void* d_ws, size_t ws_size, hipStream_t stream) {
    static int grid = 0;
    if (grid == 0) {
        if (n_in != 27 || out_size != NTOK * DM || ws_size < WS_END) { fprintf(stderr, "kernel_launch: unexpected shapes (n_in %d out %d ws %zu need %zu)\n", n_in, out_size, ws_size, (size_t)WS_END); grid = -1; return; }
        int dev = 0, cus = 0, per_cu = 0;
        if (hipGetDevice(&dev) != hipSuccess || hipDeviceGetAttribute(&cus, hipDeviceAttributeMultiprocessorCount, dev) != hipSuccess) { grid = -1; return; }
        if (hipFuncSetAttribute((const void*)hymba_fwd, hipFuncAttributeMaxDynamicSharedMemorySize, LDS_BYTES) != hipSuccess) { fprintf(stderr, "kernel_launch: hipFuncSetAttribute failed\n"); grid = -1; return; }
        if (hipOccupancyMaxActiveBlocksPerMultiprocessor(&per_cu, (const void*)hymba_fwd, NTHREADS, LDS_BYTES) != hipSuccess || per_cu < 1) { fprintf(stderr, "kernel_launch: occupancy query says %d\n", per_cu); }
        (void)hipGetLastError();
        grid = cus;
    }
    if (grid < 0) return;
    (void)hipMemsetAsync((char*)d_ws + WS_BAR, 0, 16384, stream);
    Params p{};
    for (int i = 0; i < 27; ++i) p.in[i] = (const float*)d_in[i];
    p.out = (float*)d_out; p.ws = (unsigned char*)d_ws;
#if N_LAUNCH_SPLIT
    for (int ph = 0; ph < 10; ++ph) { p.ph_lo = ph; p.ph_hi = ph + 1; hipLaunchKernelGGL(hymba_fwd, dim3(grid), dim3(NTHREADS), LDS_BYTES, stream, p); }
#else
    p.ph_lo = 0; p.ph_hi = 10;
    hipLaunchKernelGGL(hymba_fwd, dim3(grid), dim3(NTHREADS), LDS_BYTES, stream, p);
#endif
    const hipError_t le = hipPeekAtLastError();
    if (le != hipSuccess) fprintf(stderr, "kernel_launch: launch failed: %s\n", hipGetErrorName(le));
}
```

```cpp
#include <hip/hip_runtime.h>
#include <cstdio>
#include <cstdint>

#define LAS __attribute__((address_space(3)))
typedef unsigned short bf16_t;
typedef short bf16x8 __attribute__((ext_vector_type(8)));
typedef short bf16x4 __attribute__((ext_vector_type(4)));
typedef float f32x4 __attribute__((ext_vector_type(4)));
typedef float f32x2 __attribute__((ext_vector_type(2)));
typedef unsigned u32x4 __attribute__((ext_vector_type(4)));
typedef unsigned u32x2 __attribute__((ext_vector_type(2)));

constexpr int DM = 2048, NB = 8, SEQ = 2048, NTOK = NB * SEQ;
constexpr int NPROJ = 5120;
constexpr int NMOD = 6 * DM;
constexpr int NEXP = 32, DEXP = 1024;
constexpr int NTHREADS = 512;

constexpr size_t WS_BAR   = 0;
constexpr size_t WS_CNT   = 16384;
constexpr size_t WS_ROWSS1= WS_CNT + 8192;
constexpr size_t WS_ROWSS2= WS_ROWSS1 + (size_t)16384 * 16 * 4;
constexpr size_t WS_MODP  = WS_ROWSS2 + (size_t)16384 * 32 * 4;
constexpr size_t WS_MOD   = WS_MODP + (size_t)4 * 8 * NMOD * 4;
constexpr size_t WS_ROPE  = WS_MOD + (size_t)8 * NMOD * 4;
constexpr size_t WS_SSMA  = WS_ROPE + (size_t)2048 * 64 * 8;
constexpr size_t WS_WR    = WS_SSMA + (size_t)64 * 64 * 8;
constexpr size_t WS_SSMM  = WS_WR + (size_t)48 * 2048 * 2;
constexpr size_t WS_WIN   = WS_SSMM + (size_t)64 * 131072 * 2;
constexpr size_t WS_WOUT  = WS_WIN + (size_t)NPROJ * DM * 2;
constexpr size_t WS_WGLU  = WS_WOUT + (size_t)DM * DM * 2;
constexpr size_t WS_WGU   = WS_WGLU + (size_t)1024 * 1024 * 2;
constexpr size_t WS_WD    = WS_WGU + (size_t)NEXP * 2048 * 2048 * 2;
constexpr size_t WS_H     = WS_WD + (size_t)NEXP * 2048 * 1024 * 2;
constexpr size_t WS_PROJ  = WS_H + (size_t)NTOK * DM * 2;
constexpr size_t WS_Z     = WS_PROJ + (size_t)NTOK * NPROJ * 2;
constexpr size_t WS_CAT   = WS_Z + (size_t)NTOK * 1024 * 2;
constexpr size_t WS_WGT   = WS_CAT + (size_t)NTOK * DM * 2;
constexpr size_t WS_LIST  = WS_WGT + (size_t)32768 * 4;
constexpr size_t WS_SLOT  = WS_LIST + (size_t)32 * 16384 * 4;
constexpr size_t WS_X1    = WS_SLOT + (size_t)192 * 256 * 8;
constexpr size_t WS_END   = WS_X1 + (size_t)NTOK * DM * 2;
constexpr size_t WS_Y2    = WS_PROJ;
constexpr size_t WS_HM    = WS_Z;

constexpr int LDS_STAGE = 131072;
constexpr int LDS_BYTES = 147456;
constexpr int LDS_MISC  = LDS_BYTES - 2048;

struct Params { const float* in[27]; float* out; unsigned char* ws; int ph_lo, ph_hi; };

#define XB_TMO      128
#define XB_XCNT(j)  (256  + 64 * (j))
#define XB_XSUB(j)  (1280 + 64 * (j))
#define XB_XGEN(j)  (2304 + 64 * (j))
#define XB_TOP      3328
#define XB_TOPGEN   3392
#define XCD_BAR_WORDS 3456
#define XB_SPIN_CAP (1u << 22)

__device__ __forceinline__ unsigned xb_ld(unsigned* p)              { return __hip_atomic_load(p, __ATOMIC_RELAXED, __HIP_MEMORY_SCOPE_AGENT); }
__device__ __forceinline__ unsigned xb_add(unsigned* p, unsigned v) { return __hip_atomic_fetch_add(p, v, __ATOMIC_RELAXED, __HIP_MEMORY_SCOPE_AGENT); }
__device__ __forceinline__ unsigned xb_xcc_id() { return (unsigned)__builtin_amdgcn_s_getreg((3 << 11) | 20) & 0xFu; }
#define XB_SPIN(cond, bar) do { unsigned _sp = 0; while (cond) { __builtin_amdgcn_s_sleep(1); \
    if ((++_sp & 255u) == 0u) { if (xb_ld(&(bar)[XB_TMO])) break; if (_sp > XB_SPIN_CAP) { atomicAdd(&(bar)[XB_TMO], 1u); break; } } } } while (0)

struct XcdBarrier { unsigned* bar; unsigned x; volatile LAS unsigned* st; };

__device__ __forceinline__ XcdBarrier xcd_barrier_post(unsigned* bar, volatile LAS unsigned* st) {
    XcdBarrier b; b.bar = bar; b.x = xb_xcc_id(); b.st = st;
    if (threadIdx.x == 0) (void)xb_add(&bar[XB_XCNT(b.x)], 1u);
    return b;
}
__device__ __forceinline__ void xcd_barrier_complete(unsigned* bar, unsigned x, unsigned& nloc, unsigned& nx) {
    const unsigned G = gridDim.x * gridDim.y * gridDim.z;
    unsigned sum, cnt, mine, sp = 0u;
    for (;;) {
        sum = 0u; cnt = 0u; mine = 0u;
#pragma unroll
        for (unsigned j = 0; j < 16; ++j) { const unsigned c = xb_ld(&bar[XB_XCNT(j)]); sum += c; cnt += (c > 0u) ? 1u : 0u; mine = (j == x) ? c : mine; }
        if (sum == G) break;
        __builtin_amdgcn_s_sleep(1);
        if ((++sp & 255u) == 0u) { if (xb_ld(&bar[XB_TMO])) break; if (sp > XB_SPIN_CAP) { atomicAdd(&bar[XB_TMO], 1u); break; } }
    }
    nloc = mine > 0u ? mine : 1u; nx = cnt > 0u ? cnt : 1u;
}
__device__ __forceinline__ void xcd_barrier(const XcdBarrier& b) {
    asm volatile("s_waitcnt vmcnt(0)" ::: "memory");
    __syncthreads();
    if (threadIdx.x == 0) {
        unsigned* bar = b.bar;
        __builtin_amdgcn_s_waitcnt(0);
        unsigned nloc = b.st[0], nx = b.st[1];
        if (nloc == 0u) { xcd_barrier_complete(bar, b.x, nloc, nx); b.st[0] = nloc; b.st[1] = nx; }
        const unsigned old = xb_add(&bar[XB_XSUB(b.x)], 1u);
        const unsigned gen = old / nloc;
        if (old + 1u == (gen + 1u) * nloc) {
            __builtin_amdgcn_fence(__ATOMIC_RELEASE, "agent");
            asm volatile("s_waitcnt vmcnt(0)" ::: "memory");
            const unsigned og = xb_add(&bar[XB_TOP], 1u);
            const unsigned tg = og / nx;
            if (og + 1u == (tg + 1u) * nx) xb_add(&bar[XB_TOPGEN], 1u);
            else XB_SPIN(xb_ld(&bar[XB_TOPGEN]) == tg, bar);
            __builtin_amdgcn_fence(__ATOMIC_ACQUIRE, "agent");
            xb_add(&bar[XB_XGEN(b.x)], 1u);
            asm volatile("s_waitcnt vmcnt(0)" ::: "memory");
        } else {
            XB_SPIN(xb_ld(&bar[XB_XGEN(b.x)]) == gen, bar);
            __builtin_amdgcn_fence(__ATOMIC_ACQUIRE, "agent");
            asm volatile("s_waitcnt vmcnt(0)" ::: "memory");
        }
    }
    __syncthreads();
}

typedef __bf16 bf16x2_t __attribute__((ext_vector_type(2)));
__device__ __forceinline__ unsigned cvt_pk_bf16(float lo, float hi) { const f32x2 v = {lo, hi}; return __builtin_bit_cast(unsigned, __builtin_convertvector(v, bf16x2_t)); }
__device__ __forceinline__ float bf_lo(unsigned w) { return __uint_as_float(w << 16); }
__device__ __forceinline__ float bf_hi(unsigned w) { return __uint_as_float(w & 0xffff0000u); }
__device__ __forceinline__ float sigmoidf_(float x) { return __builtin_amdgcn_rcpf(1.0f + __expf(-x)); }
__device__ __forceinline__ float gelu_tanh(float x) {
    const float u = 0.7978845608028654f * (x + 0.044715f * x * x * x);
    const float t = 1.0f - 2.0f * __builtin_amdgcn_rcpf(1.0f + __expf(2.0f * u));
    return 0.5f * x * (1.0f + t);
}
__device__ __forceinline__ float wave_sum(float v) {
    v += __shfl_xor(v, 1); v += __shfl_xor(v, 2); v += __shfl_xor(v, 4); v += __shfl_xor(v, 8); v += __shfl_xor(v, 16); v += __shfl_xor(v, 32); return v;
}
__device__ __forceinline__ void sincos_d(double x, double& s, double& c) {
    const double TWO_PI = 6.283185307179586476925286766559;
    double r = x - TWO_PI * rint(x / TWO_PI);
    const double r2 = r * r;
    double ts = r, tc = 1.0; s = r; c = 1.0;
#pragma unroll 1
    for (int k = 1; k <= 14; ++k) { tc *= -r2 / (double)((2 * k - 1) * (2 * k)); ts *= -r2 / (double)((2 * k) * (2 * k + 1)); c += tc; s += ts; }
}

namespace g8 {
constexpr int BM = 256, BK = 64, HALF = 128, HTB = HALF * BK * 2, NXCD = 8, WGM = 8;
__device__ __forceinline__ int lds_byte(int r, int c) { const int st = (r >> 4) * 2 + (c >> 5), rr = r & 15, cc = c & 31, ob = rr * 64 + cc * 2; return st * 1024 + (ob ^ (((ob >> 9) & 1) << 5)); }
__device__ __forceinline__ void stage_rc(int b, int& R, int& C) { const int st = b / 1024, sb = b % 1024, swz = sb ^ (((sb >> 9) & 1) << 5); R = (st >> 1) * 16 + swz / 64; C = (st & 1) * 32 + (swz % 64) / 2; }
__device__ __forceinline__ int perm32(int rho) { const int n = rho >> 4, i = rho & 15; return 8 * (i >> 2) + 4 * n + (i & 3); }

struct Unit { unsigned aoff, boff; int pm, pn, flags, aux, aux2; };
typedef f32x4 Acc[2][2][4][2];

struct StaticOrder {
    int nM, nN, nwg, G, c;
    __device__ void init(int M, int N, int G_, int c_) { nM = M / BM; nN = N / BM; nwg = nM * nN; G = G_; c = c_; }
    __device__ __forceinline__ bool tile(int i, int& pm, int& pn) const {
        const long L = (long)i * G + c; if (L >= nwg) return false;
        int wgid = (int)L; { const int q = nwg / NXCD, r = nwg % NXCD, xcd = wgid % NXCD, off = wgid / NXCD; wgid = (xcd < r ? xcd * (q + 1) : r * (q + 1) + (xcd - r) * q) + off; }
        const int nig = WGM * nN, gid = wgid / nig, fm = gid * WGM, gsz = (nM - fm) < WGM ? (nM - fm) : WGM;
        pm = fm + ((wgid % nig) % gsz); pn = (wgid % nig) / gsz; return true;
    }
};

typedef long l64x2 __attribute__((ext_vector_type(2)));
typedef int i32x4 __attribute__((ext_vector_type(4)));
typedef int i32x8 __attribute__((ext_vector_type(8)));
template <class Epi, class Sched, bool SKIP = false, int FP8 = 0>
__device__ __forceinline__ void gemm_phase(LAS unsigned char* lds, const unsigned char* ws, const int nt, const int ldb  , const Sched& S, const Epi& E) {
    const int tid = threadIdx.x, wid = __builtin_amdgcn_readfirstlane(tid >> 6), lane = tid & 63, wr = wid >> 2, wc = wid & 3, fr = lane & 15, fq = lane >> 4;
    int R0, C0, R1, C1; stage_rc(tid * 16, R0, C0); stage_rc(tid * 16 + 8192, R1, C1);
    unsigned voffB[2];
    { const int Rb0 = Epi::PERM ? ((R0 & ~31) + perm32(R0 & 31)) : R0, Rb1 = Epi::PERM ? ((R1 & ~31) + perm32(R1 & 31)) : R1;
      voffB[0] = (unsigned)(Rb0 * 64 + C0) * 2u; voffB[1] = (unsigned)(Rb1 * 64 + C1) * 2u; }
    const unsigned kstep = (unsigned)(BK * 2);
    const unsigned kstepB = 256u * 64u * 2u;
    const unsigned hstepB = (unsigned)HALF * 64u * 2u;
    const unsigned ldsw = (unsigned)wid * 1024u;
    const int aoff = lds_byte(wr * 64 + fr, fq * 8), boff = lds_byte(wc * 32 + fr, fq * 8);
#define G8_SA(b, h) (((b) * 2 + (h)) * HTB)
#define G8_SB(b, h) ((4 + (b) * 2 + (h)) * HTB)
#define G8_STAGE(bufoff, gbase, v0, v1) do { \
        __builtin_amdgcn_global_load_lds((const unsigned*)((gbase) + (v0)), (LAS unsigned*)(lds + (bufoff) + ldsw), 16, 0, 0); \
        __builtin_amdgcn_global_load_lds((const unsigned*)((gbase) + (v1)), (LAS unsigned*)(lds + (bufoff) + ldsw + 8192), 16, 0, 0); } while (0)
#define G8_LDA(dst, b, h) do { _Pragma("unroll") for (int m = 0; m < 4; ++m) _Pragma("unroll") for (int k = 0; k < 2; ++k) dst[m][k] = *(const LAS bf16x8*)(lds + G8_SA(b, h) + aoff + m * 2048 + k * 1024); } while (0)
#define G8_LDB(dst, b, h) do { _Pragma("unroll") for (int n = 0; n < 2; ++n) _Pragma("unroll") for (int k = 0; k < 2; ++k) dst[n][k] = *(const LAS bf16x8*)(lds + G8_SB(b, h) + boff + n * 2048 + k * 1024); } while (0)
#define G8_MMA(ai, bj, At, Bt) do { __builtin_amdgcn_s_setprio(1); \
        if constexpr (FP8 == 2) { _Pragma("unroll") for (int m = 0; m < 4; ++m) _Pragma("unroll") for (int n = 0; n < 2; ++n) { \
            const i32x8 a8 = __builtin_shufflevector(__builtin_bit_cast(i32x4, At[m][0]), __builtin_bit_cast(i32x4, At[m][1]), 0, 1, 2, 3, 4, 5, 6, 7); \
            const i32x8 b8 = __builtin_shufflevector(__builtin_bit_cast(i32x4, Bt[n][0]), __builtin_bit_cast(i32x4, Bt[n][1]), 0, 1, 2, 3, 4, 5, 6, 7); \
            acc[ai][bj][m][n] = __builtin_amdgcn_mfma_scale_f32_16x16x128_f8f6f4(b8, a8, acc[ai][bj][m][n], 0, 0, 0, 0x7F7F7F7F, 0, 0x7F7F7F7F); } } \
        else { _Pragma("unroll") for (int m = 0; m < 4; ++m) _Pragma("unroll") for (int n = 0; n < 2; ++n) _Pragma("unroll") for (int k = 0; k < 2; ++k) { \
        if constexpr (FP8 == 1) { const l64x2 a2 = __builtin_bit_cast(l64x2, At[m][k]), b2 = __builtin_bit_cast(l64x2, Bt[n][k]); \
            acc[ai][bj][m][n] = __builtin_amdgcn_mfma_f32_16x16x32_fp8_fp8(b2[0], a2[0], acc[ai][bj][m][n], 0, 0, 0); \
            acc[ai][bj][m][n] = __builtin_amdgcn_mfma_f32_16x16x32_fp8_fp8(b2[1], a2[1], acc[ai][bj][m][n], 0, 0, 0); } \
        else acc[ai][bj][m][n] = __builtin_amdgcn_mfma_f32_16x16x32_bf16(Bt[n][k], At[m][k], acc[ai][bj][m][n], 0, 0, 0); } } __builtin_amdgcn_s_setprio(0); } while (0)
#define G8_WAIT_V(n) asm volatile("s_waitcnt vmcnt(" #n ")" ::: "memory")
#define G8_WAIT_L(n) asm volatile("s_waitcnt lgkmcnt(" #n ")" ::: "memory")
#define G8_BAR __builtin_amdgcn_s_barrier()
#define G8_SCHED __builtin_amdgcn_sched_barrier(0)
    Unit cur, nxt; int ui = 0;
    if (!S.next(0, cur)) return;
    Acc acc;
#pragma unroll
    for (int a = 0; a < 2; ++a)
#pragma unroll
        for (int b = 0; b < 2; ++b)
#pragma unroll
            for (int m = 0; m < 4; ++m)
#pragma unroll
                for (int n = 0; n < 2; ++n) acc[a][b][m][n] = (f32x4){0.f, 0.f, 0.f, 0.f};
    bf16x8 At[4][2], B0[2][2], B1[2][2];
    unsigned cv[2][2], nv[2][2];
    S.aoffs(cur, R0, C0, R1, C1, cv);
    const unsigned char* cA = ws + cur.aoff; const unsigned char* cB = ws + cur.boff;
    G8_STAGE(G8_SB(0, 0), cB, voffB[0], voffB[1]); G8_STAGE(G8_SA(0, 0), cA, cv[0][0], cv[0][1]);
    G8_STAGE(G8_SB(0, 1), cB + hstepB, voffB[0], voffB[1]); G8_STAGE(G8_SA(0, 1), cA, cv[1][0], cv[1][1]);
    if (wr == 1) G8_BAR;
    G8_WAIT_V(4); G8_BAR;
    G8_STAGE(G8_SB(1, 0), cB + kstepB, voffB[0], voffB[1]); G8_STAGE(G8_SA(1, 0), cA + kstep, cv[0][0], cv[0][1]);
    G8_STAGE(G8_SB(1, 1), cB + hstepB + kstepB, voffB[0], voffB[1]);
    G8_WAIT_V(6); G8_BAR;
    for (;;) {
        const bool has_next = S.next(ui + 1, nxt);
        if (has_next) S.aoffs(nxt, R0, C0, R1, C1, nv);
        else { nv[0][0] = cv[0][0]; nv[0][1] = cv[0][1]; nv[1][0] = cv[1][0]; nv[1][1] = cv[1][1]; }
        const unsigned char* nA = has_next ? ws + nxt.aoff : cA; const unsigned char* nB = has_next ? ws + nxt.boff : cB;
        const int vrows = SKIP ? cur.aux2 : 256;
        const bool do0 = !SKIP || vrows > 64 || wr == 0, do1 = !SKIP || vrows > 128;
        for (int t = 0; t < nt; t += 2) {
            const bool last = (t == nt - 2);
            const unsigned char* a1 = cA + (size_t)(t + 1) * kstep;
            const unsigned char* a2 = last ? nA : cA + (size_t)(t + 2) * kstep; const unsigned char* b2 = last ? nB : cB + (size_t)(t + 2) * kstepB;
            const unsigned char* a3 = a2 + kstep; const unsigned char* b3 = b2 + kstepB;
            const unsigned o00 = last ? nv[0][0] : cv[0][0], o01 = last ? nv[0][1] : cv[0][1], o10 = last ? nv[1][0] : cv[1][0], o11 = last ? nv[1][1] : cv[1][1];
            G8_LDB(B0, 0, 0); G8_SCHED; G8_LDA(At, 0, 0); G8_STAGE(G8_SA(1, 1), a1, cv[1][0], cv[1][1]);
            G8_WAIT_L(8); G8_BAR; G8_WAIT_L(0); if (do0) G8_MMA(0, 0, At, B0); G8_BAR; G8_SCHED;
            G8_LDB(B1, 0, 1); G8_STAGE(G8_SB(0, 0), b2, voffB[0], voffB[1]);
            G8_BAR; G8_WAIT_L(0); if (do0) G8_MMA(0, 1, At, B1); G8_BAR;
            G8_LDA(At, 0, 1); G8_STAGE(G8_SA(0, 0), a2, o00, o01);
            G8_BAR; G8_WAIT_L(0); if (do1) G8_MMA(1, 0, At, B0); G8_BAR; G8_SCHED;
            G8_STAGE(G8_SB(0, 1), b2 + hstepB, voffB[0], voffB[1]);
            G8_WAIT_V(6); G8_BAR; if (do1) G8_MMA(1, 1, At, B1); G8_BAR;
            G8_LDB(B0, 1, 0); G8_SCHED; G8_LDA(At, 1, 0); G8_STAGE(G8_SA(0, 1), a2, o10, o11);
            G8_WAIT_L(8); G8_BAR; G8_WAIT_L(0); if (do0) G8_MMA(0, 0, At, B0); G8_BAR; G8_SCHED;
            G8_LDB(B1, 1, 1); G8_STAGE(G8_SB(1, 0), b3, voffB[0], voffB[1]);
            G8_BAR; G8_WAIT_L(0); if (do0) G8_MMA(0, 1, At, B1); G8_BAR;
            G8_LDA(At, 1, 1); G8_STAGE(G8_SA(1, 0), a3, o00, o01);
            G8_BAR; G8_WAIT_L(0); if (do1) G8_MMA(1, 0, At, B0); G8_BAR; G8_SCHED;
            G8_STAGE(G8_SB(1, 1), b3 + hstepB, voffB[0], voffB[1]);
            G8_WAIT_V(6); G8_BAR; if (do1) G8_MMA(1, 1, At, B1); G8_BAR;
        }
        E(acc, cur, wr, wc, fr, fq);
        if (!has_next) break;
        if (!(cur.flags & 1)) {
#pragma unroll
            for (int a = 0; a < 2; ++a)
#pragma unroll
                for (int b = 0; b < 2; ++b)
#pragma unroll
                    for (int m = 0; m < 4; ++m)
#pragma unroll
                        for (int n = 0; n < 2; ++n) acc[a][b][m][n] = (f32x4){0.f, 0.f, 0.f, 0.f};
        }
        cur = nxt; cA = nA; cB = nB; ++ui;
        cv[0][0] = nv[0][0]; cv[0][1] = nv[0][1]; cv[1][0] = nv[1][0]; cv[1][1] = nv[1][1];
    }
    G8_WAIT_V(0);
    if (wr == 0) G8_BAR;
    G8_BAR;
#undef G8_SA
#undef G8_SB
#undef G8_STAGE
#undef G8_LDA
#undef G8_LDB
#undef G8_MMA
#undef G8_WAIT_V
#undef G8_WAIT_L
#undef G8_BAR
#undef G8_SCHED
}
}

__device__ __forceinline__ void p0_adaln(const Params& P, LAS unsigned char* lds, int tid, int item) {
    const int ks = item & 3, nc = item >> 2;
    LAS float* sc = (LAS float*)lds;
    LAS float* red = (LAS float*)(lds + 16384);
    const float* c = P.in[1];
    for (int i = tid; i < 4096; i += NTHREADS) { const int kl = i >> 3, b = i & 7; const float v = c[b * 2048 + ks * 512 + kl]; sc[i] = v / (1.0f + expf(-v)); }
    __syncthreads();
    if (tid < 384) {
        const int nq = tid % 48, kg = tid / 48;
        const float* W = P.in[2] + (size_t)(ks * 512 + kg * 64) * NMOD + nc * 192 + nq * 4;
        f32x4 acc[8];
#pragma unroll
        for (int b = 0; b < 8; ++b) acc[b] = (f32x4){0.f, 0.f, 0.f, 0.f};
#pragma unroll 16
        for (int kk = 0; kk < 64; ++kk) {
            const f32x4 w = *(const f32x4*)(W + (size_t)kk * NMOD);
            const f32x4 s0 = *(const LAS f32x4*)(sc + (kg * 64 + kk) * 8), s1 = *(const LAS f32x4*)(sc + (kg * 64 + kk) * 8 + 4);
            acc[0] += w * s0[0]; acc[1] += w * s0[1]; acc[2] += w * s0[2]; acc[3] += w * s0[3];
            acc[4] += w * s1[0]; acc[5] += w * s1[1]; acc[6] += w * s1[2]; acc[7] += w * s1[3];
        }
#pragma unroll
        for (int b = 0; b < 8; ++b) *(LAS f32x4*)(red + (kg * 8 + b) * 192 + nq * 4) = acc[b];
    }
    __syncthreads();
    float* modp = (float*)(P.ws + WS_MODP);
    for (int i = tid; i < 8 * 192; i += NTHREADS) {
        const int b = i / 192, n = i % 192; float s = 0.f;
#pragma unroll
        for (int kg = 0; kg < 8; ++kg) s += red[(kg * 8 + b) * 192 + n];
        modp[(size_t)(ks * 8 + b) * NMOD + nc * 192 + n] = s;
    }
    __syncthreads();
}

struct CvtUnit { const float* src; bf16_t* dst; int Nd, Kd, k0, n0, nmode; const float* s0; const float* s1; };
constexpr int CVT_UNITS = 640 + 256 + 64;
__device__ __forceinline__ void cvt_unit_decode(const Params& P, int L, CvtUnit& u) {
    u.s0 = nullptr; u.s1 = nullptr; u.nmode = 0;
    if (L < 640) { u.src = P.in[5]; u.dst = (bf16_t*)(P.ws + WS_WIN); u.Kd = 2048; u.Nd = 5120; u.k0 = (L / 20) * 64; u.n0 = (L % 20) * 256; u.nmode = 3; return; }
    L -= 640;
    if (L < 256) { u.src = P.in[17]; u.dst = (bf16_t*)(P.ws + WS_WOUT); u.Kd = 2048; u.Nd = 2048; u.k0 = (L / 8) * 64; u.n0 = (L % 8) * 256; u.s0 = P.in[15]; u.s1 = P.in[16]; return; }
    L -= 256;
    if (L < 64) { u.src = P.in[14]; u.dst = (bf16_t*)(P.ws + WS_WGLU); u.Kd = 1024; u.Nd = 1024; u.k0 = (L / 4) * 64; u.n0 = (L % 4) * 256; return; }
    L -= 64;
    if (L < 4096) { const int e = L >> 7, r = L & 127; u.src = P.in[23] + (size_t)e * 2048 * 1024; u.dst = (bf16_t*)(P.ws + WS_WGU) + (size_t)e * 2048 * 2048; u.Kd = 2048; u.Nd = 1024; u.k0 = (r >> 2) * 64; u.n0 = (r & 3) * 256; u.nmode = 1; return; }
    L -= 4096;
    if (L < 4096) { const int e = L >> 7, r = L & 127; u.src = P.in[24] + (size_t)e * 2048 * 1024; u.dst = (bf16_t*)(P.ws + WS_WGU) + (size_t)e * 2048 * 2048; u.Kd = 2048; u.Nd = 1024; u.k0 = (r >> 2) * 64; u.n0 = (r & 3) * 256; u.nmode = 2; return; }
    L -= 4096;
    { const int e = L >> 7, r = L & 127; u.src = P.in[25] + (size_t)e * 1024 * 2048; u.dst = (bf16_t*)(P.ws + WS_WD) + (size_t)e * 2048 * 1024; u.Kd = 1024; u.Nd = 2048; u.k0 = (r >> 3) * 64; u.n0 = (r & 7) * 256; }
}
__device__ __forceinline__ void cvt_load(const CvtUnit& u, int tid, f32x4 (&r)[8]) {
    const int kp = tid >> 4, nq = tid & 15;
    const float* p = u.src + (size_t)(u.k0 + 2 * kp) * u.Nd + u.n0 + nq * 4;
#pragma unroll
    for (int s = 0; s < 4; ++s) { r[2 * s] = *(const f32x4*)(p + s * 64); r[2 * s + 1] = *(const f32x4*)(p + u.Nd + s * 64); }
    if (u.s0) {
        const int k = u.k0 + 2 * kp;
        const float a = (k < 1024) ? u.s0[k] : u.s1[k - 1024], b = (k + 1 < 1024) ? u.s0[k + 1] : u.s1[k + 1 - 1024];
#pragma unroll
        for (int s = 0; s < 4; ++s) { r[2 * s] *= a; r[2 * s + 1] *= b; }
    }
}
__device__ __forceinline__ void cvt_to_lds(LAS unsigned* tile, const f32x4 (&r)[8], int kp, int nq) {
#pragma unroll
    for (int s = 0; s < 4; ++s)
#pragma unroll
        for (int j = 0; j < 4; ++j) tile[s * 2112 + (nq * 4 + j) * 33 + kp] = cvt_pk_bf16(r[2 * s][j], r[2 * s + 1][j]);
}
__device__ __forceinline__ void cvt_store(const LAS unsigned* tile, const CvtUnit& u, int nl, int kq) {
#pragma unroll
    for (int s = 0; s < 4; ++s) {
        u32x4 w; w.x = tile[s * 2112 + nl * 33 + kq * 4]; w.y = tile[s * 2112 + nl * 33 + kq * 4 + 1]; w.z = tile[s * 2112 + nl * 33 + kq * 4 + 2]; w.w = tile[s * 2112 + nl * 33 + kq * 4 + 3];
        const int n = u.n0 + s * 64 + nl;
        int np = n;
        if (u.nmode == 1 || u.nmode == 2) np = (n >> 7) * 256 + (n & 127) + (u.nmode == 2 ? 128 : 0);
        else if (u.nmode == 3 && n >= 1024 && n < 3072) { const int reg = (n >= 2048) ? 2048 : 1024, nr = n - reg;
            np = reg + ((nr >> 8) << 8) + (((nr >> 6) & 1) << 7) + (((nr >> 7) & 1) << 6) + (nr & 63); }
        *(u32x4*)(u.dst + (size_t)(np >> 8) * ((size_t)u.Kd * 256) + (size_t)(u.k0 >> 6) * 16384 + (np & 255) * 64 + kq * 8) = w;
    }
}
__device__ __forceinline__ void p0_convert(const Params& P, LAS unsigned char* lds, int tid, int blk, int G) {
    LAS unsigned* tileA = (LAS unsigned*)lds;
    LAS unsigned* tileB = tileA + 4 * 2112;
    const int kp = tid >> 4, nq = tid & 15, nl = tid >> 3, kq = tid & 7;
    CvtUnit uA, uB, nA, nB; f32x4 rA[8], rB[8];
    int L = blk;
    if (L >= CVT_UNITS) return;
    bool hasB = (L + G) < CVT_UNITS;
    cvt_unit_decode(P, L, uA); cvt_load(uA, tid, rA);
    if (hasB) { cvt_unit_decode(P, L + G, uB); cvt_load(uB, tid, rB); }
    for (;;) {
        cvt_to_lds(tileA, rA, kp, nq);
        if (hasB) cvt_to_lds(tileB, rB, kp, nq);
        __syncthreads();
        const int Ln = L + 2 * G; const bool moreA = Ln < CVT_UNITS, moreB = (Ln + G) < CVT_UNITS;
        if (moreA) { cvt_unit_decode(P, Ln, nA); cvt_load(nA, tid, rA); }
        if (moreB) { cvt_unit_decode(P, Ln + G, nB); cvt_load(nB, tid, rB); }
        cvt_store(tileA, uA, nl, kq);
        if (hasB) cvt_store(tileB, uB, nl, kq);
        __syncthreads();
        if (!moreA) break;
        uA = nA; uB = nB; hasB = moreB; L = Ln;
    }
}

struct Cvt8Unit { const float* src; unsigned char* dst; int Nd, Kd, k0, n0, nmode; float scale; };
constexpr float WGU_SCALE = 64.0f, WD_SCALE = 32.0f;
__device__ __forceinline__ void cvt8_decode(const Params& P, int L, Cvt8Unit& u) {
    if (L < 8192) { const int up = L >= 4096; const int r_ = L & 4095; const int e = r_ >> 7, r = r_ & 127;
        u.src = P.in[up ? 24 : 23] + (size_t)e * 2048 * 1024; u.dst = P.ws + WS_WGU + (size_t)e * 2048 * 2048; u.Kd = 2048; u.Nd = 1024; u.k0 = (r >> 3) * 128; u.n0 = (r & 7) * 128; u.nmode = up ? 2 : 1; u.scale = WGU_SCALE; return; }
    L -= 8192;
    { const int e = L >> 7, r = L & 127; u.src = P.in[25] + (size_t)e * 1024 * 2048; u.dst = P.ws + WS_WD + (size_t)e * 2048 * 1024; u.Kd = 1024; u.Nd = 2048; u.k0 = (r >> 4) * 128; u.n0 = (r & 15) * 128; u.nmode = 0; u.scale = WD_SCALE; }
}
__device__ __forceinline__ void cvt8_load(const Cvt8Unit& u, int tid, f32x4 (&r)[8]) {
    const int kg = tid >> 5, nq = tid & 31;
    const float* p = u.src + (size_t)(u.k0 + 8 * kg) * u.Nd + u.n0 + nq * 4;
#pragma unroll
    for (int kk = 0; kk < 8; ++kk) r[kk] = __builtin_nontemporal_load((const f32x4*)(p + (size_t)kk * u.Nd));
}
__device__ __forceinline__ void cvt8_to_lds(LAS unsigned* tile, const f32x4 (&r)[8], float sc, int tid) {
    const int kg = tid >> 5, nq = tid & 31;
    u32x4 w0, w1;
#pragma unroll
    for (int j = 0; j < 4; ++j) {
        int a = 0, b = 0;
        a = __builtin_amdgcn_cvt_pk_fp8_f32(r[0][j] * sc, r[1][j] * sc, a, false); a = __builtin_amdgcn_cvt_pk_fp8_f32(r[2][j] * sc, r[3][j] * sc, a, true);
        b = __builtin_amdgcn_cvt_pk_fp8_f32(r[4][j] * sc, r[5][j] * sc, b, false); b = __builtin_amdgcn_cvt_pk_fp8_f32(r[6][j] * sc, r[7][j] * sc, b, true);
        w0[j] = (unsigned)a; w1[j] = (unsigned)b;
    }
    *(LAS u32x4*)(tile + (2 * kg) * 132 + nq * 4) = w0;
    *(LAS u32x4*)(tile + (2 * kg + 1) * 132 + nq * 4) = w1;
}
__device__ __forceinline__ void cvt8_store(const LAS unsigned* tile, const Cvt8Unit& u, int tid) {
    const int nl = tid >> 2, q = tid & 3;
    u32x4 w0, w1;
    w0.x = tile[(8 * q + 0) * 132 + nl]; w0.y = tile[(8 * q + 1) * 132 + nl]; w0.z = tile[(8 * q + 2) * 132 + nl]; w0.w = tile[(8 * q + 3) * 132 + nl];
    w1.x = tile[(8 * q + 4) * 132 + nl]; w1.y = tile[(8 * q + 5) * 132 + nl]; w1.z = tile[(8 * q + 6) * 132 + nl]; w1.w = tile[(8 * q + 7) * 132 + nl];
    const int n = u.n0 + nl;
    int np = n;
    if (u.nmode == 1 || u.nmode == 2) np = (n >> 7) * 256 + (n & 127) + (u.nmode == 2 ? 128 : 0);
    unsigned char* d = u.dst + (size_t)(np >> 8) * ((size_t)u.Kd * 256) + (size_t)(u.k0 >> 7) * 32768 + (np & 255) * 128 + q * 32;
    *(u32x4*)d = w0; *(u32x4*)(d + 16) = w1;
}
__device__ __forceinline__ void p0_convert_fp8(const Params& P, LAS unsigned char* lds, int tid, int blk, int G, const int Lbeg, const int Lend) {
    LAS unsigned* tileA = (LAS unsigned*)lds;
    LAS unsigned* tileB = tileA + 32 * 132;
    Cvt8Unit uA, uB, nA, nB; f32x4 rA[8], rB[8], qA[8], qB[8];
    int L = Lbeg + blk;
    if (L >= Lend) return;
    bool hasB = (L + G) < Lend;
    cvt8_decode(P, L, uA); cvt8_load(uA, tid, rA);
    if (hasB) { cvt8_decode(P, L + G, uB); cvt8_load(uB, tid, rB); }
    for (;;) {
        const int Ln = L + 2 * G; const bool moreA = Ln < Lend, moreB = (Ln + G) < Lend;
        if (moreA) { cvt8_decode(P, Ln, nA); cvt8_load(nA, tid, qA); }
        if (moreB) { cvt8_decode(P, Ln + G, nB); cvt8_load(nB, tid, qB); }
        cvt8_to_lds(tileA, rA, uA.scale, tid);
        if (hasB) cvt8_to_lds(tileB, rB, uB.scale, tid);
        __syncthreads();
        cvt8_store(tileA, uA, tid);
        if (hasB) cvt8_store(tileB, uB, tid);
        __syncthreads();
        if (!moreA) break;
        uA = nA; uB = nB; hasB = moreB; L = Ln;
#pragma unroll
        for (int i = 0; i < 8; ++i) { rA[i] = qA[i]; rB[i] = qB[i]; }
    }
}

__device__ __forceinline__ void p0_ssm_mats(const Params& P, LAS unsigned char* lds, int tid, int item) {
    const int g = item & 63, q = item >> 6;
    LAS f32x2* pw = (LAS f32x2*)lds;
    LAS f32x2* Bb = pw + 17 * 64;
    LAS f32x2* Cc = Bb + 64 * 16;
    LAS float* Kt = (LAS float*)(Cc + 16 * 64);
    if (tid < 64) {
        const int p = tid;
        const float dt = expf(P.in[13][g]);
        const float are = P.in[6][g * 64 + p], aim = P.in[7][g * 64 + p];
        const float mag = expf(dt * are);
        double sd, cd; sincos_d((double)(dt * aim), sd, cd);
        const float abr = mag * (float)cd, abi = mag * (float)sd;
        const float inv = 1.0f / (are * are + aim * aim);
        const float nre = abr - 1.0f;
        const float fre = (nre * are + abi * aim) * inv, fim = (abi * are - nre * aim) * inv;
        float pr = 1.0f, pi = 0.0f;
        for (int n = 0; n <= 16; ++n) { pw[n * 64 + p] = (f32x2){pr, pi}; const float t = pr * abr - pi * abi; pi = pr * abi + pi * abr; pr = t; }
        for (int h = 0; h < 16; ++h) {
            const float br = P.in[8][(g * 64 + p) * 16 + h], bi = P.in[9][(g * 64 + p) * 16 + h];
            Bb[p * 16 + h] = (f32x2){fre * br - fim * bi, fre * bi + fim * br};
            Cc[h * 64 + p] = (f32x2){P.in[10][(g * 16 + h) * 64 + p], P.in[11][(g * 16 + h) * 64 + p]};
        }
        if (q == 0) { f32x2* AL = (f32x2*)(P.ws + WS_SSMA); const f32x2 v = pw[16 * 64 + p]; AL[g * 64 + p] = v; }
    }
    __syncthreads();
    {
        const int wv = tid >> 6, ln = tid & 63, fi = ln & 15, fk = ln >> 4;
#pragma unroll
        for (int tt = 0; tt < 2; ++tt) {
            const int tau = 2 * wv + tt;
            f32x4 acc = {0.f, 0.f, 0.f, 0.f};
#pragma unroll 8
            for (int st = 0; st < 32; ++st) {
                const int kk = 4 * st + fk, p = kk >> 1;
                const f32x2 c = Cc[fi * 64 + p], a = pw[tau * 64 + p], bb = Bb[p * 16 + fi];
                const float av = (kk & 1) ? -(c.x * a.y + c.y * a.x) : (c.x * a.x - c.y * a.y);
                const float bv = (kk & 1) ? bb.y : bb.x;
                acc = __builtin_amdgcn_mfma_f32_16x16x4f32(av, bv, acc, 0, 0, 0);
            }
#pragma unroll
            for (int r = 0; r < 4; ++r) Kt[(tau * 16 + 4 * fk + r) * 16 + fi] = acc[r];
        }
    }
    __syncthreads();
    bf16_t* Ms = (bf16_t*)(P.ws + WS_SSMM) + (size_t)g * 131072;
    bf16_t* TM = Ms + 32768;
    for (int o = tid; o < 32 * 128; o += NTHREADS) {
        const int row = 32 * q + (o >> 7), col = (o & 127) * 2;
        const int p = row >> 1, j = col >> 4, hi = col & 15;
        const f32x2 a = pw[(15 - j) * 64 + p], b0 = Bb[p * 16 + hi], b1 = Bb[p * 16 + hi + 1];
        float v0, v1;
        if ((row & 1) == 0) { v0 = a.x * b0.x - a.y * b0.y; v1 = a.x * b1.x - a.y * b1.y; } else { v0 = a.x * b0.y + a.y * b0.x; v1 = a.x * b1.y + a.y * b1.x; }
        *(unsigned*)(Ms + (size_t)row * 256 + col) = cvt_pk_bf16(v0, v1);
    }
    for (int o = tid; o < 64 * 192; o += NTHREADS) {
        const int row = 64 * q + o / 192, col = (o % 192) * 2;
        const int i = row >> 4, ho = row & 15; float v0, v1;
        if (col < 256) { const int j = col >> 4, hi = col & 15; if (j <= i) { v0 = Kt[((i - j) * 16 + ho) * 16 + hi]; v1 = Kt[((i - j) * 16 + ho) * 16 + hi + 1]; } else { v0 = 0.f; v1 = 0.f; } }
        else { const int p0 = (col - 256) >> 1;
            const f32x2 c0 = Cc[ho * 64 + p0], a0 = pw[(i + 1) * 64 + p0];
            v0 = c0.x * a0.x - c0.y * a0.y; v1 = -(c0.x * a0.y + c0.y * a0.x); }
        *(unsigned*)(TM + (size_t)row * 384 + col) = cvt_pk_bf16(v0, v1);
    }
    __syncthreads();
}

__device__ __forceinline__ void p0_misc(const Params& P, int tid, int blk, int G) {
    bf16_t* wr = (bf16_t*)(P.ws + WS_WR);
    for (int i = blk * NTHREADS + tid; i < 48 * 2048; i += G * NTHREADS) {
        const int n = i >> 11, k = i & 2047; float v = 0.f;
        if (n < 4) v = P.in[19][k * 4 + n]; else if (n < 36) v = P.in[21][k * 32 + (n - 4)];
        wr[i] = (bf16_t)(cvt_pk_bf16(v, 0.f) & 0xffffu);
    }
    if (blk == 0) for (int i = tid; i < 2048; i += NTHREADS) ((int*)(P.ws + WS_CNT))[i] = 0;
}

__device__ __forceinline__ void p1_norm1(const Params& P, LAS unsigned char* lds, int tid, int blk, int G) {
    const float* modp = (const float*)(P.ws + WS_MODP); const float* bada = P.in[3];
    float* mod = (float*)(P.ws + WS_MOD);
    for (int i = blk * NTHREADS + tid; i < 8 * NMOD; i += G * NTHREADS) {
        const int b = i / NMOD, j = i % NMOD;
        mod[i] = bada[j] + ((modp[(size_t)(0 * 8 + b) * NMOD + j] + modp[(size_t)(1 * 8 + b) * NMOD + j]) + (modp[(size_t)(2 * 8 + b) * NMOD + j] + modp[(size_t)(3 * 8 + b) * NMOD + j]));
    }
    LAS float* gm = (LAS float*)lds; LAS float* sh = gm + 2048;
    const int wave = tid >> 6, lane = tid & 63;
    bf16_t* H = (bf16_t*)(P.ws + WS_H);
    for (int rb = blk; rb < 256; rb += G) {
        const int b = rb >> 5;
        for (int k = tid; k < 2048; k += NTHREADS) {
            const int js = 2048 + k, jh = k;
            const float sc = bada[js] + ((modp[(size_t)(0 * 8 + b) * NMOD + js] + modp[(size_t)(1 * 8 + b) * NMOD + js]) + (modp[(size_t)(2 * 8 + b) * NMOD + js] + modp[(size_t)(3 * 8 + b) * NMOD + js]));
            const float sv = bada[jh] + ((modp[(size_t)(0 * 8 + b) * NMOD + jh] + modp[(size_t)(1 * 8 + b) * NMOD + jh]) + (modp[(size_t)(2 * 8 + b) * NMOD + jh] + modp[(size_t)(3 * 8 + b) * NMOD + jh]));
            gm[k] = P.in[4][k] * (1.0f + sc); sh[k] = sv;
        }
        __syncthreads();
        f32x4 v[8], vn[8];
        { const float* xr = P.in[0] + (size_t)(rb * 64 + wave * 8) * DM;
#pragma unroll
          for (int i = 0; i < 8; ++i) v[i] = *(const f32x4*)(xr + (i * 64 + lane) * 4); }
        for (int rr = 0; rr < 8; ++rr) {
            const int row = rb * 64 + wave * 8 + rr;
            if (rr < 7) { const float* xn = P.in[0] + (size_t)(row + 1) * DM;
#pragma unroll
                for (int i = 0; i < 8; ++i) vn[i] = *(const f32x4*)(xn + (i * 64 + lane) * 4); }
            float ss = 0.f;
#pragma unroll
            for (int i = 0; i < 8; ++i) ss += v[i][0] * v[i][0] + v[i][1] * v[i][1] + v[i][2] * v[i][2] + v[i][3] * v[i][3];
            ss = wave_sum(ss);
            const float r = rsqrtf(ss * (1.0f / 2048.0f) + 1e-6f);
#pragma unroll
            for (int i = 0; i < 8; ++i) {
                const int k = (i * 64 + lane) * 4;
                const f32x4 g4 = *(const LAS f32x4*)(gm + k), s4 = *(const LAS f32x4*)(sh + k);
                const f32x4 o = v[i] * r * g4 + s4;
                u32x2 w; w.x = cvt_pk_bf16(o[0], o[1]); w.y = cvt_pk_bf16(o[2], o[3]);
                *(u32x2*)(H + (size_t)row * DM + k) = w;
            }
#pragma unroll
            for (int i = 0; i < 8; ++i) v[i] = vn[i];
        }
        __syncthreads();
    }
}

struct DenseSched : g8::StaticOrder {
    unsigned abase, bbase; int lda, ldb; int ioff = 0, iend = 1 << 30;
    __device__ __forceinline__ bool next(int i, g8::Unit& u) const {
        int pm, pn; if (i + ioff >= iend || !tile(i + ioff, pm, pn)) return false;
        u.pm = __builtin_amdgcn_readfirstlane(pm); u.pn = __builtin_amdgcn_readfirstlane(pn); u.flags = 0; u.aux = 0;
        u.aoff = abase + (unsigned)u.pm * 256u * (unsigned)lda * 2u; u.boff = bbase + (unsigned)u.pn * 256u * (unsigned)ldb * 2u; return true;
    }
    __device__ __forceinline__ void aoffs(const g8::Unit&, int R0, int C0, int R1, int C1, unsigned (&v)[2][2]) const {
        v[0][0] = (unsigned)(R0 * lda + C0) * 2u; v[0][1] = (unsigned)(R1 * lda + C1) * 2u;
        v[1][0] = (unsigned)((128 + R0) * lda + C0) * 2u; v[1][1] = (unsigned)((128 + R1) * lda + C1) * 2u;
    }
};
struct EpiStoreBf16 {
    static constexpr bool PERM = true;
    bf16_t* O; int ldc;
    __device__ __forceinline__ void operator()(g8::Acc& acc, const g8::Unit& u, int wr, int wc, int fr, int fq) const {
        const int row0 = u.pm * 256 + wr * 64 + fr, col0 = u.pn * 256 + wc * 32 + 8 * fq;
#pragma unroll
        for (int ai = 0; ai < 2; ++ai)
#pragma unroll
            for (int m = 0; m < 4; ++m) { bf16_t* rowp = O + (size_t)(row0 + ai * 128 + m * 16) * ldc + col0;
#pragma unroll
                for (int bj = 0; bj < 2; ++bj) { const f32x4 v0 = acc[ai][bj][m][0], v1 = acc[ai][bj][m][1];
                    u32x4 w; w.x = cvt_pk_bf16(v0[0], v0[1]); w.y = cvt_pk_bf16(v0[2], v0[3]); w.z = cvt_pk_bf16(v1[0], v1[1]); w.w = cvt_pk_bf16(v1[2], v1[3]);
                    *(u32x4*)(rowp + bj * 128) = w; } }
    }
};
struct EpiInProj {
    static constexpr bool PERM = true;
    bf16_t* O;
    __device__ __forceinline__ void operator()(g8::Acc& acc, const g8::Unit& u, int wr, int wc, int fr, int fq) const {
        const int pn = u.pn;
        const int row0 = u.pm * 256 + wr * 64 + fr;
        if (pn < 4 || pn >= 12) {
            const int col0 = pn * 256 + wc * 32 + 8 * fq;
#pragma unroll
            for (int ai = 0; ai < 2; ++ai)
#pragma unroll
                for (int m = 0; m < 4; ++m) { bf16_t* rowp = O + (size_t)(row0 + ai * 128 + m * 16) * NPROJ + col0;
#pragma unroll
                    for (int bj = 0; bj < 2; ++bj) { const f32x4 v0 = acc[ai][bj][m][0], v1 = acc[ai][bj][m][1];
                        u32x4 w; w.x = cvt_pk_bf16(v0[0], v0[1]); w.y = cvt_pk_bf16(v0[2], v0[3]); w.z = cvt_pk_bf16(v1[0], v1[1]); w.w = cvt_pk_bf16(v1[2], v1[3]);
                        *(u32x4*)(rowp + bj * 128) = w; } }
            return;
        }
        const bool isq = pn < 8;
        const int head = 2 * ((pn - 4) & 3) + (wc >> 1);
        const int dd0 = 32 * (wc & 1) + 8 * fq;
        const int colbase = (isq ? 1024 : 2048) + head * 128 + dd0;
        const float lg2 = log2f(1.0f - exp2f(-5.0f - (float)head));
        float fr_[8];
#pragma unroll
        for (int t = 0; t < 8; ++t) fr_[t] = exp2f(-(float)(dd0 + t) * 0.20762050593046014f) * 0.15915494309189535f;
#pragma unroll
        for (int ai = 0; ai < 2; ++ai)
#pragma unroll
            for (int m = 0; m < 4; ++m) {
                const int row = row0 + ai * 128 + m * 16, pos = row & 2047, i = wr * 64 + m * 16 + fr;
                const float sc = isq ? exp2f(lg2 * (float)i) : exp2f(-lg2 * (float)i) * 0.08838834764831845f;
                const float fp = (float)pos;
                float o1[8], o2[8];
#pragma unroll
                for (int t = 0; t < 8; ++t) {
                    const float rev = __builtin_amdgcn_fractf(fp * fr_[t]);
                    const float cs = __builtin_amdgcn_cosf(rev) * sc, sn = __builtin_amdgcn_sinf(rev) * sc;
                    const float a = acc[ai][0][m][t >> 2][t & 3], b = acc[ai][1][m][t >> 2][t & 3];
                    o1[t] = a * cs - b * sn; o2[t] = b * cs + a * sn;
                }
                bf16_t* rowp = O + (size_t)row * NPROJ + colbase;
                u32x4 w1, w2; w1.x = cvt_pk_bf16(o1[0], o1[1]); w1.y = cvt_pk_bf16(o1[2], o1[3]); w1.z = cvt_pk_bf16(o1[4], o1[5]); w1.w = cvt_pk_bf16(o1[6], o1[7]);
                w2.x = cvt_pk_bf16(o2[0], o2[1]); w2.y = cvt_pk_bf16(o2[2], o2[3]); w2.z = cvt_pk_bf16(o2[4], o2[5]); w2.w = cvt_pk_bf16(o2[6], o2[7]);
                *(u32x4*)rowp = w1; *(u32x4*)(rowp + 64) = w2;
            }
    }
};
struct EpiGlu {
    static constexpr bool PERM = true;
    const bf16_t* Z; bf16_t* CAT; float* rowss;
    __device__ __forceinline__ void operator()(g8::Acc& acc, const g8::Unit& u, int wr, int wc, int fr, int fq) const {
        const int row0 = u.pm * 256 + wr * 64 + fr, col0 = u.pn * 256 + wc * 32 + 8 * fq;
#pragma unroll
        for (int ai = 0; ai < 2; ++ai) {
            u32x4 zz[4][2];
#pragma unroll
            for (int m = 0; m < 4; ++m)
#pragma unroll
                for (int bj = 0; bj < 2; ++bj) zz[m][bj] = *(const u32x4*)(Z + (size_t)(row0 + ai * 128 + m * 16) * 1024 + col0 + bj * 128);
#pragma unroll
            for (int m = 0; m < 4; ++m) { const int row = row0 + ai * 128 + m * 16; float ss = 0.f;
#pragma unroll
                for (int bj = 0; bj < 2; ++bj) { const f32x4 v0 = acc[ai][bj][m][0], v1 = acc[ai][bj][m][1];
                    const u32x4 z4 = zz[m][bj];
                    float o[8];
                    o[0] = bf_lo(z4.x) * sigmoidf_(v0[0]); o[1] = bf_hi(z4.x) * sigmoidf_(v0[1]); o[2] = bf_lo(z4.y) * sigmoidf_(v0[2]); o[3] = bf_hi(z4.y) * sigmoidf_(v0[3]);
                    o[4] = bf_lo(z4.z) * sigmoidf_(v1[0]); o[5] = bf_hi(z4.z) * sigmoidf_(v1[1]); o[6] = bf_lo(z4.w) * sigmoidf_(v1[2]); o[7] = bf_hi(z4.w) * sigmoidf_(v1[3]);
#pragma unroll
                    for (int j = 0; j < 8; ++j) ss += o[j] * o[j];
                    u32x4 w; w.x = cvt_pk_bf16(o[0], o[1]); w.y = cvt_pk_bf16(o[2], o[3]); w.z = cvt_pk_bf16(o[4], o[5]); w.w = cvt_pk_bf16(o[6], o[7]);
                    *(u32x4*)(CAT + (size_t)row * DM + col0 + bj * 128) = w; }
                ss += __shfl_xor(ss, 16); ss += __shfl_xor(ss, 32);
                if (fq == 0) rowss[(size_t)row * 16 + u.pn * 4 + wc] = ss; }
        }
    }
};
struct OutSched : g8::StaticOrder {
    unsigned abase, bbase;
    __device__ __forceinline__ bool next(int i, g8::Unit& u) const {
        int pm, pn; if (!tile(i >> 1, pm, pn)) return false;
        const int half = i & 1;
        u.pm = __builtin_amdgcn_readfirstlane(pm); u.pn = __builtin_amdgcn_readfirstlane(pn); u.flags = half ? 0 : 1; u.aux = half;
        u.aoff = abase + (unsigned)u.pm * 256u * 4096u + (unsigned)half * 2048u; u.boff = bbase + (unsigned)u.pn * 256u * 4096u + (unsigned)half * (16u * 32768u); return true;
    }
    __device__ __forceinline__ void aoffs(const g8::Unit&, int R0, int C0, int R1, int C1, unsigned (&v)[2][2]) const {
        v[0][0] = (unsigned)(R0 * 2048 + C0) * 2u; v[0][1] = (unsigned)(R1 * 2048 + C1) * 2u;
        v[1][0] = (unsigned)((128 + R0) * 2048 + C0) * 2u; v[1][1] = (unsigned)((128 + R1) * 2048 + C1) * 2u;
    }
};
struct EpiOut {
    static constexpr bool PERM = true;
    const float* x; const float* mod; const float* rowss1; float* rowss2; bf16_t* X1;
    __device__ __forceinline__ void operator()(g8::Acc& acc, const g8::Unit& u, int wr, int wc, int fr, int fq) const {
        const int row0 = u.pm * 256 + wr * 64 + fr;
        if (u.aux == 0) {
#pragma unroll
            for (int ai = 0; ai < 2; ++ai)
#pragma unroll
                for (int m = 0; m < 4; ++m) { const f32x4* pp = (const f32x4*)(rowss1 + (size_t)(row0 + ai * 128 + m * 16) * 16);
                    const f32x4 p0 = pp[0], p1 = pp[1], p2 = pp[2], p3 = pp[3];
                    const float tot = (((p0[0] + p0[1]) + (p0[2] + p0[3])) + ((p1[0] + p1[1]) + (p1[2] + p1[3]))) + (((p2[0] + p2[1]) + (p2[2] + p2[3])) + ((p3[0] + p3[1]) + (p3[2] + p3[3])));
                    const float r = rsqrtf(tot * (1.0f / 1024.0f) + 1e-6f);
#pragma unroll
                    for (int bj = 0; bj < 2; ++bj)
#pragma unroll
                        for (int n = 0; n < 2; ++n) acc[ai][bj][m][n] *= r; }
            return;
        }
        const int col0 = u.pn * 256 + wc * 32 + 8 * fq;
        const int b = (u.pm * 256) >> 11;
        f32x4 gt[2][2];
#pragma unroll
        for (int bj = 0; bj < 2; ++bj)
#pragma unroll
            for (int n = 0; n < 2; ++n) gt[bj][n] = *(const f32x4*)(mod + (size_t)b * NMOD + 2 * DM + col0 + bj * 128 + n * 4);
#pragma unroll
        for (int am = 0; am < 4; ++am) {
            const int ai = am >> 1, m0 = (am & 1) * 2;
            f32x4 xv[2][2][2];
#pragma unroll
            for (int mm = 0; mm < 2; ++mm)
#pragma unroll
                for (int bj = 0; bj < 2; ++bj) { const size_t off = (size_t)(row0 + ai * 128 + (m0 + mm) * 16) * DM + col0 + bj * 128; xv[mm][bj][0] = *(const f32x4*)(x + off); xv[mm][bj][1] = *(const f32x4*)(x + off + 4); }
#pragma unroll
            for (int mm = 0; mm < 2; ++mm) { const int m = m0 + mm; const int row = row0 + ai * 128 + m * 16; float ss = 0.f;
#pragma unroll
                for (int bj = 0; bj < 2; ++bj) { const size_t off = (size_t)row * DM + col0 + bj * 128;
                    const f32x4 o0 = xv[mm][bj][0] + gt[bj][0] * acc[ai][bj][m][0], o1 = xv[mm][bj][1] + gt[bj][1] * acc[ai][bj][m][1];
                    ss += (o0[0] * o0[0] + o0[1] * o0[1]) + (o0[2] * o0[2] + o0[3] * o0[3]) + (o1[0] * o1[0] + o1[1] * o1[1]) + (o1[2] * o1[2] + o1[3] * o1[3]);
                    u32x4 w; w.x = cvt_pk_bf16(o0[0], o0[1]); w.y = cvt_pk_bf16(o0[2], o0[3]); w.z = cvt_pk_bf16(o1[0], o1[1]); w.w = cvt_pk_bf16(o1[2], o1[3]);
                    *(u32x4*)(X1 + off) = w; }
                ss += __shfl_xor(ss, 16); ss += __shfl_xor(ss, 32);
                if (fq == 0) rowss2[(size_t)row * 32 + u.pn * 4 + wc] = ss; }
        }
    }
};
struct MoeSched {
    const LAS int* tinfo; const LAS int* trows; int ntiles; int G, c; const int* list; unsigned abase, bbase; int mode;
    __device__ __forceinline__ bool next(int i, g8::Unit& u) const {
        int pn, ti;
        if ((G & 63) == 0) { const int x = c & 7, r = c >> 3, per = G >> 6;
            ti = (i * 8 + x) * per + (r >> 3); pn = r & 7; }
        else { const int L = i * G + c; pn = L & 7; ti = L >> 3; }
        if (ti >= ntiles) return false;
        const int inf = __builtin_amdgcn_readfirstlane(tinfo[ti]);
        const int e = inf & 255;
        u.pm = __builtin_amdgcn_readfirstlane(ti); u.pn = pn; u.flags = 0; u.aux = inf; u.aux2 = __builtin_amdgcn_readfirstlane(trows[ti]);
        if (mode == 0) { u.aoff = abase; u.boff = bbase + (unsigned)e * (2048u * 2048u) + (unsigned)pn * (256u * 2048u); }
        else { u.aoff = abase + (unsigned)ti * (256u * 1024u); u.boff = bbase + (unsigned)e * (2048u * 1024u) + (unsigned)pn * (256u * 1024u); }
        return true;
    }
    __device__ __forceinline__ void aoffs(const g8::Unit& u, int R0, int C0, int R1, int C1, unsigned (&v)[2][2]) const {
        if (mode == 0) {
            const int e = u.aux & 255, r0 = u.aux >> 8, n = u.aux2; const int* le = list + e * 16384 + r0;
            const int i00 = R0, i01 = R1, i10 = 128 + R0, i11 = 128 + R1;
            const int t00 = (i00 < n) ? (le[i00] >> 1) : 0, t01 = (i01 < n) ? (le[i01] >> 1) : 0, t10 = (i10 < n) ? (le[i10] >> 1) : 0, t11 = (i11 < n) ? (le[i11] >> 1) : 0;
            v[0][0] = (unsigned)(t00 * 2048 + C0 * 2); v[0][1] = (unsigned)(t01 * 2048 + C1 * 2); v[1][0] = (unsigned)(t10 * 2048 + C0 * 2); v[1][1] = (unsigned)(t11 * 2048 + C1 * 2);
        } else {
            v[0][0] = (unsigned)(R0 * 1024 + C0 * 2); v[0][1] = (unsigned)(R1 * 1024 + C1 * 2);
            v[1][0] = (unsigned)((128 + R0) * 1024 + C0 * 2); v[1][1] = (unsigned)((128 + R1) * 1024 + C1 * 2);
        }
    }
};
struct EpiMoe1 {
    static constexpr bool PERM = true;
    unsigned char* HM;
    __device__ __forceinline__ void operator()(g8::Acc& acc, const g8::Unit& u, int wr, int wc, int fr, int fq) const {
        const int row0 = u.pm * 256 + wr * 64 + fr, col0 = u.pn * 128 + wc * 32 + 8 * fq;
        const float inv = 1.0f / WGU_SCALE;
#pragma unroll
        for (int ai = 0; ai < 2; ++ai)
#pragma unroll
            for (int m = 0; m < 4; ++m) { float o[8];
#pragma unroll
                for (int n = 0; n < 2; ++n)
#pragma unroll
                    for (int j = 0; j < 4; ++j) { const float gv = acc[ai][0][m][n][j] * inv, uv = acc[ai][1][m][n][j] * inv; o[n * 4 + j] = gv * sigmoidf_(gv) * uv; }
                int q0 = 0, q1 = 0;
                q0 = __builtin_amdgcn_cvt_pk_fp8_f32(o[0], o[1], q0, false); q0 = __builtin_amdgcn_cvt_pk_fp8_f32(o[2], o[3], q0, true);
                q1 = __builtin_amdgcn_cvt_pk_fp8_f32(o[4], o[5], q1, false); q1 = __builtin_amdgcn_cvt_pk_fp8_f32(o[6], o[7], q1, true);
                *(u32x2*)(HM + (size_t)(row0 + ai * 128 + m * 16) * 1024 + col0) = (u32x2){(unsigned)q0, (unsigned)q1}; }
    }
};
constexpr float Y2_SCALE = 16.0f;
struct EpiMoe2 {
    static constexpr bool PERM = true;
    const u32x2* slot; unsigned char* Y2;
    __device__ __forceinline__ void operator()(g8::Acc& acc, const g8::Unit& u, int wr, int wc, int fr, int fq) const {
        const int col0 = u.pn * 256 + wc * 32 + 8 * fq;
        u32x2 si[2][4];
#pragma unroll
        for (int ai = 0; ai < 2; ++ai)
#pragma unroll
            for (int m = 0; m < 4; ++m) si[ai][m] = slot[u.pm * 256 + ai * 128 + wr * 64 + m * 16 + fr];
#pragma unroll
        for (int ai = 0; ai < 2; ++ai)
#pragma unroll
            for (int m = 0; m < 4; ++m) { const int asg = (int)si[ai][m].x;
                if (asg >= 0) { unsigned char* rowp = Y2 + (size_t)asg * DM + col0; const float ww = __uint_as_float(si[ai][m].y) * Y2_SCALE;
#pragma unroll
                    for (int bj = 0; bj < 2; ++bj) { const f32x4 v0 = acc[ai][bj][m][0] * ww, v1 = acc[ai][bj][m][1] * ww;
                        int q0 = 0, q1 = 0;
                        q0 = __builtin_amdgcn_cvt_pk_fp8_f32(v0[0], v0[1], q0, false); q0 = __builtin_amdgcn_cvt_pk_fp8_f32(v0[2], v0[3], q0, true);
                        q1 = __builtin_amdgcn_cvt_pk_fp8_f32(v1[0], v1[1], q1, false); q1 = __builtin_amdgcn_cvt_pk_fp8_f32(v1[2], v1[3], q1, true);
                        *(u32x2*)(rowp + bj * 128) = (u32x2){(unsigned)q0, (unsigned)q1}; } } }
    }
};

constexpr size_t WS_KV = WS_H;
__device__ __forceinline__ void ssm_item(const Params& P, LAS unsigned char* lds, int tid, int item) {
    const int g = item >> 2, bp = item & 3;
    const int wave = __builtin_amdgcn_readfirstlane(tid >> 6), lane = tid & 63, fr = lane & 15, fq = lane >> 4;
    const bf16_t* proj = (const bf16_t*)(P.ws + WS_PROJ);
    const bf16_t* Ms = (const bf16_t*)(P.ws + WS_SSMM) + (size_t)g * 131072;
    const bf16_t* TM = Ms + 32768;
    bf16_t* Zo = (bf16_t*)(P.ws + WS_Z);
    constexpr int ZS = 136, MS = 264, TS = 392;
    LAS bf16_t* ZB = (LAS bf16_t*)lds;
    LAS bf16_t* WB = (LAS bf16_t*)(lds + 256 * ZS * 2);
    const int b = 2 * bp + (wave >> 2);
    int tok0[2];
    bf16x8 Uf[2][8];
#pragma unroll
    for (int mt = 0; mt < 2; ++mt) {
        const int c = 32 * (wave & 3) + 16 * mt + fr; tok0[mt] = b * 2048 + c * 16;
#pragma unroll
        for (int ks = 0; ks < 8; ++ks) Uf[mt][ks] = *(const bf16x8*)(proj + (size_t)(tok0[mt] + 2 * ks + (fq >> 1)) * NPROJ + g * 16 + 8 * (fq & 1));
    }
#pragma unroll
    for (int i = 0; i < 8; ++i) { const int row = tid >> 2, kc = (tid & 3) + 4 * i; *(LAS u32x4*)(WB + row * MS + kc * 8) = *(const u32x4*)(Ms + row * 256 + kc * 8); }
    __syncthreads();
#pragma unroll
    for (int nt = 0; nt < 8; ++nt) {
        f32x4 a0 = {0.f, 0.f, 0.f, 0.f}, a1 = {0.f, 0.f, 0.f, 0.f};
#pragma unroll
        for (int ks = 0; ks < 8; ++ks) {
            const bf16x8 bf = *(const LAS bf16x8*)(WB + (16 * nt + fr) * MS + 32 * ks + 8 * fq);
            a0 = __builtin_amdgcn_mfma_f32_16x16x32_bf16(bf, Uf[0][ks], a0, 0, 0, 0);
            a1 = __builtin_amdgcn_mfma_f32_16x16x32_bf16(bf, Uf[1][ks], a1, 0, 0, 0);
        }
        *(LAS u32x2*)(ZB + (32 * wave + fr) * ZS + 16 * nt + 4 * fq) = (u32x2){cvt_pk_bf16(a0[0], a0[1]), cvt_pk_bf16(a0[2], a0[3])};
        *(LAS u32x2*)(ZB + (32 * wave + 16 + fr) * ZS + 16 * nt + 4 * fq) = (u32x2){cvt_pk_bf16(a1[0], a1[1]), cvt_pk_bf16(a1[2], a1[3])};
    }
    u32x4 tmr[6];
#pragma unroll
    for (int i = 0; i < 6; ++i) { const int row = tid >> 3, kc = (tid & 7) + 8 * i; tmr[i] = *(const u32x4*)(TM + (size_t)row * 384 + kc * 8); }
    __syncthreads();
    if (tid < 128) {
        const int bl = tid >> 6, p = tid & 63;
        const f32x2 al = ((const f32x2*)(P.ws + WS_SSMA))[g * 64 + p];
        float xr = 0.f, xi = 0.f;
        LAS unsigned* zw = (LAS unsigned*)ZB + (bl * 128) * (ZS / 2) + p;
        for (int c0 = 0; c0 < 128; c0 += 8) {
            unsigned zv[8];
#pragma unroll
            for (int k = 0; k < 8; ++k) zv[k] = zw[(c0 + k) * (ZS / 2)];
#pragma unroll
            for (int k = 0; k < 8; ++k) {
                zw[(c0 + k) * (ZS / 2)] = cvt_pk_bf16(xr, xi);
                const float t = al.x * xr - al.y * xi + bf_lo(zv[k]); xi = al.x * xi + al.y * xr + bf_hi(zv[k]); xr = t;
            }
        }
    }
#pragma unroll
    for (int i = 0; i < 6; ++i) { const int row = tid >> 3, kc = (tid & 7) + 8 * i; *(LAS u32x4*)(WB + row * TS + kc * 8) = tmr[i]; }
    __syncthreads();
    const LAS bf16_t* xrow = ZB + (32 * wave + fr) * ZS + 8 * fq;
    const f32x4 dv = *(const f32x4*)(P.in[12] + g * 16 + 4 * fq);
#pragma unroll
    for (int cq = 0; cq < 4; ++cq) {
        u32x2 uu[4][2];
#pragma unroll
        for (int ntl = 0; ntl < 4; ++ntl)
#pragma unroll
            for (int mt = 0; mt < 2; ++mt) uu[ntl][mt] = *(const u32x2*)(proj + (size_t)(tok0[mt] + 4 * cq + ntl) * NPROJ + g * 16 + 4 * fq);
        if (cq < 3) {
#pragma unroll
            for (int i = 0; i < 6; ++i) { const int row = tid >> 3, kc = (tid & 7) + 8 * i; tmr[i] = *(const u32x4*)(TM + (size_t)(64 * (cq + 1) + row) * 384 + kc * 8); }
        }
#pragma unroll
        for (int ntl = 0; ntl < 4; ++ntl) {
            const int nt = 4 * cq + ntl;
            f32x4 a0 = {0.f, 0.f, 0.f, 0.f}, a1 = {0.f, 0.f, 0.f, 0.f};
            const LAS bf16_t* brow = WB + (16 * ntl + fr) * TS + 8 * fq;
#pragma unroll
            for (int ks = 0; ks < 8; ++ks) {
                if (2 * ks <= nt) {
                    const bf16x8 bf = *(const LAS bf16x8*)(brow + 32 * ks);
                    a0 = __builtin_amdgcn_mfma_f32_16x16x32_bf16(bf, Uf[0][ks], a0, 0, 0, 0);
                    a1 = __builtin_amdgcn_mfma_f32_16x16x32_bf16(bf, Uf[1][ks], a1, 0, 0, 0);
                }
            }
#pragma unroll
            for (int k2 = 0; k2 < 4; ++k2) {
                const bf16x8 bf = *(const LAS bf16x8*)(brow + 256 + 32 * k2);
                const bf16x8 x0 = *(const LAS bf16x8*)(xrow + 32 * k2), x1 = *(const LAS bf16x8*)(xrow + 16 * ZS + 32 * k2);
                a0 = __builtin_amdgcn_mfma_f32_16x16x32_bf16(bf, x0, a0, 0, 0, 0);
                a1 = __builtin_amdgcn_mfma_f32_16x16x32_bf16(bf, x1, a1, 0, 0, 0);
            }
#pragma unroll
            for (int mt = 0; mt < 2; ++mt) {
                const f32x4 a = mt ? a1 : a0;
                const size_t tok = (size_t)(tok0[mt] + nt);
                const u32x2 u2 = uu[ntl][mt];
                const float y0 = a[0] + dv[0] * bf_lo(u2.x), y1 = a[1] + dv[1] * bf_hi(u2.x), y2 = a[2] + dv[2] * bf_lo(u2.y), y3 = a[3] + dv[3] * bf_hi(u2.y);
                u32x2 w; w.x = cvt_pk_bf16(gelu_tanh(y0), gelu_tanh(y1)); w.y = cvt_pk_bf16(gelu_tanh(y2), gelu_tanh(y3));
                *(u32x2*)(Zo + tok * 1024 + g * 16 + 4 * fq) = w;
            }
        }
        __syncthreads();
        if (cq < 3) {
#pragma unroll
            for (int i = 0; i < 6; ++i) { const int row = tid >> 3, kc = (tid & 7) + 8 * i; *(LAS u32x4*)(WB + row * TS + kc * 8) = tmr[i]; }
            __syncthreads();
        }
    }
}

__device__ __forceinline__ bf16x8 tr_frag(const LAS bf16_t* tile, int row0, int col0, int fr, int fq) {
    const LAS bf16_t* p = tile + (row0 + 8 * fq + (fr >> 2)) * 136 + col0 + 4 * (fr & 3);
    const bf16x4 a = __builtin_amdgcn_ds_read_tr16_b64_v4i16((LAS bf16x4*)p);
    const bf16x4 b = __builtin_amdgcn_ds_read_tr16_b64_v4i16((LAS bf16x4*)(p + 4 * 136));
    bf16x8 r; r[0] = a[0]; r[1] = a[1]; r[2] = a[2]; r[3] = a[3]; r[4] = b[0]; r[5] = b[1]; r[6] = b[2]; r[7] = b[3]; return r;
}
__device__ __forceinline__ void ret_kv_items(const Params& P, LAS unsigned char* lds, int tid, int first, int stride) {
    const int wave = __builtin_amdgcn_readfirstlane(tid >> 6), lane = tid & 63, fr = lane & 15, fq = lane >> 4;
    constexpr int RS = 136;
    LAS bf16_t* Ks = (LAS bf16_t*)lds; LAS bf16_t* Vs = Ks + 128 * RS;
    const bf16_t* proj = (const bf16_t*)(P.ws + WS_PROJ);
    bf16_t* KV = (bf16_t*)(P.ws + WS_KV);
    const int si = tid >> 2, part = tid & 3, i0 = 16 * wave;
    u32x4 kr[4], vr[4];
    int item = first;
    if (item >= 768) return;
    { const int bh = item / 12, n = item % 12; const bf16_t* pr = proj + ((size_t)(bh >> 3) * 2048 + n * 128 + si) * NPROJ + (bh & 7) * 128 + 32 * part;
#pragma unroll
      for (int j = 0; j < 4; ++j) { kr[j] = *(const u32x4*)(pr + 2048 + 8 * j); vr[j] = *(const u32x4*)(pr + 3072 + 8 * j); } }
    for (;;) {
#pragma unroll
        for (int j = 0; j < 4; ++j) { *(LAS u32x4*)(Ks + si * RS + 32 * part + 8 * j) = kr[j]; *(LAS u32x4*)(Vs + si * RS + 32 * part + 8 * j) = vr[j]; }
        __syncthreads();
        const int nxt = item + stride; const bool more = nxt < 768;
        if (more) { const int bh = nxt / 12, n = nxt % 12; const bf16_t* pr = proj + ((size_t)(bh >> 3) * 2048 + n * 128 + si) * NPROJ + (bh & 7) * 128 + 32 * part;
#pragma unroll
            for (int j = 0; j < 4; ++j) { kr[j] = *(const u32x4*)(pr + 2048 + 8 * j); vr[j] = *(const u32x4*)(pr + 3072 + 8 * j); } }
        bf16x8 Vt[4];
#pragma unroll
        for (int ks = 0; ks < 4; ++ks) Vt[ks] = tr_frag(Vs, 32 * ks, i0, fr, fq);
        const int bh = item / 12, n = item % 12;
        bf16_t* op = KV + ((size_t)(bh * 16 + n) * 128 + i0 + fr) * 128 + 4 * fq;
#pragma unroll
        for (int nt = 0; nt < 8; ++nt) {
            f32x4 a = {0.f, 0.f, 0.f, 0.f};
#pragma unroll
            for (int ks = 0; ks < 4; ++ks) { const bf16x8 kf = tr_frag(Ks, 32 * ks, 16 * nt, fr, fq); a = __builtin_amdgcn_mfma_f32_16x16x32_bf16(kf, Vt[ks], a, 0, 0, 0); }
            *(u32x2*)(op + 16 * nt) = (u32x2){cvt_pk_bf16(a[0], a[1]), cvt_pk_bf16(a[2], a[3])};
        }
        __syncthreads();
        if (!more) break;
        item = nxt;
    }
}
__device__ __forceinline__ void ret_out_item(const Params& P, LAS unsigned char* lds, int tid, int item) {
    const int bh = item >> 2, q = item & 3, b = bh >> 3, h = bh & 7;
    const int wave = __builtin_amdgcn_readfirstlane(tid >> 6), lane = tid & 63, fr = lane & 15, fq = lane >> 4;
    constexpr int RS = 136;
    LAS bf16_t* Qs = (LAS bf16_t*)lds;
    LAS bf16_t* Ks = Qs + 128 * RS;
    LAS bf16_t* Vs = Ks + 128 * RS;
    LAS bf16_t* Rs = Vs + 128 * RS;
    const bf16_t* proj = (const bf16_t*)(P.ws + WS_PROJ);
    const bf16_t* KV = (const bf16_t*)(P.ws + WS_KV);
    bf16_t* CAT = (bf16_t*)(P.ws + WS_CAT);
    const float gam = 1.0f - exp2f(-5.0f - (float)h);
    const float lg2 = log2f(gam);
    const float gC1 = exp2f(lg2 * 127.0f), gC = exp2f(lg2 * 128.0f);
    const int si = tid >> 2, part = tid & 3, i0 = 16 * wave;
    u32x4 st[12];
    { const bf16_t* pr = proj + ((size_t)b * 2048 + (4 * q) * 128 + si) * NPROJ + h * 128 + 32 * part;
#pragma unroll
      for (int j = 0; j < 4; ++j) { st[j] = *(const u32x4*)(pr + 1024 + 8 * j); st[4 + j] = *(const u32x4*)(pr + 2048 + 8 * j); st[8 + j] = *(const u32x4*)(pr + 3072 + 8 * j); } }
    f32x4 accR[8];
#pragma unroll
    for (int nt = 0; nt < 8; ++nt) accR[nt] = (f32x4){0.f, 0.f, 0.f, 0.f};
    for (int m = 0; m < 4 * q; ++m) {
        const bf16_t* tp = KV + ((size_t)(bh * 16 + m) * 128 + i0 + fr) * 128 + 4 * fq;
        u32x2 t[8];
#pragma unroll
        for (int nt = 0; nt < 8; ++nt) t[nt] = *(const u32x2*)(tp + 16 * nt);
#pragma unroll
        for (int nt = 0; nt < 8; ++nt) { const f32x4 kv = {bf_lo(t[nt].x), bf_hi(t[nt].x), bf_lo(t[nt].y), bf_hi(t[nt].y)}; accR[nt] = accR[nt] * gC + kv * gC1; }
    }
#pragma unroll
    for (int nt = 0; nt < 8; ++nt)
        *(LAS u32x2*)(Rs + (i0 + fr) * RS + 16 * nt + 4 * fq) = (u32x2){cvt_pk_bf16(accR[nt][0], accR[nt][1]), cvt_pk_bf16(accR[nt][2], accR[nt][3])};
    for (int nn = 0; nn < 4; ++nn) {
        const int n = 4 * q + nn;
#pragma unroll
        for (int j = 0; j < 4; ++j) { *(LAS u32x4*)(Qs + si * RS + 32 * part + 8 * j) = st[j]; *(LAS u32x4*)(Ks + si * RS + 32 * part + 8 * j) = st[4 + j]; *(LAS u32x4*)(Vs + si * RS + 32 * part + 8 * j) = st[8 + j]; }
        __syncthreads();
        if (nn < 3) { const bf16_t* pr = proj + ((size_t)b * 2048 + (n + 1) * 128 + si) * NPROJ + h * 128 + 32 * part;
#pragma unroll
            for (int j = 0; j < 4; ++j) { st[j] = *(const u32x4*)(pr + 1024 + 8 * j); st[4 + j] = *(const u32x4*)(pr + 2048 + 8 * j); st[8 + j] = *(const u32x4*)(pr + 3072 + 8 * j); } }
        const size_t tok = (size_t)b * 2048 + n * 128 + i0 + fr;
        u32x2 gg[8];
        { const bf16_t* gp = proj + tok * NPROJ + 4096 + h * 128 + 4 * fq;
#pragma unroll
          for (int nt = 0; nt < 8; ++nt) gg[nt] = *(const u32x2*)(gp + 16 * nt); }
        bf16x8 Qf[4];
#pragma unroll
        for (int ks = 0; ks < 4; ++ks) Qf[ks] = *(const LAS bf16x8*)(Qs + (i0 + fr) * RS + 32 * ks + 8 * fq);
        f32x4 accS[8], accO[8];
#pragma unroll
        for (int nt = 0; nt < 8; ++nt) { accS[nt] = (f32x4){0.f, 0.f, 0.f, 0.f}; accO[nt] = (f32x4){0.f, 0.f, 0.f, 0.f}; }
#pragma unroll
        for (int nt = 0; nt < 8; ++nt) {
            if (nt <= wave) {
#pragma unroll
                for (int ks = 0; ks < 4; ++ks) { const bf16x8 kf = *(const LAS bf16x8*)(Ks + (16 * nt + fr) * RS + 32 * ks + 8 * fq); accS[nt] = __builtin_amdgcn_mfma_f32_16x16x32_bf16(kf, Qf[ks], accS[nt], 0, 0, 0); }
            }
        }
        if (n > 0) {
#pragma unroll
            for (int nt = 0; nt < 8; ++nt) {
#pragma unroll
                for (int ks = 0; ks < 4; ++ks) { const bf16x8 rf = *(const LAS bf16x8*)(Rs + (16 * nt + fr) * RS + 32 * ks + 8 * fq); accO[nt] = __builtin_amdgcn_mfma_f32_16x16x32_bf16(rf, Qf[ks], accO[nt], 0, 0, 0); }
                accO[nt] *= gam;
            }
        }
#pragma unroll
        for (int nt = 0; nt < 8; ++nt) {
            const int i = i0 + fr, j0 = 16 * nt + 4 * fq;
            const float p0 = (j0 <= i) ? accS[nt][0] : 0.f, p1 = (j0 + 1 <= i) ? accS[nt][1] : 0.f, p2 = (j0 + 2 <= i) ? accS[nt][2] : 0.f, p3 = (j0 + 3 <= i) ? accS[nt][3] : 0.f;
            *(LAS u32x2*)(Qs + i * RS + j0) = (u32x2){cvt_pk_bf16(p0, p1), cvt_pk_bf16(p2, p3)};
        }
        asm volatile("" ::: "memory");
        bf16x8 Pf[4];
#pragma unroll
        for (int ks = 0; ks < 4; ++ks) Pf[ks] = *(const LAS bf16x8*)(Qs + (i0 + fr) * RS + 32 * ks + 8 * fq);
#pragma unroll
        for (int ks = 0; ks < 4; ++ks) {
            if (2 * ks <= wave) {
#pragma unroll
                for (int nt = 0; nt < 8; ++nt) { const bf16x8 vf = tr_frag(Vs, 32 * ks, 16 * nt, fr, fq); accO[nt] = __builtin_amdgcn_mfma_f32_16x16x32_bf16(vf, Pf[ks], accO[nt], 0, 0, 0); }
            }
        }
        if (nn < 3) {
            bf16x8 Vt[4];
#pragma unroll
            for (int ks = 0; ks < 4; ++ks) Vt[ks] = tr_frag(Vs, 32 * ks, i0, fr, fq);
#pragma unroll
            for (int nt = 0; nt < 8; ++nt) {
                accR[nt] *= gam;
#pragma unroll
                for (int ks = 0; ks < 4; ++ks) { const bf16x8 kf = tr_frag(Ks, 32 * ks, 16 * nt, fr, fq); accR[nt] = __builtin_amdgcn_mfma_f32_16x16x32_bf16(kf, Vt[ks], accR[nt], 0, 0, 0); }
                accR[nt] *= gC1;
            }
        }
        {
            float s = 0.f;
#pragma unroll
            for (int nt = 0; nt < 8; ++nt) s += (accO[nt][0] + accO[nt][1]) + (accO[nt][2] + accO[nt][3]);
            s += __shfl_xor(s, 16); s += __shfl_xor(s, 32);
            const float mu = s * (1.0f / 128.0f); float qv = 0.f;
#pragma unroll
            for (int nt = 0; nt < 8; ++nt) { const f32x4 d = accO[nt] - mu; qv += (d[0] * d[0] + d[1] * d[1]) + (d[2] * d[2] + d[3] * d[3]); }
            qv += __shfl_xor(qv, 16); qv += __shfl_xor(qv, 32);
            const float rstd = rsqrtf(qv * (1.0f / 128.0f) + 1e-5f);
            bf16_t* op = CAT + tok * DM + 1024 + h * 128 + 4 * fq;
#pragma unroll
            for (int nt = 0; nt < 8; ++nt) {
                const float g0 = bf_lo(gg[nt].x), g1 = bf_hi(gg[nt].x), g2 = bf_lo(gg[nt].y), g3 = bf_hi(gg[nt].y);
                const f32x4 y = (accO[nt] - mu) * rstd;
                u32x2 w; w.x = cvt_pk_bf16(y[0] * g0 * sigmoidf_(g0), y[1] * g1 * sigmoidf_(g1)); w.y = cvt_pk_bf16(y[2] * g2 * sigmoidf_(g2), y[3] * g3 * sigmoidf_(g3));
                *(u32x2*)(op + 16 * nt) = w;
            }
        }
        __syncthreads();
        if (nn < 3) {
#pragma unroll
            for (int nt = 0; nt < 8; ++nt)
                *(LAS u32x2*)(Rs + (i0 + fr) * RS + 16 * nt + 4 * fq) = (u32x2){cvt_pk_bf16(accR[nt][0], accR[nt][1]), cvt_pk_bf16(accR[nt][2], accR[nt][3])};
        }
    }
}

__device__ __forceinline__ void p6_route(const Params& P, LAS unsigned char* lds, int tid, int blk, int G) {
    const int wave = __builtin_amdgcn_readfirstlane(tid >> 6), lane = tid & 63, fr = lane & 15, fq = lane >> 4;
    LAS float* gm = (LAS float*)lds; LAS float* sh = gm + 2048; LAS float* lg = sh + 2048;
    LAS float* lgr = lg + 8 * 64 * 48;
    LAS float* r2s = lgr + 64 * 36;
    LAS int* lcnt = (LAS int*)(r2s + 64); LAS int* lbase = lcnt + 32;
    int ra_ = 0, rb_ = 0, ea_ = 0, eb_ = 0; float w1_ = 0.f, w2_ = 0.f;
    const float* mod = (const float*)(P.ws + WS_MOD);
    const bf16_t* x1 = (const bf16_t*)(P.ws + WS_X1); const float* rowss2 = (const float*)(P.ws + WS_ROWSS2);
    unsigned char* H2 = P.ws + WS_H;
    const bf16_t* WR = (const bf16_t*)(P.ws + WS_WR);
    int* cnt = (int*)(P.ws + WS_CNT); int* list = (int*)(P.ws + WS_LIST); float* wgt = (float*)(P.ws + WS_WGT);
    for (int rb = blk; rb < 256; rb += G) {
        const int b = rb >> 5;
        for (int k = tid; k < 2048; k += NTHREADS) { gm[k] = P.in[18][k] * (1.0f + mod[(size_t)b * NMOD + 4 * DM + k]); sh[k] = mod[(size_t)b * NMOD + 3 * DM + k]; }
        if (tid < 32) lcnt[tid] = 0;
        if (tid >= 64 && tid < 128) { const int r = tid - 64; float tot2 = 0.f; const f32x4* pp = (const f32x4*)(rowss2 + (size_t)(rb * 64 + r) * 32);
#pragma unroll
            for (int i = 0; i < 8; ++i) { const f32x4 v = pp[i]; tot2 += (v[0] + v[1]) + (v[2] + v[3]); }
            r2s[r] = rsqrtf(tot2 * (1.0f / 2048.0f) + 1e-6f); }
        __syncthreads();
        float r2v[4];
#pragma unroll
        for (int mt = 0; mt < 4; ++mt) r2v[mt] = r2s[16 * mt + fr];
        f32x4 acc[4][3];
#pragma unroll
        for (int mt = 0; mt < 4; ++mt)
#pragma unroll
            for (int nt = 0; nt < 3; ++nt) acc[mt][nt] = (f32x4){0.f, 0.f, 0.f, 0.f};
        const bf16_t* xb = x1 + (size_t)(rb * 64 + fr) * DM + 256 * wave + 8 * fq;
        const bf16_t* wb = WR + (size_t)fr * 2048 + 256 * wave + 8 * fq;
        unsigned char* hb = H2 + (size_t)(rb * 64 + fr) * DM + 256 * wave + 8 * fq;
        u32x4 xc[2][4], xn[2][4]; bf16x8 bc[2][3], bn[2][3];
#pragma unroll
        for (int j = 0; j < 2; ++j) {
#pragma unroll
            for (int mt = 0; mt < 4; ++mt) xc[j][mt] = *(const u32x4*)(xb + (size_t)(16 * mt) * DM + 32 * j);
#pragma unroll
            for (int nt = 0; nt < 3; ++nt) bc[j][nt] = *(const bf16x8*)(wb + (size_t)(16 * nt) * 2048 + 32 * j); }
#pragma unroll 1
        for (int qt = 0; qt < 4; ++qt) {
            const int qn = qt < 3 ? qt + 1 : 3;
#pragma unroll
            for (int j = 0; j < 2; ++j) {
#pragma unroll
                for (int mt = 0; mt < 4; ++mt) xn[j][mt] = *(const u32x4*)(xb + (size_t)(16 * mt) * DM + 32 * (2 * qn + j));
#pragma unroll
                for (int nt = 0; nt < 3; ++nt) bn[j][nt] = *(const bf16x8*)(wb + (size_t)(16 * nt) * 2048 + 32 * (2 * qn + j)); }
#pragma unroll
            for (int j = 0; j < 2; ++j) {
                const int kl = 256 * wave + 32 * (2 * qt + j) + 8 * fq;
                const f32x4 g0 = *(const LAS f32x4*)(gm + kl), g1 = *(const LAS f32x4*)(gm + kl + 4), s0 = *(const LAS f32x4*)(sh + kl), s1 = *(const LAS f32x4*)(sh + kl + 4);
#pragma unroll
                for (int mt = 0; mt < 4; ++mt) {
                    const u32x4 xw = xc[j][mt];
                    const f32x4 a = {bf_lo(xw.x), bf_hi(xw.x), bf_lo(xw.y), bf_hi(xw.y)}, c = {bf_lo(xw.z), bf_hi(xw.z), bf_lo(xw.w), bf_hi(xw.w)};
                    const f32x4 h0 = a * r2v[mt] * g0 + s0, h1 = c * r2v[mt] * g1 + s1;
                    u32x4 w; w.x = cvt_pk_bf16(h0[0], h0[1]); w.y = cvt_pk_bf16(h0[2], h0[3]); w.z = cvt_pk_bf16(h1[0], h1[1]); w.w = cvt_pk_bf16(h1[2], h1[3]);
                    int q0 = 0, q1 = 0;
                    q0 = __builtin_amdgcn_cvt_pk_fp8_f32(h0[0], h0[1], q0, false); q0 = __builtin_amdgcn_cvt_pk_fp8_f32(h0[2], h0[3], q0, true);
                    q1 = __builtin_amdgcn_cvt_pk_fp8_f32(h1[0], h1[1], q1, false); q1 = __builtin_amdgcn_cvt_pk_fp8_f32(h1[2], h1[3], q1, true);
                    *(u32x2*)(hb + (size_t)(16 * mt) * DM + 32 * (2 * qt + j)) = (u32x2){(unsigned)q0, (unsigned)q1};
                    const bf16x8 af = __builtin_bit_cast(bf16x8, w);
#pragma unroll
                    for (int nt = 0; nt < 3; ++nt) acc[mt][nt] = __builtin_amdgcn_mfma_f32_16x16x32_bf16(bc[j][nt], af, acc[mt][nt], 0, 0, 0);
                }
            }
#pragma unroll
            for (int j = 0; j < 2; ++j) {
#pragma unroll
                for (int mt = 0; mt < 4; ++mt) xc[j][mt] = xn[j][mt];
#pragma unroll
                for (int nt = 0; nt < 3; ++nt) bc[j][nt] = bn[j][nt]; }
        }
#pragma unroll
        for (int mt = 0; mt < 4; ++mt)
#pragma unroll
            for (int nt = 0; nt < 3; ++nt) *(LAS f32x4*)(lg + (wave * 64 + 16 * mt + fr) * 48 + 16 * nt + 4 * fq) = acc[mt][nt];
        __syncthreads();
        for (int o = tid; o < 64 * 36; o += NTHREADS) { const int r = o / 36, nn = o % 36; float sum = 0.f;
#pragma unroll
            for (int w = 0; w < 8; ++w) sum += lg[(w * 64 + r) * 48 + nn];
            lgr[o] = sum; }
        __syncthreads();
        if (tid < 64) {
            const int tok = rb * 64 + tid;
            float l[36];
#pragma unroll
            for (int nn = 0; nn < 36; ++nn) l[nn] = lgr[tid * 36 + nn];
            float gl[4]; int gs = 0;
#pragma unroll
            for (int j = 0; j < 4; ++j) gl[j] = l[j] + P.in[20][j];
#pragma unroll
            for (int j = 1; j < 4; ++j) if (gl[j] > gl[gs]) gs = j;
            float gmax = gl[0];
#pragma unroll
            for (int j = 1; j < 4; ++j) gmax = fmaxf(gmax, gl[j]);
            float den = 0.f;
#pragma unroll
            for (int j = 0; j < 4; ++j) den += expf(gl[j] - gmax);
            const float gw = 1.0f / den;
            float el[8];
#pragma unroll
            for (int j = 0; j < 8; ++j) { float v = 0.f;
#pragma unroll
                for (int q = 0; q < 4; ++q) v = (gs == q) ? (l[4 + q * 8 + j] + P.in[22][q * 8 + j]) : v;
                el[j] = v; }
            int j1 = 0;
#pragma unroll
            for (int j = 1; j < 8; ++j) if (el[j] > el[j1]) j1 = j;
            int j2 = (j1 == 0) ? 1 : 0;
#pragma unroll
            for (int j = 0; j < 8; ++j) if (j != j1 && j != j2 && el[j] > el[j2]) j2 = j;
            float e1 = el[0], e2 = el[0];
#pragma unroll
            for (int j = 0; j < 8; ++j) { e1 = (j == j1) ? el[j] : e1; e2 = (j == j2) ? el[j] : e2; }
            const float t2 = expf(e2 - e1), w1 = gw / (1.0f + t2), w2 = gw * t2 / (1.0f + t2);
            const int ea = gs * 8 + j1, eb = gs * 8 + j2;
            ra_ = atomicAdd((int*)&lcnt[ea], 1); rb_ = atomicAdd((int*)&lcnt[eb], 1); ea_ = ea; eb_ = eb; w1_ = w1; w2_ = w2;
        }
        __syncthreads();
        if (tid < 32) { const int c = lcnt[tid]; lbase[tid] = c > 0 ? atomicAdd(cnt + tid * 64, c) : 0; }
        __syncthreads();
        if (tid < 64) {
            const int tok = rb * 64 + tid;
            list[ea_ * 16384 + lbase[ea_] + ra_] = tok * 2; wgt[tok * 2] = w1_;
            list[eb_ * 16384 + lbase[eb_] + rb_] = tok * 2 + 1; wgt[tok * 2 + 1] = w2_;
        }
        __syncthreads();
    }
}

__device__ __forceinline__ void p9_final(const Params& P, int tid, int blk, int G) {
    const int wave = tid >> 6, lane = tid & 63;
    const float* mod = (const float*)(P.ws + WS_MOD); const unsigned char* Y2 = P.ws + WS_Y2; const bf16_t* X1 = (const bf16_t*)(P.ws + WS_X1);
    f32x4 gf[8];
#pragma unroll
    for (int i = 0; i < 8; ++i) gf[i] = *(const f32x4*)(P.in[26] + (i * 64 + lane) * 4);
    int row = blk * 8 + wave;
    u32x2 xw[8], xwn[8]; unsigned ya[8], yb[8], yan[8], ybn[8];
    if (row < NTOK) {
#pragma unroll
        for (int i = 0; i < 8; ++i) { const int k = (i * 64 + lane) * 4; xw[i] = *(const u32x2*)(X1 + (size_t)row * DM + k); ya[i] = *(const unsigned*)(Y2 + (size_t)(2 * row) * DM + k); yb[i] = *(const unsigned*)(Y2 + (size_t)(2 * row + 1) * DM + k); }
    }
    for (; row < NTOK; row += G * 8) {
        const int b = row >> 11, rown = row + G * 8;
        if (rown < NTOK) {
#pragma unroll
            for (int i = 0; i < 8; ++i) { const int k = (i * 64 + lane) * 4; xwn[i] = *(const u32x2*)(X1 + (size_t)rown * DM + k); yan[i] = *(const unsigned*)(Y2 + (size_t)(2 * rown) * DM + k); ybn[i] = *(const unsigned*)(Y2 + (size_t)(2 * rown + 1) * DM + k); }
        }
        f32x4 v[8]; float ss = 0.f;
#pragma unroll
        for (int i = 0; i < 8; ++i) {
            const int k = (i * 64 + lane) * 4;
            const f32x4 xv = {bf_lo(xw[i].x), bf_hi(xw[i].x), bf_lo(xw[i].y), bf_hi(xw[i].y)};
            const f32x4 gt = *(const f32x4*)(mod + (size_t)b * NMOD + 5 * DM + k) * (1.0f / Y2_SCALE);
            const f32x2 a0 = __builtin_amdgcn_cvt_pk_f32_fp8((int)ya[i], false), a1 = __builtin_amdgcn_cvt_pk_f32_fp8((int)ya[i], true);
            const f32x2 b0 = __builtin_amdgcn_cvt_pk_f32_fp8((int)yb[i], false), b1 = __builtin_amdgcn_cvt_pk_f32_fp8((int)yb[i], true);
            const f32x4 y = {a0[0] + b0[0], a0[1] + b0[1], a1[0] + b1[0], a1[1] + b1[1]};
            v[i] = xv + gt * y;
            ss += v[i][0] * v[i][0] + v[i][1] * v[i][1] + v[i][2] * v[i][2] + v[i][3] * v[i][3];
        }
        ss = wave_sum(ss);
        const float r = rsqrtf(ss * (1.0f / 2048.0f) + 1e-6f);
        float* xr = P.out + (size_t)row * DM;
#pragma unroll
        for (int i = 0; i < 8; ++i) { const int k = (i * 64 + lane) * 4; *(f32x4*)(xr + k) = v[i] * r * gf[i]; }
#pragma unroll
        for (int i = 0; i < 8; ++i) { xw[i] = xwn[i]; ya[i] = yan[i]; yb[i] = ybn[i]; }
    }
}

__global__ void __launch_bounds__(NTHREADS, 2) hymba_fwd(Params P) {
    extern __shared__ __attribute__((aligned(16))) unsigned char lds_raw[];
    LAS unsigned char* lds = (LAS unsigned char*)lds_raw;
    const int tid = threadIdx.x, blk = blockIdx.x, G = gridDim.x;
    volatile LAS unsigned* misc = (volatile LAS unsigned*)(lds + LDS_MISC);
    if (tid < 64) misc[tid] = 0u;
    __syncthreads();
    XcdBarrier bar = xcd_barrier_post((unsigned*)(P.ws + WS_BAR), misc);
    const int lo = P.ph_lo, hi = P.ph_hi;
#define IN(k) (lo <= (k) && (k) < hi)
#define SEAM(k) do { if (IN(k) && IN((k) + 1)) xcd_barrier(bar); } while (0)
    unsigned char* ws = P.ws;

#ifndef REPR
#define REPR 1
#endif
#ifndef REPS
#define REPS 1
#endif
#ifndef REP0
#define REP0 1
#endif
#ifndef REP2
#define REP2 1
#endif
#ifndef REP7
#define REP7 1
#endif
#ifndef REP8
#define REP8 1
#endif
    if (IN(0)) for (int rep0 = 0; rep0 < REP0; ++rep0) {
        for (int it = blk; it < 256; it += G) p0_adaln(P, lds, tid, it);
        for (int it = blk; it < 256; it += G) p0_ssm_mats(P, lds, tid, it);
        p0_misc(P, tid, blk, G);
        p0_convert(P, lds, tid, blk, G);
    }
    SEAM(0);
    if (IN(1)) p1_norm1(P, lds, tid, blk, G);
    SEAM(1);
    if (IN(2)) {
        DenseSched S; S.init(NTOK, NPROJ, G, blk); S.abase = (unsigned)WS_H; S.bbase = (unsigned)WS_WIN; S.lda = DM; S.ldb = DM;
        EpiInProj E{(bf16_t*)(ws + WS_PROJ)};
        const int nu = (S.nwg - blk + G - 1) / G;
        int slot = (blk & 7) % 6; slot = slot < nu ? slot : nu;
#pragma unroll 1
        for (int part = 0; part < 2; ++part) {
            S.ioff = part ? slot : 0; S.iend = part ? (1 << 30) : slot;
            g8::gemm_phase(lds, ws, DM / 64, DM, S, E);
            if (part == 0) { __syncthreads(); int tid2 = tid, blk2 = blk; asm volatile("" : "+v"(tid2), "+s"(blk2));
                p0_convert_fp8(P, lds, tid2, blk2, G, 0, 12288); }
        }
    }
    SEAM(2);
    if (IN(3)) {
        for (int it = blk; it < 256; it += G) ssm_item(P, lds, tid, it);
        ret_kv_items(P, lds, tid, blk, G);
    }
    SEAM(3);
    if (IN(4)) {
        for (int it = blk; it < 256; it += G) ret_out_item(P, lds, tid, it);
        __syncthreads();
        DenseSched S; S.init(NTOK, 1024, G, blk); S.abase = (unsigned)WS_Z; S.bbase = (unsigned)WS_WGLU; S.lda = 1024; S.ldb = 1024;
        EpiGlu E{(const bf16_t*)(ws + WS_Z), (bf16_t*)(ws + WS_CAT), (float*)(ws + WS_ROWSS1)};
        g8::gemm_phase(lds, ws, 1024 / 64, 1024, S, E);
    }
    SEAM(4);
    if (IN(5)) {
        OutSched S; S.init(NTOK, DM, G, blk); S.abase = (unsigned)WS_CAT; S.bbase = (unsigned)WS_WOUT;
        EpiOut E{P.in[0], (const float*)(ws + WS_MOD), (const float*)(ws + WS_ROWSS1), (float*)(ws + WS_ROWSS2), (bf16_t*)(ws + WS_X1)};
        g8::gemm_phase(lds, ws, 1024 / 64, DM, S, E);
    }
    SEAM(5);
    if (IN(6)) p6_route(P, lds, tid, blk, G);
    SEAM(6);
    if (IN(7) || IN(8)) {
        LAS int* tinfo = (LAS int*)(lds + LDS_MISC + 256); LAS int* trows = tinfo + 192; LAS int* ntl = trows + 192;
        if (tid == 0) {
            const int* cg = (const int*)(ws + WS_CNT); int nt_ = 0;
            for (int e = 0; e < 32; ++e) { const int c = cg[e * 64], full = c >> 8, rem = c & 255;
                for (int t = 0; t < full; ++t) { tinfo[nt_] = e | ((t * 256) << 8); trows[nt_] = 256; ++nt_; }
                if (rem > 128) { tinfo[nt_] = e | ((full * 256) << 8); trows[nt_] = rem; ++nt_; } }
            for (int e = 0; e < 32; ++e) { const int c = cg[e * 64], full = c >> 8, rem = c & 255; if (rem > 64 && rem <= 128) { tinfo[nt_] = e | ((full * 256) << 8); trows[nt_] = rem; ++nt_; } }
            for (int e = 0; e < 32; ++e) { const int c = cg[e * 64], full = c >> 8, rem = c & 255; if (rem > 0 && rem <= 64) { tinfo[nt_] = e | ((full * 256) << 8); trows[nt_] = rem; ++nt_; } }
            ntl[0] = nt_;
        }
        __syncthreads();
        const int ntiles = __builtin_amdgcn_readfirstlane(ntl[0]);
        if (IN(7)) {
            { u32x2* slot = (u32x2*)(ws + WS_SLOT); const int* lst = (const int*)(ws + WS_LIST); const float* wg = (const float*)(ws + WS_WGT);
              for (int ti = blk; ti < ntiles; ti += G) if (tid < 256) {
                  const int inf = tinfo[ti], e = inf & 255, r0 = inf >> 8, n = trows[ti];
                  u32x2 v; v.x = 0xffffffffu; v.y = 0u;
                  if (tid < n) { const int asg = lst[e * 16384 + r0 + tid]; v.x = (unsigned)asg; v.y = __float_as_uint(wg[asg] * (1.0f / WD_SCALE)); }
                  slot[ti * 256 + tid] = v; } }
            MoeSched S{tinfo, trows, ntiles, G, blk, (const int*)(ws + WS_LIST), (unsigned)WS_H, (unsigned)WS_WGU, 0};
            EpiMoe1 E{ws + WS_HM};
            g8::gemm_phase<EpiMoe1, MoeSched, true, 2>(lds, ws, DM / 128, DM, S, E);
        }
        SEAM(7);
        if (IN(8)) {
            MoeSched S{tinfo, trows, ntiles, G, blk, (const int*)(ws + WS_LIST), (unsigned)WS_HM, (unsigned)WS_WD, 1};
            EpiMoe2 E{(const u32x2*)(ws + WS_SLOT), ws + WS_Y2};
            g8::gemm_phase<EpiMoe2, MoeSched, true, 2>(lds, ws, DEXP / 128, DEXP, S, E);
        }
    }
    SEAM(8);
    if (IN(9)) p9_final(P, tid, blk, G);
#undef IN
#undef SEAM
}

#ifndef N_LAUNCH_SPLIT
#define N_LAUNCH_SPLIT 0
#endif
extern "C" void kernel_launch(void* const* d_in, const int* in_sizes, int n_in, void* d_out, int out_size, void* d_ws, size_t ws_size, hipStream_t stream) {
    static int grid = 0;
    if (grid == 0) {
        if (n_in != 27 || out_size != NTOK * DM || ws_size < WS_END) { fprintf(stderr, "kernel_launch: unexpected shapes (n_in %d out %d ws %zu need %zu)\n", n_in, out_size, ws_size, (size_t)WS_END); grid = -1; return; }
        int dev = 0, cus = 0, per_cu = 0;
        if (hipGetDevice(&dev) != hipSuccess || hipDeviceGetAttribute(&cus, hipDeviceAttributeMultiprocessorCount, dev) != hipSuccess) { grid = -1; return; }
        if (hipFuncSetAttribute((const void*)hymba_fwd, hipFuncAttributeMaxDynamicSharedMemorySize, LDS_BYTES) != hipSuccess) { fprintf(stderr, "kernel_launch: hipFuncSetAttribute failed\n"); grid = -1; return; }
        if (hipOccupancyMaxActiveBlocksPerMultiprocessor(&per_cu, (const void*)hymba_fwd, NTHREADS, LDS_BYTES) != hipSuccess || per_cu < 1) { fprintf(stderr, "kernel_launch: occupancy query says %d\n", per_cu); }
        (void)hipGetLastError();
        grid = cus;
    }
    if (grid < 0) return;
    (void)hipMemsetAsync((char*)d_ws + WS_BAR, 0, 16384, stream);
    Params p{};
    for (int i = 0; i < 27; ++i) p.in[i] = (const float*)d_in[i];
    p.out = (float*)d_out; p.ws = (unsigned char*)d_ws;
#if N_LAUNCH_SPLIT
    for (int ph = 0; ph < 10; ++ph) { p.ph_lo = ph; p.ph_hi = ph + 1; hipLaunchKernelGGL(hymba_fwd, dim3(grid), dim3(NTHREADS), LDS_BYTES, stream, p); }
#else
    p.ph_lo = 0; p.ph_hi = 10;
    hipLaunchKernelGGL(hymba_fwd, dim3(grid), dim3(NTHREADS), LDS_BYTES, stream, p);
#endif
    const hipError_t le = hipPeekAtLastError();
    if (le != hipSuccess) fprintf(stderr, "kernel_launch: launch failed: %s\n", hipGetErrorName(le));
}
```
